# Optimizing an MI355X kernel written in HIP

```python
import jax, jax.numpy as jnp
from jax import lax
import numpy as np

D_MODEL = 1024
BATCH = 16
SEQ = 2048
DEPTH = 2

HEAD_DIM = 64
N_HEADS_A = D_MODEL // (2 * HEAD_DIM)
N_HEADS_B = D_MODEL // (2 * HEAD_DIM)
N_HEADS_D = D_MODEL // (2 * HEAD_DIM)
POOL_SIZES = (2, 4, 8, 16)
POOL_WIDTH = D_MODEL // 2
POOL_GROUP = POOL_WIDTH // len(POOL_SIZES)
Q_BLOCK = 128
MOBA_BLOCK = 256
MOBA_TOPK = 3
MOBA_Q_CHUNK = 16
PEER_HEADS = 8
PEER_NKEYS = 128
PEER_EXPERTS = PEER_NKEYS * PEER_NKEYS
PEER_TOPK = 16
PEER_DKEY = 256
PEER_TOKEN_CHUNK = 128
RMS_EPS = 1e-6
N_EVEN = (DEPTH + 1) // 2
N_ODD = DEPTH // 2
EVEN_IN = 3 * N_HEADS_A * HEAD_DIM + N_HEADS_A + 3 * N_HEADS_B * HEAD_DIM
ODD_IN = POOL_WIDTH + 3 * N_HEADS_D * HEAD_DIM
MIX_OUT = (N_HEADS_A + N_HEADS_B) * HEAD_DIM

kernel_name = 'hybrid_fox_stickbreak_pool_moba_peer'


def rmsnorm(x, g):
    xf = x.astype(jnp.float32)
    y = xf * lax.rsqrt(jnp.mean(xf * xf, axis=-1, keepdims=True) + RMS_EPS)
    return (y * g.astype(jnp.float32)).astype(x.dtype)


def split_heads(t, n_heads):
    b, s, _ = t.shape
    return t.reshape(b, s, n_heads, HEAD_DIM).transpose(0, 2, 1, 3)


def merge_heads(t):
    b, h, s, d = t.shape
    return t.transpose(0, 2, 1, 3).reshape(b, s, h * d)


def alibi_slopes(n_heads):
    return jnp.exp2(-8.0 * jnp.arange(1, n_heads + 1, dtype=jnp.float32) / n_heads)


def forgetting_attention(q, k, v, log_f):
    b, h, s, dh = q.shape
    scale = dh ** -0.5
    c = jnp.cumsum(log_f, axis=-1)
    outs = []
    for i in range(s // Q_BLOCK):
        lo, hi = i * Q_BLOCK, (i + 1) * Q_BLOCK
        lg = jnp.einsum('bhqd,bhkd->bhqk', q[:, :, lo:hi], k[:, :, :hi]).astype(jnp.float32) * scale
        lg = lg + c[:, :, lo:hi, None] - c[:, :, None, :hi]
        causal = jnp.arange(hi)[None, :] <= jnp.arange(lo, hi)[:, None]
        lg = jnp.where(causal, lg, -jnp.inf)
        p = jax.nn.softmax(lg, axis=-1).astype(v.dtype)
        outs.append(jnp.einsum('bhqk,bhkd->bhqd', p, v[:, :, :hi]))
    return jnp.concatenate(outs, axis=2)


def stick_breaking_attention(q, k, v):
    b, h, s, dh = q.shape
    scale = dh ** -0.5
    outs = []
    for i in range(s // Q_BLOCK):
        lo, hi = i * Q_BLOCK, (i + 1) * Q_BLOCK
        z = jnp.einsum('bhqd,bhkd->bhqk', q[:, :, lo:hi], k[:, :, :hi]).astype(jnp.float32) * scale
        strict = jnp.arange(hi)[None, :] < jnp.arange(lo, hi)[:, None]
        lsn = jnp.where(strict, jax.nn.log_sigmoid(-z), 0.0)
        tail = lax.cumsum(lsn, axis=3, reverse=True) - lsn
        a = jnp.where(strict, jnp.exp(jax.nn.log_sigmoid(z) + tail), 0.0)
        outs.append(jnp.einsum('bhqk,bhkd->bhqd', a.astype(v.dtype), v[:, :, :hi]))
    return jnp.concatenate(outs, axis=2)


def multiscale_pool(xc, pool_w, pool_scale):
    b, s, _ = xc.shape
    xg = xc.reshape(b, s, len(POOL_SIZES), POOL_GROUP)
    count = jnp.arange(1, s + 1, dtype=jnp.float32)
    outs = []
    for g, w in enumerate(POOL_SIZES):
        xf = xg[:, :, g].astype(jnp.float32)
        cs = jnp.pad(jnp.cumsum(xf, axis=1), ((0, 0), (1, 0), (0, 0)))
        lag = jnp.pad(cs[:, :s - w + 1], ((0, 0), (w - 1, 0), (0, 0)))
        mean = (cs[:, 1:] - lag) / jnp.minimum(count, float(w))[None, :, None]
        outs.append(jnp.einsum('bsc,cd->bsd', (mean - xf).astype(xc.dtype), pool_w[g]))
    return jnp.concatenate(outs, axis=-1) * pool_scale


def moba_attention(q, k, v):
    b, h, s, dh = q.shape
    scale = dh ** -0.5
    nb = -(-s // MOBA_BLOCK)
    sp = nb * MOBA_BLOCK
    padw = ((0, 0), (0, 0), (0, sp - s), (0, 0))
    qp, kp, vp = jnp.pad(q, padw), jnp.pad(k, padw), jnp.pad(v, padw)
    kblk = kp.reshape(b, h, nb, MOBA_BLOCK, dh)
    vblk = vp.reshape(b, h, nb, MOBA_BLOCK, dh)
    kmean = jnp.mean(kblk.astype(jnp.float32), axis=3)
    gate = jnp.einsum('bhtd,bhnd->bhtn', qp.astype(jnp.float32), kmean)
    q_block = jnp.arange(sp) // MOBA_BLOCK
    past = jnp.arange(nb)[None, :] < q_block[:, None]
    gate = jnp.where(past, gate, -jnp.inf)
    n_sel = max(1, min(MOBA_TOPK, nb - 1))
    _, sel = lax.top_k(gate, n_sel)
    sel_valid = sel < q_block[None, None, :, None]
    slopes = alibi_slopes(h)[None, :, None, None]
    b_ix = jnp.arange(b)[:, None, None, None]
    h_ix = jnp.arange(h)[None, :, None, None]

    def chunk(c):
        t0 = c * MOBA_Q_CHUNK
        qc = lax.dynamic_slice_in_dim(qp, t0, MOBA_Q_CHUNK, axis=2)
        sc = lax.dynamic_slice_in_dim(sel, t0, MOBA_Q_CHUNK, axis=2)
        vc = lax.dynamic_slice_in_dim(sel_valid, t0, MOBA_Q_CHUNK, axis=2)
        t_idx = t0 + jnp.arange(MOBA_Q_CHUNK)
        k_sel = kblk[b_ix, h_ix, sc]
        v_sel = vblk[b_ix, h_ix, sc]
        s_sel = sc[..., None] * MOBA_BLOCK + jnp.arange(MOBA_BLOCK)
        dist_sel = (t_idx[:, None, None] - s_sel).astype(jnp.float32)
        lg_sel = jnp.einsum('bhqd,bhqnjd->bhqnj', qc, k_sel).astype(jnp.float32) * scale
        lg_sel = lg_sel - slopes[..., None] * dist_sel
        lg_sel = jnp.where(vc[..., None], lg_sel, -jnp.inf).reshape(b, h, MOBA_Q_CHUNK, n_sel * MOBA_BLOCK)
        own = t0 // MOBA_BLOCK
        k_own = lax.dynamic_slice_in_dim(kp, own * MOBA_BLOCK, MOBA_BLOCK, axis=2)
        v_own = lax.dynamic_slice_in_dim(vp, own * MOBA_BLOCK, MOBA_BLOCK, axis=2)
        s_own = own * MOBA_BLOCK + jnp.arange(MOBA_BLOCK)
        dist_own = (t_idx[:, None] - s_own[None, :]).astype(jnp.float32)
        lg_own = jnp.einsum('bhqd,bhjd->bhqj', qc, k_own).astype(jnp.float32) * scale - slopes * dist_own
        lg_own = jnp.where(s_own[None, :] <= t_idx[:, None], lg_own, -jnp.inf)
        p = jax.nn.softmax(jnp.concatenate([lg_sel, lg_own], axis=-1), axis=-1)
        p_sel = p[..., :n_sel * MOBA_BLOCK].reshape(b, h, MOBA_Q_CHUNK, n_sel, MOBA_BLOCK).astype(v.dtype)
        p_own = p[..., n_sel * MOBA_BLOCK:].astype(v.dtype)
        return (jnp.einsum('bhqnj,bhqnjd->bhqd', p_sel, v_sel)
                + jnp.einsum('bhqj,bhjd->bhqd', p_own, v_own))

    out = lax.map(chunk, jnp.arange(sp // MOBA_Q_CHUNK))
    out = out.transpose(1, 2, 0, 3, 4).reshape(b, h, sp, dh)
    return out[:, :, :s]


def even_mixer(h, w_in, b_f, w_out):
    da = N_HEADS_A * HEAD_DIM
    db = N_HEADS_B * HEAD_DIM
    proj = h @ w_in
    bounds = np.cumsum([da, da, da, N_HEADS_A, db, db]).tolist()
    qa, ka, va, fa, qb, kb, vb = jnp.split(proj, bounds, axis=-1)
    log_f = jax.nn.log_sigmoid((fa + b_f).astype(jnp.float32)).transpose(0, 2, 1)
    oa = forgetting_attention(split_heads(qa, N_HEADS_A), split_heads(ka, N_HEADS_A),
                              split_heads(va, N_HEADS_A), log_f)
    ob = stick_breaking_attention(split_heads(qb, N_HEADS_B), split_heads(kb, N_HEADS_B),
                                  split_heads(vb, N_HEADS_B))
    return jnp.concatenate([merge_heads(oa), merge_heads(ob)], axis=-1) @ w_out


def odd_mixer(h, w_in, pool_w, pool_scale, w_out):
    dd = N_HEADS_D * HEAD_DIM
    proj = h @ w_in
    bounds = np.cumsum([POOL_WIDTH, dd, dd]).tolist()
    xc, qd, kd, vd = jnp.split(proj, bounds, axis=-1)
    oc = multiscale_pool(xc, pool_w, pool_scale)
    od = moba_attention(split_heads(qd, N_HEADS_D), split_heads(kd, N_HEADS_D),
                        split_heads(vd, N_HEADS_D))
    return jnp.concatenate([oc, merge_heads(od)], axis=-1) @ w_out


def peer_ffn(h, wq, k1, k2, u, v):
    b, s, d = h.shape
    t = b * s
    ht = h.reshape(t, d)
    q = (ht @ wq).reshape(t, PEER_HEADS, 2, PEER_DKEY // 2).astype(jnp.float32)
    s1 = jnp.einsum('thd,hnd->thn', q[:, :, 0], k1.astype(jnp.float32))
    s2 = jnp.einsum('thd,hnd->thn', q[:, :, 1], k2.astype(jnp.float32))
    v1, i1 = lax.top_k(s1, PEER_TOPK)
    v2, i2 = lax.top_k(s2, PEER_TOPK)
    cand = (v1[..., :, None] + v2[..., None, :]).reshape(t, PEER_HEADS, PEER_TOPK * PEER_TOPK)
    cid = (i1[..., :, None] * PEER_NKEYS + i2[..., None, :]).reshape(t, PEER_HEADS, PEER_TOPK * PEER_TOPK)
    top, pos = lax.top_k(cand, PEER_TOPK)
    eid = jnp.take_along_axis(cid, pos, axis=-1)
    gate = jax.nn.softmax(top, axis=-1)
    nc = t // PEER_TOKEN_CHUNK
    xs = ht.reshape(nc, PEER_TOKEN_CHUNK, d)
    es = eid.reshape(nc, PEER_TOKEN_CHUNK, PEER_HEADS * PEER_TOPK)
    gs = gate.reshape(nc, PEER_TOKEN_CHUNK, PEER_HEADS * PEER_TOPK)

    def chunk(args):
        xc, ec, gc = args
        pre = jnp.einsum('td,tkd->tk', xc, u[ec]).astype(jnp.float32)
        act = jax.nn.gelu(pre, approximate=False) * gc
        return jnp.einsum('tk,tkd->td', act.astype(v.dtype), v[ec])

    out = lax.map(chunk, (xs, es, gs))
    return out.reshape(b, s, d).astype(h.dtype)


def setup_inputs(seed: int = 0) -> dict:
    key = jax.random.key(seed)
    ks = jax.random.split(key, 16)
    f32 = jnp.float32

    def nrm(k, shape, scale):
        return jax.random.normal(k, shape, f32) * scale

    return {
        'x': nrm(ks[0], (BATCH, SEQ, D_MODEL), 1.0),
        'norm_mix': 1.0 + nrm(ks[1], (DEPTH, D_MODEL), 0.05),
        'norm_ffn': 1.0 + nrm(ks[2], (DEPTH, D_MODEL), 0.05),
        'ev_w_in': nrm(ks[3], (N_EVEN, D_MODEL, EVEN_IN), D_MODEL ** -0.5),
        'ev_b_f': jax.random.uniform(ks[4], (N_EVEN, N_HEADS_A), f32, 1.0, 5.0),
        'ev_w_out': nrm(ks[5], (N_EVEN, MIX_OUT, D_MODEL), MIX_OUT ** -0.5),
        'od_w_in': nrm(ks[6], (N_ODD, D_MODEL, ODD_IN), D_MODEL ** -0.5),
        'od_pool_w': nrm(ks[7], (N_ODD, len(POOL_SIZES), POOL_GROUP, POOL_GROUP), POOL_GROUP ** -0.5),
        'od_pool_scale': 1.0 + nrm(ks[8], (N_ODD, POOL_WIDTH), 0.1),
        'od_w_out': nrm(ks[9], (N_ODD, MIX_OUT, D_MODEL), MIX_OUT ** -0.5),
        'peer_wq': nrm(ks[10], (DEPTH, D_MODEL, PEER_HEADS * PEER_DKEY), D_MODEL ** -0.5),
        'peer_k1': nrm(ks[11], (DEPTH, PEER_HEADS, PEER_NKEYS, PEER_DKEY // 2), (PEER_DKEY // 2) ** -0.5),
        'peer_k2': nrm(ks[12], (DEPTH, PEER_HEADS, PEER_NKEYS, PEER_DKEY // 2), (PEER_DKEY // 2) ** -0.5),
        'peer_u': nrm(ks[13], (DEPTH, PEER_EXPERTS, D_MODEL), D_MODEL ** -0.5),
        'peer_v': nrm(ks[14], (DEPTH, PEER_EXPERTS, D_MODEL), PEER_HEADS ** -0.5),
        'norm_f': 1.0 + nrm(ks[15], (D_MODEL,), 0.05),
    }


def reference(x, norm_mix, norm_ffn, ev_w_in, ev_b_f, ev_w_out, od_w_in, od_pool_w,
              od_pool_scale, od_w_out, peer_wq, peer_k1, peer_k2, peer_u, peer_v, norm_f):
    for layer in range(DEPTH):
        h = rmsnorm(x, norm_mix[layer])
        j = layer // 2
        if layer % 2 == 0:
            x = x + even_mixer(h, ev_w_in[j], ev_b_f[j], ev_w_out[j])
        else:
            x = x + odd_mixer(h, od_w_in[j], od_pool_w[j], od_pool_scale[j], od_w_out[j])
        h = rmsnorm(x, norm_ffn[layer])
        x = x + peer_ffn(h, peer_wq[layer], peer_k1[layer], peer_k2[layer], peer_u[layer], peer_v[layer])
    return rmsnorm(x, norm_f)
```

```cpp
#include <hip/hip_runtime.h>
#include <hip/hip_cooperative_groups.h>
#include <cstdio>
#include <cstdint>
#include <cmath>
namespace cg = cooperative_groups;

#ifndef MK_MULTI
#define MK_MULTI 0
#endif

namespace pg8 {
#define PG8_LAS __attribute__((address_space(3)))
typedef unsigned short bf16_t;
typedef short bf16x8 __attribute__((ext_vector_type(8)));
typedef float f32x4 __attribute__((ext_vector_type(4)));
typedef unsigned u32x4 __attribute__((ext_vector_type(4)));
constexpr int BM = 256, BK = 64, HALF = 128, HTB = HALF * BK * 2  , STAGE_BYTES = 8 * HTB, NXCD = 8, WGM = 8;

__host__ __device__ __forceinline__ int lds_byte(int r, int c) { const int st = (r >> 4) * 2 + (c >> 5), rr = r & 15, cc = c & 31, ob = rr * 64 + cc * 2; return st * 1024 + (ob ^ (((ob >> 9) & 1) << 5)); }
__host__ __device__ __forceinline__ void stage_rc(int b, int& R, int& C) { const int st = b / 1024, sb = b % 1024, swz = sb ^ (((sb >> 9) & 1) << 5); R = (st >> 1) * 16 + swz / 64; C = (st & 1) * 32 + (swz % 64) / 2; }
__host__ __device__ __forceinline__ int perm32(int rho) { const int n = rho >> 4, i = rho & 15; return 8 * (i >> 2) + 4 * n + (i & 3); }

struct Unit { int pm, pn; };
struct Gemm { const bf16_t* A; const bf16_t* Bt; int M, N, K; };

struct StaticOrder {
    int nM, nN, nwg, G, c;
    __host__ __device__ void init(int M, int N, int G_, int c_) { nM = M / BM; nN = N / BM; nwg = nM * nN; G = G_; c = c_; }
    __host__ __device__ bool next(int i, Unit& u) const {
        const long L = (long)i * G + c; if (L >= nwg) return false;
        int wgid = (int)L; { const int q = nwg / NXCD, r = nwg % NXCD, xcd = wgid % NXCD, off = wgid / NXCD; wgid = (xcd < r ? xcd * (q + 1) : r * (q + 1) + (xcd - r) * q) + off; }
        const int nig = WGM * nN, gid = wgid / nig, fm = gid * WGM, gsz = (nM - fm) < WGM ? (nM - fm) : WGM;
        u.pm = fm + ((wgid % nig) % gsz); u.pn = (wgid % nig) / gsz; return true;
    }
    __device__ __forceinline__ void a_ready(const Unit&) const {}
    __device__ __forceinline__ void done(const Unit&) const {}
};
__device__ __forceinline__ unsigned cvt_pk_bf16(float lo, float hi) { unsigned r; asm volatile("v_cvt_pk_bf16_f32 %0, %1, %2" : "=v"(r) : "v"(lo), "v"(hi)); return r; }
template <class Epi, class Sched, bool ALIGN_EPI = false, bool SP2 = false>
__device__ __forceinline__ void gemm_phase(PG8_LAS unsigned char* lds, const Gemm g, const Sched& S, const Epi& E) {
    const int tid = threadIdx.x, wid = __builtin_amdgcn_readfirstlane(tid >> 6), lane = tid & 63, wr = wid >> 2, wc = wid & 3, fr = lane & 15, fq = lane >> 4;
    const int K = g.K, nt = K / BK;
    unsigned voffA[2], voffB[2];
#pragma unroll
    for (int i = 0; i < 2; ++i) { int R, C; stage_rc(tid * 16 + i * 8192, R, C); const int Rb = Epi::PERM ? ((R & ~31) + perm32(R & 31)) : R;
        voffA[i] = (unsigned)(R * K + C) * 2u; voffB[i] = (unsigned)(Rb * K + C) * 2u; }
    const size_t kstep = (size_t)(BK * 2);
    const size_t hstep = (size_t)HALF * K * 2;
    const size_t tstep = 2 * hstep;
    const unsigned ldsw = (unsigned)wid * 1024u;
    const int aoff = lds_byte(wr * 64 + fr, fq * 8), boff = lds_byte(wc * 32 + fr, fq * 8);
#define PG8_SA(b, h) (((b) * 2 + (h)) * HTB)
#define PG8_SB(b, h) ((4 + (b) * 2 + (h)) * HTB)
#define PG8_STAGE(bufoff, gbase, voff) do { _Pragma("unroll") for (int _i = 0; _i < 2; ++_i) \
        __builtin_amdgcn_global_load_lds((const unsigned*)((const char*)(gbase) + (voff)[_i]), (PG8_LAS unsigned*)(lds + (bufoff) + ldsw + _i * 8192), 16, 0, 0); } while (0)
#define PG8_LDA(dst, b, h) do { _Pragma("unroll") for (int m = 0; m < 4; ++m) _Pragma("unroll") for (int k = 0; k < 2; ++k) dst[m][k] = *(const PG8_LAS bf16x8*)(lds + PG8_SA(b, h) + aoff + m * 2048 + k * 1024); } while (0)
#define PG8_LDB(dst, b, h) do { _Pragma("unroll") for (int n = 0; n < 2; ++n) _Pragma("unroll") for (int k = 0; k < 2; ++k) dst[n][k] = *(const PG8_LAS bf16x8*)(lds + PG8_SB(b, h) + boff + n * 2048 + k * 1024); } while (0)
#define PG8_MMA(ai, bj, At, Bt) do { __builtin_amdgcn_s_setprio(1); _Pragma("unroll") for (int m = 0; m < 4; ++m) _Pragma("unroll") for (int n = 0; n < 2; ++n) _Pragma("unroll") for (int k = 0; k < 2; ++k) \
        acc[ai][bj][m][n] = __builtin_amdgcn_mfma_f32_16x16x32_bf16(Bt[n][k], At[m][k], acc[ai][bj][m][n], 0, 0, 0); __builtin_amdgcn_s_setprio(0); } while (0)
#define PG8_WAIT_V(n) asm volatile("s_waitcnt vmcnt(" #n ")" ::: "memory")
#define PG8_WAIT_L(n) asm volatile("s_waitcnt lgkmcnt(" #n ")" ::: "memory")
#define PG8_BAR __builtin_amdgcn_s_barrier()
#define PG8_SCHED __builtin_amdgcn_sched_barrier(0)
    Unit cur, nxt; int ui = 0;
    if (!S.next(0, cur)) return;
    f32x4 acc[2][2][4][2];
#pragma unroll
    for (int a = 0; a < 2; ++a)
#pragma unroll
        for (int b = 0; b < 2; ++b)
#pragma unroll
            for (int m = 0; m < 4; ++m)
#pragma unroll
                for (int n = 0; n < 2; ++n) acc[a][b][m][n] = (f32x4){0.f, 0.f, 0.f, 0.f};
    bf16x8 At[4][2], B0[2][2], B1[2][2];
    const char* cA = (const char*)g.A + (size_t)cur.pm * tstep; const char* cB = (const char*)g.Bt + (size_t)cur.pn * tstep;
    S.a_ready(cur);
    if constexpr (SP2) {
        PG8_STAGE(PG8_SB(0, 0), cB, voffB); PG8_STAGE(PG8_SB(0, 1), cB + hstep, voffB); PG8_STAGE(PG8_SA(0, 0), cA, voffA); PG8_STAGE(PG8_SA(0, 1), cA + hstep, voffA);
        if (wr == 1) PG8_BAR;
        PG8_WAIT_V(2); PG8_BAR;
        PG8_STAGE(PG8_SB(1, 0), cB + kstep, voffB); PG8_STAGE(PG8_SA(1, 0), cA + kstep, voffA); PG8_STAGE(PG8_SB(1, 1), cB + hstep + kstep, voffB);
        PG8_WAIT_V(6); PG8_BAR;
    } else {
        PG8_STAGE(PG8_SB(0, 0), cB, voffB); PG8_STAGE(PG8_SA(0, 0), cA, voffA); PG8_STAGE(PG8_SB(0, 1), cB + hstep, voffB); PG8_STAGE(PG8_SA(0, 1), cA + hstep, voffA);
        if (wr == 1) PG8_BAR;
        PG8_WAIT_V(4); PG8_BAR;
        PG8_STAGE(PG8_SB(1, 0), cB + kstep, voffB); PG8_STAGE(PG8_SA(1, 0), cA + kstep, voffA); PG8_STAGE(PG8_SB(1, 1), cB + hstep + kstep, voffB);
        PG8_WAIT_V(6); PG8_BAR;
    }
    for (;;) {
        const bool has_next = S.next(ui + 1, nxt);
        const char* nA = has_next ? (const char*)g.A + (size_t)nxt.pm * tstep : cA; const char* nB = has_next ? (const char*)g.Bt + (size_t)nxt.pn * tstep : cB;
        for (int t = 0; t < nt; t += 2) {
            const bool last = (t == nt - 2);
            const char* a1 = cA + (size_t)(t + 1) * kstep;
            const char* a2 = last ? nA : cA + (size_t)(t + 2) * kstep; const char* b2 = last ? nB : cB + (size_t)(t + 2) * kstep;
            const char* a3 = a2 + kstep; const char* b3 = b2 + kstep;
            if (last && has_next) S.a_ready(nxt);
            if constexpr (SP2) {
            PG8_LDB(B0, 0, 0); PG8_LDB(B1, 0, 1); PG8_SCHED; PG8_LDA(At, 0, 0); PG8_STAGE(PG8_SA(1, 1), a1 + hstep, voffA);
            PG8_WAIT_V(8); PG8_WAIT_L(0); PG8_BAR; PG8_MMA(0, 0, At, B0); PG8_MMA(0, 1, At, B1); PG8_BAR; PG8_SCHED;
            PG8_LDA(At, 0, 1); PG8_STAGE(PG8_SB(0, 0), b2, voffB); PG8_STAGE(PG8_SB(0, 1), b2 + hstep, voffB); PG8_STAGE(PG8_SA(0, 0), a2, voffA);
            PG8_WAIT_V(8); PG8_WAIT_L(0); PG8_BAR; PG8_MMA(1, 0, At, B0); PG8_MMA(1, 1, At, B1); PG8_BAR; PG8_SCHED;
            PG8_LDB(B0, 1, 0); PG8_LDB(B1, 1, 1); PG8_SCHED; PG8_LDA(At, 1, 0); PG8_STAGE(PG8_SA(0, 1), a2 + hstep, voffA);
            PG8_WAIT_V(8); PG8_WAIT_L(0); PG8_BAR; PG8_MMA(0, 0, At, B0); PG8_MMA(0, 1, At, B1); PG8_BAR; PG8_SCHED;
            PG8_LDA(At, 1, 1); PG8_STAGE(PG8_SB(1, 0), b3, voffB); PG8_STAGE(PG8_SB(1, 1), b3 + hstep, voffB); PG8_STAGE(PG8_SA(1, 0), a3, voffA);
            PG8_WAIT_V(8); PG8_WAIT_L(0); PG8_BAR; PG8_MMA(1, 0, At, B0); PG8_MMA(1, 1, At, B1); PG8_BAR; PG8_SCHED;
            } else {
            PG8_LDB(B0, 0, 0); PG8_SCHED; PG8_LDA(At, 0, 0); PG8_STAGE(PG8_SA(1, 1), a1 + hstep, voffA);
            PG8_WAIT_L(8); PG8_BAR; PG8_WAIT_L(0); PG8_MMA(0, 0, At, B0); PG8_BAR; PG8_SCHED;
            PG8_LDB(B1, 0, 1); PG8_STAGE(PG8_SB(0, 0), b2, voffB);
            PG8_BAR; PG8_WAIT_L(0); PG8_MMA(0, 1, At, B1); PG8_BAR;
            PG8_LDA(At, 0, 1); PG8_STAGE(PG8_SA(0, 0), a2, voffA);
            PG8_BAR; PG8_WAIT_L(0); PG8_MMA(1, 0, At, B0); PG8_BAR; PG8_SCHED;
            PG8_STAGE(PG8_SB(0, 1), b2 + hstep, voffB);
            PG8_WAIT_V(6); PG8_BAR; PG8_MMA(1, 1, At, B1); PG8_BAR;
            PG8_LDB(B0, 1, 0); PG8_SCHED; PG8_LDA(At, 1, 0); PG8_STAGE(PG8_SA(0, 1), a2 + hstep, voffA);
            PG8_WAIT_L(8); PG8_BAR; PG8_WAIT_L(0); PG8_MMA(0, 0, At, B0); PG8_BAR; PG8_SCHED;
            PG8_LDB(B1, 1, 1); PG8_STAGE(PG8_SB(1, 0), b3, voffB);
            PG8_BAR; PG8_WAIT_L(0); PG8_MMA(0, 1, At, B1); PG8_BAR;
            PG8_LDA(At, 1, 1); PG8_STAGE(PG8_SA(1, 0), a3, voffA);
            PG8_BAR; PG8_WAIT_L(0); PG8_MMA(1, 0, At, B0); PG8_BAR; PG8_SCHED;
            PG8_STAGE(PG8_SB(1, 1), b3 + hstep, voffB);
            PG8_WAIT_V(6); PG8_BAR; PG8_MMA(1, 1, At, B1); PG8_BAR;
            }
        }
        if constexpr (ALIGN_EPI) { if (wr == 0) PG8_BAR; }
        if constexpr (!Epi::AFTER_DRAIN) { E(acc, cur, wr, wc, fr, fq); S.done(cur); }
        if (!has_next) break;
#pragma unroll
        for (int a = 0; a < 2; ++a)
#pragma unroll
            for (int b = 0; b < 2; ++b)
#pragma unroll
                for (int m = 0; m < 4; ++m)
#pragma unroll
                    for (int n = 0; n < 2; ++n) acc[a][b][m][n] = (f32x4){0.f, 0.f, 0.f, 0.f};
        cur = nxt; cA = nA; cB = nB; ++ui;
        if constexpr (ALIGN_EPI) { if (wr == 1) PG8_BAR; }
    }
    PG8_WAIT_V(0);
    if constexpr (!ALIGN_EPI) { if (wr == 0) PG8_BAR; }
    PG8_BAR;
    if constexpr (Epi::AFTER_DRAIN) { E.fused(acc, cur, wr, wc, fr, fq, lds, wid, lane); S.done(cur); }
#undef PG8_SA
#undef PG8_SB
#undef PG8_STAGE
#undef PG8_LDA
#undef PG8_LDB
#undef PG8_MMA
#undef PG8_WAIT_V
#undef PG8_WAIT_L
#undef PG8_BAR
#undef PG8_SCHED
}
}

constexpr int NB = 16, SEQ = 2048, DM = 1024, TOK = NB * SEQ;
constexpr int EVEN_IN = 3080, EVEN_PAD = 3328;
constexpr int NEXP = 16384;
constexpr float RMS_EPS = 1e-6f;
constexpr float LOG2E = 1.4426950408889634f;
constexpr float C2 = 0.125f * LOG2E;

constexpr size_t MiB = 1u << 20;
constexpr size_t WS_CTL = 0, CTL_ZERO_BYTES = 1 * MiB;
constexpr size_t WS_W1T = 1 * MiB;
constexpr size_t WS_W2T = 8 * MiB;
constexpr size_t WS_W4T = 10 * MiB;
constexpr size_t WS_W5T = 14 * MiB;
constexpr size_t WS_W3T = 16 * MiB;
constexpr size_t WS_W6T = 20 * MiB;
constexpr size_t WS_K1B = 24 * MiB;
constexpr size_t WS_K2B = 24 * MiB + 512 * 1024;
constexpr size_t WS_PWT = 25 * MiB;
constexpr size_t WS_LF  = 25 * MiB + 256 * 1024;
constexpr size_t WS_CF  = 26 * MiB + 256 * 1024;
constexpr size_t WS_KMEAN = 27 * MiB + 256 * 1024;
constexpr size_t WS_RS0 = 27 * MiB + 512 * 1024;
constexpr size_t WS_RS2 = 27 * MiB + 640 * 1024;
constexpr size_t WS_SSQ1 = 28 * MiB;
constexpr size_t WS_SSQ3 = 30 * MiB;
constexpr size_t WS_U8S = 32 * MiB;
constexpr size_t WS_V8S = 64 * MiB;
constexpr size_t WS_XB = 160 * MiB;
constexpr size_t WS_QH = 224 * MiB;
constexpr size_t WS_KH = 288 * MiB;
constexpr size_t WS_VT = 352 * MiB;
constexpr size_t WS_QP = 224 * MiB;
constexpr size_t WS_AO = 416 * MiB;
constexpr size_t WS_EID = 480 * MiB;
constexpr size_t WS_GATE = 488 * MiB;
constexpr size_t WS_SSQ2 = 504 * MiB;
constexpr size_t WS_PREP = 224 * MiB;
constexpr size_t WS_ACO = 416 * MiB;
constexpr size_t WS_END = 506 * MiB;

constexpr int RING_BYTES = 131072;
constexpr int LDS_BYTES = 147456;
constexpr int NWAVES = 8;

#define GAS __attribute__((address_space(1)))
#define LAS __attribute__((address_space(3)))
typedef unsigned short bf16_t;
typedef unsigned u32x4 __attribute__((ext_vector_type(4)));
typedef unsigned u32x2 __attribute__((ext_vector_type(2)));
typedef float f32x4 __attribute__((ext_vector_type(4)));
typedef float f32x16 __attribute__((ext_vector_type(16)));
typedef short bf16x8 __attribute__((ext_vector_type(8)));
typedef __bf16 bf16x2 __attribute__((ext_vector_type(2)));
#define LDS_WAIT() asm volatile("s_waitcnt lgkmcnt(0)" ::: "memory")

__device__ __forceinline__ int opaque_i(int v) { asm volatile("" : "+v"(v)); return v; }
__device__ __forceinline__ unsigned f2bf(float f) { unsigned u = __builtin_bit_cast(unsigned, f); return (u + 0x7fffu + ((u >> 16) & 1u)) >> 16; }
typedef float f32x2_pk __attribute__((ext_vector_type(2)));
__device__ __forceinline__ unsigned pk2(float lo, float hi) { const f32x2_pk v = {lo, hi}; return __builtin_bit_cast(unsigned, __builtin_convertvector(v, bf16x2)); }
__device__ __forceinline__ float bf_lo(unsigned u) { return __uint_as_float(u << 16); }
__device__ __forceinline__ float bf_hi(unsigned u) { return __uint_as_float(u & 0xffff0000u); }
__device__ __forceinline__ float dot2(unsigned a, unsigned b, float acc) { return __builtin_amdgcn_fdot2_f32_bf16(__builtin_bit_cast(bf16x2, a), __builtin_bit_cast(bf16x2, b), acc, false); }
__device__ __forceinline__ float dot8(u32x4 a, u32x4 b, float acc) { acc = dot2(a.x, b.x, acc); acc = dot2(a.y, b.y, acc); acc = dot2(a.z, b.z, acc); return dot2(a.w, b.w, acc); }
__device__ __forceinline__ u32x4 pack8(f32x4 a, f32x4 b) { u32x4 w; w.x = pk2(a[0], a[1]); w.y = pk2(a[2], a[3]); w.z = pk2(b[0], b[1]); w.w = pk2(b[2], b[3]); return w; }

__device__ __forceinline__ float wave_sum(float v) {
#pragma unroll
    for (int o = 1; o < 64; o <<= 1) v += __shfl_xor(v, o);
    return v;
}
__device__ __forceinline__ float wave_max(float v) {
#pragma unroll
    for (int o = 1; o < 64; o <<= 1) v = fmaxf(v, __shfl_xor(v, o));
    return v;
}
__device__ __forceinline__ unsigned wave_umax(unsigned v) {
#pragma unroll
    for (int o = 1; o < 64; o <<= 1) { const unsigned w = (unsigned)__shfl_xor((int)v, o); v = v > w ? v : w; }
    return v;
}
__device__ __forceinline__ float dpp_row_shr(float v, int n) {
    const int iv = __builtin_bit_cast(int, v); int r;
    switch (n) { case 1: r = __builtin_amdgcn_update_dpp(0, iv, 0x111, 0xf, 0xf, true); break; case 2: r = __builtin_amdgcn_update_dpp(0, iv, 0x112, 0xf, 0xf, true); break;
                 case 4: r = __builtin_amdgcn_update_dpp(0, iv, 0x114, 0xf, 0xf, true); break; default: r = __builtin_amdgcn_update_dpp(0, iv, 0x118, 0xf, 0xf, true); break; }
    return __builtin_bit_cast(float, r);
}
__device__ __forceinline__ float wave_total(float v) {
    v += dpp_row_shr(v, 1); v += dpp_row_shr(v, 2); v += dpp_row_shr(v, 4); v += dpp_row_shr(v, 8);
    v += __builtin_bit_cast(float, __builtin_amdgcn_update_dpp(0, __builtin_bit_cast(int, v), 0x142, 0xa, 0xf, false));
    v += __builtin_bit_cast(float, __builtin_amdgcn_update_dpp(0, __builtin_bit_cast(int, v), 0x143, 0xc, 0xf, false));
    return __builtin_bit_cast(float, __builtin_amdgcn_readlane(__builtin_bit_cast(int, v), 63));
}
__device__ __forceinline__ unsigned f2ord(float f) { const unsigned u = __float_as_uint(f); return (u & 0x80000000u) ? ~u : (u | 0x80000000u); }
__device__ __forceinline__ float ord2f(unsigned o) { const unsigned u = (o & 0x80000000u) ? (o & 0x7fffffffu) : ~o; return __uint_as_float(u); }

__device__ __forceinline__ float row_scale(const float* p, int mode, int t) {
    if (mode == 0) return p[t];
    const f32x4* q = (const f32x4*)(p + (size_t)t * 16); const f32x4 a = q[0], b = q[1], c = q[2], d = q[3];
    const float s = (((a[0] + a[1]) + (a[2] + a[3])) + ((b[0] + b[1]) + (b[2] + b[3]))) + (((c[0] + c[1]) + (c[2] + c[3])) + ((d[0] + d[1]) + (d[2] + d[3])));
    return rsqrtf(s * (1.f / DM) + RMS_EPS);
}

struct EpiL0In {
    static constexpr bool PERM = true, AFTER_DRAIN = false;
    const float* rs; bf16_t* QH; bf16_t* KH; bf16_t* VT; float* LF; const float* b_f;
    __device__ __forceinline__ void operator()(const f32x4 (&acc)[2][2][4][2], const pg8::Unit& u, int wr, int wc, int fr, int fq) const {
        const int pn = u.pn;
        if (pn == 12) {
            if (wc == 0 && fq == 0) {
#pragma unroll
                for (int ai = 0; ai < 2; ++ai)
#pragma unroll
                    for (int m = 0; m < 4; ++m) {
                        const int t = u.pm * 256 + ai * 128 + wr * 64 + m * 16 + fr; const float sc = rs[t]; const int b = t >> 11, s = t & 2047;
#pragma unroll
                        for (int n = 0; n < 2; ++n)
#pragma unroll
                            for (int e = 0; e < 4; ++e) { const int h = n * 4 + e; const float x = acc[ai][0][m][n][e] * sc + b_f[h];
                                const float ls = fminf(x, 0.f) - log1pf(expf(-fabsf(x)));
                                LF[(size_t)(b * 8 + h) * 2048 + s] = ls * LOG2E; }
                    }
            }
            return;
        }
        const int sec = pn >> 1, kind = sec % 3, hbase = (sec >= 3) ? 8 : 0;
#pragma unroll
        for (int ai = 0; ai < 2; ++ai)
#pragma unroll
            for (int m = 0; m < 4; ++m) {
                const int t = u.pm * 256 + ai * 128 + wr * 64 + m * 16 + fr; const int b = t >> 11, s = t & 2047;
                const float sc = rs[t] * (kind == 0 ? C2 : 1.f);
#pragma unroll
                for (int bj = 0; bj < 2; ++bj) {
                    const int cc = (pn & 1) * 256 + bj * 128 + wc * 32 + fq * 8, hh = hbase + (cc >> 6), d0 = cc & 63;
                    const f32x4 v0 = acc[ai][bj][m][0] * sc, v1 = acc[ai][bj][m][1] * sc;
                    if (kind < 2) { bf16_t* dst = (kind == 0 ? QH : KH) + ((size_t)(b * 16 + hh) * 2048 + s) * 64 + d0; *(u32x4*)dst = pack8(v0, v1); }
                    else { bf16_t* dst = VT + ((size_t)(b * 16 + hh) * 64 + d0) * 2048 + s;
                        dst[0 * 2048] = (bf16_t)f2bf(v0[0]); dst[1 * 2048] = (bf16_t)f2bf(v0[1]); dst[2 * 2048] = (bf16_t)f2bf(v0[2]); dst[3 * 2048] = (bf16_t)f2bf(v0[3]);
                        dst[4 * 2048] = (bf16_t)f2bf(v1[0]); dst[5 * 2048] = (bf16_t)f2bf(v1[1]); dst[6 * 2048] = (bf16_t)f2bf(v1[2]); dst[7 * 2048] = (bf16_t)f2bf(v1[3]); }
                }
            }
    }
};
struct EpiL1In {
    static constexpr bool PERM = true, AFTER_DRAIN = false;
    const float* rsp; int rsmode; bf16_t* XC; bf16_t* QD; bf16_t* KD; bf16_t* VTD;
    __device__ __forceinline__ void operator()(const f32x4 (&acc)[2][2][4][2], const pg8::Unit& u, int wr, int wc, int fr, int fq) const {
        const int pn = u.pn, kind = pn >> 1;
#pragma unroll
        for (int ai = 0; ai < 2; ++ai)
#pragma unroll
            for (int m = 0; m < 4; ++m) {
                const int t = u.pm * 256 + ai * 128 + wr * 64 + m * 16 + fr; const int b = t >> 11, s = t & 2047;
                const float sc = row_scale(rsp, rsmode, t) * (kind == 1 ? C2 : 1.f);
#pragma unroll
                for (int bj = 0; bj < 2; ++bj) {
                    const int cc = (pn & 1) * 256 + bj * 128 + wc * 32 + fq * 8, hh = cc >> 6, d0 = cc & 63;
                    const f32x4 v0 = acc[ai][bj][m][0] * sc, v1 = acc[ai][bj][m][1] * sc;
                    if (kind == 0) { *(u32x4*)(XC + (size_t)t * 512 + cc) = pack8(v0, v1); }
                    else if (kind < 3) { bf16_t* dst = (kind == 1 ? QD : KD) + ((size_t)(b * 8 + hh) * 2048 + s) * 64 + d0; *(u32x4*)dst = pack8(v0, v1); }
                    else { bf16_t* dst = VTD + ((size_t)(b * 8 + hh) * 64 + d0) * 2048 + s;
                        dst[0 * 2048] = (bf16_t)f2bf(v0[0]); dst[1 * 2048] = (bf16_t)f2bf(v0[1]); dst[2 * 2048] = (bf16_t)f2bf(v0[2]); dst[3 * 2048] = (bf16_t)f2bf(v0[3]);
                        dst[4 * 2048] = (bf16_t)f2bf(v1[0]); dst[5 * 2048] = (bf16_t)f2bf(v1[1]); dst[6 * 2048] = (bf16_t)f2bf(v1[2]); dst[7 * 2048] = (bf16_t)f2bf(v1[3]); }
                }
            }
    }
};
struct EpiQ {
    static constexpr bool PERM = true, AFTER_DRAIN = false;
    const float* rsp; int rsmode; bf16_t* Q;
    __device__ __forceinline__ void operator()(const f32x4 (&acc)[2][2][4][2], const pg8::Unit& u, int wr, int wc, int fr, int fq) const {
#pragma unroll
        for (int ai = 0; ai < 2; ++ai)
#pragma unroll
            for (int m = 0; m < 4; ++m) {
                const int t = u.pm * 256 + ai * 128 + wr * 64 + m * 16 + fr; const float sc = row_scale(rsp, rsmode, t);
#pragma unroll
                for (int bj = 0; bj < 2; ++bj) { const int c = u.pn * 256 + bj * 128 + wc * 32 + fq * 8;
                    *(u32x4*)(Q + (size_t)t * 2048 + c) = pack8(acc[ai][bj][m][0] * sc, acc[ai][bj][m][1] * sc); }
            }
    }
};
template <bool BASE_BF16>
struct EpiRes {
    static constexpr bool PERM = true, AFTER_DRAIN = false;
    const void* base; bf16_t* xb; float* ssqp;
    __device__ __forceinline__ void operator()(const f32x4 (&acc)[2][2][4][2], const pg8::Unit& u, int wr, int wc, int fr, int fq) const {
#pragma unroll
        for (int ai = 0; ai < 2; ++ai)
#pragma unroll
            for (int m = 0; m < 4; ++m) {
                const int t = u.pm * 256 + ai * 128 + wr * 64 + m * 16 + fr; float ss = 0.f;
#pragma unroll
                for (int bj = 0; bj < 2; ++bj) { const size_t off = (size_t)t * DM + u.pn * 256 + bj * 128 + wc * 32 + fq * 8;
                    f32x4 b0, b1;
                    if (BASE_BF16) { const u32x4 w = *(const u32x4*)((const bf16_t*)base + off); b0 = (f32x4){bf_lo(w.x), bf_hi(w.x), bf_lo(w.y), bf_hi(w.y)}; b1 = (f32x4){bf_lo(w.z), bf_hi(w.z), bf_lo(w.w), bf_hi(w.w)}; }
                    else { b0 = *(const f32x4*)((const float*)base + off); b1 = *(const f32x4*)((const float*)base + off + 4); }
                    const f32x4 o0 = b0 + acc[ai][bj][m][0], o1 = b1 + acc[ai][bj][m][1];
                    *(u32x4*)(xb + off) = pack8(o0, o1);
                    ss += (o0[0] * o0[0] + o0[1] * o0[1]) + (o0[2] * o0[2] + o0[3] * o0[3]) + (o1[0] * o1[0] + o1[1] * o1[1]) + (o1[2] * o1[2] + o1[3] * o1[3]); }
                ss += __shfl_xor(ss, 16); ss += __shfl_xor(ss, 32);
                if (fq == 0) ssqp[(size_t)t * 16 + u.pn * 4 + wc] = ss;
            }
    }
};

#define XB_TMO      128
#define XB_XCNT(j)  (256  + 64 * (j))
#define XB_XSUB(j)  (1280 + 64 * (j))
#define XB_XGEN(j)  (2304 + 64 * (j))
#define XB_TOP      3328
#define XB_TOPGEN   3392
#define XCD_BAR_WORDS 3456
#define XB_SPIN_CAP (1u << 18)

__device__ __forceinline__ unsigned xb_ld(unsigned* p)              { return __hip_atomic_load(p, __ATOMIC_RELAXED, __HIP_MEMORY_SCOPE_AGENT); }
__device__ __forceinline__ unsigned xb_add(unsigned* p, unsigned v) { return __hip_atomic_fetch_add(p, v, __ATOMIC_RELAXED, __HIP_MEMORY_SCOPE_AGENT); }
__device__ __forceinline__ unsigned xb_xcc_id() { return (unsigned)__builtin_amdgcn_s_getreg((3 << 11) | 20) & 0xFu; }
#define XB_SPIN(cond, bar) do { unsigned _sp = 0; while (cond) { __builtin_amdgcn_s_sleep(1); \
    if ((++_sp & 255u) == 0u) { if (xb_ld(&(bar)[XB_TMO])) break; if (_sp > XB_SPIN_CAP) { atomicAdd(&(bar)[XB_TMO], 1u); break; } } } } while (0)

struct XcdBarrier {
    unsigned* bar; unsigned x;
    volatile LAS unsigned* st;
};

__device__ __forceinline__ XcdBarrier xcd_barrier_post(unsigned* bar, volatile LAS unsigned* st) {
    XcdBarrier b; b.bar = bar; b.x = xb_xcc_id(); b.st = st;
    if (threadIdx.x == 0) (void)xb_add(&bar[XB_XCNT(b.x)], 1u);
    return b;
}
__device__ __forceinline__ void xcd_barrier_complete(unsigned* bar, unsigned x, unsigned& nloc, unsigned& nx) {
    const unsigned G = gridDim.x * gridDim.y * gridDim.z;
    unsigned sum, cnt, mine, sp = 0u;
    for (;;) {
        sum = 0u; cnt = 0u; mine = 0u;
#pragma unroll
        for (unsigned j = 0; j < 16; ++j) { const unsigned c = xb_ld(&bar[XB_XCNT(j)]); sum += c; cnt += (c > 0u) ? 1u : 0u; mine = (j == x) ? c : mine; }
        if (sum == G) break;
        __builtin_amdgcn_s_sleep(1);
        if ((++sp & 255u) == 0u) { if (xb_ld(&bar[XB_TMO])) break; if (sp > XB_SPIN_CAP) { atomicAdd(&bar[XB_TMO], 1u); break; } }
    }
    nloc = mine > 0u ? mine : 1u; nx = cnt > 0u ? cnt : 1u;
}

__device__ __forceinline__ void xcd_barrier(const XcdBarrier& b) {
    asm volatile("s_waitcnt vmcnt(0)" ::: "memory");
    __syncthreads();
    if (threadIdx.x == 0) {
        unsigned* bar = b.bar;
        __builtin_amdgcn_s_waitcnt(0);
        unsigned nloc = b.st[0], nx = b.st[1];
        if (nloc == 0u) { xcd_barrier_complete(bar, b.x, nloc, nx); b.st[0] = nloc; b.st[1] = nx; }
        const unsigned old = xb_add(&bar[XB_XSUB(b.x)], 1u);
        const unsigned gen = old / nloc;
        if (old + 1u == (gen + 1u) * nloc) {
            __builtin_amdgcn_fence(__ATOMIC_RELEASE, "agent");
            asm volatile("s_waitcnt vmcnt(0)" ::: "memory");
            const unsigned og = xb_add(&bar[XB_TOP], 1u);
            const unsigned tg = og / nx;
            if (og + 1u == (tg + 1u) * nx) xb_add(&bar[XB_TOPGEN], 1u);
            else XB_SPIN(xb_ld(&bar[XB_TOPGEN]) == tg, bar);
            __builtin_amdgcn_fence(__ATOMIC_ACQUIRE, "agent");
            xb_add(&bar[XB_XGEN(b.x)], 1u);
            asm volatile("s_waitcnt vmcnt(0)" ::: "memory");
        } else {
            XB_SPIN(xb_ld(&bar[XB_XGEN(b.x)]) == gen, bar);
            __builtin_amdgcn_fence(__ATOMIC_ACQUIRE, "agent");
            asm volatile("s_waitcnt vmcnt(0)" ::: "memory");
        }
    }
    __syncthreads();
}

struct Frame {
    LAS unsigned char* lds;
    int tid, lane, wave, vcu, G;
};

__device__ __forceinline__ int remap0(int n) { return n < 1536 ? n : (n < 1544 ? 3072 + (n - 1536) : n - 8); }
__device__ __forceinline__ void p0_transpose_item(const float* W, int K, int N, bf16_t* WT, const float* g, bool remap, LAS float* scr, int item, int lane) {
    const int nblk = (N + 31) / 32, kb = item / nblk, nb = item % nblk, k0 = 64 * kb, n0 = 32 * nb;
#pragma unroll 8
    for (int i = 0; i < 32; ++i) { const int kk = 2 * i + (lane >> 5), n = n0 + (lane & 31);
        float v = (n < N) ? W[(size_t)(k0 + kk) * N + n] : 0.f; if (g) v *= g[k0 + kk]; scr[kk * 33 + (lane & 31)] = v; }
    LDS_WAIT(); asm volatile("" ::: "memory");
    const int c = lane & 7;
#pragma unroll
    for (int j = 0; j < 4; ++j) { const int nl = (lane >> 3) + 8 * j, n = n0 + nl; const LAS float* s = scr + (8 * c) * 33 + nl;
        u32x4 o; o.x = pk2(s[0 * 33], s[1 * 33]); o.y = pk2(s[2 * 33], s[3 * 33]); o.z = pk2(s[4 * 33], s[5 * 33]); o.w = pk2(s[6 * 33], s[7 * 33]);
        if (n < N) { const int nn = remap ? remap0(n) : n; *(u32x4*)(WT + (size_t)nn * K + k0 + 8 * c) = o; } }
    LDS_WAIT(); asm volatile("" ::: "memory");
}
__device__ __forceinline__ float cvt_row_1024(const float* src, bf16_t* dst, const float* g, int lane) {
    const f32x4 a0 = *(const f32x4*)(src + 8 * lane), a1 = *(const f32x4*)(src + 8 * lane + 4), c0 = *(const f32x4*)(src + 512 + 8 * lane), c1 = *(const f32x4*)(src + 516 + 8 * lane);
    float ss = (a0[0] * a0[0] + a0[1] * a0[1]) + (a0[2] * a0[2] + a0[3] * a0[3]) + (a1[0] * a1[0] + a1[1] * a1[1]) + (a1[2] * a1[2] + a1[3] * a1[3])
             + (c0[0] * c0[0] + c0[1] * c0[1]) + (c0[2] * c0[2] + c0[3] * c0[3]) + (c1[0] * c1[0] + c1[1] * c1[1]) + (c1[2] * c1[2] + c1[3] * c1[3]);
    f32x4 b0 = a0, b1 = a1, d0 = c0, d1 = c1;
    if (g) { b0 = b0 * *(const f32x4*)(g + 8 * lane); b1 = b1 * *(const f32x4*)(g + 8 * lane + 4); d0 = d0 * *(const f32x4*)(g + 512 + 8 * lane); d1 = d1 * *(const f32x4*)(g + 516 + 8 * lane); }
    *(u32x4*)(dst + 8 * lane) = pack8(b0, b1); *(u32x4*)(dst + 512 + 8 * lane) = pack8(d0, d1);
    return ss;
}

constexpr float I8_SU = 600.f, I8_SX = 127.f / 6.f;
constexpr float FP8_SU = 64.f, FP8_SV = 8.f;
__device__ __forceinline__ void cvt_row_fp8_sliced(const float* src, unsigned char* tab  , int e, const float* g, float scale, int lane) {
#pragma unroll
    for (int j = 0; j < 4; ++j) { f32x4 a = *(const f32x4*)(src + 256 * j + 4 * lane) * scale; if (g) a = a * *(const f32x4*)(g + 256 * j + 4 * lane);
        int w = 0; w = __builtin_amdgcn_cvt_pk_bf8_f32(a[0], a[1], w, false); w = __builtin_amdgcn_cvt_pk_bf8_f32(a[2], a[3], w, true);
        const int x = 2 * j + (lane >> 5);
        *(unsigned*)(tab + ((size_t)x * NEXP + e) * 128 + 4 * (lane & 31)) = (unsigned)w; }
}
__device__ __forceinline__ void cvt_row_i8_sliced(const float* src, unsigned char* tab  , int e, const float* g, float scale, int lane) {
#pragma unroll
    for (int j = 0; j < 4; ++j) { f32x4 a = *(const f32x4*)(src + 256 * j + 4 * lane) * scale; if (g) a = a * *(const f32x4*)(g + 256 * j + 4 * lane);
        unsigned w = 0u;
#pragma unroll
        for (int q = 0; q < 4; ++q) { int v = __float2int_rn(a[q]); v = v < -127 ? -127 : (v > 127 ? 127 : v); w |= ((unsigned)v & 0xffu) << (8 * q); }
        const int x = 2 * j + (lane >> 5);
        *(unsigned*)(tab + ((size_t)x * NEXP + e) * 128 + 4 * (lane & 31)) = w; }
}
struct Ptrs {
    const float *x, *norm_mix, *norm_ffn, *ev_w_in, *ev_b_f, *ev_w_out, *od_w_in, *od_pool_w, *od_pool_scale, *od_w_out, *peer_wq, *peer_k1, *peer_k2, *peer_u, *peer_v, *norm_f;
    float* out; unsigned char* ws;
};

__device__ __forceinline__ void phase_p0(Frame& F, const Ptrs& P) {
    LAS float* scr = (LAS float*)(F.lds + F.wave * 16384);
    const int gw = F.vcu * NWAVES + F.wave, NGW = F.G * NWAVES, lane = opaque_i(F.lane);
    unsigned char* ws = P.ws;
    bf16_t* W1T = (bf16_t*)(ws + WS_W1T); bf16_t* W2T = (bf16_t*)(ws + WS_W2T); bf16_t* W4T = (bf16_t*)(ws + WS_W4T); bf16_t* W5T = (bf16_t*)(ws + WS_W5T);
    bf16_t* W3T = (bf16_t*)(ws + WS_W3T); bf16_t* W6T = (bf16_t*)(ws + WS_W6T); bf16_t* PWT = (bf16_t*)(ws + WS_PWT);
    constexpr int I1 = 16 * 97, I2 = 16 * 32, I4 = 16 * 64, I5 = I2, I3 = I4, I6 = I4, IP = 4 * 2 * 4;
    constexpr int NTR = I1 + I2 + I4 + I5 + I3 + I6 + IP;
    for (int it = gw; it < NTR; it += NGW) {
        int r = it;
        if (r < I1) { p0_transpose_item(P.ev_w_in, DM, EVEN_IN, W1T, P.norm_mix, true, scr, r, lane); continue; } r -= I1;
        if (r < I2) { p0_transpose_item(P.ev_w_out, DM, DM, W2T, nullptr, false, scr, r, lane); continue; } r -= I2;
        if (r < I4) { p0_transpose_item(P.od_w_in, DM, 2048, W4T, P.norm_mix + DM, false, scr, r, lane); continue; } r -= I4;
        if (r < I5) { p0_transpose_item(P.od_w_out, DM, DM, W5T, nullptr, false, scr, r, lane); continue; } r -= I5;
        if (r < I3) { p0_transpose_item(P.peer_wq, DM, 2048, W3T, P.norm_ffn, false, scr, r, lane); continue; } r -= I3;
        if (r < I6) { p0_transpose_item(P.peer_wq + (size_t)DM * 2048, DM, 2048, W6T, P.norm_ffn + DM, false, scr, r, lane); continue; } r -= I6;
        { const int g = r >> 3; p0_transpose_item(P.od_pool_w + (size_t)g * 128 * 128, 128, 128, PWT + (size_t)g * 128 * 128, nullptr, false, scr, r & 7, lane); }
    }
    constexpr int R_Z = EVEN_PAD - EVEN_IN, R_X = TOK, R_U = 2 * NEXP, R_V = 2 * NEXP, R_K = 2 * 256;
    constexpr int NROW = R_Z + R_X + R_U + R_V + R_K;
    bf16_t* XB = (bf16_t*)(ws + WS_XB); float* RS0 = (float*)(ws + WS_RS0);
    bf16_t* K1B = (bf16_t*)(ws + WS_K1B); bf16_t* K2B = (bf16_t*)(ws + WS_K2B);
    for (int it = gw; it < NROW; it += NGW) {
        int r = it;
        if (r < R_Z) { bf16_t* d = W1T + (size_t)(EVEN_IN + r) * DM; const u32x4 z = {0u, 0u, 0u, 0u}; *(u32x4*)(d + 8 * lane) = z; *(u32x4*)(d + 512 + 8 * lane) = z; continue; } r -= R_Z;
        if (r < R_X) { const float ss = wave_sum(cvt_row_1024(P.x + (size_t)r * DM, XB + (size_t)r * DM, nullptr, lane)); if (lane == 0) RS0[r] = rsqrtf(ss * (1.f / DM) + RMS_EPS); continue; } r -= R_X;
        if (r < R_U) { const int ly = r >= NEXP; cvt_row_i8_sliced(P.peer_u + (size_t)r * DM, ws + WS_U8S + (size_t)ly * 8 * NEXP * 128, r - ly * NEXP, P.norm_ffn + (ly ? DM : 0), I8_SU, lane); continue; } r -= R_U;
        if (r < R_V) { const int ly = r >= NEXP; cvt_row_fp8_sliced(P.peer_v + (size_t)r * DM, ws + WS_V8S + (size_t)ly * 8 * NEXP * 128, r - ly * NEXP, nullptr, FP8_SV, lane); continue; } r -= R_V;
        if (r < 256) (void)cvt_row_1024(P.peer_k1 + (size_t)r * 1024, K1B + (size_t)r * 1024, nullptr, lane);
        else (void)cvt_row_1024(P.peer_k2 + (size_t)(r - 256) * 1024, K2B + (size_t)(r - 256) * 1024, nullptr, lane);
    }
}

__device__ __forceinline__ void phase_cfscan(Frame& F, const float* LF, float* CFo) {
    const int gw = F.vcu * NWAVES + F.wave, NGW = F.G * NWAVES, lane = opaque_i(F.lane);
    for (int bh = gw; bh < NB * 8; bh += NGW) {
        const float* src = LF + (size_t)bh * 2048 + 32 * lane; float v[32];
#pragma unroll
        for (int i = 0; i < 8; ++i) { const f32x4 w = *(const f32x4*)(src + 4 * i); v[4 * i] = w[0]; v[4 * i + 1] = w[1]; v[4 * i + 2] = w[2]; v[4 * i + 3] = w[3]; }
#pragma unroll
        for (int i = 1; i < 32; ++i) v[i] += v[i - 1];
        const float tot = v[31]; float inc = tot;
#pragma unroll
        for (int o = 1; o < 64; o <<= 1) { const float w = __shfl_up(inc, o); if (lane >= o) inc += w; }
        const float excl = inc - tot; float* dst = CFo + (size_t)bh * 2048 + 32 * lane;
#pragma unroll
        for (int i = 0; i < 8; ++i) { f32x4 w = {v[4 * i] + excl, v[4 * i + 1] + excl, v[4 * i + 2] + excl, v[4 * i + 3] + excl}; *(f32x4*)(dst + 4 * i) = w; }
    }
}
__device__ __forceinline__ void phase_kmean(Frame& F, const bf16_t* KD, float* KMEAN) {
    const int gw = F.vcu * NWAVES + F.wave, NGW = F.G * NWAVES, lane = opaque_i(F.lane);
    for (int it = gw; it < NB * 8 * 8; it += NGW) {
        const int bh = it >> 3, blk = it & 7; const bf16_t* src = KD + ((size_t)bh * 2048 + blk * 256) * 64 + lane; float s = 0.f;
#pragma unroll 8
        for (int j = 0; j < 256; ++j) s += __uint_as_float((unsigned)src[(size_t)j * 64] << 16);
        KMEAN[(size_t)it * 64 + lane] = s * (1.f / 256.f);
    }
}

__device__ __forceinline__ int lgi(int s) { return s + (s >> 5); }
__device__ __forceinline__ float lsn2f(float z2) { return -(fmaxf(z2, 0.f) + __log2f(1.f + exp2f(-fabsf(z2)))); }
template <int KIND>
__device__ __forceinline__ void attn_naive(Frame& F, const bf16_t* QH, const bf16_t* KH, const bf16_t* VT, int NH, int hbase, const float* CF, const float* KMEAN, bf16_t* AO, int ao_col0) {
    LAS float* lg = (LAS float*)(F.lds + F.wave * 8704);
    const int gw = F.vcu * NWAVES + F.wave, NGW = F.G * NWAVES, lane = opaque_i(F.lane);
    for (int qi = gw; qi < NB * 8 * SEQ; qi += NGW) {
        const int bh = qi >> 11, b = bh >> 3, h = bh & 7, hh = hbase + h;
        const int t = (bh & 1) ? (2047 - (qi & 2047)) : (qi & 2047);
        const size_t hb = (size_t)(b * NH + hh);
        const bf16_t* qp = QH + (hb * 2048 + t) * 64; const bf16_t* kp = KH + hb * 2048 * 64;
        float q[64];
#pragma unroll
        for (int c = 0; c < 8; ++c) { const u32x4 w = *(const u32x4*)(qp + 8 * c);
            q[8 * c] = bf_lo(w.x); q[8 * c + 1] = bf_hi(w.x); q[8 * c + 2] = bf_lo(w.y); q[8 * c + 3] = bf_hi(w.y); q[8 * c + 4] = bf_lo(w.z); q[8 * c + 5] = bf_hi(w.z); q[8 * c + 6] = bf_lo(w.w); q[8 * c + 7] = bf_hi(w.w); }
        unsigned sel = 0u; const int qb = t >> 8;
        if (KIND == 2) {
            float gate[8];
#pragma unroll
            for (int n = 0; n < 8; ++n) { const float* km = KMEAN + ((size_t)(b * 8 + h) * 8 + n) * 64; float a = 0.f;
#pragma unroll
                for (int d = 0; d < 64; ++d) a += q[d] * km[d];
                gate[n] = a; }
            const int nsel = qb < 3 ? qb : 3;
#pragma unroll
            for (int r = 0; r < 3; ++r) if (r < nsel) { float best = -INFINITY; int bi = 0;
#pragma unroll
                for (int n = 0; n < 8; ++n) if (n < qb && !((sel >> n) & 1u) && gate[n] > best) { best = gate[n]; bi = n; }
                sel |= 1u << bi; }
        }
        const int nk = (KIND == 1) ? t : t + 1;
        const int tp = (nk + 7) & ~7;
        const float cft = (KIND == 0) ? CF[(size_t)(b * 8 + h) * 2048 + t] : 0.f;
        const float slope2 = (KIND == 2) ? exp2f(-(float)(h + 1)) * LOG2E : 0.f;
        float mloc = -INFINITY;
        for (int s = lane; s < nk; s += 64) {
            float dot = 0.f;
#pragma unroll
            for (int c = 0; c < 8; ++c) { const u32x4 w = *(const u32x4*)(kp + (size_t)s * 64 + 8 * c);
                dot += q[8 * c] * bf_lo(w.x) + q[8 * c + 1] * bf_hi(w.x) + q[8 * c + 2] * bf_lo(w.y) + q[8 * c + 3] * bf_hi(w.y) + q[8 * c + 4] * bf_lo(w.z) + q[8 * c + 5] * bf_hi(w.z) + q[8 * c + 6] * bf_lo(w.w) + q[8 * c + 7] * bf_hi(w.w); }
            float v = dot;
            if (KIND == 0) v += cft - CF[(size_t)(b * 8 + h) * 2048 + s];
            if (KIND == 2) { const int n = s >> 8; const bool valid = (n == qb) || ((sel >> n) & 1u); v = valid ? v + slope2 * (float)(s - t) : -INFINITY; }
            lg[lgi(s)] = v; mloc = fmaxf(mloc, v);
        }
        float linv = 1.f;
        if (KIND != 1) {
            const float m = wave_max(mloc); float lsum = 0.f;
            for (int s = lane; s < tp; s += 64) { const float p = (s < nk) ? exp2f(lg[lgi(s)] - m) : 0.f; lg[lgi(s)] = p; lsum += p; }
            linv = 1.f / wave_sum(lsum);
        } else {
            float tot = 0.f;
            for (int i = 0; i < 32; ++i) { const int s = 32 * lane + i; if (s < nk) tot += lsn2f(lg[lgi(s)]); }
            float inc = tot;
#pragma unroll
            for (int o = 1; o < 64; o <<= 1) { const float w = __shfl_down(inc, o); if (lane + o < 64) inc += w; }
            float run = inc - tot;
            for (int i = 31; i >= 0; --i) { const int s = 32 * lane + i; float a = 0.f;
                if (s < nk) { const float z = lg[lgi(s)], l2 = lsn2f(z); a = exp2f(z + l2 + run); run += l2; }
                if (s < tp) lg[lgi(s)] = a; }
        }
        LDS_WAIT();
        const bf16_t* vp = VT + (hb * 64 + lane) * 2048; float o = 0.f;
        for (int s0 = 0; s0 < tp; s0 += 8) { const u32x4 w = *(const u32x4*)(vp + s0); const int i0 = lgi(s0);
            o += lg[i0] * bf_lo(w.x) + lg[i0 + 1] * bf_hi(w.x) + lg[i0 + 2] * bf_lo(w.y) + lg[i0 + 3] * bf_hi(w.y) + lg[i0 + 4] * bf_lo(w.z) + lg[i0 + 5] * bf_hi(w.z) + lg[i0 + 6] * bf_lo(w.w) + lg[i0 + 7] * bf_hi(w.w); }
        AO[(size_t)(b * 2048 + t) * DM + ao_col0 + h * 64 + lane] = (bf16_t)f2bf(o * linv);
        LDS_WAIT();
    }
}

__device__ __forceinline__ float lsn2q(float z2) { return -(fmaxf(z2, 0.f) + __builtin_amdgcn_logf(1.f + __builtin_amdgcn_exp2f(-fabsf(z2)))); }
__device__ __forceinline__ int pi32(int i) { return (i & ~12) | ((i & 4) << 1) | ((i & 8) >> 1); }
__device__ __forceinline__ void attn_load_k(bf16x8 (&kf)[4], const bf16_t* Kh, int kv0, int r32p, int hi) {
    const bf16_t* p = Kh + (size_t)(kv0 + r32p) * 64 + 8 * hi;
#pragma unroll
    for (int d0 = 0; d0 < 4; ++d0) kf[d0] = *(const bf16x8*)(p + 16 * d0);
}
__device__ __forceinline__ void attn_load_v(bf16x8 (&vf)[2][2], const bf16_t* Vth, int kv0, int r32, int hi) {
#pragma unroll
    for (int s = 0; s < 2; ++s)
#pragma unroll
        for (int dh = 0; dh < 2; ++dh) vf[s][dh] = *(const bf16x8*)(Vth + (size_t)(32 * dh + r32) * 2048 + kv0 + 16 * s + 8 * hi);
}
template <int KIND, int MODE>
__device__ __forceinline__ void attn_tile(const bf16x8 (&qr)[4], const bf16x8 (&kf)[4], const bf16x8 (&vf)[2][2], f32x16& O0, f32x16& O1, float& m, float& l, float& R,
                                          const f32x16& bias, const int kv0, const int q, const int hi, const bool rowok) {
    f32x16 S = bias;
#pragma unroll
    for (int d0 = 0; d0 < 4; ++d0) S = __builtin_amdgcn_mfma_f32_32x32x16_bf16(kf[d0], qr[d0], S, 0, 0, 0);
    if (MODE == 1) {
#pragma unroll
        for (int r = 0; r < 16; ++r) { const int key = kv0 + (r & 7) + 8 * hi + 16 * (r >> 3); const bool bad = (KIND == 1) ? (key >= q) : (key > q); if (bad) S[r] = -INFINITY; }
    }
    if (MODE == 2) { if (!rowok) {
#pragma unroll
        for (int r = 0; r < 16; ++r) S[r] = -INFINITY; } }
    float p[16];
    if (KIND != 1) {
        float rm = fmaxf(fmaxf(S[0], S[1]), fmaxf(S[2], S[3]));
#pragma unroll
        for (int r = 4; r < 16; r += 4) rm = fmaxf(rm, fmaxf(fmaxf(S[r], S[r + 1]), fmaxf(S[r + 2], S[r + 3])));
        rm = fmaxf(rm, __shfl_xor(rm, 32));
        const float mn = fmaxf(fmaxf(m, rm), -1e30f); const float alpha = __builtin_amdgcn_exp2f(m - mn);
        float ps = 0.f;
#pragma unroll
        for (int r = 0; r < 16; ++r) { p[r] = __builtin_amdgcn_exp2f(S[r] - mn); ps += p[r]; }
        l = l * alpha + ps; m = mn;
        O0 *= alpha; O1 *= alpha;
    } else {
        float l2[16]; float sLo = 0.f, sHi = 0.f;
#pragma unroll
        for (int r = 0; r < 16; ++r) l2[r] = lsn2q(S[r]);
#pragma unroll
        for (int r = 0; r < 8; ++r) { sLo += l2[r]; sHi += l2[8 + r]; }
        const float pLo = __shfl_xor(sLo, 32), pHi = __shfl_xor(sHi, 32);
        float run = hi ? R : R + pHi;
#pragma unroll
        for (int r = 15; r >= 8; --r) { p[r] = __builtin_amdgcn_exp2f(S[r] + l2[r] + run); run += l2[r]; }
        run = hi ? (R + sHi + pHi) : (R + pHi + sHi + pLo);
#pragma unroll
        for (int r = 7; r >= 0; --r) { p[r] = __builtin_amdgcn_exp2f(S[r] + l2[r] + run); run += l2[r]; }
        R += (sLo + sHi) + (pLo + pHi);
    }
    u32x4 w0, w1;
    w0.x = pk2(p[0], p[1]); w0.y = pk2(p[2], p[3]); w0.z = pk2(p[4], p[5]); w0.w = pk2(p[6], p[7]);
    w1.x = pk2(p[8], p[9]); w1.y = pk2(p[10], p[11]); w1.z = pk2(p[12], p[13]); w1.w = pk2(p[14], p[15]);
    const bf16x8 pf0 = __builtin_bit_cast(bf16x8, w0), pf1 = __builtin_bit_cast(bf16x8, w1);
    O0 = __builtin_amdgcn_mfma_f32_32x32x16_bf16(vf[0][0], pf0, O0, 0, 0, 0); O0 = __builtin_amdgcn_mfma_f32_32x32x16_bf16(vf[1][0], pf1, O0, 0, 0, 0);
    O1 = __builtin_amdgcn_mfma_f32_32x32x16_bf16(vf[0][1], pf0, O1, 0, 0, 0); O1 = __builtin_amdgcn_mfma_f32_32x32x16_bf16(vf[1][1], pf1, O1, 0, 0, 0);
}
template <int KIND>
__device__ __forceinline__ f32x16 attn_bias(const float* CFh, float slope2, int kv0, int q0, int hi) {
    f32x16 b = f32x16{};
    if (KIND == 0) { const float* c = CFh + kv0 + 8 * hi; const f32x4 a0 = *(const f32x4*)c, a1 = *(const f32x4*)(c + 4), a2 = *(const f32x4*)(c + 16), a3 = *(const f32x4*)(c + 20);
        b[0] = -a0[0]; b[1] = -a0[1]; b[2] = -a0[2]; b[3] = -a0[3]; b[4] = -a1[0]; b[5] = -a1[1]; b[6] = -a1[2]; b[7] = -a1[3];
        b[8] = -a2[0]; b[9] = -a2[1]; b[10] = -a2[2]; b[11] = -a2[3]; b[12] = -a3[0]; b[13] = -a3[1]; b[14] = -a3[2]; b[15] = -a3[3]; }
    if (KIND == 2) {
#pragma unroll
        for (int r = 0; r < 16; ++r) b[r] = slope2 * (float)(kv0 + (r & 7) + 8 * hi + 16 * (r >> 3) - q0); }
    return b;
}
template <int KIND>
__device__ __forceinline__ void attn_wave(const bf16_t* Qh, const bf16_t* Kh, const bf16_t* Vth, const int q0, const int lane, const float* CFh, const float slope2, const float* KMh, bf16_t* AOp) {
    const int r32 = lane & 31, hi = lane >> 5, r32p = pi32(r32), q = q0 + r32;
    bf16x8 qr[4];
#pragma unroll
    for (int d0 = 0; d0 < 4; ++d0) qr[d0] = *(const bf16x8*)(Qh + (size_t)q * 64 + 16 * d0 + 8 * hi);
    f32x16 O0 = f32x16{}, O1 = f32x16{};
    float m = -INFINITY, l = 0.f, R = 0.f;
    bf16x8 kf[4], kfn[4], vf[2][2];
    const int nt = q0 / 32 + 1;
    if (KIND == 0) {
        attn_load_k(kf, Kh, 0, r32p, hi);
        for (int it = 0; it < nt; ++it) { const int kv0 = 32 * it;
            attn_load_v(vf, Vth, kv0, r32, hi); const f32x16 bias = attn_bias<0>(CFh, 0.f, kv0, q0, hi);
            if (it + 1 < nt) attn_load_k(kfn, Kh, kv0 + 32, r32p, hi);
            if (it == nt - 1) attn_tile<0, 1>(qr, kf, vf, O0, O1, m, l, R, bias, kv0, q, hi, true); else attn_tile<0, 0>(qr, kf, vf, O0, O1, m, l, R, bias, kv0, q, hi, true);
#pragma unroll
            for (int d0 = 0; d0 < 4; ++d0) kf[d0] = kfn[d0]; }
    } else if (KIND == 1) {
        attn_load_k(kf, Kh, 32 * (nt - 1), r32p, hi);
        for (int it = nt - 1; it >= 0; --it) { const int kv0 = 32 * it;
            attn_load_v(vf, Vth, kv0, r32, hi); const f32x16 bias = f32x16{};
            if (it > 0) attn_load_k(kfn, Kh, kv0 - 32, r32p, hi);
            if (it == nt - 1) attn_tile<1, 1>(qr, kf, vf, O0, O1, m, l, R, bias, kv0, q, hi, true); else attn_tile<1, 0>(qr, kf, vf, O0, O1, m, l, R, bias, kv0, q, hi, true);
#pragma unroll
            for (int d0 = 0; d0 < 4; ++d0) kf[d0] = kfn[d0];
            if (__all(R < -200.f)) break; }
    } else {
        const int qb = q0 >> 8;
        f32x16 G = f32x16{};
#pragma unroll
        for (int d0 = 0; d0 < 4; ++d0) { u32x4 kw = {0u, 0u, 0u, 0u};
            if (r32 < 8) { const float* kmp = KMh + r32 * 64 + 16 * d0 + 8 * hi; kw = pack8(*(const f32x4*)kmp, *(const f32x4*)(kmp + 4)); }
            G = __builtin_amdgcn_mfma_f32_32x32x16_bf16(__builtin_bit_cast(bf16x8, kw), qr[d0], G, 0, 0, 0); }
        float gate[8];
#pragma unroll
        for (int n = 0; n < 4; ++n) { const float own = G[n], oth = __shfl_xor(own, 32); gate[n] = hi ? oth : own; gate[n + 4] = hi ? own : oth; }
        unsigned sel = 0u; const int nsel = qb < 3 ? qb : 3;
#pragma unroll
        for (int r = 0; r < 3; ++r) if (r < nsel) { float best = -INFINITY; int bi = 0;
#pragma unroll
            for (int n = 0; n < 8; ++n) if (n < qb && !((sel >> n) & 1u) && gate[n] > best) { best = gate[n]; bi = n; }
            sel |= 1u << bi; }
        for (int kv0 = 256 * qb; kv0 <= q0; kv0 += 32) {
            attn_load_k(kf, Kh, kv0, r32p, hi); attn_load_v(vf, Vth, kv0, r32, hi); const f32x16 bias = attn_bias<2>(nullptr, slope2, kv0, q0, hi);
            if (kv0 == q0) attn_tile<2, 1>(qr, kf, vf, O0, O1, m, l, R, bias, kv0, q, hi, true); else attn_tile<2, 0>(qr, kf, vf, O0, O1, m, l, R, bias, kv0, q, hi, true); }
        for (int j = 0; j < qb; ++j) { const bool rowok = (sel >> j) & 1u;
            if (!__any(rowok)) continue;
            attn_load_k(kf, Kh, 256 * j, r32p, hi);
            for (int i = 0; i < 8; ++i) { const int kv0 = 256 * j + 32 * i;
                attn_load_v(vf, Vth, kv0, r32, hi); const f32x16 bias = attn_bias<2>(nullptr, slope2, kv0, q0, hi);
                if (i < 7) attn_load_k(kfn, Kh, kv0 + 32, r32p, hi);
                attn_tile<2, 2>(qr, kf, vf, O0, O1, m, l, R, bias, kv0, q, hi, rowok);
#pragma unroll
                for (int d0 = 0; d0 < 4; ++d0) kf[d0] = kfn[d0]; } }
    }
    float linv = 1.f;
    if (KIND != 1) linv = 1.f / (l + __shfl_xor(l, 32));
    bf16_t* orow = AOp + (size_t)q * DM;
#pragma unroll
    for (int g = 0; g < 4; ++g) { u32x2 w;
        w.x = pk2(O0[4 * g] * linv, O0[4 * g + 1] * linv); w.y = pk2(O0[4 * g + 2] * linv, O0[4 * g + 3] * linv); *(u32x2*)(orow + 8 * g + 4 * hi) = w;
        w.x = pk2(O1[4 * g] * linv, O1[4 * g + 1] * linv); w.y = pk2(O1[4 * g + 2] * linv, O1[4 * g + 3] * linv); *(u32x2*)(orow + 32 + 8 * g + 4 * hi) = w; }
}
template <int KIND>
__device__ __forceinline__ void phase_attn(Frame& F, const bf16_t* QH, const bf16_t* KH, const bf16_t* VT, int NH, int hbase, const float* CF, const float* KMEAN, bf16_t* AO, int ao_col0) {
    for (int ug = F.vcu; ug < NB * 8 * 2; ug += F.G) {
        const int bh = ug >> 1, b = bh >> 3, h = bh & 7, hh = hbase + h; const size_t hb = (size_t)(b * NH + hh);
        const float slope2 = __builtin_amdgcn_exp2f(-(float)(h + 1)) * LOG2E;
#pragma unroll 1
        for (int i = 0; i < 4; ++i) { const int base = (i >> 1) * 2 + (ug & 1), qb = (i & 1) ? 7 - base : base, w = (i & 1) ? 7 - F.wave : F.wave;
            attn_wave<KIND>(QH + hb * 2048 * 64, KH + hb * 2048 * 64, VT + hb * 64 * 2048, 256 * qb + 32 * w, opaque_i(F.lane),
                            CF ? CF + (size_t)bh * 2048 : nullptr, slope2, KMEAN ? KMEAN + (size_t)bh * 8 * 64 : nullptr, AO + (size_t)b * 2048 * DM + ao_col0 + h * 64); }
    }
}


constexpr int AT_SLOT = 16384, AT_CF = 3 * AT_SLOT;
__device__ __forceinline__ void attn_dma_tile(const bf16_t* Kh, const bf16_t* Vth, int T, LAS unsigned char* slot, int wave, int r32, int r32p, int hi) {
    const int j = wave >> 2, d0 = wave & 3, s2 = (wave >> 1) & 1, dh = wave & 1;
    const bf16_t* ks = Kh + (size_t)(64 * T + 32 * j + r32p) * 64 + 16 * d0 + 8 * hi;
    const bf16_t* vs = Vth + (size_t)(32 * dh + r32) * 2048 + 64 * T + 32 * j + 16 * s2 + 8 * hi;
    __builtin_amdgcn_global_load_lds((const unsigned*)ks, (LAS unsigned*)(slot + (j * 4 + d0) * 1024), 16, 0, 0);
    __builtin_amdgcn_global_load_lds((const unsigned*)vs, (LAS unsigned*)(slot + 8192 + ((j * 2 + s2) * 2 + dh) * 1024), 16, 0, 0);
}
template <int MODE>
__device__ __forceinline__ void attn_fox_sub(const bf16x8 (&qr)[4], f32x16& O0, f32x16& O1, float& m, float& l, unsigned saddr  , unsigned cfaddr  , int j, int kv0, int q, int hi) {
    bf16x8 kf[4], vf[2][2]; f32x4 c0, c1, c2, c3;
    asm volatile("ds_read_b128 %0, %12\n\tds_read_b128 %1, %12 offset:1024\n\tds_read_b128 %2, %12 offset:2048\n\tds_read_b128 %3, %12 offset:3072\n\t"
                 "ds_read_b128 %4, %13\n\tds_read_b128 %5, %13 offset:1024\n\tds_read_b128 %6, %13 offset:2048\n\tds_read_b128 %7, %13 offset:3072\n\t"
                 "ds_read_b128 %8, %14\n\tds_read_b128 %9, %14 offset:16\n\tds_read_b128 %10, %14 offset:64\n\tds_read_b128 %11, %14 offset:80\n\ts_waitcnt lgkmcnt(0)"
                 : "=&v"(kf[0]), "=&v"(kf[1]), "=&v"(kf[2]), "=&v"(kf[3]), "=&v"(vf[0][0]), "=&v"(vf[0][1]), "=&v"(vf[1][0]), "=&v"(vf[1][1]), "=&v"(c0), "=&v"(c1), "=&v"(c2), "=&v"(c3)
                 : "v"(saddr + (unsigned)j * 4096u), "v"(saddr + 8192u + (unsigned)j * 4096u), "v"(cfaddr) : "memory");
    f32x16 S;
    S[0] = -c0[0]; S[1] = -c0[1]; S[2] = -c0[2]; S[3] = -c0[3]; S[4] = -c1[0]; S[5] = -c1[1]; S[6] = -c1[2]; S[7] = -c1[3];
    S[8] = -c2[0]; S[9] = -c2[1]; S[10] = -c2[2]; S[11] = -c2[3]; S[12] = -c3[0]; S[13] = -c3[1]; S[14] = -c3[2]; S[15] = -c3[3];
#pragma unroll
    for (int d0 = 0; d0 < 4; ++d0) S = __builtin_amdgcn_mfma_f32_32x32x16_bf16(kf[d0], qr[d0], S, 0, 0, 0);
    if (MODE == 1) {
#pragma unroll
        for (int r = 0; r < 16; ++r) { const int key = kv0 + (r & 7) + 8 * hi + 16 * (r >> 3); if (key > q) S[r] = -INFINITY; }
    }
    float rm = fmaxf(fmaxf(S[0], S[1]), fmaxf(S[2], S[3]));
#pragma unroll
    for (int r = 4; r < 16; r += 4) rm = fmaxf(rm, fmaxf(fmaxf(S[r], S[r + 1]), fmaxf(S[r + 2], S[r + 3])));
    { const auto rr = __builtin_amdgcn_permlane32_swap(__float_as_uint(rm), __float_as_uint(rm), false, false); rm = fmaxf(__uint_as_float(rr[0]), __uint_as_float(rr[1])); }
    if (__any(rm > m)) {
        const float mn = fmaxf(fmaxf(m, rm), -1e30f); const float alpha = __builtin_amdgcn_exp2f(m - mn);
        l *= alpha; O0 *= alpha; O1 *= alpha; m = mn; }
    float p[16]; float ps = 0.f;
#pragma unroll
    for (int r = 0; r < 16; ++r) { p[r] = __builtin_amdgcn_exp2f(S[r] - m); ps += p[r]; }
    l += ps;
    u32x4 w0, w1;
    w0.x = pk2(p[0], p[1]); w0.y = pk2(p[2], p[3]); w0.z = pk2(p[4], p[5]); w0.w = pk2(p[6], p[7]);
    w1.x = pk2(p[8], p[9]); w1.y = pk2(p[10], p[11]); w1.z = pk2(p[12], p[13]); w1.w = pk2(p[14], p[15]);
    const bf16x8 pf0 = __builtin_bit_cast(bf16x8, w0), pf1 = __builtin_bit_cast(bf16x8, w1);
    O0 = __builtin_amdgcn_mfma_f32_32x32x16_bf16(vf[0][0], pf0, O0, 0, 0, 0); O0 = __builtin_amdgcn_mfma_f32_32x32x16_bf16(vf[1][0], pf1, O0, 0, 0, 0);
    O1 = __builtin_amdgcn_mfma_f32_32x32x16_bf16(vf[0][1], pf0, O1, 0, 0, 0); O1 = __builtin_amdgcn_mfma_f32_32x32x16_bf16(vf[1][1], pf1, O1, 0, 0, 0);
}
__device__ __forceinline__ void attn_fox_unit(Frame& F, const bf16_t* Qh, const bf16_t* Kh, const bf16_t* Vth, const float* CFh, const int qb, bf16_t* AOp) {
    const int lane = opaque_i(F.lane), r32 = lane & 31, hi = lane >> 5, r32p = pi32(r32), wave = F.wave, q0 = 256 * qb + 32 * wave, q = q0 + r32;
    LAS unsigned char* ring = F.lds; const unsigned ring_a = (unsigned)(uintptr_t)ring + 16u * (unsigned)lane, cf_a = (unsigned)(uintptr_t)ring + (unsigned)AT_CF + 32u * (unsigned)hi;
    bf16x8 qr[4];
#pragma unroll
    for (int d0 = 0; d0 < 4; ++d0) qr[d0] = *(const bf16x8*)(Qh + (size_t)q * 64 + 16 * d0 + 8 * hi);
    { const f32x4 cv = *(const f32x4*)(CFh + 4 * F.tid); *(LAS f32x4*)(ring + AT_CF + 16 * F.tid) = cv; }
    asm volatile("s_waitcnt vmcnt(0) lgkmcnt(0)" ::: "memory"); __builtin_amdgcn_s_barrier();
    const int NT = 4 * qb + 4, my_last = 4 * qb + (wave >> 1), jdiag = wave & 1;
    attn_dma_tile(Kh, Vth, NT - 1, ring, wave, r32, r32p, hi);
    attn_dma_tile(Kh, Vth, NT - 2, ring + AT_SLOT, wave, r32, r32p, hi);
    f32x16 O0 = f32x16{}, O1 = f32x16{}; float m = -INFINITY, l = 0.f;
    int slot = 0;
#pragma unroll 1
    for (int T = NT - 1; T >= 0; --T) {
        if (T > 0) asm volatile("s_waitcnt vmcnt(2)" ::: "memory"); else asm volatile("s_waitcnt vmcnt(0)" ::: "memory");
        __builtin_amdgcn_s_barrier();
        if (T >= 2) { const int fs = (slot == 0) ? 2 : slot - 1; attn_dma_tile(Kh, Vth, T - 2, ring + fs * AT_SLOT, wave, r32, r32p, hi); }
        if (T <= my_last) {
            const unsigned sa = ring_a + (unsigned)(slot * AT_SLOT);
            if (T == my_last) {
                if (jdiag == 1) { attn_fox_sub<1>(qr, O0, O1, m, l, sa, cf_a + 4u * (unsigned)(64 * T + 32), 1, 64 * T + 32, q, hi); attn_fox_sub<0>(qr, O0, O1, m, l, sa, cf_a + 4u * (unsigned)(64 * T), 0, 64 * T, q, hi); }
                else attn_fox_sub<1>(qr, O0, O1, m, l, sa, cf_a + 4u * (unsigned)(64 * T), 0, 64 * T, q, hi);
            } else { attn_fox_sub<0>(qr, O0, O1, m, l, sa, cf_a + 4u * (unsigned)(64 * T + 32), 1, 64 * T + 32, q, hi); attn_fox_sub<0>(qr, O0, O1, m, l, sa, cf_a + 4u * (unsigned)(64 * T), 0, 64 * T, q, hi); }
        }
        slot = (slot == 2) ? 0 : slot + 1;
    }
    const float linv = 1.f / (l + __shfl_xor(l, 32));
    bf16_t* orow = AOp + (size_t)q * DM;
#pragma unroll
    for (int g = 0; g < 4; ++g) { u32x2 w;
        w.x = pk2(O0[4 * g] * linv, O0[4 * g + 1] * linv); w.y = pk2(O0[4 * g + 2] * linv, O0[4 * g + 3] * linv); *(u32x2*)(orow + 8 * g + 4 * hi) = w;
        w.x = pk2(O1[4 * g] * linv, O1[4 * g + 1] * linv); w.y = pk2(O1[4 * g + 2] * linv, O1[4 * g + 3] * linv); *(u32x2*)(orow + 32 + 8 * g + 4 * hi) = w; }
    asm volatile("s_waitcnt vmcnt(0) lgkmcnt(0)" ::: "memory"); __builtin_amdgcn_s_barrier();
}
__device__ __forceinline__ void phase_attn_fox(Frame& F, const bf16_t* QH, const bf16_t* KH, const bf16_t* VT, const float* CF, bf16_t* AO) {
    for (int ug = F.vcu; ug < NB * 8 * 2; ug += F.G) {
        const int bh = ug >> 1, b = bh >> 3, h = bh & 7; const size_t hb = (size_t)(b * 16 + h);
#pragma unroll 1
        for (int i = 0; i < 4; ++i) { const int base = (i >> 1) * 2 + (ug & 1), qb = (i & 1) ? 7 - base : base;
            attn_fox_unit(F, QH + hb * 2048 * 64, KH + hb * 2048 * 64, VT + hb * 64 * 2048, CF + (size_t)bh * 2048, qb, AO + (size_t)b * 2048 * DM + h * 64); }
    }
}

template <int MODE>
__device__ __forceinline__ void attn_moba_sub(const bf16x8 (&qr)[4], f32x16& O0, f32x16& O1, float& m, float& l, unsigned saddr, int j, int kv0, int q, int q0, int hi, float slope2, bool rowok) {
    bf16x8 kf[4], vf[2][2];
    asm volatile("ds_read_b128 %0, %8\n\tds_read_b128 %1, %8 offset:1024\n\tds_read_b128 %2, %8 offset:2048\n\tds_read_b128 %3, %8 offset:3072\n\t"
                 "ds_read_b128 %4, %9\n\tds_read_b128 %5, %9 offset:1024\n\tds_read_b128 %6, %9 offset:2048\n\tds_read_b128 %7, %9 offset:3072\n\ts_waitcnt lgkmcnt(0)"
                 : "=&v"(kf[0]), "=&v"(kf[1]), "=&v"(kf[2]), "=&v"(kf[3]), "=&v"(vf[0][0]), "=&v"(vf[0][1]), "=&v"(vf[1][0]), "=&v"(vf[1][1])
                 : "v"(saddr + (unsigned)j * 4096u), "v"(saddr + 8192u + (unsigned)j * 4096u) : "memory");
    f32x16 S; const float sbase = slope2 * (float)(kv0 + 8 * hi - q0);
#pragma unroll
    for (int r = 0; r < 16; ++r) S[r] = sbase + slope2 * (float)((r & 7) + 16 * (r >> 3));
#pragma unroll
    for (int d0 = 0; d0 < 4; ++d0) S = __builtin_amdgcn_mfma_f32_32x32x16_bf16(kf[d0], qr[d0], S, 0, 0, 0);
    if (MODE == 1) {
#pragma unroll
        for (int r = 0; r < 16; ++r) { const int key = kv0 + (r & 7) + 8 * hi + 16 * (r >> 3); if (key > q) S[r] = -INFINITY; }
    }
    if (MODE == 2) { if (!rowok) {
#pragma unroll
        for (int r = 0; r < 16; ++r) S[r] = -INFINITY; } }
    float rm = fmaxf(fmaxf(S[0], S[1]), fmaxf(S[2], S[3]));
#pragma unroll
    for (int r = 4; r < 16; r += 4) rm = fmaxf(rm, fmaxf(fmaxf(S[r], S[r + 1]), fmaxf(S[r + 2], S[r + 3])));
    { const auto rr = __builtin_amdgcn_permlane32_swap(__float_as_uint(rm), __float_as_uint(rm), false, false); rm = fmaxf(__uint_as_float(rr[0]), __uint_as_float(rr[1])); }
    if (__any(rm > m)) { const float mn = fmaxf(fmaxf(m, rm), -1e30f); const float alpha = __builtin_amdgcn_exp2f(m - mn); l *= alpha; O0 *= alpha; O1 *= alpha; m = mn; }
    float p[16]; float ps = 0.f;
#pragma unroll
    for (int r = 0; r < 16; ++r) { p[r] = __builtin_amdgcn_exp2f(S[r] - m); ps += p[r]; }
    l += ps;
    u32x4 w0, w1;
    w0.x = pk2(p[0], p[1]); w0.y = pk2(p[2], p[3]); w0.z = pk2(p[4], p[5]); w0.w = pk2(p[6], p[7]);
    w1.x = pk2(p[8], p[9]); w1.y = pk2(p[10], p[11]); w1.z = pk2(p[12], p[13]); w1.w = pk2(p[14], p[15]);
    const bf16x8 pf0 = __builtin_bit_cast(bf16x8, w0), pf1 = __builtin_bit_cast(bf16x8, w1);
    O0 = __builtin_amdgcn_mfma_f32_32x32x16_bf16(vf[0][0], pf0, O0, 0, 0, 0); O0 = __builtin_amdgcn_mfma_f32_32x32x16_bf16(vf[1][0], pf1, O0, 0, 0, 0);
    O1 = __builtin_amdgcn_mfma_f32_32x32x16_bf16(vf[0][1], pf0, O1, 0, 0, 0); O1 = __builtin_amdgcn_mfma_f32_32x32x16_bf16(vf[1][1], pf1, O1, 0, 0, 0);
}
__device__ __forceinline__ void attn_moba_unit(Frame& F, const bf16_t* Qh, const bf16_t* Kh, const bf16_t* Vth, const float* KMh, const float slope2, const int qb, bf16_t* AOp) {
    const int lane = opaque_i(F.lane), r32 = lane & 31, hi = lane >> 5, r32p = pi32(r32), wave = F.wave, q0 = 256 * qb + 32 * wave, q = q0 + r32;
    LAS unsigned char* ring = F.lds; const unsigned ring_a = (unsigned)(uintptr_t)ring + 16u * (unsigned)lane;
    bf16x8 qr[4];
#pragma unroll
    for (int d0 = 0; d0 < 4; ++d0) qr[d0] = *(const bf16x8*)(Qh + (size_t)q * 64 + 16 * d0 + 8 * hi);
    f32x16 G = f32x16{};
#pragma unroll
    for (int d0 = 0; d0 < 4; ++d0) { u32x4 kw = {0u, 0u, 0u, 0u};
        if (r32 < 8) { const float* kmp = KMh + r32 * 64 + 16 * d0 + 8 * hi; kw = pack8(*(const f32x4*)kmp, *(const f32x4*)(kmp + 4)); }
        G = __builtin_amdgcn_mfma_f32_32x32x16_bf16(__builtin_bit_cast(bf16x8, kw), qr[d0], G, 0, 0, 0); }
    float gate[8];
#pragma unroll
    for (int n = 0; n < 4; ++n) { const float own = G[n], oth = __shfl_xor(own, 32); gate[n] = hi ? oth : own; gate[n + 4] = hi ? own : oth; }
    unsigned sel = 0u; const int nsel = qb < 3 ? qb : 3;
#pragma unroll
    for (int r = 0; r < 3; ++r) if (r < nsel) { float best = -INFINITY; int bi = 0;
#pragma unroll
        for (int n = 0; n < 8; ++n) if (n < qb && !((sel >> n) & 1u) && gate[n] > best) { best = gate[n]; bi = n; }
        sel |= 1u << bi; }
    unsigned wsel = 0u;
#pragma unroll
    for (int n = 0; n < 8; ++n) if (__any((sel >> n) & 1u)) wsel |= 1u << n;
    asm volatile("s_waitcnt vmcnt(0) lgkmcnt(0)" ::: "memory"); __builtin_amdgcn_s_barrier();
    const int NT = 4 * qb + 4, my_last = 4 * qb + (wave >> 1), jdiag = wave & 1;
    attn_dma_tile(Kh, Vth, NT - 1, ring, wave, r32, r32p, hi);
    attn_dma_tile(Kh, Vth, NT - 2, ring + AT_SLOT, wave, r32, r32p, hi);
    f32x16 O0 = f32x16{}, O1 = f32x16{}; float m = -INFINITY, l = 0.f;
    int slot = 0;
#pragma unroll 1
    for (int T = NT - 1; T >= 0; --T) {
        if (T > 0) asm volatile("s_waitcnt vmcnt(2)" ::: "memory"); else asm volatile("s_waitcnt vmcnt(0)" ::: "memory");
        __builtin_amdgcn_s_barrier();
        if (T >= 2) { const int fs = (slot == 0) ? 2 : slot - 1; attn_dma_tile(Kh, Vth, T - 2, ring + fs * AT_SLOT, wave, r32, r32p, hi); }
        const unsigned sa = ring_a + (unsigned)(slot * AT_SLOT);
        if (T >= 4 * qb) {
            if (T == my_last) {
                if (jdiag == 1) { attn_moba_sub<1>(qr, O0, O1, m, l, sa, 1, 64 * T + 32, q, q0, hi, slope2, true); attn_moba_sub<0>(qr, O0, O1, m, l, sa, 0, 64 * T, q, q0, hi, slope2, true); }
                else attn_moba_sub<1>(qr, O0, O1, m, l, sa, 0, 64 * T, q, q0, hi, slope2, true);
            } else if (T < my_last) { attn_moba_sub<0>(qr, O0, O1, m, l, sa, 1, 64 * T + 32, q, q0, hi, slope2, true); attn_moba_sub<0>(qr, O0, O1, m, l, sa, 0, 64 * T, q, q0, hi, slope2, true); }
        } else if ((wsel >> (T >> 2)) & 1u) {
            const bool rowok = (sel >> (T >> 2)) & 1u;
            attn_moba_sub<2>(qr, O0, O1, m, l, sa, 1, 64 * T + 32, q, q0, hi, slope2, rowok); attn_moba_sub<2>(qr, O0, O1, m, l, sa, 0, 64 * T, q, q0, hi, slope2, rowok);
        }
        slot = (slot == 2) ? 0 : slot + 1;
    }
    const float linv = 1.f / (l + __shfl_xor(l, 32));
    bf16_t* orow = AOp + (size_t)q * DM;
#pragma unroll
    for (int g = 0; g < 4; ++g) { u32x2 w;
        w.x = pk2(O0[4 * g] * linv, O0[4 * g + 1] * linv); w.y = pk2(O0[4 * g + 2] * linv, O0[4 * g + 3] * linv); *(u32x2*)(orow + 8 * g + 4 * hi) = w;
        w.x = pk2(O1[4 * g] * linv, O1[4 * g + 1] * linv); w.y = pk2(O1[4 * g + 2] * linv, O1[4 * g + 3] * linv); *(u32x2*)(orow + 32 + 8 * g + 4 * hi) = w; }
    asm volatile("s_waitcnt vmcnt(0) lgkmcnt(0)" ::: "memory"); __builtin_amdgcn_s_barrier();
}
__device__ __forceinline__ void phase_attn_moba(Frame& F, const bf16_t* QD, const bf16_t* KD, const bf16_t* VTD, const float* KMEAN, bf16_t* AO) {
    for (int ug = F.vcu; ug < NB * 8 * 2; ug += F.G) {
        const int bh = ug >> 1, b = bh >> 3, h = bh & 7; const size_t hb = (size_t)bh;
        const float slope2 = __builtin_amdgcn_exp2f(-(float)(h + 1)) * LOG2E;
#pragma unroll 1
        for (int i = 0; i < 4; ++i) { const int base = (i >> 1) * 2 + (ug & 1), qb = (i & 1) ? 7 - base : base;
            attn_moba_unit(F, QD + hb * 2048 * 64, KD + hb * 2048 * 64, VTD + hb * 64 * 2048, KMEAN + (size_t)bh * 8 * 64, slope2, qb, AO + (size_t)b * 2048 * DM + 512 + h * 64); }
    }
}
__device__ __forceinline__ void phase_pool(Frame& F, const bf16_t* XC, const bf16_t* PWT, const float* pool_scale, bf16_t* AO) {
    const int gw = F.vcu * NWAVES + F.wave, NGW = F.G * NWAVES, lane = opaque_i(F.lane), r32 = lane & 31, hi = lane >> 5;
    for (int it = gw; it < (TOK / 32) * 4; it += NGW) {
        const int g = it & 3, t0 = (it >> 2) * 32, t = t0 + r32, tl = t & 2047, w = 2 << g;
        const int cnt = (tl + 1) < w ? (tl + 1) : w; const float rc = 1.f / (float)cnt;
        f32x16 acc[4];
#pragma unroll
        for (int nb = 0; nb < 4; ++nb) acc[nb] = f32x16{};
#pragma unroll 1
        for (int kk = 0; kk < 8; ++kk) {
            const int c0 = g * 128 + kk * 16 + hi * 8;
            const u32x4 self = *(const u32x4*)(XC + (size_t)t * 512 + c0);
            float s[8] = {0.f, 0.f, 0.f, 0.f, 0.f, 0.f, 0.f, 0.f};
            for (int i = 0; i < cnt; ++i) { const u32x4 x = *(const u32x4*)(XC + (size_t)(t - i) * 512 + c0);
                s[0] += bf_lo(x.x); s[1] += bf_hi(x.x); s[2] += bf_lo(x.y); s[3] += bf_hi(x.y); s[4] += bf_lo(x.z); s[5] += bf_hi(x.z); s[6] += bf_lo(x.w); s[7] += bf_hi(x.w); }
            u32x4 pa; pa.x = pk2(s[0] * rc - bf_lo(self.x), s[1] * rc - bf_hi(self.x)); pa.y = pk2(s[2] * rc - bf_lo(self.y), s[3] * rc - bf_hi(self.y));
            pa.z = pk2(s[4] * rc - bf_lo(self.z), s[5] * rc - bf_hi(self.z)); pa.w = pk2(s[6] * rc - bf_lo(self.w), s[7] * rc - bf_hi(self.w));
            const bf16x8 af = __builtin_bit_cast(bf16x8, pa);
#pragma unroll
            for (int nb = 0; nb < 4; ++nb) { const bf16x8 bfr = *(const bf16x8*)(PWT + ((size_t)g * 128 + nb * 32 + r32) * 128 + kk * 16 + hi * 8);
                acc[nb] = __builtin_amdgcn_mfma_f32_32x32x16_bf16(af, bfr, acc[nb], 0, 0, 0); }
        }
#pragma unroll
        for (int nb = 0; nb < 4; ++nb) { const int col = g * 128 + nb * 32 + r32; const float sc = pool_scale[col];
#pragma unroll
            for (int r = 0; r < 16; ++r) { const int row = (r & 3) + 8 * (r >> 2) + 4 * hi; AO[(size_t)(t0 + row) * DM + col] = (bf16_t)f2bf(acc[nb][r] * sc); } }
    }
}

__device__ __forceinline__ void phase_topk_naive(Frame& F, const bf16_t* QP, const bf16_t* K1B, const bf16_t* K2B, unsigned short* EID, float* GATE) {
    const int gw = F.vcu * NWAVES + F.wave, NGW = F.G * NWAVES, lane = opaque_i(F.lane);
    for (int task = gw; task < TOK * 8; task += NGW) {
        const int t = task >> 3, h = task & 7;
        const bf16_t* qrow = QP + (size_t)t * 2048 + h * 256; const bf16_t* k1 = K1B + (size_t)h * 128 * 128; const bf16_t* k2 = K2B + (size_t)h * 128 * 128;
        float s1a = 0.f, s1b = 0.f, s2a = 0.f, s2b = 0.f;
#pragma unroll 4
        for (int c = 0; c < 16; ++c) { const u32x4 q1 = *(const u32x4*)(qrow + 8 * c), q2 = *(const u32x4*)(qrow + 128 + 8 * c);
            s1a = dot8(*(const u32x4*)(k1 + (size_t)lane * 128 + 8 * c), q1, s1a); s1b = dot8(*(const u32x4*)(k1 + (size_t)(lane + 64) * 128 + 8 * c), q1, s1b);
            s2a = dot8(*(const u32x4*)(k2 + (size_t)lane * 128 + 8 * c), q2, s2a); s2b = dot8(*(const u32x4*)(k2 + (size_t)(lane + 64) * 128 + 8 * c), q2, s2b); }
        unsigned A = (f2ord(s1a) & ~127u) | (unsigned)(127 - lane), B = (f2ord(s1b) & ~127u) | (unsigned)(63 - lane);
        unsigned top1 = 0u, top2 = 0u, topc = 0u;
        for (int r = 0; r < 16; ++r) { const unsigned m = wave_umax(A > B ? A : B); if (lane == r) top1 = m; if (A == m) A = 0u; if (B == m) B = 0u; }
        A = (f2ord(s2a) & ~127u) | (unsigned)(127 - lane); B = (f2ord(s2b) & ~127u) | (unsigned)(63 - lane);
        for (int r = 0; r < 16; ++r) { const unsigned m = wave_umax(A > B ? A : B); if (lane == r) top2 = m; if (A == m) A = 0u; if (B == m) B = 0u; }
        const float v1 = ord2f(top1 & ~127u), v2 = ord2f(top2 & ~127u); const int i1 = 127 - (int)(top1 & 127u), i2 = 127 - (int)(top2 & 127u);
        const float va = __shfl(v1, lane >> 2); unsigned C[4];
#pragma unroll
        for (int j = 0; j < 4; ++j) { const float vb = __shfl(v2, (lane & 3) * 4 + j); C[j] = (f2ord(va + vb) & ~255u) | (unsigned)(255 - (lane * 4 + j)); }
        for (int r = 0; r < 16; ++r) { unsigned m = C[0] > C[1] ? C[0] : C[1]; const unsigned m2 = C[2] > C[3] ? C[2] : C[3]; m = wave_umax(m > m2 ? m : m2); if (lane == r) topc = m;
#pragma unroll
            for (int j = 0; j < 4; ++j) if (C[j] == m) C[j] = 0u; }
        const int c = 255 - (int)(topc & 255u); const float val = ord2f(topc & ~255u);
        const int ia = __shfl(i1, c >> 4), ib = __shfl(i2, c & 15);
        const float v0 = __shfl(val, 0); const float e = (lane < 16) ? __expf(val - v0) : 0.f; const float sum = wave_sum(e);
        if (lane < 16) { EID[(size_t)t * 128 + h * 16 + lane] = (unsigned short)(ia * 128 + ib); GATE[(size_t)t * 128 + h * 16 + lane] = e / sum; }
    }
}

#define DEVFN __device__ __forceinline__
template <int OFF, int N, int TOT> DEVFN void bitonic_sort_desc(unsigned (&a)[TOT]) {
#pragma unroll
    for (int k = 2; k <= N; k <<= 1)
#pragma unroll
        for (int j = k >> 1; j > 0; j >>= 1)
#pragma unroll
            for (int i = 0; i < N; ++i) { const int l = i ^ j; if (l > i) { const bool desc = ((i & k) == 0); const unsigned x = a[OFF + i], y = a[OFF + l];
                const unsigned mx = x > y ? x : y, mn = x > y ? y : x; a[OFF + i] = desc ? mx : mn; a[OFF + l] = desc ? mn : mx; } }
}
constexpr int OE16_N = 63;
constexpr unsigned char OE16[63][2] = {{0,1}, {2,3}, {0,2}, {1,3}, {1,2}, {4,5}, {6,7}, {4,6}, {5,7}, {5,6}, {0,4}, {2,6}, {2,4}, {1,5}, {3,7}, {3,5}, {1,2}, {3,4}, {5,6}, {8,9}, {10,11}, {8,10}, {9,11}, {9,10}, {12,13}, {14,15}, {12,14}, {13,15}, {13,14}, {8,12}, {10,14}, {10,12}, {9,13}, {11,15}, {11,13}, {9,10}, {11,12}, {13,14}, {0,8}, {4,12}, {4,8}, {2,10}, {6,14}, {6,10}, {2,4}, {6,8}, {10,12}, {1,9}, {5,13}, {5,9}, {3,11}, {7,15}, {7,11}, {3,5}, {7,9}, {11,13}, {1,2}, {3,4}, {5,6}, {7,8}, {9,10}, {11,12}, {13,14}};
template <int OFF, int TOT> DEVFN void sort16_desc(unsigned (&a)[TOT]) {
#pragma unroll
    for (int q = 0; q < OE16_N; ++q) { const int i = OFF + OE16[q][0], l = OFF + OE16[q][1]; const unsigned x = a[i], y = a[l]; a[i] = x > y ? x : y; a[l] = x > y ? y : x; }
}
template <int OFF, int TOT> DEVFN void bitonic_merge16_desc(unsigned (&a)[TOT]) {
#pragma unroll
    for (int j = 8; j > 0; j >>= 1)
#pragma unroll
        for (int i = 0; i < 16; ++i) { const int l = i ^ j; if (l > i) { const unsigned x = a[OFF + i], y = a[OFF + l]; a[OFF + i] = x > y ? x : y; a[OFF + l] = x > y ? y : x; } }
}
template <int A, int B, int TOT> DEVFN void merge_top16(unsigned (&a)[TOT]) {
#pragma unroll
    for (int i = 0; i < 16; ++i) { const unsigned x = a[A + i], y = a[B + 15 - i]; a[A + i] = x > y ? x : y; }
    bitonic_merge16_desc<A, TOT>(a);
}
DEVFN void top16of64(unsigned (&a)[64]) {
    sort16_desc<0, 64>(a); sort16_desc<16, 64>(a); sort16_desc<32, 64>(a); sort16_desc<48, 64>(a);
    merge_top16<0, 16, 64>(a); merge_top16<32, 48, 64>(a); merge_top16<0, 32, 64>(a);
}

__device__ __forceinline__ void phase_topk(Frame& F, const bf16_t* QP, const bf16_t* K1B, const bf16_t* K2B, unsigned short* EID, float* GATE) {
    const int gw = F.vcu * NWAVES + F.wave, NGW = F.G * NWAVES, lane = opaque_i(F.lane), r32 = lane & 31, hi = lane >> 5;
    LAS unsigned* I1s = (LAS unsigned*)(F.lds + F.wave * 8192); LAS unsigned* I2s = I1s + 1024;
    for (int task = gw; task < (TOK / 32) * 8; task += NGW) {
        const int tile = task >> 3, h = task & 7, t = tile * 32 + r32;
        unsigned V1[16], V2[16]; unsigned h4 = (unsigned)hi << 2; asm volatile("" : "+v"(h4));
#pragma unroll
        for (int half = 0; half < 2; ++half) {
            const bf16_t* qrow = QP + (size_t)t * 2048 + h * 256 + half * 128 + 8 * hi;
            bf16x8 qf[8];
#pragma unroll
            for (int kk = 0; kk < 8; ++kk) qf[kk] = *(const bf16x8*)(qrow + 16 * kk);
            unsigned K[64];
#pragma unroll
            for (int nb = 0; nb < 4; ++nb) { f32x16 acc = f32x16{};
                const bf16_t* kb = (half ? K2B : K1B) + ((size_t)h * 128 + nb * 32 + r32) * 128 + 8 * hi; asm volatile("" : "+v"(kb));
#pragma unroll
                for (int kk = 0; kk < 8; ++kk) acc = __builtin_amdgcn_mfma_f32_32x32x16_bf16(*(const bf16x8*)(kb + 16 * kk), qf[kk], acc, 0, 0, 0);
#pragma unroll
                for (int r = 0; r < 16; ++r) K[nb * 16 + r] = ((f2ord(acc[r]) & ~127u) | (unsigned)(127 - (nb * 32 + (r & 3) + 8 * (r >> 2)))) ^ h4;
                __builtin_amdgcn_sched_barrier(0); }
            __builtin_amdgcn_sched_barrier(0); top16of64(K); __builtin_amdgcn_sched_barrier(0);
            unsigned C[16];
#pragma unroll
            for (int i = 0; i < 16; ++i) { const unsigned y = (unsigned)__shfl_xor((int)K[15 - i], 32); C[i] = K[i] > y ? K[i] : y; }
            bitonic_merge16_desc<0, 16>(C);
#pragma unroll
            for (int i = 0; i < 16; ++i) { if (half == 0) V1[i] = C[i]; else V2[i] = C[i]; }
            __builtin_amdgcn_sched_barrier(0);
        }
        float f1[16], f2[16];
#pragma unroll
        for (int a = 0; a < 16; ++a) { I1s[a * 64 + lane] = 127u - (V1[a] & 127u); I2s[a * 64 + lane] = 127u - (V2[a] & 127u); f1[a] = ord2f(V1[a] & ~127u); f2[a] = ord2f(V2[a] & ~127u); }
        __builtin_amdgcn_sched_barrier(0);
        unsigned Cd[64];
    Cd[0] = (f2ord(f1[0] + f2[0]) & ~255u) | 255u;
    Cd[1] = (f2ord(f1[0] + f2[1]) & ~255u) | 254u;
    Cd[2] = (f2ord(f1[0] + f2[2]) & ~255u) | 253u;
    Cd[3] = (f2ord(f1[0] + f2[3]) & ~255u) | 252u;
    Cd[4] = (f2ord(f1[0] + f2[4]) & ~255u) | 251u;
    Cd[5] = (f2ord(f1[0] + f2[5]) & ~255u) | 250u;
    Cd[6] = (f2ord(f1[0] + f2[6]) & ~255u) | 249u;
    Cd[7] = (f2ord(f1[0] + f2[7]) & ~255u) | 248u;
    Cd[8] = (f2ord(f1[0] + f2[8]) & ~255u) | 247u;
    Cd[9] = (f2ord(f1[0] + f2[9]) & ~255u) | 246u;
    Cd[10] = (f2ord(f1[0] + f2[10]) & ~255u) | 245u;
    Cd[11] = (f2ord(f1[0] + f2[11]) & ~255u) | 244u;
    Cd[12] = (f2ord(f1[0] + f2[12]) & ~255u) | 243u;
    Cd[13] = (f2ord(f1[0] + f2[13]) & ~255u) | 242u;
    Cd[14] = (f2ord(f1[0] + f2[14]) & ~255u) | 241u;
    Cd[15] = (f2ord(f1[0] + f2[15]) & ~255u) | 240u;
    Cd[16] = (f2ord(f1[1] + f2[0]) & ~255u) | 239u;
    Cd[17] = (f2ord(f1[1] + f2[1]) & ~255u) | 238u;
    Cd[18] = (f2ord(f1[1] + f2[2]) & ~255u) | 237u;
    Cd[19] = (f2ord(f1[1] + f2[3]) & ~255u) | 236u;
    Cd[20] = (f2ord(f1[1] + f2[4]) & ~255u) | 235u;
    Cd[21] = (f2ord(f1[1] + f2[5]) & ~255u) | 234u;
    Cd[22] = (f2ord(f1[1] + f2[6]) & ~255u) | 233u;
    Cd[23] = (f2ord(f1[1] + f2[7]) & ~255u) | 232u;
    Cd[24] = (f2ord(f1[2] + f2[0]) & ~255u) | 223u;
    Cd[25] = (f2ord(f1[2] + f2[1]) & ~255u) | 222u;
    Cd[26] = (f2ord(f1[2] + f2[2]) & ~255u) | 221u;
    Cd[27] = (f2ord(f1[2] + f2[3]) & ~255u) | 220u;
    Cd[28] = (f2ord(f1[2] + f2[4]) & ~255u) | 219u;
    Cd[29] = (f2ord(f1[3] + f2[0]) & ~255u) | 207u;
    Cd[30] = (f2ord(f1[3] + f2[1]) & ~255u) | 206u;
    Cd[31] = (f2ord(f1[3] + f2[2]) & ~255u) | 205u;
    Cd[32] = (f2ord(f1[3] + f2[3]) & ~255u) | 204u;
    Cd[33] = (f2ord(f1[4] + f2[0]) & ~255u) | 191u;
    Cd[34] = (f2ord(f1[4] + f2[1]) & ~255u) | 190u;
    Cd[35] = (f2ord(f1[4] + f2[2]) & ~255u) | 189u;
    Cd[36] = (f2ord(f1[5] + f2[0]) & ~255u) | 175u;
    Cd[37] = (f2ord(f1[5] + f2[1]) & ~255u) | 174u;
    Cd[38] = (f2ord(f1[6] + f2[0]) & ~255u) | 159u;
    Cd[39] = (f2ord(f1[6] + f2[1]) & ~255u) | 158u;
    Cd[40] = (f2ord(f1[7] + f2[0]) & ~255u) | 143u;
    Cd[41] = (f2ord(f1[7] + f2[1]) & ~255u) | 142u;
    Cd[42] = (f2ord(f1[8] + f2[0]) & ~255u) | 127u;
    Cd[43] = (f2ord(f1[9] + f2[0]) & ~255u) | 111u;
    Cd[44] = (f2ord(f1[10] + f2[0]) & ~255u) | 95u;
    Cd[45] = (f2ord(f1[11] + f2[0]) & ~255u) | 79u;
    Cd[46] = (f2ord(f1[12] + f2[0]) & ~255u) | 63u;
    Cd[47] = (f2ord(f1[13] + f2[0]) & ~255u) | 47u;
    Cd[48] = (f2ord(f1[14] + f2[0]) & ~255u) | 31u;
    Cd[49] = (f2ord(f1[15] + f2[0]) & ~255u) | 15u;
    Cd[50] = 0u;
    Cd[51] = 0u;
    Cd[52] = 0u;
    Cd[53] = 0u;
    Cd[54] = 0u;
    Cd[55] = 0u;
    Cd[56] = 0u;
    Cd[57] = 0u;
    Cd[58] = 0u;
    Cd[59] = 0u;
    Cd[60] = 0u;
    Cd[61] = 0u;
    Cd[62] = 0u;
    Cd[63] = 0u;
        __builtin_amdgcn_sched_barrier(0); top16of64(Cd); __builtin_amdgcn_sched_barrier(0);
        LDS_WAIT();
        unsigned eid[16]; float e[16]; float sum = 0.f; const float v0 = ord2f(Cd[0] & ~255u);
#pragma unroll
        for (int r = 0; r < 16; ++r) { const unsigned c = 255u - (Cd[r] & 255u); eid[r] = I1s[(c >> 4) * 64 + lane] * 128u + I2s[(c & 15u) * 64 + lane];
            e[r] = __builtin_amdgcn_exp2f((ord2f(Cd[r] & ~255u) - v0) * LOG2E); sum += e[r]; }
        const float inv = 1.f / sum;
        u32x4 ew; ew.x = (hi ? eid[8] : eid[0]) | ((hi ? eid[9] : eid[1]) << 16); ew.y = (hi ? eid[10] : eid[2]) | ((hi ? eid[11] : eid[3]) << 16);
        ew.z = (hi ? eid[12] : eid[4]) | ((hi ? eid[13] : eid[5]) << 16); ew.w = (hi ? eid[14] : eid[6]) | ((hi ? eid[15] : eid[7]) << 16);
        *(u32x4*)(EID + (size_t)t * 128 + h * 16 + 8 * hi) = ew;
        const f32x4 g0 = {(hi ? e[8] : e[0]) * inv, (hi ? e[9] : e[1]) * inv, (hi ? e[10] : e[2]) * inv, (hi ? e[11] : e[3]) * inv};
        const f32x4 g1 = {(hi ? e[12] : e[4]) * inv, (hi ? e[13] : e[5]) * inv, (hi ? e[14] : e[6]) * inv, (hi ? e[15] : e[7]) * inv};
        *(f32x4*)(GATE + (size_t)t * 128 + h * 16 + 8 * hi) = g0; *(f32x4*)(GATE + (size_t)t * 128 + h * 16 + 8 * hi + 4) = g1;
        LDS_WAIT();
    }
}

typedef float f32x2 __attribute__((ext_vector_type(2)));
__device__ __forceinline__ float dpp_f(float v, int sel) {
    const int iv = __builtin_bit_cast(int, v); int r;
    if (sel == 0) r = __builtin_amdgcn_update_dpp(0, iv, 0xB1, 0xf, 0xf, true); else if (sel == 1) r = __builtin_amdgcn_update_dpp(0, iv, 0x4E, 0xf, 0xf, true); else r = __builtin_amdgcn_update_dpp(0, iv, 0x141, 0xf, 0xf, true);
    return __builtin_bit_cast(float, r);
}
__device__ __forceinline__ float gelu_erf(float v) {
    const float av = fabsf(v), d = av * 0.2316418882f + 1.0f; const float t = __builtin_amdgcn_rcpf(d);
    float q = t * 0.5307027145f + (-0.7265760135f); q = q * t + 0.7107068705f; q = q * t + (-0.142248368f); q = q * t + 0.127414796f; q = q * t;
    const float e = __builtin_amdgcn_exp2f((v * v) * (-0.72134752044f));
    const float m = v * (q * e), r = v - m; return v < 0.f ? m : r;
}
typedef _Float16 h16x2 __attribute__((ext_vector_type(2)));
__device__ __forceinline__ h16x2 bf8_lo2(unsigned w) { return __builtin_bit_cast(h16x2, __builtin_amdgcn_perm(0u, w, 0x010c000cu)); }
__device__ __forceinline__ h16x2 bf8_hi2(unsigned w) { return __builtin_bit_cast(h16x2, __builtin_amdgcn_perm(0u, w, 0x030c020cu)); }
__device__ __forceinline__ h16x2 bf16pair_to_h2(unsigned w) { h16x2 r; r.x = (_Float16)bf_lo(w); r.y = (_Float16)bf_hi(w); return r; }
#define PEER_E(ev0_, ev1_, w_) (int)((((w_) < 8 ? (ev0_) : (ev1_))[((w_) & 7) >> 1] >> (16 * ((w_) & 1))) & 0xffffu)
#define GLD16(dst_, ptr_) asm volatile("global_load_dwordx4 %0, %1, off" : "=v"(dst_) : "v"(ptr_) : "memory")
__device__ __forceinline__ void phase_peer_u(Frame& F, const bf16_t* XB, const float* rsp, int rsmode, const unsigned short* EID, const unsigned char* U8S, float* PREP) {
    const int lane = opaque_i(F.lane), i16 = (lane >> 3) * 16, c = lane & 7, b = (int)blockIdx.x, x = b & 7, step = (F.G >> 3) * NWAVES;
    const unsigned char* tab = U8S + (size_t)x * NEXP * 128 + 16 * c;
    int t = (b >> 3) * NWAVES + F.wave;
    u32x4 evB0, evB1, xrA0, xrA1, xrB0, xrB1; u32x4 uw[16];
    {   const u32x4 e0 = *(const u32x4*)(EID + (size_t)t * 128 + i16), e1 = *(const u32x4*)(EID + (size_t)t * 128 + i16 + 8);
        xrA0 = *(const u32x4*)(XB + (size_t)t * DM + 128 * x + 16 * c); xrA1 = *(const u32x4*)(XB + (size_t)t * DM + 128 * x + 16 * c + 8);
        const int tn = (t + step < TOK) ? t + step : t;
        evB0 = *(const u32x4*)(EID + (size_t)tn * 128 + i16); evB1 = *(const u32x4*)(EID + (size_t)tn * 128 + i16 + 8);
        xrB0 = *(const u32x4*)(XB + (size_t)tn * DM + 128 * x + 16 * c); xrB1 = *(const u32x4*)(XB + (size_t)tn * DM + 128 * x + 16 * c + 8);
        asm volatile("s_waitcnt vmcnt(0)" : "+v"(evB0), "+v"(evB1), "+v"(xrA0), "+v"(xrA1), "+v"(xrB0), "+v"(xrB1) :: "memory");
#pragma unroll
        for (int w = 0; w < 16; ++w) { const unsigned char* rp = tab + (size_t)PEER_E(e0, e1, w) * 128; GLD16(uw[w], rp); } }
#pragma unroll 1
    for (; t < TOK; t += step) {
        const int tnn = (t + 2 * step < TOK) ? t + 2 * step : t;
        u32x4 evC0, evC1, xrC0, xrC1;
        { const unsigned short* ep = EID + (size_t)tnn * 128 + i16; const bf16_t* xp = XB + (size_t)tnn * DM + 128 * x + 16 * c;
          GLD16(evC0, ep); GLD16(evC1, ep + 8); GLD16(xrC0, xp); GLD16(xrC1, xp + 8); }
        unsigned xq[4];
        { const float sx = row_scale(rsp, rsmode, t) * I8_SX;
#pragma unroll
          for (int k = 0; k < 4; ++k) { const unsigned w = (k < 2 ? xrA0 : xrA1)[2 * (k & 1)], w2 = (k < 2 ? xrA0 : xrA1)[2 * (k & 1) + 1];
              int q0 = __float2int_rn(bf_lo(w) * sx), q1 = __float2int_rn(bf_hi(w) * sx), q2 = __float2int_rn(bf_lo(w2) * sx), q3 = __float2int_rn(bf_hi(w2) * sx);
              q0 = q0 < -127 ? -127 : (q0 > 127 ? 127 : q0); q1 = q1 < -127 ? -127 : (q1 > 127 ? 127 : q1); q2 = q2 < -127 ? -127 : (q2 > 127 ? 127 : q2); q3 = q3 < -127 ? -127 : (q3 > 127 ? 127 : q3);
              xq[k] = ((unsigned)q0 & 0xffu) | (((unsigned)q1 & 0xffu) << 8) | (((unsigned)q2 & 0xffu) << 16) | ((unsigned)q3 << 24); } }
        int r_lo = 0, r_hi = 0;
#pragma unroll
        for (int w = 0; w < 16; ++w) {
            asm volatile("s_waitcnt vmcnt(19)" : "+v"(uw[w]) :: "memory");
            int p = __builtin_amdgcn_sdot4((int)uw[w][0], (int)xq[0], 0, false); int p2 = __builtin_amdgcn_sdot4((int)uw[w][1], (int)xq[1], 0, false);
            p = __builtin_amdgcn_sdot4((int)uw[w][2], (int)xq[2], p, false); p2 = __builtin_amdgcn_sdot4((int)uw[w][3], (int)xq[3], p2, false);
            p += p2;
            p += __builtin_amdgcn_update_dpp(0, p, 0xB1, 0xf, 0xf, true); p += __builtin_amdgcn_update_dpp(0, p, 0x4E, 0xf, 0xf, true); p += __builtin_amdgcn_update_dpp(0, p, 0x141, 0xf, 0xf, true);
            if (w < 8) r_lo = (c == w) ? p : r_lo; else r_hi = (c == (w & 7)) ? p : r_hi;
            { const unsigned char* rp = tab + (size_t)PEER_E(evB0, evB1, w) * 128; GLD16(uw[w], rp); }
            __builtin_amdgcn_sched_barrier(0); }
        { _Float16* dst = (_Float16*)PREP + ((size_t)x * TOK + t) * 128 + i16 + c; dst[0] = (_Float16)((float)r_lo * (1.f / (I8_SU * I8_SX))); dst[8] = (_Float16)((float)r_hi * (1.f / (I8_SU * I8_SX))); }
        asm volatile("s_waitcnt vmcnt(16)" : "+v"(evC0), "+v"(evC1), "+v"(xrC0), "+v"(xrC1) :: "memory");
        evB0 = evC0; evB1 = evC1; xrA0 = xrB0; xrA1 = xrB1; xrB0 = xrC0; xrB1 = xrC1;
    }
    asm volatile("s_waitcnt vmcnt(0)" ::: "memory");
}
__device__ __forceinline__ void phase_peer_c(Frame& F, const float* PREP, const float* rsp, int rsmode, const float* GATE, bf16_t* ACO) {
    const int gw = F.vcu * NWAVES + F.wave, NGW = F.G * NWAVES, lane = opaque_i(F.lane);
    for (int t = gw; t < TOK; t += NGW) {
        float s0 = 0.f, s1 = 0.f;
#pragma unroll
        for (int x = 0; x < 8; ++x) { const _Float16* p = (const _Float16*)PREP + ((size_t)x * TOK + t) * 128; s0 += (float)p[lane]; s1 += (float)p[64 + lane]; }
        const float rsu = 1.f;
        { const _Float16 h0 = (_Float16)(gelu_erf(s0 * rsu) * GATE[(size_t)t * 128 + lane] * (1.f / FP8_SV)), h1 = (_Float16)(gelu_erf(s1 * rsu) * GATE[(size_t)t * 128 + 64 + lane] * (1.f / FP8_SV));
          ACO[(size_t)t * 128 + lane] = __builtin_bit_cast(unsigned short, h0); ACO[(size_t)t * 128 + 64 + lane] = __builtin_bit_cast(unsigned short, h1); }
    }
}
#define PIN16(o_) asm volatile("" : "+v"(o_[0]), "+v"(o_[1]), "+v"(o_[2]), "+v"(o_[3]), "+v"(o_[4]), "+v"(o_[5]), "+v"(o_[6]), "+v"(o_[7]), "+v"(o_[8]), "+v"(o_[9]), "+v"(o_[10]), "+v"(o_[11]), "+v"(o_[12]), "+v"(o_[13]), "+v"(o_[14]), "+v"(o_[15]))
__device__ __forceinline__ void phase_peer_v(Frame& F, bf16_t* XB, const unsigned short* EID, const bf16_t* ACO, const unsigned char* V8S, float* SSQP) {
    const int lane = opaque_i(F.lane), i16 = (lane >> 3) * 16, c = lane & 7, b = (int)blockIdx.x, x = b & 7, step = (F.G >> 3) * NWAVES;
    const unsigned char* tab = V8S + (size_t)x * NEXP * 128 + 16 * c;
    const bool b5 = lane & 32, b4 = lane & 16, b3 = lane & 8;
    const int col = 128 * x + 16 * c + (b5 ? 8 : 0) + (b4 ? 4 : 0) + (b3 ? 2 : 0);
    int t = (b >> 3) * NWAVES + F.wave;
    u32x4 evB0, evB1, aA0, aA1, vw[16]; unsigned xfA;
    {   const u32x4 e0 = *(const u32x4*)(EID + (size_t)t * 128 + i16), e1 = *(const u32x4*)(EID + (size_t)t * 128 + i16 + 8);
        aA0 = *(const u32x4*)(ACO + (size_t)t * 128 + i16); aA1 = *(const u32x4*)(ACO + (size_t)t * 128 + i16 + 8);
        xfA = *(const unsigned*)(XB + (size_t)t * DM + col);
        const int tn = (t + step < TOK) ? t + step : t;
        evB0 = *(const u32x4*)(EID + (size_t)tn * 128 + i16); evB1 = *(const u32x4*)(EID + (size_t)tn * 128 + i16 + 8);
#pragma unroll
        for (int w = 0; w < 16; ++w) vw[w] = *(const u32x4*)(tab + (size_t)PEER_E(e0, e1, w) * 128); }
#pragma unroll 1
    for (; t < TOK; t += step) {
        const int tn = (t + step < TOK) ? t + step : t, tnn = (t + 2 * step < TOK) ? t + 2 * step : t;
        const u32x4 evC0 = *(const u32x4*)(EID + (size_t)tnn * 128 + i16), evC1 = *(const u32x4*)(EID + (size_t)tnn * 128 + i16 + 8);
        const u32x4 aB0 = *(const u32x4*)(ACO + (size_t)tn * 128 + i16), aB1 = *(const u32x4*)(ACO + (size_t)tn * 128 + i16 + 8);
        const unsigned xfB = *(const unsigned*)(XB + (size_t)tn * DM + col);
        float o[16];
#pragma unroll
        for (int k = 0; k < 16; ++k) o[k] = 0.f;
#pragma unroll
        for (int w = 0; w < 16; w += 2) { const unsigned aw = (w < 8 ? aA0 : aA1)[(w & 7) >> 1]; const h16x2 a2 = __builtin_bit_cast(h16x2, aw);
#pragma unroll
            for (int k = 0; k < 4; ++k) { const unsigned r0 = vw[w][k], r1 = vw[w + 1][k];
                o[4 * k]     = __builtin_amdgcn_fdot2(__builtin_bit_cast(h16x2, __builtin_amdgcn_perm(r1, r0, 0x040c000cu)), a2, o[4 * k], false);
                o[4 * k + 1] = __builtin_amdgcn_fdot2(__builtin_bit_cast(h16x2, __builtin_amdgcn_perm(r1, r0, 0x050c010cu)), a2, o[4 * k + 1], false);
                o[4 * k + 2] = __builtin_amdgcn_fdot2(__builtin_bit_cast(h16x2, __builtin_amdgcn_perm(r1, r0, 0x060c020cu)), a2, o[4 * k + 2], false);
                o[4 * k + 3] = __builtin_amdgcn_fdot2(__builtin_bit_cast(h16x2, __builtin_amdgcn_perm(r1, r0, 0x070c030cu)), a2, o[4 * k + 3], false); }
            PIN16(o);
            vw[w] = *(const u32x4*)(tab + (size_t)PEER_E(evB0, evB1, w) * 128); vw[w + 1] = *(const u32x4*)(tab + (size_t)PEER_E(evB0, evB1, w + 1) * 128);
            __builtin_amdgcn_sched_barrier(0); }
        float h8[8], h4[4], h2[2];
#pragma unroll
        for (int k = 0; k < 8; ++k) { const auto r = __builtin_amdgcn_permlane32_swap(__float_as_uint(o[k]), __float_as_uint(o[8 + k]), false, false); h8[k] = __uint_as_float(r[0]) + __uint_as_float(r[1]); }
#pragma unroll
        for (int k = 0; k < 4; ++k) { const auto r = __builtin_amdgcn_permlane16_swap(__float_as_uint(h8[k]), __float_as_uint(h8[4 + k]), false, false); h4[k] = __uint_as_float(r[0]) + __uint_as_float(r[1]); }
#pragma unroll
        for (int k = 0; k < 2; ++k) { const float keep = b3 ? h4[2 + k] : h4[k], send = b3 ? h4[k] : h4[2 + k];
            h2[k] = keep + __builtin_bit_cast(float, __builtin_amdgcn_update_dpp(0, __builtin_bit_cast(int, send), 0x128, 0xf, 0xf, true)); }
        f32x2 f = {bf_lo(xfA) + h2[0], bf_hi(xfA) + h2[1]};
        *(unsigned*)(XB + (size_t)t * DM + col) = pk2(f.x, f.y);
        const float ss = wave_total(f.x * f.x + f.y * f.y);
        if (lane == 0) { SSQP[(size_t)t * 16 + x] = ss; SSQP[(size_t)t * 16 + 8 + x] = 0.f; }
        aA0 = aB0; aA1 = aB1; evB0 = evC0; evB1 = evC1; xfA = xfB;
    }
}
__device__ __forceinline__ void phase_final_norm(Frame& F, const bf16_t* XB, float* OUT, const float* SSQP, const float* norm_f) {
    const int gw = F.vcu * NWAVES + F.wave, NGW = F.G * NWAVES, lane = opaque_i(F.lane);
    for (int t = gw; t < TOK; t += NGW) { const float r = row_scale(SSQP, 1, t);
#pragma unroll
        for (int j = 0; j < 4; ++j) { const u32x2 w = *(const u32x2*)(XB + (size_t)t * DM + 256 * j + 4 * lane); const f32x4 x = {bf_lo(w.x), bf_hi(w.x), bf_lo(w.y), bf_hi(w.y)};
            *(f32x4*)(OUT + (size_t)t * DM + 256 * j + 4 * lane) = x * r * *(const f32x4*)(norm_f + 256 * j + 4 * lane); } }
}

constexpr int N_PHASES = 20;
struct Args { const float* in[16]; float* out; unsigned char* ws; int ph_lo, ph_hi; };
template <bool COOP>
__global__ void __launch_bounds__(NWAVES * 64, 2) mk_fwd(Args args) {
    extern __shared__ __attribute__((aligned(16))) unsigned char lds[];
    Frame F;
    F.lds = (LAS unsigned char*)lds;
    F.tid = threadIdx.x; F.lane = F.tid & 63; F.wave = __builtin_amdgcn_readfirstlane(F.tid >> 6);
    F.G = gridDim.x; { const int bx = blockIdx.x; F.vcu = (F.G % 8 == 0) ? (bx % 8) * (F.G / 8) + bx / 8 : bx; }
    Ptrs P;
    P.x = args.in[0]; P.norm_mix = args.in[1]; P.norm_ffn = args.in[2]; P.ev_w_in = args.in[3]; P.ev_b_f = args.in[4]; P.ev_w_out = args.in[5]; P.od_w_in = args.in[6];
    P.od_pool_w = args.in[7]; P.od_pool_scale = args.in[8]; P.od_w_out = args.in[9]; P.peer_wq = args.in[10]; P.peer_k1 = args.in[11]; P.peer_k2 = args.in[12];
    P.peer_u = args.in[13]; P.peer_v = args.in[14]; P.norm_f = args.in[15]; P.out = args.out; P.ws = args.ws;
    unsigned char* ws = args.ws;
    bf16_t* XB = (bf16_t*)(ws + WS_XB); bf16_t* AO = (bf16_t*)(ws + WS_AO); bf16_t* QP = (bf16_t*)(ws + WS_QP);
    unsigned short* EID = (unsigned short*)(ws + WS_EID); float* GATE = (float*)(ws + WS_GATE);
    float* RS0 = (float*)(ws + WS_RS0); float* SSQ2 = (float*)(ws + WS_SSQ2); float* PREP = (float*)(ws + WS_PREP); bf16_t* ACO = (bf16_t*)(ws + WS_ACO); float* SSQ1 = (float*)(ws + WS_SSQ1); float* SSQ3 = (float*)(ws + WS_SSQ3);
    const int lo = args.ph_lo, hi = args.ph_hi;
    volatile LAS unsigned* xbst = (volatile LAS unsigned*)(F.lds + RING_BYTES + 1024);
    if (F.tid < 4) xbst[F.tid] = 0u;
    __syncthreads();
    XcdBarrier xbar; xbar.bar = (unsigned*)(ws + WS_CTL) + 4096; xbar.x = 0; xbar.st = xbst;
    if (COOP) xbar = xcd_barrier_post((unsigned*)(ws + WS_CTL) + 4096, xbst);
#define IN(k) (lo <= (k) && (k) < hi)
#define SEAM(k) do { if (COOP && IN(k) && IN((k) + 1)) { if ((k) == 0) cg::this_grid().sync(); else xcd_barrier(xbar); } } while (0)
    if (IN(0)) { phase_p0(F, P); } SEAM(0);
    if (IN(1)) {
        pg8::Gemm g{XB, (const bf16_t*)(ws + WS_W1T), TOK, EVEN_PAD, DM}; pg8::StaticOrder S; S.init(TOK, EVEN_PAD, F.G, (int)blockIdx.x);
        EpiL0In E{RS0, (bf16_t*)(ws + WS_QH), (bf16_t*)(ws + WS_KH), (bf16_t*)(ws + WS_VT), (float*)(ws + WS_LF), P.ev_b_f};
        pg8::gemm_phase<EpiL0In, pg8::StaticOrder, true, true>(F.lds, g, S, E);
    } SEAM(1);
    if (IN(2)) { phase_cfscan(F, (const float*)(ws + WS_LF), (float*)(ws + WS_CF)); } SEAM(2);
    if (IN(3)) {
        phase_attn_fox(F, (const bf16_t*)(ws + WS_QH), (const bf16_t*)(ws + WS_KH), (const bf16_t*)(ws + WS_VT), (const float*)(ws + WS_CF), AO);
        phase_attn<1>(F, (const bf16_t*)(ws + WS_QH), (const bf16_t*)(ws + WS_KH), (const bf16_t*)(ws + WS_VT), 16, 8, nullptr, nullptr, AO, 512);
    } SEAM(3);
    if (IN(4)) {
        pg8::Gemm g{AO, (const bf16_t*)(ws + WS_W2T), TOK, DM, DM}; pg8::StaticOrder S; S.init(TOK, DM, F.G, (int)blockIdx.x);
        EpiRes<false> E{P.x, XB, SSQ1};
        pg8::gemm_phase<EpiRes<false>, pg8::StaticOrder, true, true>(F.lds, g, S, E);
    } SEAM(4);
    if (IN(5)) {
        pg8::Gemm g{XB, (const bf16_t*)(ws + WS_W3T), TOK, 2048, DM}; pg8::StaticOrder S; S.init(TOK, 2048, F.G, (int)blockIdx.x);
        EpiQ E{SSQ1, 1, QP};
        pg8::gemm_phase<EpiQ, pg8::StaticOrder, true, true>(F.lds, g, S, E);
    } SEAM(5);
    if (IN(6)) { phase_topk(F, QP, (const bf16_t*)(ws + WS_K1B), (const bf16_t*)(ws + WS_K2B), EID, GATE); } SEAM(6);
    if (IN(7)) { phase_peer_u(F, XB, SSQ1, 1, EID, ws + WS_U8S, PREP); } SEAM(7);
    if (IN(8)) { phase_peer_c(F, PREP, SSQ1, 1, GATE, ACO); } SEAM(8);
    if (IN(9)) { phase_peer_v(F, XB, EID, ACO, ws + WS_V8S, SSQ2); } SEAM(9);
    if (IN(10)) {
        pg8::Gemm g{XB, (const bf16_t*)(ws + WS_W4T), TOK, 2048, DM}; pg8::StaticOrder S; S.init(TOK, 2048, F.G, (int)blockIdx.x);
        EpiL1In E{SSQ2, 1, (bf16_t*)(ws + WS_QH), (bf16_t*)(ws + WS_QH + 32 * MiB), (bf16_t*)(ws + WS_KH), (bf16_t*)(ws + WS_KH + 32 * MiB)};
        pg8::gemm_phase<EpiL1In, pg8::StaticOrder, true, true>(F.lds, g, S, E);
    } SEAM(10);
    if (IN(11)) {
        phase_pool(F, (const bf16_t*)(ws + WS_QH), (const bf16_t*)(ws + WS_PWT), P.od_pool_scale, AO);
        phase_kmean(F, (const bf16_t*)(ws + WS_KH), (float*)(ws + WS_KMEAN));
    } SEAM(11);
    if (IN(12)) {
        phase_attn_moba(F, (const bf16_t*)(ws + WS_QH + 32 * MiB), (const bf16_t*)(ws + WS_KH), (const bf16_t*)(ws + WS_KH + 32 * MiB), (const float*)(ws + WS_KMEAN), AO);
    } SEAM(12);
    if (IN(13)) {
        pg8::Gemm g{AO, (const bf16_t*)(ws + WS_W5T), TOK, DM, DM}; pg8::StaticOrder S; S.init(TOK, DM, F.G, (int)blockIdx.x);
        EpiRes<true> E{XB, XB, SSQ3};
        pg8::gemm_phase<EpiRes<true>, pg8::StaticOrder, true, true>(F.lds, g, S, E);
    } SEAM(13);
    if (IN(14)) {
        pg8::Gemm g{XB, (const bf16_t*)(ws + WS_W6T), TOK, 2048, DM}; pg8::StaticOrder S; S.init(TOK, 2048, F.G, (int)blockIdx.x);
        EpiQ E{SSQ3, 1, QP};
        pg8::gemm_phase<EpiQ, pg8::StaticOrder, true, true>(F.lds, g, S, E);
    } SEAM(14);
    if (IN(15)) { phase_topk(F, QP, (const bf16_t*)(ws + WS_K1B) + 8 * 128 * 128, (const bf16_t*)(ws + WS_K2B) + 8 * 128 * 128, EID, GATE); } SEAM(15);
    if (IN(16)) { phase_peer_u(F, XB, SSQ3, 1, EID, ws + WS_U8S + (size_t)8 * NEXP * 128, PREP); } SEAM(16);
    if (IN(17)) { phase_peer_c(F, PREP, SSQ3, 1, GATE, ACO); } SEAM(17);
    if (IN(18)) { phase_peer_v(F, XB, EID, ACO, ws + WS_V8S + (size_t)8 * NEXP * 128, SSQ2); } SEAM(18);
    if (IN(19)) { phase_final_norm(F, XB, P.out, SSQ2, P.norm_f); }
#undef IN
#undef SEAM
}

extern "C" void kernel_launch(void* const* d_in, const int* in_sizes, int n_in, void* d_out, int out_size, void* d_ws, size_t ws_size, hipStream_t stream) {
    static int grid = 0;
    constexpr bool COOP = (MK_MULTI == 0);
    if (grid == 0) {
        if (n_in != 16 || in_sizes[0] != TOK * DM || out_size != TOK * DM || ws_size < WS_END) { fprintf(stderr, "kernel_launch: unexpected shapes (n_in %d, in0 %d, out %d, ws %zu)\n", n_in, n_in > 0 ? in_sizes[0] : -1, out_size, ws_size); grid = -1; return; }
        int dev = 0, cus = 0, per_cu = 0;
        if (hipGetDevice(&dev) != hipSuccess || hipDeviceGetAttribute(&cus, hipDeviceAttributeMultiprocessorCount, dev) != hipSuccess) { grid = -1; return; }
        if (hipFuncSetAttribute((const void*)mk_fwd<COOP>, hipFuncAttributeMaxDynamicSharedMemorySize, LDS_BYTES) != hipSuccess) { fprintf(stderr, "kernel_launch: hipFuncSetAttribute failed\n"); grid = -1; return; }
        if (hipOccupancyMaxActiveBlocksPerMultiprocessor(&per_cu, (const void*)mk_fwd<COOP>, NWAVES * 64, LDS_BYTES) != hipSuccess || per_cu < 1) { fprintf(stderr, "kernel_launch: occupancy query says %d\n", per_cu); per_cu = 1; }
        (void)hipGetLastError();
        grid = cus;
    }
    if (grid < 0) return;
    if (hipMemsetAsync((char*)d_ws + WS_CTL, 0, CTL_ZERO_BYTES, stream) != hipSuccess) { fprintf(stderr, "kernel_launch: memset failed\n"); return; }
    Args a{};
    for (int i = 0; i < 16; ++i) a.in[i] = (const float*)d_in[i];
    a.out = (float*)d_out; a.ws = (unsigned char*)d_ws;
    if (COOP) {
        a.ph_lo = 0; a.ph_hi = N_PHASES;
        void* kargs[] = {&a};
        const hipError_t e = hipLaunchCooperativeKernel((const void*)mk_fwd<COOP>, dim3(grid), dim3(NWAVES * 64), kargs, LDS_BYTES, stream);
        if (e != hipSuccess) fprintf(stderr, "kernel_launch: cooperative launch failed: %s (grid %d)\n", hipGetErrorString(e), grid);
    } else {
        for (int p = 0; p < N_PHASES; ++p) { a.ph_lo = p; a.ph_hi = p + 1; hipLaunchKernelGGL(mk_fwd<COOP>, dim3(grid), dim3(NWAVES * 64), LDS_BYTES, stream, a); }
    }
}
```

```cpp
#include <hip/hip_runtime.h>
#include <hip/hip_cooperative_groups.h>
#include <cstdio>
#include <cstdint>
#include <cmath>
namespace cg = cooperative_groups;

#ifndef MK_MULTI
#define MK_MULTI 0
#endif

namespace pg8 {
#define PG8_LAS __attribute__((address_space(3)))
typedef unsigned short bf16_t;
typedef short bf16x8 __attribute__((ext_vector_type(8)));
typedef float f32x4 __attribute__((ext_vector_type(4)));
typedef unsigned u32x4 __attribute__((ext_vector_type(4)));
constexpr int BM = 256, BK = 64, HALF = 128, HTB = HALF * BK * 2  , STAGE_BYTES = 8 * HTB, NXCD = 8, WGM = 8;

__host__ __device__ __forceinline__ int lds_byte(int r, int c) { const int st = (r >> 4) * 2 + (c >> 5), rr = r & 15, cc = c & 31, ob = rr * 64 + cc * 2; return st * 1024 + (ob ^ (((ob >> 9) & 1) << 5)); }
__host__ __device__ __forceinline__ void stage_rc(int b, int& R, int& C) { const int st = b / 1024, sb = b % 1024, swz = sb ^ (((sb >> 9) & 1) << 5); R = (st >> 1) * 16 + swz / 64; C = (st & 1) * 32 + (swz % 64) / 2; }
__host__ __device__ __forceinline__ int perm32(int rho) { const int n = rho >> 4, i = rho & 15; return 8 * (i >> 2) + 4 * n + (i & 3); }

struct Unit { int pm, pn; };
struct Gemm { const bf16_t* A; const bf16_t* Bt; int M, N, K; };

struct StaticOrder {
    int nM, nN, nwg, G, c;
    __host__ __device__ void init(int M, int N, int G_, int c_) { nM = M / BM; nN = N / BM; nwg = nM * nN; G = G_; c = c_; }
    __host__ __device__ bool next(int i, Unit& u) const {
        const long L = (long)i * G + c; if (L >= nwg) return false;
        int wgid = (int)L; { const int q = nwg / NXCD, r = nwg % NXCD, xcd = wgid % NXCD, off = wgid / NXCD; wgid = (xcd < r ? xcd * (q + 1) : r * (q + 1) + (xcd - r) * q) + off; }
        const int nig = WGM * nN, gid = wgid / nig, fm = gid * WGM, gsz = (nM - fm) < WGM ? (nM - fm) : WGM;
        u.pm = fm + ((wgid % nig) % gsz); u.pn = (wgid % nig) / gsz; return true;
    }
    __device__ __forceinline__ void a_ready(const Unit&) const {}
    __device__ __forceinline__ void done(const Unit&) const {}
};
__device__ __forceinline__ unsigned cvt_pk_bf16(float lo, float hi) { unsigned r; asm volatile("v_cvt_pk_bf16_f32 %0, %1, %2" : "=v"(r) : "v"(lo), "v"(hi)); return r; }
template <class Epi, class Sched, bool ALIGN_EPI = false, bool SP2 = false>
__device__ __forceinline__ void gemm_phase(PG8_LAS unsigned char* lds, const Gemm g, const Sched& S, const Epi& E) {
    const int tid = threadIdx.x, wid = __builtin_amdgcn_readfirstlane(tid >> 6), lane = tid & 63, wr = wid >> 2, wc = wid & 3, fr = lane & 15, fq = lane >> 4;
    const int K = g.K, nt = K / BK;
    unsigned voffA[2], voffB[2];
#pragma unroll
    for (int i = 0; i < 2; ++i) { int R, C; stage_rc(tid * 16 + i * 8192, R, C); const int Rb = Epi::PERM ? ((R & ~31) + perm32(R & 31)) : R;
        voffA[i] = (unsigned)(R * K + C) * 2u; voffB[i] = (unsigned)(Rb * K + C) * 2u; }
    const size_t kstep = (size_t)(BK * 2);
    const size_t hstep = (size_t)HALF * K * 2;
    const size_t tstep = 2 * hstep;
    const unsigned ldsw = (unsigned)wid * 1024u;
    const int aoff = lds_byte(wr * 64 + fr, fq * 8), boff = lds_byte(wc * 32 + fr, fq * 8);
#define PG8_SA(b, h) (((b) * 2 + (h)) * HTB)
#define PG8_SB(b, h) ((4 + (b) * 2 + (h)) * HTB)
#define PG8_STAGE(bufoff, gbase, voff) do { _Pragma("unroll") for (int _i = 0; _i < 2; ++_i) \
        __builtin_amdgcn_global_load_lds((const unsigned*)((const char*)(gbase) + (voff)[_i]), (PG8_LAS unsigned*)(lds + (bufoff) + ldsw + _i * 8192), 16, 0, 0); } while (0)
#define PG8_LDA(dst, b, h) do { _Pragma("unroll") for (int m = 0; m < 4; ++m) _Pragma("unroll") for (int k = 0; k < 2; ++k) dst[m][k] = *(const PG8_LAS bf16x8*)(lds + PG8_SA(b, h) + aoff + m * 2048 + k * 1024); } while (0)
#define PG8_LDB(dst, b, h) do { _Pragma("unroll") for (int n = 0; n < 2; ++n) _Pragma("unroll") for (int k = 0; k < 2; ++k) dst[n][k] = *(const PG8_LAS bf16x8*)(lds + PG8_SB(b, h) + boff + n * 2048 + k * 1024); } while (0)
#define PG8_MMA(ai, bj, At, Bt) do { __builtin_amdgcn_s_setprio(1); _Pragma("unroll") for (int m = 0; m < 4; ++m) _Pragma("unroll") for (int n = 0; n < 2; ++n) _Pragma("unroll") for (int k = 0; k < 2; ++k) \
        acc[ai][bj][m][n] = __builtin_amdgcn_mfma_f32_16x16x32_bf16(Bt[n][k], At[m][k], acc[ai][bj][m][n], 0, 0, 0); __builtin_amdgcn_s_setprio(0); } while (0)
#define PG8_WAIT_V(n) asm volatile("s_waitcnt vmcnt(" #n ")" ::: "memory")
#define PG8_WAIT_L(n) asm volatile("s_waitcnt lgkmcnt(" #n ")" ::: "memory")
#define PG8_BAR __builtin_amdgcn_s_barrier()
#define PG8_SCHED __builtin_amdgcn_sched_barrier(0)
    Unit cur, nxt; int ui = 0;
    if (!S.next(0, cur)) return;
    f32x4 acc[2][2][4][2];
#pragma unroll
    for (int a = 0; a < 2; ++a)
#pragma unroll
        for (int b = 0; b < 2; ++b)
#pragma unroll
            for (int m = 0; m < 4; ++m)
#pragma unroll
                for (int n = 0; n < 2; ++n) acc[a][b][m][n] = (f32x4){0.f, 0.f, 0.f, 0.f};
    bf16x8 At[4][2], B0[2][2], B1[2][2];
    const char* cA = (const char*)g.A + (size_t)cur.pm * tstep; const char* cB = (const char*)g.Bt + (size_t)cur.pn * tstep;
    S.a_ready(cur);
    if constexpr (SP2) {
        PG8_STAGE(PG8_SB(0, 0), cB, voffB); PG8_STAGE(PG8_SB(0, 1), cB + hstep, voffB); PG8_STAGE(PG8_SA(0, 0), cA, voffA); PG8_STAGE(PG8_SA(0, 1), cA + hstep, voffA);
        if (wr == 1) PG8_BAR;
        PG8_WAIT_V(2); PG8_BAR;
        PG8_STAGE(PG8_SB(1, 0), cB + kstep, voffB); PG8_STAGE(PG8_SA(1, 0), cA + kstep, voffA); PG8_STAGE(PG8_SB(1, 1), cB + hstep + kstep, voffB);
        PG8_WAIT_V(6); PG8_BAR;
    } else {
        PG8_STAGE(PG8_SB(0, 0), cB, voffB); PG8_STAGE(PG8_SA(0, 0), cA, voffA); PG8_STAGE(PG8_SB(0, 1), cB + hstep, voffB); PG8_STAGE(PG8_SA(0, 1), cA + hstep, voffA);
        if (wr == 1) PG8_BAR;
        PG8_WAIT_V(4); PG8_BAR;
        PG8_STAGE(PG8_SB(1, 0), cB + kstep, voffB); PG8_STAGE(PG8_SA(1, 0), cA + kstep, voffA); PG8_STAGE(PG8_SB(1, 1), cB + hstep + kstep, voffB);
        PG8_WAIT_V(6); PG8_BAR;
    }
    for (;;) {
        const bool has_next = S.next(ui + 1, nxt);
        const char* nA = has_next ? (const char*)g.A + (size_t)nxt.pm * tstep : cA; const char* nB = has_next ? (const char*)g.Bt + (size_t)nxt.pn * tstep : cB;
        for (int t = 0; t < nt; t += 2) {
            const bool last = (t == nt - 2);
            const char* a1 = cA + (size_t)(t + 1) * kstep;
            const char* a2 = last ? nA : cA + (size_t)(t + 2) * kstep; const char* b2 = last ? nB : cB + (size_t)(t + 2) * kstep;
            const char* a3 = a2 + kstep; const char* b3 = b2 + kstep;
            if (last && has_next) S.a_ready(nxt);
            if constexpr (SP2) {
            PG8_LDB(B0, 0, 0); PG8_LDB(B1, 0, 1); PG8_SCHED; PG8_LDA(At, 0, 0); PG8_STAGE(PG8_SA(1, 1), a1 + hstep, voffA);
            PG8_WAIT_V(8); PG8_WAIT_L(0); PG8_BAR; PG8_MMA(0, 0, At, B0); PG8_MMA(0, 1, At, B1); PG8_BAR; PG8_SCHED;
            PG8_LDA(At, 0, 1); PG8_STAGE(PG8_SB(0, 0), b2, voffB); PG8_STAGE(PG8_SB(0, 1), b2 + hstep, voffB); PG8_STAGE(PG8_SA(0, 0), a2, voffA);
            PG8_WAIT_V(8); PG8_WAIT_L(0); PG8_BAR; PG8_MMA(1, 0, At, B0); PG8_MMA(1, 1, At, B1); PG8_BAR; PG8_SCHED;
            PG8_LDB(B0, 1, 0); PG8_LDB(B1, 1, 1); PG8_SCHED; PG8_LDA(At, 1, 0); PG8_STAGE(PG8_SA(0, 1), a2 + hstep, voffA);
            PG8_WAIT_V(8); PG8_WAIT_L(0); PG8_BAR; PG8_MMA(0, 0, At, B0); PG8_MMA(0, 1, At, B1); PG8_BAR; PG8_SCHED;
            PG8_LDA(At, 1, 1); PG8_STAGE(PG8_SB(1, 0), b3, voffB); PG8_STAGE(PG8_SB(1, 1), b3 + hstep, voffB); PG8_STAGE(PG8_SA(1, 0), a3, voffA);
            PG8_WAIT_V(8); PG8_WAIT_L(0); PG8_BAR; PG8_MMA(1, 0, At, B0); PG8_MMA(1, 1, At, B1); PG8_BAR; PG8_SCHED;
            } else {
            PG8_LDB(B0, 0, 0); PG8_SCHED; PG8_LDA(At, 0, 0); PG8_STAGE(PG8_SA(1, 1), a1 + hstep, voffA);
            PG8_WAIT_L(8); PG8_BAR; PG8_WAIT_L(0); PG8_MMA(0, 0, At, B0); PG8_BAR; PG8_SCHED;
            PG8_LDB(B1, 0, 1); PG8_STAGE(PG8_SB(0, 0), b2, voffB);
            PG8_BAR; PG8_WAIT_L(0); PG8_MMA(0, 1, At, B1); PG8_BAR;
            PG8_LDA(At, 0, 1); PG8_STAGE(PG8_SA(0, 0), a2, voffA);
            PG8_BAR; PG8_WAIT_L(0); PG8_MMA(1, 0, At, B0); PG8_BAR; PG8_SCHED;
            PG8_STAGE(PG8_SB(0, 1), b2 + hstep, voffB);
            PG8_WAIT_V(6); PG8_BAR; PG8_MMA(1, 1, At, B1); PG8_BAR;
            PG8_LDB(B0, 1, 0); PG8_SCHED; PG8_LDA(At, 1, 0); PG8_STAGE(PG8_SA(0, 1), a2 + hstep, voffA);
            PG8_WAIT_L(8); PG8_BAR; PG8_WAIT_L(0); PG8_MMA(0, 0, At, B0); PG8_BAR; PG8_SCHED;
            PG8_LDB(B1, 1, 1); PG8_STAGE(PG8_SB(1, 0), b3, voffB);
            PG8_BAR; PG8_WAIT_L(0); PG8_MMA(0, 1, At, B1); PG8_BAR;
            PG8_LDA(At, 1, 1); PG8_STAGE(PG8_SA(1, 0), a3, voffA);
            PG8_BAR; PG8_WAIT_L(0); PG8_MMA(1, 0, At, B0); PG8_BAR; PG8_SCHED;
            PG8_STAGE(PG8_SB(1, 1), b3 + hstep, voffB);
            PG8_WAIT_V(6); PG8_BAR; PG8_MMA(1, 1, At, B1); PG8_BAR;
            }
        }
        if constexpr (ALIGN_EPI) { if (wr == 0) PG8_BAR; }
        if constexpr (!Epi::AFTER_DRAIN) { E(acc, cur, wr, wc, fr, fq); S.done(cur); }
        if (!has_next) break;
#pragma unroll
        for (int a = 0; a < 2; ++a)
#pragma unroll
            for (int b = 0; b < 2; ++b)
#pragma unroll
                for (int m = 0; m < 4; ++m)
#pragma unroll
                    for (int n = 0; n < 2; ++n) acc[a][b][m][n] = (f32x4){0.f, 0.f, 0.f, 0.f};
        cur = nxt; cA = nA; cB = nB; ++ui;
        if constexpr (ALIGN_EPI) { if (wr == 1) PG8_BAR; }
    }
    PG8_WAIT_V(0);
    if constexpr (!ALIGN_EPI) { if (wr == 0) PG8_BAR; }
    PG8_BAR;
    if constexpr (Epi::AFTER_DRAIN) { E.fused(acc, cur, wr, wc, fr, fq, lds, wid, lane); S.done(cur); }
#undef PG8_SA
#undef PG8_SB
#undef PG8_STAGE
#undef PG8_LDA
#undef PG8_LDB
#undef PG8_MMA
#undef PG8_WAIT_V
#undef PG8_WAIT_L
#undef PG8_BAR
#undef PG8_SCHED
}
}

constexpr int NB = 16, SEQ = 2048, DM = 1024, TOK = NB * SEQ;
constexpr int EVEN_IN = 3080, EVEN_PAD = 3328;
constexpr int NEXP = 16384;
constexpr float RMS_EPS = 1e-6f;
constexpr float LOG2E = 1.4426950408889634f;
constexpr float C2 = 0.125f * LOG2E;

constexpr size_t MiB = 1u << 20;
constexpr size_t WS_CTL = 0, CTL_ZERO_BYTES = 1 * MiB;
constexpr size_t WS_W1T = 1 * MiB;
constexpr size_t WS_W2T = 8 * MiB;
constexpr size_t WS_W4T = 10 * MiB;
constexpr size_t WS_W5T = 14 * MiB;
constexpr size_t WS_W3T = 16 * MiB;
constexpr size_t WS_W6T = 20 * MiB;
constexpr size_t WS_K1B = 24 * MiB;
constexpr size_t WS_K2B = 24 * MiB + 512 * 1024;
constexpr size_t WS_PWT = 25 * MiB;
constexpr size_t WS_LF  = 25 * MiB + 256 * 1024;
constexpr size_t WS_CF  = 26 * MiB + 256 * 1024;
constexpr size_t WS_KMEAN = 27 * MiB + 256 * 1024;
constexpr size_t WS_RS0 = 27 * MiB + 512 * 1024;
constexpr size_t WS_RS2 = 27 * MiB + 640 * 1024;
constexpr size_t WS_SSQ1 = 28 * MiB;
constexpr size_t WS_SSQ3 = 30 * MiB;
constexpr size_t WS_U8S = 32 * MiB;
constexpr size_t WS_V8S = 64 * MiB;
constexpr size_t WS_XB = 160 * MiB;
constexpr size_t WS_QH = 224 * MiB;
constexpr size_t WS_KH = 288 * MiB;
constexpr size_t WS_VT = 352 * MiB;
constexpr size_t WS_QP = 224 * MiB;
constexpr size_t WS_AO = 416 * MiB;
constexpr size_t WS_EID = 480 * MiB;
constexpr size_t WS_GATE = 488 * MiB;
constexpr size_t WS_SSQ2 = 504 * MiB;
constexpr size_t WS_PREP = 224 * MiB;
constexpr size_t WS_ACO = 416 * MiB;
constexpr size_t WS_END = 506 * MiB;

constexpr int RING_BYTES = 131072;
constexpr int LDS_BYTES = 147456;
constexpr int NWAVES = 8;

#define GAS __attribute__((address_space(1)))
#define LAS __attribute__((address_space(3)))
typedef unsigned short bf16_t;
typedef unsigned u32x4 __attribute__((ext_vector_type(4)));
typedef unsigned u32x2 __attribute__((ext_vector_type(2)));
typedef float f32x4 __attribute__((ext_vector_type(4)));
typedef float f32x16 __attribute__((ext_vector_type(16)));
typedef short bf16x8 __attribute__((ext_vector_type(8)));
typedef __bf16 bf16x2 __attribute__((ext_vector_type(2)));
#define LDS_WAIT() asm volatile("s_waitcnt lgkmcnt(0)" ::: "memory")

__device__ __forceinline__ int opaque_i(int v) { asm volatile("" : "+v"(v)); return v; }
__device__ __forceinline__ unsigned f2bf(float f) { unsigned u = __builtin_bit_cast(unsigned, f); return (u + 0x7fffu + ((u >> 16) & 1u)) >> 16; }
typedef float f32x2_pk __attribute__((ext_vector_type(2)));
__device__ __forceinline__ unsigned pk2(float lo, float hi) { const f32x2_pk v = {lo, hi}; return __builtin_bit_cast(unsigned, __builtin_convertvector(v, bf16x2)); }
__device__ __forceinline__ float bf_lo(unsigned u) { return __uint_as_float(u << 16); }
__device__ __forceinline__ float bf_hi(unsigned u) { return __uint_as_float(u & 0xffff0000u); }
__device__ __forceinline__ float dot2(unsigned a, unsigned b, float acc) { return __builtin_amdgcn_fdot2_f32_bf16(__builtin_bit_cast(bf16x2, a), __builtin_bit_cast(bf16x2, b), acc, false); }
__device__ __forceinline__ float dot8(u32x4 a, u32x4 b, float acc) { acc = dot2(a.x, b.x, acc); acc = dot2(a.y, b.y, acc); acc = dot2(a.z, b.z, acc); return dot2(a.w, b.w, acc); }
__device__ __forceinline__ u32x4 pack8(f32x4 a, f32x4 b) { u32x4 w; w.x = pk2(a[0], a[1]); w.y = pk2(a[2], a[3]); w.z = pk2(b[0], b[1]); w.w = pk2(b[2], b[3]); return w; }

__device__ __forceinline__ float wave_sum(float v) {
#pragma unroll
    for (int o = 1; o < 64; o <<= 1) v += __shfl_xor(v, o);
    return v;
}
__device__ __forceinline__ float wave_max(float v) {
#pragma unroll
    for (int o = 1; o < 64; o <<= 1) v = fmaxf(v, __shfl_xor(v, o));
    return v;
}
__device__ __forceinline__ unsigned wave_umax(unsigned v) {
#pragma unroll
    for (int o = 1; o < 64; o <<= 1) { const unsigned w = (unsigned)__shfl_xor((int)v, o); v = v > w ? v : w; }
    return v;
}
__device__ __forceinline__ float dpp_row_shr(float v, int n) {
    const int iv = __builtin_bit_cast(int, v); int r;
    switch (n) { case 1: r = __builtin_amdgcn_update_dpp(0, iv, 0x111, 0xf, 0xf, true); break; case 2: r = __builtin_amdgcn_update_dpp(0, iv, 0x112, 0xf, 0xf, true); break;
                 case 4: r = __builtin_amdgcn_update_dpp(0, iv, 0x114, 0xf, 0xf, true); break; default: r = __builtin_amdgcn_update_dpp(0, iv, 0x118, 0xf, 0xf, true); break; }
    return __builtin_bit_cast(float, r);
}
__device__ __forceinline__ float wave_total(float v) {
    v += dpp_row_shr(v, 1); v += dpp_row_shr(v, 2); v += dpp_row_shr(v, 4); v += dpp_row_shr(v, 8);
    v += __builtin_bit_cast(float, __builtin_amdgcn_update_dpp(0, __builtin_bit_cast(int, v), 0x142, 0xa, 0xf, false));
    v += __builtin_bit_cast(float, __builtin_amdgcn_update_dpp(0, __builtin_bit_cast(int, v), 0x143, 0xc, 0xf, false));
    return __builtin_bit_cast(float, __builtin_amdgcn_readlane(__builtin_bit_cast(int, v), 63));
}
__device__ __forceinline__ unsigned f2ord(float f) { const unsigned u = __float_as_uint(f); return (u & 0x80000000u) ? ~u : (u | 0x80000000u); }
__device__ __forceinline__ float ord2f(unsigned o) { const unsigned u = (o & 0x80000000u) ? (o & 0x7fffffffu) : ~o; return __uint_as_float(u); }

__device__ __forceinline__ float row_scale(const float* p, int mode, int t) {
    if (mode == 0) return p[t];
    const f32x4* q = (const f32x4*)(p + (size_t)t * 16); const f32x4 a = q[0], b = q[1], c = q[2], d = q[3];
    const float s = (((a[0] + a[1]) + (a[2] + a[3])) + ((b[0] + b[1]) + (b[2] + b[3]))) + (((c[0] + c[1]) + (c[2] + c[3])) + ((d[0] + d[1]) + (d[2] + d[3])));
    return rsqrtf(s * (1.f / DM) + RMS_EPS);
}

struct EpiL0In {
    static constexpr bool PERM = true, AFTER_DRAIN = false;
    const float* rs; bf16_t* QH; bf16_t* KH; bf16_t* VT; float* LF; const float* b_f;
    __device__ __forceinline__ void operator()(const f32x4 (&acc)[2][2][4][2], const pg8::Unit& u, int wr, int wc, int fr, int fq) const {
        const int pn = u.pn;
        if (pn == 12) {
            if (wc == 0 && fq == 0) {
#pragma unroll
                for (int ai = 0; ai < 2; ++ai)
#pragma unroll
                    for (int m = 0; m < 4; ++m) {
                        const int t = u.pm * 256 + ai * 128 + wr * 64 + m * 16 + fr; const float sc = rs[t]; const int b = t >> 11, s = t & 2047;
#pragma unroll
                        for (int n = 0; n < 2; ++n)
#pragma unroll
                            for (int e = 0; e < 4; ++e) { const int h = n * 4 + e; const float x = acc[ai][0][m][n][e] * sc + b_f[h];
                                const float ls = fminf(x, 0.f) - log1pf(expf(-fabsf(x)));
                                LF[(size_t)(b * 8 + h) * 2048 + s] = ls * LOG2E; }
                    }
            }
            return;
        }
        const int sec = pn >> 1, kind = sec % 3, hbase = (sec >= 3) ? 8 : 0;
#pragma unroll
        for (int ai = 0; ai < 2; ++ai)
#pragma unroll
            for (int m = 0; m < 4; ++m) {
                const int t = u.pm * 256 + ai * 128 + wr * 64 + m * 16 + fr; const int b = t >> 11, s = t & 2047;
                const float sc = rs[t] * (kind == 0 ? C2 : 1.f);
#pragma unroll
                for (int bj = 0; bj < 2; ++bj) {
                    const int cc = (pn & 1) * 256 + bj * 128 + wc * 32 + fq * 8, hh = hbase + (cc >> 6), d0 = cc & 63;
                    const f32x4 v0 = acc[ai][bj][m][0] * sc, v1 = acc[ai][bj][m][1] * sc;
                    if (kind < 2) { bf16_t* dst = (kind == 0 ? QH : KH) + ((size_t)(b * 16 + hh) * 2048 + s) * 64 + d0; *(u32x4*)dst = pack8(v0, v1); }
                    else { bf16_t* dst = VT + ((size_t)(b * 16 + hh) * 64 + d0) * 2048 + s;
                        dst[0 * 2048] = (bf16_t)f2bf(v0[0]); dst[1 * 2048] = (bf16_t)f2bf(v0[1]); dst[2 * 2048] = (bf16_t)f2bf(v0[2]); dst[3 * 2048] = (bf16_t)f2bf(v0[3]);
                        dst[4 * 2048] = (bf16_t)f2bf(v1[0]); dst[5 * 2048] = (bf16_t)f2bf(v1[1]); dst[6 * 2048] = (bf16_t)f2bf(v1[2]); dst[7 * 2048] = (bf16_t)f2bf(v1[3]); }
                }
            }
    }
};
struct EpiL1In {
    static constexpr bool PERM = true, AFTER_DRAIN = false;
    const float* rsp; int rsmode; bf16_t* XC; bf16_t* QD; bf16_t* KD; bf16_t* VTD;
    __device__ __forceinline__ void operator()(const f32x4 (&acc)[2][2][4][2], const pg8::Unit& u, int wr, int wc, int fr, int fq) const {
        const int pn = u.pn, kind = pn >> 1;
#pragma unroll
        for (int ai = 0; ai < 2; ++ai)
#pragma unroll
            for (int m = 0; m < 4; ++m) {
                const int t = u.pm * 256 + ai * 128 + wr * 64 + m * 16 + fr; const int b = t >> 11, s = t & 2047;
                const float sc = row_scale(rsp, rsmode, t) * (kind == 1 ? C2 : 1.f);
#pragma unroll
                for (int bj = 0; bj < 2; ++bj) {
                    const int cc = (pn & 1) * 256 + bj * 128 + wc * 32 + fq * 8, hh = cc >> 6, d0 = cc & 63;
                    const f32x4 v0 = acc[ai][bj][m][0] * sc, v1 = acc[ai][bj][m][1] * sc;
                    if (kind == 0) { *(u32x4*)(XC + (size_t)t * 512 + cc) = pack8(v0, v1); }
                    else if (kind < 3) { bf16_t* dst = (kind == 1 ? QD : KD) + ((size_t)(b * 8 + hh) * 2048 + s) * 64 + d0; *(u32x4*)dst = pack8(v0, v1); }
                    else { bf16_t* dst = VTD + ((size_t)(b * 8 + hh) * 64 + d0) * 2048 + s;
                        dst[0 * 2048] = (bf16_t)f2bf(v0[0]); dst[1 * 2048] = (bf16_t)f2bf(v0[1]); dst[2 * 2048] = (bf16_t)f2bf(v0[2]); dst[3 * 2048] = (bf16_t)f2bf(v0[3]);
                        dst[4 * 2048] = (bf16_t)f2bf(v1[0]); dst[5 * 2048] = (bf16_t)f2bf(v1[1]); dst[6 * 2048] = (bf16_t)f2bf(v1[2]); dst[7 * 2048] = (bf16_t)f2bf(v1[3]); }
                }
            }
    }
};
struct EpiQ {
    static constexpr bool PERM = true, AFTER_DRAIN = false;
    const float* rsp; int rsmode; bf16_t* Q;
    __device__ __forceinline__ void operator()(const f32x4 (&acc)[2][2][4][2], const pg8::Unit& u, int wr, int wc, int fr, int fq) const {
#pragma unroll
        for (int ai = 0; ai < 2; ++ai)
#pragma unroll
            for (int m = 0; m < 4; ++m) {
                const int t = u.pm * 256 + ai * 128 + wr * 64 + m * 16 + fr; const float sc = row_scale(rsp, rsmode, t);
#pragma unroll
                for (int bj = 0; bj < 2; ++bj) { const int c = u.pn * 256 + bj * 128 + wc * 32 + fq * 8;
                    *(u32x4*)(Q + (size_t)t * 2048 + c) = pack8(acc[ai][bj][m][0] * sc, acc[ai][bj][m][1] * sc); }
            }
    }
};
template <bool BASE_BF16>
struct EpiRes {
    static constexpr bool PERM = true, AFTER_DRAIN = false;
    const void* base; bf16_t* xb; float* ssqp;
    __device__ __forceinline__ void operator()(const f32x4 (&acc)[2][2][4][2], const pg8::Unit& u, int wr, int wc, int fr, int fq) const {
#pragma unroll
        for (int ai = 0; ai < 2; ++ai)
#pragma unroll
            for (int m = 0; m < 4; ++m) {
                const int t = u.pm * 256 + ai * 128 + wr * 64 + m * 16 + fr; float ss = 0.f;
#pragma unroll
                for (int bj = 0; bj < 2; ++bj) { const size_t off = (size_t)t * DM + u.pn * 256 + bj * 128 + wc * 32 + fq * 8;
                    f32x4 b0, b1;
                    if (BASE_BF16) { const u32x4 w = *(const u32x4*)((const bf16_t*)base + off); b0 = (f32x4){bf_lo(w.x), bf_hi(w.x), bf_lo(w.y), bf_hi(w.y)}; b1 = (f32x4){bf_lo(w.z), bf_hi(w.z), bf_lo(w.w), bf_hi(w.w)}; }
                    else { b0 = *(const f32x4*)((const float*)base + off); b1 = *(const f32x4*)((const float*)base + off + 4); }
                    const f32x4 o0 = b0 + acc[ai][bj][m][0], o1 = b1 + acc[ai][bj][m][1];
                    *(u32x4*)(xb + off) = pack8(o0, o1);
                    ss += (o0[0] * o0[0] + o0[1] * o0[1]) + (o0[2] * o0[2] + o0[3] * o0[3]) + (o1[0] * o1[0] + o1[1] * o1[1]) + (o1[2] * o1[2] + o1[3] * o1[3]); }
                ss += __shfl_xor(ss, 16); ss += __shfl_xor(ss, 32);
                if (fq == 0) ssqp[(size_t)t * 16 + u.pn * 4 + wc] = ss;
            }
    }
};

#define XB_TMO      128
#define XB_XCNT(j)  (256  + 64 * (j))
#define XB_XSUB(j)  (1280 + 64 * (j))
#define XB_XGEN(j)  (2304 + 64 * (j))
#define XB_TOP      3328
#define XB_TOPGEN   3392
#define XCD_BAR_WORDS 3456
#define XB_SPIN_CAP (1u << 18)

__device__ __forceinline__ unsigned xb_ld(unsigned* p)              { return __hip_atomic_load(p, __ATOMIC_RELAXED, __HIP_MEMORY_SCOPE_AGENT); }
__device__ __forceinline__ unsigned xb_add(unsigned* p, unsigned v) { return __hip_atomic_fetch_add(p, v, __ATOMIC_RELAXED, __HIP_MEMORY_SCOPE_AGENT); }
__device__ __forceinline__ unsigned xb_xcc_id() { return (unsigned)__builtin_amdgcn_s_getreg((3 << 11) | 20) & 0xFu; }
#define XB_SPIN(cond, bar) do { unsigned _sp = 0; while (cond) { __builtin_amdgcn_s_sleep(1); \
    if ((++_sp & 255u) == 0u) { if (xb_ld(&(bar)[XB_TMO])) break; if (_sp > XB_SPIN_CAP) { atomicAdd(&(bar)[XB_TMO], 1u); break; } } } } while (0)

struct XcdBarrier {
    unsigned* bar; unsigned x;
    volatile LAS unsigned* st;
};

__device__ __forceinline__ XcdBarrier xcd_barrier_post(unsigned* bar, volatile LAS unsigned* st) {
    XcdBarrier b; b.bar = bar; b.x = xb_xcc_id(); b.st = st;
    if (threadIdx.x == 0) (void)xb_add(&bar[XB_XCNT(b.x)], 1u);
    return b;
}
__device__ __forceinline__ void xcd_barrier_complete(unsigned* bar, unsigned x, unsigned& nloc, unsigned& nx) {
    const unsigned G = gridDim.x * gridDim.y * gridDim.z;
    unsigned sum, cnt, mine, sp = 0u;
    for (;;) {
        sum = 0u; cnt = 0u; mine = 0u;
#pragma unroll
        for (unsigned j = 0; j < 16; ++j) { const unsigned c = xb_ld(&bar[XB_XCNT(j)]); sum += c; cnt += (c > 0u) ? 1u : 0u; mine = (j == x) ? c : mine; }
        if (sum == G) break;
        __builtin_amdgcn_s_sleep(1);
        if ((++sp & 255u) == 0u) { if (xb_ld(&bar[XB_TMO])) break; if (sp > XB_SPIN_CAP) { atomicAdd(&bar[XB_TMO], 1u); break; } }
    }
    nloc = mine > 0u ? mine : 1u; nx = cnt > 0u ? cnt : 1u;
}

__device__ __forceinline__ void xcd_barrier(const XcdBarrier& b) {
    asm volatile("s_waitcnt vmcnt(0)" ::: "memory");
    __syncthreads();
    if (threadIdx.x == 0) {
        unsigned* bar = b.bar;
        __builtin_amdgcn_s_waitcnt(0);
        unsigned nloc = b.st[0], nx = b.st[1];
        if (nloc == 0u) { xcd_barrier_complete(bar, b.x, nloc, nx); b.st[0] = nloc; b.st[1] = nx; }
        const unsigned old = xb_add(&bar[XB_XSUB(b.x)], 1u);
        const unsigned gen = old / nloc;
        if (old + 1u == (gen + 1u) * nloc) {
            __builtin_amdgcn_fence(__ATOMIC_RELEASE, "agent");
            asm volatile("s_waitcnt vmcnt(0)" ::: "memory");
            const unsigned og = xb_add(&bar[XB_TOP], 1u);
            const unsigned tg = og / nx;
            if (og + 1u == (tg + 1u) * nx) xb_add(&bar[XB_TOPGEN], 1u);
            else XB_SPIN(xb_ld(&bar[XB_TOPGEN]) == tg, bar);
            __builtin_amdgcn_fence(__ATOMIC_ACQUIRE, "agent");
            xb_add(&bar[XB_XGEN(b.x)], 1u);
            asm volatile("s_waitcnt vmcnt(0)" ::: "memory");
        } else {
            XB_SPIN(xb_ld(&bar[XB_XGEN(b.x)]) == gen, bar);
            __builtin_amdgcn_fence(__ATOMIC_ACQUIRE, "agent");
            asm volatile("s_waitcnt vmcnt(0)" ::: "memory");
        }
    }
    __syncthreads();
}

struct Frame {
    LAS unsigned char* lds;
    int tid, lane, wave, vcu, G;
};

__device__ __forceinline__ int remap0(int n) { return n < 1536 ? n : (n < 1544 ? 3072 + (n - 1536) : n - 8); }
__device__ __forceinline__ void p0_transpose_item(const float* W, int K, int N, bf16_t* WT, const float* g, bool remap, LAS float* scr, int item, int lane) {
    const int nblk = (N + 31) / 32, kb = item / nblk, nb = item % nblk, k0 = 64 * kb, n0 = 32 * nb;
#pragma unroll 8
    for (int i = 0; i < 32; ++i) { const int kk = 2 * i + (lane >> 5), n = n0 + (lane & 31);
        float v = (n < N) ? W[(size_t)(k0 + kk) * N + n] : 0.f; if (g) v *= g[k0 + kk]; scr[kk * 33 + (lane & 31)] = v; }
    LDS_WAIT(); asm volatile("" ::: "memory");
    const int c = lane & 7;
#pragma unroll
    for (int j = 0; j < 4; ++j) { const int nl = (lane >> 3) + 8 * j, n = n0 + nl; const LAS float* s = scr + (8 * c) * 33 + nl;
        u32x4 o; o.x = pk2(s[0 * 33], s[1 * 33]); o.y = pk2(s[2 * 33], s[3 * 33]); o.z = pk2(s[4 * 33], s[5 * 33]); o.w = pk2(s[6 * 33], s[7 * 33]);
        if (n < N) { const int nn = remap ? remap0(n) : n; *(u32x4*)(WT + (size_t)nn * K + k0 + 8 * c) = o; } }
    LDS_WAIT(); asm volatile("" ::: "memory");
}
__device__ __forceinline__ float cvt_row_1024(const float* src, bf16_t* dst, const float* g, int lane) {
    const f32x4 a0 = *(const f32x4*)(src + 8 * lane), a1 = *(const f32x4*)(src + 8 * lane + 4), c0 = *(const f32x4*)(src + 512 + 8 * lane), c1 = *(const f32x4*)(src + 516 + 8 * lane);
    float ss = (a0[0] * a0[0] + a0[1] * a0[1]) + (a0[2] * a0[2] + a0[3] * a0[3]) + (a1[0] * a1[0] + a1[1] * a1[1]) + (a1[2] * a1[2] + a1[3] * a1[3])
             + (c0[0] * c0[0] + c0[1] * c0[1]) + (c0[2] * c0[2] + c0[3] * c0[3]) + (c1[0] * c1[0] + c1[1] * c1[1]) + (c1[2] * c1[2] + c1[3] * c1[3]);
    f32x4 b0 = a0, b1 = a1, d0 = c0, d1 = c1;
    if (g) { b0 = b0 * *(const f32x4*)(g + 8 * lane); b1 = b1 * *(const f32x4*)(g + 8 * lane + 4); d0 = d0 * *(const f32x4*)(g + 512 + 8 * lane); d1 = d1 * *(const f32x4*)(g + 516 + 8 * lane); }
    *(u32x4*)(dst + 8 * lane) = pack8(b0, b1); *(u32x4*)(dst + 512 + 8 * lane) = pack8(d0, d1);
    return ss;
}

constexpr float I8_SU = 600.f, I8_SX = 127.f / 6.f;
constexpr float FP8_SU = 64.f, FP8_SV = 8.f;
__device__ __forceinline__ void cvt_row_fp8_sliced(const float* src, unsigned char* tab  , int e, const float* g, float scale, int lane) {
#pragma unroll
    for (int j = 0; j < 4; ++j) { f32x4 a = *(const f32x4*)(src + 256 * j + 4 * lane) * scale; if (g) a = a * *(const f32x4*)(g + 256 * j + 4 * lane);
        int w = 0; w = __builtin_amdgcn_cvt_pk_bf8_f32(a[0], a[1], w, false); w = __builtin_amdgcn_cvt_pk_bf8_f32(a[2], a[3], w, true);
        const int x = 2 * j + (lane >> 5);
        *(unsigned*)(tab + ((size_t)x * NEXP + e) * 128 + 4 * (lane & 31)) = (unsigned)w; }
}
__device__ __forceinline__ void cvt_row_i8_sliced(const float* src, unsigned char* tab  , int e, const float* g, float scale, int lane) {
#pragma unroll
    for (int j = 0; j < 4; ++j) { f32x4 a = *(const f32x4*)(src + 256 * j + 4 * lane) * scale; if (g) a = a * *(const f32x4*)(g + 256 * j + 4 * lane);
        unsigned w = 0u;
#pragma unroll
        for (int q = 0; q < 4; ++q) { int v = __float2int_rn(a[q]); v = v < -127 ? -127 : (v > 127 ? 127 : v); w |= ((unsigned)v & 0xffu) << (8 * q); }
        const int x = 2 * j + (lane >> 5);
        *(unsigned*)(tab + ((size_t)x * NEXP + e) * 128 + 4 * (lane & 31)) = w; }
}
struct Ptrs {
    const float *x, *norm_mix, *norm_ffn, *ev_w_in, *ev_b_f, *ev_w_out, *od_w_in, *od_pool_w, *od_pool_scale, *od_w_out, *peer_wq, *peer_k1, *peer_k2, *peer_u, *peer_v, *norm_f;
    float* out; unsigned char* ws;
};

__device__ __forceinline__ void phase_p0(Frame& F, const Ptrs& P) {
    LAS float* scr = (LAS float*)(F.lds + F.wave * 16384);
    const int gw = F.vcu * NWAVES + F.wave, NGW = F.G * NWAVES, lane = opaque_i(F.lane);
    unsigned char* ws = P.ws;
    bf16_t* W1T = (bf16_t*)(ws + WS_W1T); bf16_t* W2T = (bf16_t*)(ws + WS_W2T); bf16_t* W4T = (bf16_t*)(ws + WS_W4T); bf16_t* W5T = (bf16_t*)(ws + WS_W5T);
    bf16_t* W3T = (bf16_t*)(ws + WS_W3T); bf16_t* W6T = (bf16_t*)(ws + WS_W6T); bf16_t* PWT = (bf16_t*)(ws + WS_PWT);
    constexpr int I1 = 16 * 97, I2 = 16 * 32, I4 = 16 * 64, I5 = I2, I3 = I4, I6 = I4, IP = 4 * 2 * 4;
    constexpr int NTR = I1 + I2 + I4 + I5 + I3 + I6 + IP;
    for (int it = gw; it < NTR; it += NGW) {
        int r = it;
        if (r < I1) { p0_transpose_item(P.ev_w_in, DM, EVEN_IN, W1T, P.norm_mix, true, scr, r, lane); continue; } r -= I1;
        if (r < I2) { p0_transpose_item(P.ev_w_out, DM, DM, W2T, nullptr, false, scr, r, lane); continue; } r -= I2;
        if (r < I4) { p0_transpose_item(P.od_w_in, DM, 2048, W4T, P.norm_mix + DM, false, scr, r, lane); continue; } r -= I4;
        if (r < I5) { p0_transpose_item(P.od_w_out, DM, DM, W5T, nullptr, false, scr, r, lane); continue; } r -= I5;
        if (r < I3) { p0_transpose_item(P.peer_wq, DM, 2048, W3T, P.norm_ffn, false, scr, r, lane); continue; } r -= I3;
        if (r < I6) { p0_transpose_item(P.peer_wq + (size_t)DM * 2048, DM, 2048, W6T, P.norm_ffn + DM, false, scr, r, lane); continue; } r -= I6;
        { const int g = r >> 3; p0_transpose_item(P.od_pool_w + (size_t)g * 128 * 128, 128, 128, PWT + (size_t)g * 128 * 128, nullptr, false, scr, r & 7, lane); }
    }
    constexpr int R_Z = EVEN_PAD - EVEN_IN, R_X = TOK, R_U = 2 * NEXP, R_V = 2 * NEXP, R_K = 2 * 256;
    constexpr int NROW = R_Z + R_X + R_U + R_V + R_K;
    bf16_t* XB = (bf16_t*)(ws + WS_XB); float* RS0 = (float*)(ws + WS_RS0);
    bf16_t* K1B = (bf16_t*)(ws + WS_K1B); bf16_t* K2B = (bf16_t*)(ws + WS_K2B);
    for (int it = gw; it < NROW; it += NGW) {
        int r = it;
        if (r < R_Z) { bf16_t* d = W1T + (size_t)(EVEN_IN + r) * DM; const u32x4 z = {0u, 0u, 0u, 0u}; *(u32x4*)(d + 8 * lane) = z; *(u32x4*)(d + 512 + 8 * lane) = z; continue; } r -= R_Z;
        if (r < R_X) { const float ss = wave_sum(cvt_row_1024(P.x + (size_t)r * DM, XB + (size_t)r * DM, nullptr, lane)); if (lane == 0) RS0[r] = rsqrtf(ss * (1.f / DM) + RMS_EPS); continue; } r -= R_X;
        if (r < R_U) { const int ly = r >= NEXP; cvt_row_i8_sliced(P.peer_u + (size_t)r * DM, ws + WS_U8S + (size_t)ly * 8 * NEXP * 128, r - ly * NEXP, P.norm_ffn + (ly ? DM : 0), I8_SU, lane); continue; } r -= R_U;
        if (r < R_V) { const int ly = r >= NEXP; cvt_row_fp8_sliced(P.peer_v + (size_t)r * DM, ws + WS_V8S + (size_t)ly * 8 * NEXP * 128, r - ly * NEXP, nullptr, FP8_SV, lane); continue; } r -= R_V;
        if (r < 256) (void)cvt_row_1024(P.peer_k1 + (size_t)r * 1024, K1B + (size_t)r * 1024, nullptr, lane);
        else (void)cvt_row_1024(P.peer_k2 + (size_t)(r - 256) * 1024, K2B + (size_t)(r - 256) * 1024, nullptr, lane);
    }
}

__device__ __forceinline__ void phase_cfscan(Frame& F, const float* LF, float* CFo) {
    const int gw = F.vcu * NWAVES + F.wave, NGW = F.G * NWAVES, lane = opaque_i(F.lane);
    for (int bh = gw; bh < NB * 8; bh += NGW) {
        const float* src = LF + (size_t)bh * 2048 + 32 * lane; float v[32];
#pragma unroll
        for (int i = 0; i < 8; ++i) { const f32x4 w = *(const f32x4*)(src + 4 * i); v[4 * i] = w[0]; v[4 * i + 1] = w[1]; v[4 * i + 2] = w[2]; v[4 * i + 3] = w[3]; }
#pragma unroll
        for (int i = 1; i < 32; ++i) v[i] += v[i - 1];
        const float tot = v[31]; float inc = tot;
#pragma unroll
        for (int o = 1; o < 64; o <<= 1) { const float w = __shfl_up(inc, o); if (lane >= o) inc += w; }
        const float excl = inc - tot; float* dst = CFo + (size_t)bh * 2048 + 32 * lane;
#pragma unroll
        for (int i = 0; i < 8; ++i) { f32x4 w = {v[4 * i] + excl, v[4 * i + 1] + excl, v[4 * i + 2] + excl, v[4 * i + 3] + excl}; *(f32x4*)(dst + 4 * i) = w; }
    }
}
__device__ __forceinline__ void phase_kmean(Frame& F, const bf16_t* KD, float* KMEAN) {
    const int gw = F.vcu * NWAVES + F.wave, NGW = F.G * NWAVES, lane = opaque_i(F.lane);
    for (int it = gw; it < NB * 8 * 8; it += NGW) {
        const int bh = it >> 3, blk = it & 7; const bf16_t* src = KD + ((size_t)bh * 2048 + blk * 256) * 64 + lane; float s = 0.f;
#pragma unroll 8
        for (int j = 0; j < 256; ++j) s += __uint_as_float((unsigned)src[(size_t)j * 64] << 16);
        KMEAN[(size_t)it * 64 + lane] = s * (1.f / 256.f);
    }
}

__device__ __forceinline__ int lgi(int s) { return s + (s >> 5); }
__device__ __forceinline__ float lsn2f(float z2) { return -(fmaxf(z2, 0.f) + __log2f(1.f + exp2f(-fabsf(z2)))); }
template <int KIND>
__device__ __forceinline__ void attn_naive(Frame& F, const bf16_t* QH, const bf16_t* KH, const bf16_t* VT, int NH, int hbase, const float* CF, const float* KMEAN, bf16_t* AO, int ao_col0) {
    LAS float* lg = (LAS float*)(F.lds + F.wave * 8704);
    const int gw = F.vcu * NWAVES + F.wave, NGW = F.G * NWAVES, lane = opaque_i(F.lane);
    for (int qi = gw; qi < NB * 8 * SEQ; qi += NGW) {
        const int bh = qi >> 11, b = bh >> 3, h = bh & 7, hh = hbase + h;
        const int t = (bh & 1) ? (2047 - (qi & 2047)) : (qi & 2047);
        const size_t hb = (size_t)(b * NH + hh);
        const bf16_t* qp = QH + (hb * 2048 + t) * 64; const bf16_t* kp = KH + hb * 2048 * 64;
        float q[64];
#pragma unroll
        for (int c = 0; c < 8; ++c) { const u32x4 w = *(const u32x4*)(qp + 8 * c);
            q[8 * c] = bf_lo(w.x); q[8 * c + 1] = bf_hi(w.x); q[8 * c + 2] = bf_lo(w.y); q[8 * c + 3] = bf_hi(w.y); q[8 * c + 4] = bf_lo(w.z); q[8 * c + 5] = bf_hi(w.z); q[8 * c + 6] = bf_lo(w.w); q[8 * c + 7] = bf_hi(w.w); }
        unsigned sel = 0u; const int qb = t >> 8;
        if (KIND == 2) {
            float gate[8];
#pragma unroll
            for (int n = 0; n < 8; ++n) { const float* km = KMEAN + ((size_t)(b * 8 + h) * 8 + n) * 64; float a = 0.f;
#pragma unroll
                for (int d = 0; d < 64; ++d) a += q[d] * km[d];
                gate[n] = a; }
            const int nsel = qb < 3 ? qb : 3;
#pragma unroll
            for (int r = 0; r < 3; ++r) if (r < nsel) { float best = -INFINITY; int bi = 0;
#pragma unroll
                for (int n = 0; n < 8; ++n) if (n < qb && !((sel >> n) & 1u) && gate[n] > best) { best = gate[n]; bi = n; }
                sel |= 1u << bi; }
        }
        const int nk = (KIND == 1) ? t : t + 1;
        const int tp = (nk + 7) & ~7;
        const float cft = (KIND == 0) ? CF[(size_t)(b * 8 + h) * 2048 + t] : 0.f;
        const float slope2 = (KIND == 2) ? exp2f(-(float)(h + 1)) * LOG2E : 0.f;
        float mloc = -INFINITY;
        for (int s = lane; s < nk; s += 64) {
            float dot = 0.f;
#pragma unroll
            for (int c = 0; c < 8; ++c) { const u32x4 w = *(const u32x4*)(kp + (size_t)s * 64 + 8 * c);
                dot += q[8 * c] * bf_lo(w.x) + q[8 * c + 1] * bf_hi(w.x) + q[8 * c + 2] * bf_lo(w.y) + q[8 * c + 3] * bf_hi(w.y) + q[8 * c + 4] * bf_lo(w.z) + q[8 * c + 5] * bf_hi(w.z) + q[8 * c + 6] * bf_lo(w.w) + q[8 * c + 7] * bf_hi(w.w); }
            float v = dot;
            if (KIND == 0) v += cft - CF[(size_t)(b * 8 + h) * 2048 + s];
            if (KIND == 2) { const int n = s >> 8; const bool valid = (n == qb) || ((sel >> n) & 1u); v = valid ? v + slope2 * (float)(s - t) : -INFINITY; }
            lg[lgi(s)] = v; mloc = fmaxf(mloc, v);
        }
        float linv = 1.f;
        if (KIND != 1) {
            const float m = wave_max(mloc); float lsum = 0.f;
            for (int s = lane; s < tp; s += 64) { const float p = (s < nk) ? exp2f(lg[lgi(s)] - m) : 0.f; lg[lgi(s)] = p; lsum += p; }
            linv = 1.f / wave_sum(lsum);
        } else {
            float tot = 0.f;
            for (int i = 0; i < 32; ++i) { const int s = 32 * lane + i; if (s < nk) tot += lsn2f(lg[lgi(s)]); }
            float inc = tot;
#pragma unroll
            for (int o = 1; o < 64; o <<= 1) { const float w = __shfl_down(inc, o); if (lane + o < 64) inc += w; }
            float run = inc - tot;
            for (int i = 31; i >= 0; --i) { const int s = 32 * lane + i; float a = 0.f;
                if (s < nk) { const float z = lg[lgi(s)], l2 = lsn2f(z); a = exp2f(z + l2 + run); run += l2; }
                if (s < tp) lg[lgi(s)] = a; }
        }
        LDS_WAIT();
        const bf16_t* vp = VT + (hb * 64 + lane) * 2048; float o = 0.f;
        for (int s0 = 0; s0 < tp; s0 += 8) { const u32x4 w = *(const u32x4*)(vp + s0); const int i0 = lgi(s0);
            o += lg[i0] * bf_lo(w.x) + lg[i0 + 1] * bf_hi(w.x) + lg[i0 + 2] * bf_lo(w.y) + lg[i0 + 3] * bf_hi(w.y) + lg[i0 + 4] * bf_lo(w.z) + lg[i0 + 5] * bf_hi(w.z) + lg[i0 + 6] * bf_lo(w.w) + lg[i0 + 7] * bf_hi(w.w); }
        AO[(size_t)(b * 2048 + t) * DM + ao_col0 + h * 64 + lane] = (bf16_t)f2bf(o * linv);
        LDS_WAIT();
    }
}

__device__ __forceinline__ float lsn2q(float z2) { return -(fmaxf(z2, 0.f) + __builtin_amdgcn_logf(1.f + __builtin_amdgcn_exp2f(-fabsf(z2)))); }
__device__ __forceinline__ int pi32(int i) { return (i & ~12) | ((i & 4) << 1) | ((i & 8) >> 1); }
__device__ __forceinline__ void attn_load_k(bf16x8 (&kf)[4], const bf16_t* Kh, int kv0, int r32p, int hi) {
    const bf16_t* p = Kh + (size_t)(kv0 + r32p) * 64 + 8 * hi;
#pragma unroll
    for (int d0 = 0; d0 < 4; ++d0) kf[d0] = *(const bf16x8*)(p + 16 * d0);
}
__device__ __forceinline__ void attn_load_v(bf16x8 (&vf)[2][2], const bf16_t* Vth, int kv0, int r32, int hi) {
#pragma unroll
    for (int s = 0; s < 2; ++s)
#pragma unroll
        for (int dh = 0; dh < 2; ++dh) vf[s][dh] = *(const bf16x8*)(Vth + (size_t)(32 * dh + r32) * 2048 + kv0 + 16 * s + 8 * hi);
}
template <int KIND, int MODE>
__device__ __forceinline__ void attn_tile(const bf16x8 (&qr)[4], const bf16x8 (&kf)[4], const bf16x8 (&vf)[2][2], f32x16& O0, f32x16& O1, float& m, float& l, float& R,
                                          const f32x16& bias, const int kv0, const int q, const int hi, const bool rowok) {
    f32x16 S = bias;
#pragma unroll
    for (int d0 = 0; d0 < 4; ++d0) S = __builtin_amdgcn_mfma_f32_32x32x16_bf16(kf[d0], qr[d0], S, 0, 0, 0);
    if (MODE == 1) {
#pragma unroll
        for (int r = 0; r < 16; ++r) { const int key = kv0 + (r & 7) + 8 * hi + 16 * (r >> 3); const bool bad = (KIND == 1) ? (key >= q) : (key > q); if (bad) S[r] = -INFINITY; }
    }
    if (MODE == 2) { if (!rowok) {
#pragma unroll
        for (int r = 0; r < 16; ++r) S[r] = -INFINITY; } }
    float p[16];
    if (KIND != 1) {
        float rm = fmaxf(fmaxf(S[0], S[1]), fmaxf(S[2], S[3]));
#pragma unroll
        for (int r = 4; r < 16; r += 4) rm = fmaxf(rm, fmaxf(fmaxf(S[r], S[r + 1]), fmaxf(S[r + 2], S[r + 3])));
        rm = fmaxf(rm, __shfl_xor(rm, 32));
        const float mn = fmaxf(fmaxf(m, rm), -1e30f); const float alpha = __builtin_amdgcn_exp2f(m - mn);
        float ps = 0.f;
#pragma unroll
        for (int r = 0; r < 16; ++r) { p[r] = __builtin_amdgcn_exp2f(S[r] - mn); ps += p[r]; }
        l = l * alpha + ps; m = mn;
        O0 *= alpha; O1 *= alpha;
    } else {
        float l2[16]; float sLo = 0.f, sHi = 0.f;
#pragma unroll
        for (int r = 0; r < 16; ++r) l2[r] = lsn2q(S[r]);
#pragma unroll
        for (int r = 0; r < 8; ++r) { sLo += l2[r]; sHi += l2[8 + r]; }
        const float pLo = __shfl_xor(sLo, 32), pHi = __shfl_xor(sHi, 32);
        float run = hi ? R : R + pHi;
#pragma unroll
        for (int r = 15; r >= 8; --r) { p[r] = __builtin_amdgcn_exp2f(S[r] + l2[r] + run); run += l2[r]; }
        run = hi ? (R + sHi + pHi) : (R + pHi + sHi + pLo);
#pragma unroll
        for (int r = 7; r >= 0; --r) { p[r] = __builtin_amdgcn_exp2f(S[r] + l2[r] + run); run += l2[r]; }
        R += (sLo + sHi) + (pLo + pHi);
    }
    u32x4 w0, w1;
    w0.x = pk2(p[0], p[1]); w0.y = pk2(p[2], p[3]); w0.z = pk2(p[4], p[5]); w0.w = pk2(p[6], p[7]);
    w1.x = pk2(p[8], p[9]); w1.y = pk2(p[10], p[11]); w1.z = pk2(p[12], p[13]); w1.w = pk2(p[14], p[15]);
    const bf16x8 pf0 = __builtin_bit_cast(bf16x8, w0), pf1 = __builtin_bit_cast(bf16x8, w1);
    O0 = __builtin_amdgcn_mfma_f32_32x32x16_bf16(vf[0][0], pf0, O0, 0, 0, 0); O0 = __builtin_amdgcn_mfma_f32_32x32x16_bf16(vf[1][0], pf1, O0, 0, 0, 0);
    O1 = __builtin_amdgcn_mfma_f32_32x32x16_bf16(vf[0][1], pf0, O1, 0, 0, 0); O1 = __builtin_amdgcn_mfma_f32_32x32x16_bf16(vf[1][1], pf1, O1, 0, 0, 0);
}
template <int KIND>
__device__ __forceinline__ f32x16 attn_bias(const float* CFh, float slope2, int kv0, int q0, int hi) {
    f32x16 b = f32x16{};
    if (KIND == 0) { const float* c = CFh + kv0 + 8 * hi; const f32x4 a0 = *(const f32x4*)c, a1 = *(const f32x4*)(c + 4), a2 = *(const f32x4*)(c + 16), a3 = *(const f32x4*)(c + 20);
        b[0] = -a0[0]; b[1] = -a0[1]; b[2] = -a0[2]; b[3] = -a0[3]; b[4] = -a1[0]; b[5] = -a1[1]; b[6] = -a1[2]; b[7] = -a1[3];
        b[8] = -a2[0]; b[9] = -a2[1]; b[10] = -a2[2]; b[11] = -a2[3]; b[12] = -a3[0]; b[13] = -a3[1]; b[14] = -a3[2]; b[15] = -a3[3]; }
    if (KIND == 2) {
#pragma unroll
        for (int r = 0; r < 16; ++r) b[r] = slope2 * (float)(kv0 + (r & 7) + 8 * hi + 16 * (r >> 3) - q0); }
    return b;
}
template <int KIND>
__device__ __forceinline__ void attn_wave(const bf16_t* Qh, const bf16_t* Kh, const bf16_t* Vth, const int q0, const int lane, const float* CFh, const float slope2, const float* KMh, bf16_t* AOp) {
    const int r32 = lane & 31, hi = lane >> 5, r32p = pi32(r32), q = q0 + r32;
    bf16x8 qr[4];
#pragma unroll
    for (int d0 = 0; d0 < 4; ++d0) qr[d0] = *(const bf16x8*)(Qh + (size_t)q * 64 + 16 * d0 + 8 * hi);
    f32x16 O0 = f32x16{}, O1 = f32x16{};
    float m = -INFINITY, l = 0.f, R = 0.f;
    bf16x8 kf[4], kfn[4], vf[2][2];
    const int nt = q0 / 32 + 1;
    if (KIND == 0) {
        attn_load_k(kf, Kh, 0, r32p, hi);
        for (int it = 0; it < nt; ++it) { const int kv0 = 32 * it;
            attn_load_v(vf, Vth, kv0, r32, hi); const f32x16 bias = attn_bias<0>(CFh, 0.f, kv0, q0, hi);
            if (it + 1 < nt) attn_load_k(kfn, Kh, kv0 + 32, r32p, hi);
            if (it == nt - 1) attn_tile<0, 1>(qr, kf, vf, O0, O1, m, l, R, bias, kv0, q, hi, true); else attn_tile<0, 0>(qr, kf, vf, O0, O1, m, l, R, bias, kv0, q, hi, true);
#pragma unroll
            for (int d0 = 0; d0 < 4; ++d0) kf[d0] = kfn[d0]; }
    } else if (KIND == 1) {
        attn_load_k(kf, Kh, 32 * (nt - 1), r32p, hi);
        for (int it = nt - 1; it >= 0; --it) { const int kv0 = 32 * it;
            attn_load_v(vf, Vth, kv0, r32, hi); const f32x16 bias = f32x16{};
            if (it > 0) attn_load_k(kfn, Kh, kv0 - 32, r32p, hi);
            if (it == nt - 1) attn_tile<1, 1>(qr, kf, vf, O0, O1, m, l, R, bias, kv0, q, hi, true); else attn_tile<1, 0>(qr, kf, vf, O0, O1, m, l, R, bias, kv0, q, hi, true);
#pragma unroll
            for (int d0 = 0; d0 < 4; ++d0) kf[d0] = kfn[d0];
            if (__all(R < -200.f)) break; }
    } else {
        const int qb = q0 >> 8;
        f32x16 G = f32x16{};
#pragma unroll
        for (int d0 = 0; d0 < 4; ++d0) { u32x4 kw = {0u, 0u, 0u, 0u};
            if (r32 < 8) { const float* kmp = KMh + r32 * 64 + 16 * d0 + 8 * hi; kw = pack8(*(const f32x4*)kmp, *(const f32x4*)(kmp + 4)); }
            G = __builtin_amdgcn_mfma_f32_32x32x16_bf16(__builtin_bit_cast(bf16x8, kw), qr[d0], G, 0, 0, 0); }
        float gate[8];
#pragma unroll
        for (int n = 0; n < 4; ++n) { const float own = G[n], oth = __shfl_xor(own, 32); gate[n] = hi ? oth : own; gate[n + 4] = hi ? own : oth; }
        unsigned sel = 0u; const int nsel = qb < 3 ? qb : 3;
#pragma unroll
        for (int r = 0; r < 3; ++r) if (r < nsel) { float best = -INFINITY; int bi = 0;
#pragma unroll
            for (int n = 0; n < 8; ++n) if (n < qb && !((sel >> n) & 1u) && gate[n] > best) { best = gate[n]; bi = n; }
            sel |= 1u << bi; }
        for (int kv0 = 256 * qb; kv0 <= q0; kv0 += 32) {
            attn_load_k(kf, Kh, kv0, r32p, hi); attn_load_v(vf, Vth, kv0, r32, hi); const f32x16 bias = attn_bias<2>(nullptr, slope2, kv0, q0, hi);
            if (kv0 == q0) attn_tile<2, 1>(qr, kf, vf, O0, O1, m, l, R, bias, kv0, q, hi, true); else attn_tile<2, 0>(qr, kf, vf, O0, O1, m, l, R, bias, kv0, q, hi, true); }
        for (int j = 0; j < qb; ++j) { const bool rowok = (sel >> j) & 1u;
            if (!__any(rowok)) continue;
            attn_load_k(kf, Kh, 256 * j, r32p, hi);
            for (int i = 0; i < 8; ++i) { const int kv0 = 256 * j + 32 * i;
                attn_load_v(vf, Vth, kv0, r32, hi); const f32x16 bias = attn_bias<2>(nullptr, slope2, kv0, q0, hi);
                if (i < 7) attn_load_k(kfn, Kh, kv0 + 32, r32p, hi);
                attn_tile<2, 2>(qr, kf, vf, O0, O1, m, l, R, bias, kv0, q, hi, rowok);
#pragma unroll
                for (int d0 = 0; d0 < 4; ++d0) kf[d0] = kfn[d0]; } }
    }
    float linv = 1.f;
    if (KIND != 1) linv = 1.f / (l + __shfl_xor(l, 32));
    bf16_t* orow = AOp + (size_t)q * DM;
#pragma unroll
    for (int g = 0; g < 4; ++g) { u32x2 w;
        w.x = pk2(O0[4 * g] * linv, O0[4 * g + 1] * linv); w.y = pk2(O0[4 * g + 2] * linv, O0[4 * g + 3] * linv); *(u32x2*)(orow + 8 * g + 4 * hi) = w;
        w.x = pk2(O1[4 * g] * linv, O1[4 * g + 1] * linv); w.y = pk2(O1[4 * g + 2] * linv, O1[4 * g + 3] * linv); *(u32x2*)(orow + 32 + 8 * g + 4 * hi) = w; }
}
template <int KIND>
__device__ __forceinline__ void phase_attn(Frame& F, const bf16_t* QH, const bf16_t* KH, const bf16_t* VT, int NH, int hbase, const float* CF, const float* KMEAN, bf16_t* AO, int ao_col0) {
    for (int ug = F.vcu; ug < NB * 8 * 2; ug += F.G) {
        const int bh = ug >> 1, b = bh >> 3, h = bh & 7, hh = hbase + h; const size_t hb = (size_t)(b * NH + hh);
        const float slope2 = __builtin_amdgcn_exp2f(-(float)(h + 1)) * LOG2E;
#pragma unroll 1
        for (int i = 0; i < 4; ++i) { const int base = (i >> 1) * 2 + (ug & 1), qb = (i & 1) ? 7 - base : base, w = (i & 1) ? 7 - F.wave : F.wave;
            attn_wave<KIND>(QH + hb * 2048 * 64, KH + hb * 2048 * 64, VT + hb * 64 * 2048, 256 * qb + 32 * w, opaque_i(F.lane),
                            CF ? CF + (size_t)bh * 2048 : nullptr, slope2, KMEAN ? KMEAN + (size_t)bh * 8 * 64 : nullptr, AO + (size_t)b * 2048 * DM + ao_col0 + h * 64); }
    }
}


constexpr int AT_SLOT = 16384, AT_CF = 3 * AT_SLOT;
__device__ __forceinline__ void attn_dma_tile(const bf16_t* Kh, const bf16_t* Vth, int T, LAS unsigned char* slot, int wave, int r32, int r32p, int hi) {
    const int j = wave >> 2, d0 = wave & 3, s2 = (wave >> 1) & 1, dh = wave & 1;
    const bf16_t* ks = Kh + (size_t)(64 * T + 32 * j + r32p) * 64 + 16 * d0 + 8 * hi;
    const bf16_t* vs = Vth + (size_t)(32 * dh + r32) * 2048 + 64 * T + 32 * j + 16 * s2 + 8 * hi;
    __builtin_amdgcn_global_load_lds((const unsigned*)ks, (LAS unsigned*)(slot + (j * 4 + d0) * 1024), 16, 0, 0);
    __builtin_amdgcn_global_load_lds((const unsigned*)vs, (LAS unsigned*)(slot + 8192 + ((j * 2 + s2) * 2 + dh) * 1024), 16, 0, 0);
}
template <int MODE>
__device__ __forceinline__ void attn_fox_sub(const bf16x8 (&qr)[4], f32x16& O0, f32x16& O1, float& m, float& l, unsigned saddr  , unsigned cfaddr  , int j, int kv0, int q, int hi) {
    bf16x8 kf[4], vf[2][2]; f32x4 c0, c1, c2, c3;
    asm volatile("ds_read_b128 %0, %12\n\tds_read_b128 %1, %12 offset:1024\n\tds_read_b128 %2, %12 offset:2048\n\tds_read_b128 %3, %12 offset:3072\n\t"
                 "ds_read_b128 %4, %13\n\tds_read_b128 %5, %13 offset:1024\n\tds_read_b128 %6, %13 offset:2048\n\tds_read_b128 %7, %13 offset:3072\n\t"
                 "ds_read_b128 %8, %14\n\tds_read_b128 %9, %14 offset:16\n\tds_read_b128 %10, %14 offset:64\n\tds_read_b128 %11, %14 offset:80\n\ts_waitcnt lgkmcnt(0)"
                 : "=&v"(kf[0]), "=&v"(kf[1]), "=&v"(kf[2]), "=&v"(kf[3]), "=&v"(vf[0][0]), "=&v"(vf[0][1]), "=&v"(vf[1][0]), "=&v"(vf[1][1]), "=&v"(c0), "=&v"(c1), "=&v"(c2), "=&v"(c3)
                 : "v"(saddr + (unsigned)j * 4096u), "v"(saddr + 8192u + (unsigned)j * 4096u), "v"(cfaddr) : "memory");
    f32x16 S;
    S[0] = c0[0]; S[1] = c0[1]; S[2] = c0[2]; S[3] = c0[3]; S[4] = c1[0]; S[5] = c1[1]; S[6] = c1[2]; S[7] = c1[3];
    S[8] = c2[0]; S[9] = c2[1]; S[10] = c2[2]; S[11] = c2[3]; S[12] = c3[0]; S[13] = c3[1]; S[14] = c3[2]; S[15] = c3[3];
#pragma unroll
    for (int d0 = 0; d0 < 4; ++d0) S = __builtin_amdgcn_mfma_f32_32x32x16_bf16(kf[d0], qr[d0], S, 0, 0, 0);
    if (MODE == 1) {
#pragma unroll
        for (int r = 0; r < 16; ++r) { const int key = kv0 + (r & 7) + 8 * hi + 16 * (r >> 3); if (key > q) S[r] = -INFINITY; }
    }
    float rm = fmaxf(fmaxf(S[0], S[1]), fmaxf(S[2], S[3]));
#pragma unroll
    for (int r = 4; r < 16; r += 4) rm = fmaxf(rm, fmaxf(fmaxf(S[r], S[r + 1]), fmaxf(S[r + 2], S[r + 3])));
    { const auto rr = __builtin_amdgcn_permlane32_swap(__float_as_uint(rm), __float_as_uint(rm), false, false); rm = fmaxf(__uint_as_float(rr[0]), __uint_as_float(rr[1])); }
    if (__any(rm > m)) {
        const float mn = fmaxf(fmaxf(m, rm), -1e30f); const float alpha = __builtin_amdgcn_exp2f(m - mn);
        l *= alpha; O0 *= alpha; O1 *= alpha; m = mn; }
    float p[16]; float ps = 0.f;
#pragma unroll
    for (int r = 0; r < 16; ++r) { p[r] = __builtin_amdgcn_exp2f(S[r] - m); ps += p[r]; }
    l += ps;
    u32x4 w0, w1;
    w0.x = pk2(p[0], p[1]); w0.y = pk2(p[2], p[3]); w0.z = pk2(p[4], p[5]); w0.w = pk2(p[6], p[7]);
    w1.x = pk2(p[8], p[9]); w1.y = pk2(p[10], p[11]); w1.z = pk2(p[12], p[13]); w1.w = pk2(p[14], p[15]);
    const bf16x8 pf0 = __builtin_bit_cast(bf16x8, w0), pf1 = __builtin_bit_cast(bf16x8, w1);
    O0 = __builtin_amdgcn_mfma_f32_32x32x16_bf16(vf[0][0], pf0, O0, 0, 0, 0); O0 = __builtin_amdgcn_mfma_f32_32x32x16_bf16(vf[1][0], pf1, O0, 0, 0, 0);
    O1 = __builtin_amdgcn_mfma_f32_32x32x16_bf16(vf[0][1], pf0, O1, 0, 0, 0); O1 = __builtin_amdgcn_mfma_f32_32x32x16_bf16(vf[1][1], pf1, O1, 0, 0, 0);
}
__device__ __forceinline__ void attn_fox_unit(Frame& F, const bf16_t* Qh, const bf16_t* Kh, const bf16_t* Vth, const float* CFh, const int qb, bf16_t* AOp) {
    const int lane = opaque_i(F.lane), r32 = lane & 31, hi = lane >> 5, r32p = pi32(r32), wave = F.wave, q0 = 256 * qb + 32 * wave, q = q0 + r32;
    LAS unsigned char* ring = F.lds; const unsigned ring_a = (unsigned)(uintptr_t)ring + 16u * (unsigned)lane, cf_a = (unsigned)(uintptr_t)ring + (unsigned)AT_CF + 32u * (unsigned)hi;
    bf16x8 qr[4];
#pragma unroll
    for (int d0 = 0; d0 < 4; ++d0) qr[d0] = *(const bf16x8*)(Qh + (size_t)q * 64 + 16 * d0 + 8 * hi);
    { const f32x4 cv = *(const f32x4*)(CFh + 4 * F.tid); *(LAS f32x4*)(ring + AT_CF + 16 * F.tid) = -cv; }
    asm volatile("s_waitcnt vmcnt(0) lgkmcnt(0)" ::: "memory"); __builtin_amdgcn_s_barrier();
    const int NT = 4 * qb + 4, my_last = 4 * qb + (wave >> 1), jdiag = wave & 1;
    attn_dma_tile(Kh, Vth, NT - 1, ring, wave, r32, r32p, hi);
    attn_dma_tile(Kh, Vth, NT - 2, ring + AT_SLOT, wave, r32, r32p, hi);
    f32x16 O0 = f32x16{}, O1 = f32x16{}; float m = -INFINITY, l = 0.f;
    int slot = 0;
#pragma unroll 1
    for (int T = NT - 1; T >= 0; --T) {
        if (T > 0) asm volatile("s_waitcnt vmcnt(2)" ::: "memory"); else asm volatile("s_waitcnt vmcnt(0)" ::: "memory");
        __builtin_amdgcn_s_barrier();
        if (T >= 2) { const int fs = (slot == 0) ? 2 : slot - 1; attn_dma_tile(Kh, Vth, T - 2, ring + fs * AT_SLOT, wave, r32, r32p, hi); }
        if (T <= my_last) {
            const unsigned sa = ring_a + (unsigned)(slot * AT_SLOT);
            if (T == my_last) {
                if (jdiag == 1) { attn_fox_sub<1>(qr, O0, O1, m, l, sa, cf_a + 4u * (unsigned)(64 * T + 32), 1, 64 * T + 32, q, hi); attn_fox_sub<0>(qr, O0, O1, m, l, sa, cf_a + 4u * (unsigned)(64 * T), 0, 64 * T, q, hi); }
                else attn_fox_sub<1>(qr, O0, O1, m, l, sa, cf_a + 4u * (unsigned)(64 * T), 0, 64 * T, q, hi);
            } else { attn_fox_sub<0>(qr, O0, O1, m, l, sa, cf_a + 4u * (unsigned)(64 * T + 32), 1, 64 * T + 32, q, hi); attn_fox_sub<0>(qr, O0, O1, m, l, sa, cf_a + 4u * (unsigned)(64 * T), 0, 64 * T, q, hi); }
        }
        slot = (slot == 2) ? 0 : slot + 1;
    }
    const float linv = 1.f / (l + __shfl_xor(l, 32));
    bf16_t* orow = AOp + (size_t)q * DM;
#pragma unroll
    for (int g = 0; g < 4; ++g) { u32x2 w;
        w.x = pk2(O0[4 * g] * linv, O0[4 * g + 1] * linv); w.y = pk2(O0[4 * g + 2] * linv, O0[4 * g + 3] * linv); *(u32x2*)(orow + 8 * g + 4 * hi) = w;
        w.x = pk2(O1[4 * g] * linv, O1[4 * g + 1] * linv); w.y = pk2(O1[4 * g + 2] * linv, O1[4 * g + 3] * linv); *(u32x2*)(orow + 32 + 8 * g + 4 * hi) = w; }
    asm volatile("s_waitcnt vmcnt(0) lgkmcnt(0)" ::: "memory"); __builtin_amdgcn_s_barrier();
}
__device__ __forceinline__ void phase_attn_fox(Frame& F, const bf16_t* QH, const bf16_t* KH, const bf16_t* VT, const float* CF, bf16_t* AO) {
    for (int ug = F.vcu; ug < NB * 8 * 2; ug += F.G) {
        const int bh = ug >> 1, b = bh >> 3, h = bh & 7; const size_t hb = (size_t)(b * 16 + h);
#pragma unroll 1
        for (int i = 0; i < 4; ++i) { const int base = (i >> 1) * 2 + (ug & 1), qb = (i & 1) ? 7 - base : base;
            attn_fox_unit(F, QH + hb * 2048 * 64, KH + hb * 2048 * 64, VT + hb * 64 * 2048, CF + (size_t)bh * 2048, qb, AO + (size_t)b * 2048 * DM + h * 64); }
    }
}

template <int MODE>
__device__ __forceinline__ void attn_moba_sub(const bf16x8 (&qr)[4], f32x16& O0, f32x16& O1, float& m, float& l, unsigned saddr, int j, int kv0, int q, int q0, int hi, float slope2, bool rowok) {
    bf16x8 kf[4], vf[2][2];
    asm volatile("ds_read_b128 %0, %8\n\tds_read_b128 %1, %8 offset:1024\n\tds_read_b128 %2, %8 offset:2048\n\tds_read_b128 %3, %8 offset:3072\n\t"
                 "ds_read_b128 %4, %9\n\tds_read_b128 %5, %9 offset:1024\n\tds_read_b128 %6, %9 offset:2048\n\tds_read_b128 %7, %9 offset:3072\n\ts_waitcnt lgkmcnt(0)"
                 : "=&v"(kf[0]), "=&v"(kf[1]), "=&v"(kf[2]), "=&v"(kf[3]), "=&v"(vf[0][0]), "=&v"(vf[0][1]), "=&v"(vf[1][0]), "=&v"(vf[1][1])
                 : "v"(saddr + (unsigned)j * 4096u), "v"(saddr + 8192u + (unsigned)j * 4096u) : "memory");
    f32x16 S; const float sbase = slope2 * (float)(kv0 + 8 * hi - q0);
#pragma unroll
    for (int r = 0; r < 16; ++r) S[r] = sbase + slope2 * (float)((r & 7) + 16 * (r >> 3));
#pragma unroll
    for (int d0 = 0; d0 < 4; ++d0) S = __builtin_amdgcn_mfma_f32_32x32x16_bf16(kf[d0], qr[d0], S, 0, 0, 0);
    if (MODE == 1) {
#pragma unroll
        for (int r = 0; r < 16; ++r) { const int key = kv0 + (r & 7) + 8 * hi + 16 * (r >> 3); if (key > q) S[r] = -INFINITY; }
    }
    if (MODE == 2) { if (!rowok) {
#pragma unroll
        for (int r = 0; r < 16; ++r) S[r] = -INFINITY; } }
    float rm = fmaxf(fmaxf(S[0], S[1]), fmaxf(S[2], S[3]));
#pragma unroll
    for (int r = 4; r < 16; r += 4) rm = fmaxf(rm, fmaxf(fmaxf(S[r], S[r + 1]), fmaxf(S[r + 2], S[r + 3])));
    { const auto rr = __builtin_amdgcn_permlane32_swap(__float_as_uint(rm), __float_as_uint(rm), false, false); rm = fmaxf(__uint_as_float(rr[0]), __uint_as_float(rr[1])); }
    if (__any(rm > m)) { const float mn = fmaxf(fmaxf(m, rm), -1e30f); const float alpha = __builtin_amdgcn_exp2f(m - mn); l *= alpha; O0 *= alpha; O1 *= alpha; m = mn; }
    float p[16]; float ps = 0.f;
#pragma unroll
    for (int r = 0; r < 16; ++r) { p[r] = __builtin_amdgcn_exp2f(S[r] - m); ps += p[r]; }
    l += ps;
    u32x4 w0, w1;
    w0.x = pk2(p[0], p[1]); w0.y = pk2(p[2], p[3]); w0.z = pk2(p[4], p[5]); w0.w = pk2(p[6], p[7]);
    w1.x = pk2(p[8], p[9]); w1.y = pk2(p[10], p[11]); w1.z = pk2(p[12], p[13]); w1.w = pk2(p[14], p[15]);
    const bf16x8 pf0 = __builtin_bit_cast(bf16x8, w0), pf1 = __builtin_bit_cast(bf16x8, w1);
    O0 = __builtin_amdgcn_mfma_f32_32x32x16_bf16(vf[0][0], pf0, O0, 0, 0, 0); O0 = __builtin_amdgcn_mfma_f32_32x32x16_bf16(vf[1][0], pf1, O0, 0, 0, 0);
    O1 = __builtin_amdgcn_mfma_f32_32x32x16_bf16(vf[0][1], pf0, O1, 0, 0, 0); O1 = __builtin_amdgcn_mfma_f32_32x32x16_bf16(vf[1][1], pf1, O1, 0, 0, 0);
}
__device__ __forceinline__ void attn_moba_unit(Frame& F, const bf16_t* Qh, const bf16_t* Kh, const bf16_t* Vth, const float* KMh, const float slope2, const int qb, bf16_t* AOp) {
    const int lane = opaque_i(F.lane), r32 = lane & 31, hi = lane >> 5, r32p = pi32(r32), wave = F.wave, q0 = 256 * qb + 32 * wave, q = q0 + r32;
    LAS unsigned char* ring = F.lds; const unsigned ring_a = (unsigned)(uintptr_t)ring + 16u * (unsigned)lane;
    bf16x8 qr[4];
#pragma unroll
    for (int d0 = 0; d0 < 4; ++d0) qr[d0] = *(const bf16x8*)(Qh + (size_t)q * 64 + 16 * d0 + 8 * hi);
    f32x16 G = f32x16{};
#pragma unroll
    for (int d0 = 0; d0 < 4; ++d0) { u32x4 kw = {0u, 0u, 0u, 0u};
        if (r32 < 8) { const float* kmp = KMh + r32 * 64 + 16 * d0 + 8 * hi; kw = pack8(*(const f32x4*)kmp, *(const f32x4*)(kmp + 4)); }
        G = __builtin_amdgcn_mfma_f32_32x32x16_bf16(__builtin_bit_cast(bf16x8, kw), qr[d0], G, 0, 0, 0); }
    float gate[8];
#pragma unroll
    for (int n = 0; n < 4; ++n) { const float own = G[n], oth = __shfl_xor(own, 32); gate[n] = hi ? oth : own; gate[n + 4] = hi ? own : oth; }
    unsigned sel = 0u; const int nsel = qb < 3 ? qb : 3;
#pragma unroll
    for (int r = 0; r < 3; ++r) if (r < nsel) { float best = -INFINITY; int bi = 0;
#pragma unroll
        for (int n = 0; n < 8; ++n) if (n < qb && !((sel >> n) & 1u) && gate[n] > best) { best = gate[n]; bi = n; }
        sel |= 1u << bi; }
    unsigned wsel = 0u;
#pragma unroll
    for (int n = 0; n < 8; ++n) if (__any((sel >> n) & 1u)) wsel |= 1u << n;
    asm volatile("s_waitcnt vmcnt(0) lgkmcnt(0)" ::: "memory"); __builtin_amdgcn_s_barrier();
    const int NT = 4 * qb + 4, my_last = 4 * qb + (wave >> 1), jdiag = wave & 1;
    attn_dma_tile(Kh, Vth, NT - 1, ring, wave, r32, r32p, hi);
    attn_dma_tile(Kh, Vth, NT - 2, ring + AT_SLOT, wave, r32, r32p, hi);
    f32x16 O0 = f32x16{}, O1 = f32x16{}; float m = -INFINITY, l = 0.f;
    int slot = 0;
#pragma unroll 1
    for (int T = NT - 1; T >= 0; --T) {
        if (T > 0) asm volatile("s_waitcnt vmcnt(2)" ::: "memory"); else asm volatile("s_waitcnt vmcnt(0)" ::: "memory");
        __builtin_amdgcn_s_barrier();
        if (T >= 2) { const int fs = (slot == 0) ? 2 : slot - 1; attn_dma_tile(Kh, Vth, T - 2, ring + fs * AT_SLOT, wave, r32, r32p, hi); }
        const unsigned sa = ring_a + (unsigned)(slot * AT_SLOT);
        if (T >= 4 * qb) {
            if (T == my_last) {
                if (jdiag == 1) { attn_moba_sub<1>(qr, O0, O1, m, l, sa, 1, 64 * T + 32, q, q0, hi, slope2, true); attn_moba_sub<0>(qr, O0, O1, m, l, sa, 0, 64 * T, q, q0, hi, slope2, true); }
                else attn_moba_sub<1>(qr, O0, O1, m, l, sa, 0, 64 * T, q, q0, hi, slope2, true);
            } else if (T < my_last) { attn_moba_sub<0>(qr, O0, O1, m, l, sa, 1, 64 * T + 32, q, q0, hi, slope2, true); attn_moba_sub<0>(qr, O0, O1, m, l, sa, 0, 64 * T, q, q0, hi, slope2, true); }
        } else if ((wsel >> (T >> 2)) & 1u) {
            const bool rowok = (sel >> (T >> 2)) & 1u;
            attn_moba_sub<2>(qr, O0, O1, m, l, sa, 1, 64 * T + 32, q, q0, hi, slope2, rowok); attn_moba_sub<2>(qr, O0, O1, m, l, sa, 0, 64 * T, q, q0, hi, slope2, rowok);
        }
        slot = (slot == 2) ? 0 : slot + 1;
    }
    const float linv = 1.f / (l + __shfl_xor(l, 32));
    bf16_t* orow = AOp + (size_t)q * DM;
#pragma unroll
    for (int g = 0; g < 4; ++g) { u32x2 w;
        w.x = pk2(O0[4 * g] * linv, O0[4 * g + 1] * linv); w.y = pk2(O0[4 * g + 2] * linv, O0[4 * g + 3] * linv); *(u32x2*)(orow + 8 * g + 4 * hi) = w;
        w.x = pk2(O1[4 * g] * linv, O1[4 * g + 1] * linv); w.y = pk2(O1[4 * g + 2] * linv, O1[4 * g + 3] * linv); *(u32x2*)(orow + 32 + 8 * g + 4 * hi) = w; }
    asm volatile("s_waitcnt vmcnt(0) lgkmcnt(0)" ::: "memory"); __builtin_amdgcn_s_barrier();
}
__device__ __forceinline__ void phase_attn_moba(Frame& F, const bf16_t* QD, const bf16_t* KD, const bf16_t* VTD, const float* KMEAN, bf16_t* AO) {
    for (int ug = F.vcu; ug < NB * 8 * 2; ug += F.G) {
        const int bh = ug >> 1, b = bh >> 3, h = bh & 7; const size_t hb = (size_t)bh;
        const float slope2 = __builtin_amdgcn_exp2f(-(float)(h + 1)) * LOG2E;
#pragma unroll 1
        for (int i = 0; i < 4; ++i) { const int base = (i >> 1) * 2 + (ug & 1), qb = (i & 1) ? 7 - base : base;
            attn_moba_unit(F, QD + hb * 2048 * 64, KD + hb * 2048 * 64, VTD + hb * 64 * 2048, KMEAN + (size_t)bh * 8 * 64, slope2, qb, AO + (size_t)b * 2048 * DM + 512 + h * 64); }
    }
}
__device__ __forceinline__ void phase_pool(Frame& F, const bf16_t* XC, const bf16_t* PWT, const float* pool_scale, bf16_t* AO) {
    const int gw = F.vcu * NWAVES + F.wave, NGW = F.G * NWAVES, lane = opaque_i(F.lane), r32 = lane & 31, hi = lane >> 5;
    for (int it = gw; it < (TOK / 32) * 4; it += NGW) {
        const int g = it & 3, t0 = (it >> 2) * 32, t = t0 + r32, tl = t & 2047, w = 2 << g;
        const int cnt = (tl + 1) < w ? (tl + 1) : w; const float rc = 1.f / (float)cnt;
        f32x16 acc[4];
#pragma unroll
        for (int nb = 0; nb < 4; ++nb) acc[nb] = f32x16{};
#pragma unroll 1
        for (int kk = 0; kk < 8; ++kk) {
            const int c0 = g * 128 + kk * 16 + hi * 8;
            const u32x4 self = *(const u32x4*)(XC + (size_t)t * 512 + c0);
            float s[8] = {0.f, 0.f, 0.f, 0.f, 0.f, 0.f, 0.f, 0.f};
            for (int i = 0; i < cnt; ++i) { const u32x4 x = *(const u32x4*)(XC + (size_t)(t - i) * 512 + c0);
                s[0] += bf_lo(x.x); s[1] += bf_hi(x.x); s[2] += bf_lo(x.y); s[3] += bf_hi(x.y); s[4] += bf_lo(x.z); s[5] += bf_hi(x.z); s[6] += bf_lo(x.w); s[7] += bf_hi(x.w); }
            u32x4 pa; pa.x = pk2(s[0] * rc - bf_lo(self.x), s[1] * rc - bf_hi(self.x)); pa.y = pk2(s[2] * rc - bf_lo(self.y), s[3] * rc - bf_hi(self.y));
            pa.z = pk2(s[4] * rc - bf_lo(self.z), s[5] * rc - bf_hi(self.z)); pa.w = pk2(s[6] * rc - bf_lo(self.w), s[7] * rc - bf_hi(self.w));
            const bf16x8 af = __builtin_bit_cast(bf16x8, pa);
#pragma unroll
            for (int nb = 0; nb < 4; ++nb) { const bf16x8 bfr = *(const bf16x8*)(PWT + ((size_t)g * 128 + nb * 32 + r32) * 128 + kk * 16 + hi * 8);
                acc[nb] = __builtin_amdgcn_mfma_f32_32x32x16_bf16(af, bfr, acc[nb], 0, 0, 0); }
        }
#pragma unroll
        for (int nb = 0; nb < 4; ++nb) { const int col = g * 128 + nb * 32 + r32; const float sc = pool_scale[col];
#pragma unroll
            for (int r = 0; r < 16; ++r) { const int row = (r & 3) + 8 * (r >> 2) + 4 * hi; AO[(size_t)(t0 + row) * DM + col] = (bf16_t)f2bf(acc[nb][r] * sc); } }
    }
}

__device__ __forceinline__ void phase_topk_naive(Frame& F, const bf16_t* QP, const bf16_t* K1B, const bf16_t* K2B, unsigned short* EID, float* GATE) {
    const int gw = F.vcu * NWAVES + F.wave, NGW = F.G * NWAVES, lane = opaque_i(F.lane);
    for (int task = gw; task < TOK * 8; task += NGW) {
        const int t = task >> 3, h = task & 7;
        const bf16_t* qrow = QP + (size_t)t * 2048 + h * 256; const bf16_t* k1 = K1B + (size_t)h * 128 * 128; const bf16_t* k2 = K2B + (size_t)h * 128 * 128;
        float s1a = 0.f, s1b = 0.f, s2a = 0.f, s2b = 0.f;
#pragma unroll 4
        for (int c = 0; c < 16; ++c) { const u32x4 q1 = *(const u32x4*)(qrow + 8 * c), q2 = *(const u32x4*)(qrow + 128 + 8 * c);
            s1a = dot8(*(const u32x4*)(k1 + (size_t)lane * 128 + 8 * c), q1, s1a); s1b = dot8(*(const u32x4*)(k1 + (size_t)(lane + 64) * 128 + 8 * c), q1, s1b);
            s2a = dot8(*(const u32x4*)(k2 + (size_t)lane * 128 + 8 * c), q2, s2a); s2b = dot8(*(const u32x4*)(k2 + (size_t)(lane + 64) * 128 + 8 * c), q2, s2b); }
        unsigned A = (f2ord(s1a) & ~127u) | (unsigned)(127 - lane), B = (f2ord(s1b) & ~127u) | (unsigned)(63 - lane);
        unsigned top1 = 0u, top2 = 0u, topc = 0u;
        for (int r = 0; r < 16; ++r) { const unsigned m = wave_umax(A > B ? A : B); if (lane == r) top1 = m; if (A == m) A = 0u; if (B == m) B = 0u; }
        A = (f2ord(s2a) & ~127u) | (unsigned)(127 - lane); B = (f2ord(s2b) & ~127u) | (unsigned)(63 - lane);
        for (int r = 0; r < 16; ++r) { const unsigned m = wave_umax(A > B ? A : B); if (lane == r) top2 = m; if (A == m) A = 0u; if (B == m) B = 0u; }
        const float v1 = ord2f(top1 & ~127u), v2 = ord2f(top2 & ~127u); const int i1 = 127 - (int)(top1 & 127u), i2 = 127 - (int)(top2 & 127u);
        const float va = __shfl(v1, lane >> 2); unsigned C[4];
#pragma unroll
        for (int j = 0; j < 4; ++j) { const float vb = __shfl(v2, (lane & 3) * 4 + j); C[j] = (f2ord(va + vb) & ~255u) | (unsigned)(255 - (lane * 4 + j)); }
        for (int r = 0; r < 16; ++r) { unsigned m = C[0] > C[1] ? C[0] : C[1]; const unsigned m2 = C[2] > C[3] ? C[2] : C[3]; m = wave_umax(m > m2 ? m : m2); if (lane == r) topc = m;
#pragma unroll
            for (int j = 0; j < 4; ++j) if (C[j] == m) C[j] = 0u; }
        const int c = 255 - (int)(topc & 255u); const float val = ord2f(topc & ~255u);
        const int ia = __shfl(i1, c >> 4), ib = __shfl(i2, c & 15);
        const float v0 = __shfl(val, 0); const float e = (lane < 16) ? __expf(val - v0) : 0.f; const float sum = wave_sum(e);
        if (lane < 16) { EID[(size_t)t * 128 + h * 16 + lane] = (unsigned short)(ia * 128 + ib); GATE[(size_t)t * 128 + h * 16 + lane] = e / sum; }
    }
}

#define DEVFN __device__ __forceinline__
template <int OFF, int N, int TOT> DEVFN void bitonic_sort_desc(unsigned (&a)[TOT]) {
#pragma unroll
    for (int k = 2; k <= N; k <<= 1)
#pragma unroll
        for (int j = k >> 1; j > 0; j >>= 1)
#pragma unroll
            for (int i = 0; i < N; ++i) { const int l = i ^ j; if (l > i) { const bool desc = ((i & k) == 0); const unsigned x = a[OFF + i], y = a[OFF + l];
                const unsigned mx = x > y ? x : y, mn = x > y ? y : x; a[OFF + i] = desc ? mx : mn; a[OFF + l] = desc ? mn : mx; } }
}
constexpr int OE16_N = 63;
constexpr unsigned char OE16[63][2] = {{0,1}, {2,3}, {0,2}, {1,3}, {1,2}, {4,5}, {6,7}, {4,6}, {5,7}, {5,6}, {0,4}, {2,6}, {2,4}, {1,5}, {3,7}, {3,5}, {1,2}, {3,4}, {5,6}, {8,9}, {10,11}, {8,10}, {9,11}, {9,10}, {12,13}, {14,15}, {12,14}, {13,15}, {13,14}, {8,12}, {10,14}, {10,12}, {9,13}, {11,15}, {11,13}, {9,10}, {11,12}, {13,14}, {0,8}, {4,12}, {4,8}, {2,10}, {6,14}, {6,10}, {2,4}, {6,8}, {10,12}, {1,9}, {5,13}, {5,9}, {3,11}, {7,15}, {7,11}, {3,5}, {7,9}, {11,13}, {1,2}, {3,4}, {5,6}, {7,8}, {9,10}, {11,12}, {13,14}};
template <int OFF, int TOT> DEVFN void sort16_desc(unsigned (&a)[TOT]) {
#pragma unroll
    for (int q = 0; q < OE16_N; ++q) { const int i = OFF + OE16[q][0], l = OFF + OE16[q][1]; const unsigned x = a[i], y = a[l]; a[i] = x > y ? x : y; a[l] = x > y ? y : x; }
}
template <int OFF, int TOT> DEVFN void bitonic_merge16_desc(unsigned (&a)[TOT]) {
#pragma unroll
    for (int j = 8; j > 0; j >>= 1)
#pragma unroll
        for (int i = 0; i < 16; ++i) { const int l = i ^ j; if (l > i) { const unsigned x = a[OFF + i], y = a[OFF + l]; a[OFF + i] = x > y ? x : y; a[OFF + l] = x > y ? y : x; } }
}
template <int A, int B, int TOT> DEVFN void merge_top16(unsigned (&a)[TOT]) {
#pragma unroll
    for (int i = 0; i < 16; ++i) { const unsigned x = a[A + i], y = a[B + 15 - i]; a[A + i] = x > y ? x : y; }
    bitonic_merge16_desc<A, TOT>(a);
}
DEVFN void top16of64(unsigned (&a)[64]) {
    sort16_desc<0, 64>(a); sort16_desc<16, 64>(a); sort16_desc<32, 64>(a); sort16_desc<48, 64>(a);
    merge_top16<0, 16, 64>(a); merge_top16<32, 48, 64>(a); merge_top16<0, 32, 64>(a);
}

__device__ __forceinline__ void phase_topk(Frame& F, const bf16_t* QP, const bf16_t* K1B, const bf16_t* K2B, unsigned short* EID, float* GATE) {
    const int gw = F.vcu * NWAVES + F.wave, NGW = F.G * NWAVES, lane = opaque_i(F.lane), r32 = lane & 31, hi = lane >> 5;
    LAS unsigned* I1s = (LAS unsigned*)(F.lds + F.wave * 8192); LAS unsigned* I2s = I1s + 1024;
    for (int task = gw; task < (TOK / 32) * 8; task += NGW) {
        const int tile = task >> 3, h = task & 7, t = tile * 32 + r32;
        unsigned V1[16], V2[16]; unsigned h4 = (unsigned)hi << 2; asm volatile("" : "+v"(h4));
#pragma unroll
        for (int half = 0; half < 2; ++half) {
            const bf16_t* qrow = QP + (size_t)t * 2048 + h * 256 + half * 128 + 8 * hi;
            bf16x8 qf[8];
#pragma unroll
            for (int kk = 0; kk < 8; ++kk) qf[kk] = *(const bf16x8*)(qrow + 16 * kk);
            unsigned K[64];
#pragma unroll
            for (int nb = 0; nb < 4; ++nb) { f32x16 acc = f32x16{};
                const bf16_t* kb = (half ? K2B : K1B) + ((size_t)h * 128 + nb * 32 + r32) * 128 + 8 * hi; asm volatile("" : "+v"(kb));
#pragma unroll
                for (int kk = 0; kk < 8; ++kk) acc = __builtin_amdgcn_mfma_f32_32x32x16_bf16(*(const bf16x8*)(kb + 16 * kk), qf[kk], acc, 0, 0, 0);
#pragma unroll
                for (int r = 0; r < 16; ++r) K[nb * 16 + r] = ((f2ord(acc[r]) & ~127u) | (unsigned)(127 - (nb * 32 + (r & 3) + 8 * (r >> 2)))) ^ h4;
                __builtin_amdgcn_sched_barrier(0); }
            __builtin_amdgcn_sched_barrier(0); top16of64(K); __builtin_amdgcn_sched_barrier(0);
            unsigned C[16];
#pragma unroll
            for (int i = 0; i < 16; ++i) { const unsigned y = (unsigned)__shfl_xor((int)K[15 - i], 32); C[i] = K[i] > y ? K[i] : y; }
            bitonic_merge16_desc<0, 16>(C);
#pragma unroll
            for (int i = 0; i < 16; ++i) { if (half == 0) V1[i] = C[i]; else V2[i] = C[i]; }
            __builtin_amdgcn_sched_barrier(0);
        }
        float f1[16], f2[16];
#pragma unroll
        for (int a = 0; a < 16; ++a) { I1s[a * 64 + lane] = 127u - (V1[a] & 127u); I2s[a * 64 + lane] = 127u - (V2[a] & 127u); f1[a] = ord2f(V1[a] & ~127u); f2[a] = ord2f(V2[a] & ~127u); }
        __builtin_amdgcn_sched_barrier(0);
        unsigned Cd[64];
    Cd[0] = (f2ord(f1[0] + f2[0]) & ~255u) | 255u;
    Cd[1] = (f2ord(f1[0] + f2[1]) & ~255u) | 254u;
    Cd[2] = (f2ord(f1[0] + f2[2]) & ~255u) | 253u;
    Cd[3] = (f2ord(f1[0] + f2[3]) & ~255u) | 252u;
    Cd[4] = (f2ord(f1[0] + f2[4]) & ~255u) | 251u;
    Cd[5] = (f2ord(f1[0] + f2[5]) & ~255u) | 250u;
    Cd[6] = (f2ord(f1[0] + f2[6]) & ~255u) | 249u;
    Cd[7] = (f2ord(f1[0] + f2[7]) & ~255u) | 248u;
    Cd[8] = (f2ord(f1[0] + f2[8]) & ~255u) | 247u;
    Cd[9] = (f2ord(f1[0] + f2[9]) & ~255u) | 246u;
    Cd[10] = (f2ord(f1[0] + f2[10]) & ~255u) | 245u;
    Cd[11] = (f2ord(f1[0] + f2[11]) & ~255u) | 244u;
    Cd[12] = (f2ord(f1[0] + f2[12]) & ~255u) | 243u;
    Cd[13] = (f2ord(f1[0] + f2[13]) & ~255u) | 242u;
    Cd[14] = (f2ord(f1[0] + f2[14]) & ~255u) | 241u;
    Cd[15] = (f2ord(f1[0] + f2[15]) & ~255u) | 240u;
    Cd[16] = (f2ord(f1[1] + f2[0]) & ~255u) | 239u;
    Cd[17] = (f2ord(f1[1] + f2[1]) & ~255u) | 238u;
    Cd[18] = (f2ord(f1[1] + f2[2]) & ~255u) | 237u;
    Cd[19] = (f2ord(f1[1] + f2[3]) & ~255u) | 236u;
    Cd[20] = (f2ord(f1[1] + f2[4]) & ~255u) | 235u;
    Cd[21] = (f2ord(f1[1] + f2[5]) & ~255u) | 234u;
    Cd[22] = (f2ord(f1[1] + f2[6]) & ~255u) | 233u;
    Cd[23] = (f2ord(f1[1] + f2[7]) & ~255u) | 232u;
    Cd[24] = (f2ord(f1[2] + f2[0]) & ~255u) | 223u;
    Cd[25] = (f2ord(f1[2] + f2[1]) & ~255u) | 222u;
    Cd[26] = (f2ord(f1[2] + f2[2]) & ~255u) | 221u;
    Cd[27] = (f2ord(f1[2] + f2[3]) & ~255u) | 220u;
    Cd[28] = (f2ord(f1[2] + f2[4]) & ~255u) | 219u;
    Cd[29] = (f2ord(f1[3] + f2[0]) & ~255u) | 207u;
    Cd[30] = (f2ord(f1[3] + f2[1]) & ~255u) | 206u;
    Cd[31] = (f2ord(f1[3] + f2[2]) & ~255u) | 205u;
    Cd[32] = (f2ord(f1[3] + f2[3]) & ~255u) | 204u;
    Cd[33] = (f2ord(f1[4] + f2[0]) & ~255u) | 191u;
    Cd[34] = (f2ord(f1[4] + f2[1]) & ~255u) | 190u;
    Cd[35] = (f2ord(f1[4] + f2[2]) & ~255u) | 189u;
    Cd[36] = (f2ord(f1[5] + f2[0]) & ~255u) | 175u;
    Cd[37] = (f2ord(f1[5] + f2[1]) & ~255u) | 174u;
    Cd[38] = (f2ord(f1[6] + f2[0]) & ~255u) | 159u;
    Cd[39] = (f2ord(f1[6] + f2[1]) & ~255u) | 158u;
    Cd[40] = (f2ord(f1[7] + f2[0]) & ~255u) | 143u;
    Cd[41] = (f2ord(f1[7] + f2[1]) & ~255u) | 142u;
    Cd[42] = (f2ord(f1[8] + f2[0]) & ~255u) | 127u;
    Cd[43] = (f2ord(f1[9] + f2[0]) & ~255u) | 111u;
    Cd[44] = (f2ord(f1[10] + f2[0]) & ~255u) | 95u;
    Cd[45] = (f2ord(f1[11] + f2[0]) & ~255u) | 79u;
    Cd[46] = (f2ord(f1[12] + f2[0]) & ~255u) | 63u;
    Cd[47] = (f2ord(f1[13] + f2[0]) & ~255u) | 47u;
    Cd[48] = (f2ord(f1[14] + f2[0]) & ~255u) | 31u;
    Cd[49] = (f2ord(f1[15] + f2[0]) & ~255u) | 15u;
    Cd[50] = 0u;
    Cd[51] = 0u;
    Cd[52] = 0u;
    Cd[53] = 0u;
    Cd[54] = 0u;
    Cd[55] = 0u;
    Cd[56] = 0u;
    Cd[57] = 0u;
    Cd[58] = 0u;
    Cd[59] = 0u;
    Cd[60] = 0u;
    Cd[61] = 0u;
    Cd[62] = 0u;
    Cd[63] = 0u;
        __builtin_amdgcn_sched_barrier(0); top16of64(Cd); __builtin_amdgcn_sched_barrier(0);
        LDS_WAIT();
        unsigned eid[16]; float e[16]; float sum = 0.f; const float v0 = ord2f(Cd[0] & ~255u);
#pragma unroll
        for (int r = 0; r < 16; ++r) { const unsigned c = 255u - (Cd[r] & 255u); eid[r] = I1s[(c >> 4) * 64 + lane] * 128u + I2s[(c & 15u) * 64 + lane];
            e[r] = __builtin_amdgcn_exp2f((ord2f(Cd[r] & ~255u) - v0) * LOG2E); sum += e[r]; }
        const float inv = 1.f / sum;
        u32x4 ew; ew.x = (hi ? eid[8] : eid[0]) | ((hi ? eid[9] : eid[1]) << 16); ew.y = (hi ? eid[10] : eid[2]) | ((hi ? eid[11] : eid[3]) << 16);
        ew.z = (hi ? eid[12] : eid[4]) | ((hi ? eid[13] : eid[5]) << 16); ew.w = (hi ? eid[14] : eid[6]) | ((hi ? eid[15] : eid[7]) << 16);
        *(u32x4*)(EID + (size_t)t * 128 + h * 16 + 8 * hi) = ew;
        const f32x4 g0 = {(hi ? e[8] : e[0]) * inv, (hi ? e[9] : e[1]) * inv, (hi ? e[10] : e[2]) * inv, (hi ? e[11] : e[3]) * inv};
        const f32x4 g1 = {(hi ? e[12] : e[4]) * inv, (hi ? e[13] : e[5]) * inv, (hi ? e[14] : e[6]) * inv, (hi ? e[15] : e[7]) * inv};
        *(f32x4*)(GATE + (size_t)t * 128 + h * 16 + 8 * hi) = g0; *(f32x4*)(GATE + (size_t)t * 128 + h * 16 + 8 * hi + 4) = g1;
        LDS_WAIT();
    }
}

typedef float f32x2 __attribute__((ext_vector_type(2)));
__device__ __forceinline__ float dpp_f(float v, int sel) {
    const int iv = __builtin_bit_cast(int, v); int r;
    if (sel == 0) r = __builtin_amdgcn_update_dpp(0, iv, 0xB1, 0xf, 0xf, true); else if (sel == 1) r = __builtin_amdgcn_update_dpp(0, iv, 0x4E, 0xf, 0xf, true); else r = __builtin_amdgcn_update_dpp(0, iv, 0x141, 0xf, 0xf, true);
    return __builtin_bit_cast(float, r);
}
__device__ __forceinline__ float gelu_erf(float v) {
    const float av = fabsf(v), d = av * 0.2316418882f + 1.0f; const float t = __builtin_amdgcn_rcpf(d);
    float q = t * 0.5307027145f + (-0.7265760135f); q = q * t + 0.7107068705f; q = q * t + (-0.142248368f); q = q * t + 0.127414796f; q = q * t;
    const float e = __builtin_amdgcn_exp2f((v * v) * (-0.72134752044f));
    const float m = v * (q * e), r = v - m; return v < 0.f ? m : r;
}
typedef _Float16 h16x2 __attribute__((ext_vector_type(2)));
__device__ __forceinline__ h16x2 bf8_lo2(unsigned w) { return __builtin_bit_cast(h16x2, __builtin_amdgcn_perm(0u, w, 0x010c000cu)); }
__device__ __forceinline__ h16x2 bf8_hi2(unsigned w) { return __builtin_bit_cast(h16x2, __builtin_amdgcn_perm(0u, w, 0x030c020cu)); }
__device__ __forceinline__ h16x2 bf16pair_to_h2(unsigned w) { h16x2 r; r.x = (_Float16)bf_lo(w); r.y = (_Float16)bf_hi(w); return r; }
#define PEER_E(ev0_, ev1_, w_) (int)((((w_) < 8 ? (ev0_) : (ev1_))[((w_) & 7) >> 1] >> (16 * ((w_) & 1))) & 0xffffu)
#define GLD16(dst_, ptr_) asm volatile("global_load_dwordx4 %0, %1, off" : "=v"(dst_) : "v"(ptr_) : "memory")
__device__ __forceinline__ void phase_peer_u(Frame& F, const bf16_t* XB, const float* rsp, int rsmode, const unsigned short* EID, const unsigned char* U8S, float* PREP) {
    const int lane = opaque_i(F.lane), i16 = (lane >> 3) * 16, c = lane & 7, b = (int)blockIdx.x, x = b & 7, step = (F.G >> 3) * NWAVES;
    const unsigned char* tab = U8S + (size_t)x * NEXP * 128 + 16 * c;
    int t = (b >> 3) * NWAVES + F.wave;
    u32x4 evB0, evB1, xrA0, xrA1, xrB0, xrB1; u32x4 uw[16];
    {   const u32x4 e0 = *(const u32x4*)(EID + (size_t)t * 128 + i16), e1 = *(const u32x4*)(EID + (size_t)t * 128 + i16 + 8);
        xrA0 = *(const u32x4*)(XB + (size_t)t * DM + 128 * x + 16 * c); xrA1 = *(const u32x4*)(XB + (size_t)t * DM + 128 * x + 16 * c + 8);
        const int tn = (t + step < TOK) ? t + step : t;
        evB0 = *(const u32x4*)(EID + (size_t)tn * 128 + i16); evB1 = *(const u32x4*)(EID + (size_t)tn * 128 + i16 + 8);
        xrB0 = *(const u32x4*)(XB + (size_t)tn * DM + 128 * x + 16 * c); xrB1 = *(const u32x4*)(XB + (size_t)tn * DM + 128 * x + 16 * c + 8);
        asm volatile("s_waitcnt vmcnt(0)" : "+v"(evB0), "+v"(evB1), "+v"(xrA0), "+v"(xrA1), "+v"(xrB0), "+v"(xrB1) :: "memory");
#pragma unroll
        for (int w = 0; w < 16; ++w) { const unsigned char* rp = tab + (size_t)PEER_E(e0, e1, w) * 128; GLD16(uw[w], rp); } }
#pragma unroll 1
    for (; t < TOK; t += step) {
        const int tnn = (t + 2 * step < TOK) ? t + 2 * step : t;
        u32x4 evC0, evC1, xrC0, xrC1;
        { const unsigned short* ep = EID + (size_t)tnn * 128 + i16; const bf16_t* xp = XB + (size_t)tnn * DM + 128 * x + 16 * c;
          GLD16(evC0, ep); GLD16(evC1, ep + 8); GLD16(xrC0, xp); GLD16(xrC1, xp + 8); }
        unsigned xq[4];
        { const float sx = row_scale(rsp, rsmode, t) * I8_SX;
#pragma unroll
          for (int k = 0; k < 4; ++k) { const unsigned w = (k < 2 ? xrA0 : xrA1)[2 * (k & 1)], w2 = (k < 2 ? xrA0 : xrA1)[2 * (k & 1) + 1];
              int q0 = __float2int_rn(bf_lo(w) * sx), q1 = __float2int_rn(bf_hi(w) * sx), q2 = __float2int_rn(bf_lo(w2) * sx), q3 = __float2int_rn(bf_hi(w2) * sx);
              q0 = q0 < -127 ? -127 : (q0 > 127 ? 127 : q0); q1 = q1 < -127 ? -127 : (q1 > 127 ? 127 : q1); q2 = q2 < -127 ? -127 : (q2 > 127 ? 127 : q2); q3 = q3 < -127 ? -127 : (q3 > 127 ? 127 : q3);
              xq[k] = ((unsigned)q0 & 0xffu) | (((unsigned)q1 & 0xffu) << 8) | (((unsigned)q2 & 0xffu) << 16) | ((unsigned)q3 << 24); } }
        int r_lo = 0, r_hi = 0;
#pragma unroll
        for (int w = 0; w < 16; ++w) {
            asm volatile("s_waitcnt vmcnt(19)" : "+v"(uw[w]) :: "memory");
            int p = __builtin_amdgcn_sdot4((int)uw[w][0], (int)xq[0], 0, false); int p2 = __builtin_amdgcn_sdot4((int)uw[w][1], (int)xq[1], 0, false);
            p = __builtin_amdgcn_sdot4((int)uw[w][2], (int)xq[2], p, false); p2 = __builtin_amdgcn_sdot4((int)uw[w][3], (int)xq[3], p2, false);
            p += p2;
            p += __builtin_amdgcn_update_dpp(0, p, 0xB1, 0xf, 0xf, true); p += __builtin_amdgcn_update_dpp(0, p, 0x4E, 0xf, 0xf, true); p += __builtin_amdgcn_update_dpp(0, p, 0x141, 0xf, 0xf, true);
            if (w < 8) r_lo = (c == w) ? p : r_lo; else r_hi = (c == (w & 7)) ? p : r_hi;
            { const unsigned char* rp = tab + (size_t)PEER_E(evB0, evB1, w) * 128; GLD16(uw[w], rp); }
            }
        float* dst = PREP + ((size_t)x * TOK + t) * 128 + i16 + c; dst[0] = (float)r_lo * (1.f / (I8_SU * I8_SX)); dst[8] = (float)r_hi * (1.f / (I8_SU * I8_SX));
        asm volatile("s_waitcnt vmcnt(16)" : "+v"(evC0), "+v"(evC1), "+v"(xrC0), "+v"(xrC1) :: "memory");
        evB0 = evC0; evB1 = evC1; xrA0 = xrB0; xrA1 = xrB1; xrB0 = xrC0; xrB1 = xrC1;
    }
    asm volatile("s_waitcnt vmcnt(0)" ::: "memory");
}
__device__ __forceinline__ void phase_peer_c(Frame& F, const float* PREP, const float* rsp, int rsmode, const float* GATE, bf16_t* ACO) {
    const int gw = F.vcu * NWAVES + F.wave, NGW = F.G * NWAVES, lane = opaque_i(F.lane);
    for (int t = gw; t < TOK; t += NGW) {
        float s0 = 0.f, s1 = 0.f;
#pragma unroll
        for (int x = 0; x < 8; ++x) { const float* p = PREP + ((size_t)x * TOK + t) * 128; s0 += p[lane]; s1 += p[64 + lane]; }
        const float rsu = 1.f;
        { const _Float16 h0 = (_Float16)(gelu_erf(s0 * rsu) * GATE[(size_t)t * 128 + lane] * (1.f / FP8_SV)), h1 = (_Float16)(gelu_erf(s1 * rsu) * GATE[(size_t)t * 128 + 64 + lane] * (1.f / FP8_SV));
          ACO[(size_t)t * 128 + lane] = __builtin_bit_cast(unsigned short, h0); ACO[(size_t)t * 128 + 64 + lane] = __builtin_bit_cast(unsigned short, h1); }
    }
}
#define PIN16(o_) asm volatile("" : "+v"(o_[0]), "+v"(o_[1]), "+v"(o_[2]), "+v"(o_[3]), "+v"(o_[4]), "+v"(o_[5]), "+v"(o_[6]), "+v"(o_[7]), "+v"(o_[8]), "+v"(o_[9]), "+v"(o_[10]), "+v"(o_[11]), "+v"(o_[12]), "+v"(o_[13]), "+v"(o_[14]), "+v"(o_[15]))
__device__ __forceinline__ void phase_peer_v(Frame& F, bf16_t* XB, const unsigned short* EID, const bf16_t* ACO, const unsigned char* V8S, float* SSQP) {
    const int lane = opaque_i(F.lane), i16 = (lane >> 3) * 16, c = lane & 7, b = (int)blockIdx.x, x = b & 7, step = (F.G >> 3) * NWAVES;
    const unsigned char* tab = V8S + (size_t)x * NEXP * 128 + 16 * c;
    const bool b5 = lane & 32, b4 = lane & 16, b3 = lane & 8;
    const int col = 128 * x + 16 * c + (b5 ? 8 : 0) + (b4 ? 4 : 0) + (b3 ? 2 : 0);
    int t = (b >> 3) * NWAVES + F.wave;
    u32x4 evB0, evB1, aA0, aA1, vw[16]; unsigned xfA;
    {   const u32x4 e0 = *(const u32x4*)(EID + (size_t)t * 128 + i16), e1 = *(const u32x4*)(EID + (size_t)t * 128 + i16 + 8);
        aA0 = *(const u32x4*)(ACO + (size_t)t * 128 + i16); aA1 = *(const u32x4*)(ACO + (size_t)t * 128 + i16 + 8);
        xfA = *(const unsigned*)(XB + (size_t)t * DM + col);
        const int tn = (t + step < TOK) ? t + step : t;
        evB0 = *(const u32x4*)(EID + (size_t)tn * 128 + i16); evB1 = *(const u32x4*)(EID + (size_t)tn * 128 + i16 + 8);
#pragma unroll
        for (int w = 0; w < 16; ++w) vw[w] = *(const u32x4*)(tab + (size_t)PEER_E(e0, e1, w) * 128); }
#pragma unroll 1
    for (; t < TOK; t += step) {
        const int tn = (t + step < TOK) ? t + step : t, tnn = (t + 2 * step < TOK) ? t + 2 * step : t;
        const u32x4 evC0 = *(const u32x4*)(EID + (size_t)tnn * 128 + i16), evC1 = *(const u32x4*)(EID + (size_t)tnn * 128 + i16 + 8);
        const u32x4 aB0 = *(const u32x4*)(ACO + (size_t)tn * 128 + i16), aB1 = *(const u32x4*)(ACO + (size_t)tn * 128 + i16 + 8);
        const unsigned xfB = *(const unsigned*)(XB + (size_t)tn * DM + col);
        float o[16];
#pragma unroll
        for (int k = 0; k < 16; ++k) o[k] = 0.f;
#pragma unroll
        for (int w = 0; w < 16; w += 2) { const unsigned aw = (w < 8 ? aA0 : aA1)[(w & 7) >> 1]; const h16x2 a2 = __builtin_bit_cast(h16x2, aw);
#pragma unroll
            for (int k = 0; k < 4; ++k) { const unsigned r0 = vw[w][k], r1 = vw[w + 1][k];
                o[4 * k]     = __builtin_amdgcn_fdot2(__builtin_bit_cast(h16x2, __builtin_amdgcn_perm(r1, r0, 0x040c000cu)), a2, o[4 * k], false);
                o[4 * k + 1] = __builtin_amdgcn_fdot2(__builtin_bit_cast(h16x2, __builtin_amdgcn_perm(r1, r0, 0x050c010cu)), a2, o[4 * k + 1], false);
                o[4 * k + 2] = __builtin_amdgcn_fdot2(__builtin_bit_cast(h16x2, __builtin_amdgcn_perm(r1, r0, 0x060c020cu)), a2, o[4 * k + 2], false);
                o[4 * k + 3] = __builtin_amdgcn_fdot2(__builtin_bit_cast(h16x2, __builtin_amdgcn_perm(r1, r0, 0x070c030cu)), a2, o[4 * k + 3], false); }
            PIN16(o);
            vw[w] = *(const u32x4*)(tab + (size_t)PEER_E(evB0, evB1, w) * 128); vw[w + 1] = *(const u32x4*)(tab + (size_t)PEER_E(evB0, evB1, w + 1) * 128);
            __builtin_amdgcn_sched_barrier(0); }
        float h8[8], h4[4], h2[2];
#pragma unroll
        for (int k = 0; k < 8; ++k) { const auto r = __builtin_amdgcn_permlane32_swap(__float_as_uint(o[k]), __float_as_uint(o[8 + k]), false, false); h8[k] = __uint_as_float(r[0]) + __uint_as_float(r[1]); }
#pragma unroll
        for (int k = 0; k < 4; ++k) { const auto r = __builtin_amdgcn_permlane16_swap(__float_as_uint(h8[k]), __float_as_uint(h8[4 + k]), false, false); h4[k] = __uint_as_float(r[0]) + __uint_as_float(r[1]); }
#pragma unroll
        for (int k = 0; k < 2; ++k) { const float keep = b3 ? h4[2 + k] : h4[k], send = b3 ? h4[k] : h4[2 + k];
            h2[k] = keep + __builtin_bit_cast(float, __builtin_amdgcn_update_dpp(0, __builtin_bit_cast(int, send), 0x128, 0xf, 0xf, true)); }
        f32x2 f = {bf_lo(xfA) + h2[0], bf_hi(xfA) + h2[1]};
        *(unsigned*)(XB + (size_t)t * DM + col) = pk2(f.x, f.y);
        const float ss = wave_total(f.x * f.x + f.y * f.y);
        if (lane == 0) { SSQP[(size_t)t * 16 + x] = ss; SSQP[(size_t)t * 16 + 8 + x] = 0.f; }
        aA0 = aB0; aA1 = aB1; evB0 = evC0; evB1 = evC1; xfA = xfB;
    }
}
__device__ __forceinline__ void phase_final_norm(Frame& F, const bf16_t* XB, float* OUT, const float* SSQP, const float* norm_f) {
    const int gw = F.vcu * NWAVES + F.wave, NGW = F.G * NWAVES, lane = opaque_i(F.lane);
    for (int t = gw; t < TOK; t += NGW) { const float r = row_scale(SSQP, 1, t);
#pragma unroll
        for (int j = 0; j < 4; ++j) { const u32x2 w = *(const u32x2*)(XB + (size_t)t * DM + 256 * j + 4 * lane); const f32x4 x = {bf_lo(w.x), bf_hi(w.x), bf_lo(w.y), bf_hi(w.y)};
            *(f32x4*)(OUT + (size_t)t * DM + 256 * j + 4 * lane) = x * r * *(const f32x4*)(norm_f + 256 * j + 4 * lane); } }
}

constexpr int N_PHASES = 20;
struct Args { const float* in[16]; float* out; unsigned char* ws; int ph_lo, ph_hi; };
template <bool COOP>
__global__ void __launch_bounds__(NWAVES * 64, 2) mk_fwd(Args args) {
    extern __shared__ __attribute__((aligned(16))) unsigned char lds[];
    Frame F;
    F.lds = (LAS unsigned char*)lds;
    F.tid = threadIdx.x; F.lane = F.tid & 63; F.wave = __builtin_amdgcn_readfirstlane(F.tid >> 6);
    F.G = gridDim.x; { const int bx = blockIdx.x; F.vcu = (F.G % 8 == 0) ? (bx % 8) * (F.G / 8) + bx / 8 : bx; }
    Ptrs P;
    P.x = args.in[0]; P.norm_mix = args.in[1]; P.norm_ffn = args.in[2]; P.ev_w_in = args.in[3]; P.ev_b_f = args.in[4]; P.ev_w_out = args.in[5]; P.od_w_in = args.in[6];
    P.od_pool_w = args.in[7]; P.od_pool_scale = args.in[8]; P.od_w_out = args.in[9]; P.peer_wq = args.in[10]; P.peer_k1 = args.in[11]; P.peer_k2 = args.in[12];
    P.peer_u = args.in[13]; P.peer_v = args.in[14]; P.norm_f = args.in[15]; P.out = args.out; P.ws = args.ws;
    unsigned char* ws = args.ws;
    bf16_t* XB = (bf16_t*)(ws + WS_XB); bf16_t* AO = (bf16_t*)(ws + WS_AO); bf16_t* QP = (bf16_t*)(ws + WS_QP);
    unsigned short* EID = (unsigned short*)(ws + WS_EID); float* GATE = (float*)(ws + WS_GATE);
    float* RS0 = (float*)(ws + WS_RS0); float* SSQ2 = (float*)(ws + WS_SSQ2); float* PREP = (float*)(ws + WS_PREP); bf16_t* ACO = (bf16_t*)(ws + WS_ACO); float* SSQ1 = (float*)(ws + WS_SSQ1); float* SSQ3 = (float*)(ws + WS_SSQ3);
    const int lo = args.ph_lo, hi = args.ph_hi;
    volatile LAS unsigned* xbst = (volatile LAS unsigned*)(F.lds + RING_BYTES + 1024);
    if (F.tid < 4) xbst[F.tid] = 0u;
    __syncthreads();
    XcdBarrier xbar; xbar.bar = (unsigned*)(ws + WS_CTL) + 4096; xbar.x = 0; xbar.st = xbst;
    if (COOP) xbar = xcd_barrier_post((unsigned*)(ws + WS_CTL) + 4096, xbst);
#define IN(k) (lo <= (k) && (k) < hi)
#define SEAM(k) do { if (COOP && IN(k) && IN((k) + 1)) { if ((k) == 0) cg::this_grid().sync(); else xcd_barrier(xbar); } } while (0)
    if (IN(0)) { phase_p0(F, P); } SEAM(0);
    if (IN(1)) {
        pg8::Gemm g{XB, (const bf16_t*)(ws + WS_W1T), TOK, EVEN_PAD, DM}; pg8::StaticOrder S; S.init(TOK, EVEN_PAD, F.G, (int)blockIdx.x);
        EpiL0In E{RS0, (bf16_t*)(ws + WS_QH), (bf16_t*)(ws + WS_KH), (bf16_t*)(ws + WS_VT), (float*)(ws + WS_LF), P.ev_b_f};
        pg8::gemm_phase<EpiL0In, pg8::StaticOrder, true, true>(F.lds, g, S, E);
    } SEAM(1);
    if (IN(2)) { phase_cfscan(F, (const float*)(ws + WS_LF), (float*)(ws + WS_CF)); } SEAM(2);
    if (IN(3)) {
        phase_attn_fox(F, (const bf16_t*)(ws + WS_QH), (const bf16_t*)(ws + WS_KH), (const bf16_t*)(ws + WS_VT), (const float*)(ws + WS_CF), AO);
        phase_attn<1>(F, (const bf16_t*)(ws + WS_QH), (const bf16_t*)(ws + WS_KH), (const bf16_t*)(ws + WS_VT), 16, 8, nullptr, nullptr, AO, 512);
    } SEAM(3);
    if (IN(4)) {
        pg8::Gemm g{AO, (const bf16_t*)(ws + WS_W2T), TOK, DM, DM}; pg8::StaticOrder S; S.init(TOK, DM, F.G, (int)blockIdx.x);
        EpiRes<false> E{P.x, XB, SSQ1};
        pg8::gemm_phase<EpiRes<false>, pg8::StaticOrder, true, true>(F.lds, g, S, E);
    } SEAM(4);
    if (IN(5)) {
        pg8::Gemm g{XB, (const bf16_t*)(ws + WS_W3T), TOK, 2048, DM}; pg8::StaticOrder S; S.init(TOK, 2048, F.G, (int)blockIdx.x);
        EpiQ E{SSQ1, 1, QP};
        pg8::gemm_phase<EpiQ, pg8::StaticOrder, true, true>(F.lds, g, S, E);
    } SEAM(5);
    if (IN(6)) { phase_topk(F, QP, (const bf16_t*)(ws + WS_K1B), (const bf16_t*)(ws + WS_K2B), EID, GATE); } SEAM(6);
    if (IN(7)) { phase_peer_u(F, XB, SSQ1, 1, EID, ws + WS_U8S, PREP); } SEAM(7);
    if (IN(8)) { phase_peer_c(F, PREP, SSQ1, 1, GATE, ACO); } SEAM(8);
    if (IN(9)) { phase_peer_v(F, XB, EID, ACO, ws + WS_V8S, SSQ2); } SEAM(9);
    if (IN(10)) {
        pg8::Gemm g{XB, (const bf16_t*)(ws + WS_W4T), TOK, 2048, DM}; pg8::StaticOrder S; S.init(TOK, 2048, F.G, (int)blockIdx.x);
        EpiL1In E{SSQ2, 1, (bf16_t*)(ws + WS_QH), (bf16_t*)(ws + WS_QH + 32 * MiB), (bf16_t*)(ws + WS_KH), (bf16_t*)(ws + WS_KH + 32 * MiB)};
        pg8::gemm_phase<EpiL1In, pg8::StaticOrder, true, true>(F.lds, g, S, E);
    } SEAM(10);
    if (IN(11)) {
        phase_pool(F, (const bf16_t*)(ws + WS_QH), (const bf16_t*)(ws + WS_PWT), P.od_pool_scale, AO);
        phase_kmean(F, (const bf16_t*)(ws + WS_KH), (float*)(ws + WS_KMEAN));
    } SEAM(11);
    if (IN(12)) {
        phase_attn_moba(F, (const bf16_t*)(ws + WS_QH + 32 * MiB), (const bf16_t*)(ws + WS_KH), (const bf16_t*)(ws + WS_KH + 32 * MiB), (const float*)(ws + WS_KMEAN), AO);
    } SEAM(12);
    if (IN(13)) {
        pg8::Gemm g{AO, (const bf16_t*)(ws + WS_W5T), TOK, DM, DM}; pg8::StaticOrder S; S.init(TOK, DM, F.G, (int)blockIdx.x);
        EpiRes<true> E{XB, XB, SSQ3};
        pg8::gemm_phase<EpiRes<true>, pg8::StaticOrder, true, true>(F.lds, g, S, E);
    } SEAM(13);
    if (IN(14)) {
        pg8::Gemm g{XB, (const bf16_t*)(ws + WS_W6T), TOK, 2048, DM}; pg8::StaticOrder S; S.init(TOK, 2048, F.G, (int)blockIdx.x);
        EpiQ E{SSQ3, 1, QP};
        pg8::gemm_phase<EpiQ, pg8::StaticOrder, true, true>(F.lds, g, S, E);
    } SEAM(14);
    if (IN(15)) { phase_topk(F, QP, (const bf16_t*)(ws + WS_K1B) + 8 * 128 * 128, (const bf16_t*)(ws + WS_K2B) + 8 * 128 * 128, EID, GATE); } SEAM(15);
    if (IN(16)) { phase_peer_u(F, XB, SSQ3, 1, EID, ws + WS_U8S + (size_t)8 * NEXP * 128, PREP); } SEAM(16);
    if (IN(17)) { phase_peer_c(F, PREP, SSQ3, 1, GATE, ACO); } SEAM(17);
    if (IN(18)) { phase_peer_v(F, XB, EID, ACO, ws + WS_V8S + (size_t)8 * NEXP * 128, SSQ2); } SEAM(18);
    if (IN(19)) { phase_final_norm(F, XB, P.out, SSQ2, P.norm_f); }
#undef IN
#undef SEAM
}

extern "C" void kernel_launch(void* const* d_in, const int* in_sizes, int n_in, void* d_out, int out_size, void* d_ws, size_t ws_size, hipStream_t stream) {
    static int grid = 0;
    constexpr bool COOP = (MK_MULTI == 0);
    if (grid == 0) {
        if (n_in != 16 || in_sizes[0] != TOK * DM || out_size != TOK * DM || ws_size < WS_END) { fprintf(stderr, "kernel_launch: unexpected shapes (n_in %d, in0 %d, out %d, ws %zu)\n", n_in, n_in > 0 ? in_sizes[0] : -1, out_size, ws_size); grid = -1; return; }
        int dev = 0, cus = 0, per_cu = 0;
        if (hipGetDevice(&dev) != hipSuccess || hipDeviceGetAttribute(&cus, hipDeviceAttributeMultiprocessorCount, dev) != hipSuccess) { grid = -1; return; }
        if (hipFuncSetAttribute((const void*)mk_fwd<COOP>, hipFuncAttributeMaxDynamicSharedMemorySize, LDS_BYTES) != hipSuccess) { fprintf(stderr, "kernel_launch: hipFuncSetAttribute failed\n"); grid = -1; return; }
        if (hipOccupancyMaxActiveBlocksPerMultiprocessor(&per_cu, (const void*)mk_fwd<COOP>, NWAVES * 64, LDS_BYTES) != hipSuccess || per_cu < 1) { fprintf(stderr, "kernel_launch: occupancy query says %d\n", per_cu); per_cu = 1; }
        (void)hipGetLastError();
        grid = cus;
    }
    if (grid < 0) return;
    if (hipMemsetAsync((char*)d_ws + WS_CTL, 0, CTL_ZERO_BYTES, stream) != hipSuccess) { fprintf(stderr, "kernel_launch: memset failed\n"); return; }
    Args a{};
    for (int i = 0; i < 16; ++i) a.in[i] = (const float*)d_in[i];
    a.out = (float*)d_out; a.ws = (unsigned char*)d_ws;
    if (COOP) {
        a.ph_lo = 0; a.ph_hi = N_PHASES;
        void* kargs[] = {&a};
        const hipError_t e = hipLaunchCooperativeKernel((const void*)mk_fwd<COOP>, dim3(grid), dim3(NWAVES * 64), kargs, LDS_BYTES, stream);
        if (e != hipSuccess) fprintf(stderr, "kernel_launch: cooperative launch failed: %s (grid %d)\n", hipGetErrorString(e), grid);
    } else {
        for (int p = 0; p < N_PHASES; ++p) { a.ph_lo = p; a.ph_hi = p + 1; hipLaunchKernelGGL(mk_fwd<COOP>, dim3(grid), dim3(NWAVES * 64), LDS_BYTES, stream, a); }
    }
}
```

```cpp
#include <hip/hip_runtime.h>
#include <hip/hip_cooperative_groups.h>
#include <cstdio>
#include <cstdint>
#include <cmath>
namespace cg = cooperative_groups;

#ifndef MK_MULTI
#define MK_MULTI 0
#endif

namespace pg8 {
#define PG8_LAS __attribute__((address_space(3)))
typedef unsigned short bf16_t;
typedef short bf16x8 __attribute__((ext_vector_type(8)));
typedef float f32x4 __attribute__((ext_vector_type(4)));
typedef unsigned u32x4 __attribute__((ext_vector_type(4)));
constexpr int BM = 256, BK = 64, HALF = 128, HTB = HALF * BK * 2  , STAGE_BYTES = 8 * HTB, NXCD = 8, WGM = 8;

__host__ __device__ __forceinline__ int lds_byte(int r, int c) { const int st = (r >> 4) * 2 + (c >> 5), rr = r & 15, cc = c & 31, ob = rr * 64 + cc * 2; return st * 1024 + (ob ^ (((ob >> 9) & 1) << 5)); }
__host__ __device__ __forceinline__ void stage_rc(int b, int& R, int& C) { const int st = b / 1024, sb = b % 1024, swz = sb ^ (((sb >> 9) & 1) << 5); R = (st >> 1) * 16 + swz / 64; C = (st & 1) * 32 + (swz % 64) / 2; }
__host__ __device__ __forceinline__ int perm32(int rho) { const int n = rho >> 4, i = rho & 15; return 8 * (i >> 2) + 4 * n + (i & 3); }

struct Unit { int pm, pn; };
struct Gemm { const bf16_t* A; const bf16_t* Bt; int M, N, K; };

struct StaticOrder {
    int nM, nN, nwg, G, c;
    __host__ __device__ void init(int M, int N, int G_, int c_) { nM = M / BM; nN = N / BM; nwg = nM * nN; G = G_; c = c_; }
    __host__ __device__ bool next(int i, Unit& u) const {
        const long L = (long)i * G + c; if (L >= nwg) return false;
        int wgid = (int)L; { const int q = nwg / NXCD, r = nwg % NXCD, xcd = wgid % NXCD, off = wgid / NXCD; wgid = (xcd < r ? xcd * (q + 1) : r * (q + 1) + (xcd - r) * q) + off; }
        const int nig = WGM * nN, gid = wgid / nig, fm = gid * WGM, gsz = (nM - fm) < WGM ? (nM - fm) : WGM;
        u.pm = fm + ((wgid % nig) % gsz); u.pn = (wgid % nig) / gsz; return true;
    }
    __device__ __forceinline__ void a_ready(const Unit&) const {}
    __device__ __forceinline__ void done(const Unit&) const {}
};
__device__ __forceinline__ unsigned cvt_pk_bf16(float lo, float hi) { unsigned r; asm volatile("v_cvt_pk_bf16_f32 %0, %1, %2" : "=v"(r) : "v"(lo), "v"(hi)); return r; }
template <class Epi, class Sched, bool ALIGN_EPI = false, bool SP2 = false>
__device__ __forceinline__ void gemm_phase(PG8_LAS unsigned char* lds, const Gemm g, const Sched& S, const Epi& E) {
    const int tid = threadIdx.x, wid = __builtin_amdgcn_readfirstlane(tid >> 6), lane = tid & 63, wr = wid >> 2, wc = wid & 3, fr = lane & 15, fq = lane >> 4;
    const int K = g.K, nt = K / BK;
    unsigned voffA[2], voffB[2];
#pragma unroll
    for (int i = 0; i < 2; ++i) { int R, C; stage_rc(tid * 16 + i * 8192, R, C); const int Rb = Epi::PERM ? ((R & ~31) + perm32(R & 31)) : R;
        voffA[i] = (unsigned)(R * K + C) * 2u; voffB[i] = (unsigned)(Rb * K + C) * 2u; }
    const size_t kstep = (size_t)(BK * 2);
    const size_t hstep = (size_t)HALF * K * 2;
    const size_t tstep = 2 * hstep;
    const unsigned ldsw = (unsigned)wid * 1024u;
    const int aoff = lds_byte(wr * 64 + fr, fq * 8), boff = lds_byte(wc * 32 + fr, fq * 8);
#define PG8_SA(b, h) (((b) * 2 + (h)) * HTB)
#define PG8_SB(b, h) ((4 + (b) * 2 + (h)) * HTB)
#define PG8_STAGE(bufoff, gbase, voff) do { _Pragma("unroll") for (int _i = 0; _i < 2; ++_i) \
        __builtin_amdgcn_global_load_lds((const unsigned*)((const char*)(gbase) + (voff)[_i]), (PG8_LAS unsigned*)(lds + (bufoff) + ldsw + _i * 8192), 16, 0, 0); } while (0)
#define PG8_LDA(dst, b, h) do { _Pragma("unroll") for (int m = 0; m < 4; ++m) _Pragma("unroll") for (int k = 0; k < 2; ++k) dst[m][k] = *(const PG8_LAS bf16x8*)(lds + PG8_SA(b, h) + aoff + m * 2048 + k * 1024); } while (0)
#define PG8_LDB(dst, b, h) do { _Pragma("unroll") for (int n = 0; n < 2; ++n) _Pragma("unroll") for (int k = 0; k < 2; ++k) dst[n][k] = *(const PG8_LAS bf16x8*)(lds + PG8_SB(b, h) + boff + n * 2048 + k * 1024); } while (0)
#define PG8_MMA(ai, bj, At, Bt) do { __builtin_amdgcn_s_setprio(1); _Pragma("unroll") for (int m = 0; m < 4; ++m) _Pragma("unroll") for (int n = 0; n < 2; ++n) _Pragma("unroll") for (int k = 0; k < 2; ++k) \
        acc[ai][bj][m][n] = __builtin_amdgcn_mfma_f32_16x16x32_bf16(Bt[n][k], At[m][k], acc[ai][bj][m][n], 0, 0, 0); __builtin_amdgcn_s_setprio(0); } while (0)
#define PG8_WAIT_V(n) asm volatile("s_waitcnt vmcnt(" #n ")" ::: "memory")
#define PG8_WAIT_L(n) asm volatile("s_waitcnt lgkmcnt(" #n ")" ::: "memory")
#define PG8_BAR __builtin_amdgcn_s_barrier()
#define PG8_SCHED __builtin_amdgcn_sched_barrier(0)
    Unit cur, nxt; int ui = 0;
    if (!S.next(0, cur)) return;
    f32x4 acc[2][2][4][2];
#pragma unroll
    for (int a = 0; a < 2; ++a)
#pragma unroll
        for (int b = 0; b < 2; ++b)
#pragma unroll
            for (int m = 0; m < 4; ++m)
#pragma unroll
                for (int n = 0; n < 2; ++n) acc[a][b][m][n] = (f32x4){0.f, 0.f, 0.f, 0.f};
    bf16x8 At[4][2], B0[2][2], B1[2][2];
    const char* cA = (const char*)g.A + (size_t)cur.pm * tstep; const char* cB = (const char*)g.Bt + (size_t)cur.pn * tstep;
    S.a_ready(cur);
    if constexpr (SP2) {
        PG8_STAGE(PG8_SB(0, 0), cB, voffB); PG8_STAGE(PG8_SB(0, 1), cB + hstep, voffB); PG8_STAGE(PG8_SA(0, 0), cA, voffA); PG8_STAGE(PG8_SA(0, 1), cA + hstep, voffA);
        if (wr == 1) PG8_BAR;
        PG8_WAIT_V(2); PG8_BAR;
        PG8_STAGE(PG8_SB(1, 0), cB + kstep, voffB); PG8_STAGE(PG8_SA(1, 0), cA + kstep, voffA); PG8_STAGE(PG8_SB(1, 1), cB + hstep + kstep, voffB);
        PG8_WAIT_V(6); PG8_BAR;
    } else {
        PG8_STAGE(PG8_SB(0, 0), cB, voffB); PG8_STAGE(PG8_SA(0, 0), cA, voffA); PG8_STAGE(PG8_SB(0, 1), cB + hstep, voffB); PG8_STAGE(PG8_SA(0, 1), cA + hstep, voffA);
        if (wr == 1) PG8_BAR;
        PG8_WAIT_V(4); PG8_BAR;
        PG8_STAGE(PG8_SB(1, 0), cB + kstep, voffB); PG8_STAGE(PG8_SA(1, 0), cA + kstep, voffA); PG8_STAGE(PG8_SB(1, 1), cB + hstep + kstep, voffB);
        PG8_WAIT_V(6); PG8_BAR;
    }
    for (;;) {
        const bool has_next = S.next(ui + 1, nxt);
        const char* nA = has_next ? (const char*)g.A + (size_t)nxt.pm * tstep : cA; const char* nB = has_next ? (const char*)g.Bt + (size_t)nxt.pn * tstep : cB;
        for (int t = 0; t < nt; t += 2) {
            const bool last = (t == nt - 2);
            const char* a1 = cA + (size_t)(t + 1) * kstep;
            const char* a2 = last ? nA : cA + (size_t)(t + 2) * kstep; const char* b2 = last ? nB : cB + (size_t)(t + 2) * kstep;
            const char* a3 = a2 + kstep; const char* b3 = b2 + kstep;
            if (last && has_next) S.a_ready(nxt);
            if constexpr (SP2) {
            PG8_LDB(B0, 0, 0); PG8_LDB(B1, 0, 1); PG8_SCHED; PG8_LDA(At, 0, 0); PG8_STAGE(PG8_SA(1, 1), a1 + hstep, voffA);
            PG8_WAIT_V(8); PG8_WAIT_L(0); PG8_BAR; PG8_MMA(0, 0, At, B0); PG8_MMA(0, 1, At, B1); PG8_BAR; PG8_SCHED;
            PG8_LDA(At, 0, 1); PG8_STAGE(PG8_SB(0, 0), b2, voffB); PG8_STAGE(PG8_SB(0, 1), b2 + hstep, voffB); PG8_STAGE(PG8_SA(0, 0), a2, voffA);
            PG8_WAIT_V(8); PG8_WAIT_L(0); PG8_BAR; PG8_MMA(1, 0, At, B0); PG8_MMA(1, 1, At, B1); PG8_BAR; PG8_SCHED;
            PG8_LDB(B0, 1, 0); PG8_LDB(B1, 1, 1); PG8_SCHED; PG8_LDA(At, 1, 0); PG8_STAGE(PG8_SA(0, 1), a2 + hstep, voffA);
            PG8_WAIT_V(8); PG8_WAIT_L(0); PG8_BAR; PG8_MMA(0, 0, At, B0); PG8_MMA(0, 1, At, B1); PG8_BAR; PG8_SCHED;
            PG8_LDA(At, 1, 1); PG8_STAGE(PG8_SB(1, 0), b3, voffB); PG8_STAGE(PG8_SB(1, 1), b3 + hstep, voffB); PG8_STAGE(PG8_SA(1, 0), a3, voffA);
            PG8_WAIT_V(8); PG8_WAIT_L(0); PG8_BAR; PG8_MMA(1, 0, At, B0); PG8_MMA(1, 1, At, B1); PG8_BAR; PG8_SCHED;
            } else {
            PG8_LDB(B0, 0, 0); PG8_SCHED; PG8_LDA(At, 0, 0); PG8_STAGE(PG8_SA(1, 1), a1 + hstep, voffA);
            PG8_WAIT_L(8); PG8_BAR; PG8_WAIT_L(0); PG8_MMA(0, 0, At, B0); PG8_BAR; PG8_SCHED;
            PG8_LDB(B1, 0, 1); PG8_STAGE(PG8_SB(0, 0), b2, voffB);
            PG8_BAR; PG8_WAIT_L(0); PG8_MMA(0, 1, At, B1); PG8_BAR;
            PG8_LDA(At, 0, 1); PG8_STAGE(PG8_SA(0, 0), a2, voffA);
            PG8_BAR; PG8_WAIT_L(0); PG8_MMA(1, 0, At, B0); PG8_BAR; PG8_SCHED;
            PG8_STAGE(PG8_SB(0, 1), b2 + hstep, voffB);
            PG8_WAIT_V(6); PG8_BAR; PG8_MMA(1, 1, At, B1); PG8_BAR;
            PG8_LDB(B0, 1, 0); PG8_SCHED; PG8_LDA(At, 1, 0); PG8_STAGE(PG8_SA(0, 1), a2 + hstep, voffA);
            PG8_WAIT_L(8); PG8_BAR; PG8_WAIT_L(0); PG8_MMA(0, 0, At, B0); PG8_BAR; PG8_SCHED;
            PG8_LDB(B1, 1, 1); PG8_STAGE(PG8_SB(1, 0), b3, voffB);
            PG8_BAR; PG8_WAIT_L(0); PG8_MMA(0, 1, At, B1); PG8_BAR;
            PG8_LDA(At, 1, 1); PG8_STAGE(PG8_SA(1, 0), a3, voffA);
            PG8_BAR; PG8_WAIT_L(0); PG8_MMA(1, 0, At, B0); PG8_BAR; PG8_SCHED;
            PG8_STAGE(PG8_SB(1, 1), b3 + hstep, voffB);
            PG8_WAIT_V(6); PG8_BAR; PG8_MMA(1, 1, At, B1); PG8_BAR;
            }
        }
        if constexpr (ALIGN_EPI) { if (wr == 0) PG8_BAR; }
        if constexpr (!Epi::AFTER_DRAIN) { E(acc, cur, wr, wc, fr, fq); S.done(cur); }
        if (!has_next) break;
#pragma unroll
        for (int a = 0; a < 2; ++a)
#pragma unroll
            for (int b = 0; b < 2; ++b)
#pragma unroll
                for (int m = 0; m < 4; ++m)
#pragma unroll
                    for (int n = 0; n < 2; ++n) acc[a][b][m][n] = (f32x4){0.f, 0.f, 0.f, 0.f};
        cur = nxt; cA = nA; cB = nB; ++ui;
        if constexpr (ALIGN_EPI) { if (wr == 1) PG8_BAR; }
    }
    PG8_WAIT_V(0);
    if constexpr (!ALIGN_EPI) { if (wr == 0) PG8_BAR; }
    PG8_BAR;
    if constexpr (Epi::AFTER_DRAIN) { E.fused(acc, cur, wr, wc, fr, fq, lds, wid, lane); S.done(cur); }
#undef PG8_SA
#undef PG8_SB
#undef PG8_STAGE
#undef PG8_LDA
#undef PG8_LDB
#undef PG8_MMA
#undef PG8_WAIT_V
#undef PG8_WAIT_L
#undef PG8_BAR
#undef PG8_SCHED
}
}

constexpr int NB = 16, SEQ = 2048, DM = 1024, TOK = NB * SEQ;
constexpr int EVEN_IN = 3080, EVEN_PAD = 3328;
constexpr int NEXP = 16384;
constexpr float RMS_EPS = 1e-6f;
constexpr float LOG2E = 1.4426950408889634f;
constexpr float C2 = 0.125f * LOG2E;

constexpr size_t MiB = 1u << 20;
constexpr size_t WS_CTL = 0, CTL_ZERO_BYTES = 1 * MiB;
constexpr size_t WS_W1T = 1 * MiB;
constexpr size_t WS_W2T = 8 * MiB;
constexpr size_t WS_W4T = 10 * MiB;
constexpr size_t WS_W5T = 14 * MiB;
constexpr size_t WS_W3T = 16 * MiB;
constexpr size_t WS_W6T = 20 * MiB;
constexpr size_t WS_K1B = 24 * MiB;
constexpr size_t WS_K2B = 24 * MiB + 512 * 1024;
constexpr size_t WS_PWT = 25 * MiB;
constexpr size_t WS_LF  = 25 * MiB + 256 * 1024;
constexpr size_t WS_CF  = 26 * MiB + 256 * 1024;
constexpr size_t WS_KMEAN = 27 * MiB + 256 * 1024;
constexpr size_t WS_RS0 = 27 * MiB + 512 * 1024;
constexpr size_t WS_RS2 = 27 * MiB + 640 * 1024;
constexpr size_t WS_SSQ1 = 28 * MiB;
constexpr size_t WS_SSQ3 = 30 * MiB;
constexpr size_t WS_U8S = 32 * MiB;
constexpr size_t WS_V8S = 64 * MiB;
constexpr size_t WS_XB = 160 * MiB;
constexpr size_t WS_QH = 224 * MiB;
constexpr size_t WS_KH = 288 * MiB;
constexpr size_t WS_VT = 352 * MiB;
constexpr size_t WS_QP = 224 * MiB;
constexpr size_t WS_AO = 416 * MiB;
constexpr size_t WS_EID = 480 * MiB;
constexpr size_t WS_GATE = 488 * MiB;
constexpr size_t WS_SSQ2 = 504 * MiB;
constexpr size_t WS_PREP = 224 * MiB;
constexpr size_t WS_ACO = 416 * MiB;
constexpr size_t WS_END = 506 * MiB;

constexpr int RING_BYTES = 131072;
constexpr int LDS_BYTES = 147456;
constexpr int NWAVES = 8;

#define GAS __attribute__((address_space(1)))
#define LAS __attribute__((address_space(3)))
typedef unsigned short bf16_t;
typedef unsigned u32x4 __attribute__((ext_vector_type(4)));
typedef unsigned u32x2 __attribute__((ext_vector_type(2)));
typedef float f32x4 __attribute__((ext_vector_type(4)));
typedef float f32x16 __attribute__((ext_vector_type(16)));
typedef short bf16x8 __attribute__((ext_vector_type(8)));
typedef __bf16 bf16x2 __attribute__((ext_vector_type(2)));
#define LDS_WAIT() asm volatile("s_waitcnt lgkmcnt(0)" ::: "memory")

__device__ __forceinline__ int opaque_i(int v) { asm volatile("" : "+v"(v)); return v; }
__device__ __forceinline__ unsigned f2bf(float f) { unsigned u = __builtin_bit_cast(unsigned, f); return (u + 0x7fffu + ((u >> 16) & 1u)) >> 16; }
typedef float f32x2_pk __attribute__((ext_vector_type(2)));
__device__ __forceinline__ unsigned pk2(float lo, float hi) { const f32x2_pk v = {lo, hi}; return __builtin_bit_cast(unsigned, __builtin_convertvector(v, bf16x2)); }
__device__ __forceinline__ float bf_lo(unsigned u) { return __uint_as_float(u << 16); }
__device__ __forceinline__ float bf_hi(unsigned u) { return __uint_as_float(u & 0xffff0000u); }
__device__ __forceinline__ float dot2(unsigned a, unsigned b, float acc) { return __builtin_amdgcn_fdot2_f32_bf16(__builtin_bit_cast(bf16x2, a), __builtin_bit_cast(bf16x2, b), acc, false); }
__device__ __forceinline__ float dot8(u32x4 a, u32x4 b, float acc) { acc = dot2(a.x, b.x, acc); acc = dot2(a.y, b.y, acc); acc = dot2(a.z, b.z, acc); return dot2(a.w, b.w, acc); }
__device__ __forceinline__ u32x4 pack8(f32x4 a, f32x4 b) { u32x4 w; w.x = pk2(a[0], a[1]); w.y = pk2(a[2], a[3]); w.z = pk2(b[0], b[1]); w.w = pk2(b[2], b[3]); return w; }

__device__ __forceinline__ float wave_sum(float v) {
#pragma unroll
    for (int o = 1; o < 64; o <<= 1) v += __shfl_xor(v, o);
    return v;
}
__device__ __forceinline__ float wave_max(float v) {
#pragma unroll
    for (int o = 1; o < 64; o <<= 1) v = fmaxf(v, __shfl_xor(v, o));
    return v;
}
__device__ __forceinline__ unsigned wave_umax(unsigned v) {
#pragma unroll
    for (int o = 1; o < 64; o <<= 1) { const unsigned w = (unsigned)__shfl_xor((int)v, o); v = v > w ? v : w; }
    return v;
}
__device__ __forceinline__ float dpp_row_shr(float v, int n) {
    const int iv = __builtin_bit_cast(int, v); int r;
    switch (n) { case 1: r = __builtin_amdgcn_update_dpp(0, iv, 0x111, 0xf, 0xf, true); break; case 2: r = __builtin_amdgcn_update_dpp(0, iv, 0x112, 0xf, 0xf, true); break;
                 case 4: r = __builtin_amdgcn_update_dpp(0, iv, 0x114, 0xf, 0xf, true); break; default: r = __builtin_amdgcn_update_dpp(0, iv, 0x118, 0xf, 0xf, true); break; }
    return __builtin_bit_cast(float, r);
}
__device__ __forceinline__ float wave_total(float v) {
    v += dpp_row_shr(v, 1); v += dpp_row_shr(v, 2); v += dpp_row_shr(v, 4); v += dpp_row_shr(v, 8);
    v += __builtin_bit_cast(float, __builtin_amdgcn_update_dpp(0, __builtin_bit_cast(int, v), 0x142, 0xa, 0xf, false));
    v += __builtin_bit_cast(float, __builtin_amdgcn_update_dpp(0, __builtin_bit_cast(int, v), 0x143, 0xc, 0xf, false));
    return __builtin_bit_cast(float, __builtin_amdgcn_readlane(__builtin_bit_cast(int, v), 63));
}
__device__ __forceinline__ unsigned f2ord(float f) { const unsigned u = __float_as_uint(f); return (u & 0x80000000u) ? ~u : (u | 0x80000000u); }
__device__ __forceinline__ float ord2f(unsigned o) { const unsigned u = (o & 0x80000000u) ? (o & 0x7fffffffu) : ~o; return __uint_as_float(u); }

__device__ __forceinline__ float row_scale(const float* p, int mode, int t) {
    if (mode == 0) return p[t];
    const f32x4* q = (const f32x4*)(p + (size_t)t * 16); const f32x4 a = q[0], b = q[1], c = q[2], d = q[3];
    const float s = (((a[0] + a[1]) + (a[2] + a[3])) + ((b[0] + b[1]) + (b[2] + b[3]))) + (((c[0] + c[1]) + (c[2] + c[3])) + ((d[0] + d[1]) + (d[2] + d[3])));
    return rsqrtf(s * (1.f / DM) + RMS_EPS);
}

struct EpiL0In {
    static constexpr bool PERM = true, AFTER_DRAIN = false;
    const float* rs; bf16_t* QH; bf16_t* KH; bf16_t* VT; float* LF; const float* b_f;
    __device__ __forceinline__ void operator()(const f32x4 (&acc)[2][2][4][2], const pg8::Unit& u, int wr, int wc, int fr, int fq) const {
        const int pn = u.pn;
        if (pn == 12) {
            if (wc == 0 && fq == 0) {
#pragma unroll
                for (int ai = 0; ai < 2; ++ai)
#pragma unroll
                    for (int m = 0; m < 4; ++m) {
                        const int t = u.pm * 256 + ai * 128 + wr * 64 + m * 16 + fr; const float sc = rs[t]; const int b = t >> 11, s = t & 2047;
#pragma unroll
                        for (int n = 0; n < 2; ++n)
#pragma unroll
                            for (int e = 0; e < 4; ++e) { const int h = n * 4 + e; const float x = acc[ai][0][m][n][e] * sc + b_f[h];
                                const float ls = fminf(x, 0.f) - log1pf(expf(-fabsf(x)));
                                LF[(size_t)(b * 8 + h) * 2048 + s] = ls * LOG2E; }
                    }
            }
            return;
        }
        const int sec = pn >> 1, kind = sec % 3, hbase = (sec >= 3) ? 8 : 0;
#pragma unroll
        for (int ai = 0; ai < 2; ++ai)
#pragma unroll
            for (int m = 0; m < 4; ++m) {
                const int t = u.pm * 256 + ai * 128 + wr * 64 + m * 16 + fr; const int b = t >> 11, s = t & 2047;
                const float sc = rs[t] * (kind == 0 ? C2 : 1.f);
#pragma unroll
                for (int bj = 0; bj < 2; ++bj) {
                    const int cc = (pn & 1) * 256 + bj * 128 + wc * 32 + fq * 8, hh = hbase + (cc >> 6), d0 = cc & 63;
                    const f32x4 v0 = acc[ai][bj][m][0] * sc, v1 = acc[ai][bj][m][1] * sc;
                    if (kind < 2) { bf16_t* dst = (kind == 0 ? QH : KH) + ((size_t)(b * 16 + hh) * 2048 + s) * 64 + d0; *(u32x4*)dst = pack8(v0, v1); }
                    else { bf16_t* dst = VT + ((size_t)(b * 16 + hh) * 64 + d0) * 2048 + s;
                        dst[0 * 2048] = (bf16_t)f2bf(v0[0]); dst[1 * 2048] = (bf16_t)f2bf(v0[1]); dst[2 * 2048] = (bf16_t)f2bf(v0[2]); dst[3 * 2048] = (bf16_t)f2bf(v0[3]);
                        dst[4 * 2048] = (bf16_t)f2bf(v1[0]); dst[5 * 2048] = (bf16_t)f2bf(v1[1]); dst[6 * 2048] = (bf16_t)f2bf(v1[2]); dst[7 * 2048] = (bf16_t)f2bf(v1[3]); }
                }
            }
    }
};
struct EpiL1In {
    static constexpr bool PERM = true, AFTER_DRAIN = false;
    const float* rsp; int rsmode; bf16_t* XC; bf16_t* QD; bf16_t* KD; bf16_t* VTD;
    __device__ __forceinline__ void operator()(const f32x4 (&acc)[2][2][4][2], const pg8::Unit& u, int wr, int wc, int fr, int fq) const {
        const int pn = u.pn, kind = pn >> 1;
#pragma unroll
        for (int ai = 0; ai < 2; ++ai)
#pragma unroll
            for (int m = 0; m < 4; ++m) {
                const int t = u.pm * 256 + ai * 128 + wr * 64 + m * 16 + fr; const int b = t >> 11, s = t & 2047;
                const float sc = row_scale(rsp, rsmode, t) * (kind == 1 ? C2 : 1.f);
#pragma unroll
                for (int bj = 0; bj < 2; ++bj) {
                    const int cc = (pn & 1) * 256 + bj * 128 + wc * 32 + fq * 8, hh = cc >> 6, d0 = cc & 63;
                    const f32x4 v0 = acc[ai][bj][m][0] * sc, v1 = acc[ai][bj][m][1] * sc;
                    if (kind == 0) { *(u32x4*)(XC + (size_t)t * 512 + cc) = pack8(v0, v1); }
                    else if (kind < 3) { bf16_t* dst = (kind == 1 ? QD : KD) + ((size_t)(b * 8 + hh) * 2048 + s) * 64 + d0; *(u32x4*)dst = pack8(v0, v1); }
                    else { bf16_t* dst = VTD + ((size_t)(b * 8 + hh) * 64 + d0) * 2048 + s;
                        dst[0 * 2048] = (bf16_t)f2bf(v0[0]); dst[1 * 2048] = (bf16_t)f2bf(v0[1]); dst[2 * 2048] = (bf16_t)f2bf(v0[2]); dst[3 * 2048] = (bf16_t)f2bf(v0[3]);
                        dst[4 * 2048] = (bf16_t)f2bf(v1[0]); dst[5 * 2048] = (bf16_t)f2bf(v1[1]); dst[6 * 2048] = (bf16_t)f2bf(v1[2]); dst[7 * 2048] = (bf16_t)f2bf(v1[3]); }
                }
            }
    }
};
struct EpiQ {
    static constexpr bool PERM = true, AFTER_DRAIN = false;
    const float* rsp; int rsmode; bf16_t* Q;
    __device__ __forceinline__ void operator()(const f32x4 (&acc)[2][2][4][2], const pg8::Unit& u, int wr, int wc, int fr, int fq) const {
#pragma unroll
        for (int ai = 0; ai < 2; ++ai)
#pragma unroll
            for (int m = 0; m < 4; ++m) {
                const int t = u.pm * 256 + ai * 128 + wr * 64 + m * 16 + fr; const float sc = row_scale(rsp, rsmode, t);
#pragma unroll
                for (int bj = 0; bj < 2; ++bj) { const int c = u.pn * 256 + bj * 128 + wc * 32 + fq * 8;
                    *(u32x4*)(Q + (size_t)t * 2048 + c) = pack8(acc[ai][bj][m][0] * sc, acc[ai][bj][m][1] * sc); }
            }
    }
};
template <bool BASE_BF16>
struct EpiRes {
    static constexpr bool PERM = true, AFTER_DRAIN = false;
    const void* base; bf16_t* xb; float* ssqp;
    __device__ __forceinline__ void operator()(const f32x4 (&acc)[2][2][4][2], const pg8::Unit& u, int wr, int wc, int fr, int fq) const {
#pragma unroll
        for (int ai = 0; ai < 2; ++ai)
#pragma unroll
            for (int m = 0; m < 4; ++m) {
                const int t = u.pm * 256 + ai * 128 + wr * 64 + m * 16 + fr; float ss = 0.f;
#pragma unroll
                for (int bj = 0; bj < 2; ++bj) { const size_t off = (size_t)t * DM + u.pn * 256 + bj * 128 + wc * 32 + fq * 8;
                    f32x4 b0, b1;
                    if (BASE_BF16) { const u32x4 w = *(const u32x4*)((const bf16_t*)base + off); b0 = (f32x4){bf_lo(w.x), bf_hi(w.x), bf_lo(w.y), bf_hi(w.y)}; b1 = (f32x4){bf_lo(w.z), bf_hi(w.z), bf_lo(w.w), bf_hi(w.w)}; }
                    else { b0 = *(const f32x4*)((const float*)base + off); b1 = *(const f32x4*)((const float*)base + off + 4); }
                    const f32x4 o0 = b0 + acc[ai][bj][m][0], o1 = b1 + acc[ai][bj][m][1];
                    *(u32x4*)(xb + off) = pack8(o0, o1);
                    ss += (o0[0] * o0[0] + o0[1] * o0[1]) + (o0[2] * o0[2] + o0[3] * o0[3]) + (o1[0] * o1[0] + o1[1] * o1[1]) + (o1[2] * o1[2] + o1[3] * o1[3]); }
                ss += __shfl_xor(ss, 16); ss += __shfl_xor(ss, 32);
                if (fq == 0) ssqp[(size_t)t * 16 + u.pn * 4 + wc] = ss;
            }
    }
};

#define XB_TMO      128
#define XB_XCNT(j)  (256  + 64 * (j))
#define XB_XSUB(j)  (1280 + 64 * (j))
#define XB_XGEN(j)  (2304 + 64 * (j))
#define XB_TOP      3328
#define XB_TOPGEN   3392
#define XCD_BAR_WORDS 3456
#define XB_SPIN_CAP (1u << 18)

__device__ __forceinline__ unsigned xb_ld(unsigned* p)              { return __hip_atomic_load(p, __ATOMIC_RELAXED, __HIP_MEMORY_SCOPE_AGENT); }
__device__ __forceinline__ unsigned xb_add(unsigned* p, unsigned v) { return __hip_atomic_fetch_add(p, v, __ATOMIC_RELAXED, __HIP_MEMORY_SCOPE_AGENT); }
__device__ __forceinline__ unsigned xb_xcc_id() { return (unsigned)__builtin_amdgcn_s_getreg((3 << 11) | 20) & 0xFu; }
#define XB_SPIN(cond, bar) do { unsigned _sp = 0; while (cond) { __builtin_amdgcn_s_sleep(1); \
    if ((++_sp & 255u) == 0u) { if (xb_ld(&(bar)[XB_TMO])) break; if (_sp > XB_SPIN_CAP) { atomicAdd(&(bar)[XB_TMO], 1u); break; } } } } while (0)

struct XcdBarrier {
    unsigned* bar; unsigned x;
    volatile LAS unsigned* st;
};

__device__ __forceinline__ XcdBarrier xcd_barrier_post(unsigned* bar, volatile LAS unsigned* st) {
    XcdBarrier b; b.bar = bar; b.x = xb_xcc_id(); b.st = st;
    if (threadIdx.x == 0) (void)xb_add(&bar[XB_XCNT(b.x)], 1u);
    return b;
}
__device__ __forceinline__ void xcd_barrier_complete(unsigned* bar, unsigned x, unsigned& nloc, unsigned& nx) {
    const unsigned G = gridDim.x * gridDim.y * gridDim.z;
    unsigned sum, cnt, mine, sp = 0u;
    for (;;) {
        sum = 0u; cnt = 0u; mine = 0u;
#pragma unroll
        for (unsigned j = 0; j < 16; ++j) { const unsigned c = xb_ld(&bar[XB_XCNT(j)]); sum += c; cnt += (c > 0u) ? 1u : 0u; mine = (j == x) ? c : mine; }
        if (sum == G) break;
        __builtin_amdgcn_s_sleep(1);
        if ((++sp & 255u) == 0u) { if (xb_ld(&bar[XB_TMO])) break; if (sp > XB_SPIN_CAP) { atomicAdd(&bar[XB_TMO], 1u); break; } }
    }
    nloc = mine > 0u ? mine : 1u; nx = cnt > 0u ? cnt : 1u;
}

__device__ __forceinline__ void xcd_barrier(const XcdBarrier& b) {
    asm volatile("s_waitcnt vmcnt(0)" ::: "memory");
    __syncthreads();
    if (threadIdx.x == 0) {
        unsigned* bar = b.bar;
        __builtin_amdgcn_s_waitcnt(0);
        unsigned nloc = b.st[0], nx = b.st[1];
        if (nloc == 0u) { xcd_barrier_complete(bar, b.x, nloc, nx); b.st[0] = nloc; b.st[1] = nx; }
        const unsigned old = xb_add(&bar[XB_XSUB(b.x)], 1u);
        const unsigned gen = old / nloc;
        if (old + 1u == (gen + 1u) * nloc) {
            __builtin_amdgcn_fence(__ATOMIC_RELEASE, "agent");
            asm volatile("s_waitcnt vmcnt(0)" ::: "memory");
            const unsigned og = xb_add(&bar[XB_TOP], 1u);
            const unsigned tg = og / nx;
            if (og + 1u == (tg + 1u) * nx) xb_add(&bar[XB_TOPGEN], 1u);
            else XB_SPIN(xb_ld(&bar[XB_TOPGEN]) == tg, bar);
            __builtin_amdgcn_fence(__ATOMIC_ACQUIRE, "agent");
            xb_add(&bar[XB_XGEN(b.x)], 1u);
            asm volatile("s_waitcnt vmcnt(0)" ::: "memory");
        } else {
            XB_SPIN(xb_ld(&bar[XB_XGEN(b.x)]) == gen, bar);
            __builtin_amdgcn_fence(__ATOMIC_ACQUIRE, "agent");
            asm volatile("s_waitcnt vmcnt(0)" ::: "memory");
        }
    }
    __syncthreads();
}

struct Frame {
    LAS unsigned char* lds;
    int tid, lane, wave, vcu, G;
};

__device__ __forceinline__ int remap0(int n) { return n < 1536 ? n : (n < 1544 ? 3072 + (n - 1536) : n - 8); }
__device__ __forceinline__ void p0_transpose_item(const float* W, int K, int N, bf16_t* WT, const float* g, bool remap, LAS float* scr, int item, int lane) {
    const int nblk = (N + 31) / 32, kb = item / nblk, nb = item % nblk, k0 = 64 * kb, n0 = 32 * nb;
#pragma unroll 8
    for (int i = 0; i < 32; ++i) { const int kk = 2 * i + (lane >> 5), n = n0 + (lane & 31);
        float v = (n < N) ? W[(size_t)(k0 + kk) * N + n] : 0.f; if (g) v *= g[k0 + kk]; scr[kk * 33 + (lane & 31)] = v; }
    LDS_WAIT(); asm volatile("" ::: "memory");
    const int c = lane & 7;
#pragma unroll
    for (int j = 0; j < 4; ++j) { const int nl = (lane >> 3) + 8 * j, n = n0 + nl; const LAS float* s = scr + (8 * c) * 33 + nl;
        u32x4 o; o.x = pk2(s[0 * 33], s[1 * 33]); o.y = pk2(s[2 * 33], s[3 * 33]); o.z = pk2(s[4 * 33], s[5 * 33]); o.w = pk2(s[6 * 33], s[7 * 33]);
        if (n < N) { const int nn = remap ? remap0(n) : n; *(u32x4*)(WT + (size_t)nn * K + k0 + 8 * c) = o; } }
    LDS_WAIT(); asm volatile("" ::: "memory");
}
__device__ __forceinline__ float cvt_row_1024(const float* src, bf16_t* dst, const float* g, int lane) {
    const f32x4 a0 = *(const f32x4*)(src + 8 * lane), a1 = *(const f32x4*)(src + 8 * lane + 4), c0 = *(const f32x4*)(src + 512 + 8 * lane), c1 = *(const f32x4*)(src + 516 + 8 * lane);
    float ss = (a0[0] * a0[0] + a0[1] * a0[1]) + (a0[2] * a0[2] + a0[3] * a0[3]) + (a1[0] * a1[0] + a1[1] * a1[1]) + (a1[2] * a1[2] + a1[3] * a1[3])
             + (c0[0] * c0[0] + c0[1] * c0[1]) + (c0[2] * c0[2] + c0[3] * c0[3]) + (c1[0] * c1[0] + c1[1] * c1[1]) + (c1[2] * c1[2] + c1[3] * c1[3]);
    f32x4 b0 = a0, b1 = a1, d0 = c0, d1 = c1;
    if (g) { b0 = b0 * *(const f32x4*)(g + 8 * lane); b1 = b1 * *(const f32x4*)(g + 8 * lane + 4); d0 = d0 * *(const f32x4*)(g + 512 + 8 * lane); d1 = d1 * *(const f32x4*)(g + 516 + 8 * lane); }
    *(u32x4*)(dst + 8 * lane) = pack8(b0, b1); *(u32x4*)(dst + 512 + 8 * lane) = pack8(d0, d1);
    return ss;
}

constexpr float I8_SU = 600.f, I8_SX = 127.f / 6.f;
constexpr float FP8_SU = 64.f, FP8_SV = 8.f;
__device__ __forceinline__ void cvt_row_fp8_sliced(const float* src, unsigned char* tab  , int e, const float* g, float scale, int lane) {
#pragma unroll
    for (int j = 0; j < 4; ++j) { f32x4 a = *(const f32x4*)(src + 256 * j + 4 * lane) * scale; if (g) a = a * *(const f32x4*)(g + 256 * j + 4 * lane);
        int w = 0; w = __builtin_amdgcn_cvt_pk_bf8_f32(a[0], a[1], w, false); w = __builtin_amdgcn_cvt_pk_bf8_f32(a[2], a[3], w, true);
        const int x = 2 * j + (lane >> 5);
        *(unsigned*)(tab + ((size_t)x * NEXP + e) * 128 + 4 * (lane & 31)) = (unsigned)w; }
}
__device__ __forceinline__ void cvt_row_i8_sliced(const float* src, unsigned char* tab  , int e, const float* g, float scale, int lane) {
#pragma unroll
    for (int j = 0; j < 4; ++j) { f32x4 a = *(const f32x4*)(src + 256 * j + 4 * lane) * scale; if (g) a = a * *(const f32x4*)(g + 256 * j + 4 * lane);
        unsigned w = 0u;
#pragma unroll
        for (int q = 0; q < 4; ++q) { int v = __float2int_rn(a[q]); v = v < -127 ? -127 : (v > 127 ? 127 : v); w |= ((unsigned)v & 0xffu) << (8 * q); }
        const int x = 2 * j + (lane >> 5);
        *(unsigned*)(tab + ((size_t)x * NEXP + e) * 128 + 4 * (lane & 31)) = w; }
}
struct Ptrs {
    const float *x, *norm_mix, *norm_ffn, *ev_w_in, *ev_b_f, *ev_w_out, *od_w_in, *od_pool_w, *od_pool_scale, *od_w_out, *peer_wq, *peer_k1, *peer_k2, *peer_u, *peer_v, *norm_f;
    float* out; unsigned char* ws;
};

__device__ __forceinline__ void phase_p0(Frame& F, const Ptrs& P) {
    LAS float* scr = (LAS float*)(F.lds + F.wave * 16384);
    const int gw = F.vcu * NWAVES + F.wave, NGW = F.G * NWAVES, lane = opaque_i(F.lane);
    unsigned char* ws = P.ws;
    bf16_t* W1T = (bf16_t*)(ws + WS_W1T); bf16_t* W2T = (bf16_t*)(ws + WS_W2T); bf16_t* W4T = (bf16_t*)(ws + WS_W4T); bf16_t* W5T = (bf16_t*)(ws + WS_W5T);
    bf16_t* W3T = (bf16_t*)(ws + WS_W3T); bf16_t* W6T = (bf16_t*)(ws + WS_W6T); bf16_t* PWT = (bf16_t*)(ws + WS_PWT);
    constexpr int I1 = 16 * 97, I2 = 16 * 32, I4 = 16 * 64, I5 = I2, I3 = I4, I6 = I4, IP = 4 * 2 * 4;
    constexpr int NTR = I1 + I2 + I4 + I5 + I3 + I6 + IP;
    for (int it = gw; it < NTR; it += NGW) {
        int r = it;
        if (r < I1) { p0_transpose_item(P.ev_w_in, DM, EVEN_IN, W1T, P.norm_mix, true, scr, r, lane); continue; } r -= I1;
        if (r < I2) { p0_transpose_item(P.ev_w_out, DM, DM, W2T, nullptr, false, scr, r, lane); continue; } r -= I2;
        if (r < I4) { p0_transpose_item(P.od_w_in, DM, 2048, W4T, P.norm_mix + DM, false, scr, r, lane); continue; } r -= I4;
        if (r < I5) { p0_transpose_item(P.od_w_out, DM, DM, W5T, nullptr, false, scr, r, lane); continue; } r -= I5;
        if (r < I3) { p0_transpose_item(P.peer_wq, DM, 2048, W3T, P.norm_ffn, false, scr, r, lane); continue; } r -= I3;
        if (r < I6) { p0_transpose_item(P.peer_wq + (size_t)DM * 2048, DM, 2048, W6T, P.norm_ffn + DM, false, scr, r, lane); continue; } r -= I6;
        { const int g = r >> 3; p0_transpose_item(P.od_pool_w + (size_t)g * 128 * 128, 128, 128, PWT + (size_t)g * 128 * 128, nullptr, false, scr, r & 7, lane); }
    }
    constexpr int R_Z = EVEN_PAD - EVEN_IN, R_X = TOK, R_U = 2 * NEXP, R_V = 2 * NEXP, R_K = 2 * 256;
    constexpr int NROW = R_Z + R_X + R_U + R_V + R_K;
    bf16_t* XB = (bf16_t*)(ws + WS_XB); float* RS0 = (float*)(ws + WS_RS0);
    bf16_t* K1B = (bf16_t*)(ws + WS_K1B); bf16_t* K2B = (bf16_t*)(ws + WS_K2B);
    for (int it = gw; it < NROW; it += NGW) {
        int r = it;
        if (r < R_Z) { bf16_t* d = W1T + (size_t)(EVEN_IN + r) * DM; const u32x4 z = {0u, 0u, 0u, 0u}; *(u32x4*)(d + 8 * lane) = z; *(u32x4*)(d + 512 + 8 * lane) = z; continue; } r -= R_Z;
        if (r < R_X) { const float ss = wave_sum(cvt_row_1024(P.x + (size_t)r * DM, XB + (size_t)r * DM, nullptr, lane)); if (lane == 0) RS0[r] = rsqrtf(ss * (1.f / DM) + RMS_EPS); continue; } r -= R_X;
        if (r < R_U) { const int ly = r >= NEXP; cvt_row_i8_sliced(P.peer_u + (size_t)r * DM, ws + WS_U8S + (size_t)ly * 8 * NEXP * 128, r - ly * NEXP, P.norm_ffn + (ly ? DM : 0), I8_SU, lane); continue; } r -= R_U;
        if (r < R_V) { const int ly = r >= NEXP; cvt_row_fp8_sliced(P.peer_v + (size_t)r * DM, ws + WS_V8S + (size_t)ly * 8 * NEXP * 128, r - ly * NEXP, nullptr, FP8_SV, lane); continue; } r -= R_V;
        if (r < 256) (void)cvt_row_1024(P.peer_k1 + (size_t)r * 1024, K1B + (size_t)r * 1024, nullptr, lane);
        else (void)cvt_row_1024(P.peer_k2 + (size_t)(r - 256) * 1024, K2B + (size_t)(r - 256) * 1024, nullptr, lane);
    }
}

__device__ __forceinline__ void phase_cfscan(Frame& F, const float* LF, float* CFo) {
    const int gw = F.vcu * NWAVES + F.wave, NGW = F.G * NWAVES, lane = opaque_i(F.lane);
    for (int bh = gw; bh < NB * 8; bh += NGW) {
        const float* src = LF + (size_t)bh * 2048 + 32 * lane; float v[32];
#pragma unroll
        for (int i = 0; i < 8; ++i) { const f32x4 w = *(const f32x4*)(src + 4 * i); v[4 * i] = w[0]; v[4 * i + 1] = w[1]; v[4 * i + 2] = w[2]; v[4 * i + 3] = w[3]; }
#pragma unroll
        for (int i = 1; i < 32; ++i) v[i] += v[i - 1];
        const float tot = v[31]; float inc = tot;
#pragma unroll
        for (int o = 1; o < 64; o <<= 1) { const float w = __shfl_up(inc, o); if (lane >= o) inc += w; }
        const float excl = inc - tot; float* dst = CFo + (size_t)bh * 2048 + 32 * lane;
#pragma unroll
        for (int i = 0; i < 8; ++i) { f32x4 w = {v[4 * i] + excl, v[4 * i + 1] + excl, v[4 * i + 2] + excl, v[4 * i + 3] + excl}; *(f32x4*)(dst + 4 * i) = w; }
    }
}
__device__ __forceinline__ void phase_kmean(Frame& F, const bf16_t* KD, float* KMEAN) {
    const int gw = F.vcu * NWAVES + F.wave, NGW = F.G * NWAVES, lane = opaque_i(F.lane);
    for (int it = gw; it < NB * 8 * 8; it += NGW) {
        const int bh = it >> 3, blk = it & 7; const bf16_t* src = KD + ((size_t)bh * 2048 + blk * 256) * 64 + lane; float s = 0.f;
#pragma unroll 8
        for (int j = 0; j < 256; ++j) s += __uint_as_float((unsigned)src[(size_t)j * 64] << 16);
        KMEAN[(size_t)it * 64 + lane] = s * (1.f / 256.f);
    }
}

__device__ __forceinline__ int lgi(int s) { return s + (s >> 5); }
__device__ __forceinline__ float lsn2f(float z2) { return -(fmaxf(z2, 0.f) + __log2f(1.f + exp2f(-fabsf(z2)))); }
template <int KIND>
__device__ __forceinline__ void attn_naive(Frame& F, const bf16_t* QH, const bf16_t* KH, const bf16_t* VT, int NH, int hbase, const float* CF, const float* KMEAN, bf16_t* AO, int ao_col0) {
    LAS float* lg = (LAS float*)(F.lds + F.wave * 8704);
    const int gw = F.vcu * NWAVES + F.wave, NGW = F.G * NWAVES, lane = opaque_i(F.lane);
    for (int qi = gw; qi < NB * 8 * SEQ; qi += NGW) {
        const int bh = qi >> 11, b = bh >> 3, h = bh & 7, hh = hbase + h;
        const int t = (bh & 1) ? (2047 - (qi & 2047)) : (qi & 2047);
        const size_t hb = (size_t)(b * NH + hh);
        const bf16_t* qp = QH + (hb * 2048 + t) * 64; const bf16_t* kp = KH + hb * 2048 * 64;
        float q[64];
#pragma unroll
        for (int c = 0; c < 8; ++c) { const u32x4 w = *(const u32x4*)(qp + 8 * c);
            q[8 * c] = bf_lo(w.x); q[8 * c + 1] = bf_hi(w.x); q[8 * c + 2] = bf_lo(w.y); q[8 * c + 3] = bf_hi(w.y); q[8 * c + 4] = bf_lo(w.z); q[8 * c + 5] = bf_hi(w.z); q[8 * c + 6] = bf_lo(w.w); q[8 * c + 7] = bf_hi(w.w); }
        unsigned sel = 0u; const int qb = t >> 8;
        if (KIND == 2) {
            float gate[8];
#pragma unroll
            for (int n = 0; n < 8; ++n) { const float* km = KMEAN + ((size_t)(b * 8 + h) * 8 + n) * 64; float a = 0.f;
#pragma unroll
                for (int d = 0; d < 64; ++d) a += q[d] * km[d];
                gate[n] = a; }
            const int nsel = qb < 3 ? qb : 3;
#pragma unroll
            for (int r = 0; r < 3; ++r) if (r < nsel) { float best = -INFINITY; int bi = 0;
#pragma unroll
                for (int n = 0; n < 8; ++n) if (n < qb && !((sel >> n) & 1u) && gate[n] > best) { best = gate[n]; bi = n; }
                sel |= 1u << bi; }
        }
        const int nk = (KIND == 1) ? t : t + 1;
        const int tp = (nk + 7) & ~7;
        const float cft = (KIND == 0) ? CF[(size_t)(b * 8 + h) * 2048 + t] : 0.f;
        const float slope2 = (KIND == 2) ? exp2f(-(float)(h + 1)) * LOG2E : 0.f;
        float mloc = -INFINITY;
        for (int s = lane; s < nk; s += 64) {
            float dot = 0.f;
#pragma unroll
            for (int c = 0; c < 8; ++c) { const u32x4 w = *(const u32x4*)(kp + (size_t)s * 64 + 8 * c);
                dot += q[8 * c] * bf_lo(w.x) + q[8 * c + 1] * bf_hi(w.x) + q[8 * c + 2] * bf_lo(w.y) + q[8 * c + 3] * bf_hi(w.y) + q[8 * c + 4] * bf_lo(w.z) + q[8 * c + 5] * bf_hi(w.z) + q[8 * c + 6] * bf_lo(w.w) + q[8 * c + 7] * bf_hi(w.w); }
            float v = dot;
            if (KIND == 0) v += cft - CF[(size_t)(b * 8 + h) * 2048 + s];
            if (KIND == 2) { const int n = s >> 8; const bool valid = (n == qb) || ((sel >> n) & 1u); v = valid ? v + slope2 * (float)(s - t) : -INFINITY; }
            lg[lgi(s)] = v; mloc = fmaxf(mloc, v);
        }
        float linv = 1.f;
        if (KIND != 1) {
            const float m = wave_max(mloc); float lsum = 0.f;
            for (int s = lane; s < tp; s += 64) { const float p = (s < nk) ? exp2f(lg[lgi(s)] - m) : 0.f; lg[lgi(s)] = p; lsum += p; }
            linv = 1.f / wave_sum(lsum);
        } else {
            float tot = 0.f;
            for (int i = 0; i < 32; ++i) { const int s = 32 * lane + i; if (s < nk) tot += lsn2f(lg[lgi(s)]); }
            float inc = tot;
#pragma unroll
            for (int o = 1; o < 64; o <<= 1) { const float w = __shfl_down(inc, o); if (lane + o < 64) inc += w; }
            float run = inc - tot;
            for (int i = 31; i >= 0; --i) { const int s = 32 * lane + i; float a = 0.f;
                if (s < nk) { const float z = lg[lgi(s)], l2 = lsn2f(z); a = exp2f(z + l2 + run); run += l2; }
                if (s < tp) lg[lgi(s)] = a; }
        }
        LDS_WAIT();
        const bf16_t* vp = VT + (hb * 64 + lane) * 2048; float o = 0.f;
        for (int s0 = 0; s0 < tp; s0 += 8) { const u32x4 w = *(const u32x4*)(vp + s0); const int i0 = lgi(s0);
            o += lg[i0] * bf_lo(w.x) + lg[i0 + 1] * bf_hi(w.x) + lg[i0 + 2] * bf_lo(w.y) + lg[i0 + 3] * bf_hi(w.y) + lg[i0 + 4] * bf_lo(w.z) + lg[i0 + 5] * bf_hi(w.z) + lg[i0 + 6] * bf_lo(w.w) + lg[i0 + 7] * bf_hi(w.w); }
        AO[(size_t)(b * 2048 + t) * DM + ao_col0 + h * 64 + lane] = (bf16_t)f2bf(o * linv);
        LDS_WAIT();
    }
}

__device__ __forceinline__ float lsn2q(float z2) { return -(fmaxf(z2, 0.f) + __builtin_amdgcn_logf(1.f + __builtin_amdgcn_exp2f(-fabsf(z2)))); }
__device__ __forceinline__ int pi32(int i) { return (i & ~12) | ((i & 4) << 1) | ((i & 8) >> 1); }
__device__ __forceinline__ void attn_load_k(bf16x8 (&kf)[4], const bf16_t* Kh, int kv0, int r32p, int hi) {
    const bf16_t* p = Kh + (size_t)(kv0 + r32p) * 64 + 8 * hi;
#pragma unroll
    for (int d0 = 0; d0 < 4; ++d0) kf[d0] = *(const bf16x8*)(p + 16 * d0);
}
__device__ __forceinline__ void attn_load_v(bf16x8 (&vf)[2][2], const bf16_t* Vth, int kv0, int r32, int hi) {
#pragma unroll
    for (int s = 0; s < 2; ++s)
#pragma unroll
        for (int dh = 0; dh < 2; ++dh) vf[s][dh] = *(const bf16x8*)(Vth + (size_t)(32 * dh + r32) * 2048 + kv0 + 16 * s + 8 * hi);
}
template <int KIND, int MODE>
__device__ __forceinline__ void attn_tile(const bf16x8 (&qr)[4], const bf16x8 (&kf)[4], const bf16x8 (&vf)[2][2], f32x16& O0, f32x16& O1, float& m, float& l, float& R,
                                          const f32x16& bias, const int kv0, const int q, const int hi, const bool rowok) {
    f32x16 S = bias;
#pragma unroll
    for (int d0 = 0; d0 < 4; ++d0) S = __builtin_amdgcn_mfma_f32_32x32x16_bf16(kf[d0], qr[d0], S, 0, 0, 0);
    if (MODE == 1) {
#pragma unroll
        for (int r = 0; r < 16; ++r) { const int key = kv0 + (r & 7) + 8 * hi + 16 * (r >> 3); const bool bad = (KIND == 1) ? (key >= q) : (key > q); if (bad) S[r] = -INFINITY; }
    }
    if (MODE == 2) { if (!rowok) {
#pragma unroll
        for (int r = 0; r < 16; ++r) S[r] = -INFINITY; } }
    float p[16];
    if (KIND != 1) {
        float rm = fmaxf(fmaxf(S[0], S[1]), fmaxf(S[2], S[3]));
#pragma unroll
        for (int r = 4; r < 16; r += 4) rm = fmaxf(rm, fmaxf(fmaxf(S[r], S[r + 1]), fmaxf(S[r + 2], S[r + 3])));
        rm = fmaxf(rm, __shfl_xor(rm, 32));
        const float mn = fmaxf(fmaxf(m, rm), -1e30f); const float alpha = __builtin_amdgcn_exp2f(m - mn);
        float ps = 0.f;
#pragma unroll
        for (int r = 0; r < 16; ++r) { p[r] = __builtin_amdgcn_exp2f(S[r] - mn); ps += p[r]; }
        l = l * alpha + ps; m = mn;
        O0 *= alpha; O1 *= alpha;
    } else {
        float l2[16]; float sLo = 0.f, sHi = 0.f;
#pragma unroll
        for (int r = 0; r < 16; ++r) l2[r] = lsn2q(S[r]);
#pragma unroll
        for (int r = 0; r < 8; ++r) { sLo += l2[r]; sHi += l2[8 + r]; }
        const float pLo = __shfl_xor(sLo, 32), pHi = __shfl_xor(sHi, 32);
        float run = hi ? R : R + pHi;
#pragma unroll
        for (int r = 15; r >= 8; --r) { p[r] = __builtin_amdgcn_exp2f(S[r] + l2[r] + run); run += l2[r]; }
        run = hi ? (R + sHi + pHi) : (R + pHi + sHi + pLo);
#pragma unroll
        for (int r = 7; r >= 0; --r) { p[r] = __builtin_amdgcn_exp2f(S[r] + l2[r] + run); run += l2[r]; }
        R += (sLo + sHi) + (pLo + pHi);
    }
    u32x4 w0, w1;
    w0.x = pk2(p[0], p[1]); w0.y = pk2(p[2], p[3]); w0.z = pk2(p[4], p[5]); w0.w = pk2(p[6], p[7]);
    w1.x = pk2(p[8], p[9]); w1.y = pk2(p[10], p[11]); w1.z = pk2(p[12], p[13]); w1.w = pk2(p[14], p[15]);
    const bf16x8 pf0 = __builtin_bit_cast(bf16x8, w0), pf1 = __builtin_bit_cast(bf16x8, w1);
    O0 = __builtin_amdgcn_mfma_f32_32x32x16_bf16(vf[0][0], pf0, O0, 0, 0, 0); O0 = __builtin_amdgcn_mfma_f32_32x32x16_bf16(vf[1][0], pf1, O0, 0, 0, 0);
    O1 = __builtin_amdgcn_mfma_f32_32x32x16_bf16(vf[0][1], pf0, O1, 0, 0, 0); O1 = __builtin_amdgcn_mfma_f32_32x32x16_bf16(vf[1][1], pf1, O1, 0, 0, 0);
}
template <int KIND>
__device__ __forceinline__ f32x16 attn_bias(const float* CFh, float slope2, int kv0, int q0, int hi) {
    f32x16 b = f32x16{};
    if (KIND == 0) { const float* c = CFh + kv0 + 8 * hi; const f32x4 a0 = *(const f32x4*)c, a1 = *(const f32x4*)(c + 4), a2 = *(const f32x4*)(c + 16), a3 = *(const f32x4*)(c + 20);
        b[0] = -a0[0]; b[1] = -a0[1]; b[2] = -a0[2]; b[3] = -a0[3]; b[4] = -a1[0]; b[5] = -a1[1]; b[6] = -a1[2]; b[7] = -a1[3];
        b[8] = -a2[0]; b[9] = -a2[1]; b[10] = -a2[2]; b[11] = -a2[3]; b[12] = -a3[0]; b[13] = -a3[1]; b[14] = -a3[2]; b[15] = -a3[3]; }
    if (KIND == 2) {
#pragma unroll
        for (int r = 0; r < 16; ++r) b[r] = slope2 * (float)(kv0 + (r & 7) + 8 * hi + 16 * (r >> 3) - q0); }
    return b;
}
template <int KIND>
__device__ __forceinline__ void attn_wave(const bf16_t* Qh, const bf16_t* Kh, const bf16_t* Vth, const int q0, const int lane, const float* CFh, const float slope2, const float* KMh, bf16_t* AOp) {
    const int r32 = lane & 31, hi = lane >> 5, r32p = pi32(r32), q = q0 + r32;
    bf16x8 qr[4];
#pragma unroll
    for (int d0 = 0; d0 < 4; ++d0) qr[d0] = *(const bf16x8*)(Qh + (size_t)q * 64 + 16 * d0 + 8 * hi);
    f32x16 O0 = f32x16{}, O1 = f32x16{};
    float m = -INFINITY, l = 0.f, R = 0.f;
    bf16x8 kf[4], kfn[4], vf[2][2];
    const int nt = q0 / 32 + 1;
    if (KIND == 0) {
        attn_load_k(kf, Kh, 0, r32p, hi);
        for (int it = 0; it < nt; ++it) { const int kv0 = 32 * it;
            attn_load_v(vf, Vth, kv0, r32, hi); const f32x16 bias = attn_bias<0>(CFh, 0.f, kv0, q0, hi);
            if (it + 1 < nt) attn_load_k(kfn, Kh, kv0 + 32, r32p, hi);
            if (it == nt - 1) attn_tile<0, 1>(qr, kf, vf, O0, O1, m, l, R, bias, kv0, q, hi, true); else attn_tile<0, 0>(qr, kf, vf, O0, O1, m, l, R, bias, kv0, q, hi, true);
#pragma unroll
            for (int d0 = 0; d0 < 4; ++d0) kf[d0] = kfn[d0]; }
    } else if (KIND == 1) {
        attn_load_k(kf, Kh, 32 * (nt - 1), r32p, hi);
        for (int it = nt - 1; it >= 0; --it) { const int kv0 = 32 * it;
            attn_load_v(vf, Vth, kv0, r32, hi); const f32x16 bias = f32x16{};
            if (it > 0) attn_load_k(kfn, Kh, kv0 - 32, r32p, hi);
            if (it == nt - 1) attn_tile<1, 1>(qr, kf, vf, O0, O1, m, l, R, bias, kv0, q, hi, true); else attn_tile<1, 0>(qr, kf, vf, O0, O1, m, l, R, bias, kv0, q, hi, true);
#pragma unroll
            for (int d0 = 0; d0 < 4; ++d0) kf[d0] = kfn[d0];
            if (__all(R < -200.f)) break; }
    } else {
        const int qb = q0 >> 8;
        f32x16 G = f32x16{};
#pragma unroll
        for (int d0 = 0; d0 < 4; ++d0) { u32x4 kw = {0u, 0u, 0u, 0u};
            if (r32 < 8) { const float* kmp = KMh + r32 * 64 + 16 * d0 + 8 * hi; kw = pack8(*(const f32x4*)kmp, *(const f32x4*)(kmp + 4)); }
            G = __builtin_amdgcn_mfma_f32_32x32x16_bf16(__builtin_bit_cast(bf16x8, kw), qr[d0], G, 0, 0, 0); }
        float gate[8];
#pragma unroll
        for (int n = 0; n < 4; ++n) { const float own = G[n], oth = __shfl_xor(own, 32); gate[n] = hi ? oth : own; gate[n + 4] = hi ? own : oth; }
        unsigned sel = 0u; const int nsel = qb < 3 ? qb : 3;
#pragma unroll
        for (int r = 0; r < 3; ++r) if (r < nsel) { float best = -INFINITY; int bi = 0;
#pragma unroll
            for (int n = 0; n < 8; ++n) if (n < qb && !((sel >> n) & 1u) && gate[n] > best) { best = gate[n]; bi = n; }
            sel |= 1u << bi; }
        for (int kv0 = 256 * qb; kv0 <= q0; kv0 += 32) {
            attn_load_k(kf, Kh, kv0, r32p, hi); attn_load_v(vf, Vth, kv0, r32, hi); const f32x16 bias = attn_bias<2>(nullptr, slope2, kv0, q0, hi);
            if (kv0 == q0) attn_tile<2, 1>(qr, kf, vf, O0, O1, m, l, R, bias, kv0, q, hi, true); else attn_tile<2, 0>(qr, kf, vf, O0, O1, m, l, R, bias, kv0, q, hi, true); }
        for (int j = 0; j < qb; ++j) { const bool rowok = (sel >> j) & 1u;
            if (!__any(rowok)) continue;
            attn_load_k(kf, Kh, 256 * j, r32p, hi);
            for (int i = 0; i < 8; ++i) { const int kv0 = 256 * j + 32 * i;
                attn_load_v(vf, Vth, kv0, r32, hi); const f32x16 bias = attn_bias<2>(nullptr, slope2, kv0, q0, hi);
                if (i < 7) attn_load_k(kfn, Kh, kv0 + 32, r32p, hi);
                attn_tile<2, 2>(qr, kf, vf, O0, O1, m, l, R, bias, kv0, q, hi, rowok);
#pragma unroll
                for (int d0 = 0; d0 < 4; ++d0) kf[d0] = kfn[d0]; } }
    }
    float linv = 1.f;
    if (KIND != 1) linv = 1.f / (l + __shfl_xor(l, 32));
    bf16_t* orow = AOp + (size_t)q * DM;
#pragma unroll
    for (int g = 0; g < 4; ++g) { u32x2 w;
        w.x = pk2(O0[4 * g] * linv, O0[4 * g + 1] * linv); w.y = pk2(O0[4 * g + 2] * linv, O0[4 * g + 3] * linv); *(u32x2*)(orow + 8 * g + 4 * hi) = w;
        w.x = pk2(O1[4 * g] * linv, O1[4 * g + 1] * linv); w.y = pk2(O1[4 * g + 2] * linv, O1[4 * g + 3] * linv); *(u32x2*)(orow + 32 + 8 * g + 4 * hi) = w; }
}
template <int KIND>
__device__ __forceinline__ void phase_attn(Frame& F, const bf16_t* QH, const bf16_t* KH, const bf16_t* VT, int NH, int hbase, const float* CF, const float* KMEAN, bf16_t* AO, int ao_col0) {
    for (int ug = F.vcu; ug < NB * 8 * 2; ug += F.G) {
        const int bh = ug >> 1, b = bh >> 3, h = bh & 7, hh = hbase + h; const size_t hb = (size_t)(b * NH + hh);
        const float slope2 = __builtin_amdgcn_exp2f(-(float)(h + 1)) * LOG2E;
#pragma unroll 1
        for (int i = 0; i < 4; ++i) { const int base = (i >> 1) * 2 + (ug & 1), qb = (i & 1) ? 7 - base : base, w = (i & 1) ? 7 - F.wave : F.wave;
            attn_wave<KIND>(QH + hb * 2048 * 64, KH + hb * 2048 * 64, VT + hb * 64 * 2048, 256 * qb + 32 * w, opaque_i(F.lane),
                            CF ? CF + (size_t)bh * 2048 : nullptr, slope2, KMEAN ? KMEAN + (size_t)bh * 8 * 64 : nullptr, AO + (size_t)b * 2048 * DM + ao_col0 + h * 64); }
    }
}


constexpr int AT_SLOT = 16384, AT_CF = 3 * AT_SLOT;
__device__ __forceinline__ void attn_dma_tile(const bf16_t* Kh, const bf16_t* Vth, int T, LAS unsigned char* slot, int wave, int r32, int r32p, int hi) {
    const int j = wave >> 2, d0 = wave & 3, s2 = (wave >> 1) & 1, dh = wave & 1;
    const bf16_t* ks = Kh + (size_t)(64 * T + 32 * j + r32p) * 64 + 16 * d0 + 8 * hi;
    const bf16_t* vs = Vth + (size_t)(32 * dh + r32) * 2048 + 64 * T + 32 * j + 16 * s2 + 8 * hi;
    __builtin_amdgcn_global_load_lds((const unsigned*)ks, (LAS unsigned*)(slot + (j * 4 + d0) * 1024), 16, 0, 0);
    __builtin_amdgcn_global_load_lds((const unsigned*)vs, (LAS unsigned*)(slot + 8192 + ((j * 2 + s2) * 2 + dh) * 1024), 16, 0, 0);
}
template <int MODE>
__device__ __forceinline__ void attn_fox_sub(const bf16x8 (&qr)[4], f32x16& O0, f32x16& O1, float& m, float& l, unsigned saddr  , unsigned cfaddr  , int j, int kv0, int q, int hi) {
    bf16x8 kf[4], vf[2][2]; f32x4 c0, c1, c2, c3;
    asm volatile("ds_read_b128 %0, %12\n\tds_read_b128 %1, %12 offset:1024\n\tds_read_b128 %2, %12 offset:2048\n\tds_read_b128 %3, %12 offset:3072\n\t"
                 "ds_read_b128 %4, %13\n\tds_read_b128 %5, %13 offset:1024\n\tds_read_b128 %6, %13 offset:2048\n\tds_read_b128 %7, %13 offset:3072\n\t"
                 "ds_read_b128 %8, %14\n\tds_read_b128 %9, %14 offset:16\n\tds_read_b128 %10, %14 offset:64\n\tds_read_b128 %11, %14 offset:80\n\ts_waitcnt lgkmcnt(0)"
                 : "=&v"(kf[0]), "=&v"(kf[1]), "=&v"(kf[2]), "=&v"(kf[3]), "=&v"(vf[0][0]), "=&v"(vf[0][1]), "=&v"(vf[1][0]), "=&v"(vf[1][1]), "=&v"(c0), "=&v"(c1), "=&v"(c2), "=&v"(c3)
                 : "v"(saddr + (unsigned)j * 4096u), "v"(saddr + 8192u + (unsigned)j * 4096u), "v"(cfaddr) : "memory");
    f32x16 S;
    S[0] = c0[0]; S[1] = c0[1]; S[2] = c0[2]; S[3] = c0[3]; S[4] = c1[0]; S[5] = c1[1]; S[6] = c1[2]; S[7] = c1[3];
    S[8] = c2[0]; S[9] = c2[1]; S[10] = c2[2]; S[11] = c2[3]; S[12] = c3[0]; S[13] = c3[1]; S[14] = c3[2]; S[15] = c3[3];
#pragma unroll
    for (int d0 = 0; d0 < 4; ++d0) S = __builtin_amdgcn_mfma_f32_32x32x16_bf16(kf[d0], qr[d0], S, 0, 0, 0);
    if (MODE == 1) {
#pragma unroll
        for (int r = 0; r < 16; ++r) { const int key = kv0 + (r & 7) + 8 * hi + 16 * (r >> 3); if (key > q) S[r] = -INFINITY; }
    }
    float rm = fmaxf(fmaxf(S[0], S[1]), fmaxf(S[2], S[3]));
#pragma unroll
    for (int r = 4; r < 16; r += 4) rm = fmaxf(rm, fmaxf(fmaxf(S[r], S[r + 1]), fmaxf(S[r + 2], S[r + 3])));
    { const auto rr = __builtin_amdgcn_permlane32_swap(__float_as_uint(rm), __float_as_uint(rm), false, false); rm = fmaxf(__uint_as_float(rr[0]), __uint_as_float(rr[1])); }
    if (__any(rm > m)) {
        const float mn = fmaxf(fmaxf(m, rm), -1e30f); const float alpha = __builtin_amdgcn_exp2f(m - mn);
        l *= alpha; O0 *= alpha; O1 *= alpha; m = mn; }
    float p[16]; float ps = 0.f;
#pragma unroll
    for (int r = 0; r < 16; ++r) { p[r] = __builtin_amdgcn_exp2f(S[r] - m); ps += p[r]; }
    l += ps;
    u32x4 w0, w1;
    w0.x = pk2(p[0], p[1]); w0.y = pk2(p[2], p[3]); w0.z = pk2(p[4], p[5]); w0.w = pk2(p[6], p[7]);
    w1.x = pk2(p[8], p[9]); w1.y = pk2(p[10], p[11]); w1.z = pk2(p[12], p[13]); w1.w = pk2(p[14], p[15]);
    const bf16x8 pf0 = __builtin_bit_cast(bf16x8, w0), pf1 = __builtin_bit_cast(bf16x8, w1);
    O0 = __builtin_amdgcn_mfma_f32_32x32x16_bf16(vf[0][0], pf0, O0, 0, 0, 0); O0 = __builtin_amdgcn_mfma_f32_32x32x16_bf16(vf[1][0], pf1, O0, 0, 0, 0);
    O1 = __builtin_amdgcn_mfma_f32_32x32x16_bf16(vf[0][1], pf0, O1, 0, 0, 0); O1 = __builtin_amdgcn_mfma_f32_32x32x16_bf16(vf[1][1], pf1, O1, 0, 0, 0);
}
__device__ __forceinline__ void attn_fox_unit(Frame& F, const bf16_t* Qh, const bf16_t* Kh, const bf16_t* Vth, const float* CFh, const int qb, bf16_t* AOp) {
    const int lane = opaque_i(F.lane), r32 = lane & 31, hi = lane >> 5, r32p = pi32(r32), wave = F.wave, q0 = 256 * qb + 32 * wave, q = q0 + r32;
    LAS unsigned char* ring = F.lds; const unsigned ring_a = (unsigned)(uintptr_t)ring + 16u * (unsigned)lane, cf_a = (unsigned)(uintptr_t)ring + (unsigned)AT_CF + 32u * (unsigned)hi;
    bf16x8 qr[4];
#pragma unroll
    for (int d0 = 0; d0 < 4; ++d0) qr[d0] = *(const bf16x8*)(Qh + (size_t)q * 64 + 16 * d0 + 8 * hi);
    { const f32x4 cv = *(const f32x4*)(CFh + 4 * F.tid); *(LAS f32x4*)(ring + AT_CF + 16 * F.tid) = -cv; }
    asm volatile("s_waitcnt vmcnt(0) lgkmcnt(0)" ::: "memory"); __builtin_amdgcn_s_barrier();
    const int NT = 4 * qb + 4, my_last = 4 * qb + (wave >> 1), jdiag = wave & 1;
    attn_dma_tile(Kh, Vth, NT - 1, ring, wave, r32, r32p, hi);
    attn_dma_tile(Kh, Vth, NT - 2, ring + AT_SLOT, wave, r32, r32p, hi);
    f32x16 O0 = f32x16{}, O1 = f32x16{}; float m = -INFINITY, l = 0.f;
    int slot = 0;
#pragma unroll 1
    for (int T = NT - 1; T >= 0; --T) {
        if (T > 0) asm volatile("s_waitcnt vmcnt(2)" ::: "memory"); else asm volatile("s_waitcnt vmcnt(0)" ::: "memory");
        __builtin_amdgcn_s_barrier();
        if (T >= 2) { const int fs = (slot == 0) ? 2 : slot - 1; attn_dma_tile(Kh, Vth, T - 2, ring + fs * AT_SLOT, wave, r32, r32p, hi); }
        if (T <= my_last) {
            const unsigned sa = ring_a + (unsigned)(slot * AT_SLOT);
            if (T == my_last) {
                if (jdiag == 1) { attn_fox_sub<1>(qr, O0, O1, m, l, sa, cf_a + 4u * (unsigned)(64 * T + 32), 1, 64 * T + 32, q, hi); attn_fox_sub<0>(qr, O0, O1, m, l, sa, cf_a + 4u * (unsigned)(64 * T), 0, 64 * T, q, hi); }
                else attn_fox_sub<1>(qr, O0, O1, m, l, sa, cf_a + 4u * (unsigned)(64 * T), 0, 64 * T, q, hi);
            } else { attn_fox_sub<0>(qr, O0, O1, m, l, sa, cf_a + 4u * (unsigned)(64 * T + 32), 1, 64 * T + 32, q, hi); attn_fox_sub<0>(qr, O0, O1, m, l, sa, cf_a + 4u * (unsigned)(64 * T), 0, 64 * T, q, hi); }
        }
        slot = (slot == 2) ? 0 : slot + 1;
    }
    const float linv = 1.f / (l + __shfl_xor(l, 32));
    bf16_t* orow = AOp + (size_t)q * DM;
#pragma unroll
    for (int g = 0; g < 4; ++g) { u32x2 w;
        w.x = pk2(O0[4 * g] * linv, O0[4 * g + 1] * linv); w.y = pk2(O0[4 * g + 2] * linv, O0[4 * g + 3] * linv); *(u32x2*)(orow + 8 * g + 4 * hi) = w;
        w.x = pk2(O1[4 * g] * linv, O1[4 * g + 1] * linv); w.y = pk2(O1[4 * g + 2] * linv, O1[4 * g + 3] * linv); *(u32x2*)(orow + 32 + 8 * g + 4 * hi) = w; }
    asm volatile("s_waitcnt vmcnt(0) lgkmcnt(0)" ::: "memory"); __builtin_amdgcn_s_barrier();
}
__device__ __forceinline__ void phase_attn_fox(Frame& F, const bf16_t* QH, const bf16_t* KH, const bf16_t* VT, const float* CF, bf16_t* AO) {
    for (int ug = F.vcu; ug < NB * 8 * 2; ug += F.G) {
        const int bh = ug >> 1, b = bh >> 3, h = bh & 7; const size_t hb = (size_t)(b * 16 + h);
#pragma unroll 1
        for (int i = 0; i < 4; ++i) { const int base = (i >> 1) * 2 + (ug & 1), qb = (i & 1) ? 7 - base : base;
            attn_fox_unit(F, QH + hb * 2048 * 64, KH + hb * 2048 * 64, VT + hb * 64 * 2048, CF + (size_t)bh * 2048, qb, AO + (size_t)b * 2048 * DM + h * 64); }
    }
}

template <int MODE>
__device__ __forceinline__ void attn_moba_sub(const bf16x8 (&qr)[4], f32x16& O0, f32x16& O1, float& m, float& l, unsigned saddr, int j, int kv0, int q, int q0, int hi, float slope2, bool rowok) {
    bf16x8 kf[4], vf[2][2];
    asm volatile("ds_read_b128 %0, %8\n\tds_read_b128 %1, %8 offset:1024\n\tds_read_b128 %2, %8 offset:2048\n\tds_read_b128 %3, %8 offset:3072\n\t"
                 "ds_read_b128 %4, %9\n\tds_read_b128 %5, %9 offset:1024\n\tds_read_b128 %6, %9 offset:2048\n\tds_read_b128 %7, %9 offset:3072\n\ts_waitcnt lgkmcnt(0)"
                 : "=&v"(kf[0]), "=&v"(kf[1]), "=&v"(kf[2]), "=&v"(kf[3]), "=&v"(vf[0][0]), "=&v"(vf[0][1]), "=&v"(vf[1][0]), "=&v"(vf[1][1])
                 : "v"(saddr + (unsigned)j * 4096u), "v"(saddr + 8192u + (unsigned)j * 4096u) : "memory");
    f32x16 S; const float sbase = slope2 * (float)(kv0 + 8 * hi - q0);
#pragma unroll
    for (int r = 0; r < 16; ++r) S[r] = sbase + slope2 * (float)((r & 7) + 16 * (r >> 3));
#pragma unroll
    for (int d0 = 0; d0 < 4; ++d0) S = __builtin_amdgcn_mfma_f32_32x32x16_bf16(kf[d0], qr[d0], S, 0, 0, 0);
    if (MODE == 1) {
#pragma unroll
        for (int r = 0; r < 16; ++r) { const int key = kv0 + (r & 7) + 8 * hi + 16 * (r >> 3); if (key > q) S[r] = -INFINITY; }
    }
    if (MODE == 2) { if (!rowok) {
#pragma unroll
        for (int r = 0; r < 16; ++r) S[r] = -INFINITY; } }
    float rm = fmaxf(fmaxf(S[0], S[1]), fmaxf(S[2], S[3]));
#pragma unroll
    for (int r = 4; r < 16; r += 4) rm = fmaxf(rm, fmaxf(fmaxf(S[r], S[r + 1]), fmaxf(S[r + 2], S[r + 3])));
    { const auto rr = __builtin_amdgcn_permlane32_swap(__float_as_uint(rm), __float_as_uint(rm), false, false); rm = fmaxf(__uint_as_float(rr[0]), __uint_as_float(rr[1])); }
    if (__any(rm > m)) { const float mn = fmaxf(fmaxf(m, rm), -1e30f); const float alpha = __builtin_amdgcn_exp2f(m - mn); l *= alpha; O0 *= alpha; O1 *= alpha; m = mn; }
    float p[16]; float ps = 0.f;
#pragma unroll
    for (int r = 0; r < 16; ++r) { p[r] = __builtin_amdgcn_exp2f(S[r] - m); ps += p[r]; }
    l += ps;
    u32x4 w0, w1;
    w0.x = pk2(p[0], p[1]); w0.y = pk2(p[2], p[3]); w0.z = pk2(p[4], p[5]); w0.w = pk2(p[6], p[7]);
    w1.x = pk2(p[8], p[9]); w1.y = pk2(p[10], p[11]); w1.z = pk2(p[12], p[13]); w1.w = pk2(p[14], p[15]);
    const bf16x8 pf0 = __builtin_bit_cast(bf16x8, w0), pf1 = __builtin_bit_cast(bf16x8, w1);
    O0 = __builtin_amdgcn_mfma_f32_32x32x16_bf16(vf[0][0], pf0, O0, 0, 0, 0); O0 = __builtin_amdgcn_mfma_f32_32x32x16_bf16(vf[1][0], pf1, O0, 0, 0, 0);
    O1 = __builtin_amdgcn_mfma_f32_32x32x16_bf16(vf[0][1], pf0, O1, 0, 0, 0); O1 = __builtin_amdgcn_mfma_f32_32x32x16_bf16(vf[1][1], pf1, O1, 0, 0, 0);
}
__device__ __forceinline__ void attn_moba_unit(Frame& F, const bf16_t* Qh, const bf16_t* Kh, const bf16_t* Vth, const float* KMh, const float slope2, const int qb, bf16_t* AOp) {
    const int lane = opaque_i(F.lane), r32 = lane & 31, hi = lane >> 5, r32p = pi32(r32), wave = F.wave, q0 = 256 * qb + 32 * wave, q = q0 + r32;
    LAS unsigned char* ring = F.lds; const unsigned ring_a = (unsigned)(uintptr_t)ring + 16u * (unsigned)lane;
    bf16x8 qr[4];
#pragma unroll
    for (int d0 = 0; d0 < 4; ++d0) qr[d0] = *(const bf16x8*)(Qh + (size_t)q * 64 + 16 * d0 + 8 * hi);
    f32x16 G = f32x16{};
#pragma unroll
    for (int d0 = 0; d0 < 4; ++d0) { u32x4 kw = {0u, 0u, 0u, 0u};
        if (r32 < 8) { const float* kmp = KMh + r32 * 64 + 16 * d0 + 8 * hi; kw = pack8(*(const f32x4*)kmp, *(const f32x4*)(kmp + 4)); }
        G = __builtin_amdgcn_mfma_f32_32x32x16_bf16(__builtin_bit_cast(bf16x8, kw), qr[d0], G, 0, 0, 0); }
    float gate[8];
#pragma unroll
    for (int n = 0; n < 4; ++n) { const float own = G[n], oth = __shfl_xor(own, 32); gate[n] = hi ? oth : own; gate[n + 4] = hi ? own : oth; }
    unsigned sel = 0u; const int nsel = qb < 3 ? qb : 3;
#pragma unroll
    for (int r = 0; r < 3; ++r) if (r < nsel) { float best = -INFINITY; int bi = 0;
#pragma unroll
        for (int n = 0; n < 8; ++n) if (n < qb && !((sel >> n) & 1u) && gate[n] > best) { best = gate[n]; bi = n; }
        sel |= 1u << bi; }
    unsigned wsel = 0u;
#pragma unroll
    for (int n = 0; n < 8; ++n) if (__any((sel >> n) & 1u)) wsel |= 1u << n;
    asm volatile("s_waitcnt vmcnt(0) lgkmcnt(0)" ::: "memory"); __builtin_amdgcn_s_barrier();
    const int NT = 4 * qb + 4, my_last = 4 * qb + (wave >> 1), jdiag = wave & 1;
    attn_dma_tile(Kh, Vth, NT - 1, ring, wave, r32, r32p, hi);
    attn_dma_tile(Kh, Vth, NT - 2, ring + AT_SLOT, wave, r32, r32p, hi);
    f32x16 O0 = f32x16{}, O1 = f32x16{}; float m = -INFINITY, l = 0.f;
    int slot = 0;
#pragma unroll 1
    for (int T = NT - 1; T >= 0; --T) {
        if (T > 0) asm volatile("s_waitcnt vmcnt(2)" ::: "memory"); else asm volatile("s_waitcnt vmcnt(0)" ::: "memory");
        __builtin_amdgcn_s_barrier();
        if (T >= 2) { const int fs = (slot == 0) ? 2 : slot - 1; attn_dma_tile(Kh, Vth, T - 2, ring + fs * AT_SLOT, wave, r32, r32p, hi); }
        const unsigned sa = ring_a + (unsigned)(slot * AT_SLOT);
        if (T >= 4 * qb) {
            if (T == my_last) {
                if (jdiag == 1) { attn_moba_sub<1>(qr, O0, O1, m, l, sa, 1, 64 * T + 32, q, q0, hi, slope2, true); attn_moba_sub<0>(qr, O0, O1, m, l, sa, 0, 64 * T, q, q0, hi, slope2, true); }
                else attn_moba_sub<1>(qr, O0, O1, m, l, sa, 0, 64 * T, q, q0, hi, slope2, true);
            } else if (T < my_last) { attn_moba_sub<0>(qr, O0, O1, m, l, sa, 1, 64 * T + 32, q, q0, hi, slope2, true); attn_moba_sub<0>(qr, O0, O1, m, l, sa, 0, 64 * T, q, q0, hi, slope2, true); }
        } else if ((wsel >> (T >> 2)) & 1u) {
            const bool rowok = (sel >> (T >> 2)) & 1u;
            attn_moba_sub<2>(qr, O0, O1, m, l, sa, 1, 64 * T + 32, q, q0, hi, slope2, rowok); attn_moba_sub<2>(qr, O0, O1, m, l, sa, 0, 64 * T, q, q0, hi, slope2, rowok);
        }
        slot = (slot == 2) ? 0 : slot + 1;
    }
    const float linv = 1.f / (l + __shfl_xor(l, 32));
    bf16_t* orow = AOp + (size_t)q * DM;
#pragma unroll
    for (int g = 0; g < 4; ++g) { u32x2 w;
        w.x = pk2(O0[4 * g] * linv, O0[4 * g + 1] * linv); w.y = pk2(O0[4 * g + 2] * linv, O0[4 * g + 3] * linv); *(u32x2*)(orow + 8 * g + 4 * hi) = w;
        w.x = pk2(O1[4 * g] * linv, O1[4 * g + 1] * linv); w.y = pk2(O1[4 * g + 2] * linv, O1[4 * g + 3] * linv); *(u32x2*)(orow + 32 + 8 * g + 4 * hi) = w; }
    asm volatile("s_waitcnt vmcnt(0) lgkmcnt(0)" ::: "memory"); __builtin_amdgcn_s_barrier();
}
__device__ __forceinline__ void phase_attn_moba(Frame& F, const bf16_t* QD, const bf16_t* KD, const bf16_t* VTD, const float* KMEAN, bf16_t* AO) {
    for (int ug = F.vcu; ug < NB * 8 * 2; ug += F.G) {
        const int bh = ug >> 1, b = bh >> 3, h = bh & 7; const size_t hb = (size_t)bh;
        const float slope2 = __builtin_amdgcn_exp2f(-(float)(h + 1)) * LOG2E;
#pragma unroll 1
        for (int i = 0; i < 4; ++i) { const int base = (i >> 1) * 2 + (ug & 1), qb = (i & 1) ? 7 - base : base;
            attn_moba_unit(F, QD + hb * 2048 * 64, KD + hb * 2048 * 64, VTD + hb * 64 * 2048, KMEAN + (size_t)bh * 8 * 64, slope2, qb, AO + (size_t)b * 2048 * DM + 512 + h * 64); }
    }
}
__device__ __forceinline__ void phase_pool(Frame& F, const bf16_t* XC, const bf16_t* PWT, const float* pool_scale, bf16_t* AO) {
    const int gw = F.vcu * NWAVES + F.wave, NGW = F.G * NWAVES, lane = opaque_i(F.lane), r32 = lane & 31, hi = lane >> 5;
    for (int it = gw; it < (TOK / 32) * 4; it += NGW) {
        const int g = it & 3, t0 = (it >> 2) * 32, t = t0 + r32, tl = t & 2047, w = 2 << g;
        const int cnt = (tl + 1) < w ? (tl + 1) : w; const float rc = 1.f / (float)cnt;
        f32x16 acc[4];
#pragma unroll
        for (int nb = 0; nb < 4; ++nb) acc[nb] = f32x16{};
#pragma unroll 1
        for (int kk = 0; kk < 8; ++kk) {
            const int c0 = g * 128 + kk * 16 + hi * 8;
            const u32x4 self = *(const u32x4*)(XC + (size_t)t * 512 + c0);
            float s[8] = {0.f, 0.f, 0.f, 0.f, 0.f, 0.f, 0.f, 0.f};
            for (int i = 0; i < cnt; ++i) { const u32x4 x = *(const u32x4*)(XC + (size_t)(t - i) * 512 + c0);
                s[0] += bf_lo(x.x); s[1] += bf_hi(x.x); s[2] += bf_lo(x.y); s[3] += bf_hi(x.y); s[4] += bf_lo(x.z); s[5] += bf_hi(x.z); s[6] += bf_lo(x.w); s[7] += bf_hi(x.w); }
            u32x4 pa; pa.x = pk2(s[0] * rc - bf_lo(self.x), s[1] * rc - bf_hi(self.x)); pa.y = pk2(s[2] * rc - bf_lo(self.y), s[3] * rc - bf_hi(self.y));
            pa.z = pk2(s[4] * rc - bf_lo(self.z), s[5] * rc - bf_hi(self.z)); pa.w = pk2(s[6] * rc - bf_lo(self.w), s[7] * rc - bf_hi(self.w));
            const bf16x8 af = __builtin_bit_cast(bf16x8, pa);
#pragma unroll
            for (int nb = 0; nb < 4; ++nb) { const bf16x8 bfr = *(const bf16x8*)(PWT + ((size_t)g * 128 + nb * 32 + r32) * 128 + kk * 16 + hi * 8);
                acc[nb] = __builtin_amdgcn_mfma_f32_32x32x16_bf16(af, bfr, acc[nb], 0, 0, 0); }
        }
#pragma unroll
        for (int nb = 0; nb < 4; ++nb) { const int col = g * 128 + nb * 32 + r32; const float sc = pool_scale[col];
#pragma unroll
            for (int r = 0; r < 16; ++r) { const int row = (r & 3) + 8 * (r >> 2) + 4 * hi; AO[(size_t)(t0 + row) * DM + col] = (bf16_t)f2bf(acc[nb][r] * sc); } }
    }
}

__device__ __forceinline__ void phase_topk_naive(Frame& F, const bf16_t* QP, const bf16_t* K1B, const bf16_t* K2B, unsigned short* EID, float* GATE) {
    const int gw = F.vcu * NWAVES + F.wave, NGW = F.G * NWAVES, lane = opaque_i(F.lane);
    for (int task = gw; task < TOK * 8; task += NGW) {
        const int t = task >> 3, h = task & 7;
        const bf16_t* qrow = QP + (size_t)t * 2048 + h * 256; const bf16_t* k1 = K1B + (size_t)h * 128 * 128; const bf16_t* k2 = K2B + (size_t)h * 128 * 128;
        float s1a = 0.f, s1b = 0.f, s2a = 0.f, s2b = 0.f;
#pragma unroll 4
        for (int c = 0; c < 16; ++c) { const u32x4 q1 = *(const u32x4*)(qrow + 8 * c), q2 = *(const u32x4*)(qrow + 128 + 8 * c);
            s1a = dot8(*(const u32x4*)(k1 + (size_t)lane * 128 + 8 * c), q1, s1a); s1b = dot8(*(const u32x4*)(k1 + (size_t)(lane + 64) * 128 + 8 * c), q1, s1b);
            s2a = dot8(*(const u32x4*)(k2 + (size_t)lane * 128 + 8 * c), q2, s2a); s2b = dot8(*(const u32x4*)(k2 + (size_t)(lane + 64) * 128 + 8 * c), q2, s2b); }
        unsigned A = (f2ord(s1a) & ~127u) | (unsigned)(127 - lane), B = (f2ord(s1b) & ~127u) | (unsigned)(63 - lane);
        unsigned top1 = 0u, top2 = 0u, topc = 0u;
        for (int r = 0; r < 16; ++r) { const unsigned m = wave_umax(A > B ? A : B); if (lane == r) top1 = m; if (A == m) A = 0u; if (B == m) B = 0u; }
        A = (f2ord(s2a) & ~127u) | (unsigned)(127 - lane); B = (f2ord(s2b) & ~127u) | (unsigned)(63 - lane);
        for (int r = 0; r < 16; ++r) { const unsigned m = wave_umax(A > B ? A : B); if (lane == r) top2 = m; if (A == m) A = 0u; if (B == m) B = 0u; }
        const float v1 = ord2f(top1 & ~127u), v2 = ord2f(top2 & ~127u); const int i1 = 127 - (int)(top1 & 127u), i2 = 127 - (int)(top2 & 127u);
        const float va = __shfl(v1, lane >> 2); unsigned C[4];
#pragma unroll
        for (int j = 0; j < 4; ++j) { const float vb = __shfl(v2, (lane & 3) * 4 + j); C[j] = (f2ord(va + vb) & ~255u) | (unsigned)(255 - (lane * 4 + j)); }
        for (int r = 0; r < 16; ++r) { unsigned m = C[0] > C[1] ? C[0] : C[1]; const unsigned m2 = C[2] > C[3] ? C[2] : C[3]; m = wave_umax(m > m2 ? m : m2); if (lane == r) topc = m;
#pragma unroll
            for (int j = 0; j < 4; ++j) if (C[j] == m) C[j] = 0u; }
        const int c = 255 - (int)(topc & 255u); const float val = ord2f(topc & ~255u);
        const int ia = __shfl(i1, c >> 4), ib = __shfl(i2, c & 15);
        const float v0 = __shfl(val, 0); const float e = (lane < 16) ? __expf(val - v0) : 0.f; const float sum = wave_sum(e);
        if (lane < 16) { EID[(size_t)t * 128 + h * 16 + lane] = (unsigned short)(ia * 128 + ib); GATE[(size_t)t * 128 + h * 16 + lane] = e / sum; }
    }
}

#define DEVFN __device__ __forceinline__
template <int OFF, int N, int TOT> DEVFN void bitonic_sort_desc(unsigned (&a)[TOT]) {
#pragma unroll
    for (int k = 2; k <= N; k <<= 1)
#pragma unroll
        for (int j = k >> 1; j > 0; j >>= 1)
#pragma unroll
            for (int i = 0; i < N; ++i) { const int l = i ^ j; if (l > i) { const bool desc = ((i & k) == 0); const unsigned x = a[OFF + i], y = a[OFF + l];
                const unsigned mx = x > y ? x : y, mn = x > y ? y : x; a[OFF + i] = desc ? mx : mn; a[OFF + l] = desc ? mn : mx; } }
}
constexpr int OE16_N = 63;
constexpr unsigned char OE16[63][2] = {{0,1}, {2,3}, {0,2}, {1,3}, {1,2}, {4,5}, {6,7}, {4,6}, {5,7}, {5,6}, {0,4}, {2,6}, {2,4}, {1,5}, {3,7}, {3,5}, {1,2}, {3,4}, {5,6}, {8,9}, {10,11}, {8,10}, {9,11}, {9,10}, {12,13}, {14,15}, {12,14}, {13,15}, {13,14}, {8,12}, {10,14}, {10,12}, {9,13}, {11,15}, {11,13}, {9,10}, {11,12}, {13,14}, {0,8}, {4,12}, {4,8}, {2,10}, {6,14}, {6,10}, {2,4}, {6,8}, {10,12}, {1,9}, {5,13}, {5,9}, {3,11}, {7,15}, {7,11}, {3,5}, {7,9}, {11,13}, {1,2}, {3,4}, {5,6}, {7,8}, {9,10}, {11,12}, {13,14}};
template <int OFF, int TOT> DEVFN void sort16_desc(unsigned (&a)[TOT]) {
#pragma unroll
    for (int q = 0; q < OE16_N; ++q) { const int i = OFF + OE16[q][0], l = OFF + OE16[q][1]; const unsigned x = a[i], y = a[l]; a[i] = x > y ? x : y; a[l] = x > y ? y : x; }
}
template <int OFF, int TOT> DEVFN void bitonic_merge16_desc(unsigned (&a)[TOT]) {
#pragma unroll
    for (int j = 8; j > 0; j >>= 1)
#pragma unroll
        for (int i = 0; i < 16; ++i) { const int l = i ^ j; if (l > i) { const unsigned x = a[OFF + i], y = a[OFF + l]; a[OFF + i] = x > y ? x : y; a[OFF + l] = x > y ? y : x; } }
}
template <int A, int B, int TOT> DEVFN void merge_top16(unsigned (&a)[TOT]) {
#pragma unroll
    for (int i = 0; i < 16; ++i) { const unsigned x = a[A + i], y = a[B + 15 - i]; a[A + i] = x > y ? x : y; }
    bitonic_merge16_desc<A, TOT>(a);
}
DEVFN void top16of64(unsigned (&a)[64]) {
    sort16_desc<0, 64>(a); sort16_desc<16, 64>(a); sort16_desc<32, 64>(a); sort16_desc<48, 64>(a);
    merge_top16<0, 16, 64>(a); merge_top16<32, 48, 64>(a); merge_top16<0, 32, 64>(a);
}

__device__ __forceinline__ void phase_topk(Frame& F, const bf16_t* QP, const bf16_t* K1B, const bf16_t* K2B, unsigned short* EID, float* GATE) {
    const int gw = F.vcu * NWAVES + F.wave, NGW = F.G * NWAVES, lane = opaque_i(F.lane), r32 = lane & 31, hi = lane >> 5;
    LAS unsigned* I1s = (LAS unsigned*)(F.lds + F.wave * 8192); LAS unsigned* I2s = I1s + 1024;
    for (int task = gw; task < (TOK / 32) * 8; task += NGW) {
        const int tile = task >> 3, h = task & 7, t = tile * 32 + r32;
        unsigned V1[16], V2[16]; unsigned h4 = (unsigned)hi << 2; asm volatile("" : "+v"(h4));
#pragma unroll
        for (int half = 0; half < 2; ++half) {
            const bf16_t* qrow = QP + (size_t)t * 2048 + h * 256 + half * 128 + 8 * hi;
            bf16x8 qf[8];
#pragma unroll
            for (int kk = 0; kk < 8; ++kk) qf[kk] = *(const bf16x8*)(qrow + 16 * kk);
            unsigned K[64];
#pragma unroll
            for (int nb = 0; nb < 4; ++nb) { f32x16 acc = f32x16{};
                const bf16_t* kb = (half ? K2B : K1B) + ((size_t)h * 128 + nb * 32 + r32) * 128 + 8 * hi; asm volatile("" : "+v"(kb));
#pragma unroll
                for (int kk = 0; kk < 8; ++kk) acc = __builtin_amdgcn_mfma_f32_32x32x16_bf16(*(const bf16x8*)(kb + 16 * kk), qf[kk], acc, 0, 0, 0);
#pragma unroll
                for (int r = 0; r < 16; ++r) K[nb * 16 + r] = ((f2ord(acc[r]) & ~127u) | (unsigned)(127 - (nb * 32 + (r & 3) + 8 * (r >> 2)))) ^ h4;
                __builtin_amdgcn_sched_barrier(0); }
            __builtin_amdgcn_sched_barrier(0); top16of64(K); __builtin_amdgcn_sched_barrier(0);
            unsigned C[16];
#pragma unroll
            for (int i = 0; i < 16; ++i) { const unsigned y = (unsigned)__shfl_xor((int)K[15 - i], 32); C[i] = K[i] > y ? K[i] : y; }
            bitonic_merge16_desc<0, 16>(C);
#pragma unroll
            for (int i = 0; i < 16; ++i) { if (half == 0) V1[i] = C[i]; else V2[i] = C[i]; }
            __builtin_amdgcn_sched_barrier(0);
        }
        float f1[16], f2[16];
#pragma unroll
        for (int a = 0; a < 16; ++a) { I1s[a * 64 + lane] = 127u - (V1[a] & 127u); I2s[a * 64 + lane] = 127u - (V2[a] & 127u); f1[a] = ord2f(V1[a] & ~127u); f2[a] = ord2f(V2[a] & ~127u); }
        __builtin_amdgcn_sched_barrier(0);
        unsigned Cd[64];
    Cd[0] = (f2ord(f1[0] + f2[0]) & ~255u) | 255u;
    Cd[1] = (f2ord(f1[0] + f2[1]) & ~255u) | 254u;
    Cd[2] = (f2ord(f1[0] + f2[2]) & ~255u) | 253u;
    Cd[3] = (f2ord(f1[0] + f2[3]) & ~255u) | 252u;
    Cd[4] = (f2ord(f1[0] + f2[4]) & ~255u) | 251u;
    Cd[5] = (f2ord(f1[0] + f2[5]) & ~255u) | 250u;
    Cd[6] = (f2ord(f1[0] + f2[6]) & ~255u) | 249u;
    Cd[7] = (f2ord(f1[0] + f2[7]) & ~255u) | 248u;
    Cd[8] = (f2ord(f1[0] + f2[8]) & ~255u) | 247u;
    Cd[9] = (f2ord(f1[0] + f2[9]) & ~255u) | 246u;
    Cd[10] = (f2ord(f1[0] + f2[10]) & ~255u) | 245u;
    Cd[11] = (f2ord(f1[0] + f2[11]) & ~255u) | 244u;
    Cd[12] = (f2ord(f1[0] + f2[12]) & ~255u) | 243u;
    Cd[13] = (f2ord(f1[0] + f2[13]) & ~255u) | 242u;
    Cd[14] = (f2ord(f1[0] + f2[14]) & ~255u) | 241u;
    Cd[15] = (f2ord(f1[0] + f2[15]) & ~255u) | 240u;
    Cd[16] = (f2ord(f1[1] + f2[0]) & ~255u) | 239u;
    Cd[17] = (f2ord(f1[1] + f2[1]) & ~255u) | 238u;
    Cd[18] = (f2ord(f1[1] + f2[2]) & ~255u) | 237u;
    Cd[19] = (f2ord(f1[1] + f2[3]) & ~255u) | 236u;
    Cd[20] = (f2ord(f1[1] + f2[4]) & ~255u) | 235u;
    Cd[21] = (f2ord(f1[1] + f2[5]) & ~255u) | 234u;
    Cd[22] = (f2ord(f1[1] + f2[6]) & ~255u) | 233u;
    Cd[23] = (f2ord(f1[1] + f2[7]) & ~255u) | 232u;
    Cd[24] = (f2ord(f1[2] + f2[0]) & ~255u) | 223u;
    Cd[25] = (f2ord(f1[2] + f2[1]) & ~255u) | 222u;
    Cd[26] = (f2ord(f1[2] + f2[2]) & ~255u) | 221u;
    Cd[27] = (f2ord(f1[2] + f2[3]) & ~255u) | 220u;
    Cd[28] = (f2ord(f1[2] + f2[4]) & ~255u) | 219u;
    Cd[29] = (f2ord(f1[3] + f2[0]) & ~255u) | 207u;
    Cd[30] = (f2ord(f1[3] + f2[1]) & ~255u) | 206u;
    Cd[31] = (f2ord(f1[3] + f2[2]) & ~255u) | 205u;
    Cd[32] = (f2ord(f1[3] + f2[3]) & ~255u) | 204u;
    Cd[33] = (f2ord(f1[4] + f2[0]) & ~255u) | 191u;
    Cd[34] = (f2ord(f1[4] + f2[1]) & ~255u) | 190u;
    Cd[35] = (f2ord(f1[4] + f2[2]) & ~255u) | 189u;
    Cd[36] = (f2ord(f1[5] + f2[0]) & ~255u) | 175u;
    Cd[37] = (f2ord(f1[5] + f2[1]) & ~255u) | 174u;
    Cd[38] = (f2ord(f1[6] + f2[0]) & ~255u) | 159u;
    Cd[39] = (f2ord(f1[6] + f2[1]) & ~255u) | 158u;
    Cd[40] = (f2ord(f1[7] + f2[0]) & ~255u) | 143u;
    Cd[41] = (f2ord(f1[7] + f2[1]) & ~255u) | 142u;
    Cd[42] = (f2ord(f1[8] + f2[0]) & ~255u) | 127u;
    Cd[43] = (f2ord(f1[9] + f2[0]) & ~255u) | 111u;
    Cd[44] = (f2ord(f1[10] + f2[0]) & ~255u) | 95u;
    Cd[45] = (f2ord(f1[11] + f2[0]) & ~255u) | 79u;
    Cd[46] = (f2ord(f1[12] + f2[0]) & ~255u) | 63u;
    Cd[47] = (f2ord(f1[13] + f2[0]) & ~255u) | 47u;
    Cd[48] = (f2ord(f1[14] + f2[0]) & ~255u) | 31u;
    Cd[49] = (f2ord(f1[15] + f2[0]) & ~255u) | 15u;
    Cd[50] = 0u;
    Cd[51] = 0u;
    Cd[52] = 0u;
    Cd[53] = 0u;
    Cd[54] = 0u;
    Cd[55] = 0u;
    Cd[56] = 0u;
    Cd[57] = 0u;
    Cd[58] = 0u;
    Cd[59] = 0u;
    Cd[60] = 0u;
    Cd[61] = 0u;
    Cd[62] = 0u;
    Cd[63] = 0u;
        __builtin_amdgcn_sched_barrier(0); top16of64(Cd); __builtin_amdgcn_sched_barrier(0);
        LDS_WAIT();
        unsigned eid[16]; float e[16]; float sum = 0.f; const float v0 = ord2f(Cd[0] & ~255u);
#pragma unroll
        for (int r = 0; r < 16; ++r) { const unsigned c = 255u - (Cd[r] & 255u); eid[r] = I1s[(c >> 4) * 64 + lane] * 128u + I2s[(c & 15u) * 64 + lane];
            e[r] = __builtin_amdgcn_exp2f((ord2f(Cd[r] & ~255u) - v0) * LOG2E); sum += e[r]; }
        const float inv = 1.f / sum;
        u32x4 ew; ew.x = (hi ? eid[8] : eid[0]) | ((hi ? eid[9] : eid[1]) << 16); ew.y = (hi ? eid[10] : eid[2]) | ((hi ? eid[11] : eid[3]) << 16);
        ew.z = (hi ? eid[12] : eid[4]) | ((hi ? eid[13] : eid[5]) << 16); ew.w = (hi ? eid[14] : eid[6]) | ((hi ? eid[15] : eid[7]) << 16);
        *(u32x4*)(EID + (size_t)t * 128 + h * 16 + 8 * hi) = ew;
        const f32x4 g0 = {(hi ? e[8] : e[0]) * inv, (hi ? e[9] : e[1]) * inv, (hi ? e[10] : e[2]) * inv, (hi ? e[11] : e[3]) * inv};
        const f32x4 g1 = {(hi ? e[12] : e[4]) * inv, (hi ? e[13] : e[5]) * inv, (hi ? e[14] : e[6]) * inv, (hi ? e[15] : e[7]) * inv};
        *(f32x4*)(GATE + (size_t)t * 128 + h * 16 + 8 * hi) = g0; *(f32x4*)(GATE + (size_t)t * 128 + h * 16 + 8 * hi + 4) = g1;
        LDS_WAIT();
    }
}

typedef float f32x2 __attribute__((ext_vector_type(2)));
__device__ __forceinline__ float dpp_f(float v, int sel) {
    const int iv = __builtin_bit_cast(int, v); int r;
    if (sel == 0) r = __builtin_amdgcn_update_dpp(0, iv, 0xB1, 0xf, 0xf, true); else if (sel == 1) r = __builtin_amdgcn_update_dpp(0, iv, 0x4E, 0xf, 0xf, true); else r = __builtin_amdgcn_update_dpp(0, iv, 0x141, 0xf, 0xf, true);
    return __builtin_bit_cast(float, r);
}
__device__ __forceinline__ float gelu_erf(float v) {
    const float av = fabsf(v), d = av * 0.2316418882f + 1.0f; const float t = __builtin_amdgcn_rcpf(d);
    float q = t * 0.5307027145f + (-0.7265760135f); q = q * t + 0.7107068705f; q = q * t + (-0.142248368f); q = q * t + 0.127414796f; q = q * t;
    const float e = __builtin_amdgcn_exp2f((v * v) * (-0.72134752044f));
    const float m = v * (q * e), r = v - m; return v < 0.f ? m : r;
}
typedef _Float16 h16x2 __attribute__((ext_vector_type(2)));
__device__ __forceinline__ h16x2 bf8_lo2(unsigned w) { return __builtin_bit_cast(h16x2, __builtin_amdgcn_perm(0u, w, 0x010c000cu)); }
__device__ __forceinline__ h16x2 bf8_hi2(unsigned w) { return __builtin_bit_cast(h16x2, __builtin_amdgcn_perm(0u, w, 0x030c020cu)); }
__device__ __forceinline__ h16x2 bf16pair_to_h2(unsigned w) { h16x2 r; r.x = (_Float16)bf_lo(w); r.y = (_Float16)bf_hi(w); return r; }
#define PEER_E(ev0_, ev1_, w_) (int)((((w_) < 8 ? (ev0_) : (ev1_))[((w_) & 7) >> 1] >> (16 * ((w_) & 1))) & 0xffffu)
#define GLD16(dst_, ptr_) asm volatile("global_load_dwordx4 %0, %1, off" : "=v"(dst_) : "v"(ptr_) : "memory")
__device__ __forceinline__ void phase_peer_u(Frame& F, const bf16_t* XB, const float* rsp, int rsmode, const unsigned short* EID, const unsigned char* U8S, float* PREP) {
    const int lane = opaque_i(F.lane), i16 = (lane >> 3) * 16, c = lane & 7, b = (int)blockIdx.x, x = b & 7, step = (F.G >> 3) * NWAVES;
    const unsigned char* tab = U8S + (size_t)x * NEXP * 128 + 16 * c;
    int t = (b >> 3) * NWAVES + F.wave;
    u32x4 evB0, evB1, xrA0, xrA1, xrB0, xrB1; u32x4 uw[16];
    {   const u32x4 e0 = *(const u32x4*)(EID + (size_t)t * 128 + i16), e1 = *(const u32x4*)(EID + (size_t)t * 128 + i16 + 8);
        xrA0 = *(const u32x4*)(XB + (size_t)t * DM + 128 * x + 16 * c); xrA1 = *(const u32x4*)(XB + (size_t)t * DM + 128 * x + 16 * c + 8);
        const int tn = (t + step < TOK) ? t + step : t;
        evB0 = *(const u32x4*)(EID + (size_t)tn * 128 + i16); evB1 = *(const u32x4*)(EID + (size_t)tn * 128 + i16 + 8);
        xrB0 = *(const u32x4*)(XB + (size_t)tn * DM + 128 * x + 16 * c); xrB1 = *(const u32x4*)(XB + (size_t)tn * DM + 128 * x + 16 * c + 8);
        asm volatile("s_waitcnt vmcnt(0)" : "+v"(evB0), "+v"(evB1), "+v"(xrA0), "+v"(xrA1), "+v"(xrB0), "+v"(xrB1) :: "memory");
#pragma unroll
        for (int w = 0; w < 16; ++w) { const unsigned char* rp = tab + (size_t)PEER_E(e0, e1, w) * 128; GLD16(uw[w], rp); } }
#pragma unroll 1
    for (; t < TOK; t += step) {
        const int tnn = (t + 2 * step < TOK) ? t + 2 * step : t;
        u32x4 evC0, evC1, xrC0, xrC1;
        { const unsigned short* ep = EID + (size_t)tnn * 128 + i16; const bf16_t* xp = XB + (size_t)tnn * DM + 128 * x + 16 * c;
          GLD16(evC0, ep); GLD16(evC1, ep + 8); GLD16(xrC0, xp); GLD16(xrC1, xp + 8); }
        unsigned xq[4];
        { const float sx = row_scale(rsp, rsmode, t) * I8_SX;
#pragma unroll
          for (int k = 0; k < 4; ++k) { const unsigned w = (k < 2 ? xrA0 : xrA1)[2 * (k & 1)], w2 = (k < 2 ? xrA0 : xrA1)[2 * (k & 1) + 1];
              int q0 = __float2int_rn(bf_lo(w) * sx), q1 = __float2int_rn(bf_hi(w) * sx), q2 = __float2int_rn(bf_lo(w2) * sx), q3 = __float2int_rn(bf_hi(w2) * sx);
              q0 = q0 < -127 ? -127 : (q0 > 127 ? 127 : q0); q1 = q1 < -127 ? -127 : (q1 > 127 ? 127 : q1); q2 = q2 < -127 ? -127 : (q2 > 127 ? 127 : q2); q3 = q3 < -127 ? -127 : (q3 > 127 ? 127 : q3);
              xq[k] = ((unsigned)q0 & 0xffu) | (((unsigned)q1 & 0xffu) << 8) | (((unsigned)q2 & 0xffu) << 16) | ((unsigned)q3 << 24); } }
        int r_lo = 0, r_hi = 0;
#pragma unroll
        for (int w = 0; w < 16; ++w) {
            asm volatile("s_waitcnt vmcnt(19)" : "+v"(uw[w]) :: "memory");
            int p = __builtin_amdgcn_sdot4((int)uw[w][0], (int)xq[0], 0, false); int p2 = __builtin_amdgcn_sdot4((int)uw[w][1], (int)xq[1], 0, false);
            p = __builtin_amdgcn_sdot4((int)uw[w][2], (int)xq[2], p, false); p2 = __builtin_amdgcn_sdot4((int)uw[w][3], (int)xq[3], p2, false);
            p += p2;
            p += __builtin_amdgcn_update_dpp(0, p, 0xB1, 0xf, 0xf, true); p += __builtin_amdgcn_update_dpp(0, p, 0x4E, 0xf, 0xf, true); p += __builtin_amdgcn_update_dpp(0, p, 0x141, 0xf, 0xf, true);
            if (w < 8) r_lo = (c == w) ? p : r_lo; else r_hi = (c == (w & 7)) ? p : r_hi;
            { const unsigned char* rp = tab + (size_t)PEER_E(evB0, evB1, w) * 128; GLD16(uw[w], rp); }
            }
        float* dst = PREP + ((size_t)x * TOK + t) * 128 + i16 + c; dst[0] = (float)r_lo * (1.f / (I8_SU * I8_SX)); dst[8] = (float)r_hi * (1.f / (I8_SU * I8_SX));
        asm volatile("s_waitcnt vmcnt(16)" : "+v"(evC0), "+v"(evC1), "+v"(xrC0), "+v"(xrC1) :: "memory");
        evB0 = evC0; evB1 = evC1; xrA0 = xrB0; xrA1 = xrB1; xrB0 = xrC0; xrB1 = xrC1;
    }
    asm volatile("s_waitcnt vmcnt(0)" ::: "memory");
}
__device__ __forceinline__ void phase_peer_c(Frame& F, const float* PREP, const float* rsp, int rsmode, const float* GATE, bf16_t* ACO) {
    const int gw = F.vcu * NWAVES + F.wave, NGW = F.G * NWAVES, lane = opaque_i(F.lane);
    for (int t = gw; t < TOK; t += NGW) {
        float s0 = 0.f, s1 = 0.f;
#pragma unroll
        for (int x = 0; x < 8; ++x) { const float* p = PREP + ((size_t)x * TOK + t) * 128; s0 += p[lane]; s1 += p[64 + lane]; }
        const float rsu = 1.f;
        { const _Float16 h0 = (_Float16)(gelu_erf(s0 * rsu) * GATE[(size_t)t * 128 + lane] * (1.f / FP8_SV)), h1 = (_Float16)(gelu_erf(s1 * rsu) * GATE[(size_t)t * 128 + 64 + lane] * (1.f / FP8_SV));
          ACO[(size_t)t * 128 + lane] = __builtin_bit_cast(unsigned short, h0); ACO[(size_t)t * 128 + 64 + lane] = __builtin_bit_cast(unsigned short, h1); }
    }
}
#define PIN16(o_) asm volatile("" : "+v"(o_[0]), "+v"(o_[1]), "+v"(o_[2]), "+v"(o_[3]), "+v"(o_[4]), "+v"(o_[5]), "+v"(o_[6]), "+v"(o_[7]), "+v"(o_[8]), "+v"(o_[9]), "+v"(o_[10]), "+v"(o_[11]), "+v"(o_[12]), "+v"(o_[13]), "+v"(o_[14]), "+v"(o_[15]))
#define GLD4(dst_, ptr_) asm volatile("global_load_dword %0, %1, off" : "=v"(dst_) : "v"(ptr_) : "memory")
__device__ __forceinline__ void phase_peer_v(Frame& F, bf16_t* XB, const unsigned short* EID, const bf16_t* ACO, const unsigned char* V8S, float* SSQP) {
    const int lane = opaque_i(F.lane), i16 = (lane >> 3) * 16, c = lane & 7, b = (int)blockIdx.x, x = b & 7, step = (F.G >> 3) * NWAVES;
    const unsigned char* tab = V8S + (size_t)x * NEXP * 128 + 16 * c;
    const bool b3 = lane & 8;
    const int col = 128 * x + 16 * c + ((lane & 32) ? 8 : 0) + ((lane & 16) ? 4 : 0) + (b3 ? 2 : 0);
    int t = (b >> 3) * NWAVES + F.wave;
    u32x4 evB0, evB1, aA0, aA1, vw[16]; unsigned xfA;
    {   const u32x4 e0 = *(const u32x4*)(EID + (size_t)t * 128 + i16), e1 = *(const u32x4*)(EID + (size_t)t * 128 + i16 + 8);
        aA0 = *(const u32x4*)(ACO + (size_t)t * 128 + i16); aA1 = *(const u32x4*)(ACO + (size_t)t * 128 + i16 + 8);
        xfA = *(const unsigned*)(XB + (size_t)t * DM + col);
        const int tn = (t + step < TOK) ? t + step : t;
        evB0 = *(const u32x4*)(EID + (size_t)tn * 128 + i16); evB1 = *(const u32x4*)(EID + (size_t)tn * 128 + i16 + 8);
        asm volatile("s_waitcnt vmcnt(0)" : "+v"(evB0), "+v"(evB1), "+v"(aA0), "+v"(aA1), "+v"(xfA) :: "memory");
#pragma unroll
        for (int w = 0; w < 16; ++w) { const unsigned char* rp = tab + (size_t)PEER_E(e0, e1, w) * 128; GLD16(vw[w], rp); } }
#pragma unroll 1
    for (; t < TOK; t += step) {
        const int tn = (t + step < TOK) ? t + step : t, tnn = (t + 2 * step < TOK) ? t + 2 * step : t;
        u32x4 evC0, evC1, aB0, aB1; unsigned xfB;
        { const unsigned short* ep = EID + (size_t)tnn * 128 + i16; const bf16_t* ap = ACO + (size_t)tn * 128 + i16; const bf16_t* xp = XB + (size_t)tn * DM + col;
          GLD16(evC0, ep); GLD16(evC1, ep + 8); GLD16(aB0, ap); GLD16(aB1, ap + 8); GLD4(xfB, xp); }
        float o[16];
#pragma unroll
        for (int k = 0; k < 16; ++k) o[k] = 0.f;
#pragma unroll
        for (int w = 0; w < 16; w += 2) {
            asm volatile("s_waitcnt vmcnt(19)" : "+v"(vw[w]), "+v"(vw[w + 1]) :: "memory");
            const unsigned aw = (w < 8 ? aA0 : aA1)[(w & 7) >> 1]; const h16x2 a2 = __builtin_bit_cast(h16x2, aw);
#pragma unroll
            for (int k = 0; k < 4; ++k) { const unsigned r0 = vw[w][k], r1 = vw[w + 1][k];
                o[4 * k]     = __builtin_amdgcn_fdot2(__builtin_bit_cast(h16x2, __builtin_amdgcn_perm(r1, r0, 0x040c000cu)), a2, o[4 * k], false);
                o[4 * k + 1] = __builtin_amdgcn_fdot2(__builtin_bit_cast(h16x2, __builtin_amdgcn_perm(r1, r0, 0x050c010cu)), a2, o[4 * k + 1], false);
                o[4 * k + 2] = __builtin_amdgcn_fdot2(__builtin_bit_cast(h16x2, __builtin_amdgcn_perm(r1, r0, 0x060c020cu)), a2, o[4 * k + 2], false);
                o[4 * k + 3] = __builtin_amdgcn_fdot2(__builtin_bit_cast(h16x2, __builtin_amdgcn_perm(r1, r0, 0x070c030cu)), a2, o[4 * k + 3], false); }
            PIN16(o);
            { const unsigned char* rp = tab + (size_t)PEER_E(evB0, evB1, w) * 128; GLD16(vw[w], rp); }
            { const unsigned char* rp = tab + (size_t)PEER_E(evB0, evB1, w + 1) * 128; GLD16(vw[w + 1], rp); } }
        float h8[8], h4[4], h2[2];
#pragma unroll
        for (int k = 0; k < 8; ++k) { const auto r = __builtin_amdgcn_permlane32_swap(__float_as_uint(o[k]), __float_as_uint(o[8 + k]), false, false); h8[k] = __uint_as_float(r[0]) + __uint_as_float(r[1]); }
#pragma unroll
        for (int k = 0; k < 4; ++k) { const auto r = __builtin_amdgcn_permlane16_swap(__float_as_uint(h8[k]), __float_as_uint(h8[4 + k]), false, false); h4[k] = __uint_as_float(r[0]) + __uint_as_float(r[1]); }
#pragma unroll
        for (int k = 0; k < 2; ++k) { const float keep = b3 ? h4[2 + k] : h4[k], send = b3 ? h4[k] : h4[2 + k];
            h2[k] = keep + __builtin_bit_cast(float, __builtin_amdgcn_update_dpp(0, __builtin_bit_cast(int, send), 0x128, 0xf, 0xf, true)); }
        const f32x2 f = {bf_lo(xfA) + h2[0], bf_hi(xfA) + h2[1]};
        *(unsigned*)(XB + (size_t)t * DM + col) = pk2(f.x, f.y);
        const float ss = wave_total(f.x * f.x + f.y * f.y);
        if (lane == 0) { SSQP[(size_t)t * 16 + x] = ss; SSQP[(size_t)t * 16 + 8 + x] = 0.f; }
        asm volatile("s_waitcnt vmcnt(16)" : "+v"(evC0), "+v"(evC1), "+v"(aB0), "+v"(aB1), "+v"(xfB) :: "memory");
        aA0 = aB0; aA1 = aB1; evB0 = evC0; evB1 = evC1; xfA = xfB;
    }
    asm volatile("s_waitcnt vmcnt(0)" ::: "memory");
}

__device__ __forceinline__ void phase_final_norm(Frame& F, const bf16_t* XB, float* OUT, const float* SSQP, const float* norm_f) {
    const int gw = F.vcu * NWAVES + F.wave, NGW = F.G * NWAVES, lane = opaque_i(F.lane);
    for (int t = gw; t < TOK; t += NGW) { const float r = row_scale(SSQP, 1, t);
#pragma unroll
        for (int j = 0; j < 4; ++j) { const u32x2 w = *(const u32x2*)(XB + (size_t)t * DM + 256 * j + 4 * lane); const f32x4 x = {bf_lo(w.x), bf_hi(w.x), bf_lo(w.y), bf_hi(w.y)};
            *(f32x4*)(OUT + (size_t)t * DM + 256 * j + 4 * lane) = x * r * *(const f32x4*)(norm_f + 256 * j + 4 * lane); } }
}

constexpr int N_PHASES = 20;
struct Args { const float* in[16]; float* out; unsigned char* ws; int ph_lo, ph_hi; };
template <bool COOP>
__global__ void __launch_bounds__(NWAVES * 64, 2) mk_fwd(Args args) {
    extern __shared__ __attribute__((aligned(16))) unsigned char lds[];
    Frame F;
    F.lds = (LAS unsigned char*)lds;
    F.tid = threadIdx.x; F.lane = F.tid & 63; F.wave = __builtin_amdgcn_readfirstlane(F.tid >> 6);
    F.G = gridDim.x; { const int bx = blockIdx.x; F.vcu = (F.G % 8 == 0) ? (bx % 8) * (F.G / 8) + bx / 8 : bx; }
    Ptrs P;
    P.x = args.in[0]; P.norm_mix = args.in[1]; P.norm_ffn = args.in[2]; P.ev_w_in = args.in[3]; P.ev_b_f = args.in[4]; P.ev_w_out = args.in[5]; P.od_w_in = args.in[6];
    P.od_pool_w = args.in[7]; P.od_pool_scale = args.in[8]; P.od_w_out = args.in[9]; P.peer_wq = args.in[10]; P.peer_k1 = args.in[11]; P.peer_k2 = args.in[12];
    P.peer_u = args.in[13]; P.peer_v = args.in[14]; P.norm_f = args.in[15]; P.out = args.out; P.ws = args.ws;
    unsigned char* ws = args.ws;
    bf16_t* XB = (bf16_t*)(ws + WS_XB); bf16_t* AO = (bf16_t*)(ws + WS_AO); bf16_t* QP = (bf16_t*)(ws + WS_QP);
    unsigned short* EID = (unsigned short*)(ws + WS_EID); float* GATE = (float*)(ws + WS_GATE);
    float* RS0 = (float*)(ws + WS_RS0); float* SSQ2 = (float*)(ws + WS_SSQ2); float* PREP = (float*)(ws + WS_PREP); bf16_t* ACO = (bf16_t*)(ws + WS_ACO); float* SSQ1 = (float*)(ws + WS_SSQ1); float* SSQ3 = (float*)(ws + WS_SSQ3);
    const int lo = args.ph_lo, hi = args.ph_hi;
    volatile LAS unsigned* xbst = (volatile LAS unsigned*)(F.lds + RING_BYTES + 1024);
    if (F.tid < 4) xbst[F.tid] = 0u;
    __syncthreads();
    XcdBarrier xbar; xbar.bar = (unsigned*)(ws + WS_CTL) + 4096; xbar.x = 0; xbar.st = xbst;
    if (COOP) xbar = xcd_barrier_post((unsigned*)(ws + WS_CTL) + 4096, xbst);
#define IN(k) (lo <= (k) && (k) < hi)
#define SEAM(k) do { if (COOP && IN(k) && IN((k) + 1)) { if ((k) == 0) cg::this_grid().sync(); else xcd_barrier(xbar); } } while (0)
    if (IN(0)) { phase_p0(F, P); } SEAM(0);
    if (IN(1)) {
        pg8::Gemm g{XB, (const bf16_t*)(ws + WS_W1T), TOK, EVEN_PAD, DM}; pg8::StaticOrder S; S.init(TOK, EVEN_PAD, F.G, (int)blockIdx.x);
        EpiL0In E{RS0, (bf16_t*)(ws + WS_QH), (bf16_t*)(ws + WS_KH), (bf16_t*)(ws + WS_VT), (float*)(ws + WS_LF), P.ev_b_f};
        pg8::gemm_phase<EpiL0In, pg8::StaticOrder, true, true>(F.lds, g, S, E);
    } SEAM(1);
    if (IN(2)) { phase_cfscan(F, (const float*)(ws + WS_LF), (float*)(ws + WS_CF)); } SEAM(2);
    if (IN(3)) {
        phase_attn_fox(F, (const bf16_t*)(ws + WS_QH), (const bf16_t*)(ws + WS_KH), (const bf16_t*)(ws + WS_VT), (const float*)(ws + WS_CF), AO);
        phase_attn<1>(F, (const bf16_t*)(ws + WS_QH), (const bf16_t*)(ws + WS_KH), (const bf16_t*)(ws + WS_VT), 16, 8, nullptr, nullptr, AO, 512);
    } SEAM(3);
    if (IN(4)) {
        pg8::Gemm g{AO, (const bf16_t*)(ws + WS_W2T), TOK, DM, DM}; pg8::StaticOrder S; S.init(TOK, DM, F.G, (int)blockIdx.x);
        EpiRes<false> E{P.x, XB, SSQ1};
        pg8::gemm_phase<EpiRes<false>, pg8::StaticOrder, true, true>(F.lds, g, S, E);
    } SEAM(4);
    if (IN(5)) {
        pg8::Gemm g{XB, (const bf16_t*)(ws + WS_W3T), TOK, 2048, DM}; pg8::StaticOrder S; S.init(TOK, 2048, F.G, (int)blockIdx.x);
        EpiQ E{SSQ1, 1, QP};
        pg8::gemm_phase<EpiQ, pg8::StaticOrder, true, true>(F.lds, g, S, E);
    } SEAM(5);
    if (IN(6)) { phase_topk(F, QP, (const bf16_t*)(ws + WS_K1B), (const bf16_t*)(ws + WS_K2B), EID, GATE); } SEAM(6);
    if (IN(7)) { phase_peer_u(F, XB, SSQ1, 1, EID, ws + WS_U8S, PREP); } SEAM(7);
    if (IN(8)) { phase_peer_c(F, PREP, SSQ1, 1, GATE, ACO); } SEAM(8);
    if (IN(9)) { phase_peer_v(F, XB, EID, ACO, ws + WS_V8S, SSQ2); } SEAM(9);
    if (IN(10)) {
        pg8::Gemm g{XB, (const bf16_t*)(ws + WS_W4T), TOK, 2048, DM}; pg8::StaticOrder S; S.init(TOK, 2048, F.G, (int)blockIdx.x);
        EpiL1In E{SSQ2, 1, (bf16_t*)(ws + WS_QH), (bf16_t*)(ws + WS_QH + 32 * MiB), (bf16_t*)(ws + WS_KH), (bf16_t*)(ws + WS_KH + 32 * MiB)};
        pg8::gemm_phase<EpiL1In, pg8::StaticOrder, true, true>(F.lds, g, S, E);
    } SEAM(10);
    if (IN(11)) {
        phase_pool(F, (const bf16_t*)(ws + WS_QH), (const bf16_t*)(ws + WS_PWT), P.od_pool_scale, AO);
        phase_kmean(F, (const bf16_t*)(ws + WS_KH), (float*)(ws + WS_KMEAN));
    } SEAM(11);
    if (IN(12)) {
        phase_attn_moba(F, (const bf16_t*)(ws + WS_QH + 32 * MiB), (const bf16_t*)(ws + WS_KH), (const bf16_t*)(ws + WS_KH + 32 * MiB), (const float*)(ws + WS_KMEAN), AO);
    } SEAM(12);
    if (IN(13)) {
        pg8::Gemm g{AO, (const bf16_t*)(ws + WS_W5T), TOK, DM, DM}; pg8::StaticOrder S; S.init(TOK, DM, F.G, (int)blockIdx.x);
        EpiRes<true> E{XB, XB, SSQ3};
        pg8::gemm_phase<EpiRes<true>, pg8::StaticOrder, true, true>(F.lds, g, S, E);
    } SEAM(13);
    if (IN(14)) {
        pg8::Gemm g{XB, (const bf16_t*)(ws + WS_W6T), TOK, 2048, DM}; pg8::StaticOrder S; S.init(TOK, 2048, F.G, (int)blockIdx.x);
        EpiQ E{SSQ3, 1, QP};
        pg8::gemm_phase<EpiQ, pg8::StaticOrder, true, true>(F.lds, g, S, E);
    } SEAM(14);
    if (IN(15)) { phase_topk(F, QP, (const bf16_t*)(ws + WS_K1B) + 8 * 128 * 128, (const bf16_t*)(ws + WS_K2B) + 8 * 128 * 128, EID, GATE); } SEAM(15);
    if (IN(16)) { phase_peer_u(F, XB, SSQ3, 1, EID, ws + WS_U8S + (size_t)8 * NEXP * 128, PREP); } SEAM(16);
    if (IN(17)) { phase_peer_c(F, PREP, SSQ3, 1, GATE, ACO); } SEAM(17);
    if (IN(18)) { phase_peer_v(F, XB, EID, ACO, ws + WS_V8S + (size_t)8 * NEXP * 128, SSQ2); } SEAM(18);
    if (IN(19)) { phase_final_norm(F, XB, P.out, SSQ2, P.norm_f); }
#undef IN
#undef SEAM
}

extern "C" void kernel_launch(void* const* d_in, const int* in_sizes, int n_in, void* d_out, int out_size, void* d_ws, size_t ws_size, hipStream_t stream) {
    static int grid = 0;
    constexpr bool COOP = (MK_MULTI == 0);
    if (grid == 0) {
        if (n_in != 16 || in_sizes[0] != TOK * DM || out_size != TOK * DM || ws_size < WS_END) { fprintf(stderr, "kernel_launch: unexpected shapes (n_in %d, in0 %d, out %d, ws %zu)\n", n_in, n_in > 0 ? in_sizes[0] : -1, out_size, ws_size); grid = -1; return; }
        int dev = 0, cus = 0, per_cu = 0;
        if (hipGetDevice(&dev) != hipSuccess || hipDeviceGetAttribute(&cus, hipDeviceAttributeMultiprocessorCount, dev) != hipSuccess) { grid = -1; return; }
        if (hipFuncSetAttribute((const void*)mk_fwd<COOP>, hipFuncAttributeMaxDynamicSharedMemorySize, LDS_BYTES) != hipSuccess) { fprintf(stderr, "kernel_launch: hipFuncSetAttribute failed\n"); grid = -1; return; }
        if (hipOccupancyMaxActiveBlocksPerMultiprocessor(&per_cu, (const void*)mk_fwd<COOP>, NWAVES * 64, LDS_BYTES) != hipSuccess || per_cu < 1) { fprintf(stderr, "kernel_launch: occupancy query says %d\n", per_cu); per_cu = 1; }
        (void)hipGetLastError();
        grid = cus;
    }
    if (grid < 0) return;
    if (hipMemsetAsync((char*)d_ws + WS_CTL, 0, CTL_ZERO_BYTES, stream) != hipSuccess) { fprintf(stderr, "kernel_launch: memset failed\n"); return; }
    Args a{};
    for (int i = 0; i < 16; ++i) a.in[i] = (const float*)d_in[i];
    a.out = (float*)d_out; a.ws = (unsigned char*)d_ws;
    if (COOP) {
        a.ph_lo = 0; a.ph_hi = N_PHASES;
        void* kargs[] = {&a};
        const hipError_t e = hipLaunchCooperativeKernel((const void*)mk_fwd<COOP>, dim3(grid), dim3(NWAVES * 64), kargs, LDS_BYTES, stream);
        if (e != hipSuccess) fprintf(stderr, "kernel_launch: cooperative launch failed: %s (grid %d)\n", hipGetErrorString(e), grid);
    } else {
        for (int p = 0; p < N_PHASES; ++p) { a.ph_lo = p; a.ph_hi = p + 1; hipLaunchKernelGGL(mk_fwd<COOP>, dim3(grid), dim3(NWAVES * 64), LDS_BYTES, stream, a); }
    }
}
```

```cpp
#include <hip/hip_runtime.h>
#include <hip/hip_cooperative_groups.h>
#include <cstdio>
#include <cstdint>
#include <cmath>
namespace cg = cooperative_groups;

#ifndef MK_MULTI
#define MK_MULTI 0
#endif

namespace pg8 {
#define PG8_LAS __attribute__((address_space(3)))
typedef unsigned short bf16_t;
typedef short bf16x8 __attribute__((ext_vector_type(8)));
typedef float f32x4 __attribute__((ext_vector_type(4)));
typedef unsigned u32x4 __attribute__((ext_vector_type(4)));
constexpr int BM = 256, BK = 64, HALF = 128, HTB = HALF * BK * 2  , STAGE_BYTES = 8 * HTB, NXCD = 8, WGM = 8;

__host__ __device__ __forceinline__ int lds_byte(int r, int c) { const int st = (r >> 4) * 2 + (c >> 5), rr = r & 15, cc = c & 31, ob = rr * 64 + cc * 2; return st * 1024 + (ob ^ (((ob >> 9) & 1) << 5)); }
__host__ __device__ __forceinline__ void stage_rc(int b, int& R, int& C) { const int st = b / 1024, sb = b % 1024, swz = sb ^ (((sb >> 9) & 1) << 5); R = (st >> 1) * 16 + swz / 64; C = (st & 1) * 32 + (swz % 64) / 2; }
__host__ __device__ __forceinline__ int perm32(int rho) { const int n = rho >> 4, i = rho & 15; return 8 * (i >> 2) + 4 * n + (i & 3); }

struct Unit { int pm, pn; };
struct Gemm { const bf16_t* A; const bf16_t* Bt; int M, N, K; };

struct StaticOrder {
    int nM, nN, nwg, G, c;
    __host__ __device__ void init(int M, int N, int G_, int c_) { nM = M / BM; nN = N / BM; nwg = nM * nN; G = G_; c = c_; }
    __host__ __device__ bool next(int i, Unit& u) const {
        const long L = (long)i * G + c; if (L >= nwg) return false;
        int wgid = (int)L; { const int q = nwg / NXCD, r = nwg % NXCD, xcd = wgid % NXCD, off = wgid / NXCD; wgid = (xcd < r ? xcd * (q + 1) : r * (q + 1) + (xcd - r) * q) + off; }
        const int nig = WGM * nN, gid = wgid / nig, fm = gid * WGM, gsz = (nM - fm) < WGM ? (nM - fm) : WGM;
        u.pm = fm + ((wgid % nig) % gsz); u.pn = (wgid % nig) / gsz; return true;
    }
    __device__ __forceinline__ void a_ready(const Unit&) const {}
    __device__ __forceinline__ void done(const Unit&) const {}
};
__device__ __forceinline__ unsigned cvt_pk_bf16(float lo, float hi) { unsigned r; asm volatile("v_cvt_pk_bf16_f32 %0, %1, %2" : "=v"(r) : "v"(lo), "v"(hi)); return r; }
template <class Epi, class Sched, bool ALIGN_EPI = false, bool SP2 = false>
__device__ __forceinline__ void gemm_phase(PG8_LAS unsigned char* lds, const Gemm g, const Sched& S, const Epi& E) {
    const int tid = threadIdx.x, wid = __builtin_amdgcn_readfirstlane(tid >> 6), lane = tid & 63, wr = wid >> 2, wc = wid & 3, fr = lane & 15, fq = lane >> 4;
    const int K = g.K, nt = K / BK;
    unsigned voffA[2], voffB[2];
#pragma unroll
    for (int i = 0; i < 2; ++i) { int R, C; stage_rc(tid * 16 + i * 8192, R, C); const int Rb = Epi::PERM ? ((R & ~31) + perm32(R & 31)) : R;
        voffA[i] = (unsigned)(R * K + C) * 2u; voffB[i] = (unsigned)(Rb * K + C) * 2u; }
    const size_t kstep = (size_t)(BK * 2);
    const size_t hstep = (size_t)HALF * K * 2;
    const size_t tstep = 2 * hstep;
    const unsigned ldsw = (unsigned)wid * 1024u;
    const int aoff = lds_byte(wr * 64 + fr, fq * 8), boff = lds_byte(wc * 32 + fr, fq * 8);
#define PG8_SA(b, h) (((b) * 2 + (h)) * HTB)
#define PG8_SB(b, h) ((4 + (b) * 2 + (h)) * HTB)
#define PG8_STAGE(bufoff, gbase, voff) do { _Pragma("unroll") for (int _i = 0; _i < 2; ++_i) \
        __builtin_amdgcn_global_load_lds((const unsigned*)((const char*)(gbase) + (voff)[_i]), (PG8_LAS unsigned*)(lds + (bufoff) + ldsw + _i * 8192), 16, 0, 0); } while (0)
#define PG8_LDA(dst, b, h) do { _Pragma("unroll") for (int m = 0; m < 4; ++m) _Pragma("unroll") for (int k = 0; k < 2; ++k) dst[m][k] = *(const PG8_LAS bf16x8*)(lds + PG8_SA(b, h) + aoff + m * 2048 + k * 1024); } while (0)
#define PG8_LDB(dst, b, h) do { _Pragma("unroll") for (int n = 0; n < 2; ++n) _Pragma("unroll") for (int k = 0; k < 2; ++k) dst[n][k] = *(const PG8_LAS bf16x8*)(lds + PG8_SB(b, h) + boff + n * 2048 + k * 1024); } while (0)
#define PG8_MMA(ai, bj, At, Bt) do { __builtin_amdgcn_s_setprio(1); _Pragma("unroll") for (int m = 0; m < 4; ++m) _Pragma("unroll") for (int n = 0; n < 2; ++n) _Pragma("unroll") for (int k = 0; k < 2; ++k) \
        acc[ai][bj][m][n] = __builtin_amdgcn_mfma_f32_16x16x32_bf16(Bt[n][k], At[m][k], acc[ai][bj][m][n], 0, 0, 0); __builtin_amdgcn_s_setprio(0); } while (0)
#define PG8_WAIT_V(n) asm volatile("s_waitcnt vmcnt(" #n ")" ::: "memory")
#define PG8_WAIT_L(n) asm volatile("s_waitcnt lgkmcnt(" #n ")" ::: "memory")
#define PG8_BAR __builtin_amdgcn_s_barrier()
#define PG8_SCHED __builtin_amdgcn_sched_barrier(0)
    Unit cur, nxt; int ui = 0;
    if (!S.next(0, cur)) return;
    f32x4 acc[2][2][4][2];
#pragma unroll
    for (int a = 0; a < 2; ++a)
#pragma unroll
        for (int b = 0; b < 2; ++b)
#pragma unroll
            for (int m = 0; m < 4; ++m)
#pragma unroll
                for (int n = 0; n < 2; ++n) acc[a][b][m][n] = (f32x4){0.f, 0.f, 0.f, 0.f};
    bf16x8 At[4][2], B0[2][2], B1[2][2];
    const char* cA = (const char*)g.A + (size_t)cur.pm * tstep; const char* cB = (const char*)g.Bt + (size_t)cur.pn * tstep;
    S.a_ready(cur);
    if constexpr (SP2) {
        PG8_STAGE(PG8_SB(0, 0), cB, voffB); PG8_STAGE(PG8_SB(0, 1), cB + hstep, voffB); PG8_STAGE(PG8_SA(0, 0), cA, voffA); PG8_STAGE(PG8_SA(0, 1), cA + hstep, voffA);
        if (wr == 1) PG8_BAR;
        PG8_WAIT_V(2); PG8_BAR;
        PG8_STAGE(PG8_SB(1, 0), cB + kstep, voffB); PG8_STAGE(PG8_SA(1, 0), cA + kstep, voffA); PG8_STAGE(PG8_SB(1, 1), cB + hstep + kstep, voffB);
        PG8_WAIT_V(6); PG8_BAR;
    } else {
        PG8_STAGE(PG8_SB(0, 0), cB, voffB); PG8_STAGE(PG8_SA(0, 0), cA, voffA); PG8_STAGE(PG8_SB(0, 1), cB + hstep, voffB); PG8_STAGE(PG8_SA(0, 1), cA + hstep, voffA);
        if (wr == 1) PG8_BAR;
        PG8_WAIT_V(4); PG8_BAR;
        PG8_STAGE(PG8_SB(1, 0), cB + kstep, voffB); PG8_STAGE(PG8_SA(1, 0), cA + kstep, voffA); PG8_STAGE(PG8_SB(1, 1), cB + hstep + kstep, voffB);
        PG8_WAIT_V(6); PG8_BAR;
    }
    for (;;) {
        const bool has_next = S.next(ui + 1, nxt);
        const char* nA = has_next ? (const char*)g.A + (size_t)nxt.pm * tstep : cA; const char* nB = has_next ? (const char*)g.Bt + (size_t)nxt.pn * tstep : cB;
        for (int t = 0; t < nt; t += 2) {
            const bool last = (t == nt - 2);
            const char* a1 = cA + (size_t)(t + 1) * kstep;
            const char* a2 = last ? nA : cA + (size_t)(t + 2) * kstep; const char* b2 = last ? nB : cB + (size_t)(t + 2) * kstep;
            const char* a3 = a2 + kstep; const char* b3 = b2 + kstep;
            if (last && has_next) S.a_ready(nxt);
            if constexpr (SP2) {
            PG8_LDB(B0, 0, 0); PG8_LDB(B1, 0, 1); PG8_SCHED; PG8_LDA(At, 0, 0); PG8_STAGE(PG8_SA(1, 1), a1 + hstep, voffA);
            PG8_WAIT_V(8); PG8_WAIT_L(0); PG8_BAR; PG8_MMA(0, 0, At, B0); PG8_MMA(0, 1, At, B1); PG8_BAR; PG8_SCHED;
            PG8_LDA(At, 0, 1); PG8_STAGE(PG8_SB(0, 0), b2, voffB); PG8_STAGE(PG8_SB(0, 1), b2 + hstep, voffB); PG8_STAGE(PG8_SA(0, 0), a2, voffA);
            PG8_WAIT_V(8); PG8_WAIT_L(0); PG8_BAR; PG8_MMA(1, 0, At, B0); PG8_MMA(1, 1, At, B1); PG8_BAR; PG8_SCHED;
            PG8_LDB(B0, 1, 0); PG8_LDB(B1, 1, 1); PG8_SCHED; PG8_LDA(At, 1, 0); PG8_STAGE(PG8_SA(0, 1), a2 + hstep, voffA);
            PG8_WAIT_V(8); PG8_WAIT_L(0); PG8_BAR; PG8_MMA(0, 0, At, B0); PG8_MMA(0, 1, At, B1); PG8_BAR; PG8_SCHED;
            PG8_LDA(At, 1, 1); PG8_STAGE(PG8_SB(1, 0), b3, voffB); PG8_STAGE(PG8_SB(1, 1), b3 + hstep, voffB); PG8_STAGE(PG8_SA(1, 0), a3, voffA);
            PG8_WAIT_V(8); PG8_WAIT_L(0); PG8_BAR; PG8_MMA(1, 0, At, B0); PG8_MMA(1, 1, At, B1); PG8_BAR; PG8_SCHED;
            } else {
            PG8_LDB(B0, 0, 0); PG8_SCHED; PG8_LDA(At, 0, 0); PG8_STAGE(PG8_SA(1, 1), a1 + hstep, voffA);
            PG8_WAIT_L(8); PG8_BAR; PG8_WAIT_L(0); PG8_MMA(0, 0, At, B0); PG8_BAR; PG8_SCHED;
            PG8_LDB(B1, 0, 1); PG8_STAGE(PG8_SB(0, 0), b2, voffB);
            PG8_BAR; PG8_WAIT_L(0); PG8_MMA(0, 1, At, B1); PG8_BAR;
            PG8_LDA(At, 0, 1); PG8_STAGE(PG8_SA(0, 0), a2, voffA);
            PG8_BAR; PG8_WAIT_L(0); PG8_MMA(1, 0, At, B0); PG8_BAR; PG8_SCHED;
            PG8_STAGE(PG8_SB(0, 1), b2 + hstep, voffB);
            PG8_WAIT_V(6); PG8_BAR; PG8_MMA(1, 1, At, B1); PG8_BAR;
            PG8_LDB(B0, 1, 0); PG8_SCHED; PG8_LDA(At, 1, 0); PG8_STAGE(PG8_SA(0, 1), a2 + hstep, voffA);
            PG8_WAIT_L(8); PG8_BAR; PG8_WAIT_L(0); PG8_MMA(0, 0, At, B0); PG8_BAR; PG8_SCHED;
            PG8_LDB(B1, 1, 1); PG8_STAGE(PG8_SB(1, 0), b3, voffB);
            PG8_BAR; PG8_WAIT_L(0); PG8_MMA(0, 1, At, B1); PG8_BAR;
            PG8_LDA(At, 1, 1); PG8_STAGE(PG8_SA(1, 0), a3, voffA);
            PG8_BAR; PG8_WAIT_L(0); PG8_MMA(1, 0, At, B0); PG8_BAR; PG8_SCHED;
            PG8_STAGE(PG8_SB(1, 1), b3 + hstep, voffB);
            PG8_WAIT_V(6); PG8_BAR; PG8_MMA(1, 1, At, B1); PG8_BAR;
            }
        }
        if constexpr (ALIGN_EPI) { if (wr == 0) PG8_BAR; }
        if constexpr (!Epi::AFTER_DRAIN) { E(acc, cur, wr, wc, fr, fq); S.done(cur); }
        if (!has_next) break;
#pragma unroll
        for (int a = 0; a < 2; ++a)
#pragma unroll
            for (int b = 0; b < 2; ++b)
#pragma unroll
                for (int m = 0; m < 4; ++m)
#pragma unroll
                    for (int n = 0; n < 2; ++n) acc[a][b][m][n] = (f32x4){0.f, 0.f, 0.f, 0.f};
        cur = nxt; cA = nA; cB = nB; ++ui;
        if constexpr (ALIGN_EPI) { if (wr == 1) PG8_BAR; }
    }
    PG8_WAIT_V(0);
    if constexpr (!ALIGN_EPI) { if (wr == 0) PG8_BAR; }
    PG8_BAR;
    if constexpr (Epi::AFTER_DRAIN) { E.fused(acc, cur, wr, wc, fr, fq, lds, wid, lane); S.done(cur); }
#undef PG8_SA
#undef PG8_SB
#undef PG8_STAGE
#undef PG8_LDA
#undef PG8_LDB
#undef PG8_MMA
#undef PG8_WAIT_V
#undef PG8_WAIT_L
#undef PG8_BAR
#undef PG8_SCHED
}
}

constexpr int NB = 16, SEQ = 2048, DM = 1024, TOK = NB * SEQ;
constexpr int EVEN_IN = 3080, EVEN_PAD = 3328;
constexpr int NEXP = 16384;
constexpr float RMS_EPS = 1e-6f;
constexpr float LOG2E = 1.4426950408889634f;
constexpr float C2 = 0.125f * LOG2E;

constexpr size_t MiB = 1u << 20;
constexpr size_t WS_CTL = 0, CTL_ZERO_BYTES = 1 * MiB;
constexpr size_t WS_W1T = 1 * MiB;
constexpr size_t WS_W2T = 8 * MiB;
constexpr size_t WS_W4T = 10 * MiB;
constexpr size_t WS_W5T = 14 * MiB;
constexpr size_t WS_W3T = 16 * MiB;
constexpr size_t WS_W6T = 20 * MiB;
constexpr size_t WS_K1B = 24 * MiB;
constexpr size_t WS_K2B = 24 * MiB + 512 * 1024;
constexpr size_t WS_PWT = 25 * MiB;
constexpr size_t WS_LF  = 25 * MiB + 256 * 1024;
constexpr size_t WS_CF  = 26 * MiB + 256 * 1024;
constexpr size_t WS_KMEAN = 27 * MiB + 256 * 1024;
constexpr size_t WS_RS0 = 27 * MiB + 512 * 1024;
constexpr size_t WS_RS2 = 27 * MiB + 640 * 1024;
constexpr size_t WS_SSQ1 = 28 * MiB;
constexpr size_t WS_SSQ3 = 30 * MiB;
constexpr size_t WS_U8S = 32 * MiB;
constexpr size_t WS_V8S = 64 * MiB;
constexpr size_t WS_XB = 160 * MiB;
constexpr size_t WS_QH = 224 * MiB;
constexpr size_t WS_KH = 288 * MiB;
constexpr size_t WS_VT = 352 * MiB;
constexpr size_t WS_QP = 224 * MiB;
constexpr size_t WS_AO = 416 * MiB;
constexpr size_t WS_EID = 480 * MiB;
constexpr size_t WS_GATE = 488 * MiB;
constexpr size_t WS_SSQ2 = 504 * MiB;
constexpr size_t WS_PREP = 224 * MiB;
constexpr size_t WS_ACO = 416 * MiB;
constexpr size_t WS_END = 506 * MiB;

constexpr int RING_BYTES = 131072;
constexpr int LDS_BYTES = 147456;
constexpr int NWAVES = 8;

#define GAS __attribute__((address_space(1)))
#define LAS __attribute__((address_space(3)))
typedef unsigned short bf16_t;
typedef unsigned u32x4 __attribute__((ext_vector_type(4)));
typedef unsigned u32x2 __attribute__((ext_vector_type(2)));
typedef float f32x4 __attribute__((ext_vector_type(4)));
typedef float f32x16 __attribute__((ext_vector_type(16)));
typedef short bf16x8 __attribute__((ext_vector_type(8)));
typedef __bf16 bf16x2 __attribute__((ext_vector_type(2)));
#define LDS_WAIT() asm volatile("s_waitcnt lgkmcnt(0)" ::: "memory")

__device__ __forceinline__ int opaque_i(int v) { asm volatile("" : "+v"(v)); return v; }
__device__ __forceinline__ unsigned f2bf(float f) { unsigned u = __builtin_bit_cast(unsigned, f); return (u + 0x7fffu + ((u >> 16) & 1u)) >> 16; }
typedef float f32x2_pk __attribute__((ext_vector_type(2)));
__device__ __forceinline__ unsigned pk2(float lo, float hi) { const f32x2_pk v = {lo, hi}; return __builtin_bit_cast(unsigned, __builtin_convertvector(v, bf16x2)); }
__device__ __forceinline__ float bf_lo(unsigned u) { return __uint_as_float(u << 16); }
__device__ __forceinline__ float bf_hi(unsigned u) { return __uint_as_float(u & 0xffff0000u); }
__device__ __forceinline__ float dot2(unsigned a, unsigned b, float acc) { return __builtin_amdgcn_fdot2_f32_bf16(__builtin_bit_cast(bf16x2, a), __builtin_bit_cast(bf16x2, b), acc, false); }
__device__ __forceinline__ float dot8(u32x4 a, u32x4 b, float acc) { acc = dot2(a.x, b.x, acc); acc = dot2(a.y, b.y, acc); acc = dot2(a.z, b.z, acc); return dot2(a.w, b.w, acc); }
__device__ __forceinline__ u32x4 pack8(f32x4 a, f32x4 b) { u32x4 w; w.x = pk2(a[0], a[1]); w.y = pk2(a[2], a[3]); w.z = pk2(b[0], b[1]); w.w = pk2(b[2], b[3]); return w; }

__device__ __forceinline__ float wave_sum(float v) {
#pragma unroll
    for (int o = 1; o < 64; o <<= 1) v += __shfl_xor(v, o);
    return v;
}
__device__ __forceinline__ float wave_max(float v) {
#pragma unroll
    for (int o = 1; o < 64; o <<= 1) v = fmaxf(v, __shfl_xor(v, o));
    return v;
}
__device__ __forceinline__ unsigned wave_umax(unsigned v) {
#pragma unroll
    for (int o = 1; o < 64; o <<= 1) { const unsigned w = (unsigned)__shfl_xor((int)v, o); v = v > w ? v : w; }
    return v;
}
__device__ __forceinline__ float dpp_row_shr(float v, int n) {
    const int iv = __builtin_bit_cast(int, v); int r;
    switch (n) { case 1: r = __builtin_amdgcn_update_dpp(0, iv, 0x111, 0xf, 0xf, true); break; case 2: r = __builtin_amdgcn_update_dpp(0, iv, 0x112, 0xf, 0xf, true); break;
                 case 4: r = __builtin_amdgcn_update_dpp(0, iv, 0x114, 0xf, 0xf, true); break; default: r = __builtin_amdgcn_update_dpp(0, iv, 0x118, 0xf, 0xf, true); break; }
    return __builtin_bit_cast(float, r);
}
__device__ __forceinline__ float wave_total(float v) {
    v += dpp_row_shr(v, 1); v += dpp_row_shr(v, 2); v += dpp_row_shr(v, 4); v += dpp_row_shr(v, 8);
    v += __builtin_bit_cast(float, __builtin_amdgcn_update_dpp(0, __builtin_bit_cast(int, v), 0x142, 0xa, 0xf, false));
    v += __builtin_bit_cast(float, __builtin_amdgcn_update_dpp(0, __builtin_bit_cast(int, v), 0x143, 0xc, 0xf, false));
    return __builtin_bit_cast(float, __builtin_amdgcn_readlane(__builtin_bit_cast(int, v), 63));
}
__device__ __forceinline__ unsigned f2ord(float f) { const unsigned u = __float_as_uint(f); return (u & 0x80000000u) ? ~u : (u | 0x80000000u); }
__device__ __forceinline__ float ord2f(unsigned o) { const unsigned u = (o & 0x80000000u) ? (o & 0x7fffffffu) : ~o; return __uint_as_float(u); }

__device__ __forceinline__ float row_scale(const float* p, int mode, int t) {
    if (mode == 0) return p[t];
    const f32x4* q = (const f32x4*)(p + (size_t)t * 16); const f32x4 a = q[0], b = q[1], c = q[2], d = q[3];
    const float s = (((a[0] + a[1]) + (a[2] + a[3])) + ((b[0] + b[1]) + (b[2] + b[3]))) + (((c[0] + c[1]) + (c[2] + c[3])) + ((d[0] + d[1]) + (d[2] + d[3])));
    return rsqrtf(s * (1.f / DM) + RMS_EPS);
}

struct EpiL0In {
    static constexpr bool PERM = true, AFTER_DRAIN = false;
    const float* rs; bf16_t* QH; bf16_t* KH; bf16_t* VT; float* LF; const float* b_f;
    __device__ __forceinline__ void operator()(const f32x4 (&acc)[2][2][4][2], const pg8::Unit& u, int wr, int wc, int fr, int fq) const {
        const int pn = u.pn;
        if (pn == 12) {
            if (wc == 0 && fq == 0) {
#pragma unroll
                for (int ai = 0; ai < 2; ++ai)
#pragma unroll
                    for (int m = 0; m < 4; ++m) {
                        const int t = u.pm * 256 + ai * 128 + wr * 64 + m * 16 + fr; const float sc = rs[t]; const int b = t >> 11, s = t & 2047;
#pragma unroll
                        for (int n = 0; n < 2; ++n)
#pragma unroll
                            for (int e = 0; e < 4; ++e) { const int h = n * 4 + e; const float x = acc[ai][0][m][n][e] * sc + b_f[h];
                                const float ls = fminf(x, 0.f) - log1pf(expf(-fabsf(x)));
                                LF[(size_t)(b * 8 + h) * 2048 + s] = ls * LOG2E; }
                    }
            }
            return;
        }
        const int sec = pn >> 1, kind = sec % 3, hbase = (sec >= 3) ? 8 : 0;
#pragma unroll
        for (int ai = 0; ai < 2; ++ai)
#pragma unroll
            for (int m = 0; m < 4; ++m) {
                const int t = u.pm * 256 + ai * 128 + wr * 64 + m * 16 + fr; const int b = t >> 11, s = t & 2047;
                const float sc = rs[t] * (kind == 0 ? C2 : 1.f);
#pragma unroll
                for (int bj = 0; bj < 2; ++bj) {
                    const int cc = (pn & 1) * 256 + bj * 128 + wc * 32 + fq * 8, hh = hbase + (cc >> 6), d0 = cc & 63;
                    const f32x4 v0 = acc[ai][bj][m][0] * sc, v1 = acc[ai][bj][m][1] * sc;
                    if (kind < 2) { bf16_t* dst = (kind == 0 ? QH : KH) + ((size_t)(b * 16 + hh) * 2048 + s) * 64 + d0; *(u32x4*)dst = pack8(v0, v1); }
                    else { bf16_t* dst = VT + ((size_t)(b * 16 + hh) * 64 + d0) * 2048 + s;
                        dst[0 * 2048] = (bf16_t)f2bf(v0[0]); dst[1 * 2048] = (bf16_t)f2bf(v0[1]); dst[2 * 2048] = (bf16_t)f2bf(v0[2]); dst[3 * 2048] = (bf16_t)f2bf(v0[3]);
                        dst[4 * 2048] = (bf16_t)f2bf(v1[0]); dst[5 * 2048] = (bf16_t)f2bf(v1[1]); dst[6 * 2048] = (bf16_t)f2bf(v1[2]); dst[7 * 2048] = (bf16_t)f2bf(v1[3]); }
                }
            }
    }
};
struct EpiL1In {
    static constexpr bool PERM = true, AFTER_DRAIN = false;
    const float* rsp; int rsmode; bf16_t* XC; bf16_t* QD; bf16_t* KD; bf16_t* VTD;
    __device__ __forceinline__ void operator()(const f32x4 (&acc)[2][2][4][2], const pg8::Unit& u, int wr, int wc, int fr, int fq) const {
        const int pn = u.pn, kind = pn >> 1;
#pragma unroll
        for (int ai = 0; ai < 2; ++ai)
#pragma unroll
            for (int m = 0; m < 4; ++m) {
                const int t = u.pm * 256 + ai * 128 + wr * 64 + m * 16 + fr; const int b = t >> 11, s = t & 2047;
                const float sc = row_scale(rsp, rsmode, t) * (kind == 1 ? C2 : 1.f);
#pragma unroll
                for (int bj = 0; bj < 2; ++bj) {
                    const int cc = (pn & 1) * 256 + bj * 128 + wc * 32 + fq * 8, hh = cc >> 6, d0 = cc & 63;
                    const f32x4 v0 = acc[ai][bj][m][0] * sc, v1 = acc[ai][bj][m][1] * sc;
                    if (kind == 0) { *(u32x4*)(XC + (size_t)t * 512 + cc) = pack8(v0, v1); }
                    else if (kind < 3) { bf16_t* dst = (kind == 1 ? QD : KD) + ((size_t)(b * 8 + hh) * 2048 + s) * 64 + d0; *(u32x4*)dst = pack8(v0, v1); }
                    else { bf16_t* dst = VTD + ((size_t)(b * 8 + hh) * 64 + d0) * 2048 + s;
                        dst[0 * 2048] = (bf16_t)f2bf(v0[0]); dst[1 * 2048] = (bf16_t)f2bf(v0[1]); dst[2 * 2048] = (bf16_t)f2bf(v0[2]); dst[3 * 2048] = (bf16_t)f2bf(v0[3]);
                        dst[4 * 2048] = (bf16_t)f2bf(v1[0]); dst[5 * 2048] = (bf16_t)f2bf(v1[1]); dst[6 * 2048] = (bf16_t)f2bf(v1[2]); dst[7 * 2048] = (bf16_t)f2bf(v1[3]); }
                }
            }
    }
};
struct EpiQ {
    static constexpr bool PERM = true, AFTER_DRAIN = false;
    const float* rsp; int rsmode; bf16_t* Q;
    __device__ __forceinline__ void operator()(const f32x4 (&acc)[2][2][4][2], const pg8::Unit& u, int wr, int wc, int fr, int fq) const {
#pragma unroll
        for (int ai = 0; ai < 2; ++ai)
#pragma unroll
            for (int m = 0; m < 4; ++m) {
                const int t = u.pm * 256 + ai * 128 + wr * 64 + m * 16 + fr; const float sc = row_scale(rsp, rsmode, t);
#pragma unroll
                for (int bj = 0; bj < 2; ++bj) { const int c = u.pn * 256 + bj * 128 + wc * 32 + fq * 8;
                    *(u32x4*)(Q + (size_t)t * 2048 + c) = pack8(acc[ai][bj][m][0] * sc, acc[ai][bj][m][1] * sc); }
            }
    }
};
template <bool BASE_BF16>
struct EpiRes {
    static constexpr bool PERM = true, AFTER_DRAIN = false;
    const void* base; bf16_t* xb; float* ssqp;
    __device__ __forceinline__ void operator()(const f32x4 (&acc)[2][2][4][2], const pg8::Unit& u, int wr, int wc, int fr, int fq) const {
#pragma unroll
        for (int ai = 0; ai < 2; ++ai)
#pragma unroll
            for (int m = 0; m < 4; ++m) {
                const int t = u.pm * 256 + ai * 128 + wr * 64 + m * 16 + fr; float ss = 0.f;
#pragma unroll
                for (int bj = 0; bj < 2; ++bj) { const size_t off = (size_t)t * DM + u.pn * 256 + bj * 128 + wc * 32 + fq * 8;
                    f32x4 b0, b1;
                    if (BASE_BF16) { const u32x4 w = *(const u32x4*)((const bf16_t*)base + off); b0 = (f32x4){bf_lo(w.x), bf_hi(w.x), bf_lo(w.y), bf_hi(w.y)}; b1 = (f32x4){bf_lo(w.z), bf_hi(w.z), bf_lo(w.w), bf_hi(w.w)}; }
                    else { b0 = *(const f32x4*)((const float*)base + off); b1 = *(const f32x4*)((const float*)base + off + 4); }
                    const f32x4 o0 = b0 + acc[ai][bj][m][0], o1 = b1 + acc[ai][bj][m][1];
                    *(u32x4*)(xb + off) = pack8(o0, o1);
                    ss += (o0[0] * o0[0] + o0[1] * o0[1]) + (o0[2] * o0[2] + o0[3] * o0[3]) + (o1[0] * o1[0] + o1[1] * o1[1]) + (o1[2] * o1[2] + o1[3] * o1[3]); }
                ss += __shfl_xor(ss, 16); ss += __shfl_xor(ss, 32);
                if (fq == 0) ssqp[(size_t)t * 16 + u.pn * 4 + wc] = ss;
            }
    }
};

#define XB_TMO      128
#define XB_XCNT(j)  (256  + 64 * (j))
#define XB_XSUB(j)  (1280 + 64 * (j))
#define XB_XGEN(j)  (2304 + 64 * (j))
#define XB_TOP      3328
#define XB_TOPGEN   3392
#define XCD_BAR_WORDS 3456
#define XB_SPIN_CAP (1u << 18)

__device__ __forceinline__ unsigned xb_ld(unsigned* p)              { return __hip_atomic_load(p, __ATOMIC_RELAXED, __HIP_MEMORY_SCOPE_AGENT); }
__device__ __forceinline__ unsigned xb_add(unsigned* p, unsigned v) { return __hip_atomic_fetch_add(p, v, __ATOMIC_RELAXED, __HIP_MEMORY_SCOPE_AGENT); }
__device__ __forceinline__ unsigned xb_xcc_id() { return (unsigned)__builtin_amdgcn_s_getreg((3 << 11) | 20) & 0xFu; }
#define XB_SPIN(cond, bar) do { unsigned _sp = 0; while (cond) { __builtin_amdgcn_s_sleep(1); \
    if ((++_sp & 255u) == 0u) { if (xb_ld(&(bar)[XB_TMO])) break; if (_sp > XB_SPIN_CAP) { atomicAdd(&(bar)[XB_TMO], 1u); break; } } } } while (0)

struct XcdBarrier {
    unsigned* bar; unsigned x;
    volatile LAS unsigned* st;
};

__device__ __forceinline__ XcdBarrier xcd_barrier_post(unsigned* bar, volatile LAS unsigned* st) {
    XcdBarrier b; b.bar = bar; b.x = xb_xcc_id(); b.st = st;
    if (threadIdx.x == 0) (void)xb_add(&bar[XB_XCNT(b.x)], 1u);
    return b;
}
__device__ __forceinline__ void xcd_barrier_complete(unsigned* bar, unsigned x, unsigned& nloc, unsigned& nx) {
    const unsigned G = gridDim.x * gridDim.y * gridDim.z;
    unsigned sum, cnt, mine, sp = 0u;
    for (;;) {
        sum = 0u; cnt = 0u; mine = 0u;
#pragma unroll
        for (unsigned j = 0; j < 16; ++j) { const unsigned c = xb_ld(&bar[XB_XCNT(j)]); sum += c; cnt += (c > 0u) ? 1u : 0u; mine = (j == x) ? c : mine; }
        if (sum == G) break;
        __builtin_amdgcn_s_sleep(1);
        if ((++sp & 255u) == 0u) { if (xb_ld(&bar[XB_TMO])) break; if (sp > XB_SPIN_CAP) { atomicAdd(&bar[XB_TMO], 1u); break; } }
    }
    nloc = mine > 0u ? mine : 1u; nx = cnt > 0u ? cnt : 1u;
}

__device__ __forceinline__ void xcd_barrier(const XcdBarrier& b) {
    asm volatile("s_waitcnt vmcnt(0)" ::: "memory");
    __syncthreads();
    if (threadIdx.x == 0) {
        unsigned* bar = b.bar;
        __builtin_amdgcn_s_waitcnt(0);
        unsigned nloc = b.st[0], nx = b.st[1];
        if (nloc == 0u) { xcd_barrier_complete(bar, b.x, nloc, nx); b.st[0] = nloc; b.st[1] = nx; }
        const unsigned old = xb_add(&bar[XB_XSUB(b.x)], 1u);
        const unsigned gen = old / nloc;
        if (old + 1u == (gen + 1u) * nloc) {
            __builtin_amdgcn_fence(__ATOMIC_RELEASE, "agent");
            asm volatile("s_waitcnt vmcnt(0)" ::: "memory");
            const unsigned og = xb_add(&bar[XB_TOP], 1u);
            const unsigned tg = og / nx;
            if (og + 1u == (tg + 1u) * nx) xb_add(&bar[XB_TOPGEN], 1u);
            else XB_SPIN(xb_ld(&bar[XB_TOPGEN]) == tg, bar);
            __builtin_amdgcn_fence(__ATOMIC_ACQUIRE, "agent");
            xb_add(&bar[XB_XGEN(b.x)], 1u);
            asm volatile("s_waitcnt vmcnt(0)" ::: "memory");
        } else {
            XB_SPIN(xb_ld(&bar[XB_XGEN(b.x)]) == gen, bar);
            __builtin_amdgcn_fence(__ATOMIC_ACQUIRE, "agent");
            asm volatile("s_waitcnt vmcnt(0)" ::: "memory");
        }
    }
    __syncthreads();
}

struct Frame {
    LAS unsigned char* lds;
    int tid, lane, wave, vcu, G;
};

__device__ __forceinline__ int remap0(int n) { return n < 1536 ? n : (n < 1544 ? 3072 + (n - 1536) : n - 8); }
__device__ __forceinline__ void p0_transpose_item(const float* W, int K, int N, bf16_t* WT, const float* g, bool remap, LAS float* scr, int item, int lane) {
    const int nblk = (N + 31) / 32, kb = item / nblk, nb = item % nblk, k0 = 64 * kb, n0 = 32 * nb;
#pragma unroll 8
    for (int i = 0; i < 32; ++i) { const int kk = 2 * i + (lane >> 5), n = n0 + (lane & 31);
        float v = (n < N) ? W[(size_t)(k0 + kk) * N + n] : 0.f; if (g) v *= g[k0 + kk]; scr[kk * 33 + (lane & 31)] = v; }
    LDS_WAIT(); asm volatile("" ::: "memory");
    const int c = lane & 7;
#pragma unroll
    for (int j = 0; j < 4; ++j) { const int nl = (lane >> 3) + 8 * j, n = n0 + nl; const LAS float* s = scr + (8 * c) * 33 + nl;
        u32x4 o; o.x = pk2(s[0 * 33], s[1 * 33]); o.y = pk2(s[2 * 33], s[3 * 33]); o.z = pk2(s[4 * 33], s[5 * 33]); o.w = pk2(s[6 * 33], s[7 * 33]);
        if (n < N) { const int nn = remap ? remap0(n) : n; *(u32x4*)(WT + (size_t)nn * K + k0 + 8 * c) = o; } }
    LDS_WAIT(); asm volatile("" ::: "memory");
}
__device__ __forceinline__ float cvt_row_1024(const float* src, bf16_t* dst, const float* g, int lane) {
    const f32x4 a0 = *(const f32x4*)(src + 8 * lane), a1 = *(const f32x4*)(src + 8 * lane + 4), c0 = *(const f32x4*)(src + 512 + 8 * lane), c1 = *(const f32x4*)(src + 516 + 8 * lane);
    float ss = (a0[0] * a0[0] + a0[1] * a0[1]) + (a0[2] * a0[2] + a0[3] * a0[3]) + (a1[0] * a1[0] + a1[1] * a1[1]) + (a1[2] * a1[2] + a1[3] * a1[3])
             + (c0[0] * c0[0] + c0[1] * c0[1]) + (c0[2] * c0[2] + c0[3] * c0[3]) + (c1[0] * c1[0] + c1[1] * c1[1]) + (c1[2] * c1[2] + c1[3] * c1[3]);
    f32x4 b0 = a0, b1 = a1, d0 = c0, d1 = c1;
    if (g) { b0 = b0 * *(const f32x4*)(g + 8 * lane); b1 = b1 * *(const f32x4*)(g + 8 * lane + 4); d0 = d0 * *(const f32x4*)(g + 512 + 8 * lane); d1 = d1 * *(const f32x4*)(g + 516 + 8 * lane); }
    *(u32x4*)(dst + 8 * lane) = pack8(b0, b1); *(u32x4*)(dst + 512 + 8 * lane) = pack8(d0, d1);
    return ss;
}

constexpr float I8_SU = 600.f, I8_SX = 127.f / 6.f;
constexpr float FP8_SU = 64.f, FP8_SV = 8.f;
__device__ __forceinline__ void cvt_row_fp8_sliced(const float* src, unsigned char* tab  , int e, const float* g, float scale, int lane) {
#pragma unroll
    for (int j = 0; j < 4; ++j) { f32x4 a = *(const f32x4*)(src + 256 * j + 4 * lane) * scale; if (g) a = a * *(const f32x4*)(g + 256 * j + 4 * lane);
        int w = 0; w = __builtin_amdgcn_cvt_pk_bf8_f32(a[0], a[1], w, false); w = __builtin_amdgcn_cvt_pk_bf8_f32(a[2], a[3], w, true);
        const int x = 2 * j + (lane >> 5);
        *(unsigned*)(tab + ((size_t)x * NEXP + e) * 128 + 4 * (lane & 31)) = (unsigned)w; }
}
__device__ __forceinline__ void cvt_row_i8_sliced(const float* src, unsigned char* tab  , int e, const float* g, float scale, int lane) {
#pragma unroll
    for (int j = 0; j < 4; ++j) { f32x4 a = *(const f32x4*)(src + 256 * j + 4 * lane) * scale; if (g) a = a * *(const f32x4*)(g + 256 * j + 4 * lane);
        unsigned w = 0u;
#pragma unroll
        for (int q = 0; q < 4; ++q) { int v = __float2int_rn(a[q]); v = v < -127 ? -127 : (v > 127 ? 127 : v); w |= ((unsigned)v & 0xffu) << (8 * q); }
        const int x = 2 * j + (lane >> 5);
        *(unsigned*)(tab + ((size_t)x * NEXP + e) * 128 + 4 * (lane & 31)) = w; }
}
struct Ptrs {
    const float *x, *norm_mix, *norm_ffn, *ev_w_in, *ev_b_f, *ev_w_out, *od_w_in, *od_pool_w, *od_pool_scale, *od_w_out, *peer_wq, *peer_k1, *peer_k2, *peer_u, *peer_v, *norm_f;
    float* out; unsigned char* ws;
};

__device__ __forceinline__ void phase_p0(Frame& F, const Ptrs& P) {
    LAS float* scr = (LAS float*)(F.lds + F.wave * 16384);
    const int gw = F.vcu * NWAVES + F.wave, NGW = F.G * NWAVES, lane = opaque_i(F.lane);
    unsigned char* ws = P.ws;
    bf16_t* W1T = (bf16_t*)(ws + WS_W1T); bf16_t* W2T = (bf16_t*)(ws + WS_W2T); bf16_t* W4T = (bf16_t*)(ws + WS_W4T); bf16_t* W5T = (bf16_t*)(ws + WS_W5T);
    bf16_t* W3T = (bf16_t*)(ws + WS_W3T); bf16_t* W6T = (bf16_t*)(ws + WS_W6T); bf16_t* PWT = (bf16_t*)(ws + WS_PWT);
    constexpr int I1 = 16 * 97, I2 = 16 * 32, I4 = 16 * 64, I5 = I2, I3 = I4, I6 = I4, IP = 4 * 2 * 4;
    constexpr int NTR = I1 + I2 + I4 + I5 + I3 + I6 + IP;
    for (int it = gw; it < NTR; it += NGW) {
        int r = it;
        if (r < I1) { p0_transpose_item(P.ev_w_in, DM, EVEN_IN, W1T, P.norm_mix, true, scr, r, lane); continue; } r -= I1;
        if (r < I2) { p0_transpose_item(P.ev_w_out, DM, DM, W2T, nullptr, false, scr, r, lane); continue; } r -= I2;
        if (r < I4) { p0_transpose_item(P.od_w_in, DM, 2048, W4T, P.norm_mix + DM, false, scr, r, lane); continue; } r -= I4;
        if (r < I5) { p0_transpose_item(P.od_w_out, DM, DM, W5T, nullptr, false, scr, r, lane); continue; } r -= I5;
        if (r < I3) { p0_transpose_item(P.peer_wq, DM, 2048, W3T, P.norm_ffn, false, scr, r, lane); continue; } r -= I3;
        if (r < I6) { p0_transpose_item(P.peer_wq + (size_t)DM * 2048, DM, 2048, W6T, P.norm_ffn + DM, false, scr, r, lane); continue; } r -= I6;
        { const int g = r >> 3; p0_transpose_item(P.od_pool_w + (size_t)g * 128 * 128, 128, 128, PWT + (size_t)g * 128 * 128, nullptr, false, scr, r & 7, lane); }
    }
    constexpr int R_Z = EVEN_PAD - EVEN_IN, R_X = TOK, R_U = 2 * NEXP, R_V = 2 * NEXP, R_K = 2 * 256;
    constexpr int NROW = R_Z + R_X + R_U + R_V + R_K;
    bf16_t* XB = (bf16_t*)(ws + WS_XB); float* RS0 = (float*)(ws + WS_RS0);
    bf16_t* K1B = (bf16_t*)(ws + WS_K1B); bf16_t* K2B = (bf16_t*)(ws + WS_K2B);
    for (int it = gw; it < NROW; it += NGW) {
        int r = it;
        if (r < R_Z) { bf16_t* d = W1T + (size_t)(EVEN_IN + r) * DM; const u32x4 z = {0u, 0u, 0u, 0u}; *(u32x4*)(d + 8 * lane) = z; *(u32x4*)(d + 512 + 8 * lane) = z; continue; } r -= R_Z;
        if (r < R_X) { const float ss = wave_sum(cvt_row_1024(P.x + (size_t)r * DM, XB + (size_t)r * DM, nullptr, lane)); if (lane == 0) RS0[r] = rsqrtf(ss * (1.f / DM) + RMS_EPS); continue; } r -= R_X;
        if (r < R_U) { const int ly = r >= NEXP; cvt_row_i8_sliced(P.peer_u + (size_t)r * DM, ws + WS_U8S + (size_t)ly * 8 * NEXP * 128, r - ly * NEXP, P.norm_ffn + (ly ? DM : 0), I8_SU, lane); continue; } r -= R_U;
        if (r < R_V) { const int ly = r >= NEXP; cvt_row_fp8_sliced(P.peer_v + (size_t)r * DM, ws + WS_V8S + (size_t)ly * 8 * NEXP * 128, r - ly * NEXP, nullptr, FP8_SV, lane); continue; } r -= R_V;
        if (r < 256) (void)cvt_row_1024(P.peer_k1 + (size_t)r * 1024, K1B + (size_t)r * 1024, nullptr, lane);
        else (void)cvt_row_1024(P.peer_k2 + (size_t)(r - 256) * 1024, K2B + (size_t)(r - 256) * 1024, nullptr, lane);
    }
}

__device__ __forceinline__ void phase_cfscan(Frame& F, const float* LF, float* CFo) {
    const int gw = F.vcu * NWAVES + F.wave, NGW = F.G * NWAVES, lane = opaque_i(F.lane);
    for (int bh = gw; bh < NB * 8; bh += NGW) {
        const float* src = LF + (size_t)bh * 2048 + 32 * lane; float v[32];
#pragma unroll
        for (int i = 0; i < 8; ++i) { const f32x4 w = *(const f32x4*)(src + 4 * i); v[4 * i] = w[0]; v[4 * i + 1] = w[1]; v[4 * i + 2] = w[2]; v[4 * i + 3] = w[3]; }
#pragma unroll
        for (int i = 1; i < 32; ++i) v[i] += v[i - 1];
        const float tot = v[31]; float inc = tot;
#pragma unroll
        for (int o = 1; o < 64; o <<= 1) { const float w = __shfl_up(inc, o); if (lane >= o) inc += w; }
        const float excl = inc - tot; float* dst = CFo + (size_t)bh * 2048 + 32 * lane;
#pragma unroll
        for (int i = 0; i < 8; ++i) { f32x4 w = {v[4 * i] + excl, v[4 * i + 1] + excl, v[4 * i + 2] + excl, v[4 * i + 3] + excl}; *(f32x4*)(dst + 4 * i) = w; }
    }
}
__device__ __forceinline__ void phase_kmean(Frame& F, const bf16_t* KD, float* KMEAN) {
    const int gw = F.vcu * NWAVES + F.wave, NGW = F.G * NWAVES, lane = opaque_i(F.lane), jg = lane >> 3, dq = lane & 7;
    for (int it = gw; it < NB * 8 * 8; it += NGW) {
        const int bh = it >> 3, blk = it & 7; const bf16_t* src = KD + ((size_t)bh * 2048 + blk * 256 + jg) * 64 + 8 * dq; float s[8] = {0.f, 0.f, 0.f, 0.f, 0.f, 0.f, 0.f, 0.f};
#pragma unroll 8
        for (int i = 0; i < 32; ++i) { const u32x4 w = *(const u32x4*)(src + (size_t)i * 8 * 64);
            s[0] += bf_lo(w.x); s[1] += bf_hi(w.x); s[2] += bf_lo(w.y); s[3] += bf_hi(w.y); s[4] += bf_lo(w.z); s[5] += bf_hi(w.z); s[6] += bf_lo(w.w); s[7] += bf_hi(w.w); }
#pragma unroll
        for (int k = 0; k < 8; ++k) { s[k] += __shfl_xor(s[k], 8); s[k] += __shfl_xor(s[k], 16); s[k] += __shfl_xor(s[k], 32); }
        if (jg == 0) { float* d = KMEAN + (size_t)it * 64 + 8 * dq; *(f32x4*)d = (f32x4){s[0], s[1], s[2], s[3]} * (1.f / 256.f); *(f32x4*)(d + 4) = (f32x4){s[4], s[5], s[6], s[7]} * (1.f / 256.f); }
    }
}
__device__ __forceinline__ int lgi(int s) { return s + (s >> 5); }
__device__ __forceinline__ float lsn2f(float z2) { return -(fmaxf(z2, 0.f) + __log2f(1.f + exp2f(-fabsf(z2)))); }
template <int KIND>
__device__ __forceinline__ void attn_naive(Frame& F, const bf16_t* QH, const bf16_t* KH, const bf16_t* VT, int NH, int hbase, const float* CF, const float* KMEAN, bf16_t* AO, int ao_col0) {
    LAS float* lg = (LAS float*)(F.lds + F.wave * 8704);
    const int gw = F.vcu * NWAVES + F.wave, NGW = F.G * NWAVES, lane = opaque_i(F.lane);
    for (int qi = gw; qi < NB * 8 * SEQ; qi += NGW) {
        const int bh = qi >> 11, b = bh >> 3, h = bh & 7, hh = hbase + h;
        const int t = (bh & 1) ? (2047 - (qi & 2047)) : (qi & 2047);
        const size_t hb = (size_t)(b * NH + hh);
        const bf16_t* qp = QH + (hb * 2048 + t) * 64; const bf16_t* kp = KH + hb * 2048 * 64;
        float q[64];
#pragma unroll
        for (int c = 0; c < 8; ++c) { const u32x4 w = *(const u32x4*)(qp + 8 * c);
            q[8 * c] = bf_lo(w.x); q[8 * c + 1] = bf_hi(w.x); q[8 * c + 2] = bf_lo(w.y); q[8 * c + 3] = bf_hi(w.y); q[8 * c + 4] = bf_lo(w.z); q[8 * c + 5] = bf_hi(w.z); q[8 * c + 6] = bf_lo(w.w); q[8 * c + 7] = bf_hi(w.w); }
        unsigned sel = 0u; const int qb = t >> 8;
        if (KIND == 2) {
            float gate[8];
#pragma unroll
            for (int n = 0; n < 8; ++n) { const float* km = KMEAN + ((size_t)(b * 8 + h) * 8 + n) * 64; float a = 0.f;
#pragma unroll
                for (int d = 0; d < 64; ++d) a += q[d] * km[d];
                gate[n] = a; }
            const int nsel = qb < 3 ? qb : 3;
#pragma unroll
            for (int r = 0; r < 3; ++r) if (r < nsel) { float best = -INFINITY; int bi = 0;
#pragma unroll
                for (int n = 0; n < 8; ++n) if (n < qb && !((sel >> n) & 1u) && gate[n] > best) { best = gate[n]; bi = n; }
                sel |= 1u << bi; }
        }
        const int nk = (KIND == 1) ? t : t + 1;
        const int tp = (nk + 7) & ~7;
        const float cft = (KIND == 0) ? CF[(size_t)(b * 8 + h) * 2048 + t] : 0.f;
        const float slope2 = (KIND == 2) ? exp2f(-(float)(h + 1)) * LOG2E : 0.f;
        float mloc = -INFINITY;
        for (int s = lane; s < nk; s += 64) {
            float dot = 0.f;
#pragma unroll
            for (int c = 0; c < 8; ++c) { const u32x4 w = *(const u32x4*)(kp + (size_t)s * 64 + 8 * c);
                dot += q[8 * c] * bf_lo(w.x) + q[8 * c + 1] * bf_hi(w.x) + q[8 * c + 2] * bf_lo(w.y) + q[8 * c + 3] * bf_hi(w.y) + q[8 * c + 4] * bf_lo(w.z) + q[8 * c + 5] * bf_hi(w.z) + q[8 * c + 6] * bf_lo(w.w) + q[8 * c + 7] * bf_hi(w.w); }
            float v = dot;
            if (KIND == 0) v += cft - CF[(size_t)(b * 8 + h) * 2048 + s];
            if (KIND == 2) { const int n = s >> 8; const bool valid = (n == qb) || ((sel >> n) & 1u); v = valid ? v + slope2 * (float)(s - t) : -INFINITY; }
            lg[lgi(s)] = v; mloc = fmaxf(mloc, v);
        }
        float linv = 1.f;
        if (KIND != 1) {
            const float m = wave_max(mloc); float lsum = 0.f;
            for (int s = lane; s < tp; s += 64) { const float p = (s < nk) ? exp2f(lg[lgi(s)] - m) : 0.f; lg[lgi(s)] = p; lsum += p; }
            linv = 1.f / wave_sum(lsum);
        } else {
            float tot = 0.f;
            for (int i = 0; i < 32; ++i) { const int s = 32 * lane + i; if (s < nk) tot += lsn2f(lg[lgi(s)]); }
            float inc = tot;
#pragma unroll
            for (int o = 1; o < 64; o <<= 1) { const float w = __shfl_down(inc, o); if (lane + o < 64) inc += w; }
            float run = inc - tot;
            for (int i = 31; i >= 0; --i) { const int s = 32 * lane + i; float a = 0.f;
                if (s < nk) { const float z = lg[lgi(s)], l2 = lsn2f(z); a = exp2f(z + l2 + run); run += l2; }
                if (s < tp) lg[lgi(s)] = a; }
        }
        LDS_WAIT();
        const bf16_t* vp = VT + (hb * 64 + lane) * 2048; float o = 0.f;
        for (int s0 = 0; s0 < tp; s0 += 8) { const u32x4 w = *(const u32x4*)(vp + s0); const int i0 = lgi(s0);
            o += lg[i0] * bf_lo(w.x) + lg[i0 + 1] * bf_hi(w.x) + lg[i0 + 2] * bf_lo(w.y) + lg[i0 + 3] * bf_hi(w.y) + lg[i0 + 4] * bf_lo(w.z) + lg[i0 + 5] * bf_hi(w.z) + lg[i0 + 6] * bf_lo(w.w) + lg[i0 + 7] * bf_hi(w.w); }
        AO[(size_t)(b * 2048 + t) * DM + ao_col0 + h * 64 + lane] = (bf16_t)f2bf(o * linv);
        LDS_WAIT();
    }
}

__device__ __forceinline__ float lsn2q(float z2) { return -(fmaxf(z2, 0.f) + __builtin_amdgcn_logf(1.f + __builtin_amdgcn_exp2f(-fabsf(z2)))); }
__device__ __forceinline__ int pi32(int i) { return (i & ~12) | ((i & 4) << 1) | ((i & 8) >> 1); }
__device__ __forceinline__ void attn_load_k(bf16x8 (&kf)[4], const bf16_t* Kh, int kv0, int r32p, int hi) {
    const bf16_t* p = Kh + (size_t)(kv0 + r32p) * 64 + 8 * hi;
#pragma unroll
    for (int d0 = 0; d0 < 4; ++d0) kf[d0] = *(const bf16x8*)(p + 16 * d0);
}
__device__ __forceinline__ void attn_load_v(bf16x8 (&vf)[2][2], const bf16_t* Vth, int kv0, int r32, int hi) {
#pragma unroll
    for (int s = 0; s < 2; ++s)
#pragma unroll
        for (int dh = 0; dh < 2; ++dh) vf[s][dh] = *(const bf16x8*)(Vth + (size_t)(32 * dh + r32) * 2048 + kv0 + 16 * s + 8 * hi);
}
template <int KIND, int MODE>
__device__ __forceinline__ void attn_tile(const bf16x8 (&qr)[4], const bf16x8 (&kf)[4], const bf16x8 (&vf)[2][2], f32x16& O0, f32x16& O1, float& m, float& l, float& R,
                                          const f32x16& bias, const int kv0, const int q, const int hi, const bool rowok) {
    f32x16 S = bias;
#pragma unroll
    for (int d0 = 0; d0 < 4; ++d0) S = __builtin_amdgcn_mfma_f32_32x32x16_bf16(kf[d0], qr[d0], S, 0, 0, 0);
    if (MODE == 1) {
#pragma unroll
        for (int r = 0; r < 16; ++r) { const int key = kv0 + (r & 7) + 8 * hi + 16 * (r >> 3); const bool bad = (KIND == 1) ? (key >= q) : (key > q); if (bad) S[r] = -INFINITY; }
    }
    if (MODE == 2) { if (!rowok) {
#pragma unroll
        for (int r = 0; r < 16; ++r) S[r] = -INFINITY; } }
    float p[16];
    if (KIND != 1) {
        float rm = fmaxf(fmaxf(S[0], S[1]), fmaxf(S[2], S[3]));
#pragma unroll
        for (int r = 4; r < 16; r += 4) rm = fmaxf(rm, fmaxf(fmaxf(S[r], S[r + 1]), fmaxf(S[r + 2], S[r + 3])));
        rm = fmaxf(rm, __shfl_xor(rm, 32));
        const float mn = fmaxf(fmaxf(m, rm), -1e30f); const float alpha = __builtin_amdgcn_exp2f(m - mn);
        float ps = 0.f;
#pragma unroll
        for (int r = 0; r < 16; ++r) { p[r] = __builtin_amdgcn_exp2f(S[r] - mn); ps += p[r]; }
        l = l * alpha + ps; m = mn;
        O0 *= alpha; O1 *= alpha;
    } else {
        float l2[16]; float sLo = 0.f, sHi = 0.f;
#pragma unroll
        for (int r = 0; r < 16; ++r) l2[r] = lsn2q(S[r]);
#pragma unroll
        for (int r = 0; r < 8; ++r) { sLo += l2[r]; sHi += l2[8 + r]; }
        const float pLo = __shfl_xor(sLo, 32), pHi = __shfl_xor(sHi, 32);
        float run = hi ? R : R + pHi;
#pragma unroll
        for (int r = 15; r >= 8; --r) { p[r] = __builtin_amdgcn_exp2f(S[r] + l2[r] + run); run += l2[r]; }
        run = hi ? (R + sHi + pHi) : (R + pHi + sHi + pLo);
#pragma unroll
        for (int r = 7; r >= 0; --r) { p[r] = __builtin_amdgcn_exp2f(S[r] + l2[r] + run); run += l2[r]; }
        R += (sLo + sHi) + (pLo + pHi);
    }
    u32x4 w0, w1;
    w0.x = pk2(p[0], p[1]); w0.y = pk2(p[2], p[3]); w0.z = pk2(p[4], p[5]); w0.w = pk2(p[6], p[7]);
    w1.x = pk2(p[8], p[9]); w1.y = pk2(p[10], p[11]); w1.z = pk2(p[12], p[13]); w1.w = pk2(p[14], p[15]);
    const bf16x8 pf0 = __builtin_bit_cast(bf16x8, w0), pf1 = __builtin_bit_cast(bf16x8, w1);
    O0 = __builtin_amdgcn_mfma_f32_32x32x16_bf16(vf[0][0], pf0, O0, 0, 0, 0); O0 = __builtin_amdgcn_mfma_f32_32x32x16_bf16(vf[1][0], pf1, O0, 0, 0, 0);
    O1 = __builtin_amdgcn_mfma_f32_32x32x16_bf16(vf[0][1], pf0, O1, 0, 0, 0); O1 = __builtin_amdgcn_mfma_f32_32x32x16_bf16(vf[1][1], pf1, O1, 0, 0, 0);
}
template <int KIND>
__device__ __forceinline__ f32x16 attn_bias(const float* CFh, float slope2, int kv0, int q0, int hi) {
    f32x16 b = f32x16{};
    if (KIND == 0) { const float* c = CFh + kv0 + 8 * hi; const f32x4 a0 = *(const f32x4*)c, a1 = *(const f32x4*)(c + 4), a2 = *(const f32x4*)(c + 16), a3 = *(const f32x4*)(c + 20);
        b[0] = -a0[0]; b[1] = -a0[1]; b[2] = -a0[2]; b[3] = -a0[3]; b[4] = -a1[0]; b[5] = -a1[1]; b[6] = -a1[2]; b[7] = -a1[3];
        b[8] = -a2[0]; b[9] = -a2[1]; b[10] = -a2[2]; b[11] = -a2[3]; b[12] = -a3[0]; b[13] = -a3[1]; b[14] = -a3[2]; b[15] = -a3[3]; }
    if (KIND == 2) {
#pragma unroll
        for (int r = 0; r < 16; ++r) b[r] = slope2 * (float)(kv0 + (r & 7) + 8 * hi + 16 * (r >> 3) - q0); }
    return b;
}
template <int KIND>
__device__ __forceinline__ void attn_wave(const bf16_t* Qh, const bf16_t* Kh, const bf16_t* Vth, const int q0, const int lane, const float* CFh, const float slope2, const float* KMh, bf16_t* AOp) {
    const int r32 = lane & 31, hi = lane >> 5, r32p = pi32(r32), q = q0 + r32;
    bf16x8 qr[4];
#pragma unroll
    for (int d0 = 0; d0 < 4; ++d0) qr[d0] = *(const bf16x8*)(Qh + (size_t)q * 64 + 16 * d0 + 8 * hi);
    f32x16 O0 = f32x16{}, O1 = f32x16{};
    float m = -INFINITY, l = 0.f, R = 0.f;
    bf16x8 kf[4], kfn[4], vf[2][2];
    const int nt = q0 / 32 + 1;
    if (KIND == 0) {
        attn_load_k(kf, Kh, 0, r32p, hi);
        for (int it = 0; it < nt; ++it) { const int kv0 = 32 * it;
            attn_load_v(vf, Vth, kv0, r32, hi); const f32x16 bias = attn_bias<0>(CFh, 0.f, kv0, q0, hi);
            if (it + 1 < nt) attn_load_k(kfn, Kh, kv0 + 32, r32p, hi);
            if (it == nt - 1) attn_tile<0, 1>(qr, kf, vf, O0, O1, m, l, R, bias, kv0, q, hi, true); else attn_tile<0, 0>(qr, kf, vf, O0, O1, m, l, R, bias, kv0, q, hi, true);
#pragma unroll
            for (int d0 = 0; d0 < 4; ++d0) kf[d0] = kfn[d0]; }
    } else if (KIND == 1) {
        attn_load_k(kf, Kh, 32 * (nt - 1), r32p, hi);
        for (int it = nt - 1; it >= 0; --it) { const int kv0 = 32 * it;
            attn_load_v(vf, Vth, kv0, r32, hi); const f32x16 bias = f32x16{};
            if (it > 0) attn_load_k(kfn, Kh, kv0 - 32, r32p, hi);
            if (it == nt - 1) attn_tile<1, 1>(qr, kf, vf, O0, O1, m, l, R, bias, kv0, q, hi, true); else attn_tile<1, 0>(qr, kf, vf, O0, O1, m, l, R, bias, kv0, q, hi, true);
#pragma unroll
            for (int d0 = 0; d0 < 4; ++d0) kf[d0] = kfn[d0];
            if (__all(R < -200.f)) break; }
    } else {
        const int qb = q0 >> 8;
        f32x16 G = f32x16{};
#pragma unroll
        for (int d0 = 0; d0 < 4; ++d0) { u32x4 kw = {0u, 0u, 0u, 0u};
            if (r32 < 8) { const float* kmp = KMh + r32 * 64 + 16 * d0 + 8 * hi; kw = pack8(*(const f32x4*)kmp, *(const f32x4*)(kmp + 4)); }
            G = __builtin_amdgcn_mfma_f32_32x32x16_bf16(__builtin_bit_cast(bf16x8, kw), qr[d0], G, 0, 0, 0); }
        float gate[8];
#pragma unroll
        for (int n = 0; n < 4; ++n) { const float own = G[n], oth = __shfl_xor(own, 32); gate[n] = hi ? oth : own; gate[n + 4] = hi ? own : oth; }
        unsigned sel = 0u; const int nsel = qb < 3 ? qb : 3;
#pragma unroll
        for (int r = 0; r < 3; ++r) if (r < nsel) { float best = -INFINITY; int bi = 0;
#pragma unroll
            for (int n = 0; n < 8; ++n) if (n < qb && !((sel >> n) & 1u) && gate[n] > best) { best = gate[n]; bi = n; }
            sel |= 1u << bi; }
        for (int kv0 = 256 * qb; kv0 <= q0; kv0 += 32) {
            attn_load_k(kf, Kh, kv0, r32p, hi); attn_load_v(vf, Vth, kv0, r32, hi); const f32x16 bias = attn_bias<2>(nullptr, slope2, kv0, q0, hi);
            if (kv0 == q0) attn_tile<2, 1>(qr, kf, vf, O0, O1, m, l, R, bias, kv0, q, hi, true); else attn_tile<2, 0>(qr, kf, vf, O0, O1, m, l, R, bias, kv0, q, hi, true); }
        for (int j = 0; j < qb; ++j) { const bool rowok = (sel >> j) & 1u;
            if (!__any(rowok)) continue;
            attn_load_k(kf, Kh, 256 * j, r32p, hi);
            for (int i = 0; i < 8; ++i) { const int kv0 = 256 * j + 32 * i;
                attn_load_v(vf, Vth, kv0, r32, hi); const f32x16 bias = attn_bias<2>(nullptr, slope2, kv0, q0, hi);
                if (i < 7) attn_load_k(kfn, Kh, kv0 + 32, r32p, hi);
                attn_tile<2, 2>(qr, kf, vf, O0, O1, m, l, R, bias, kv0, q, hi, rowok);
#pragma unroll
                for (int d0 = 0; d0 < 4; ++d0) kf[d0] = kfn[d0]; } }
    }
    float linv = 1.f;
    if (KIND != 1) linv = 1.f / (l + __shfl_xor(l, 32));
    bf16_t* orow = AOp + (size_t)q * DM;
#pragma unroll
    for (int g = 0; g < 4; ++g) { u32x2 w;
        w.x = pk2(O0[4 * g] * linv, O0[4 * g + 1] * linv); w.y = pk2(O0[4 * g + 2] * linv, O0[4 * g + 3] * linv); *(u32x2*)(orow + 8 * g + 4 * hi) = w;
        w.x = pk2(O1[4 * g] * linv, O1[4 * g + 1] * linv); w.y = pk2(O1[4 * g + 2] * linv, O1[4 * g + 3] * linv); *(u32x2*)(orow + 32 + 8 * g + 4 * hi) = w; }
}
template <int KIND>
__device__ __forceinline__ void phase_attn(Frame& F, const bf16_t* QH, const bf16_t* KH, const bf16_t* VT, int NH, int hbase, const float* CF, const float* KMEAN, bf16_t* AO, int ao_col0) {
    for (int ug = F.vcu; ug < NB * 8 * 2; ug += F.G) {
        const int bh = ug >> 1, b = bh >> 3, h = bh & 7, hh = hbase + h; const size_t hb = (size_t)(b * NH + hh);
        const float slope2 = __builtin_amdgcn_exp2f(-(float)(h + 1)) * LOG2E;
#pragma unroll 1
        for (int i = 0; i < 4; ++i) { const int base = (i >> 1) * 2 + (ug & 1), qb = (i & 1) ? 7 - base : base, w = (i & 1) ? 7 - F.wave : F.wave;
            attn_wave<KIND>(QH + hb * 2048 * 64, KH + hb * 2048 * 64, VT + hb * 64 * 2048, 256 * qb + 32 * w, opaque_i(F.lane),
                            CF ? CF + (size_t)bh * 2048 : nullptr, slope2, KMEAN ? KMEAN + (size_t)bh * 8 * 64 : nullptr, AO + (size_t)b * 2048 * DM + ao_col0 + h * 64); }
    }
}


constexpr int AT_SLOT = 16384, AT_CF = 3 * AT_SLOT;
__device__ __forceinline__ void attn_dma_tile(const bf16_t* Kh, const bf16_t* Vth, int T, LAS unsigned char* slot, int wave, int r32, int r32p, int hi) {
    const int j = wave >> 2, d0 = wave & 3, s2 = (wave >> 1) & 1, dh = wave & 1;
    const bf16_t* ks = Kh + (size_t)(64 * T + 32 * j + r32p) * 64 + 16 * d0 + 8 * hi;
    const bf16_t* vs = Vth + (size_t)(32 * dh + r32) * 2048 + 64 * T + 32 * j + 16 * s2 + 8 * hi;
    __builtin_amdgcn_global_load_lds((const unsigned*)ks, (LAS unsigned*)(slot + (j * 4 + d0) * 1024), 16, 0, 0);
    __builtin_amdgcn_global_load_lds((const unsigned*)vs, (LAS unsigned*)(slot + 8192 + ((j * 2 + s2) * 2 + dh) * 1024), 16, 0, 0);
}
template <int MODE>
__device__ __forceinline__ void attn_fox_sub(const bf16x8 (&qr)[4], f32x16& O0, f32x16& O1, float& m, float& l, unsigned saddr  , unsigned cfaddr  , int j, int kv0, int q, int hi) {
    bf16x8 kf[4], vf[2][2]; f32x4 c0, c1, c2, c3;
    asm volatile("ds_read_b128 %0, %12\n\tds_read_b128 %1, %12 offset:1024\n\tds_read_b128 %2, %12 offset:2048\n\tds_read_b128 %3, %12 offset:3072\n\t"
                 "ds_read_b128 %4, %13\n\tds_read_b128 %5, %13 offset:1024\n\tds_read_b128 %6, %13 offset:2048\n\tds_read_b128 %7, %13 offset:3072\n\t"
                 "ds_read_b128 %8, %14\n\tds_read_b128 %9, %14 offset:16\n\tds_read_b128 %10, %14 offset:64\n\tds_read_b128 %11, %14 offset:80\n\ts_waitcnt lgkmcnt(0)"
                 : "=&v"(kf[0]), "=&v"(kf[1]), "=&v"(kf[2]), "=&v"(kf[3]), "=&v"(vf[0][0]), "=&v"(vf[0][1]), "=&v"(vf[1][0]), "=&v"(vf[1][1]), "=&v"(c0), "=&v"(c1), "=&v"(c2), "=&v"(c3)
                 : "v"(saddr + (unsigned)j * 4096u), "v"(saddr + 8192u + (unsigned)j * 4096u), "v"(cfaddr) : "memory");
    f32x16 S;
    S[0] = c0[0]; S[1] = c0[1]; S[2] = c0[2]; S[3] = c0[3]; S[4] = c1[0]; S[5] = c1[1]; S[6] = c1[2]; S[7] = c1[3];
    S[8] = c2[0]; S[9] = c2[1]; S[10] = c2[2]; S[11] = c2[3]; S[12] = c3[0]; S[13] = c3[1]; S[14] = c3[2]; S[15] = c3[3];
#pragma unroll
    for (int d0 = 0; d0 < 4; ++d0) S = __builtin_amdgcn_mfma_f32_32x32x16_bf16(kf[d0], qr[d0], S, 0, 0, 0);
    if (MODE == 1) {
#pragma unroll
        for (int r = 0; r < 16; ++r) { const int key = kv0 + (r & 7) + 8 * hi + 16 * (r >> 3); if (key > q) S[r] = -INFINITY; }
    }
    float rm = fmaxf(fmaxf(S[0], S[1]), fmaxf(S[2], S[3]));
#pragma unroll
    for (int r = 4; r < 16; r += 4) rm = fmaxf(rm, fmaxf(fmaxf(S[r], S[r + 1]), fmaxf(S[r + 2], S[r + 3])));
    { const auto rr = __builtin_amdgcn_permlane32_swap(__float_as_uint(rm), __float_as_uint(rm), false, false); rm = fmaxf(__uint_as_float(rr[0]), __uint_as_float(rr[1])); }
    if (__any(rm > m)) {
        const float mn = fmaxf(fmaxf(m, rm), -1e30f); const float alpha = __builtin_amdgcn_exp2f(m - mn);
        l *= alpha; O0 *= alpha; O1 *= alpha; m = mn; }
    float p[16]; float ps = 0.f;
#pragma unroll
    for (int r = 0; r < 16; ++r) { p[r] = __builtin_amdgcn_exp2f(S[r] - m); ps += p[r]; }
    l += ps;
    u32x4 w0, w1;
    w0.x = pk2(p[0], p[1]); w0.y = pk2(p[2], p[3]); w0.z = pk2(p[4], p[5]); w0.w = pk2(p[6], p[7]);
    w1.x = pk2(p[8], p[9]); w1.y = pk2(p[10], p[11]); w1.z = pk2(p[12], p[13]); w1.w = pk2(p[14], p[15]);
    const bf16x8 pf0 = __builtin_bit_cast(bf16x8, w0), pf1 = __builtin_bit_cast(bf16x8, w1);
    O0 = __builtin_amdgcn_mfma_f32_32x32x16_bf16(vf[0][0], pf0, O0, 0, 0, 0); O0 = __builtin_amdgcn_mfma_f32_32x32x16_bf16(vf[1][0], pf1, O0, 0, 0, 0);
    O1 = __builtin_amdgcn_mfma_f32_32x32x16_bf16(vf[0][1], pf0, O1, 0, 0, 0); O1 = __builtin_amdgcn_mfma_f32_32x32x16_bf16(vf[1][1], pf1, O1, 0, 0, 0);
}
__device__ __forceinline__ void attn_fox_unit(Frame& F, const bf16_t* Qh, const bf16_t* Kh, const bf16_t* Vth, const float* CFh, const int qb, bf16_t* AOp) {
    const int lane = opaque_i(F.lane), r32 = lane & 31, hi = lane >> 5, r32p = pi32(r32), wave = F.wave, q0 = 256 * qb + 32 * wave, q = q0 + r32;
    LAS unsigned char* ring = F.lds; const unsigned ring_a = (unsigned)(uintptr_t)ring + 16u * (unsigned)lane, cf_a = (unsigned)(uintptr_t)ring + (unsigned)AT_CF + 32u * (unsigned)hi;
    bf16x8 qr[4];
#pragma unroll
    for (int d0 = 0; d0 < 4; ++d0) qr[d0] = *(const bf16x8*)(Qh + (size_t)q * 64 + 16 * d0 + 8 * hi);
    { const f32x4 cv = *(const f32x4*)(CFh + 4 * F.tid); *(LAS f32x4*)(ring + AT_CF + 16 * F.tid) = -cv; }
    asm volatile("s_waitcnt vmcnt(0) lgkmcnt(0)" ::: "memory"); __builtin_amdgcn_s_barrier();
    const int NT = 4 * qb + 4, my_last = 4 * qb + (wave >> 1), jdiag = wave & 1;
    attn_dma_tile(Kh, Vth, NT - 1, ring, wave, r32, r32p, hi);
    attn_dma_tile(Kh, Vth, NT - 2, ring + AT_SLOT, wave, r32, r32p, hi);
    f32x16 O0 = f32x16{}, O1 = f32x16{}; float m = -INFINITY, l = 0.f;
    int slot = 0;
#pragma unroll 1
    for (int T = NT - 1; T >= 0; --T) {
        if (T > 0) asm volatile("s_waitcnt vmcnt(2)" ::: "memory"); else asm volatile("s_waitcnt vmcnt(0)" ::: "memory");
        __builtin_amdgcn_s_barrier();
        if (T >= 2) { const int fs = (slot == 0) ? 2 : slot - 1; attn_dma_tile(Kh, Vth, T - 2, ring + fs * AT_SLOT, wave, r32, r32p, hi); }
        if (T <= my_last) {
            const unsigned sa = ring_a + (unsigned)(slot * AT_SLOT);
            if (T == my_last) {
                if (jdiag == 1) { attn_fox_sub<1>(qr, O0, O1, m, l, sa, cf_a + 4u * (unsigned)(64 * T + 32), 1, 64 * T + 32, q, hi); attn_fox_sub<0>(qr, O0, O1, m, l, sa, cf_a + 4u * (unsigned)(64 * T), 0, 64 * T, q, hi); }
                else attn_fox_sub<1>(qr, O0, O1, m, l, sa, cf_a + 4u * (unsigned)(64 * T), 0, 64 * T, q, hi);
            } else { attn_fox_sub<0>(qr, O0, O1, m, l, sa, cf_a + 4u * (unsigned)(64 * T + 32), 1, 64 * T + 32, q, hi); attn_fox_sub<0>(qr, O0, O1, m, l, sa, cf_a + 4u * (unsigned)(64 * T), 0, 64 * T, q, hi); }
        }
        slot = (slot == 2) ? 0 : slot + 1;
    }
    const float linv = 1.f / (l + __shfl_xor(l, 32));
    bf16_t* orow = AOp + (size_t)q * DM;
#pragma unroll
    for (int g = 0; g < 4; ++g) { u32x2 w;
        w.x = pk2(O0[4 * g] * linv, O0[4 * g + 1] * linv); w.y = pk2(O0[4 * g + 2] * linv, O0[4 * g + 3] * linv); *(u32x2*)(orow + 8 * g + 4 * hi) = w;
        w.x = pk2(O1[4 * g] * linv, O1[4 * g + 1] * linv); w.y = pk2(O1[4 * g + 2] * linv, O1[4 * g + 3] * linv); *(u32x2*)(orow + 32 + 8 * g + 4 * hi) = w; }
    asm volatile("s_waitcnt vmcnt(0) lgkmcnt(0)" ::: "memory"); __builtin_amdgcn_s_barrier();
}
__device__ __forceinline__ void phase_attn_fox(Frame& F, const bf16_t* QH, const bf16_t* KH, const bf16_t* VT, const float* CF, bf16_t* AO) {
    for (int ug = F.vcu; ug < NB * 8 * 2; ug += F.G) {
        const int bh = ug >> 1, b = bh >> 3, h = bh & 7; const size_t hb = (size_t)(b * 16 + h);
#pragma unroll 1
        for (int i = 0; i < 4; ++i) { const int base = (i >> 1) * 2 + (ug & 1), qb = (i & 1) ? 7 - base : base;
            attn_fox_unit(F, QH + hb * 2048 * 64, KH + hb * 2048 * 64, VT + hb * 64 * 2048, CF + (size_t)bh * 2048, qb, AO + (size_t)b * 2048 * DM + h * 64); }
    }
}

template <int MODE>
__device__ __forceinline__ void attn_moba_sub(const bf16x8 (&qr)[4], f32x16& O0, f32x16& O1, float& m, float& l, unsigned saddr, int j, int kv0, int q, int q0, int hi, float slope2, bool rowok) {
    bf16x8 kf[4], vf[2][2];
    asm volatile("ds_read_b128 %0, %8\n\tds_read_b128 %1, %8 offset:1024\n\tds_read_b128 %2, %8 offset:2048\n\tds_read_b128 %3, %8 offset:3072\n\t"
                 "ds_read_b128 %4, %9\n\tds_read_b128 %5, %9 offset:1024\n\tds_read_b128 %6, %9 offset:2048\n\tds_read_b128 %7, %9 offset:3072\n\ts_waitcnt lgkmcnt(0)"
                 : "=&v"(kf[0]), "=&v"(kf[1]), "=&v"(kf[2]), "=&v"(kf[3]), "=&v"(vf[0][0]), "=&v"(vf[0][1]), "=&v"(vf[1][0]), "=&v"(vf[1][1])
                 : "v"(saddr + (unsigned)j * 4096u), "v"(saddr + 8192u + (unsigned)j * 4096u) : "memory");
    f32x16 S; const float sbase = slope2 * (float)(kv0 + 8 * hi - q0);
#pragma unroll
    for (int r = 0; r < 16; ++r) S[r] = sbase + slope2 * (float)((r & 7) + 16 * (r >> 3));
#pragma unroll
    for (int d0 = 0; d0 < 4; ++d0) S = __builtin_amdgcn_mfma_f32_32x32x16_bf16(kf[d0], qr[d0], S, 0, 0, 0);
    if (MODE == 1) {
#pragma unroll
        for (int r = 0; r < 16; ++r) { const int key = kv0 + (r & 7) + 8 * hi + 16 * (r >> 3); if (key > q) S[r] = -INFINITY; }
    }
    if (MODE == 2) { if (!rowok) {
#pragma unroll
        for (int r = 0; r < 16; ++r) S[r] = -INFINITY; } }
    float rm = fmaxf(fmaxf(S[0], S[1]), fmaxf(S[2], S[3]));
#pragma unroll
    for (int r = 4; r < 16; r += 4) rm = fmaxf(rm, fmaxf(fmaxf(S[r], S[r + 1]), fmaxf(S[r + 2], S[r + 3])));
    { const auto rr = __builtin_amdgcn_permlane32_swap(__float_as_uint(rm), __float_as_uint(rm), false, false); rm = fmaxf(__uint_as_float(rr[0]), __uint_as_float(rr[1])); }
    if (__any(rm > m)) { const float mn = fmaxf(fmaxf(m, rm), -1e30f); const float alpha = __builtin_amdgcn_exp2f(m - mn); l *= alpha; O0 *= alpha; O1 *= alpha; m = mn; }
    float p[16]; float ps = 0.f;
#pragma unroll
    for (int r = 0; r < 16; ++r) { p[r] = __builtin_amdgcn_exp2f(S[r] - m); ps += p[r]; }
    l += ps;
    u32x4 w0, w1;
    w0.x = pk2(p[0], p[1]); w0.y = pk2(p[2], p[3]); w0.z = pk2(p[4], p[5]); w0.w = pk2(p[6], p[7]);
    w1.x = pk2(p[8], p[9]); w1.y = pk2(p[10], p[11]); w1.z = pk2(p[12], p[13]); w1.w = pk2(p[14], p[15]);
    const bf16x8 pf0 = __builtin_bit_cast(bf16x8, w0), pf1 = __builtin_bit_cast(bf16x8, w1);
    O0 = __builtin_amdgcn_mfma_f32_32x32x16_bf16(vf[0][0], pf0, O0, 0, 0, 0); O0 = __builtin_amdgcn_mfma_f32_32x32x16_bf16(vf[1][0], pf1, O0, 0, 0, 0);
    O1 = __builtin_amdgcn_mfma_f32_32x32x16_bf16(vf[0][1], pf0, O1, 0, 0, 0); O1 = __builtin_amdgcn_mfma_f32_32x32x16_bf16(vf[1][1], pf1, O1, 0, 0, 0);
}
__device__ __forceinline__ void attn_moba_unit(Frame& F, const bf16_t* Qh, const bf16_t* Kh, const bf16_t* Vth, const float* KMh, const float slope2, const int qb, bf16_t* AOp) {
    const int lane = opaque_i(F.lane), r32 = lane & 31, hi = lane >> 5, r32p = pi32(r32), wave = F.wave, q0 = 256 * qb + 32 * wave, q = q0 + r32;
    LAS unsigned char* ring = F.lds; const unsigned ring_a = (unsigned)(uintptr_t)ring + 16u * (unsigned)lane;
    bf16x8 qr[4];
#pragma unroll
    for (int d0 = 0; d0 < 4; ++d0) qr[d0] = *(const bf16x8*)(Qh + (size_t)q * 64 + 16 * d0 + 8 * hi);
    f32x16 G = f32x16{};
#pragma unroll
    for (int d0 = 0; d0 < 4; ++d0) { u32x4 kw = {0u, 0u, 0u, 0u};
        if (r32 < 8) { const float* kmp = KMh + r32 * 64 + 16 * d0 + 8 * hi; kw = pack8(*(const f32x4*)kmp, *(const f32x4*)(kmp + 4)); }
        G = __builtin_amdgcn_mfma_f32_32x32x16_bf16(__builtin_bit_cast(bf16x8, kw), qr[d0], G, 0, 0, 0); }
    float gate[8];
#pragma unroll
    for (int n = 0; n < 4; ++n) { const float own = G[n], oth = __shfl_xor(own, 32); gate[n] = hi ? oth : own; gate[n + 4] = hi ? own : oth; }
    unsigned sel = 0u; const int nsel = qb < 3 ? qb : 3;
#pragma unroll
    for (int r = 0; r < 3; ++r) if (r < nsel) { float best = -INFINITY; int bi = 0;
#pragma unroll
        for (int n = 0; n < 8; ++n) if (n < qb && !((sel >> n) & 1u) && gate[n] > best) { best = gate[n]; bi = n; }
        sel |= 1u << bi; }
    unsigned wsel = 0u;
#pragma unroll
    for (int n = 0; n < 8; ++n) if (__any((sel >> n) & 1u)) wsel |= 1u << n;
    asm volatile("s_waitcnt vmcnt(0) lgkmcnt(0)" ::: "memory"); __builtin_amdgcn_s_barrier();
    const int NT = 4 * qb + 4, my_last = 4 * qb + (wave >> 1), jdiag = wave & 1;
    attn_dma_tile(Kh, Vth, NT - 1, ring, wave, r32, r32p, hi);
    attn_dma_tile(Kh, Vth, NT - 2, ring + AT_SLOT, wave, r32, r32p, hi);
    f32x16 O0 = f32x16{}, O1 = f32x16{}; float m = -INFINITY, l = 0.f;
    int slot = 0;
#pragma unroll 1
    for (int T = NT - 1; T >= 0; --T) {
        if (T > 0) asm volatile("s_waitcnt vmcnt(2)" ::: "memory"); else asm volatile("s_waitcnt vmcnt(0)" ::: "memory");
        __builtin_amdgcn_s_barrier();
        if (T >= 2) { const int fs = (slot == 0) ? 2 : slot - 1; attn_dma_tile(Kh, Vth, T - 2, ring + fs * AT_SLOT, wave, r32, r32p, hi); }
        const unsigned sa = ring_a + (unsigned)(slot * AT_SLOT);
        if (T >= 4 * qb) {
            if (T == my_last) {
                if (jdiag == 1) { attn_moba_sub<1>(qr, O0, O1, m, l, sa, 1, 64 * T + 32, q, q0, hi, slope2, true); attn_moba_sub<0>(qr, O0, O1, m, l, sa, 0, 64 * T, q, q0, hi, slope2, true); }
                else attn_moba_sub<1>(qr, O0, O1, m, l, sa, 0, 64 * T, q, q0, hi, slope2, true);
            } else if (T < my_last) { attn_moba_sub<0>(qr, O0, O1, m, l, sa, 1, 64 * T + 32, q, q0, hi, slope2, true); attn_moba_sub<0>(qr, O0, O1, m, l, sa, 0, 64 * T, q, q0, hi, slope2, true); }
        } else if ((wsel >> (T >> 2)) & 1u) {
            const bool rowok = (sel >> (T >> 2)) & 1u;
            attn_moba_sub<2>(qr, O0, O1, m, l, sa, 1, 64 * T + 32, q, q0, hi, slope2, rowok); attn_moba_sub<2>(qr, O0, O1, m, l, sa, 0, 64 * T, q, q0, hi, slope2, rowok);
        }
        slot = (slot == 2) ? 0 : slot + 1;
    }
    const float linv = 1.f / (l + __shfl_xor(l, 32));
    bf16_t* orow = AOp + (size_t)q * DM;
#pragma unroll
    for (int g = 0; g < 4; ++g) { u32x2 w;
        w.x = pk2(O0[4 * g] * linv, O0[4 * g + 1] * linv); w.y = pk2(O0[4 * g + 2] * linv, O0[4 * g + 3] * linv); *(u32x2*)(orow + 8 * g + 4 * hi) = w;
        w.x = pk2(O1[4 * g] * linv, O1[4 * g + 1] * linv); w.y = pk2(O1[4 * g + 2] * linv, O1[4 * g + 3] * linv); *(u32x2*)(orow + 32 + 8 * g + 4 * hi) = w; }
    asm volatile("s_waitcnt vmcnt(0) lgkmcnt(0)" ::: "memory"); __builtin_amdgcn_s_barrier();
}
__device__ __forceinline__ void phase_attn_moba(Frame& F, const bf16_t* QD, const bf16_t* KD, const bf16_t* VTD, const float* KMEAN, bf16_t* AO) {
    for (int ug = F.vcu; ug < NB * 8 * 2; ug += F.G) {
        const int bh = ug >> 1, b = bh >> 3, h = bh & 7; const size_t hb = (size_t)bh;
        const float slope2 = __builtin_amdgcn_exp2f(-(float)(h + 1)) * LOG2E;
#pragma unroll 1
        for (int i = 0; i < 4; ++i) { const int base = (i >> 1) * 2 + (ug & 1), qb = (i & 1) ? 7 - base : base;
            attn_moba_unit(F, QD + hb * 2048 * 64, KD + hb * 2048 * 64, VTD + hb * 64 * 2048, KMEAN + (size_t)bh * 8 * 64, slope2, qb, AO + (size_t)b * 2048 * DM + 512 + h * 64); }
    }
}
__device__ __forceinline__ void phase_pool(Frame& F, const bf16_t* XC, const bf16_t* PWT, const float* pool_scale, bf16_t* AO) {
    const int gw = F.vcu * NWAVES + F.wave, NGW = F.G * NWAVES, lane = opaque_i(F.lane), r32 = lane & 31, hi = lane >> 5;
    for (int it = gw; it < (TOK / 32) * 4; it += NGW) {
        const int rnd = it / NGW, gq = it - rnd * NGW;
        const int g = (rnd & 1) ? 3 - (gq & 3) : (gq & 3), t0 = (rnd * (NGW >> 2) + (gq >> 2)) * 32, t = t0 + r32, tl = t & 2047, w = 2 << g;
        const int cnt = (tl + 1) < w ? (tl + 1) : w; const float rc = 1.f / (float)cnt;
        f32x16 acc[4];
#pragma unroll
        for (int nb = 0; nb < 4; ++nb) acc[nb] = f32x16{};
#pragma unroll 1
        for (int kk = 0; kk < 8; ++kk) {
            const int c0 = g * 128 + kk * 16 + hi * 8;
            const u32x4 self = *(const u32x4*)(XC + (size_t)t * 512 + c0);
            float s[8] = {0.f, 0.f, 0.f, 0.f, 0.f, 0.f, 0.f, 0.f};
            for (int i = 0; i < cnt; ++i) { const u32x4 x = *(const u32x4*)(XC + (size_t)(t - i) * 512 + c0);
                s[0] += bf_lo(x.x); s[1] += bf_hi(x.x); s[2] += bf_lo(x.y); s[3] += bf_hi(x.y); s[4] += bf_lo(x.z); s[5] += bf_hi(x.z); s[6] += bf_lo(x.w); s[7] += bf_hi(x.w); }
            u32x4 pa; pa.x = pk2(s[0] * rc - bf_lo(self.x), s[1] * rc - bf_hi(self.x)); pa.y = pk2(s[2] * rc - bf_lo(self.y), s[3] * rc - bf_hi(self.y));
            pa.z = pk2(s[4] * rc - bf_lo(self.z), s[5] * rc - bf_hi(self.z)); pa.w = pk2(s[6] * rc - bf_lo(self.w), s[7] * rc - bf_hi(self.w));
            const bf16x8 af = __builtin_bit_cast(bf16x8, pa);
#pragma unroll
            for (int nb = 0; nb < 4; ++nb) { const bf16x8 bfr = *(const bf16x8*)(PWT + ((size_t)g * 128 + nb * 32 + r32) * 128 + kk * 16 + hi * 8);
                acc[nb] = __builtin_amdgcn_mfma_f32_32x32x16_bf16(af, bfr, acc[nb], 0, 0, 0); }
        }
#pragma unroll
        for (int nb = 0; nb < 4; ++nb) { const int col = g * 128 + nb * 32 + r32; const float sc = pool_scale[col];
#pragma unroll
            for (int r = 0; r < 16; ++r) { const int row = (r & 3) + 8 * (r >> 2) + 4 * hi; AO[(size_t)(t0 + row) * DM + col] = (bf16_t)f2bf(acc[nb][r] * sc); } }
    }
}

__device__ __forceinline__ void phase_topk_naive(Frame& F, const bf16_t* QP, const bf16_t* K1B, const bf16_t* K2B, unsigned short* EID, float* GATE) {
    const int gw = F.vcu * NWAVES + F.wave, NGW = F.G * NWAVES, lane = opaque_i(F.lane);
    for (int task = gw; task < TOK * 8; task += NGW) {
        const int t = task >> 3, h = task & 7;
        const bf16_t* qrow = QP + (size_t)t * 2048 + h * 256; const bf16_t* k1 = K1B + (size_t)h * 128 * 128; const bf16_t* k2 = K2B + (size_t)h * 128 * 128;
        float s1a = 0.f, s1b = 0.f, s2a = 0.f, s2b = 0.f;
#pragma unroll 4
        for (int c = 0; c < 16; ++c) { const u32x4 q1 = *(const u32x4*)(qrow + 8 * c), q2 = *(const u32x4*)(qrow + 128 + 8 * c);
            s1a = dot8(*(const u32x4*)(k1 + (size_t)lane * 128 + 8 * c), q1, s1a); s1b = dot8(*(const u32x4*)(k1 + (size_t)(lane + 64) * 128 + 8 * c), q1, s1b);
            s2a = dot8(*(const u32x4*)(k2 + (size_t)lane * 128 + 8 * c), q2, s2a); s2b = dot8(*(const u32x4*)(k2 + (size_t)(lane + 64) * 128 + 8 * c), q2, s2b); }
        unsigned A = (f2ord(s1a) & ~127u) | (unsigned)(127 - lane), B = (f2ord(s1b) & ~127u) | (unsigned)(63 - lane);
        unsigned top1 = 0u, top2 = 0u, topc = 0u;
        for (int r = 0; r < 16; ++r) { const unsigned m = wave_umax(A > B ? A : B); if (lane == r) top1 = m; if (A == m) A = 0u; if (B == m) B = 0u; }
        A = (f2ord(s2a) & ~127u) | (unsigned)(127 - lane); B = (f2ord(s2b) & ~127u) | (unsigned)(63 - lane);
        for (int r = 0; r < 16; ++r) { const unsigned m = wave_umax(A > B ? A : B); if (lane == r) top2 = m; if (A == m) A = 0u; if (B == m) B = 0u; }
        const float v1 = ord2f(top1 & ~127u), v2 = ord2f(top2 & ~127u); const int i1 = 127 - (int)(top1 & 127u), i2 = 127 - (int)(top2 & 127u);
        const float va = __shfl(v1, lane >> 2); unsigned C[4];
#pragma unroll
        for (int j = 0; j < 4; ++j) { const float vb = __shfl(v2, (lane & 3) * 4 + j); C[j] = (f2ord(va + vb) & ~255u) | (unsigned)(255 - (lane * 4 + j)); }
        for (int r = 0; r < 16; ++r) { unsigned m = C[0] > C[1] ? C[0] : C[1]; const unsigned m2 = C[2] > C[3] ? C[2] : C[3]; m = wave_umax(m > m2 ? m : m2); if (lane == r) topc = m;
#pragma unroll
            for (int j = 0; j < 4; ++j) if (C[j] == m) C[j] = 0u; }
        const int c = 255 - (int)(topc & 255u); const float val = ord2f(topc & ~255u);
        const int ia = __shfl(i1, c >> 4), ib = __shfl(i2, c & 15);
        const float v0 = __shfl(val, 0); const float e = (lane < 16) ? __expf(val - v0) : 0.f; const float sum = wave_sum(e);
        if (lane < 16) { EID[(size_t)t * 128 + h * 16 + lane] = (unsigned short)(ia * 128 + ib); GATE[(size_t)t * 128 + h * 16 + lane] = e / sum; }
    }
}

#define DEVFN __device__ __forceinline__
template <int OFF, int N, int TOT> DEVFN void bitonic_sort_desc(unsigned (&a)[TOT]) {
#pragma unroll
    for (int k = 2; k <= N; k <<= 1)
#pragma unroll
        for (int j = k >> 1; j > 0; j >>= 1)
#pragma unroll
            for (int i = 0; i < N; ++i) { const int l = i ^ j; if (l > i) { const bool desc = ((i & k) == 0); const unsigned x = a[OFF + i], y = a[OFF + l];
                const unsigned mx = x > y ? x : y, mn = x > y ? y : x; a[OFF + i] = desc ? mx : mn; a[OFF + l] = desc ? mn : mx; } }
}
constexpr int OE16_N = 63;
constexpr unsigned char OE16[63][2] = {{0,1}, {2,3}, {0,2}, {1,3}, {1,2}, {4,5}, {6,7}, {4,6}, {5,7}, {5,6}, {0,4}, {2,6}, {2,4}, {1,5}, {3,7}, {3,5}, {1,2}, {3,4}, {5,6}, {8,9}, {10,11}, {8,10}, {9,11}, {9,10}, {12,13}, {14,15}, {12,14}, {13,15}, {13,14}, {8,12}, {10,14}, {10,12}, {9,13}, {11,15}, {11,13}, {9,10}, {11,12}, {13,14}, {0,8}, {4,12}, {4,8}, {2,10}, {6,14}, {6,10}, {2,4}, {6,8}, {10,12}, {1,9}, {5,13}, {5,9}, {3,11}, {7,15}, {7,11}, {3,5}, {7,9}, {11,13}, {1,2}, {3,4}, {5,6}, {7,8}, {9,10}, {11,12}, {13,14}};
template <int OFF, int TOT> DEVFN void sort16_desc(unsigned (&a)[TOT]) {
#pragma unroll
    for (int q = 0; q < OE16_N; ++q) { const int i = OFF + OE16[q][0], l = OFF + OE16[q][1]; const unsigned x = a[i], y = a[l]; a[i] = x > y ? x : y; a[l] = x > y ? y : x; }
}
template <int OFF, int TOT> DEVFN void bitonic_merge16_desc(unsigned (&a)[TOT]) {
#pragma unroll
    for (int j = 8; j > 0; j >>= 1)
#pragma unroll
        for (int i = 0; i < 16; ++i) { const int l = i ^ j; if (l > i) { const unsigned x = a[OFF + i], y = a[OFF + l]; a[OFF + i] = x > y ? x : y; a[OFF + l] = x > y ? y : x; } }
}
template <int A, int B, int TOT> DEVFN void merge_top16(unsigned (&a)[TOT]) {
#pragma unroll
    for (int i = 0; i < 16; ++i) { const unsigned x = a[A + i], y = a[B + 15 - i]; a[A + i] = x > y ? x : y; }
    bitonic_merge16_desc<A, TOT>(a);
}
DEVFN void top16of64(unsigned (&a)[64]) {
    sort16_desc<0, 64>(a); sort16_desc<16, 64>(a); sort16_desc<32, 64>(a); sort16_desc<48, 64>(a);
    merge_top16<0, 16, 64>(a); merge_top16<32, 48, 64>(a); merge_top16<0, 32, 64>(a);
}

__device__ __forceinline__ void phase_topk(Frame& F, const bf16_t* QP, const bf16_t* K1B, const bf16_t* K2B, unsigned short* EID, float* GATE) {
    const int gw = F.vcu * NWAVES + F.wave, NGW = F.G * NWAVES, lane = opaque_i(F.lane), r32 = lane & 31, hi = lane >> 5;
    LAS unsigned* I1s = (LAS unsigned*)(F.lds + F.wave * 8192); LAS unsigned* I2s = I1s + 1024;
    for (int task = gw; task < (TOK / 32) * 8; task += NGW) {
        const int tile = task >> 3, h = task & 7, t = tile * 32 + r32;
        unsigned V1[16], V2[16]; unsigned h4 = (unsigned)hi << 2; asm volatile("" : "+v"(h4));
#pragma unroll
        for (int half = 0; half < 2; ++half) {
            const bf16_t* qrow = QP + (size_t)t * 2048 + h * 256 + half * 128 + 8 * hi;
            bf16x8 qf[8];
#pragma unroll
            for (int kk = 0; kk < 8; ++kk) qf[kk] = *(const bf16x8*)(qrow + 16 * kk);
            unsigned K[64];
#pragma unroll
            for (int nb = 0; nb < 4; ++nb) { f32x16 acc = f32x16{};
                const bf16_t* kb = (half ? K2B : K1B) + ((size_t)h * 128 + nb * 32 + r32) * 128 + 8 * hi; asm volatile("" : "+v"(kb));
#pragma unroll
                for (int kk = 0; kk < 8; ++kk) acc = __builtin_amdgcn_mfma_f32_32x32x16_bf16(*(const bf16x8*)(kb + 16 * kk), qf[kk], acc, 0, 0, 0);
#pragma unroll
                for (int r = 0; r < 16; ++r) K[nb * 16 + r] = ((f2ord(acc[r]) & ~127u) | (unsigned)(127 - (nb * 32 + (r & 3) + 8 * (r >> 2)))) ^ h4;
                __builtin_amdgcn_sched_barrier(0); }
            __builtin_amdgcn_sched_barrier(0); top16of64(K); __builtin_amdgcn_sched_barrier(0);
            unsigned C[16];
#pragma unroll
            for (int i = 0; i < 16; ++i) { const unsigned y = (unsigned)__shfl_xor((int)K[15 - i], 32); C[i] = K[i] > y ? K[i] : y; }
            bitonic_merge16_desc<0, 16>(C);
#pragma unroll
            for (int i = 0; i < 16; ++i) { if (half == 0) V1[i] = C[i]; else V2[i] = C[i]; }
            __builtin_amdgcn_sched_barrier(0);
        }
        float f1[16], f2[16];
#pragma unroll
        for (int a = 0; a < 16; ++a) { I1s[a * 64 + lane] = 127u - (V1[a] & 127u); I2s[a * 64 + lane] = 127u - (V2[a] & 127u); f1[a] = ord2f(V1[a] & ~127u); f2[a] = ord2f(V2[a] & ~127u); }
        __builtin_amdgcn_sched_barrier(0);
        unsigned Cd[64];
    Cd[0] = (f2ord(f1[0] + f2[0]) & ~255u) | 255u;
    Cd[1] = (f2ord(f1[0] + f2[1]) & ~255u) | 254u;
    Cd[2] = (f2ord(f1[0] + f2[2]) & ~255u) | 253u;
    Cd[3] = (f2ord(f1[0] + f2[3]) & ~255u) | 252u;
    Cd[4] = (f2ord(f1[0] + f2[4]) & ~255u) | 251u;
    Cd[5] = (f2ord(f1[0] + f2[5]) & ~255u) | 250u;
    Cd[6] = (f2ord(f1[0] + f2[6]) & ~255u) | 249u;
    Cd[7] = (f2ord(f1[0] + f2[7]) & ~255u) | 248u;
    Cd[8] = (f2ord(f1[0] + f2[8]) & ~255u) | 247u;
    Cd[9] = (f2ord(f1[0] + f2[9]) & ~255u) | 246u;
    Cd[10] = (f2ord(f1[0] + f2[10]) & ~255u) | 245u;
    Cd[11] = (f2ord(f1[0] + f2[11]) & ~255u) | 244u;
    Cd[12] = (f2ord(f1[0] + f2[12]) & ~255u) | 243u;
    Cd[13] = (f2ord(f1[0] + f2[13]) & ~255u) | 242u;
    Cd[14] = (f2ord(f1[0] + f2[14]) & ~255u) | 241u;
    Cd[15] = (f2ord(f1[0] + f2[15]) & ~255u) | 240u;
    Cd[16] = (f2ord(f1[1] + f2[0]) & ~255u) | 239u;
    Cd[17] = (f2ord(f1[1] + f2[1]) & ~255u) | 238u;
    Cd[18] = (f2ord(f1[1] + f2[2]) & ~255u) | 237u;
    Cd[19] = (f2ord(f1[1] + f2[3]) & ~255u) | 236u;
    Cd[20] = (f2ord(f1[1] + f2[4]) & ~255u) | 235u;
    Cd[21] = (f2ord(f1[1] + f2[5]) & ~255u) | 234u;
    Cd[22] = (f2ord(f1[1] + f2[6]) & ~255u) | 233u;
    Cd[23] = (f2ord(f1[1] + f2[7]) & ~255u) | 232u;
    Cd[24] = (f2ord(f1[2] + f2[0]) & ~255u) | 223u;
    Cd[25] = (f2ord(f1[2] + f2[1]) & ~255u) | 222u;
    Cd[26] = (f2ord(f1[2] + f2[2]) & ~255u) | 221u;
    Cd[27] = (f2ord(f1[2] + f2[3]) & ~255u) | 220u;
    Cd[28] = (f2ord(f1[2] + f2[4]) & ~255u) | 219u;
    Cd[29] = (f2ord(f1[3] + f2[0]) & ~255u) | 207u;
    Cd[30] = (f2ord(f1[3] + f2[1]) & ~255u) | 206u;
    Cd[31] = (f2ord(f1[3] + f2[2]) & ~255u) | 205u;
    Cd[32] = (f2ord(f1[3] + f2[3]) & ~255u) | 204u;
    Cd[33] = (f2ord(f1[4] + f2[0]) & ~255u) | 191u;
    Cd[34] = (f2ord(f1[4] + f2[1]) & ~255u) | 190u;
    Cd[35] = (f2ord(f1[4] + f2[2]) & ~255u) | 189u;
    Cd[36] = (f2ord(f1[5] + f2[0]) & ~255u) | 175u;
    Cd[37] = (f2ord(f1[5] + f2[1]) & ~255u) | 174u;
    Cd[38] = (f2ord(f1[6] + f2[0]) & ~255u) | 159u;
    Cd[39] = (f2ord(f1[6] + f2[1]) & ~255u) | 158u;
    Cd[40] = (f2ord(f1[7] + f2[0]) & ~255u) | 143u;
    Cd[41] = (f2ord(f1[7] + f2[1]) & ~255u) | 142u;
    Cd[42] = (f2ord(f1[8] + f2[0]) & ~255u) | 127u;
    Cd[43] = (f2ord(f1[9] + f2[0]) & ~255u) | 111u;
    Cd[44] = (f2ord(f1[10] + f2[0]) & ~255u) | 95u;
    Cd[45] = (f2ord(f1[11] + f2[0]) & ~255u) | 79u;
    Cd[46] = (f2ord(f1[12] + f2[0]) & ~255u) | 63u;
    Cd[47] = (f2ord(f1[13] + f2[0]) & ~255u) | 47u;
    Cd[48] = (f2ord(f1[14] + f2[0]) & ~255u) | 31u;
    Cd[49] = (f2ord(f1[15] + f2[0]) & ~255u) | 15u;
    Cd[50] = 0u;
    Cd[51] = 0u;
    Cd[52] = 0u;
    Cd[53] = 0u;
    Cd[54] = 0u;
    Cd[55] = 0u;
    Cd[56] = 0u;
    Cd[57] = 0u;
    Cd[58] = 0u;
    Cd[59] = 0u;
    Cd[60] = 0u;
    Cd[61] = 0u;
    Cd[62] = 0u;
    Cd[63] = 0u;
        __builtin_amdgcn_sched_barrier(0); top16of64(Cd); __builtin_amdgcn_sched_barrier(0);
        LDS_WAIT();
        unsigned eid[16]; float e[16]; float sum = 0.f; const float v0 = ord2f(Cd[0] & ~255u);
#pragma unroll
        for (int r = 0; r < 16; ++r) { const unsigned c = 255u - (Cd[r] & 255u); eid[r] = I1s[(c >> 4) * 64 + lane] * 128u + I2s[(c & 15u) * 64 + lane];
            e[r] = __builtin_amdgcn_exp2f((ord2f(Cd[r] & ~255u) - v0) * LOG2E); sum += e[r]; }
        const float inv = 1.f / sum;
        u32x4 ew; ew.x = (hi ? eid[8] : eid[0]) | ((hi ? eid[9] : eid[1]) << 16); ew.y = (hi ? eid[10] : eid[2]) | ((hi ? eid[11] : eid[3]) << 16);
        ew.z = (hi ? eid[12] : eid[4]) | ((hi ? eid[13] : eid[5]) << 16); ew.w = (hi ? eid[14] : eid[6]) | ((hi ? eid[15] : eid[7]) << 16);
        *(u32x4*)(EID + (size_t)t * 128 + h * 16 + 8 * hi) = ew;
        const f32x4 g0 = {(hi ? e[8] : e[0]) * inv, (hi ? e[9] : e[1]) * inv, (hi ? e[10] : e[2]) * inv, (hi ? e[11] : e[3]) * inv};
        const f32x4 g1 = {(hi ? e[12] : e[4]) * inv, (hi ? e[13] : e[5]) * inv, (hi ? e[14] : e[6]) * inv, (hi ? e[15] : e[7]) * inv};
        *(f32x4*)(GATE + (size_t)t * 128 + h * 16 + 8 * hi) = g0; *(f32x4*)(GATE + (size_t)t * 128 + h * 16 + 8 * hi + 4) = g1;
        LDS_WAIT();
    }
}

typedef float f32x2 __attribute__((ext_vector_type(2)));
__device__ __forceinline__ float dpp_f(float v, int sel) {
    const int iv = __builtin_bit_cast(int, v); int r;
    if (sel == 0) r = __builtin_amdgcn_update_dpp(0, iv, 0xB1, 0xf, 0xf, true); else if (sel == 1) r = __builtin_amdgcn_update_dpp(0, iv, 0x4E, 0xf, 0xf, true); else r = __builtin_amdgcn_update_dpp(0, iv, 0x141, 0xf, 0xf, true);
    return __builtin_bit_cast(float, r);
}
__device__ __forceinline__ float gelu_erf(float v) {
    const float av = fabsf(v), d = av * 0.2316418882f + 1.0f; const float t = __builtin_amdgcn_rcpf(d);
    float q = t * 0.5307027145f + (-0.7265760135f); q = q * t + 0.7107068705f; q = q * t + (-0.142248368f); q = q * t + 0.127414796f; q = q * t;
    const float e = __builtin_amdgcn_exp2f((v * v) * (-0.72134752044f));
    const float m = v * (q * e), r = v - m; return v < 0.f ? m : r;
}
typedef _Float16 h16x2 __attribute__((ext_vector_type(2)));
__device__ __forceinline__ h16x2 bf8_lo2(unsigned w) { return __builtin_bit_cast(h16x2, __builtin_amdgcn_perm(0u, w, 0x010c000cu)); }
__device__ __forceinline__ h16x2 bf8_hi2(unsigned w) { return __builtin_bit_cast(h16x2, __builtin_amdgcn_perm(0u, w, 0x030c020cu)); }
__device__ __forceinline__ h16x2 bf16pair_to_h2(unsigned w) { h16x2 r; r.x = (_Float16)bf_lo(w); r.y = (_Float16)bf_hi(w); return r; }
#define PEER_E(ev0_, ev1_, w_) (int)((((w_) < 8 ? (ev0_) : (ev1_))[((w_) & 7) >> 1] >> (16 * ((w_) & 1))) & 0xffffu)
#define GLD16(dst_, ptr_) asm volatile("global_load_dwordx4 %0, %1, off" : "=v"(dst_) : "v"(ptr_) : "memory")
__device__ __forceinline__ void phase_peer_u(Frame& F, const bf16_t* XB, const float* rsp, int rsmode, const unsigned short* EID, const unsigned char* U8S, float* PREP) {
    const int lane = opaque_i(F.lane), i16 = (lane >> 3) * 16, c = lane & 7, b = (int)blockIdx.x, x = b & 7, step = (F.G >> 3) * NWAVES;
    const unsigned char* tab = U8S + (size_t)x * NEXP * 128 + 16 * c;
    int t = (b >> 3) * NWAVES + F.wave;
    u32x4 evB0, evB1, xrA0, xrA1, xrB0, xrB1; u32x4 uw[16];
    {   const u32x4 e0 = *(const u32x4*)(EID + (size_t)t * 128 + i16), e1 = *(const u32x4*)(EID + (size_t)t * 128 + i16 + 8);
        xrA0 = *(const u32x4*)(XB + (size_t)t * DM + 128 * x + 16 * c); xrA1 = *(const u32x4*)(XB + (size_t)t * DM + 128 * x + 16 * c + 8);
        const int tn = (t + step < TOK) ? t + step : t;
        evB0 = *(const u32x4*)(EID + (size_t)tn * 128 + i16); evB1 = *(const u32x4*)(EID + (size_t)tn * 128 + i16 + 8);
        xrB0 = *(const u32x4*)(XB + (size_t)tn * DM + 128 * x + 16 * c); xrB1 = *(const u32x4*)(XB + (size_t)tn * DM + 128 * x + 16 * c + 8);
        asm volatile("s_waitcnt vmcnt(0)" : "+v"(evB0), "+v"(evB1), "+v"(xrA0), "+v"(xrA1), "+v"(xrB0), "+v"(xrB1) :: "memory");
#pragma unroll
        for (int w = 0; w < 16; ++w) { const unsigned char* rp = tab + (size_t)PEER_E(e0, e1, w) * 128; GLD16(uw[w], rp); } }
#pragma unroll 1
    for (; t < TOK; t += step) {
        const int tnn = (t + 2 * step < TOK) ? t + 2 * step : t;
        u32x4 evC0, evC1, xrC0, xrC1;
        { const unsigned short* ep = EID + (size_t)tnn * 128 + i16; const bf16_t* xp = XB + (size_t)tnn * DM + 128 * x + 16 * c;
          GLD16(evC0, ep); GLD16(evC1, ep + 8); GLD16(xrC0, xp); GLD16(xrC1, xp + 8); }
        unsigned xq[4];
        { const float sx = row_scale(rsp, rsmode, t) * I8_SX;
#pragma unroll
          for (int k = 0; k < 4; ++k) { const unsigned w = (k < 2 ? xrA0 : xrA1)[2 * (k & 1)], w2 = (k < 2 ? xrA0 : xrA1)[2 * (k & 1) + 1];
              int q0 = __float2int_rn(bf_lo(w) * sx), q1 = __float2int_rn(bf_hi(w) * sx), q2 = __float2int_rn(bf_lo(w2) * sx), q3 = __float2int_rn(bf_hi(w2) * sx);
              q0 = q0 < -127 ? -127 : (q0 > 127 ? 127 : q0); q1 = q1 < -127 ? -127 : (q1 > 127 ? 127 : q1); q2 = q2 < -127 ? -127 : (q2 > 127 ? 127 : q2); q3 = q3 < -127 ? -127 : (q3 > 127 ? 127 : q3);
              xq[k] = ((unsigned)q0 & 0xffu) | (((unsigned)q1 & 0xffu) << 8) | (((unsigned)q2 & 0xffu) << 16) | ((unsigned)q3 << 24); } }
        int r_lo = 0, r_hi = 0;
#pragma unroll
        for (int w = 0; w < 16; ++w) {
            asm volatile("s_waitcnt vmcnt(19)" : "+v"(uw[w]) :: "memory");
            int p = __builtin_amdgcn_sdot4((int)uw[w][0], (int)xq[0], 0, false); int p2 = __builtin_amdgcn_sdot4((int)uw[w][1], (int)xq[1], 0, false);
            p = __builtin_amdgcn_sdot4((int)uw[w][2], (int)xq[2], p, false); p2 = __builtin_amdgcn_sdot4((int)uw[w][3], (int)xq[3], p2, false);
            p += p2;
            p += __builtin_amdgcn_update_dpp(0, p, 0xB1, 0xf, 0xf, true); p += __builtin_amdgcn_update_dpp(0, p, 0x4E, 0xf, 0xf, true); p += __builtin_amdgcn_update_dpp(0, p, 0x141, 0xf, 0xf, true);
            if (w < 8) r_lo = (c == w) ? p : r_lo; else r_hi = (c == (w & 7)) ? p : r_hi;
            { const unsigned char* rp = tab + (size_t)PEER_E(evB0, evB1, w) * 128; GLD16(uw[w], rp); }
            }
        float* dst = PREP + ((size_t)x * TOK + t) * 128 + i16 + c; dst[0] = (float)r_lo * (1.f / (I8_SU * I8_SX)); dst[8] = (float)r_hi * (1.f / (I8_SU * I8_SX));
        asm volatile("s_waitcnt vmcnt(16)" : "+v"(evC0), "+v"(evC1), "+v"(xrC0), "+v"(xrC1) :: "memory");
        evB0 = evC0; evB1 = evC1; xrA0 = xrB0; xrA1 = xrB1; xrB0 = xrC0; xrB1 = xrC1;
    }
    asm volatile("s_waitcnt vmcnt(0)" ::: "memory");
}
__device__ __forceinline__ void phase_peer_c(Frame& F, const float* PREP, const float* rsp, int rsmode, const float* GATE, bf16_t* ACO) {
    const int gw = F.vcu * NWAVES + F.wave, NGW = F.G * NWAVES, lane = opaque_i(F.lane);
    for (int t = gw; t < TOK; t += NGW) {
        float s0 = 0.f, s1 = 0.f;
#pragma unroll
        for (int x = 0; x < 8; ++x) { const float* p = PREP + ((size_t)x * TOK + t) * 128; s0 += p[lane]; s1 += p[64 + lane]; }
        const float rsu = 1.f;
        { const _Float16 h0 = (_Float16)(gelu_erf(s0 * rsu) * GATE[(size_t)t * 128 + lane] * (1.f / FP8_SV)), h1 = (_Float16)(gelu_erf(s1 * rsu) * GATE[(size_t)t * 128 + 64 + lane] * (1.f / FP8_SV));
          ACO[(size_t)t * 128 + lane] = __builtin_bit_cast(unsigned short, h0); ACO[(size_t)t * 128 + 64 + lane] = __builtin_bit_cast(unsigned short, h1); }
    }
}
#define PIN16(o_) asm volatile("" : "+v"(o_[0]), "+v"(o_[1]), "+v"(o_[2]), "+v"(o_[3]), "+v"(o_[4]), "+v"(o_[5]), "+v"(o_[6]), "+v"(o_[7]), "+v"(o_[8]), "+v"(o_[9]), "+v"(o_[10]), "+v"(o_[11]), "+v"(o_[12]), "+v"(o_[13]), "+v"(o_[14]), "+v"(o_[15]))
#define GLD4(dst_, ptr_) asm volatile("global_load_dword %0, %1, off" : "=v"(dst_) : "v"(ptr_) : "memory")
__device__ __forceinline__ void phase_peer_v(Frame& F, bf16_t* XB, const unsigned short* EID, const bf16_t* ACO, const unsigned char* V8S, float* SSQP) {
    const int lane = opaque_i(F.lane), i16 = (lane >> 3) * 16, c = lane & 7, b = (int)blockIdx.x, x = b & 7, step = (F.G >> 3) * NWAVES;
    const unsigned char* tab = V8S + (size_t)x * NEXP * 128 + 16 * c;
    const bool b3 = lane & 8;
    const int col = 128 * x + 16 * c + ((lane & 32) ? 8 : 0) + ((lane & 16) ? 4 : 0) + (b3 ? 2 : 0);
    int t = (b >> 3) * NWAVES + F.wave;
    u32x4 evB0, evB1, aA0, aA1, vw[16]; unsigned xfA;
    {   const u32x4 e0 = *(const u32x4*)(EID + (size_t)t * 128 + i16), e1 = *(const u32x4*)(EID + (size_t)t * 128 + i16 + 8);
        aA0 = *(const u32x4*)(ACO + (size_t)t * 128 + i16); aA1 = *(const u32x4*)(ACO + (size_t)t * 128 + i16 + 8);
        xfA = *(const unsigned*)(XB + (size_t)t * DM + col);
        const int tn = (t + step < TOK) ? t + step : t;
        evB0 = *(const u32x4*)(EID + (size_t)tn * 128 + i16); evB1 = *(const u32x4*)(EID + (size_t)tn * 128 + i16 + 8);
        asm volatile("s_waitcnt vmcnt(0)" : "+v"(evB0), "+v"(evB1), "+v"(aA0), "+v"(aA1), "+v"(xfA) :: "memory");
#pragma unroll
        for (int w = 0; w < 16; ++w) { const unsigned char* rp = tab + (size_t)PEER_E(e0, e1, w) * 128; GLD16(vw[w], rp); } }
#pragma unroll 1
    for (; t < TOK; t += step) {
        const int tn = (t + step < TOK) ? t + step : t, tnn = (t + 2 * step < TOK) ? t + 2 * step : t;
        u32x4 evC0, evC1, aB0, aB1; unsigned xfB;
        { const unsigned short* ep = EID + (size_t)tnn * 128 + i16; const bf16_t* ap = ACO + (size_t)tn * 128 + i16; const bf16_t* xp = XB + (size_t)tn * DM + col;
          GLD16(evC0, ep); GLD16(evC1, ep + 8); GLD16(aB0, ap); GLD16(aB1, ap + 8); GLD4(xfB, xp); }
        float o[16];
#pragma unroll
        for (int k = 0; k < 16; ++k) o[k] = 0.f;
#pragma unroll
        for (int w = 0; w < 16; w += 2) {
            asm volatile("s_waitcnt vmcnt(19)" : "+v"(vw[w]), "+v"(vw[w + 1]) :: "memory");
            const unsigned aw = (w < 8 ? aA0 : aA1)[(w & 7) >> 1]; const h16x2 a2 = __builtin_bit_cast(h16x2, aw);
#pragma unroll
            for (int k = 0; k < 4; ++k) { const unsigned r0 = vw[w][k], r1 = vw[w + 1][k];
                o[4 * k]     = __builtin_amdgcn_fdot2(__builtin_bit_cast(h16x2, __builtin_amdgcn_perm(r1, r0, 0x040c000cu)), a2, o[4 * k], false);
                o[4 * k + 1] = __builtin_amdgcn_fdot2(__builtin_bit_cast(h16x2, __builtin_amdgcn_perm(r1, r0, 0x050c010cu)), a2, o[4 * k + 1], false);
                o[4 * k + 2] = __builtin_amdgcn_fdot2(__builtin_bit_cast(h16x2, __builtin_amdgcn_perm(r1, r0, 0x060c020cu)), a2, o[4 * k + 2], false);
                o[4 * k + 3] = __builtin_amdgcn_fdot2(__builtin_bit_cast(h16x2, __builtin_amdgcn_perm(r1, r0, 0x070c030cu)), a2, o[4 * k + 3], false); }
            PIN16(o);
            { const unsigned char* rp = tab + (size_t)PEER_E(evB0, evB1, w) * 128; GLD16(vw[w], rp); }
            { const unsigned char* rp = tab + (size_t)PEER_E(evB0, evB1, w + 1) * 128; GLD16(vw[w + 1], rp); } }
        float h8[8], h4[4], h2[2];
#pragma unroll
        for (int k = 0; k < 8; ++k) { const auto r = __builtin_amdgcn_permlane32_swap(__float_as_uint(o[k]), __float_as_uint(o[8 + k]), false, false); h8[k] = __uint_as_float(r[0]) + __uint_as_float(r[1]); }
#pragma unroll
        for (int k = 0; k < 4; ++k) { const auto r = __builtin_amdgcn_permlane16_swap(__float_as_uint(h8[k]), __float_as_uint(h8[4 + k]), false, false); h4[k] = __uint_as_float(r[0]) + __uint_as_float(r[1]); }
#pragma unroll
        for (int k = 0; k < 2; ++k) { const float keep = b3 ? h4[2 + k] : h4[k], send = b3 ? h4[k] : h4[2 + k];
            h2[k] = keep + __builtin_bit_cast(float, __builtin_amdgcn_update_dpp(0, __builtin_bit_cast(int, send), 0x128, 0xf, 0xf, true)); }
        const f32x2 f = {bf_lo(xfA) + h2[0], bf_hi(xfA) + h2[1]};
        *(unsigned*)(XB + (size_t)t * DM + col) = pk2(f.x, f.y);
        const float ss = wave_total(f.x * f.x + f.y * f.y);
        if (lane == 0) { SSQP[(size_t)t * 16 + x] = ss; SSQP[(size_t)t * 16 + 8 + x] = 0.f; }
        asm volatile("s_waitcnt vmcnt(16)" : "+v"(evC0), "+v"(evC1), "+v"(aB0), "+v"(aB1), "+v"(xfB) :: "memory");
        aA0 = aB0; aA1 = aB1; evB0 = evC0; evB1 = evC1; xfA = xfB;
    }
    asm volatile("s_waitcnt vmcnt(0)" ::: "memory");
}

__device__ __forceinline__ void phase_final_norm(Frame& F, const bf16_t* XB, float* OUT, const float* SSQP, const float* norm_f) {
    const int gw = F.vcu * NWAVES + F.wave, NGW = F.G * NWAVES, lane = opaque_i(F.lane);
    for (int t = gw; t < TOK; t += NGW) { const float r = row_scale(SSQP, 1, t);
#pragma unroll
        for (int j = 0; j < 4; ++j) { const u32x2 w = *(const u32x2*)(XB + (size_t)t * DM + 256 * j + 4 * lane); const f32x4 x = {bf_lo(w.x), bf_hi(w.x), bf_lo(w.y), bf_hi(w.y)};
            *(f32x4*)(OUT + (size_t)t * DM + 256 * j + 4 * lane) = x * r * *(const f32x4*)(norm_f + 256 * j + 4 * lane); } }
}

constexpr int N_PHASES = 20;
struct Args { const float* in[16]; float* out; unsigned char* ws; int ph_lo, ph_hi; };
template <bool COOP>
__global__ void __launch_bounds__(NWAVES * 64, 2) mk_fwd(Args args) {
    extern __shared__ __attribute__((aligned(16))) unsigned char lds[];
    Frame F;
    F.lds = (LAS unsigned char*)lds;
    F.tid = threadIdx.x; F.lane = F.tid & 63; F.wave = __builtin_amdgcn_readfirstlane(F.tid >> 6);
    F.G = gridDim.x; { const int bx = blockIdx.x; F.vcu = (F.G % 8 == 0) ? (bx % 8) * (F.G / 8) + bx / 8 : bx; }
    Ptrs P;
    P.x = args.in[0]; P.norm_mix = args.in[1]; P.norm_ffn = args.in[2]; P.ev_w_in = args.in[3]; P.ev_b_f = args.in[4]; P.ev_w_out = args.in[5]; P.od_w_in = args.in[6];
    P.od_pool_w = args.in[7]; P.od_pool_scale = args.in[8]; P.od_w_out = args.in[9]; P.peer_wq = args.in[10]; P.peer_k1 = args.in[11]; P.peer_k2 = args.in[12];
    P.peer_u = args.in[13]; P.peer_v = args.in[14]; P.norm_f = args.in[15]; P.out = args.out; P.ws = args.ws;
    unsigned char* ws = args.ws;
    bf16_t* XB = (bf16_t*)(ws + WS_XB); bf16_t* AO = (bf16_t*)(ws + WS_AO); bf16_t* QP = (bf16_t*)(ws + WS_QP);
    unsigned short* EID = (unsigned short*)(ws + WS_EID); float* GATE = (float*)(ws + WS_GATE);
    float* RS0 = (float*)(ws + WS_RS0); float* SSQ2 = (float*)(ws + WS_SSQ2); float* PREP = (float*)(ws + WS_PREP); bf16_t* ACO = (bf16_t*)(ws + WS_ACO); float* SSQ1 = (float*)(ws + WS_SSQ1); float* SSQ3 = (float*)(ws + WS_SSQ3);
    const int lo = args.ph_lo, hi = args.ph_hi;
    volatile LAS unsigned* xbst = (volatile LAS unsigned*)(F.lds + RING_BYTES + 1024);
    if (F.tid < 4) xbst[F.tid] = 0u;
    __syncthreads();
    XcdBarrier xbar; xbar.bar = (unsigned*)(ws + WS_CTL) + 4096; xbar.x = 0; xbar.st = xbst;
    if (COOP) xbar = xcd_barrier_post((unsigned*)(ws + WS_CTL) + 4096, xbst);
#define IN(k) (lo <= (k) && (k) < hi)
#define SEAM(k) do { if (COOP && IN(k) && IN((k) + 1)) { if ((k) == 0) cg::this_grid().sync(); else xcd_barrier(xbar); } } while (0)
    if (IN(0)) { phase_p0(F, P); } SEAM(0);
    if (IN(1)) {
        pg8::Gemm g{XB, (const bf16_t*)(ws + WS_W1T), TOK, EVEN_PAD, DM}; pg8::StaticOrder S; S.init(TOK, EVEN_PAD, F.G, (int)blockIdx.x);
        EpiL0In E{RS0, (bf16_t*)(ws + WS_QH), (bf16_t*)(ws + WS_KH), (bf16_t*)(ws + WS_VT), (float*)(ws + WS_LF), P.ev_b_f};
        pg8::gemm_phase<EpiL0In, pg8::StaticOrder, true, true>(F.lds, g, S, E);
    } SEAM(1);
    if (IN(2)) { phase_cfscan(F, (const float*)(ws + WS_LF), (float*)(ws + WS_CF)); } SEAM(2);
    if (IN(3)) {
        phase_attn_fox(F, (const bf16_t*)(ws + WS_QH), (const bf16_t*)(ws + WS_KH), (const bf16_t*)(ws + WS_VT), (const float*)(ws + WS_CF), AO);
        phase_attn<1>(F, (const bf16_t*)(ws + WS_QH), (const bf16_t*)(ws + WS_KH), (const bf16_t*)(ws + WS_VT), 16, 8, nullptr, nullptr, AO, 512);
    } SEAM(3);
    if (IN(4)) {
        pg8::Gemm g{AO, (const bf16_t*)(ws + WS_W2T), TOK, DM, DM}; pg8::StaticOrder S; S.init(TOK, DM, F.G, (int)blockIdx.x);
        EpiRes<false> E{P.x, XB, SSQ1};
        pg8::gemm_phase<EpiRes<false>, pg8::StaticOrder, true, true>(F.lds, g, S, E);
    } SEAM(4);
    if (IN(5)) {
        pg8::Gemm g{XB, (const bf16_t*)(ws + WS_W3T), TOK, 2048, DM}; pg8::StaticOrder S; S.init(TOK, 2048, F.G, (int)blockIdx.x);
        EpiQ E{SSQ1, 1, QP};
        pg8::gemm_phase<EpiQ, pg8::StaticOrder, true, true>(F.lds, g, S, E);
    } SEAM(5);
    if (IN(6)) { phase_topk(F, QP, (const bf16_t*)(ws + WS_K1B), (const bf16_t*)(ws + WS_K2B), EID, GATE); } SEAM(6);
    if (IN(7)) { phase_peer_u(F, XB, SSQ1, 1, EID, ws + WS_U8S, PREP); } SEAM(7);
    if (IN(8)) { phase_peer_c(F, PREP, SSQ1, 1, GATE, ACO); } SEAM(8);
    if (IN(9)) { phase_peer_v(F, XB, EID, ACO, ws + WS_V8S, SSQ2); } SEAM(9);
    if (IN(10)) {
        pg8::Gemm g{XB, (const bf16_t*)(ws + WS_W4T), TOK, 2048, DM}; pg8::StaticOrder S; S.init(TOK, 2048, F.G, (int)blockIdx.x);
        EpiL1In E{SSQ2, 1, (bf16_t*)(ws + WS_QH), (bf16_t*)(ws + WS_QH + 32 * MiB), (bf16_t*)(ws + WS_KH), (bf16_t*)(ws + WS_KH + 32 * MiB)};
        pg8::gemm_phase<EpiL1In, pg8::StaticOrder, true, true>(F.lds, g, S, E);
    } SEAM(10);
    if (IN(11)) {
        phase_pool(F, (const bf16_t*)(ws + WS_QH), (const bf16_t*)(ws + WS_PWT), P.od_pool_scale, AO);
        phase_kmean(F, (const bf16_t*)(ws + WS_KH), (float*)(ws + WS_KMEAN));
    } SEAM(11);
    if (IN(12)) {
        phase_attn_moba(F, (const bf16_t*)(ws + WS_QH + 32 * MiB), (const bf16_t*)(ws + WS_KH), (const bf16_t*)(ws + WS_KH + 32 * MiB), (const float*)(ws + WS_KMEAN), AO);
    } SEAM(12);
    if (IN(13)) {
        pg8::Gemm g{AO, (const bf16_t*)(ws + WS_W5T), TOK, DM, DM}; pg8::StaticOrder S; S.init(TOK, DM, F.G, (int)blockIdx.x);
        EpiRes<true> E{XB, XB, SSQ3};
        pg8::gemm_phase<EpiRes<true>, pg8::StaticOrder, true, true>(F.lds, g, S, E);
    } SEAM(13);
    if (IN(14)) {
        pg8::Gemm g{XB, (const bf16_t*)(ws + WS_W6T), TOK, 2048, DM}; pg8::StaticOrder S; S.init(TOK, 2048, F.G, (int)blockIdx.x);
        EpiQ E{SSQ3, 1, QP};
        pg8::gemm_phase<EpiQ, pg8::StaticOrder, true, true>(F.lds, g, S, E);
    } SEAM(14);
    if (IN(15)) { phase_topk(F, QP, (const bf16_t*)(ws + WS_K1B) + 8 * 128 * 128, (const bf16_t*)(ws + WS_K2B) + 8 * 128 * 128, EID, GATE); } SEAM(15);
    if (IN(16)) { phase_peer_u(F, XB, SSQ3, 1, EID, ws + WS_U8S + (size_t)8 * NEXP * 128, PREP); } SEAM(16);
    if (IN(17)) { phase_peer_c(F, PREP, SSQ3, 1, GATE, ACO); } SEAM(17);
    if (IN(18)) { phase_peer_v(F, XB, EID, ACO, ws + WS_V8S + (size_t)8 * NEXP * 128, SSQ2); } SEAM(18);
    if (IN(19)) { phase_final_norm(F, XB, P.out, SSQ2, P.norm_f); }
#undef IN
#undef SEAM
}

extern "C" void kernel_launch(void* const* d_in, const int* in_sizes, int n_in, void* d_out, int out_size, void* d_ws, size_t ws_size, hipStream_t stream) {
    static int grid = 0;
    constexpr bool COOP = (MK_MULTI == 0);
    if (grid == 0) {
        if (n_in != 16 || in_sizes[0] != TOK * DM || out_size != TOK * DM || ws_size < WS_END) { fprintf(stderr, "kernel_launch: unexpected shapes (n_in %d, in0 %d, out %d, ws %zu)\n", n_in, n_in > 0 ? in_sizes[0] : -1, out_size, ws_size); grid = -1; return; }
        int dev = 0, cus = 0, per_cu = 0;
        if (hipGetDevice(&dev) != hipSuccess || hipDeviceGetAttribute(&cus, hipDeviceAttributeMultiprocessorCount, dev) != hipSuccess) { grid = -1; return; }
        if (hipFuncSetAttribute((const void*)mk_fwd<COOP>, hipFuncAttributeMaxDynamicSharedMemorySize, LDS_BYTES) != hipSuccess) { fprintf(stderr, "kernel_launch: hipFuncSetAttribute failed\n"); grid = -1; return; }
        if (hipOccupancyMaxActiveBlocksPerMultiprocessor(&per_cu, (const void*)mk_fwd<COOP>, NWAVES * 64, LDS_BYTES) != hipSuccess || per_cu < 1) { fprintf(stderr, "kernel_launch: occupancy query says %d\n", per_cu); per_cu = 1; }
        (void)hipGetLastError();
        grid = cus;
    }
    if (grid < 0) return;
    if (hipMemsetAsync((char*)d_ws + WS_CTL, 0, CTL_ZERO_BYTES, stream) != hipSuccess) { fprintf(stderr, "kernel_launch: memset failed\n"); return; }
    Args a{};
    for (int i = 0; i < 16; ++i) a.in[i] = (const float*)d_in[i];
    a.out = (float*)d_out; a.ws = (unsigned char*)d_ws;
    if (COOP) {
        a.ph_lo = 0; a.ph_hi = N_PHASES;
        void* kargs[] = {&a};
        const hipError_t e = hipLaunchCooperativeKernel((const void*)mk_fwd<COOP>, dim3(grid), dim3(NWAVES * 64), kargs, LDS_BYTES, stream);
        if (e != hipSuccess) fprintf(stderr, "kernel_launch: cooperative launch failed: %s (grid %d)\n", hipGetErrorString(e), grid);
    } else {
        for (int p = 0; p < N_PHASES; ++p) { a.ph_lo = p; a.ph_hi = p + 1; hipLaunchKernelGGL(mk_fwd<COOP>, dim3(grid), dim3(NWAVES * 64), LDS_BYTES, stream, a); }
    }
}
```

```cpp
#include <hip/hip_runtime.h>
#include <hip/hip_cooperative_groups.h>
#include <cstdio>
#include <cstdint>
#include <cmath>
namespace cg = cooperative_groups;

#ifndef MK_MULTI
#define MK_MULTI 0
#endif

namespace pg8 {
#define PG8_LAS __attribute__((address_space(3)))
typedef unsigned short bf16_t;
typedef short bf16x8 __attribute__((ext_vector_type(8)));
typedef float f32x4 __attribute__((ext_vector_type(4)));
typedef unsigned u32x4 __attribute__((ext_vector_type(4)));
constexpr int BM = 256, BK = 64, HALF = 128, HTB = HALF * BK * 2  , STAGE_BYTES = 8 * HTB, NXCD = 8, WGM = 8;

__host__ __device__ __forceinline__ int lds_byte(int r, int c) { const int st = (r >> 4) * 2 + (c >> 5), rr = r & 15, cc = c & 31, ob = rr * 64 + cc * 2; return st * 1024 + (ob ^ (((ob >> 9) & 1) << 5)); }
__host__ __device__ __forceinline__ void stage_rc(int b, int& R, int& C) { const int st = b / 1024, sb = b % 1024, swz = sb ^ (((sb >> 9) & 1) << 5); R = (st >> 1) * 16 + swz / 64; C = (st & 1) * 32 + (swz % 64) / 2; }
__host__ __device__ __forceinline__ int perm32(int rho) { const int n = rho >> 4, i = rho & 15; return 8 * (i >> 2) + 4 * n + (i & 3); }

struct Unit { int pm, pn; };
struct Gemm { const bf16_t* A; const bf16_t* Bt; int M, N, K; };

struct StaticOrder {
    int nM, nN, nwg, G, c;
    __host__ __device__ void init(int M, int N, int G_, int c_) { nM = M / BM; nN = N / BM; nwg = nM * nN; G = G_; c = c_; }
    __host__ __device__ bool next(int i, Unit& u) const {
        const long L = (long)i * G + c; if (L >= nwg) return false;
        int wgid = (int)L; { const int q = nwg / NXCD, r = nwg % NXCD, xcd = wgid % NXCD, off = wgid / NXCD; wgid = (xcd < r ? xcd * (q + 1) : r * (q + 1) + (xcd - r) * q) + off; }
        const int nig = WGM * nN, gid = wgid / nig, fm = gid * WGM, gsz = (nM - fm) < WGM ? (nM - fm) : WGM;
        u.pm = fm + ((wgid % nig) % gsz); u.pn = (wgid % nig) / gsz; return true;
    }
    __device__ __forceinline__ void a_ready(const Unit&) const {}
    __device__ __forceinline__ void done(const Unit&) const {}
};
__device__ __forceinline__ unsigned cvt_pk_bf16(float lo, float hi) { unsigned r; asm volatile("v_cvt_pk_bf16_f32 %0, %1, %2" : "=v"(r) : "v"(lo), "v"(hi)); return r; }
template <class Epi, class Sched, bool ALIGN_EPI = false, bool SP2 = false>
__device__ __forceinline__ void gemm_phase(PG8_LAS unsigned char* lds, const Gemm g, const Sched& S, const Epi& E) {
    const int tid = threadIdx.x, wid = __builtin_amdgcn_readfirstlane(tid >> 6), lane = tid & 63, wr = wid >> 2, wc = wid & 3, fr = lane & 15, fq = lane >> 4;
    const int K = g.K, nt = K / BK;
    unsigned voffA[2], voffB[2];
#pragma unroll
    for (int i = 0; i < 2; ++i) { int R, C; stage_rc(tid * 16 + i * 8192, R, C); const int Rb = Epi::PERM ? ((R & ~31) + perm32(R & 31)) : R;
        voffA[i] = (unsigned)(R * K + C) * 2u; voffB[i] = (unsigned)(Rb * K + C) * 2u; }
    const size_t kstep = (size_t)(BK * 2);
    const size_t hstep = (size_t)HALF * K * 2;
    const size_t tstep = 2 * hstep;
    const unsigned ldsw = (unsigned)wid * 1024u;
    const int aoff = lds_byte(wr * 64 + fr, fq * 8), boff = lds_byte(wc * 32 + fr, fq * 8);
#define PG8_SA(b, h) (((b) * 2 + (h)) * HTB)
#define PG8_SB(b, h) ((4 + (b) * 2 + (h)) * HTB)
#define PG8_STAGE(bufoff, gbase, voff) do { _Pragma("unroll") for (int _i = 0; _i < 2; ++_i) \
        __builtin_amdgcn_global_load_lds((const unsigned*)((const char*)(gbase) + (voff)[_i]), (PG8_LAS unsigned*)(lds + (bufoff) + ldsw + _i * 8192), 16, 0, 0); } while (0)
#define PG8_LDA(dst, b, h) do { _Pragma("unroll") for (int m = 0; m < 4; ++m) _Pragma("unroll") for (int k = 0; k < 2; ++k) dst[m][k] = *(const PG8_LAS bf16x8*)(lds + PG8_SA(b, h) + aoff + m * 2048 + k * 1024); } while (0)
#define PG8_LDB(dst, b, h) do { _Pragma("unroll") for (int n = 0; n < 2; ++n) _Pragma("unroll") for (int k = 0; k < 2; ++k) dst[n][k] = *(const PG8_LAS bf16x8*)(lds + PG8_SB(b, h) + boff + n * 2048 + k * 1024); } while (0)
#define PG8_MMA(ai, bj, At, Bt) do { __builtin_amdgcn_s_setprio(1); _Pragma("unroll") for (int m = 0; m < 4; ++m) _Pragma("unroll") for (int n = 0; n < 2; ++n) _Pragma("unroll") for (int k = 0; k < 2; ++k) \
        acc[ai][bj][m][n] = __builtin_amdgcn_mfma_f32_16x16x32_bf16(Bt[n][k], At[m][k], acc[ai][bj][m][n], 0, 0, 0); __builtin_amdgcn_s_setprio(0); } while (0)
#define PG8_WAIT_V(n) asm volatile("s_waitcnt vmcnt(" #n ")" ::: "memory")
#define PG8_WAIT_L(n) asm volatile("s_waitcnt lgkmcnt(" #n ")" ::: "memory")
#define PG8_BAR __builtin_amdgcn_s_barrier()
#define PG8_SCHED __builtin_amdgcn_sched_barrier(0)
    Unit cur, nxt; int ui = 0;
    if (!S.next(0, cur)) return;
    f32x4 acc[2][2][4][2];
#pragma unroll
    for (int a = 0; a < 2; ++a)
#pragma unroll
        for (int b = 0; b < 2; ++b)
#pragma unroll
            for (int m = 0; m < 4; ++m)
#pragma unroll
                for (int n = 0; n < 2; ++n) acc[a][b][m][n] = (f32x4){0.f, 0.f, 0.f, 0.f};
    bf16x8 At[4][2], B0[2][2], B1[2][2];
    const char* cA = (const char*)g.A + (size_t)cur.pm * tstep; const char* cB = (const char*)g.Bt + (size_t)cur.pn * tstep;
    S.a_ready(cur);
    if constexpr (SP2) {
        PG8_STAGE(PG8_SB(0, 0), cB, voffB); PG8_STAGE(PG8_SB(0, 1), cB + hstep, voffB); PG8_STAGE(PG8_SA(0, 0), cA, voffA); PG8_STAGE(PG8_SA(0, 1), cA + hstep, voffA);
        if (wr == 1) PG8_BAR;
        PG8_WAIT_V(2); PG8_BAR;
        PG8_STAGE(PG8_SB(1, 0), cB + kstep, voffB); PG8_STAGE(PG8_SA(1, 0), cA + kstep, voffA); PG8_STAGE(PG8_SB(1, 1), cB + hstep + kstep, voffB);
        PG8_WAIT_V(6); PG8_BAR;
    } else {
        PG8_STAGE(PG8_SB(0, 0), cB, voffB); PG8_STAGE(PG8_SA(0, 0), cA, voffA); PG8_STAGE(PG8_SB(0, 1), cB + hstep, voffB); PG8_STAGE(PG8_SA(0, 1), cA + hstep, voffA);
        if (wr == 1) PG8_BAR;
        PG8_WAIT_V(4); PG8_BAR;
        PG8_STAGE(PG8_SB(1, 0), cB + kstep, voffB); PG8_STAGE(PG8_SA(1, 0), cA + kstep, voffA); PG8_STAGE(PG8_SB(1, 1), cB + hstep + kstep, voffB);
        PG8_WAIT_V(6); PG8_BAR;
    }
    for (;;) {
        const bool has_next = S.next(ui + 1, nxt);
        const char* nA = has_next ? (const char*)g.A + (size_t)nxt.pm * tstep : cA; const char* nB = has_next ? (const char*)g.Bt + (size_t)nxt.pn * tstep : cB;
        for (int t = 0; t < nt; t += 2) {
            const bool last = (t == nt - 2);
            const char* a1 = cA + (size_t)(t + 1) * kstep;
            const char* a2 = last ? nA : cA + (size_t)(t + 2) * kstep; const char* b2 = last ? nB : cB + (size_t)(t + 2) * kstep;
            const char* a3 = a2 + kstep; const char* b3 = b2 + kstep;
            if (last && has_next) S.a_ready(nxt);
            if constexpr (SP2) {
            PG8_LDB(B0, 0, 0); PG8_LDB(B1, 0, 1); PG8_SCHED; PG8_LDA(At, 0, 0); PG8_STAGE(PG8_SA(1, 1), a1 + hstep, voffA);
            PG8_WAIT_V(8); PG8_WAIT_L(0); PG8_BAR; PG8_MMA(0, 0, At, B0); PG8_MMA(0, 1, At, B1); PG8_BAR; PG8_SCHED;
            PG8_LDA(At, 0, 1); PG8_STAGE(PG8_SB(0, 0), b2, voffB); PG8_STAGE(PG8_SB(0, 1), b2 + hstep, voffB); PG8_STAGE(PG8_SA(0, 0), a2, voffA);
            PG8_WAIT_V(8); PG8_WAIT_L(0); PG8_BAR; PG8_MMA(1, 0, At, B0); PG8_MMA(1, 1, At, B1); PG8_BAR; PG8_SCHED;
            PG8_LDB(B0, 1, 0); PG8_LDB(B1, 1, 1); PG8_SCHED; PG8_LDA(At, 1, 0); PG8_STAGE(PG8_SA(0, 1), a2 + hstep, voffA);
            PG8_WAIT_V(8); PG8_WAIT_L(0); PG8_BAR; PG8_MMA(0, 0, At, B0); PG8_MMA(0, 1, At, B1); PG8_BAR; PG8_SCHED;
            PG8_LDA(At, 1, 1); PG8_STAGE(PG8_SB(1, 0), b3, voffB); PG8_STAGE(PG8_SB(1, 1), b3 + hstep, voffB); PG8_STAGE(PG8_SA(1, 0), a3, voffA);
            PG8_WAIT_V(8); PG8_WAIT_L(0); PG8_BAR; PG8_MMA(1, 0, At, B0); PG8_MMA(1, 1, At, B1); PG8_BAR; PG8_SCHED;
            } else {
            PG8_LDB(B0, 0, 0); PG8_SCHED; PG8_LDA(At, 0, 0); PG8_STAGE(PG8_SA(1, 1), a1 + hstep, voffA);
            PG8_WAIT_L(8); PG8_BAR; PG8_WAIT_L(0); PG8_MMA(0, 0, At, B0); PG8_BAR; PG8_SCHED;
            PG8_LDB(B1, 0, 1); PG8_STAGE(PG8_SB(0, 0), b2, voffB);
            PG8_BAR; PG8_WAIT_L(0); PG8_MMA(0, 1, At, B1); PG8_BAR;
            PG8_LDA(At, 0, 1); PG8_STAGE(PG8_SA(0, 0), a2, voffA);
            PG8_BAR; PG8_WAIT_L(0); PG8_MMA(1, 0, At, B0); PG8_BAR; PG8_SCHED;
            PG8_STAGE(PG8_SB(0, 1), b2 + hstep, voffB);
            PG8_WAIT_V(6); PG8_BAR; PG8_MMA(1, 1, At, B1); PG8_BAR;
            PG8_LDB(B0, 1, 0); PG8_SCHED; PG8_LDA(At, 1, 0); PG8_STAGE(PG8_SA(0, 1), a2 + hstep, voffA);
            PG8_WAIT_L(8); PG8_BAR; PG8_WAIT_L(0); PG8_MMA(0, 0, At, B0); PG8_BAR; PG8_SCHED;
            PG8_LDB(B1, 1, 1); PG8_STAGE(PG8_SB(1, 0), b3, voffB);
            PG8_BAR; PG8_WAIT_L(0); PG8_MMA(0, 1, At, B1); PG8_BAR;
            PG8_LDA(At, 1, 1); PG8_STAGE(PG8_SA(1, 0), a3, voffA);
            PG8_BAR; PG8_WAIT_L(0); PG8_MMA(1, 0, At, B0); PG8_BAR; PG8_SCHED;
            PG8_STAGE(PG8_SB(1, 1), b3 + hstep, voffB);
            PG8_WAIT_V(6); PG8_BAR; PG8_MMA(1, 1, At, B1); PG8_BAR;
            }
        }
        if constexpr (ALIGN_EPI) { if (wr == 0) PG8_BAR; }
        if constexpr (!Epi::AFTER_DRAIN) { E(acc, cur, wr, wc, fr, fq); S.done(cur); }
        if (!has_next) break;
#pragma unroll
        for (int a = 0; a < 2; ++a)
#pragma unroll
            for (int b = 0; b < 2; ++b)
#pragma unroll
                for (int m = 0; m < 4; ++m)
#pragma unroll
                    for (int n = 0; n < 2; ++n) acc[a][b][m][n] = (f32x4){0.f, 0.f, 0.f, 0.f};
        cur = nxt; cA = nA; cB = nB; ++ui;
        if constexpr (ALIGN_EPI) { if (wr == 1) PG8_BAR; }
    }
    PG8_WAIT_V(0);
    if constexpr (!ALIGN_EPI) { if (wr == 0) PG8_BAR; }
    PG8_BAR;
    if constexpr (Epi::AFTER_DRAIN) { E.fused(acc, cur, wr, wc, fr, fq, lds, wid, lane); S.done(cur); }
#undef PG8_SA
#undef PG8_SB
#undef PG8_STAGE
#undef PG8_LDA
#undef PG8_LDB
#undef PG8_MMA
#undef PG8_WAIT_V
#undef PG8_WAIT_L
#undef PG8_BAR
#undef PG8_SCHED
}
}

constexpr int NB = 16, SEQ = 2048, DM = 1024, TOK = NB * SEQ;
constexpr int EVEN_IN = 3080, EVEN_PAD = 3328;
constexpr int NEXP = 16384;
constexpr float RMS_EPS = 1e-6f;
constexpr float LOG2E = 1.4426950408889634f;
constexpr float C2 = 0.125f * LOG2E;

constexpr size_t MiB = 1u << 20;
constexpr size_t WS_CTL = 0, CTL_ZERO_BYTES = 1 * MiB;
constexpr size_t WS_W1T = 1 * MiB;
constexpr size_t WS_W2T = 8 * MiB;
constexpr size_t WS_W4T = 10 * MiB;
constexpr size_t WS_W5T = 14 * MiB;
constexpr size_t WS_W3T = 16 * MiB;
constexpr size_t WS_W6T = 20 * MiB;
constexpr size_t WS_K1B = 24 * MiB;
constexpr size_t WS_K2B = 24 * MiB + 512 * 1024;
constexpr size_t WS_PWT = 25 * MiB;
constexpr size_t WS_LF  = 25 * MiB + 256 * 1024;
constexpr size_t WS_CF  = 26 * MiB + 256 * 1024;
constexpr size_t WS_KMEAN = 27 * MiB + 256 * 1024;
constexpr size_t WS_RS0 = 27 * MiB + 512 * 1024;
constexpr size_t WS_RS2 = 27 * MiB + 640 * 1024;
constexpr size_t WS_SSQ1 = 28 * MiB;
constexpr size_t WS_SSQ3 = 30 * MiB;
constexpr size_t WS_U8S = 32 * MiB;
constexpr size_t WS_V8S = 64 * MiB;
constexpr size_t WS_XB = 160 * MiB;
constexpr size_t WS_QH = 224 * MiB;
constexpr size_t WS_KH = 288 * MiB;
constexpr size_t WS_VT = 352 * MiB;
constexpr size_t WS_QP = 224 * MiB;
constexpr size_t WS_AO = 416 * MiB;
constexpr size_t WS_EID = 480 * MiB;
constexpr size_t WS_GATE = 488 * MiB;
constexpr size_t WS_SSQ2 = 504 * MiB;
constexpr size_t WS_PREP = 224 * MiB;
constexpr size_t WS_ACO = 416 * MiB;
constexpr size_t WS_END = 506 * MiB;

constexpr int RING_BYTES = 131072;
constexpr int LDS_BYTES = 147456;
constexpr int NWAVES = 8;

#define GAS __attribute__((address_space(1)))
#define LAS __attribute__((address_space(3)))
typedef unsigned short bf16_t;
typedef unsigned u32x4 __attribute__((ext_vector_type(4)));
typedef unsigned u32x2 __attribute__((ext_vector_type(2)));
typedef float f32x4 __attribute__((ext_vector_type(4)));
typedef float f32x16 __attribute__((ext_vector_type(16)));
typedef short bf16x8 __attribute__((ext_vector_type(8)));
typedef __bf16 bf16x2 __attribute__((ext_vector_type(2)));
#define LDS_WAIT() asm volatile("s_waitcnt lgkmcnt(0)" ::: "memory")

__device__ __forceinline__ int opaque_i(int v) { asm volatile("" : "+v"(v)); return v; }
__device__ __forceinline__ unsigned f2bf(float f) { unsigned u = __builtin_bit_cast(unsigned, f); return (u + 0x7fffu + ((u >> 16) & 1u)) >> 16; }
typedef float f32x2_pk __attribute__((ext_vector_type(2)));
__device__ __forceinline__ unsigned pk2(float lo, float hi) { const f32x2_pk v = {lo, hi}; return __builtin_bit_cast(unsigned, __builtin_convertvector(v, bf16x2)); }
__device__ __forceinline__ float bf_lo(unsigned u) { return __uint_as_float(u << 16); }
__device__ __forceinline__ float bf_hi(unsigned u) { return __uint_as_float(u & 0xffff0000u); }
__device__ __forceinline__ float dot2(unsigned a, unsigned b, float acc) { return __builtin_amdgcn_fdot2_f32_bf16(__builtin_bit_cast(bf16x2, a), __builtin_bit_cast(bf16x2, b), acc, false); }
__device__ __forceinline__ float dot8(u32x4 a, u32x4 b, float acc) { acc = dot2(a.x, b.x, acc); acc = dot2(a.y, b.y, acc); acc = dot2(a.z, b.z, acc); return dot2(a.w, b.w, acc); }
__device__ __forceinline__ u32x4 pack8(f32x4 a, f32x4 b) { u32x4 w; w.x = pk2(a[0], a[1]); w.y = pk2(a[2], a[3]); w.z = pk2(b[0], b[1]); w.w = pk2(b[2], b[3]); return w; }

__device__ __forceinline__ float wave_sum(float v) {
#pragma unroll
    for (int o = 1; o < 64; o <<= 1) v += __shfl_xor(v, o);
    return v;
}
__device__ __forceinline__ float wave_max(float v) {
#pragma unroll
    for (int o = 1; o < 64; o <<= 1) v = fmaxf(v, __shfl_xor(v, o));
    return v;
}
__device__ __forceinline__ unsigned wave_umax(unsigned v) {
#pragma unroll
    for (int o = 1; o < 64; o <<= 1) { const unsigned w = (unsigned)__shfl_xor((int)v, o); v = v > w ? v : w; }
    return v;
}
__device__ __forceinline__ float dpp_row_shr(float v, int n) {
    const int iv = __builtin_bit_cast(int, v); int r;
    switch (n) { case 1: r = __builtin_amdgcn_update_dpp(0, iv, 0x111, 0xf, 0xf, true); break; case 2: r = __builtin_amdgcn_update_dpp(0, iv, 0x112, 0xf, 0xf, true); break;
                 case 4: r = __builtin_amdgcn_update_dpp(0, iv, 0x114, 0xf, 0xf, true); break; default: r = __builtin_amdgcn_update_dpp(0, iv, 0x118, 0xf, 0xf, true); break; }
    return __builtin_bit_cast(float, r);
}
__device__ __forceinline__ float wave_total(float v) {
    v += dpp_row_shr(v, 1); v += dpp_row_shr(v, 2); v += dpp_row_shr(v, 4); v += dpp_row_shr(v, 8);
    v += __builtin_bit_cast(float, __builtin_amdgcn_update_dpp(0, __builtin_bit_cast(int, v), 0x142, 0xa, 0xf, false));
    v += __builtin_bit_cast(float, __builtin_amdgcn_update_dpp(0, __builtin_bit_cast(int, v), 0x143, 0xc, 0xf, false));
    return __builtin_bit_cast(float, __builtin_amdgcn_readlane(__builtin_bit_cast(int, v), 63));
}
__device__ __forceinline__ unsigned f2ord(float f) { const unsigned u = __float_as_uint(f); return (u & 0x80000000u) ? ~u : (u | 0x80000000u); }
__device__ __forceinline__ float ord2f(unsigned o) { const unsigned u = (o & 0x80000000u) ? (o & 0x7fffffffu) : ~o; return __uint_as_float(u); }

__device__ __forceinline__ float row_scale(const float* p, int mode, int t) {
    if (mode == 0) return p[t];
    const f32x4* q = (const f32x4*)(p + (size_t)t * 16); const f32x4 a = q[0], b = q[1], c = q[2], d = q[3];
    const float s = (((a[0] + a[1]) + (a[2] + a[3])) + ((b[0] + b[1]) + (b[2] + b[3]))) + (((c[0] + c[1]) + (c[2] + c[3])) + ((d[0] + d[1]) + (d[2] + d[3])));
    return rsqrtf(s * (1.f / DM) + RMS_EPS);
}

struct EpiL0In {
    static constexpr bool PERM = true, AFTER_DRAIN = false;
    const float* rs; bf16_t* QH; bf16_t* KH; bf16_t* VT; float* LF; const float* b_f;
    __device__ __forceinline__ void operator()(const f32x4 (&acc)[2][2][4][2], const pg8::Unit& u, int wr, int wc, int fr, int fq) const {
        const int pn = u.pn;
        if (pn == 12) {
            if (wc == 0 && fq == 0) {
#pragma unroll
                for (int ai = 0; ai < 2; ++ai)
#pragma unroll
                    for (int m = 0; m < 4; ++m) {
                        const int t = u.pm * 256 + ai * 128 + wr * 64 + m * 16 + fr; const float sc = rs[t]; const int b = t >> 11, s = t & 2047;
#pragma unroll
                        for (int n = 0; n < 2; ++n)
#pragma unroll
                            for (int e = 0; e < 4; ++e) { const int h = n * 4 + e; const float x = acc[ai][0][m][n][e] * sc + b_f[h];
                                const float ls = fminf(x, 0.f) - log1pf(expf(-fabsf(x)));
                                LF[(size_t)(b * 8 + h) * 2048 + s] = ls * LOG2E; }
                    }
            }
            return;
        }
        const int sec = pn >> 1, kind = sec % 3, hbase = (sec >= 3) ? 8 : 0;
#pragma unroll
        for (int ai = 0; ai < 2; ++ai)
#pragma unroll
            for (int m = 0; m < 4; ++m) {
                const int t = u.pm * 256 + ai * 128 + wr * 64 + m * 16 + fr; const int b = t >> 11, s = t & 2047;
                const float sc = rs[t] * (kind == 0 ? C2 : 1.f);
#pragma unroll
                for (int bj = 0; bj < 2; ++bj) {
                    const int cc = (pn & 1) * 256 + bj * 128 + wc * 32 + fq * 8, hh = hbase + (cc >> 6), d0 = cc & 63;
                    const f32x4 v0 = acc[ai][bj][m][0] * sc, v1 = acc[ai][bj][m][1] * sc;
                    if (kind < 2) { bf16_t* dst = (kind == 0 ? QH : KH) + ((size_t)(b * 16 + hh) * 2048 + s) * 64 + d0; *(u32x4*)dst = pack8(v0, v1); }
                    else { bf16_t* dst = VT + ((size_t)(b * 16 + hh) * 64 + d0) * 2048 + s;
                        dst[0 * 2048] = (bf16_t)f2bf(v0[0]); dst[1 * 2048] = (bf16_t)f2bf(v0[1]); dst[2 * 2048] = (bf16_t)f2bf(v0[2]); dst[3 * 2048] = (bf16_t)f2bf(v0[3]);
                        dst[4 * 2048] = (bf16_t)f2bf(v1[0]); dst[5 * 2048] = (bf16_t)f2bf(v1[1]); dst[6 * 2048] = (bf16_t)f2bf(v1[2]); dst[7 * 2048] = (bf16_t)f2bf(v1[3]); }
                }
            }
    }
};
struct EpiL1In {
    static constexpr bool PERM = true, AFTER_DRAIN = false;
    const float* rsp; int rsmode; bf16_t* XC; bf16_t* QD; bf16_t* KD; bf16_t* VTD;
    __device__ __forceinline__ void operator()(const f32x4 (&acc)[2][2][4][2], const pg8::Unit& u, int wr, int wc, int fr, int fq) const {
        const int pn = u.pn, kind = pn >> 1;
#pragma unroll
        for (int ai = 0; ai < 2; ++ai)
#pragma unroll
            for (int m = 0; m < 4; ++m) {
                const int t = u.pm * 256 + ai * 128 + wr * 64 + m * 16 + fr; const int b = t >> 11, s = t & 2047;
                const float sc = row_scale(rsp, rsmode, t) * (kind == 1 ? C2 : 1.f);
#pragma unroll
                for (int bj = 0; bj < 2; ++bj) {
                    const int cc = (pn & 1) * 256 + bj * 128 + wc * 32 + fq * 8, hh = cc >> 6, d0 = cc & 63;
                    const f32x4 v0 = acc[ai][bj][m][0] * sc, v1 = acc[ai][bj][m][1] * sc;
                    if (kind == 0) { *(u32x4*)(XC + (size_t)t * 512 + cc) = pack8(v0, v1); }
                    else if (kind < 3) { bf16_t* dst = (kind == 1 ? QD : KD) + ((size_t)(b * 8 + hh) * 2048 + s) * 64 + d0; *(u32x4*)dst = pack8(v0, v1); }
                    else { bf16_t* dst = VTD + ((size_t)(b * 8 + hh) * 64 + d0) * 2048 + s;
                        dst[0 * 2048] = (bf16_t)f2bf(v0[0]); dst[1 * 2048] = (bf16_t)f2bf(v0[1]); dst[2 * 2048] = (bf16_t)f2bf(v0[2]); dst[3 * 2048] = (bf16_t)f2bf(v0[3]);
                        dst[4 * 2048] = (bf16_t)f2bf(v1[0]); dst[5 * 2048] = (bf16_t)f2bf(v1[1]); dst[6 * 2048] = (bf16_t)f2bf(v1[2]); dst[7 * 2048] = (bf16_t)f2bf(v1[3]); }
                }
            }
    }
};
struct EpiQ {
    static constexpr bool PERM = true, AFTER_DRAIN = false;
    const float* rsp; int rsmode; bf16_t* Q;
    __device__ __forceinline__ void operator()(const f32x4 (&acc)[2][2][4][2], const pg8::Unit& u, int wr, int wc, int fr, int fq) const {
#pragma unroll
        for (int ai = 0; ai < 2; ++ai)
#pragma unroll
            for (int m = 0; m < 4; ++m) {
                const int t = u.pm * 256 + ai * 128 + wr * 64 + m * 16 + fr; const float sc = row_scale(rsp, rsmode, t);
#pragma unroll
                for (int bj = 0; bj < 2; ++bj) { const int c = u.pn * 256 + bj * 128 + wc * 32 + fq * 8;
                    *(u32x4*)(Q + (size_t)t * 2048 + c) = pack8(acc[ai][bj][m][0] * sc, acc[ai][bj][m][1] * sc); }
            }
    }
};
template <bool BASE_BF16>
struct EpiRes {
    static constexpr bool PERM = true, AFTER_DRAIN = false;
    const void* base; bf16_t* xb; float* ssqp;
    __device__ __forceinline__ void operator()(const f32x4 (&acc)[2][2][4][2], const pg8::Unit& u, int wr, int wc, int fr, int fq) const {
#pragma unroll
        for (int ai = 0; ai < 2; ++ai)
#pragma unroll
            for (int m = 0; m < 4; ++m) {
                const int t = u.pm * 256 + ai * 128 + wr * 64 + m * 16 + fr; float ss = 0.f;
#pragma unroll
                for (int bj = 0; bj < 2; ++bj) { const size_t off = (size_t)t * DM + u.pn * 256 + bj * 128 + wc * 32 + fq * 8;
                    f32x4 b0, b1;
                    if (BASE_BF16) { const u32x4 w = *(const u32x4*)((const bf16_t*)base + off); b0 = (f32x4){bf_lo(w.x), bf_hi(w.x), bf_lo(w.y), bf_hi(w.y)}; b1 = (f32x4){bf_lo(w.z), bf_hi(w.z), bf_lo(w.w), bf_hi(w.w)}; }
                    else { b0 = *(const f32x4*)((const float*)base + off); b1 = *(const f32x4*)((const float*)base + off + 4); }
                    const f32x4 o0 = b0 + acc[ai][bj][m][0], o1 = b1 + acc[ai][bj][m][1];
                    *(u32x4*)(xb + off) = pack8(o0, o1);
                    ss += (o0[0] * o0[0] + o0[1] * o0[1]) + (o0[2] * o0[2] + o0[3] * o0[3]) + (o1[0] * o1[0] + o1[1] * o1[1]) + (o1[2] * o1[2] + o1[3] * o1[3]); }
                ss += __shfl_xor(ss, 16); ss += __shfl_xor(ss, 32);
                if (fq == 0) ssqp[(size_t)t * 16 + u.pn * 4 + wc] = ss;
            }
    }
};

#define XB_TMO      128
#define XB_XCNT(j)  (256  + 64 * (j))
#define XB_XSUB(j)  (1280 + 64 * (j))
#define XB_XGEN(j)  (2304 + 64 * (j))
#define XB_TOP      3328
#define XB_TOPGEN   3392
#define XCD_BAR_WORDS 3456
#define XB_SPIN_CAP (1u << 18)

__device__ __forceinline__ unsigned xb_ld(unsigned* p)              { return __hip_atomic_load(p, __ATOMIC_RELAXED, __HIP_MEMORY_SCOPE_AGENT); }
__device__ __forceinline__ unsigned xb_add(unsigned* p, unsigned v) { return __hip_atomic_fetch_add(p, v, __ATOMIC_RELAXED, __HIP_MEMORY_SCOPE_AGENT); }
__device__ __forceinline__ unsigned xb_xcc_id() { return (unsigned)__builtin_amdgcn_s_getreg((3 << 11) | 20) & 0xFu; }
#define XB_SPIN(cond, bar) do { unsigned _sp = 0; while (cond) { __builtin_amdgcn_s_sleep(1); \
    if ((++_sp & 255u) == 0u) { if (xb_ld(&(bar)[XB_TMO])) break; if (_sp > XB_SPIN_CAP) { atomicAdd(&(bar)[XB_TMO], 1u); break; } } } } while (0)

struct XcdBarrier {
    unsigned* bar; unsigned x;
    volatile LAS unsigned* st;
};

__device__ __forceinline__ XcdBarrier xcd_barrier_post(unsigned* bar, volatile LAS unsigned* st) {
    XcdBarrier b; b.bar = bar; b.x = xb_xcc_id(); b.st = st;
    if (threadIdx.x == 0) (void)xb_add(&bar[XB_XCNT(b.x)], 1u);
    return b;
}
__device__ __forceinline__ void xcd_barrier_complete(unsigned* bar, unsigned x, unsigned& nloc, unsigned& nx) {
    const unsigned G = gridDim.x * gridDim.y * gridDim.z;
    unsigned sum, cnt, mine, sp = 0u;
    for (;;) {
        sum = 0u; cnt = 0u; mine = 0u;
#pragma unroll
        for (unsigned j = 0; j < 16; ++j) { const unsigned c = xb_ld(&bar[XB_XCNT(j)]); sum += c; cnt += (c > 0u) ? 1u : 0u; mine = (j == x) ? c : mine; }
        if (sum == G) break;
        __builtin_amdgcn_s_sleep(1);
        if ((++sp & 255u) == 0u) { if (xb_ld(&bar[XB_TMO])) break; if (sp > XB_SPIN_CAP) { atomicAdd(&bar[XB_TMO], 1u); break; } }
    }
    nloc = mine > 0u ? mine : 1u; nx = cnt > 0u ? cnt : 1u;
}

__device__ __forceinline__ void xcd_barrier(const XcdBarrier& b) {
    asm volatile("s_waitcnt vmcnt(0)" ::: "memory");
    __syncthreads();
    if (threadIdx.x == 0) {
        unsigned* bar = b.bar;
        __builtin_amdgcn_s_waitcnt(0);
        unsigned nloc = b.st[0], nx = b.st[1];
        if (nloc == 0u) { xcd_barrier_complete(bar, b.x, nloc, nx); b.st[0] = nloc; b.st[1] = nx; }
        const unsigned old = xb_add(&bar[XB_XSUB(b.x)], 1u);
        const unsigned gen = old / nloc;
        if (old + 1u == (gen + 1u) * nloc) {
            __builtin_amdgcn_fence(__ATOMIC_RELEASE, "agent");
            asm volatile("s_waitcnt vmcnt(0)" ::: "memory");
            const unsigned og = xb_add(&bar[XB_TOP], 1u);
            const unsigned tg = og / nx;
            if (og + 1u == (tg + 1u) * nx) xb_add(&bar[XB_TOPGEN], 1u);
            else XB_SPIN(xb_ld(&bar[XB_TOPGEN]) == tg, bar);
            __builtin_amdgcn_fence(__ATOMIC_ACQUIRE, "agent");
            xb_add(&bar[XB_XGEN(b.x)], 1u);
            asm volatile("s_waitcnt vmcnt(0)" ::: "memory");
        } else {
            XB_SPIN(xb_ld(&bar[XB_XGEN(b.x)]) == gen, bar);
            __builtin_amdgcn_fence(__ATOMIC_ACQUIRE, "agent");
            asm volatile("s_waitcnt vmcnt(0)" ::: "memory");
        }
    }
    __syncthreads();
}

struct Frame {
    LAS unsigned char* lds;
    int tid, lane, wave, vcu, G;
};

__device__ __forceinline__ int remap0(int n) { return n < 1536 ? n : (n < 1544 ? 3072 + (n - 1536) : n - 8); }
__device__ __forceinline__ void p0_transpose_item(const float* W, int K, int N, bf16_t* WT, const float* g, bool remap, LAS float* scr, int item, int lane) {
    const int nblk = (N + 31) / 32, kb = item / nblk, nb = item % nblk, k0 = 64 * kb, n0 = 32 * nb;
#pragma unroll 8
    for (int i = 0; i < 32; ++i) { const int kk = 2 * i + (lane >> 5), n = n0 + (lane & 31);
        float v = (n < N) ? W[(size_t)(k0 + kk) * N + n] : 0.f; if (g) v *= g[k0 + kk]; scr[kk * 33 + (lane & 31)] = v; }
    LDS_WAIT(); asm volatile("" ::: "memory");
    const int c = lane & 7;
#pragma unroll
    for (int j = 0; j < 4; ++j) { const int nl = (lane >> 3) + 8 * j, n = n0 + nl; const LAS float* s = scr + (8 * c) * 33 + nl;
        u32x4 o; o.x = pk2(s[0 * 33], s[1 * 33]); o.y = pk2(s[2 * 33], s[3 * 33]); o.z = pk2(s[4 * 33], s[5 * 33]); o.w = pk2(s[6 * 33], s[7 * 33]);
        if (n < N) { const int nn = remap ? remap0(n) : n; *(u32x4*)(WT + (size_t)nn * K + k0 + 8 * c) = o; } }
    LDS_WAIT(); asm volatile("" ::: "memory");
}
__device__ __forceinline__ float cvt_row_1024(const float* src, bf16_t* dst, const float* g, int lane) {
    const f32x4 a0 = *(const f32x4*)(src + 8 * lane), a1 = *(const f32x4*)(src + 8 * lane + 4), c0 = *(const f32x4*)(src + 512 + 8 * lane), c1 = *(const f32x4*)(src + 516 + 8 * lane);
    float ss = (a0[0] * a0[0] + a0[1] * a0[1]) + (a0[2] * a0[2] + a0[3] * a0[3]) + (a1[0] * a1[0] + a1[1] * a1[1]) + (a1[2] * a1[2] + a1[3] * a1[3])
             + (c0[0] * c0[0] + c0[1] * c0[1]) + (c0[2] * c0[2] + c0[3] * c0[3]) + (c1[0] * c1[0] + c1[1] * c1[1]) + (c1[2] * c1[2] + c1[3] * c1[3]);
    f32x4 b0 = a0, b1 = a1, d0 = c0, d1 = c1;
    if (g) { b0 = b0 * *(const f32x4*)(g + 8 * lane); b1 = b1 * *(const f32x4*)(g + 8 * lane + 4); d0 = d0 * *(const f32x4*)(g + 512 + 8 * lane); d1 = d1 * *(const f32x4*)(g + 516 + 8 * lane); }
    *(u32x4*)(dst + 8 * lane) = pack8(b0, b1); *(u32x4*)(dst + 512 + 8 * lane) = pack8(d0, d1);
    return ss;
}

constexpr float I8_SU = 600.f, I8_SX = 127.f / 6.f;
constexpr float FP8_SU = 64.f, FP8_SV = 8.f;
__device__ __forceinline__ void cvt_row_fp8_sliced(const float* src, unsigned char* tab  , int e, const float* g, float scale, int lane) {
#pragma unroll
    for (int j = 0; j < 4; ++j) { f32x4 a = *(const f32x4*)(src + 256 * j + 4 * lane) * scale; if (g) a = a * *(const f32x4*)(g + 256 * j + 4 * lane);
        int w = 0; w = __builtin_amdgcn_cvt_pk_bf8_f32(a[0], a[1], w, false); w = __builtin_amdgcn_cvt_pk_bf8_f32(a[2], a[3], w, true);
        const int x = 2 * j + (lane >> 5);
        *(unsigned*)(tab + ((size_t)x * NEXP + e) * 128 + 4 * (lane & 31)) = (unsigned)w; }
}
__device__ __forceinline__ void cvt_row_i8_sliced(const float* src, unsigned char* tab  , int e, const float* g, float scale, int lane) {
#pragma unroll
    for (int j = 0; j < 4; ++j) { f32x4 a = *(const f32x4*)(src + 256 * j + 4 * lane) * scale; if (g) a = a * *(const f32x4*)(g + 256 * j + 4 * lane);
        unsigned w = 0u;
#pragma unroll
        for (int q = 0; q < 4; ++q) { int v = __float2int_rn(a[q]); v = v < -127 ? -127 : (v > 127 ? 127 : v); w |= ((unsigned)v & 0xffu) << (8 * q); }
        const int x = 2 * j + (lane >> 5);
        *(unsigned*)(tab + ((size_t)x * NEXP + e) * 128 + 4 * (lane & 31)) = w; }
}
struct Ptrs {
    const float *x, *norm_mix, *norm_ffn, *ev_w_in, *ev_b_f, *ev_w_out, *od_w_in, *od_pool_w, *od_pool_scale, *od_w_out, *peer_wq, *peer_k1, *peer_k2, *peer_u, *peer_v, *norm_f;
    float* out; unsigned char* ws;
};

__device__ __forceinline__ void phase_p0(Frame& F, const Ptrs& P) {
    LAS float* scr = (LAS float*)(F.lds + F.wave * 16384);
    const int gw = F.vcu * NWAVES + F.wave, NGW = F.G * NWAVES, lane = opaque_i(F.lane);
    unsigned char* ws = P.ws;
    bf16_t* W1T = (bf16_t*)(ws + WS_W1T); bf16_t* W2T = (bf16_t*)(ws + WS_W2T); bf16_t* W4T = (bf16_t*)(ws + WS_W4T); bf16_t* W5T = (bf16_t*)(ws + WS_W5T);
    bf16_t* W3T = (bf16_t*)(ws + WS_W3T); bf16_t* W6T = (bf16_t*)(ws + WS_W6T); bf16_t* PWT = (bf16_t*)(ws + WS_PWT);
    constexpr int I1 = 16 * 97, I2 = 16 * 32, I4 = 16 * 64, I5 = I2, I3 = I4, I6 = I4, IP = 4 * 2 * 4;
    constexpr int NTR = I1 + I2 + I4 + I5 + I3 + I6 + IP;
    for (int it = gw; it < NTR; it += NGW) {
        int r = it;
        if (r < I1) { p0_transpose_item(P.ev_w_in, DM, EVEN_IN, W1T, P.norm_mix, true, scr, r, lane); continue; } r -= I1;
        if (r < I2) { p0_transpose_item(P.ev_w_out, DM, DM, W2T, nullptr, false, scr, r, lane); continue; } r -= I2;
        if (r < I4) { p0_transpose_item(P.od_w_in, DM, 2048, W4T, P.norm_mix + DM, false, scr, r, lane); continue; } r -= I4;
        if (r < I5) { p0_transpose_item(P.od_w_out, DM, DM, W5T, nullptr, false, scr, r, lane); continue; } r -= I5;
        if (r < I3) { p0_transpose_item(P.peer_wq, DM, 2048, W3T, P.norm_ffn, false, scr, r, lane); continue; } r -= I3;
        if (r < I6) { p0_transpose_item(P.peer_wq + (size_t)DM * 2048, DM, 2048, W6T, P.norm_ffn + DM, false, scr, r, lane); continue; } r -= I6;
        { const int g = r >> 3; p0_transpose_item(P.od_pool_w + (size_t)g * 128 * 128, 128, 128, PWT + (size_t)g * 128 * 128, nullptr, false, scr, r & 7, lane); }
    }
    constexpr int R_Z = EVEN_PAD - EVEN_IN, R_X = TOK, R_U = 2 * NEXP, R_V = 2 * NEXP, R_K = 2 * 256;
    constexpr int NROW = R_Z + R_X + R_U + R_V + R_K;
    bf16_t* XB = (bf16_t*)(ws + WS_XB); float* RS0 = (float*)(ws + WS_RS0);
    bf16_t* K1B = (bf16_t*)(ws + WS_K1B); bf16_t* K2B = (bf16_t*)(ws + WS_K2B);
    for (int it = gw; it < NROW; it += NGW) {
        int r = it;
        if (r < R_Z) { bf16_t* d = W1T + (size_t)(EVEN_IN + r) * DM; const u32x4 z = {0u, 0u, 0u, 0u}; *(u32x4*)(d + 8 * lane) = z; *(u32x4*)(d + 512 + 8 * lane) = z; continue; } r -= R_Z;
        if (r < R_X) { const float ss = wave_sum(cvt_row_1024(P.x + (size_t)r * DM, XB + (size_t)r * DM, nullptr, lane)); if (lane == 0) RS0[r] = rsqrtf(ss * (1.f / DM) + RMS_EPS); continue; } r -= R_X;
        if (r < R_U) { const int ly = r >= NEXP; cvt_row_i8_sliced(P.peer_u + (size_t)r * DM, ws + WS_U8S + (size_t)ly * 8 * NEXP * 128, r - ly * NEXP, P.norm_ffn + (ly ? DM : 0), I8_SU, lane); continue; } r -= R_U;
        if (r < R_V) { const int ly = r >= NEXP; cvt_row_fp8_sliced(P.peer_v + (size_t)r * DM, ws + WS_V8S + (size_t)ly * 8 * NEXP * 128, r - ly * NEXP, nullptr, FP8_SV, lane); continue; } r -= R_V;
        if (r < 256) (void)cvt_row_1024(P.peer_k1 + (size_t)r * 1024, K1B + (size_t)r * 1024, nullptr, lane);
        else (void)cvt_row_1024(P.peer_k2 + (size_t)(r - 256) * 1024, K2B + (size_t)(r - 256) * 1024, nullptr, lane);
    }
}

__device__ __forceinline__ void phase_cfscan(Frame& F, const float* LF, float* CFo) {
    const int gw = F.vcu * NWAVES + F.wave, NGW = F.G * NWAVES, lane = opaque_i(F.lane);
    for (int bh = gw; bh < NB * 8; bh += NGW) {
        const float* src = LF + (size_t)bh * 2048 + 32 * lane; float v[32];
#pragma unroll
        for (int i = 0; i < 8; ++i) { const f32x4 w = *(const f32x4*)(src + 4 * i); v[4 * i] = w[0]; v[4 * i + 1] = w[1]; v[4 * i + 2] = w[2]; v[4 * i + 3] = w[3]; }
#pragma unroll
        for (int i = 1; i < 32; ++i) v[i] += v[i - 1];
        const float tot = v[31]; float inc = tot;
#pragma unroll
        for (int o = 1; o < 64; o <<= 1) { const float w = __shfl_up(inc, o); if (lane >= o) inc += w; }
        const float excl = inc - tot; float* dst = CFo + (size_t)bh * 2048 + 32 * lane;
#pragma unroll
        for (int i = 0; i < 8; ++i) { f32x4 w = {v[4 * i] + excl, v[4 * i + 1] + excl, v[4 * i + 2] + excl, v[4 * i + 3] + excl}; *(f32x4*)(dst + 4 * i) = w; }
    }
}
__device__ __forceinline__ void phase_kmean(Frame& F, const bf16_t* KD, float* KMEAN) {
    const int gw = F.vcu * NWAVES + F.wave, NGW = F.G * NWAVES, lane = opaque_i(F.lane), jg = lane >> 3, dq = lane & 7;
    for (int it = gw; it < NB * 8 * 8; it += NGW) {
        const int bh = it >> 3, blk = it & 7; const bf16_t* src = KD + ((size_t)bh * 2048 + blk * 256 + jg) * 64 + 8 * dq; float s[8] = {0.f, 0.f, 0.f, 0.f, 0.f, 0.f, 0.f, 0.f};
#pragma unroll 8
        for (int i = 0; i < 32; ++i) { const u32x4 w = *(const u32x4*)(src + (size_t)i * 8 * 64);
            s[0] += bf_lo(w.x); s[1] += bf_hi(w.x); s[2] += bf_lo(w.y); s[3] += bf_hi(w.y); s[4] += bf_lo(w.z); s[5] += bf_hi(w.z); s[6] += bf_lo(w.w); s[7] += bf_hi(w.w); }
#pragma unroll
        for (int k = 0; k < 8; ++k) { s[k] += __shfl_xor(s[k], 8); s[k] += __shfl_xor(s[k], 16); s[k] += __shfl_xor(s[k], 32); }
        if (jg == 0) { float* d = KMEAN + (size_t)it * 64 + 8 * dq; *(f32x4*)d = (f32x4){s[0], s[1], s[2], s[3]} * (1.f / 256.f); *(f32x4*)(d + 4) = (f32x4){s[4], s[5], s[6], s[7]} * (1.f / 256.f); }
    }
}
__device__ __forceinline__ int lgi(int s) { return s + (s >> 5); }
__device__ __forceinline__ float lsn2f(float z2) { return -(fmaxf(z2, 0.f) + __log2f(1.f + exp2f(-fabsf(z2)))); }
template <int KIND>
__device__ __forceinline__ void attn_naive(Frame& F, const bf16_t* QH, const bf16_t* KH, const bf16_t* VT, int NH, int hbase, const float* CF, const float* KMEAN, bf16_t* AO, int ao_col0) {
    LAS float* lg = (LAS float*)(F.lds + F.wave * 8704);
    const int gw = F.vcu * NWAVES + F.wave, NGW = F.G * NWAVES, lane = opaque_i(F.lane);
    for (int qi = gw; qi < NB * 8 * SEQ; qi += NGW) {
        const int bh = qi >> 11, b = bh >> 3, h = bh & 7, hh = hbase + h;
        const int t = (bh & 1) ? (2047 - (qi & 2047)) : (qi & 2047);
        const size_t hb = (size_t)(b * NH + hh);
        const bf16_t* qp = QH + (hb * 2048 + t) * 64; const bf16_t* kp = KH + hb * 2048 * 64;
        float q[64];
#pragma unroll
        for (int c = 0; c < 8; ++c) { const u32x4 w = *(const u32x4*)(qp + 8 * c);
            q[8 * c] = bf_lo(w.x); q[8 * c + 1] = bf_hi(w.x); q[8 * c + 2] = bf_lo(w.y); q[8 * c + 3] = bf_hi(w.y); q[8 * c + 4] = bf_lo(w.z); q[8 * c + 5] = bf_hi(w.z); q[8 * c + 6] = bf_lo(w.w); q[8 * c + 7] = bf_hi(w.w); }
        unsigned sel = 0u; const int qb = t >> 8;
        if (KIND == 2) {
            float gate[8];
#pragma unroll
            for (int n = 0; n < 8; ++n) { const float* km = KMEAN + ((size_t)(b * 8 + h) * 8 + n) * 64; float a = 0.f;
#pragma unroll
                for (int d = 0; d < 64; ++d) a += q[d] * km[d];
                gate[n] = a; }
            const int nsel = qb < 3 ? qb : 3;
#pragma unroll
            for (int r = 0; r < 3; ++r) if (r < nsel) { float best = -INFINITY; int bi = 0;
#pragma unroll
                for (int n = 0; n < 8; ++n) if (n < qb && !((sel >> n) & 1u) && gate[n] > best) { best = gate[n]; bi = n; }
                sel |= 1u << bi; }
        }
        const int nk = (KIND == 1) ? t : t + 1;
        const int tp = (nk + 7) & ~7;
        const float cft = (KIND == 0) ? CF[(size_t)(b * 8 + h) * 2048 + t] : 0.f;
        const float slope2 = (KIND == 2) ? exp2f(-(float)(h + 1)) * LOG2E : 0.f;
        float mloc = -INFINITY;
        for (int s = lane; s < nk; s += 64) {
            float dot = 0.f;
#pragma unroll
            for (int c = 0; c < 8; ++c) { const u32x4 w = *(const u32x4*)(kp + (size_t)s * 64 + 8 * c);
                dot += q[8 * c] * bf_lo(w.x) + q[8 * c + 1] * bf_hi(w.x) + q[8 * c + 2] * bf_lo(w.y) + q[8 * c + 3] * bf_hi(w.y) + q[8 * c + 4] * bf_lo(w.z) + q[8 * c + 5] * bf_hi(w.z) + q[8 * c + 6] * bf_lo(w.w) + q[8 * c + 7] * bf_hi(w.w); }
            float v = dot;
            if (KIND == 0) v += cft - CF[(size_t)(b * 8 + h) * 2048 + s];
            if (KIND == 2) { const int n = s >> 8; const bool valid = (n == qb) || ((sel >> n) & 1u); v = valid ? v + slope2 * (float)(s - t) : -INFINITY; }
            lg[lgi(s)] = v; mloc = fmaxf(mloc, v);
        }
        float linv = 1.f;
        if (KIND != 1) {
            const float m = wave_max(mloc); float lsum = 0.f;
            for (int s = lane; s < tp; s += 64) { const float p = (s < nk) ? exp2f(lg[lgi(s)] - m) : 0.f; lg[lgi(s)] = p; lsum += p; }
            linv = 1.f / wave_sum(lsum);
        } else {
            float tot = 0.f;
            for (int i = 0; i < 32; ++i) { const int s = 32 * lane + i; if (s < nk) tot += lsn2f(lg[lgi(s)]); }
            float inc = tot;
#pragma unroll
            for (int o = 1; o < 64; o <<= 1) { const float w = __shfl_down(inc, o); if (lane + o < 64) inc += w; }
            float run = inc - tot;
            for (int i = 31; i >= 0; --i) { const int s = 32 * lane + i; float a = 0.f;
                if (s < nk) { const float z = lg[lgi(s)], l2 = lsn2f(z); a = exp2f(z + l2 + run); run += l2; }
                if (s < tp) lg[lgi(s)] = a; }
        }
        LDS_WAIT();
        const bf16_t* vp = VT + (hb * 64 + lane) * 2048; float o = 0.f;
        for (int s0 = 0; s0 < tp; s0 += 8) { const u32x4 w = *(const u32x4*)(vp + s0); const int i0 = lgi(s0);
            o += lg[i0] * bf_lo(w.x) + lg[i0 + 1] * bf_hi(w.x) + lg[i0 + 2] * bf_lo(w.y) + lg[i0 + 3] * bf_hi(w.y) + lg[i0 + 4] * bf_lo(w.z) + lg[i0 + 5] * bf_hi(w.z) + lg[i0 + 6] * bf_lo(w.w) + lg[i0 + 7] * bf_hi(w.w); }
        AO[(size_t)(b * 2048 + t) * DM + ao_col0 + h * 64 + lane] = (bf16_t)f2bf(o * linv);
        LDS_WAIT();
    }
}

__device__ __forceinline__ float lsn2q(float z2) { return -(fmaxf(z2, 0.f) + __builtin_amdgcn_logf(1.f + __builtin_amdgcn_exp2f(-fabsf(z2)))); }
__device__ __forceinline__ int pi32(int i) { return (i & ~12) | ((i & 4) << 1) | ((i & 8) >> 1); }
__device__ __forceinline__ void attn_load_k(bf16x8 (&kf)[4], const bf16_t* Kh, int kv0, int r32p, int hi) {
    const bf16_t* p = Kh + (size_t)(kv0 + r32p) * 64 + 8 * hi;
#pragma unroll
    for (int d0 = 0; d0 < 4; ++d0) kf[d0] = *(const bf16x8*)(p + 16 * d0);
}
__device__ __forceinline__ void attn_load_v(bf16x8 (&vf)[2][2], const bf16_t* Vth, int kv0, int r32, int hi) {
#pragma unroll
    for (int s = 0; s < 2; ++s)
#pragma unroll
        for (int dh = 0; dh < 2; ++dh) vf[s][dh] = *(const bf16x8*)(Vth + (size_t)(32 * dh + r32) * 2048 + kv0 + 16 * s + 8 * hi);
}
template <int KIND, int MODE>
__device__ __forceinline__ void attn_tile(const bf16x8 (&qr)[4], const bf16x8 (&kf)[4], const bf16x8 (&vf)[2][2], f32x16& O0, f32x16& O1, float& m, float& l, float& R,
                                          const f32x16& bias, const int kv0, const int q, const int hi, const bool rowok) {
    f32x16 S = bias;
#pragma unroll
    for (int d0 = 0; d0 < 4; ++d0) S = __builtin_amdgcn_mfma_f32_32x32x16_bf16(kf[d0], qr[d0], S, 0, 0, 0);
    if (MODE == 1) {
#pragma unroll
        for (int r = 0; r < 16; ++r) { const int key = kv0 + (r & 7) + 8 * hi + 16 * (r >> 3); const bool bad = (KIND == 1) ? (key >= q) : (key > q); if (bad) S[r] = -INFINITY; }
    }
    if (MODE == 2) { if (!rowok) {
#pragma unroll
        for (int r = 0; r < 16; ++r) S[r] = -INFINITY; } }
    float p[16];
    if (KIND != 1) {
        float rm = fmaxf(fmaxf(S[0], S[1]), fmaxf(S[2], S[3]));
#pragma unroll
        for (int r = 4; r < 16; r += 4) rm = fmaxf(rm, fmaxf(fmaxf(S[r], S[r + 1]), fmaxf(S[r + 2], S[r + 3])));
        rm = fmaxf(rm, __shfl_xor(rm, 32));
        const float mn = fmaxf(fmaxf(m, rm), -1e30f); const float alpha = __builtin_amdgcn_exp2f(m - mn);
        float ps = 0.f;
#pragma unroll
        for (int r = 0; r < 16; ++r) { p[r] = __builtin_amdgcn_exp2f(S[r] - mn); ps += p[r]; }
        l = l * alpha + ps; m = mn;
        O0 *= alpha; O1 *= alpha;
    } else {
        float l2[16]; float sLo = 0.f, sHi = 0.f;
#pragma unroll
        for (int r = 0; r < 16; ++r) l2[r] = lsn2q(S[r]);
#pragma unroll
        for (int r = 0; r < 8; ++r) { sLo += l2[r]; sHi += l2[8 + r]; }
        const float pLo = __shfl_xor(sLo, 32), pHi = __shfl_xor(sHi, 32);
        float run = hi ? R : R + pHi;
#pragma unroll
        for (int r = 15; r >= 8; --r) { p[r] = __builtin_amdgcn_exp2f(S[r] + l2[r] + run); run += l2[r]; }
        run = hi ? (R + sHi + pHi) : (R + pHi + sHi + pLo);
#pragma unroll
        for (int r = 7; r >= 0; --r) { p[r] = __builtin_amdgcn_exp2f(S[r] + l2[r] + run); run += l2[r]; }
        R += (sLo + sHi) + (pLo + pHi);
    }
    u32x4 w0, w1;
    w0.x = pk2(p[0], p[1]); w0.y = pk2(p[2], p[3]); w0.z = pk2(p[4], p[5]); w0.w = pk2(p[6], p[7]);
    w1.x = pk2(p[8], p[9]); w1.y = pk2(p[10], p[11]); w1.z = pk2(p[12], p[13]); w1.w = pk2(p[14], p[15]);
    const bf16x8 pf0 = __builtin_bit_cast(bf16x8, w0), pf1 = __builtin_bit_cast(bf16x8, w1);
    O0 = __builtin_amdgcn_mfma_f32_32x32x16_bf16(vf[0][0], pf0, O0, 0, 0, 0); O0 = __builtin_amdgcn_mfma_f32_32x32x16_bf16(vf[1][0], pf1, O0, 0, 0, 0);
    O1 = __builtin_amdgcn_mfma_f32_32x32x16_bf16(vf[0][1], pf0, O1, 0, 0, 0); O1 = __builtin_amdgcn_mfma_f32_32x32x16_bf16(vf[1][1], pf1, O1, 0, 0, 0);
}
template <int KIND>
__device__ __forceinline__ f32x16 attn_bias(const float* CFh, float slope2, int kv0, int q0, int hi) {
    f32x16 b = f32x16{};
    if (KIND == 0) { const float* c = CFh + kv0 + 8 * hi; const f32x4 a0 = *(const f32x4*)c, a1 = *(const f32x4*)(c + 4), a2 = *(const f32x4*)(c + 16), a3 = *(const f32x4*)(c + 20);
        b[0] = -a0[0]; b[1] = -a0[1]; b[2] = -a0[2]; b[3] = -a0[3]; b[4] = -a1[0]; b[5] = -a1[1]; b[6] = -a1[2]; b[7] = -a1[3];
        b[8] = -a2[0]; b[9] = -a2[1]; b[10] = -a2[2]; b[11] = -a2[3]; b[12] = -a3[0]; b[13] = -a3[1]; b[14] = -a3[2]; b[15] = -a3[3]; }
    if (KIND == 2) {
#pragma unroll
        for (int r = 0; r < 16; ++r) b[r] = slope2 * (float)(kv0 + (r & 7) + 8 * hi + 16 * (r >> 3) - q0); }
    return b;
}
template <int KIND>
__device__ __forceinline__ void attn_wave(const bf16_t* Qh, const bf16_t* Kh, const bf16_t* Vth, const int q0, const int lane, const float* CFh, const float slope2, const float* KMh, bf16_t* AOp) {
    const int r32 = lane & 31, hi = lane >> 5, r32p = pi32(r32), q = q0 + r32;
    bf16x8 qr[4];
#pragma unroll
    for (int d0 = 0; d0 < 4; ++d0) qr[d0] = *(const bf16x8*)(Qh + (size_t)q * 64 + 16 * d0 + 8 * hi);
    f32x16 O0 = f32x16{}, O1 = f32x16{};
    float m = -INFINITY, l = 0.f, R = 0.f;
    bf16x8 kf[4], kfn[4], vf[2][2];
    const int nt = q0 / 32 + 1;
    if (KIND == 0) {
        attn_load_k(kf, Kh, 0, r32p, hi);
        for (int it = 0; it < nt; ++it) { const int kv0 = 32 * it;
            attn_load_v(vf, Vth, kv0, r32, hi); const f32x16 bias = attn_bias<0>(CFh, 0.f, kv0, q0, hi);
            if (it + 1 < nt) attn_load_k(kfn, Kh, kv0 + 32, r32p, hi);
            if (it == nt - 1) attn_tile<0, 1>(qr, kf, vf, O0, O1, m, l, R, bias, kv0, q, hi, true); else attn_tile<0, 0>(qr, kf, vf, O0, O1, m, l, R, bias, kv0, q, hi, true);
#pragma unroll
            for (int d0 = 0; d0 < 4; ++d0) kf[d0] = kfn[d0]; }
    } else if (KIND == 1) {
        attn_load_k(kf, Kh, 32 * (nt - 1), r32p, hi);
        for (int it = nt - 1; it >= 0; --it) { const int kv0 = 32 * it;
            attn_load_v(vf, Vth, kv0, r32, hi); const f32x16 bias = f32x16{};
            if (it > 0) attn_load_k(kfn, Kh, kv0 - 32, r32p, hi);
            if (it == nt - 1) attn_tile<1, 1>(qr, kf, vf, O0, O1, m, l, R, bias, kv0, q, hi, true); else attn_tile<1, 0>(qr, kf, vf, O0, O1, m, l, R, bias, kv0, q, hi, true);
#pragma unroll
            for (int d0 = 0; d0 < 4; ++d0) kf[d0] = kfn[d0];
            if (__all(R < -200.f)) break; }
    } else {
        const int qb = q0 >> 8;
        f32x16 G = f32x16{};
#pragma unroll
        for (int d0 = 0; d0 < 4; ++d0) { u32x4 kw = {0u, 0u, 0u, 0u};
            if (r32 < 8) { const float* kmp = KMh + r32 * 64 + 16 * d0 + 8 * hi; kw = pack8(*(const f32x4*)kmp, *(const f32x4*)(kmp + 4)); }
            G = __builtin_amdgcn_mfma_f32_32x32x16_bf16(__builtin_bit_cast(bf16x8, kw), qr[d0], G, 0, 0, 0); }
        float gate[8];
#pragma unroll
        for (int n = 0; n < 4; ++n) { const float own = G[n], oth = __shfl_xor(own, 32); gate[n] = hi ? oth : own; gate[n + 4] = hi ? own : oth; }
        unsigned sel = 0u; const int nsel = qb < 3 ? qb : 3;
#pragma unroll
        for (int r = 0; r < 3; ++r) if (r < nsel) { float best = -INFINITY; int bi = 0;
#pragma unroll
            for (int n = 0; n < 8; ++n) if (n < qb && !((sel >> n) & 1u) && gate[n] > best) { best = gate[n]; bi = n; }
            sel |= 1u << bi; }
        for (int kv0 = 256 * qb; kv0 <= q0; kv0 += 32) {
            attn_load_k(kf, Kh, kv0, r32p, hi); attn_load_v(vf, Vth, kv0, r32, hi); const f32x16 bias = attn_bias<2>(nullptr, slope2, kv0, q0, hi);
            if (kv0 == q0) attn_tile<2, 1>(qr, kf, vf, O0, O1, m, l, R, bias, kv0, q, hi, true); else attn_tile<2, 0>(qr, kf, vf, O0, O1, m, l, R, bias, kv0, q, hi, true); }
        for (int j = 0; j < qb; ++j) { const bool rowok = (sel >> j) & 1u;
            if (!__any(rowok)) continue;
            attn_load_k(kf, Kh, 256 * j, r32p, hi);
            for (int i = 0; i < 8; ++i) { const int kv0 = 256 * j + 32 * i;
                attn_load_v(vf, Vth, kv0, r32, hi); const f32x16 bias = attn_bias<2>(nullptr, slope2, kv0, q0, hi);
                if (i < 7) attn_load_k(kfn, Kh, kv0 + 32, r32p, hi);
                attn_tile<2, 2>(qr, kf, vf, O0, O1, m, l, R, bias, kv0, q, hi, rowok);
#pragma unroll
                for (int d0 = 0; d0 < 4; ++d0) kf[d0] = kfn[d0]; } }
    }
    float linv = 1.f;
    if (KIND != 1) linv = 1.f / (l + __shfl_xor(l, 32));
    bf16_t* orow = AOp + (size_t)q * DM;
#pragma unroll
    for (int g = 0; g < 4; ++g) { u32x2 w;
        w.x = pk2(O0[4 * g] * linv, O0[4 * g + 1] * linv); w.y = pk2(O0[4 * g + 2] * linv, O0[4 * g + 3] * linv); *(u32x2*)(orow + 8 * g + 4 * hi) = w;
        w.x = pk2(O1[4 * g] * linv, O1[4 * g + 1] * linv); w.y = pk2(O1[4 * g + 2] * linv, O1[4 * g + 3] * linv); *(u32x2*)(orow + 32 + 8 * g + 4 * hi) = w; }
}
template <int KIND>
__device__ __forceinline__ void phase_attn(Frame& F, const bf16_t* QH, const bf16_t* KH, const bf16_t* VT, int NH, int hbase, const float* CF, const float* KMEAN, bf16_t* AO, int ao_col0) {
    for (int ug = F.vcu; ug < NB * 8 * 2; ug += F.G) {
        const int bh = ug >> 1, b = bh >> 3, h = bh & 7, hh = hbase + h; const size_t hb = (size_t)(b * NH + hh);
        const float slope2 = __builtin_amdgcn_exp2f(-(float)(h + 1)) * LOG2E;
#pragma unroll 1
        for (int i = 0; i < 4; ++i) { const int base = (i >> 1) * 2 + (ug & 1), qb = (i & 1) ? 7 - base : base, w = (i & 1) ? 7 - F.wave : F.wave;
            attn_wave<KIND>(QH + hb * 2048 * 64, KH + hb * 2048 * 64, VT + hb * 64 * 2048, 256 * qb + 32 * w, opaque_i(F.lane),
                            CF ? CF + (size_t)bh * 2048 : nullptr, slope2, KMEAN ? KMEAN + (size_t)bh * 8 * 64 : nullptr, AO + (size_t)b * 2048 * DM + ao_col0 + h * 64); }
    }
}


constexpr int AT_SLOT = 16384, AT_CF = 3 * AT_SLOT;
__device__ __forceinline__ void attn_dma_tile(const bf16_t* Kh, const bf16_t* Vth, int T, LAS unsigned char* slot, int wave, int r32, int r32p, int hi) {
    const int j = wave >> 2, d0 = wave & 3, s2 = (wave >> 1) & 1, dh = wave & 1;
    const bf16_t* ks = Kh + (size_t)(64 * T + 32 * j + r32p) * 64 + 16 * d0 + 8 * hi;
    const bf16_t* vs = Vth + (size_t)(32 * dh + r32) * 2048 + 64 * T + 32 * j + 16 * s2 + 8 * hi;
    __builtin_amdgcn_global_load_lds((const unsigned*)ks, (LAS unsigned*)(slot + (j * 4 + d0) * 1024), 16, 0, 0);
    __builtin_amdgcn_global_load_lds((const unsigned*)vs, (LAS unsigned*)(slot + 8192 + ((j * 2 + s2) * 2 + dh) * 1024), 16, 0, 0);
}
template <int MODE>
__device__ __forceinline__ void attn_fox_sub(const bf16x8 (&qr)[4], f32x16& O0, f32x16& O1, float& m, float& l, unsigned saddr  , unsigned cfaddr  , int j, int kv0, int q, int hi) {
    bf16x8 kf[4], vf[2][2]; f32x4 c0, c1, c2, c3;
    asm volatile("ds_read_b128 %0, %12\n\tds_read_b128 %1, %12 offset:1024\n\tds_read_b128 %2, %12 offset:2048\n\tds_read_b128 %3, %12 offset:3072\n\t"
                 "ds_read_b128 %4, %13\n\tds_read_b128 %5, %13 offset:1024\n\tds_read_b128 %6, %13 offset:2048\n\tds_read_b128 %7, %13 offset:3072\n\t"
                 "ds_read_b128 %8, %14\n\tds_read_b128 %9, %14 offset:16\n\tds_read_b128 %10, %14 offset:64\n\tds_read_b128 %11, %14 offset:80\n\ts_waitcnt lgkmcnt(0)"
                 : "=&v"(kf[0]), "=&v"(kf[1]), "=&v"(kf[2]), "=&v"(kf[3]), "=&v"(vf[0][0]), "=&v"(vf[0][1]), "=&v"(vf[1][0]), "=&v"(vf[1][1]), "=&v"(c0), "=&v"(c1), "=&v"(c2), "=&v"(c3)
                 : "v"(saddr + (unsigned)j * 4096u), "v"(saddr + 8192u + (unsigned)j * 4096u), "v"(cfaddr) : "memory");
    f32x16 S;
    S[0] = c0[0]; S[1] = c0[1]; S[2] = c0[2]; S[3] = c0[3]; S[4] = c1[0]; S[5] = c1[1]; S[6] = c1[2]; S[7] = c1[3];
    S[8] = c2[0]; S[9] = c2[1]; S[10] = c2[2]; S[11] = c2[3]; S[12] = c3[0]; S[13] = c3[1]; S[14] = c3[2]; S[15] = c3[3];
#pragma unroll
    for (int d0 = 0; d0 < 4; ++d0) S = __builtin_amdgcn_mfma_f32_32x32x16_bf16(kf[d0], qr[d0], S, 0, 0, 0);
    if (MODE == 1) {
#pragma unroll
        for (int r = 0; r < 16; ++r) { const int key = kv0 + (r & 7) + 8 * hi + 16 * (r >> 3); if (key > q) S[r] = -INFINITY; }
    }
    float rm = fmaxf(fmaxf(S[0], S[1]), fmaxf(S[2], S[3]));
#pragma unroll
    for (int r = 4; r < 16; r += 4) rm = fmaxf(rm, fmaxf(fmaxf(S[r], S[r + 1]), fmaxf(S[r + 2], S[r + 3])));
    { const auto rr = __builtin_amdgcn_permlane32_swap(__float_as_uint(rm), __float_as_uint(rm), false, false); rm = fmaxf(__uint_as_float(rr[0]), __uint_as_float(rr[1])); }
    if (__any(rm > m)) {
        const float mn = fmaxf(fmaxf(m, rm), -1e30f); const float alpha = __builtin_amdgcn_exp2f(m - mn);
        l *= alpha; O0 *= alpha; O1 *= alpha; m = mn; }
    float p[16]; float ps = 0.f;
#pragma unroll
    for (int r = 0; r < 16; ++r) { p[r] = __builtin_amdgcn_exp2f(S[r] - m); ps += p[r]; }
    l += ps;
    u32x4 w0, w1;
    w0.x = pk2(p[0], p[1]); w0.y = pk2(p[2], p[3]); w0.z = pk2(p[4], p[5]); w0.w = pk2(p[6], p[7]);
    w1.x = pk2(p[8], p[9]); w1.y = pk2(p[10], p[11]); w1.z = pk2(p[12], p[13]); w1.w = pk2(p[14], p[15]);
    const bf16x8 pf0 = __builtin_bit_cast(bf16x8, w0), pf1 = __builtin_bit_cast(bf16x8, w1);
    O0 = __builtin_amdgcn_mfma_f32_32x32x16_bf16(vf[0][0], pf0, O0, 0, 0, 0); O0 = __builtin_amdgcn_mfma_f32_32x32x16_bf16(vf[1][0], pf1, O0, 0, 0, 0);
    O1 = __builtin_amdgcn_mfma_f32_32x32x16_bf16(vf[0][1], pf0, O1, 0, 0, 0); O1 = __builtin_amdgcn_mfma_f32_32x32x16_bf16(vf[1][1], pf1, O1, 0, 0, 0);
}
__device__ __forceinline__ void attn_fox_unit(Frame& F, const bf16_t* Qh, const bf16_t* Kh, const bf16_t* Vth, const float* CFh, const int qb, bf16_t* AOp) {
    const int lane = opaque_i(F.lane), r32 = lane & 31, hi = lane >> 5, r32p = pi32(r32), wave = F.wave, q0 = 256 * qb + 32 * wave, q = q0 + r32;
    LAS unsigned char* ring = F.lds; const unsigned ring_a = (unsigned)(uintptr_t)ring + 16u * (unsigned)lane, cf_a = (unsigned)(uintptr_t)ring + (unsigned)AT_CF + 32u * (unsigned)hi;
    bf16x8 qr[4];
#pragma unroll
    for (int d0 = 0; d0 < 4; ++d0) qr[d0] = *(const bf16x8*)(Qh + (size_t)q * 64 + 16 * d0 + 8 * hi);
    { const f32x4 cv = *(const f32x4*)(CFh + 4 * F.tid); *(LAS f32x4*)(ring + AT_CF + 16 * F.tid) = -cv; }
    asm volatile("s_waitcnt vmcnt(0) lgkmcnt(0)" ::: "memory"); __builtin_amdgcn_s_barrier();
    const int NT = 4 * qb + 4, my_last = 4 * qb + (wave >> 1), jdiag = wave & 1;
    attn_dma_tile(Kh, Vth, NT - 1, ring, wave, r32, r32p, hi);
    attn_dma_tile(Kh, Vth, NT - 2, ring + AT_SLOT, wave, r32, r32p, hi);
    f32x16 O0 = f32x16{}, O1 = f32x16{}; float m = -INFINITY, l = 0.f;
    int slot = 0;
#pragma unroll 1
    for (int T = NT - 1; T >= 0; --T) {
        if (T > 0) asm volatile("s_waitcnt vmcnt(2)" ::: "memory"); else asm volatile("s_waitcnt vmcnt(0)" ::: "memory");
        __builtin_amdgcn_s_barrier();
        if (T >= 2) { const int fs = (slot == 0) ? 2 : slot - 1; attn_dma_tile(Kh, Vth, T - 2, ring + fs * AT_SLOT, wave, r32, r32p, hi); }
        if (T <= my_last) {
            const unsigned sa = ring_a + (unsigned)(slot * AT_SLOT);
            if (T == my_last) {
                if (jdiag == 1) { attn_fox_sub<1>(qr, O0, O1, m, l, sa, cf_a + 4u * (unsigned)(64 * T + 32), 1, 64 * T + 32, q, hi); attn_fox_sub<0>(qr, O0, O1, m, l, sa, cf_a + 4u * (unsigned)(64 * T), 0, 64 * T, q, hi); }
                else attn_fox_sub<1>(qr, O0, O1, m, l, sa, cf_a + 4u * (unsigned)(64 * T), 0, 64 * T, q, hi);
            } else { attn_fox_sub<0>(qr, O0, O1, m, l, sa, cf_a + 4u * (unsigned)(64 * T + 32), 1, 64 * T + 32, q, hi); attn_fox_sub<0>(qr, O0, O1, m, l, sa, cf_a + 4u * (unsigned)(64 * T), 0, 64 * T, q, hi); }
        }
        slot = (slot == 2) ? 0 : slot + 1;
    }
    const float linv = 1.f / (l + __shfl_xor(l, 32));
    bf16_t* orow = AOp + (size_t)q * DM;
#pragma unroll
    for (int g = 0; g < 4; ++g) { u32x2 w;
        w.x = pk2(O0[4 * g] * linv, O0[4 * g + 1] * linv); w.y = pk2(O0[4 * g + 2] * linv, O0[4 * g + 3] * linv); *(u32x2*)(orow + 8 * g + 4 * hi) = w;
        w.x = pk2(O1[4 * g] * linv, O1[4 * g + 1] * linv); w.y = pk2(O1[4 * g + 2] * linv, O1[4 * g + 3] * linv); *(u32x2*)(orow + 32 + 8 * g + 4 * hi) = w; }
    asm volatile("s_waitcnt vmcnt(0) lgkmcnt(0)" ::: "memory"); __builtin_amdgcn_s_barrier();
}
__device__ __forceinline__ void phase_attn_fox(Frame& F, const bf16_t* QH, const bf16_t* KH, const bf16_t* VT, const float* CF, bf16_t* AO) {
    for (int ug = F.vcu; ug < NB * 8 * 2; ug += F.G) {
        const int bh = ug >> 1, b = bh >> 3, h = bh & 7; const size_t hb = (size_t)(b * 16 + h);
#pragma unroll 1
        for (int i = 0; i < 4; ++i) { const int base = (i >> 1) * 2 + (ug & 1), qb = (i & 1) ? 7 - base : base;
            attn_fox_unit(F, QH + hb * 2048 * 64, KH + hb * 2048 * 64, VT + hb * 64 * 2048, CF + (size_t)bh * 2048, qb, AO + (size_t)b * 2048 * DM + h * 64); }
    }
}

template <int MODE>
__device__ __forceinline__ void attn_moba_sub(const bf16x8 (&qr)[4], f32x16& O0, f32x16& O1, float& m, float& l, unsigned saddr, int j, int kv0, int q, int q0, int hi, float slope2, bool rowok) {
    bf16x8 kf[4], vf[2][2];
    asm volatile("ds_read_b128 %0, %8\n\tds_read_b128 %1, %8 offset:1024\n\tds_read_b128 %2, %8 offset:2048\n\tds_read_b128 %3, %8 offset:3072\n\t"
                 "ds_read_b128 %4, %9\n\tds_read_b128 %5, %9 offset:1024\n\tds_read_b128 %6, %9 offset:2048\n\tds_read_b128 %7, %9 offset:3072\n\ts_waitcnt lgkmcnt(0)"
                 : "=&v"(kf[0]), "=&v"(kf[1]), "=&v"(kf[2]), "=&v"(kf[3]), "=&v"(vf[0][0]), "=&v"(vf[0][1]), "=&v"(vf[1][0]), "=&v"(vf[1][1])
                 : "v"(saddr + (unsigned)j * 4096u), "v"(saddr + 8192u + (unsigned)j * 4096u) : "memory");
    f32x16 S; const float sbase = slope2 * (float)(kv0 + 8 * hi - q0);
#pragma unroll
    for (int r = 0; r < 16; ++r) S[r] = sbase + slope2 * (float)((r & 7) + 16 * (r >> 3));
#pragma unroll
    for (int d0 = 0; d0 < 4; ++d0) S = __builtin_amdgcn_mfma_f32_32x32x16_bf16(kf[d0], qr[d0], S, 0, 0, 0);
    if (MODE == 1) {
#pragma unroll
        for (int r = 0; r < 16; ++r) { const int key = kv0 + (r & 7) + 8 * hi + 16 * (r >> 3); if (key > q) S[r] = -INFINITY; }
    }
    if (MODE == 2) { if (!rowok) {
#pragma unroll
        for (int r = 0; r < 16; ++r) S[r] = -INFINITY; } }
    float rm = fmaxf(fmaxf(S[0], S[1]), fmaxf(S[2], S[3]));
#pragma unroll
    for (int r = 4; r < 16; r += 4) rm = fmaxf(rm, fmaxf(fmaxf(S[r], S[r + 1]), fmaxf(S[r + 2], S[r + 3])));
    { const auto rr = __builtin_amdgcn_permlane32_swap(__float_as_uint(rm), __float_as_uint(rm), false, false); rm = fmaxf(__uint_as_float(rr[0]), __uint_as_float(rr[1])); }
    if (__any(rm > m)) { const float mn = fmaxf(fmaxf(m, rm), -1e30f); const float alpha = __builtin_amdgcn_exp2f(m - mn); l *= alpha; O0 *= alpha; O1 *= alpha; m = mn; }
    float p[16]; float ps = 0.f;
#pragma unroll
    for (int r = 0; r < 16; ++r) { p[r] = __builtin_amdgcn_exp2f(S[r] - m); ps += p[r]; }
    l += ps;
    u32x4 w0, w1;
    w0.x = pk2(p[0], p[1]); w0.y = pk2(p[2], p[3]); w0.z = pk2(p[4], p[5]); w0.w = pk2(p[6], p[7]);
    w1.x = pk2(p[8], p[9]); w1.y = pk2(p[10], p[11]); w1.z = pk2(p[12], p[13]); w1.w = pk2(p[14], p[15]);
    const bf16x8 pf0 = __builtin_bit_cast(bf16x8, w0), pf1 = __builtin_bit_cast(bf16x8, w1);
    O0 = __builtin_amdgcn_mfma_f32_32x32x16_bf16(vf[0][0], pf0, O0, 0, 0, 0); O0 = __builtin_amdgcn_mfma_f32_32x32x16_bf16(vf[1][0], pf1, O0, 0, 0, 0);
    O1 = __builtin_amdgcn_mfma_f32_32x32x16_bf16(vf[0][1], pf0, O1, 0, 0, 0); O1 = __builtin_amdgcn_mfma_f32_32x32x16_bf16(vf[1][1], pf1, O1, 0, 0, 0);
}
__device__ __forceinline__ void attn_moba_unit(Frame& F, const bf16_t* Qh, const bf16_t* Kh, const bf16_t* Vth, const float* KMh, const float slope2, const int qb, bf16_t* AOp) {
    const int lane = opaque_i(F.lane), r32 = lane & 31, hi = lane >> 5, r32p = pi32(r32), wave = F.wave, q0 = 256 * qb + 32 * wave, q = q0 + r32;
    LAS unsigned char* ring = F.lds; const unsigned ring_a = (unsigned)(uintptr_t)ring + 16u * (unsigned)lane;
    bf16x8 qr[4];
#pragma unroll
    for (int d0 = 0; d0 < 4; ++d0) qr[d0] = *(const bf16x8*)(Qh + (size_t)q * 64 + 16 * d0 + 8 * hi);
    f32x16 G = f32x16{};
#pragma unroll
    for (int d0 = 0; d0 < 4; ++d0) { u32x4 kw = {0u, 0u, 0u, 0u};
        if (r32 < 8) { const float* kmp = KMh + r32 * 64 + 16 * d0 + 8 * hi; kw = pack8(*(const f32x4*)kmp, *(const f32x4*)(kmp + 4)); }
        G = __builtin_amdgcn_mfma_f32_32x32x16_bf16(__builtin_bit_cast(bf16x8, kw), qr[d0], G, 0, 0, 0); }
    float gate[8];
#pragma unroll
    for (int n = 0; n < 4; ++n) { const float own = G[n], oth = __shfl_xor(own, 32); gate[n] = hi ? oth : own; gate[n + 4] = hi ? own : oth; }
    unsigned sel = 0u; const int nsel = qb < 3 ? qb : 3;
#pragma unroll
    for (int r = 0; r < 3; ++r) if (r < nsel) { float best = -INFINITY; int bi = 0;
#pragma unroll
        for (int n = 0; n < 8; ++n) if (n < qb && !((sel >> n) & 1u) && gate[n] > best) { best = gate[n]; bi = n; }
        sel |= 1u << bi; }
    unsigned wsel = 0u;
#pragma unroll
    for (int n = 0; n < 8; ++n) if (__any((sel >> n) & 1u)) wsel |= 1u << n;
    asm volatile("s_waitcnt vmcnt(0) lgkmcnt(0)" ::: "memory"); __builtin_amdgcn_s_barrier();
    const int NT = 4 * qb + 4, my_last = 4 * qb + (wave >> 1), jdiag = wave & 1;
    attn_dma_tile(Kh, Vth, NT - 1, ring, wave, r32, r32p, hi);
    attn_dma_tile(Kh, Vth, NT - 2, ring + AT_SLOT, wave, r32, r32p, hi);
    f32x16 O0 = f32x16{}, O1 = f32x16{}; float m = -INFINITY, l = 0.f;
    int slot = 0;
#pragma unroll 1
    for (int T = NT - 1; T >= 0; --T) {
        if (T > 0) asm volatile("s_waitcnt vmcnt(2)" ::: "memory"); else asm volatile("s_waitcnt vmcnt(0)" ::: "memory");
        __builtin_amdgcn_s_barrier();
        if (T >= 2) { const int fs = (slot == 0) ? 2 : slot - 1; attn_dma_tile(Kh, Vth, T - 2, ring + fs * AT_SLOT, wave, r32, r32p, hi); }
        const unsigned sa = ring_a + (unsigned)(slot * AT_SLOT);
        if (T >= 4 * qb) {
            if (T == my_last) {
                if (jdiag == 1) { attn_moba_sub<1>(qr, O0, O1, m, l, sa, 1, 64 * T + 32, q, q0, hi, slope2, true); attn_moba_sub<0>(qr, O0, O1, m, l, sa, 0, 64 * T, q, q0, hi, slope2, true); }
                else attn_moba_sub<1>(qr, O0, O1, m, l, sa, 0, 64 * T, q, q0, hi, slope2, true);
            } else if (T < my_last) { attn_moba_sub<0>(qr, O0, O1, m, l, sa, 1, 64 * T + 32, q, q0, hi, slope2, true); attn_moba_sub<0>(qr, O0, O1, m, l, sa, 0, 64 * T, q, q0, hi, slope2, true); }
        } else if ((wsel >> (T >> 2)) & 1u) {
            const bool rowok = (sel >> (T >> 2)) & 1u;
            attn_moba_sub<2>(qr, O0, O1, m, l, sa, 1, 64 * T + 32, q, q0, hi, slope2, rowok); attn_moba_sub<2>(qr, O0, O1, m, l, sa, 0, 64 * T, q, q0, hi, slope2, rowok);
        }
        slot = (slot == 2) ? 0 : slot + 1;
    }
    const float linv = 1.f / (l + __shfl_xor(l, 32));
    bf16_t* orow = AOp + (size_t)q * DM;
#pragma unroll
    for (int g = 0; g < 4; ++g) { u32x2 w;
        w.x = pk2(O0[4 * g] * linv, O0[4 * g + 1] * linv); w.y = pk2(O0[4 * g + 2] * linv, O0[4 * g + 3] * linv); *(u32x2*)(orow + 8 * g + 4 * hi) = w;
        w.x = pk2(O1[4 * g] * linv, O1[4 * g + 1] * linv); w.y = pk2(O1[4 * g + 2] * linv, O1[4 * g + 3] * linv); *(u32x2*)(orow + 32 + 8 * g + 4 * hi) = w; }
    asm volatile("s_waitcnt vmcnt(0) lgkmcnt(0)" ::: "memory"); __builtin_amdgcn_s_barrier();
}
__device__ __forceinline__ void phase_attn_moba(Frame& F, const bf16_t* QD, const bf16_t* KD, const bf16_t* VTD, const float* KMEAN, bf16_t* AO) {
    for (int ug = F.vcu; ug < NB * 8 * 2; ug += F.G) {
        const int bh = ug >> 1, b = bh >> 3, h = bh & 7; const size_t hb = (size_t)bh;
        const float slope2 = __builtin_amdgcn_exp2f(-(float)(h + 1)) * LOG2E;
#pragma unroll 1
        for (int i = 0; i < 4; ++i) { const int base = (i >> 1) * 2 + (ug & 1), qb = (i & 1) ? 7 - base : base;
            attn_moba_unit(F, QD + hb * 2048 * 64, KD + hb * 2048 * 64, VTD + hb * 64 * 2048, KMEAN + (size_t)bh * 8 * 64, slope2, qb, AO + (size_t)b * 2048 * DM + 512 + h * 64); }
    }
}
__device__ __forceinline__ void phase_pool(Frame& F, const bf16_t* XC, const bf16_t* PWT, const float* pool_scale, bf16_t* AO) {
    const int gw = F.vcu * NWAVES + F.wave, NGW = F.G * NWAVES, lane = opaque_i(F.lane), r32 = lane & 31, hi = lane >> 5;
    for (int it = gw; it < (TOK / 32) * 4; it += NGW) {
        const int rnd = it / NGW, gq = it - rnd * NGW;
        const int g = (rnd & 1) ? 3 - (gq & 3) : (gq & 3), t0 = (rnd * (NGW >> 2) + (gq >> 2)) * 32, t = t0 + r32, tl = t & 2047, w = 2 << g;
        const int cnt = (tl + 1) < w ? (tl + 1) : w; const float rc = 1.f / (float)cnt;
        f32x16 acc[4];
#pragma unroll
        for (int nb = 0; nb < 4; ++nb) acc[nb] = f32x16{};
#pragma unroll 1
        for (int kk = 0; kk < 8; ++kk) {
            const int c0 = g * 128 + kk * 16 + hi * 8;
            const u32x4 self = *(const u32x4*)(XC + (size_t)t * 512 + c0);
            float s[8] = {0.f, 0.f, 0.f, 0.f, 0.f, 0.f, 0.f, 0.f};
            for (int i = 0; i < cnt; ++i) { const u32x4 x = *(const u32x4*)(XC + (size_t)(t - i) * 512 + c0);
                s[0] += bf_lo(x.x); s[1] += bf_hi(x.x); s[2] += bf_lo(x.y); s[3] += bf_hi(x.y); s[4] += bf_lo(x.z); s[5] += bf_hi(x.z); s[6] += bf_lo(x.w); s[7] += bf_hi(x.w); }
            u32x4 pa; pa.x = pk2(s[0] * rc - bf_lo(self.x), s[1] * rc - bf_hi(self.x)); pa.y = pk2(s[2] * rc - bf_lo(self.y), s[3] * rc - bf_hi(self.y));
            pa.z = pk2(s[4] * rc - bf_lo(self.z), s[5] * rc - bf_hi(self.z)); pa.w = pk2(s[6] * rc - bf_lo(self.w), s[7] * rc - bf_hi(self.w));
            const bf16x8 af = __builtin_bit_cast(bf16x8, pa);
#pragma unroll
            for (int nb = 0; nb < 4; ++nb) { const bf16x8 bfr = *(const bf16x8*)(PWT + ((size_t)g * 128 + nb * 32 + r32) * 128 + kk * 16 + hi * 8);
                acc[nb] = __builtin_amdgcn_mfma_f32_32x32x16_bf16(af, bfr, acc[nb], 0, 0, 0); }
        }
#pragma unroll
        for (int nb = 0; nb < 4; ++nb) { const int col = g * 128 + nb * 32 + r32; const float sc = pool_scale[col];
#pragma unroll
            for (int r = 0; r < 16; ++r) { const int row = (r & 3) + 8 * (r >> 2) + 4 * hi; AO[(size_t)(t0 + row) * DM + col] = (bf16_t)f2bf(acc[nb][r] * sc); } }
    }
}

__device__ __forceinline__ void phase_topk_naive(Frame& F, const bf16_t* QP, const bf16_t* K1B, const bf16_t* K2B, unsigned short* EID, float* GATE) {
    const int gw = F.vcu * NWAVES + F.wave, NGW = F.G * NWAVES, lane = opaque_i(F.lane);
    for (int task = gw; task < TOK * 8; task += NGW) {
        const int t = task >> 3, h = task & 7;
        const bf16_t* qrow = QP + (size_t)t * 2048 + h * 256; const bf16_t* k1 = K1B + (size_t)h * 128 * 128; const bf16_t* k2 = K2B + (size_t)h * 128 * 128;
        float s1a = 0.f, s1b = 0.f, s2a = 0.f, s2b = 0.f;
#pragma unroll 4
        for (int c = 0; c < 16; ++c) { const u32x4 q1 = *(const u32x4*)(qrow + 8 * c), q2 = *(const u32x4*)(qrow + 128 + 8 * c);
            s1a = dot8(*(const u32x4*)(k1 + (size_t)lane * 128 + 8 * c), q1, s1a); s1b = dot8(*(const u32x4*)(k1 + (size_t)(lane + 64) * 128 + 8 * c), q1, s1b);
            s2a = dot8(*(const u32x4*)(k2 + (size_t)lane * 128 + 8 * c), q2, s2a); s2b = dot8(*(const u32x4*)(k2 + (size_t)(lane + 64) * 128 + 8 * c), q2, s2b); }
        unsigned A = (f2ord(s1a) & ~127u) | (unsigned)(127 - lane), B = (f2ord(s1b) & ~127u) | (unsigned)(63 - lane);
        unsigned top1 = 0u, top2 = 0u, topc = 0u;
        for (int r = 0; r < 16; ++r) { const unsigned m = wave_umax(A > B ? A : B); if (lane == r) top1 = m; if (A == m) A = 0u; if (B == m) B = 0u; }
        A = (f2ord(s2a) & ~127u) | (unsigned)(127 - lane); B = (f2ord(s2b) & ~127u) | (unsigned)(63 - lane);
        for (int r = 0; r < 16; ++r) { const unsigned m = wave_umax(A > B ? A : B); if (lane == r) top2 = m; if (A == m) A = 0u; if (B == m) B = 0u; }
        const float v1 = ord2f(top1 & ~127u), v2 = ord2f(top2 & ~127u); const int i1 = 127 - (int)(top1 & 127u), i2 = 127 - (int)(top2 & 127u);
        const float va = __shfl(v1, lane >> 2); unsigned C[4];
#pragma unroll
        for (int j = 0; j < 4; ++j) { const float vb = __shfl(v2, (lane & 3) * 4 + j); C[j] = (f2ord(va + vb) & ~255u) | (unsigned)(255 - (lane * 4 + j)); }
        for (int r = 0; r < 16; ++r) { unsigned m = C[0] > C[1] ? C[0] : C[1]; const unsigned m2 = C[2] > C[3] ? C[2] : C[3]; m = wave_umax(m > m2 ? m : m2); if (lane == r) topc = m;
#pragma unroll
            for (int j = 0; j < 4; ++j) if (C[j] == m) C[j] = 0u; }
        const int c = 255 - (int)(topc & 255u); const float val = ord2f(topc & ~255u);
        const int ia = __shfl(i1, c >> 4), ib = __shfl(i2, c & 15);
        const float v0 = __shfl(val, 0); const float e = (lane < 16) ? __expf(val - v0) : 0.f; const float sum = wave_sum(e);
        if (lane < 16) { EID[(size_t)t * 128 + h * 16 + lane] = (unsigned short)(ia * 128 + ib); GATE[(size_t)t * 128 + h * 16 + lane] = e / sum; }
    }
}

#define DEVFN __device__ __forceinline__
template <int OFF, int N, int TOT> DEVFN void bitonic_sort_desc(unsigned (&a)[TOT]) {
#pragma unroll
    for (int k = 2; k <= N; k <<= 1)
#pragma unroll
        for (int j = k >> 1; j > 0; j >>= 1)
#pragma unroll
            for (int i = 0; i < N; ++i) { const int l = i ^ j; if (l > i) { const bool desc = ((i & k) == 0); const unsigned x = a[OFF + i], y = a[OFF + l];
                const unsigned mx = x > y ? x : y, mn = x > y ? y : x; a[OFF + i] = desc ? mx : mn; a[OFF + l] = desc ? mn : mx; } }
}
constexpr int OE16_N = 63;
constexpr unsigned char OE16[63][2] = {{0,1}, {2,3}, {0,2}, {1,3}, {1,2}, {4,5}, {6,7}, {4,6}, {5,7}, {5,6}, {0,4}, {2,6}, {2,4}, {1,5}, {3,7}, {3,5}, {1,2}, {3,4}, {5,6}, {8,9}, {10,11}, {8,10}, {9,11}, {9,10}, {12,13}, {14,15}, {12,14}, {13,15}, {13,14}, {8,12}, {10,14}, {10,12}, {9,13}, {11,15}, {11,13}, {9,10}, {11,12}, {13,14}, {0,8}, {4,12}, {4,8}, {2,10}, {6,14}, {6,10}, {2,4}, {6,8}, {10,12}, {1,9}, {5,13}, {5,9}, {3,11}, {7,15}, {7,11}, {3,5}, {7,9}, {11,13}, {1,2}, {3,4}, {5,6}, {7,8}, {9,10}, {11,12}, {13,14}};
template <int OFF, int TOT> DEVFN void sort16_desc(unsigned (&a)[TOT]) {
#pragma unroll
    for (int q = 0; q < OE16_N; ++q) { const int i = OFF + OE16[q][0], l = OFF + OE16[q][1]; const unsigned x = a[i], y = a[l]; a[i] = x > y ? x : y; a[l] = x > y ? y : x; }
}
template <int OFF, int TOT> DEVFN void bitonic_merge16_desc(unsigned (&a)[TOT]) {
#pragma unroll
    for (int j = 8; j > 0; j >>= 1)
#pragma unroll
        for (int i = 0; i < 16; ++i) { const int l = i ^ j; if (l > i) { const unsigned x = a[OFF + i], y = a[OFF + l]; a[OFF + i] = x > y ? x : y; a[OFF + l] = x > y ? y : x; } }
}
template <int A, int B, int TOT> DEVFN void merge_top16(unsigned (&a)[TOT]) {
#pragma unroll
    for (int i = 0; i < 16; ++i) { const unsigned x = a[A + i], y = a[B + 15 - i]; a[A + i] = x > y ? x : y; }
    bitonic_merge16_desc<A, TOT>(a);
}
DEVFN void top16of64(unsigned (&a)[64]) {
    sort16_desc<0, 64>(a); sort16_desc<16, 64>(a); sort16_desc<32, 64>(a); sort16_desc<48, 64>(a);
    merge_top16<0, 16, 64>(a); merge_top16<32, 48, 64>(a); merge_top16<0, 32, 64>(a);
}

__device__ __forceinline__ void phase_topk(Frame& F, const bf16_t* QP, const bf16_t* K1B, const bf16_t* K2B, unsigned short* EID, float* GATE) {
    const int gw = F.vcu * NWAVES + F.wave, NGW = F.G * NWAVES, lane = opaque_i(F.lane), r32 = lane & 31, hi = lane >> 5;
    LAS unsigned* I1s = (LAS unsigned*)(F.lds + F.wave * 8192); LAS unsigned* I2s = I1s + 1024;
    for (int task = gw; task < (TOK / 32) * 8; task += NGW) {
        const int tile = task >> 3, h = task & 7, t = tile * 32 + r32;
        unsigned V1[16], V2[16]; unsigned h4 = (unsigned)hi << 2; asm volatile("" : "+v"(h4));
#pragma unroll
        for (int half = 0; half < 2; ++half) {
            const bf16_t* qrow = QP + (size_t)t * 2048 + h * 256 + half * 128 + 8 * hi;
            bf16x8 qf[8];
#pragma unroll
            for (int kk = 0; kk < 8; ++kk) qf[kk] = *(const bf16x8*)(qrow + 16 * kk);
            unsigned K[64];
#pragma unroll
            for (int nb = 0; nb < 4; ++nb) { f32x16 acc = f32x16{};
                const bf16_t* kb = (half ? K2B : K1B) + ((size_t)h * 128 + nb * 32 + r32) * 128 + 8 * hi; asm volatile("" : "+v"(kb));
#pragma unroll
                for (int kk = 0; kk < 8; ++kk) acc = __builtin_amdgcn_mfma_f32_32x32x16_bf16(*(const bf16x8*)(kb + 16 * kk), qf[kk], acc, 0, 0, 0);
#pragma unroll
                for (int r = 0; r < 16; ++r) K[nb * 16 + r] = ((f2ord(acc[r]) & ~127u) | (unsigned)(127 - (nb * 32 + (r & 3) + 8 * (r >> 2)))) ^ h4;
                __builtin_amdgcn_sched_barrier(0); }
            __builtin_amdgcn_sched_barrier(0); top16of64(K); __builtin_amdgcn_sched_barrier(0);
            unsigned C[16];
#pragma unroll
            for (int i = 0; i < 16; ++i) { const unsigned y = (unsigned)__shfl_xor((int)K[15 - i], 32); C[i] = K[i] > y ? K[i] : y; }
            bitonic_merge16_desc<0, 16>(C);
#pragma unroll
            for (int i = 0; i < 16; ++i) { if (half == 0) V1[i] = C[i]; else V2[i] = C[i]; }
            __builtin_amdgcn_sched_barrier(0);
        }
        float f1[16], f2[16];
#pragma unroll
        for (int a = 0; a < 16; ++a) { I1s[a * 64 + lane] = 127u - (V1[a] & 127u); I2s[a * 64 + lane] = 127u - (V2[a] & 127u); f1[a] = ord2f(V1[a] & ~127u); f2[a] = ord2f(V2[a] & ~127u); }
        __builtin_amdgcn_sched_barrier(0);
        unsigned Cd[64];
    Cd[0] = (f2ord(f1[0] + f2[0]) & ~255u) | 255u;
    Cd[1] = (f2ord(f1[0] + f2[1]) & ~255u) | 254u;
    Cd[2] = (f2ord(f1[0] + f2[2]) & ~255u) | 253u;
    Cd[3] = (f2ord(f1[0] + f2[3]) & ~255u) | 252u;
    Cd[4] = (f2ord(f1[0] + f2[4]) & ~255u) | 251u;
    Cd[5] = (f2ord(f1[0] + f2[5]) & ~255u) | 250u;
    Cd[6] = (f2ord(f1[0] + f2[6]) & ~255u) | 249u;
    Cd[7] = (f2ord(f1[0] + f2[7]) & ~255u) | 248u;
    Cd[8] = (f2ord(f1[0] + f2[8]) & ~255u) | 247u;
    Cd[9] = (f2ord(f1[0] + f2[9]) & ~255u) | 246u;
    Cd[10] = (f2ord(f1[0] + f2[10]) & ~255u) | 245u;
    Cd[11] = (f2ord(f1[0] + f2[11]) & ~255u) | 244u;
    Cd[12] = (f2ord(f1[0] + f2[12]) & ~255u) | 243u;
    Cd[13] = (f2ord(f1[0] + f2[13]) & ~255u) | 242u;
    Cd[14] = (f2ord(f1[0] + f2[14]) & ~255u) | 241u;
    Cd[15] = (f2ord(f1[0] + f2[15]) & ~255u) | 240u;
    Cd[16] = (f2ord(f1[1] + f2[0]) & ~255u) | 239u;
    Cd[17] = (f2ord(f1[1] + f2[1]) & ~255u) | 238u;
    Cd[18] = (f2ord(f1[1] + f2[2]) & ~255u) | 237u;
    Cd[19] = (f2ord(f1[1] + f2[3]) & ~255u) | 236u;
    Cd[20] = (f2ord(f1[1] + f2[4]) & ~255u) | 235u;
    Cd[21] = (f2ord(f1[1] + f2[5]) & ~255u) | 234u;
    Cd[22] = (f2ord(f1[1] + f2[6]) & ~255u) | 233u;
    Cd[23] = (f2ord(f1[1] + f2[7]) & ~255u) | 232u;
    Cd[24] = (f2ord(f1[2] + f2[0]) & ~255u) | 223u;
    Cd[25] = (f2ord(f1[2] + f2[1]) & ~255u) | 222u;
    Cd[26] = (f2ord(f1[2] + f2[2]) & ~255u) | 221u;
    Cd[27] = (f2ord(f1[2] + f2[3]) & ~255u) | 220u;
    Cd[28] = (f2ord(f1[2] + f2[4]) & ~255u) | 219u;
    Cd[29] = (f2ord(f1[3] + f2[0]) & ~255u) | 207u;
    Cd[30] = (f2ord(f1[3] + f2[1]) & ~255u) | 206u;
    Cd[31] = (f2ord(f1[3] + f2[2]) & ~255u) | 205u;
    Cd[32] = (f2ord(f1[3] + f2[3]) & ~255u) | 204u;
    Cd[33] = (f2ord(f1[4] + f2[0]) & ~255u) | 191u;
    Cd[34] = (f2ord(f1[4] + f2[1]) & ~255u) | 190u;
    Cd[35] = (f2ord(f1[4] + f2[2]) & ~255u) | 189u;
    Cd[36] = (f2ord(f1[5] + f2[0]) & ~255u) | 175u;
    Cd[37] = (f2ord(f1[5] + f2[1]) & ~255u) | 174u;
    Cd[38] = (f2ord(f1[6] + f2[0]) & ~255u) | 159u;
    Cd[39] = (f2ord(f1[6] + f2[1]) & ~255u) | 158u;
    Cd[40] = (f2ord(f1[7] + f2[0]) & ~255u) | 143u;
    Cd[41] = (f2ord(f1[7] + f2[1]) & ~255u) | 142u;
    Cd[42] = (f2ord(f1[8] + f2[0]) & ~255u) | 127u;
    Cd[43] = (f2ord(f1[9] + f2[0]) & ~255u) | 111u;
    Cd[44] = (f2ord(f1[10] + f2[0]) & ~255u) | 95u;
    Cd[45] = (f2ord(f1[11] + f2[0]) & ~255u) | 79u;
    Cd[46] = (f2ord(f1[12] + f2[0]) & ~255u) | 63u;
    Cd[47] = (f2ord(f1[13] + f2[0]) & ~255u) | 47u;
    Cd[48] = (f2ord(f1[14] + f2[0]) & ~255u) | 31u;
    Cd[49] = (f2ord(f1[15] + f2[0]) & ~255u) | 15u;
    Cd[50] = 0u;
    Cd[51] = 0u;
    Cd[52] = 0u;
    Cd[53] = 0u;
    Cd[54] = 0u;
    Cd[55] = 0u;
    Cd[56] = 0u;
    Cd[57] = 0u;
    Cd[58] = 0u;
    Cd[59] = 0u;
    Cd[60] = 0u;
    Cd[61] = 0u;
    Cd[62] = 0u;
    Cd[63] = 0u;
        __builtin_amdgcn_sched_barrier(0); top16of64(Cd); __builtin_amdgcn_sched_barrier(0);
        LDS_WAIT();
        unsigned eid[16]; float e[16]; float sum = 0.f; const float v0 = ord2f(Cd[0] & ~255u);
#pragma unroll
        for (int r = 0; r < 16; ++r) { const unsigned c = 255u - (Cd[r] & 255u); eid[r] = I1s[(c >> 4) * 64 + lane] * 128u + I2s[(c & 15u) * 64 + lane];
            e[r] = __builtin_amdgcn_exp2f((ord2f(Cd[r] & ~255u) - v0) * LOG2E); sum += e[r]; }
        const float inv = 1.f / sum;
        u32x4 ew; ew.x = (hi ? eid[8] : eid[0]) | ((hi ? eid[9] : eid[1]) << 16); ew.y = (hi ? eid[10] : eid[2]) | ((hi ? eid[11] : eid[3]) << 16);
        ew.z = (hi ? eid[12] : eid[4]) | ((hi ? eid[13] : eid[5]) << 16); ew.w = (hi ? eid[14] : eid[6]) | ((hi ? eid[15] : eid[7]) << 16);
        *(u32x4*)(EID + (size_t)t * 128 + h * 16 + 8 * hi) = ew;
        const f32x4 g0 = {(hi ? e[8] : e[0]) * inv, (hi ? e[9] : e[1]) * inv, (hi ? e[10] : e[2]) * inv, (hi ? e[11] : e[3]) * inv};
        const f32x4 g1 = {(hi ? e[12] : e[4]) * inv, (hi ? e[13] : e[5]) * inv, (hi ? e[14] : e[6]) * inv, (hi ? e[15] : e[7]) * inv};
        *(f32x4*)(GATE + (size_t)t * 128 + h * 16 + 8 * hi) = g0; *(f32x4*)(GATE + (size_t)t * 128 + h * 16 + 8 * hi + 4) = g1;
        LDS_WAIT();
    }
}

typedef float f32x2 __attribute__((ext_vector_type(2)));
__device__ __forceinline__ float dpp_f(float v, int sel) {
    const int iv = __builtin_bit_cast(int, v); int r;
    if (sel == 0) r = __builtin_amdgcn_update_dpp(0, iv, 0xB1, 0xf, 0xf, true); else if (sel == 1) r = __builtin_amdgcn_update_dpp(0, iv, 0x4E, 0xf, 0xf, true); else r = __builtin_amdgcn_update_dpp(0, iv, 0x141, 0xf, 0xf, true);
    return __builtin_bit_cast(float, r);
}
__device__ __forceinline__ float gelu_erf(float v) {
    const float av = fabsf(v), d = av * 0.2316418882f + 1.0f; const float t = __builtin_amdgcn_rcpf(d);
    float q = t * 0.5307027145f + (-0.7265760135f); q = q * t + 0.7107068705f; q = q * t + (-0.142248368f); q = q * t + 0.127414796f; q = q * t;
    const float e = __builtin_amdgcn_exp2f((v * v) * (-0.72134752044f));
    const float m = v * (q * e), r = v - m; return v < 0.f ? m : r;
}
typedef _Float16 h16x2 __attribute__((ext_vector_type(2)));
__device__ __forceinline__ h16x2 bf8_lo2(unsigned w) { return __builtin_bit_cast(h16x2, __builtin_amdgcn_perm(0u, w, 0x010c000cu)); }
__device__ __forceinline__ h16x2 bf8_hi2(unsigned w) { return __builtin_bit_cast(h16x2, __builtin_amdgcn_perm(0u, w, 0x030c020cu)); }
__device__ __forceinline__ h16x2 bf16pair_to_h2(unsigned w) { h16x2 r; r.x = (_Float16)bf_lo(w); r.y = (_Float16)bf_hi(w); return r; }
#define PEER_E(ev0_, ev1_, w_) (int)((((w_) < 8 ? (ev0_) : (ev1_))[((w_) & 7) >> 1] >> (16 * ((w_) & 1))) & 0xffffu)
#define GLD4(dst_, ptr_) asm volatile("global_load_dword %0, %1, off" : "=v"(dst_) : "v"(ptr_) : "memory")
#define GLD16(dst_, ptr_) asm volatile("global_load_dwordx4 %0, %1, off" : "=v"(dst_) : "v"(ptr_) : "memory")
__device__ __forceinline__ void phase_peer_u(Frame& F, const bf16_t* XB, const float* rsp, int rsmode, const unsigned short* EID, const unsigned char* U8S, float* PREP) {
    const int lane = opaque_i(F.lane), i16 = (lane >> 3) * 16, c = lane & 7, b = (int)blockIdx.x, x = b & 7, step = (F.G >> 3) * NWAVES;
    const unsigned char* tab = U8S + (size_t)x * NEXP * 128 + 16 * c;
    int t = (b >> 3) * NWAVES + F.wave;
    u32x4 evB0, evB1, xrA0, xrA1, xrB0, xrB1; u32x4 uw[16]; unsigned sqA, sqB;
    {   const u32x4 e0 = *(const u32x4*)(EID + (size_t)t * 128 + i16), e1 = *(const u32x4*)(EID + (size_t)t * 128 + i16 + 8);
        xrA0 = *(const u32x4*)(XB + (size_t)t * DM + 128 * x + 16 * c); xrA1 = *(const u32x4*)(XB + (size_t)t * DM + 128 * x + 16 * c + 8);
        const int tn = (t + step < TOK) ? t + step : t;
        evB0 = *(const u32x4*)(EID + (size_t)tn * 128 + i16); evB1 = *(const u32x4*)(EID + (size_t)tn * 128 + i16 + 8);
        sqA = __float_as_uint(rsp[(size_t)t * 16 + (lane & 15)]); sqB = __float_as_uint(rsp[(size_t)tn * 16 + (lane & 15)]);
        xrB0 = *(const u32x4*)(XB + (size_t)tn * DM + 128 * x + 16 * c); xrB1 = *(const u32x4*)(XB + (size_t)tn * DM + 128 * x + 16 * c + 8);
        asm volatile("s_waitcnt vmcnt(0)" : "+v"(evB0), "+v"(evB1), "+v"(xrA0), "+v"(xrA1), "+v"(xrB0), "+v"(xrB1), "+v"(sqA), "+v"(sqB) :: "memory");
#pragma unroll
        for (int w = 0; w < 16; ++w) { const unsigned char* rp = tab + (size_t)PEER_E(e0, e1, w) * 128; GLD16(uw[w], rp); } }
#pragma unroll 1
    for (; t < TOK; t += step) {
        const int tnn = (t + 2 * step < TOK) ? t + 2 * step : t;
        u32x4 evC0, evC1, xrC0, xrC1; unsigned sqC;
        { const unsigned short* ep = EID + (size_t)tnn * 128 + i16; const bf16_t* xp = XB + (size_t)tnn * DM + 128 * x + 16 * c;
          GLD16(evC0, ep); GLD16(evC1, ep + 8); GLD16(xrC0, xp); GLD16(xrC1, xp + 8); { const float* sp = rsp + (size_t)tnn * 16 + (lane & 15); GLD4(sqC, sp); } }
        unsigned xq[4];
        { float sq = __uint_as_float(sqA); sq += dpp_row_shr(sq, 1); sq += dpp_row_shr(sq, 2); sq += dpp_row_shr(sq, 4); sq += dpp_row_shr(sq, 8);
          sq = __builtin_bit_cast(float, __builtin_amdgcn_readlane(__builtin_bit_cast(int, sq), 15));
          const float sx = rsqrtf(sq * (1.f / DM) + RMS_EPS) * I8_SX;
#pragma unroll
          for (int k = 0; k < 4; ++k) { const unsigned w = (k < 2 ? xrA0 : xrA1)[2 * (k & 1)], w2 = (k < 2 ? xrA0 : xrA1)[2 * (k & 1) + 1];
              int q0 = __float2int_rn(bf_lo(w) * sx), q1 = __float2int_rn(bf_hi(w) * sx), q2 = __float2int_rn(bf_lo(w2) * sx), q3 = __float2int_rn(bf_hi(w2) * sx);
              q0 = q0 < -127 ? -127 : (q0 > 127 ? 127 : q0); q1 = q1 < -127 ? -127 : (q1 > 127 ? 127 : q1); q2 = q2 < -127 ? -127 : (q2 > 127 ? 127 : q2); q3 = q3 < -127 ? -127 : (q3 > 127 ? 127 : q3);
              xq[k] = ((unsigned)q0 & 0xffu) | (((unsigned)q1 & 0xffu) << 8) | (((unsigned)q2 & 0xffu) << 16) | ((unsigned)q3 << 24); } }
        int r_lo = 0, r_hi = 0;
#pragma unroll
        for (int w = 0; w < 16; ++w) {
            asm volatile("s_waitcnt vmcnt(20)" : "+v"(uw[w]) :: "memory");
            int p = __builtin_amdgcn_sdot4((int)uw[w][0], (int)xq[0], 0, false); int p2 = __builtin_amdgcn_sdot4((int)uw[w][1], (int)xq[1], 0, false);
            p = __builtin_amdgcn_sdot4((int)uw[w][2], (int)xq[2], p, false); p2 = __builtin_amdgcn_sdot4((int)uw[w][3], (int)xq[3], p2, false);
            p += p2;
            p += __builtin_amdgcn_update_dpp(0, p, 0xB1, 0xf, 0xf, true); p += __builtin_amdgcn_update_dpp(0, p, 0x4E, 0xf, 0xf, true); p += __builtin_amdgcn_update_dpp(0, p, 0x141, 0xf, 0xf, true);
            if (w < 8) r_lo = (c == w) ? p : r_lo; else r_hi = (c == (w & 7)) ? p : r_hi;
            { const unsigned char* rp = tab + (size_t)PEER_E(evB0, evB1, w) * 128; GLD16(uw[w], rp); }
            }
        float* dst = PREP + ((size_t)x * TOK + t) * 128 + i16 + c; dst[0] = (float)r_lo * (1.f / (I8_SU * I8_SX)); dst[8] = (float)r_hi * (1.f / (I8_SU * I8_SX));
        asm volatile("s_waitcnt vmcnt(16)" : "+v"(evC0), "+v"(evC1), "+v"(xrC0), "+v"(xrC1), "+v"(sqC) :: "memory");
        evB0 = evC0; evB1 = evC1; xrA0 = xrB0; xrA1 = xrB1; xrB0 = xrC0; xrB1 = xrC1; sqA = sqB; sqB = sqC;
    }
    asm volatile("s_waitcnt vmcnt(0)" ::: "memory");
}
__device__ __forceinline__ void phase_peer_c(Frame& F, const float* PREP, const float* rsp, int rsmode, const float* GATE, bf16_t* ACO) {
    const int gw = F.vcu * NWAVES + F.wave, NGW = F.G * NWAVES, lane = opaque_i(F.lane);
    for (int t = gw; t < TOK; t += NGW) {
        float s0 = 0.f, s1 = 0.f;
#pragma unroll
        for (int x = 0; x < 8; ++x) { const float* p = PREP + ((size_t)x * TOK + t) * 128; s0 += p[lane]; s1 += p[64 + lane]; }
        const float rsu = 1.f;
        { const _Float16 h0 = (_Float16)(gelu_erf(s0 * rsu) * GATE[(size_t)t * 128 + lane] * (1.f / FP8_SV)), h1 = (_Float16)(gelu_erf(s1 * rsu) * GATE[(size_t)t * 128 + 64 + lane] * (1.f / FP8_SV));
          ACO[(size_t)t * 128 + lane] = __builtin_bit_cast(unsigned short, h0); ACO[(size_t)t * 128 + 64 + lane] = __builtin_bit_cast(unsigned short, h1); }
    }
}
#define PIN16(o_) asm volatile("" : "+v"(o_[0]), "+v"(o_[1]), "+v"(o_[2]), "+v"(o_[3]), "+v"(o_[4]), "+v"(o_[5]), "+v"(o_[6]), "+v"(o_[7]), "+v"(o_[8]), "+v"(o_[9]), "+v"(o_[10]), "+v"(o_[11]), "+v"(o_[12]), "+v"(o_[13]), "+v"(o_[14]), "+v"(o_[15]))
__device__ __forceinline__ void phase_peer_v(Frame& F, bf16_t* XB, const unsigned short* EID, const bf16_t* ACO, const unsigned char* V8S, float* SSQP) {
    const int lane = opaque_i(F.lane), i16 = (lane >> 3) * 16, c = lane & 7, b = (int)blockIdx.x, x = b & 7, step = (F.G >> 3) * NWAVES;
    const unsigned char* tab = V8S + (size_t)x * NEXP * 128 + 16 * c;
    const bool b3 = lane & 8;
    const int col = 128 * x + 16 * c + ((lane & 32) ? 8 : 0) + ((lane & 16) ? 4 : 0) + (b3 ? 2 : 0);
    int t = (b >> 3) * NWAVES + F.wave;
    u32x4 evB0, evB1, aA0, aA1, vw[16]; unsigned xfA;
    {   const u32x4 e0 = *(const u32x4*)(EID + (size_t)t * 128 + i16), e1 = *(const u32x4*)(EID + (size_t)t * 128 + i16 + 8);
        aA0 = *(const u32x4*)(ACO + (size_t)t * 128 + i16); aA1 = *(const u32x4*)(ACO + (size_t)t * 128 + i16 + 8);
        xfA = *(const unsigned*)(XB + (size_t)t * DM + col);
        const int tn = (t + step < TOK) ? t + step : t;
        evB0 = *(const u32x4*)(EID + (size_t)tn * 128 + i16); evB1 = *(const u32x4*)(EID + (size_t)tn * 128 + i16 + 8);
        asm volatile("s_waitcnt vmcnt(0)" : "+v"(evB0), "+v"(evB1), "+v"(aA0), "+v"(aA1), "+v"(xfA) :: "memory");
#pragma unroll
        for (int w = 0; w < 16; ++w) { const unsigned char* rp = tab + (size_t)PEER_E(e0, e1, w) * 128; GLD16(vw[w], rp); } }
#pragma unroll 1
    for (; t < TOK; t += step) {
        const int tn = (t + step < TOK) ? t + step : t, tnn = (t + 2 * step < TOK) ? t + 2 * step : t;
        u32x4 evC0, evC1, aB0, aB1; unsigned xfB;
        { const unsigned short* ep = EID + (size_t)tnn * 128 + i16; const bf16_t* ap = ACO + (size_t)tn * 128 + i16; const bf16_t* xp = XB + (size_t)tn * DM + col;
          GLD16(evC0, ep); GLD16(evC1, ep + 8); GLD16(aB0, ap); GLD16(aB1, ap + 8); GLD4(xfB, xp); }
        float o[16];
#pragma unroll
        for (int k = 0; k < 16; ++k) o[k] = 0.f;
#pragma unroll
        for (int w = 0; w < 16; w += 2) {
            asm volatile("s_waitcnt vmcnt(19)" : "+v"(vw[w]), "+v"(vw[w + 1]) :: "memory");
            const unsigned aw = (w < 8 ? aA0 : aA1)[(w & 7) >> 1]; const h16x2 a2 = __builtin_bit_cast(h16x2, aw);
#pragma unroll
            for (int k = 0; k < 4; ++k) { const unsigned r0 = vw[w][k], r1 = vw[w + 1][k];
                o[4 * k]     = __builtin_amdgcn_fdot2(__builtin_bit_cast(h16x2, __builtin_amdgcn_perm(r1, r0, 0x040c000cu)), a2, o[4 * k], false);
                o[4 * k + 1] = __builtin_amdgcn_fdot2(__builtin_bit_cast(h16x2, __builtin_amdgcn_perm(r1, r0, 0x050c010cu)), a2, o[4 * k + 1], false);
                o[4 * k + 2] = __builtin_amdgcn_fdot2(__builtin_bit_cast(h16x2, __builtin_amdgcn_perm(r1, r0, 0x060c020cu)), a2, o[4 * k + 2], false);
                o[4 * k + 3] = __builtin_amdgcn_fdot2(__builtin_bit_cast(h16x2, __builtin_amdgcn_perm(r1, r0, 0x070c030cu)), a2, o[4 * k + 3], false); }
            PIN16(o);
            { const unsigned char* rp = tab + (size_t)PEER_E(evB0, evB1, w) * 128; GLD16(vw[w], rp); }
            { const unsigned char* rp = tab + (size_t)PEER_E(evB0, evB1, w + 1) * 128; GLD16(vw[w + 1], rp); } }
        float h8[8], h4[4], h2[2];
#pragma unroll
        for (int k = 0; k < 8; ++k) { const auto r = __builtin_amdgcn_permlane32_swap(__float_as_uint(o[k]), __float_as_uint(o[8 + k]), false, false); h8[k] = __uint_as_float(r[0]) + __uint_as_float(r[1]); }
#pragma unroll
        for (int k = 0; k < 4; ++k) { const auto r = __builtin_amdgcn_permlane16_swap(__float_as_uint(h8[k]), __float_as_uint(h8[4 + k]), false, false); h4[k] = __uint_as_float(r[0]) + __uint_as_float(r[1]); }
#pragma unroll
        for (int k = 0; k < 2; ++k) { const float keep = b3 ? h4[2 + k] : h4[k], send = b3 ? h4[k] : h4[2 + k];
            h2[k] = keep + __builtin_bit_cast(float, __builtin_amdgcn_update_dpp(0, __builtin_bit_cast(int, send), 0x128, 0xf, 0xf, true)); }
        const f32x2 f = {bf_lo(xfA) + h2[0], bf_hi(xfA) + h2[1]};
        *(unsigned*)(XB + (size_t)t * DM + col) = pk2(f.x, f.y);
        const float ss = wave_total(f.x * f.x + f.y * f.y);
        if (lane == 0) { SSQP[(size_t)t * 16 + x] = ss; SSQP[(size_t)t * 16 + 8 + x] = 0.f; }
        asm volatile("s_waitcnt vmcnt(16)" : "+v"(evC0), "+v"(evC1), "+v"(aB0), "+v"(aB1), "+v"(xfB) :: "memory");
        aA0 = aB0; aA1 = aB1; evB0 = evC0; evB1 = evC1; xfA = xfB;
    }
    asm volatile("s_waitcnt vmcnt(0)" ::: "memory");
}

__device__ __forceinline__ void phase_final_norm(Frame& F, const bf16_t* XB, float* OUT, const float* SSQP, const float* norm_f) {
    const int gw = F.vcu * NWAVES + F.wave, NGW = F.G * NWAVES, lane = opaque_i(F.lane);
    for (int t = gw; t < TOK; t += NGW) { const float r = row_scale(SSQP, 1, t);
#pragma unroll
        for (int j = 0; j < 4; ++j) { const u32x2 w = *(const u32x2*)(XB + (size_t)t * DM + 256 * j + 4 * lane); const f32x4 x = {bf_lo(w.x), bf_hi(w.x), bf_lo(w.y), bf_hi(w.y)};
            *(f32x4*)(OUT + (size_t)t * DM + 256 * j + 4 * lane) = x * r * *(const f32x4*)(norm_f + 256 * j + 4 * lane); } }
}

constexpr int N_PHASES = 20;
struct Args { const float* in[16]; float* out; unsigned char* ws; int ph_lo, ph_hi; };
template <bool COOP>
__global__ void __launch_bounds__(NWAVES * 64, 2) mk_fwd(Args args) {
    extern __shared__ __attribute__((aligned(16))) unsigned char lds[];
    Frame F;
    F.lds = (LAS unsigned char*)lds;
    F.tid = threadIdx.x; F.lane = F.tid & 63; F.wave = __builtin_amdgcn_readfirstlane(F.tid >> 6);
    F.G = gridDim.x; { const int bx = blockIdx.x; F.vcu = (F.G % 8 == 0) ? (bx % 8) * (F.G / 8) + bx / 8 : bx; }
    Ptrs P;
    P.x = args.in[0]; P.norm_mix = args.in[1]; P.norm_ffn = args.in[2]; P.ev_w_in = args.in[3]; P.ev_b_f = args.in[4]; P.ev_w_out = args.in[5]; P.od_w_in = args.in[6];
    P.od_pool_w = args.in[7]; P.od_pool_scale = args.in[8]; P.od_w_out = args.in[9]; P.peer_wq = args.in[10]; P.peer_k1 = args.in[11]; P.peer_k2 = args.in[12];
    P.peer_u = args.in[13]; P.peer_v = args.in[14]; P.norm_f = args.in[15]; P.out = args.out; P.ws = args.ws;
    unsigned char* ws = args.ws;
    bf16_t* XB = (bf16_t*)(ws + WS_XB); bf16_t* AO = (bf16_t*)(ws + WS_AO); bf16_t* QP = (bf16_t*)(ws + WS_QP);
    unsigned short* EID = (unsigned short*)(ws + WS_EID); float* GATE = (float*)(ws + WS_GATE);
    float* RS0 = (float*)(ws + WS_RS0); float* SSQ2 = (float*)(ws + WS_SSQ2); float* PREP = (float*)(ws + WS_PREP); bf16_t* ACO = (bf16_t*)(ws + WS_ACO); float* SSQ1 = (float*)(ws + WS_SSQ1); float* SSQ3 = (float*)(ws + WS_SSQ3);
    const int lo = args.ph_lo, hi = args.ph_hi;
    volatile LAS unsigned* xbst = (volatile LAS unsigned*)(F.lds + RING_BYTES + 1024);
    if (F.tid < 4) xbst[F.tid] = 0u;
    __syncthreads();
    XcdBarrier xbar; xbar.bar = (unsigned*)(ws + WS_CTL) + 4096; xbar.x = 0; xbar.st = xbst;
    if (COOP) xbar = xcd_barrier_post((unsigned*)(ws + WS_CTL) + 4096, xbst);
#define IN(k) (lo <= (k) && (k) < hi)
#define SEAM(k) do { if (COOP && IN(k) && IN((k) + 1)) { if ((k) == 0) cg::this_grid().sync(); else xcd_barrier(xbar); } } while (0)
    if (IN(0)) { phase_p0(F, P); } SEAM(0);
    if (IN(1)) {
        pg8::Gemm g{XB, (const bf16_t*)(ws + WS_W1T), TOK, EVEN_PAD, DM}; pg8::StaticOrder S; S.init(TOK, EVEN_PAD, F.G, (int)blockIdx.x);
        EpiL0In E{RS0, (bf16_t*)(ws + WS_QH), (bf16_t*)(ws + WS_KH), (bf16_t*)(ws + WS_VT), (float*)(ws + WS_LF), P.ev_b_f};
        pg8::gemm_phase<EpiL0In, pg8::StaticOrder, true, true>(F.lds, g, S, E);
    } SEAM(1);
    if (IN(2)) { phase_cfscan(F, (const float*)(ws + WS_LF), (float*)(ws + WS_CF)); } SEAM(2);
    if (IN(3)) {
        phase_attn_fox(F, (const bf16_t*)(ws + WS_QH), (const bf16_t*)(ws + WS_KH), (const bf16_t*)(ws + WS_VT), (const float*)(ws + WS_CF), AO);
        phase_attn<1>(F, (const bf16_t*)(ws + WS_QH), (const bf16_t*)(ws + WS_KH), (const bf16_t*)(ws + WS_VT), 16, 8, nullptr, nullptr, AO, 512);
    } SEAM(3);
    if (IN(4)) {
        pg8::Gemm g{AO, (const bf16_t*)(ws + WS_W2T), TOK, DM, DM}; pg8::StaticOrder S; S.init(TOK, DM, F.G, (int)blockIdx.x);
        EpiRes<false> E{P.x, XB, SSQ1};
        pg8::gemm_phase<EpiRes<false>, pg8::StaticOrder, true, true>(F.lds, g, S, E);
    } SEAM(4);
    if (IN(5)) {
        pg8::Gemm g{XB, (const bf16_t*)(ws + WS_W3T), TOK, 2048, DM}; pg8::StaticOrder S; S.init(TOK, 2048, F.G, (int)blockIdx.x);
        EpiQ E{SSQ1, 1, QP};
        pg8::gemm_phase<EpiQ, pg8::StaticOrder, true, true>(F.lds, g, S, E);
    } SEAM(5);
    if (IN(6)) { phase_topk(F, QP, (const bf16_t*)(ws + WS_K1B), (const bf16_t*)(ws + WS_K2B), EID, GATE); } SEAM(6);
    if (IN(7)) { phase_peer_u(F, XB, SSQ1, 1, EID, ws + WS_U8S, PREP); } SEAM(7);
    if (IN(8)) { phase_peer_c(F, PREP, SSQ1, 1, GATE, ACO); } SEAM(8);
    if (IN(9)) { phase_peer_v(F, XB, EID, ACO, ws + WS_V8S, SSQ2); } SEAM(9);
    if (IN(10)) {
        pg8::Gemm g{XB, (const bf16_t*)(ws + WS_W4T), TOK, 2048, DM}; pg8::StaticOrder S; S.init(TOK, 2048, F.G, (int)blockIdx.x);
        EpiL1In E{SSQ2, 1, (bf16_t*)(ws + WS_QH), (bf16_t*)(ws + WS_QH + 32 * MiB), (bf16_t*)(ws + WS_KH), (bf16_t*)(ws + WS_KH + 32 * MiB)};
        pg8::gemm_phase<EpiL1In, pg8::StaticOrder, true, true>(F.lds, g, S, E);
    } SEAM(10);
    if (IN(11)) {
        phase_pool(F, (const bf16_t*)(ws + WS_QH), (const bf16_t*)(ws + WS_PWT), P.od_pool_scale, AO);
        phase_kmean(F, (const bf16_t*)(ws + WS_KH), (float*)(ws + WS_KMEAN));
    } SEAM(11);
    if (IN(12)) {
        phase_attn_moba(F, (const bf16_t*)(ws + WS_QH + 32 * MiB), (const bf16_t*)(ws + WS_KH), (const bf16_t*)(ws + WS_KH + 32 * MiB), (const float*)(ws + WS_KMEAN), AO);
    } SEAM(12);
    if (IN(13)) {
        pg8::Gemm g{AO, (const bf16_t*)(ws + WS_W5T), TOK, DM, DM}; pg8::StaticOrder S; S.init(TOK, DM, F.G, (int)blockIdx.x);
        EpiRes<true> E{XB, XB, SSQ3};
        pg8::gemm_phase<EpiRes<true>, pg8::StaticOrder, true, true>(F.lds, g, S, E);
    } SEAM(13);
    if (IN(14)) {
        pg8::Gemm g{XB, (const bf16_t*)(ws + WS_W6T), TOK, 2048, DM}; pg8::StaticOrder S; S.init(TOK, 2048, F.G, (int)blockIdx.x);
        EpiQ E{SSQ3, 1, QP};
        pg8::gemm_phase<EpiQ, pg8::StaticOrder, true, true>(F.lds, g, S, E);
    } SEAM(14);
    if (IN(15)) { phase_topk(F, QP, (const bf16_t*)(ws + WS_K1B) + 8 * 128 * 128, (const bf16_t*)(ws + WS_K2B) + 8 * 128 * 128, EID, GATE); } SEAM(15);
    if (IN(16)) { phase_peer_u(F, XB, SSQ3, 1, EID, ws + WS_U8S + (size_t)8 * NEXP * 128, PREP); } SEAM(16);
    if (IN(17)) { phase_peer_c(F, PREP, SSQ3, 1, GATE, ACO); } SEAM(17);
    if (IN(18)) { phase_peer_v(F, XB, EID, ACO, ws + WS_V8S + (size_t)8 * NEXP * 128, SSQ2); } SEAM(18);
    if (IN(19)) { phase_final_norm(F, XB, P.out, SSQ2, P.norm_f); }
#undef IN
#undef SEAM
}

extern "C" void kernel_launch(void* const* d_in, const int* in_sizes, int n_in, void* d_out, int out_size, void* d_ws, size_t ws_size, hipStream_t stream) {
    static int grid = 0;
    constexpr bool COOP = (MK_MULTI == 0);
    if (grid == 0) {
        if (n_in != 16 || in_sizes[0] != TOK * DM || out_size != TOK * DM || ws_size < WS_END) { fprintf(stderr, "kernel_launch: unexpected shapes (n_in %d, in0 %d, out %d, ws %zu)\n", n_in, n_in > 0 ? in_sizes[0] : -1, out_size, ws_size); grid = -1; return; }
        int dev = 0, cus = 0, per_cu = 0;
        if (hipGetDevice(&dev) != hipSuccess || hipDeviceGetAttribute(&cus, hipDeviceAttributeMultiprocessorCount, dev) != hipSuccess) { grid = -1; return; }
        if (hipFuncSetAttribute((const void*)mk_fwd<COOP>, hipFuncAttributeMaxDynamicSharedMemorySize, LDS_BYTES) != hipSuccess) { fprintf(stderr, "kernel_launch: hipFuncSetAttribute failed\n"); grid = -1; return; }
        if (hipOccupancyMaxActiveBlocksPerMultiprocessor(&per_cu, (const void*)mk_fwd<COOP>, NWAVES * 64, LDS_BYTES) != hipSuccess || per_cu < 1) { fprintf(stderr, "kernel_launch: occupancy query says %d\n", per_cu); per_cu = 1; }
        (void)hipGetLastError();
        grid = cus;
    }
    if (grid < 0) return;
    if (hipMemsetAsync((char*)d_ws + WS_CTL, 0, CTL_ZERO_BYTES, stream) != hipSuccess) { fprintf(stderr, "kernel_launch: memset failed\n"); return; }
    Args a{};
    for (int i = 0; i < 16; ++i) a.in[i] = (const float*)d_in[i];
    a.out = (float*)d_out; a.ws = (unsigned char*)d_ws;
    if (COOP) {
        a.ph_lo = 0; a.ph_hi = N_PHASES;
        void* kargs[] = {&a};
        const hipError_t e = hipLaunchCooperativeKernel((const void*)mk_fwd<COOP>, dim3(grid), dim3(NWAVES * 64), kargs, LDS_BYTES, stream);
        if (e != hipSuccess) fprintf(stderr, "kernel_launch: cooperative launch failed: %s (grid %d)\n", hipGetErrorString(e), grid);
    } else {
        for (int p = 0; p < N_PHASES; ++p) { a.ph_lo = p; a.ph_hi = p + 1; hipLaunchKernelGGL(mk_fwd<COOP>, dim3(grid), dim3(NWAVES * 64), LDS_BYTES, stream, a); }
    }
}
```

```cpp
#include <hip/hip_runtime.h>
#include <hip/hip_cooperative_groups.h>
#include <cstdio>
#include <cstdint>
#include <cmath>
namespace cg = cooperative_groups;

#ifndef MK_MULTI
#define MK_MULTI 0
#endif

namespace pg8 {
#define PG8_LAS __attribute__((address_space(3)))
typedef unsigned short bf16_t;
typedef short bf16x8 __attribute__((ext_vector_type(8)));
typedef float f32x4 __attribute__((ext_vector_type(4)));
typedef unsigned u32x4 __attribute__((ext_vector_type(4)));
constexpr int BM = 256, BK = 64, HALF = 128, HTB = HALF * BK * 2  , STAGE_BYTES = 8 * HTB, NXCD = 8, WGM = 8;

__host__ __device__ __forceinline__ int lds_byte(int r, int c) { const int st = (r >> 4) * 2 + (c >> 5), rr = r & 15, cc = c & 31, ob = rr * 64 + cc * 2; return st * 1024 + (ob ^ (((ob >> 9) & 1) << 5)); }
__host__ __device__ __forceinline__ void stage_rc(int b, int& R, int& C) { const int st = b / 1024, sb = b % 1024, swz = sb ^ (((sb >> 9) & 1) << 5); R = (st >> 1) * 16 + swz / 64; C = (st & 1) * 32 + (swz % 64) / 2; }
__host__ __device__ __forceinline__ int perm32(int rho) { const int n = rho >> 4, i = rho & 15; return 8 * (i >> 2) + 4 * n + (i & 3); }

struct Unit { int pm, pn; };
struct Gemm { const bf16_t* A; const bf16_t* Bt; int M, N, K; };

struct StaticOrder {
    int nM, nN, nwg, G, c;
    __host__ __device__ void init(int M, int N, int G_, int c_) { nM = M / BM; nN = N / BM; nwg = nM * nN; G = G_; c = c_; }
    __host__ __device__ bool next(int i, Unit& u) const {
        const long L = (long)i * G + c; if (L >= nwg) return false;
        int wgid = (int)L; { const int q = nwg / NXCD, r = nwg % NXCD, xcd = wgid % NXCD, off = wgid / NXCD; wgid = (xcd < r ? xcd * (q + 1) : r * (q + 1) + (xcd - r) * q) + off; }
        const int nig = WGM * nN, gid = wgid / nig, fm = gid * WGM, gsz = (nM - fm) < WGM ? (nM - fm) : WGM;
        u.pm = fm + ((wgid % nig) % gsz); u.pn = (wgid % nig) / gsz; return true;
    }
    __device__ __forceinline__ void a_ready(const Unit&) const {}
    __device__ __forceinline__ void done(const Unit&) const {}
};
__device__ __forceinline__ unsigned cvt_pk_bf16(float lo, float hi) { unsigned r; asm volatile("v_cvt_pk_bf16_f32 %0, %1, %2" : "=v"(r) : "v"(lo), "v"(hi)); return r; }
template <class Epi, class Sched, bool ALIGN_EPI = false, bool SP2 = false>
__device__ __forceinline__ void gemm_phase(PG8_LAS unsigned char* lds, const Gemm g, const Sched& S, const Epi& E) {
    const int tid = threadIdx.x, wid = __builtin_amdgcn_readfirstlane(tid >> 6), lane = tid & 63, wr = wid >> 2, wc = wid & 3, fr = lane & 15, fq = lane >> 4;
    const int K = g.K, nt = K / BK;
    unsigned voffA[2], voffB[2];
#pragma unroll
    for (int i = 0; i < 2; ++i) { int R, C; stage_rc(tid * 16 + i * 8192, R, C); const int Rb = Epi::PERM ? ((R & ~31) + perm32(R & 31)) : R;
        voffA[i] = (unsigned)(R * K + C) * 2u; voffB[i] = (unsigned)(Rb * K + C) * 2u; }
    const size_t kstep = (size_t)(BK * 2);
    const size_t hstep = (size_t)HALF * K * 2;
    const size_t tstep = 2 * hstep;
    const unsigned ldsw = (unsigned)wid * 1024u;
    const int aoff = lds_byte(wr * 64 + fr, fq * 8), boff = lds_byte(wc * 32 + fr, fq * 8);
#define PG8_SA(b, h) (((b) * 2 + (h)) * HTB)
#define PG8_SB(b, h) ((4 + (b) * 2 + (h)) * HTB)
#define PG8_STAGE(bufoff, gbase, voff) do { _Pragma("unroll") for (int _i = 0; _i < 2; ++_i) \
        __builtin_amdgcn_global_load_lds((const unsigned*)((const char*)(gbase) + (voff)[_i]), (PG8_LAS unsigned*)(lds + (bufoff) + ldsw + _i * 8192), 16, 0, 0); } while (0)
#define PG8_LDA(dst, b, h) do { _Pragma("unroll") for (int m = 0; m < 4; ++m) _Pragma("unroll") for (int k = 0; k < 2; ++k) dst[m][k] = *(const PG8_LAS bf16x8*)(lds + PG8_SA(b, h) + aoff + m * 2048 + k * 1024); } while (0)
#define PG8_LDB(dst, b, h) do { _Pragma("unroll") for (int n = 0; n < 2; ++n) _Pragma("unroll") for (int k = 0; k < 2; ++k) dst[n][k] = *(const PG8_LAS bf16x8*)(lds + PG8_SB(b, h) + boff + n * 2048 + k * 1024); } while (0)
#define PG8_MMA(ai, bj, At, Bt) do { __builtin_amdgcn_s_setprio(1); _Pragma("unroll") for (int m = 0; m < 4; ++m) _Pragma("unroll") for (int n = 0; n < 2; ++n) _Pragma("unroll") for (int k = 0; k < 2; ++k) \
        acc[ai][bj][m][n] = __builtin_amdgcn_mfma_f32_16x16x32_bf16(Bt[n][k], At[m][k], acc[ai][bj][m][n], 0, 0, 0); __builtin_amdgcn_s_setprio(0); } while (0)
#define PG8_WAIT_V(n) asm volatile("s_waitcnt vmcnt(" #n ")" ::: "memory")
#define PG8_WAIT_L(n) asm volatile("s_waitcnt lgkmcnt(" #n ")" ::: "memory")
#define PG8_BAR __builtin_amdgcn_s_barrier()
#define PG8_SCHED __builtin_amdgcn_sched_barrier(0)
    Unit cur, nxt; int ui = 0;
    if (!S.next(0, cur)) return;
    f32x4 acc[2][2][4][2];
#pragma unroll
    for (int a = 0; a < 2; ++a)
#pragma unroll
        for (int b = 0; b < 2; ++b)
#pragma unroll
            for (int m = 0; m < 4; ++m)
#pragma unroll
                for (int n = 0; n < 2; ++n) acc[a][b][m][n] = (f32x4){0.f, 0.f, 0.f, 0.f};
    bf16x8 At[4][2], B0[2][2], B1[2][2];
    const char* cA = (const char*)g.A + (size_t)cur.pm * tstep; const char* cB = (const char*)g.Bt + (size_t)cur.pn * tstep;
    S.a_ready(cur);
    if constexpr (SP2) {
        PG8_STAGE(PG8_SB(0, 0), cB, voffB); PG8_STAGE(PG8_SB(0, 1), cB + hstep, voffB); PG8_STAGE(PG8_SA(0, 0), cA, voffA); PG8_STAGE(PG8_SA(0, 1), cA + hstep, voffA);
        if (wr == 1) PG8_BAR;
        PG8_WAIT_V(2); PG8_BAR;
        PG8_STAGE(PG8_SB(1, 0), cB + kstep, voffB); PG8_STAGE(PG8_SA(1, 0), cA + kstep, voffA); PG8_STAGE(PG8_SB(1, 1), cB + hstep + kstep, voffB);
        PG8_WAIT_V(6); PG8_BAR;
    } else {
        PG8_STAGE(PG8_SB(0, 0), cB, voffB); PG8_STAGE(PG8_SA(0, 0), cA, voffA); PG8_STAGE(PG8_SB(0, 1), cB + hstep, voffB); PG8_STAGE(PG8_SA(0, 1), cA + hstep, voffA);
        if (wr == 1) PG8_BAR;
        PG8_WAIT_V(4); PG8_BAR;
        PG8_STAGE(PG8_SB(1, 0), cB + kstep, voffB); PG8_STAGE(PG8_SA(1, 0), cA + kstep, voffA); PG8_STAGE(PG8_SB(1, 1), cB + hstep + kstep, voffB);
        PG8_WAIT_V(6); PG8_BAR;
    }
    for (;;) {
        const bool has_next = S.next(ui + 1, nxt);
        const char* nA = has_next ? (const char*)g.A + (size_t)nxt.pm * tstep : cA; const char* nB = has_next ? (const char*)g.Bt + (size_t)nxt.pn * tstep : cB;
        for (int t = 0; t < nt; t += 2) {
            const bool last = (t == nt - 2);
            const char* a1 = cA + (size_t)(t + 1) * kstep;
            const char* a2 = last ? nA : cA + (size_t)(t + 2) * kstep; const char* b2 = last ? nB : cB + (size_t)(t + 2) * kstep;
            const char* a3 = a2 + kstep; const char* b3 = b2 + kstep;
            if (last && has_next) S.a_ready(nxt);
            if constexpr (SP2) {
            PG8_LDB(B0, 0, 0); PG8_LDB(B1, 0, 1); PG8_SCHED; PG8_LDA(At, 0, 0); PG8_STAGE(PG8_SA(1, 1), a1 + hstep, voffA);
            PG8_WAIT_V(8); PG8_WAIT_L(0); PG8_BAR; PG8_MMA(0, 0, At, B0); PG8_MMA(0, 1, At, B1); PG8_BAR; PG8_SCHED;
            PG8_LDA(At, 0, 1); PG8_STAGE(PG8_SB(0, 0), b2, voffB); PG8_STAGE(PG8_SB(0, 1), b2 + hstep, voffB); PG8_STAGE(PG8_SA(0, 0), a2, voffA);
            PG8_WAIT_V(8); PG8_WAIT_L(0); PG8_BAR; PG8_MMA(1, 0, At, B0); PG8_MMA(1, 1, At, B1); PG8_BAR; PG8_SCHED;
            PG8_LDB(B0, 1, 0); PG8_LDB(B1, 1, 1); PG8_SCHED; PG8_LDA(At, 1, 0); PG8_STAGE(PG8_SA(0, 1), a2 + hstep, voffA);
            PG8_WAIT_V(8); PG8_WAIT_L(0); PG8_BAR; PG8_MMA(0, 0, At, B0); PG8_MMA(0, 1, At, B1); PG8_BAR; PG8_SCHED;
            PG8_LDA(At, 1, 1); PG8_STAGE(PG8_SB(1, 0), b3, voffB); PG8_STAGE(PG8_SB(1, 1), b3 + hstep, voffB); PG8_STAGE(PG8_SA(1, 0), a3, voffA);
            PG8_WAIT_V(8); PG8_WAIT_L(0); PG8_BAR; PG8_MMA(1, 0, At, B0); PG8_MMA(1, 1, At, B1); PG8_BAR; PG8_SCHED;
            } else {
            PG8_LDB(B0, 0, 0); PG8_SCHED; PG8_LDA(At, 0, 0); PG8_STAGE(PG8_SA(1, 1), a1 + hstep, voffA);
            PG8_WAIT_L(8); PG8_BAR; PG8_WAIT_L(0); PG8_MMA(0, 0, At, B0); PG8_BAR; PG8_SCHED;
            PG8_LDB(B1, 0, 1); PG8_STAGE(PG8_SB(0, 0), b2, voffB);
            PG8_BAR; PG8_WAIT_L(0); PG8_MMA(0, 1, At, B1); PG8_BAR;
            PG8_LDA(At, 0, 1); PG8_STAGE(PG8_SA(0, 0), a2, voffA);
            PG8_BAR; PG8_WAIT_L(0); PG8_MMA(1, 0, At, B0); PG8_BAR; PG8_SCHED;
            PG8_STAGE(PG8_SB(0, 1), b2 + hstep, voffB);
            PG8_WAIT_V(6); PG8_BAR; PG8_MMA(1, 1, At, B1); PG8_BAR;
            PG8_LDB(B0, 1, 0); PG8_SCHED; PG8_LDA(At, 1, 0); PG8_STAGE(PG8_SA(0, 1), a2 + hstep, voffA);
            PG8_WAIT_L(8); PG8_BAR; PG8_WAIT_L(0); PG8_MMA(0, 0, At, B0); PG8_BAR; PG8_SCHED;
            PG8_LDB(B1, 1, 1); PG8_STAGE(PG8_SB(1, 0), b3, voffB);
            PG8_BAR; PG8_WAIT_L(0); PG8_MMA(0, 1, At, B1); PG8_BAR;
            PG8_LDA(At, 1, 1); PG8_STAGE(PG8_SA(1, 0), a3, voffA);
            PG8_BAR; PG8_WAIT_L(0); PG8_MMA(1, 0, At, B0); PG8_BAR; PG8_SCHED;
            PG8_STAGE(PG8_SB(1, 1), b3 + hstep, voffB);
            PG8_WAIT_V(6); PG8_BAR; PG8_MMA(1, 1, At, B1); PG8_BAR;
            }
        }
        if constexpr (ALIGN_EPI) { if (wr == 0) PG8_BAR; }
        if constexpr (!Epi::AFTER_DRAIN) { E(acc, cur, wr, wc, fr, fq); S.done(cur); }
        if (!has_next) break;
#pragma unroll
        for (int a = 0; a < 2; ++a)
#pragma unroll
            for (int b = 0; b < 2; ++b)
#pragma unroll
                for (int m = 0; m < 4; ++m)
#pragma unroll
                    for (int n = 0; n < 2; ++n) acc[a][b][m][n] = (f32x4){0.f, 0.f, 0.f, 0.f};
        cur = nxt; cA = nA; cB = nB; ++ui;
        if constexpr (ALIGN_EPI) { if (wr == 1) PG8_BAR; }
    }
    PG8_WAIT_V(0);
    if constexpr (!ALIGN_EPI) { if (wr == 0) PG8_BAR; }
    PG8_BAR;
    if constexpr (Epi::AFTER_DRAIN) { E.fused(acc, cur, wr, wc, fr, fq, lds, wid, lane); S.done(cur); }
#undef PG8_SA
#undef PG8_SB
#undef PG8_STAGE
#undef PG8_LDA
#undef PG8_LDB
#undef PG8_MMA
#undef PG8_WAIT_V
#undef PG8_WAIT_L
#undef PG8_BAR
#undef PG8_SCHED
}
}

constexpr int NB = 16, SEQ = 2048, DM = 1024, TOK = NB * SEQ;
constexpr int EVEN_IN = 3080, EVEN_PAD = 3328;
constexpr int NEXP = 16384;
constexpr float RMS_EPS = 1e-6f;
constexpr float LOG2E = 1.4426950408889634f;
constexpr float C2 = 0.125f * LOG2E;

constexpr size_t MiB = 1u << 20;
constexpr size_t WS_CTL = 0, CTL_ZERO_BYTES = 1 * MiB;
constexpr size_t WS_W1T = 1 * MiB;
constexpr size_t WS_W2T = 8 * MiB;
constexpr size_t WS_W4T = 10 * MiB;
constexpr size_t WS_W5T = 14 * MiB;
constexpr size_t WS_W3T = 16 * MiB;
constexpr size_t WS_W6T = 20 * MiB;
constexpr size_t WS_K1B = 24 * MiB;
constexpr size_t WS_K2B = 24 * MiB + 512 * 1024;
constexpr size_t WS_PWT = 25 * MiB;
constexpr size_t WS_LF  = 25 * MiB + 256 * 1024;
constexpr size_t WS_CF  = 26 * MiB + 256 * 1024;
constexpr size_t WS_KMEAN = 27 * MiB + 256 * 1024;
constexpr size_t WS_RS0 = 27 * MiB + 512 * 1024;
constexpr size_t WS_RS2 = 27 * MiB + 640 * 1024;
constexpr size_t WS_SSQ1 = 28 * MiB;
constexpr size_t WS_SSQ3 = 30 * MiB;
constexpr size_t WS_U8S = 32 * MiB;
constexpr size_t WS_V8S = 64 * MiB;
constexpr size_t WS_XB = 160 * MiB;
constexpr size_t WS_QH = 224 * MiB;
constexpr size_t WS_KH = 288 * MiB;
constexpr size_t WS_VT = 352 * MiB;
constexpr size_t WS_QP = 224 * MiB;
constexpr size_t WS_AO = 416 * MiB;
constexpr size_t WS_EID = 480 * MiB;
constexpr size_t WS_GATE = 488 * MiB;
constexpr size_t WS_SSQ2 = 504 * MiB;
constexpr size_t WS_PREP = 224 * MiB;
constexpr size_t WS_ACO = 416 * MiB;
constexpr size_t WS_END = 506 * MiB;

constexpr int RING_BYTES = 131072;
constexpr int LDS_BYTES = 147456;
constexpr int NWAVES = 8;

#define GAS __attribute__((address_space(1)))
#define LAS __attribute__((address_space(3)))
typedef unsigned short bf16_t;
typedef unsigned u32x4 __attribute__((ext_vector_type(4)));
typedef unsigned u32x2 __attribute__((ext_vector_type(2)));
typedef float f32x4 __attribute__((ext_vector_type(4)));
typedef float f32x16 __attribute__((ext_vector_type(16)));
typedef short bf16x8 __attribute__((ext_vector_type(8)));
typedef __bf16 bf16x2 __attribute__((ext_vector_type(2)));
#define LDS_WAIT() asm volatile("s_waitcnt lgkmcnt(0)" ::: "memory")

__device__ __forceinline__ int opaque_i(int v) { asm volatile("" : "+v"(v)); return v; }
__device__ __forceinline__ unsigned f2bf(float f) { unsigned u = __builtin_bit_cast(unsigned, f); return (u + 0x7fffu + ((u >> 16) & 1u)) >> 16; }
typedef float f32x2_pk __attribute__((ext_vector_type(2)));
__device__ __forceinline__ unsigned pk2(float lo, float hi) { const f32x2_pk v = {lo, hi}; return __builtin_bit_cast(unsigned, __builtin_convertvector(v, bf16x2)); }
__device__ __forceinline__ float bf_lo(unsigned u) { return __uint_as_float(u << 16); }
__device__ __forceinline__ float bf_hi(unsigned u) { return __uint_as_float(u & 0xffff0000u); }
__device__ __forceinline__ float dot2(unsigned a, unsigned b, float acc) { return __builtin_amdgcn_fdot2_f32_bf16(__builtin_bit_cast(bf16x2, a), __builtin_bit_cast(bf16x2, b), acc, false); }
__device__ __forceinline__ float dot8(u32x4 a, u32x4 b, float acc) { acc = dot2(a.x, b.x, acc); acc = dot2(a.y, b.y, acc); acc = dot2(a.z, b.z, acc); return dot2(a.w, b.w, acc); }
__device__ __forceinline__ u32x4 pack8(f32x4 a, f32x4 b) { u32x4 w; w.x = pk2(a[0], a[1]); w.y = pk2(a[2], a[3]); w.z = pk2(b[0], b[1]); w.w = pk2(b[2], b[3]); return w; }

__device__ __forceinline__ float wave_sum(float v) {
#pragma unroll
    for (int o = 1; o < 64; o <<= 1) v += __shfl_xor(v, o);
    return v;
}
__device__ __forceinline__ float wave_max(float v) {
#pragma unroll
    for (int o = 1; o < 64; o <<= 1) v = fmaxf(v, __shfl_xor(v, o));
    return v;
}
__device__ __forceinline__ unsigned wave_umax(unsigned v) {
#pragma unroll
    for (int o = 1; o < 64; o <<= 1) { const unsigned w = (unsigned)__shfl_xor((int)v, o); v = v > w ? v : w; }
    return v;
}
__device__ __forceinline__ float dpp_row_shr(float v, int n) {
    const int iv = __builtin_bit_cast(int, v); int r;
    switch (n) { case 1: r = __builtin_amdgcn_update_dpp(0, iv, 0x111, 0xf, 0xf, true); break; case 2: r = __builtin_amdgcn_update_dpp(0, iv, 0x112, 0xf, 0xf, true); break;
                 case 4: r = __builtin_amdgcn_update_dpp(0, iv, 0x114, 0xf, 0xf, true); break; default: r = __builtin_amdgcn_update_dpp(0, iv, 0x118, 0xf, 0xf, true); break; }
    return __builtin_bit_cast(float, r);
}
__device__ __forceinline__ float wave_total(float v) {
    v += dpp_row_shr(v, 1); v += dpp_row_shr(v, 2); v += dpp_row_shr(v, 4); v += dpp_row_shr(v, 8);
    v += __builtin_bit_cast(float, __builtin_amdgcn_update_dpp(0, __builtin_bit_cast(int, v), 0x142, 0xa, 0xf, false));
    v += __builtin_bit_cast(float, __builtin_amdgcn_update_dpp(0, __builtin_bit_cast(int, v), 0x143, 0xc, 0xf, false));
    return __builtin_bit_cast(float, __builtin_amdgcn_readlane(__builtin_bit_cast(int, v), 63));
}
__device__ __forceinline__ unsigned f2ord(float f) { const unsigned u = __float_as_uint(f); return u ^ ((unsigned)((int)u >> 31) | 0x80000000u); }
__device__ __forceinline__ float ord2f(unsigned o) { return __uint_as_float(o ^ (~(unsigned)((int)o >> 31) | 0x80000000u)); }

__device__ __forceinline__ float row_scale(const float* p, int mode, int t) {
    if (mode == 0) return p[t];
    const f32x4* q = (const f32x4*)(p + (size_t)t * 16); const f32x4 a = q[0], b = q[1], c = q[2], d = q[3];
    const float s = (((a[0] + a[1]) + (a[2] + a[3])) + ((b[0] + b[1]) + (b[2] + b[3]))) + (((c[0] + c[1]) + (c[2] + c[3])) + ((d[0] + d[1]) + (d[2] + d[3])));
    return rsqrtf(s * (1.f / DM) + RMS_EPS);
}

struct EpiL0In {
    static constexpr bool PERM = true, AFTER_DRAIN = false;
    const float* rs; bf16_t* QH; bf16_t* KH; bf16_t* VT; float* LF; const float* b_f;
    __device__ __forceinline__ void operator()(const f32x4 (&acc)[2][2][4][2], const pg8::Unit& u, int wr, int wc, int fr, int fq) const {
        const int pn = u.pn;
        if (pn == 12) {
            if (wc == 0 && fq == 0) {
#pragma unroll
                for (int ai = 0; ai < 2; ++ai)
#pragma unroll
                    for (int m = 0; m < 4; ++m) {
                        const int t = u.pm * 256 + ai * 128 + wr * 64 + m * 16 + fr; const float sc = rs[t]; const int b = t >> 11, s = t & 2047;
#pragma unroll
                        for (int n = 0; n < 2; ++n)
#pragma unroll
                            for (int e = 0; e < 4; ++e) { const int h = n * 4 + e; const float x = acc[ai][0][m][n][e] * sc + b_f[h];
                                const float ls = fminf(x, 0.f) - log1pf(expf(-fabsf(x)));
                                LF[(size_t)(b * 8 + h) * 2048 + s] = ls * LOG2E; }
                    }
            }
            return;
        }
        const int sec = pn >> 1, kind = sec % 3, hbase = (sec >= 3) ? 8 : 0;
#pragma unroll
        for (int ai = 0; ai < 2; ++ai)
#pragma unroll
            for (int m = 0; m < 4; ++m) {
                const int t = u.pm * 256 + ai * 128 + wr * 64 + m * 16 + fr; const int b = t >> 11, s = t & 2047;
                const float sc = rs[t] * (kind == 0 ? C2 : 1.f);
#pragma unroll
                for (int bj = 0; bj < 2; ++bj) {
                    const int cc = (pn & 1) * 256 + bj * 128 + wc * 32 + fq * 8, hh = hbase + (cc >> 6), d0 = cc & 63;
                    const f32x4 v0 = acc[ai][bj][m][0] * sc, v1 = acc[ai][bj][m][1] * sc;
                    if (kind < 2) { bf16_t* dst = (kind == 0 ? QH : KH) + ((size_t)(b * 16 + hh) * 2048 + s) * 64 + d0; __builtin_nontemporal_store(pack8(v0, v1), (u32x4*)dst); }
                    else { bf16_t* dst = VT + ((size_t)(b * 16 + hh) * 64 + d0) * 2048 + s;
                        dst[0 * 2048] = (bf16_t)f2bf(v0[0]); dst[1 * 2048] = (bf16_t)f2bf(v0[1]); dst[2 * 2048] = (bf16_t)f2bf(v0[2]); dst[3 * 2048] = (bf16_t)f2bf(v0[3]);
                        dst[4 * 2048] = (bf16_t)f2bf(v1[0]); dst[5 * 2048] = (bf16_t)f2bf(v1[1]); dst[6 * 2048] = (bf16_t)f2bf(v1[2]); dst[7 * 2048] = (bf16_t)f2bf(v1[3]); }
                }
            }
    }
};
struct EpiL1In {
    static constexpr bool PERM = true, AFTER_DRAIN = false;
    const float* rsp; int rsmode; bf16_t* XC; bf16_t* QD; bf16_t* KD; bf16_t* VTD;
    __device__ __forceinline__ void operator()(const f32x4 (&acc)[2][2][4][2], const pg8::Unit& u, int wr, int wc, int fr, int fq) const {
        const int pn = u.pn, kind = pn >> 1;
#pragma unroll
        for (int ai = 0; ai < 2; ++ai)
#pragma unroll
            for (int m = 0; m < 4; ++m) {
                const int t = u.pm * 256 + ai * 128 + wr * 64 + m * 16 + fr; const int b = t >> 11, s = t & 2047;
                const float sc = row_scale(rsp, rsmode, t) * (kind == 1 ? C2 : 1.f);
#pragma unroll
                for (int bj = 0; bj < 2; ++bj) {
                    const int cc = (pn & 1) * 256 + bj * 128 + wc * 32 + fq * 8, hh = cc >> 6, d0 = cc & 63;
                    const f32x4 v0 = acc[ai][bj][m][0] * sc, v1 = acc[ai][bj][m][1] * sc;
                    if (kind == 0) { __builtin_nontemporal_store(pack8(v0, v1), (u32x4*)(XC + (size_t)t * 512 + cc)); }
                    else if (kind < 3) { bf16_t* dst = (kind == 1 ? QD : KD) + ((size_t)(b * 8 + hh) * 2048 + s) * 64 + d0; __builtin_nontemporal_store(pack8(v0, v1), (u32x4*)dst); }
                    else { bf16_t* dst = VTD + ((size_t)(b * 8 + hh) * 64 + d0) * 2048 + s;
                        dst[0 * 2048] = (bf16_t)f2bf(v0[0]); dst[1 * 2048] = (bf16_t)f2bf(v0[1]); dst[2 * 2048] = (bf16_t)f2bf(v0[2]); dst[3 * 2048] = (bf16_t)f2bf(v0[3]);
                        dst[4 * 2048] = (bf16_t)f2bf(v1[0]); dst[5 * 2048] = (bf16_t)f2bf(v1[1]); dst[6 * 2048] = (bf16_t)f2bf(v1[2]); dst[7 * 2048] = (bf16_t)f2bf(v1[3]); }
                }
            }
    }
};
struct EpiQ {
    static constexpr bool PERM = true, AFTER_DRAIN = false;
    const float* rsp; int rsmode; bf16_t* Q;
    __device__ __forceinline__ void operator()(const f32x4 (&acc)[2][2][4][2], const pg8::Unit& u, int wr, int wc, int fr, int fq) const {
#pragma unroll
        for (int ai = 0; ai < 2; ++ai)
#pragma unroll
            for (int m = 0; m < 4; ++m) {
                const int t = u.pm * 256 + ai * 128 + wr * 64 + m * 16 + fr; const float sc = row_scale(rsp, rsmode, t);
#pragma unroll
                for (int bj = 0; bj < 2; ++bj) { const int c = u.pn * 256 + bj * 128 + wc * 32 + fq * 8;
                    __builtin_nontemporal_store(pack8(acc[ai][bj][m][0] * sc, acc[ai][bj][m][1] * sc), (u32x4*)(Q + (size_t)t * 2048 + c)); }
            }
    }
};
template <bool BASE_BF16>
struct EpiRes {
    static constexpr bool PERM = true, AFTER_DRAIN = false;
    const void* base; bf16_t* xb; float* ssqp;
    __device__ __forceinline__ void operator()(const f32x4 (&acc)[2][2][4][2], const pg8::Unit& u, int wr, int wc, int fr, int fq) const {
#pragma unroll
        for (int ai = 0; ai < 2; ++ai)
#pragma unroll
            for (int m = 0; m < 4; ++m) {
                const int t = u.pm * 256 + ai * 128 + wr * 64 + m * 16 + fr; float ss = 0.f;
#pragma unroll
                for (int bj = 0; bj < 2; ++bj) { const size_t off = (size_t)t * DM + u.pn * 256 + bj * 128 + wc * 32 + fq * 8;
                    f32x4 b0, b1;
                    if (BASE_BF16) { const u32x4 w = *(const u32x4*)((const bf16_t*)base + off); b0 = (f32x4){bf_lo(w.x), bf_hi(w.x), bf_lo(w.y), bf_hi(w.y)}; b1 = (f32x4){bf_lo(w.z), bf_hi(w.z), bf_lo(w.w), bf_hi(w.w)}; }
                    else { b0 = *(const f32x4*)((const float*)base + off); b1 = *(const f32x4*)((const float*)base + off + 4); }
                    const f32x4 o0 = b0 + acc[ai][bj][m][0], o1 = b1 + acc[ai][bj][m][1];
                    __builtin_nontemporal_store(pack8(o0, o1), (u32x4*)(xb + off));
                    ss += (o0[0] * o0[0] + o0[1] * o0[1]) + (o0[2] * o0[2] + o0[3] * o0[3]) + (o1[0] * o1[0] + o1[1] * o1[1]) + (o1[2] * o1[2] + o1[3] * o1[3]); }
                ss += __shfl_xor(ss, 16); ss += __shfl_xor(ss, 32);
                if (fq == 0) ssqp[(size_t)t * 16 + u.pn * 4 + wc] = ss;
            }
    }
};

#define XB_TMO      128
#define XB_XCNT(j)  (256  + 64 * (j))
#define XB_XSUB(j)  (1280 + 64 * (j))
#define XB_XGEN(j)  (2304 + 64 * (j))
#define XB_TOP      3328
#define XB_TOPGEN   3392
#define XCD_BAR_WORDS 3456
#define XB_SPIN_CAP (1u << 18)

__device__ __forceinline__ unsigned xb_ld(unsigned* p)              { return __hip_atomic_load(p, __ATOMIC_RELAXED, __HIP_MEMORY_SCOPE_AGENT); }
__device__ __forceinline__ unsigned xb_add(unsigned* p, unsigned v) { return __hip_atomic_fetch_add(p, v, __ATOMIC_RELAXED, __HIP_MEMORY_SCOPE_AGENT); }
__device__ __forceinline__ unsigned xb_xcc_id() { return (unsigned)__builtin_amdgcn_s_getreg((3 << 11) | 20) & 0xFu; }
#define XB_SPIN(cond, bar) do { unsigned _sp = 0; while (cond) { __builtin_amdgcn_s_sleep(1); \
    if ((++_sp & 255u) == 0u) { if (xb_ld(&(bar)[XB_TMO])) break; if (_sp > XB_SPIN_CAP) { atomicAdd(&(bar)[XB_TMO], 1u); break; } } } } while (0)

struct XcdBarrier {
    unsigned* bar; unsigned x;
    volatile LAS unsigned* st;
};

__device__ __forceinline__ XcdBarrier xcd_barrier_post(unsigned* bar, volatile LAS unsigned* st) {
    XcdBarrier b; b.bar = bar; b.x = xb_xcc_id(); b.st = st;
    if (threadIdx.x == 0) (void)xb_add(&bar[XB_XCNT(b.x)], 1u);
    return b;
}
__device__ __forceinline__ void xcd_barrier_complete(unsigned* bar, unsigned x, unsigned& nloc, unsigned& nx) {
    const unsigned G = gridDim.x * gridDim.y * gridDim.z;
    unsigned sum, cnt, mine, sp = 0u;
    for (;;) {
        sum = 0u; cnt = 0u; mine = 0u;
#pragma unroll
        for (unsigned j = 0; j < 16; ++j) { const unsigned c = xb_ld(&bar[XB_XCNT(j)]); sum += c; cnt += (c > 0u) ? 1u : 0u; mine = (j == x) ? c : mine; }
        if (sum == G) break;
        __builtin_amdgcn_s_sleep(1);
        if ((++sp & 255u) == 0u) { if (xb_ld(&bar[XB_TMO])) break; if (sp > XB_SPIN_CAP) { atomicAdd(&bar[XB_TMO], 1u); break; } }
    }
    nloc = mine > 0u ? mine : 1u; nx = cnt > 0u ? cnt : 1u;
}

__device__ __forceinline__ void xcd_barrier(const XcdBarrier& b) {
    asm volatile("s_waitcnt vmcnt(0)" ::: "memory");
    __syncthreads();
    if (threadIdx.x == 0) {
        unsigned* bar = b.bar;
        __builtin_amdgcn_s_waitcnt(0);
        unsigned nloc = b.st[0], nx = b.st[1];
        if (nloc == 0u) { xcd_barrier_complete(bar, b.x, nloc, nx); b.st[0] = nloc; b.st[1] = nx; }
        const unsigned old = xb_add(&bar[XB_XSUB(b.x)], 1u);
        const unsigned gen = old / nloc;
        if (old + 1u == (gen + 1u) * nloc) {
            __builtin_amdgcn_fence(__ATOMIC_RELEASE, "agent");
            asm volatile("s_waitcnt vmcnt(0)" ::: "memory");
            const unsigned og = xb_add(&bar[XB_TOP], 1u);
            const unsigned tg = og / nx;
            if (og + 1u == (tg + 1u) * nx) xb_add(&bar[XB_TOPGEN], 1u);
            else XB_SPIN(xb_ld(&bar[XB_TOPGEN]) == tg, bar);
            __builtin_amdgcn_fence(__ATOMIC_ACQUIRE, "agent");
            xb_add(&bar[XB_XGEN(b.x)], 1u);
            asm volatile("s_waitcnt vmcnt(0)" ::: "memory");
        } else {
            XB_SPIN(xb_ld(&bar[XB_XGEN(b.x)]) == gen, bar);
            __builtin_amdgcn_fence(__ATOMIC_ACQUIRE, "agent");
            asm volatile("s_waitcnt vmcnt(0)" ::: "memory");
        }
    }
    __syncthreads();
}

struct Frame {
    LAS unsigned char* lds;
    int tid, lane, wave, vcu, G;
};

__device__ __forceinline__ int remap0(int n) { return n < 1536 ? n : (n < 1544 ? 3072 + (n - 1536) : n - 8); }
__device__ __forceinline__ void p0_transpose_item(const float* W, int K, int N, bf16_t* WT, const float* g, bool remap, LAS float* scr, int item, int lane) {
    const int nblk = (N + 31) / 32, kb = item / nblk, nb = item % nblk, k0 = 64 * kb, n0 = 32 * nb;
#pragma unroll 8
    for (int i = 0; i < 32; ++i) { const int kk = 2 * i + (lane >> 5), n = n0 + (lane & 31);
        float v = (n < N) ? W[(size_t)(k0 + kk) * N + n] : 0.f; if (g) v *= g[k0 + kk]; scr[kk * 33 + (lane & 31)] = v; }
    LDS_WAIT(); asm volatile("" ::: "memory");
    const int c = lane & 7;
#pragma unroll
    for (int j = 0; j < 4; ++j) { const int nl = (lane >> 3) + 8 * j, n = n0 + nl; const LAS float* s = scr + (8 * c) * 33 + nl;
        u32x4 o; o.x = pk2(s[0 * 33], s[1 * 33]); o.y = pk2(s[2 * 33], s[3 * 33]); o.z = pk2(s[4 * 33], s[5 * 33]); o.w = pk2(s[6 * 33], s[7 * 33]);
        if (n < N) { const int nn = remap ? remap0(n) : n; *(u32x4*)(WT + (size_t)nn * K + k0 + 8 * c) = o; } }
    LDS_WAIT(); asm volatile("" ::: "memory");
}
__device__ __forceinline__ float cvt_row_1024(const float* src, bf16_t* dst, const float* g, int lane) {
    const f32x4 a0 = *(const f32x4*)(src + 8 * lane), a1 = *(const f32x4*)(src + 8 * lane + 4), c0 = *(const f32x4*)(src + 512 + 8 * lane), c1 = *(const f32x4*)(src + 516 + 8 * lane);
    float ss = (a0[0] * a0[0] + a0[1] * a0[1]) + (a0[2] * a0[2] + a0[3] * a0[3]) + (a1[0] * a1[0] + a1[1] * a1[1]) + (a1[2] * a1[2] + a1[3] * a1[3])
             + (c0[0] * c0[0] + c0[1] * c0[1]) + (c0[2] * c0[2] + c0[3] * c0[3]) + (c1[0] * c1[0] + c1[1] * c1[1]) + (c1[2] * c1[2] + c1[3] * c1[3]);
    f32x4 b0 = a0, b1 = a1, d0 = c0, d1 = c1;
    if (g) { b0 = b0 * *(const f32x4*)(g + 8 * lane); b1 = b1 * *(const f32x4*)(g + 8 * lane + 4); d0 = d0 * *(const f32x4*)(g + 512 + 8 * lane); d1 = d1 * *(const f32x4*)(g + 516 + 8 * lane); }
    *(u32x4*)(dst + 8 * lane) = pack8(b0, b1); *(u32x4*)(dst + 512 + 8 * lane) = pack8(d0, d1);
    return ss;
}

constexpr float I8_SV = 64.f;
constexpr float I4_SV = 8.44f;
constexpr float I4_SU = 95.5f;
constexpr float I8_SU = 600.f, I8_SX = 127.f / 6.f;
constexpr float FP8_SU = 64.f, FP8_SV = 8.f;
__device__ __forceinline__ void cvt_row_fp8_sliced(const float* src, unsigned char* tab  , int e, const float* g, float scale, int lane) {
#pragma unroll
    for (int j = 0; j < 4; ++j) { f32x4 a = *(const f32x4*)(src + 256 * j + 4 * lane) * scale; if (g) a = a * *(const f32x4*)(g + 256 * j + 4 * lane);
        int w = 0; w = __builtin_amdgcn_cvt_pk_bf8_f32(a[0], a[1], w, false); w = __builtin_amdgcn_cvt_pk_bf8_f32(a[2], a[3], w, true);
        const int x = 2 * j + (lane >> 5);
        *(unsigned*)(tab + ((size_t)x * NEXP + e) * 128 + 4 * (lane & 31)) = (unsigned)w; }
}
__device__ __forceinline__ void cvt_row_i8_sliced(const float* src, unsigned char* tab  , int e, const float* g, float scale, int lane) {
#pragma unroll
    for (int j = 0; j < 4; ++j) { f32x4 a = *(const f32x4*)(src + 256 * j + 4 * lane) * scale; if (g) a = a * *(const f32x4*)(g + 256 * j + 4 * lane);
        unsigned w = 0u;
#pragma unroll
        for (int q = 0; q < 4; ++q) { int v = __float2int_rn(a[q]); v = v < -127 ? -127 : (v > 127 ? 127 : v); w |= ((unsigned)v & 0xffu) << (8 * q); }
        const int x = 2 * j + (lane >> 5);
        *(unsigned*)(tab + ((size_t)x * NEXP + e) * 128 + 4 * (lane & 31)) = w; }
}
struct Ptrs {
    const float *x, *norm_mix, *norm_ffn, *ev_w_in, *ev_b_f, *ev_w_out, *od_w_in, *od_pool_w, *od_pool_scale, *od_w_out, *peer_wq, *peer_k1, *peer_k2, *peer_u, *peer_v, *norm_f;
    float* out; unsigned char* ws;
};

__device__ __forceinline__ void phase_p0(Frame& F, const Ptrs& P) {
    LAS float* scr = (LAS float*)(F.lds + F.wave * 16384);
    const int gw = F.vcu * NWAVES + F.wave, NGW = F.G * NWAVES, lane = opaque_i(F.lane);
    unsigned char* ws = P.ws;
    bf16_t* W1T = (bf16_t*)(ws + WS_W1T); bf16_t* W2T = (bf16_t*)(ws + WS_W2T); bf16_t* W4T = (bf16_t*)(ws + WS_W4T); bf16_t* W5T = (bf16_t*)(ws + WS_W5T);
    bf16_t* W3T = (bf16_t*)(ws + WS_W3T); bf16_t* W6T = (bf16_t*)(ws + WS_W6T); bf16_t* PWT = (bf16_t*)(ws + WS_PWT);
    constexpr int I1 = 16 * 97, I2 = 16 * 32, I4 = 16 * 64, I5 = I2, I3 = I4, I6 = I4, IP = 4 * 2 * 4;
    constexpr int NTR = I1 + I2 + I4 + I5 + I3 + I6 + IP;
    for (int it = gw; it < NTR; it += NGW) {
        int r = it;
        if (r < I1) { p0_transpose_item(P.ev_w_in, DM, EVEN_IN, W1T, P.norm_mix, true, scr, r, lane); continue; } r -= I1;
        if (r < I2) { p0_transpose_item(P.ev_w_out, DM, DM, W2T, nullptr, false, scr, r, lane); continue; } r -= I2;
        if (r < I4) { p0_transpose_item(P.od_w_in, DM, 2048, W4T, P.norm_mix + DM, false, scr, r, lane); continue; } r -= I4;
        if (r < I5) { p0_transpose_item(P.od_w_out, DM, DM, W5T, nullptr, false, scr, r, lane); continue; } r -= I5;
        if (r < I3) { p0_transpose_item(P.peer_wq, DM, 2048, W3T, P.norm_ffn, false, scr, r, lane); continue; } r -= I3;
        if (r < I6) { p0_transpose_item(P.peer_wq + (size_t)DM * 2048, DM, 2048, W6T, P.norm_ffn + DM, false, scr, r, lane); continue; } r -= I6;
        { const int g = r >> 3; p0_transpose_item(P.od_pool_w + (size_t)g * 128 * 128, 128, 128, PWT + (size_t)g * 128 * 128, nullptr, false, scr, r & 7, lane); }
    }
    bf16_t* XB = (bf16_t*)(ws + WS_XB); float* RS0 = (float*)(ws + WS_RS0);
    bf16_t* K1B = (bf16_t*)(ws + WS_K1B); bf16_t* K2B = (bf16_t*)(ws + WS_K2B);
    f32x4 wf[16][2];
    __syncthreads();
    { LAS float* wl = (LAS float*)F.lds;
      for (int k = F.tid; k < DM; k += NWAVES * 64) { const float gk = P.norm_mix[k]; const float* wp = P.ev_w_in + (size_t)k * EVEN_IN + 1536; LAS float* d = wl + 8 * k + 4 * (k >> 3);
          *(LAS f32x4*)d = *(const f32x4*)wp * gk; *(LAS f32x4*)(d + 4) = *(const f32x4*)(wp + 4) * gk; }
      __syncthreads();
#pragma unroll
      for (int j = 0; j < 16; ++j) { const int k = (j < 8 ? 0 : 512) + 8 * lane + (j & 7); const LAS float* s = wl + 8 * k + 4 * (k >> 3); wf[j][0] = *(const LAS f32x4*)s; wf[j][1] = *(const LAS f32x4*)(s + 4); } }
    float* LF = (float*)(ws + WS_LF); const float bfl = P.ev_b_f[lane & 7];
    for (int r0 = gw * 4; r0 < TOK; r0 += NGW * 4) {
        f32x4 a[4][4];
#pragma unroll
        for (int q = 0; q < 4; ++q) { const float* s = P.x + (size_t)(r0 + q) * DM + 8 * lane; a[q][0] = *(const f32x4*)s; a[q][1] = *(const f32x4*)(s + 4); a[q][2] = *(const f32x4*)(s + 512); a[q][3] = *(const f32x4*)(s + 516); }
#pragma unroll
        for (int q = 0; q < 4; ++q) { float ss = 0.f;
#pragma unroll
            for (int j = 0; j < 4; ++j) ss += (a[q][j][0] * a[q][j][0] + a[q][j][1] * a[q][j][1]) + (a[q][j][2] * a[q][j][2] + a[q][j][3] * a[q][j][3]);
            bf16_t* d = XB + (size_t)(r0 + q) * DM + 8 * lane; __builtin_nontemporal_store(pack8(a[q][0], a[q][1]), (u32x4*)d); __builtin_nontemporal_store(pack8(a[q][2], a[q][3]), (u32x4*)(d + 512));
            ss = wave_sum(ss); const float rs = rsqrtf(ss * (1.f / DM) + RMS_EPS); if (lane == 0) RS0[r0 + q] = rs;
            f32x4 g0 = {0.f, 0.f, 0.f, 0.f}, g1 = {0.f, 0.f, 0.f, 0.f};
#pragma unroll
            for (int j = 0; j < 16; ++j) { const float xv = a[q][j >> 2][j & 3]; g0 += wf[j][0] * xv; g1 += wf[j][1] * xv; }
            float gv = 0.f;
#pragma unroll
            for (int h = 0; h < 8; ++h) { const float tot = wave_total(h < 4 ? g0[h & 3] : g1[h & 3]); gv = (lane == h) ? tot : gv; }
            if (lane < 8) { const int r = r0 + q; const float x = gv * rs + bfl; const float ls = fminf(x, 0.f) - log1pf(expf(-fabsf(x)));
                LF[(size_t)((r >> 11) * 8 + lane) * 2048 + (r & 2047)] = ls * LOG2E; }
        }
    }
#pragma unroll 1
    for (int tb = 0; tb < 2; ++tb) {
        const float* srcT = tb ? P.peer_v : P.peer_u; unsigned char* tabT = ws + (tb ? WS_V8S : WS_U8S); const float scale = tb ? I4_SV : I4_SU;
        for (int r0 = gw * 4; r0 < 2 * NEXP; r0 += NGW * 4) {
            const int ly = r0 >= NEXP, e0 = r0 - ly * NEXP; unsigned char* tab = tabT + (size_t)ly * 4 * NEXP * 128;
            f32x4 a[4][4], g[4];
#pragma unroll
            for (int q = 0; q < 4; ++q)
#pragma unroll
                for (int j = 0; j < 4; ++j) a[q][j] = *(const f32x4*)(srcT + (size_t)(r0 + q) * DM + 256 * j + 4 * lane);
#pragma unroll
            for (int j = 0; j < 4; ++j) { g[j] = (f32x4){scale, scale, scale, scale}; if (!tb) g[j] = g[j] * *(const f32x4*)(P.norm_ffn + (ly ? DM : 0) + 256 * j + 4 * lane); }
#pragma unroll
            for (int q = 0; q < 4; ++q)
#pragma unroll
                for (int j = 0; j < 4; ++j) { const f32x4 v = a[q][j] * g[j]; unsigned w = 0u;
                    if (!tb) {
#pragma unroll
                        for (int k = 0; k < 4; ++k) { int iv = __float2int_rn(v[k]); iv = iv < -8 ? -8 : (iv > 7 ? 7 : iv); w |= ((unsigned)iv & 0xfu) << (4 * k); }
                        *(unsigned short*)(tab + ((size_t)j * NEXP + e0 + q) * 128 + 2 * lane) = (unsigned short)w;
                    } else {
#pragma unroll
                        for (int k = 0; k < 4; ++k) { int iv = __float2int_rn(v[k]); iv = iv < -8 ? -8 : (iv > 7 ? 7 : iv); w |= ((unsigned)((k & 1) ? iv : iv + 8) & 0xfu) << (4 * k); }
                        *(unsigned short*)(tab + ((size_t)j * NEXP + e0 + q) * 128 + 2 * lane) = (unsigned short)w; } }
        }
    }
    constexpr int R_Z = EVEN_PAD - EVEN_IN, R_K = 2 * 256;
    for (int it = gw; it < R_Z + R_K; it += NGW) {
        int r = it;
        if (r < R_Z) { bf16_t* d = W1T + (size_t)(EVEN_IN + r) * DM; const u32x4 z = {0u, 0u, 0u, 0u}; *(u32x4*)(d + 8 * lane) = z; *(u32x4*)(d + 512 + 8 * lane) = z; continue; } r -= R_Z;
        if (r < 256) (void)cvt_row_1024(P.peer_k1 + (size_t)r * 1024, K1B + (size_t)r * 1024, nullptr, lane);
        else (void)cvt_row_1024(P.peer_k2 + (size_t)(r - 256) * 1024, K2B + (size_t)(r - 256) * 1024, nullptr, lane);
    }
}

__device__ __forceinline__ void phase_cfscan(Frame& F, const float* LF, float* CFo) {
    const int gw = F.vcu * NWAVES + F.wave, NGW = F.G * NWAVES, lane = opaque_i(F.lane);
    for (int bh = gw; bh < NB * 8; bh += NGW) {
        const float* src = LF + (size_t)bh * 2048 + 32 * lane; float v[32];
#pragma unroll
        for (int i = 0; i < 8; ++i) { const f32x4 w = *(const f32x4*)(src + 4 * i); v[4 * i] = w[0]; v[4 * i + 1] = w[1]; v[4 * i + 2] = w[2]; v[4 * i + 3] = w[3]; }
#pragma unroll
        for (int i = 1; i < 32; ++i) v[i] += v[i - 1];
        const float tot = v[31]; float inc = tot;
#pragma unroll
        for (int o = 1; o < 64; o <<= 1) { const float w = __shfl_up(inc, o); if (lane >= o) inc += w; }
        const float excl = inc - tot; float* dst = CFo + (size_t)bh * 2048 + 32 * lane;
#pragma unroll
        for (int i = 0; i < 8; ++i) { f32x4 w = {v[4 * i] + excl, v[4 * i + 1] + excl, v[4 * i + 2] + excl, v[4 * i + 3] + excl}; *(f32x4*)(dst + 4 * i) = w; }
    }
}
__device__ __forceinline__ void cfscan_block(Frame& F, const float* LF, float* CFo, int bh) {
    LAS float* wt = (LAS float*)(F.lds + RING_BYTES + 2048);
    const int lane = opaque_i(F.lane);
    const f32x4 w = *(const f32x4*)(LF + (size_t)bh * 2048 + 4 * F.tid);
    const float p0 = w[0], p1 = p0 + w[1], p2 = p1 + w[2], p3 = p2 + w[3];
    float inc = p3;
#pragma unroll
    for (int o = 1; o < 64; o <<= 1) { const float u = __shfl_up(inc, o); if (lane >= o) inc += u; }
    if (lane == 63) wt[F.wave] = inc;
    __syncthreads();
    float base = inc - p3;
#pragma unroll
    for (int k = 0; k < NWAVES - 1; ++k) base += (k < F.wave) ? wt[k] : 0.f;
    *(f32x4*)(CFo + (size_t)bh * 2048 + 4 * F.tid) = (f32x4){p0 + base, p1 + base, p2 + base, p3 + base};
    asm volatile("s_waitcnt vmcnt(0)" ::: "memory");
    __syncthreads();
}
__device__ __forceinline__ void phase_kmean(Frame& F, const bf16_t* KD, float* KMEAN, int bh) {
    const int lane = opaque_i(F.lane), jg = lane >> 3, dq = lane & 7;
    for (int it = bh * 8 + F.wave; it < bh * 8 + 8; it += NWAVES) {
        const int bh = it >> 3, blk = it & 7; const bf16_t* src = KD + ((size_t)bh * 2048 + blk * 256 + jg) * 64 + 8 * dq; float s[8] = {0.f, 0.f, 0.f, 0.f, 0.f, 0.f, 0.f, 0.f};
#pragma unroll 8
        for (int i = 0; i < 32; ++i) { const u32x4 w = *(const u32x4*)(src + (size_t)i * 8 * 64);
            s[0] += bf_lo(w.x); s[1] += bf_hi(w.x); s[2] += bf_lo(w.y); s[3] += bf_hi(w.y); s[4] += bf_lo(w.z); s[5] += bf_hi(w.z); s[6] += bf_lo(w.w); s[7] += bf_hi(w.w); }
#pragma unroll
        for (int k = 0; k < 8; ++k) { s[k] += __shfl_xor(s[k], 8); s[k] += __shfl_xor(s[k], 16); s[k] += __shfl_xor(s[k], 32); }
        if (jg == 0) { float* d = KMEAN + (size_t)it * 64 + 8 * dq; *(f32x4*)d = (f32x4){s[0], s[1], s[2], s[3]} * (1.f / 256.f); *(f32x4*)(d + 4) = (f32x4){s[4], s[5], s[6], s[7]} * (1.f / 256.f); }
    }
}
__device__ __forceinline__ int lgi(int s) { return s + (s >> 5); }
__device__ __forceinline__ float lsn2f(float z2) { return -(fmaxf(z2, 0.f) + __log2f(1.f + exp2f(-fabsf(z2)))); }
template <int KIND>
__device__ __forceinline__ void attn_naive(Frame& F, const bf16_t* QH, const bf16_t* KH, const bf16_t* VT, int NH, int hbase, const float* CF, const float* KMEAN, bf16_t* AO, int ao_col0) {
    LAS float* lg = (LAS float*)(F.lds + F.wave * 8704);
    const int gw = F.vcu * NWAVES + F.wave, NGW = F.G * NWAVES, lane = opaque_i(F.lane);
    for (int qi = gw; qi < NB * 8 * SEQ; qi += NGW) {
        const int bh = qi >> 11, b = bh >> 3, h = bh & 7, hh = hbase + h;
        const int t = (bh & 1) ? (2047 - (qi & 2047)) : (qi & 2047);
        const size_t hb = (size_t)(b * NH + hh);
        const bf16_t* qp = QH + (hb * 2048 + t) * 64; const bf16_t* kp = KH + hb * 2048 * 64;
        float q[64];
#pragma unroll
        for (int c = 0; c < 8; ++c) { const u32x4 w = *(const u32x4*)(qp + 8 * c);
            q[8 * c] = bf_lo(w.x); q[8 * c + 1] = bf_hi(w.x); q[8 * c + 2] = bf_lo(w.y); q[8 * c + 3] = bf_hi(w.y); q[8 * c + 4] = bf_lo(w.z); q[8 * c + 5] = bf_hi(w.z); q[8 * c + 6] = bf_lo(w.w); q[8 * c + 7] = bf_hi(w.w); }
        unsigned sel = 0u; const int qb = t >> 8;
        if (KIND == 2) {
            float gate[8];
#pragma unroll
            for (int n = 0; n < 8; ++n) { const float* km = KMEAN + ((size_t)(b * 8 + h) * 8 + n) * 64; float a = 0.f;
#pragma unroll
                for (int d = 0; d < 64; ++d) a += q[d] * km[d];
                gate[n] = a; }
            const int nsel = qb < 3 ? qb : 3;
#pragma unroll
            for (int r = 0; r < 3; ++r) if (r < nsel) { float best = -INFINITY; int bi = 0;
#pragma unroll
                for (int n = 0; n < 8; ++n) if (n < qb && !((sel >> n) & 1u) && gate[n] > best) { best = gate[n]; bi = n; }
                sel |= 1u << bi; }
        }
        const int nk = (KIND == 1) ? t : t + 1;
        const int tp = (nk + 7) & ~7;
        const float cft = (KIND == 0) ? CF[(size_t)(b * 8 + h) * 2048 + t] : 0.f;
        const float slope2 = (KIND == 2) ? exp2f(-(float)(h + 1)) * LOG2E : 0.f;
        float mloc = -INFINITY;
        for (int s = lane; s < nk; s += 64) {
            float dot = 0.f;
#pragma unroll
            for (int c = 0; c < 8; ++c) { const u32x4 w = *(const u32x4*)(kp + (size_t)s * 64 + 8 * c);
                dot += q[8 * c] * bf_lo(w.x) + q[8 * c + 1] * bf_hi(w.x) + q[8 * c + 2] * bf_lo(w.y) + q[8 * c + 3] * bf_hi(w.y) + q[8 * c + 4] * bf_lo(w.z) + q[8 * c + 5] * bf_hi(w.z) + q[8 * c + 6] * bf_lo(w.w) + q[8 * c + 7] * bf_hi(w.w); }
            float v = dot;
            if (KIND == 0) v += cft - CF[(size_t)(b * 8 + h) * 2048 + s];
            if (KIND == 2) { const int n = s >> 8; const bool valid = (n == qb) || ((sel >> n) & 1u); v = valid ? v + slope2 * (float)(s - t) : -INFINITY; }
            lg[lgi(s)] = v; mloc = fmaxf(mloc, v);
        }
        float linv = 1.f;
        if (KIND != 1) {
            const float m = wave_max(mloc); float lsum = 0.f;
            for (int s = lane; s < tp; s += 64) { const float p = (s < nk) ? exp2f(lg[lgi(s)] - m) : 0.f; lg[lgi(s)] = p; lsum += p; }
            linv = 1.f / wave_sum(lsum);
        } else {
            float tot = 0.f;
            for (int i = 0; i < 32; ++i) { const int s = 32 * lane + i; if (s < nk) tot += lsn2f(lg[lgi(s)]); }
            float inc = tot;
#pragma unroll
            for (int o = 1; o < 64; o <<= 1) { const float w = __shfl_down(inc, o); if (lane + o < 64) inc += w; }
            float run = inc - tot;
            for (int i = 31; i >= 0; --i) { const int s = 32 * lane + i; float a = 0.f;
                if (s < nk) { const float z = lg[lgi(s)], l2 = lsn2f(z); a = exp2f(z + l2 + run); run += l2; }
                if (s < tp) lg[lgi(s)] = a; }
        }
        LDS_WAIT();
        const bf16_t* vp = VT + (hb * 64 + lane) * 2048; float o = 0.f;
        for (int s0 = 0; s0 < tp; s0 += 8) { const u32x4 w = *(const u32x4*)(vp + s0); const int i0 = lgi(s0);
            o += lg[i0] * bf_lo(w.x) + lg[i0 + 1] * bf_hi(w.x) + lg[i0 + 2] * bf_lo(w.y) + lg[i0 + 3] * bf_hi(w.y) + lg[i0 + 4] * bf_lo(w.z) + lg[i0 + 5] * bf_hi(w.z) + lg[i0 + 6] * bf_lo(w.w) + lg[i0 + 7] * bf_hi(w.w); }
        AO[(size_t)(b * 2048 + t) * DM + ao_col0 + h * 64 + lane] = (bf16_t)f2bf(o * linv);
        LDS_WAIT();
    }
}

__device__ __forceinline__ float lsn2q(float z2) { return -(fmaxf(z2, 0.f) + __builtin_amdgcn_logf(1.f + __builtin_amdgcn_exp2f(-fabsf(z2)))); }
__device__ __forceinline__ int pi32(int i) { return (i & ~12) | ((i & 4) << 1) | ((i & 8) >> 1); }
__device__ __forceinline__ void attn_load_k(bf16x8 (&kf)[4], const bf16_t* Kh, int kv0, int r32p, int hi) {
    const bf16_t* p = Kh + (size_t)(kv0 + r32p) * 64 + 8 * hi;
#pragma unroll
    for (int d0 = 0; d0 < 4; ++d0) kf[d0] = *(const bf16x8*)(p + 16 * d0);
}
__device__ __forceinline__ void attn_load_v(bf16x8 (&vf)[2][2], const bf16_t* Vth, int kv0, int r32, int hi) {
#pragma unroll
    for (int s = 0; s < 2; ++s)
#pragma unroll
        for (int dh = 0; dh < 2; ++dh) vf[s][dh] = *(const bf16x8*)(Vth + (size_t)(32 * dh + r32) * 2048 + kv0 + 16 * s + 8 * hi);
}
template <int KIND, int MODE>
__device__ __forceinline__ void attn_tile(const bf16x8 (&qr)[4], const bf16x8 (&kf)[4], const bf16x8 (&vf)[2][2], f32x16& O0, f32x16& O1, float& m, float& l, float& R,
                                          const f32x16& bias, const int kv0, const int q, const int hi, const bool rowok) {
    f32x16 S = bias;
#pragma unroll
    for (int d0 = 0; d0 < 4; ++d0) S = __builtin_amdgcn_mfma_f32_32x32x16_bf16(kf[d0], qr[d0], S, 0, 0, 0);
    if (MODE == 1) {
#pragma unroll
        for (int r = 0; r < 16; ++r) { const int key = kv0 + (r & 7) + 8 * hi + 16 * (r >> 3); const bool bad = (KIND == 1) ? (key >= q) : (key > q); if (bad) S[r] = -INFINITY; }
    }
    if (MODE == 2) { if (!rowok) {
#pragma unroll
        for (int r = 0; r < 16; ++r) S[r] = -INFINITY; } }
    float p[16];
    if (KIND != 1) {
        float rm = fmaxf(fmaxf(S[0], S[1]), fmaxf(S[2], S[3]));
#pragma unroll
        for (int r = 4; r < 16; r += 4) rm = fmaxf(rm, fmaxf(fmaxf(S[r], S[r + 1]), fmaxf(S[r + 2], S[r + 3])));
        rm = fmaxf(rm, __shfl_xor(rm, 32));
        const float mn = fmaxf(fmaxf(m, rm), -1e30f); const float alpha = __builtin_amdgcn_exp2f(m - mn);
        float ps = 0.f;
#pragma unroll
        for (int r = 0; r < 16; ++r) { p[r] = __builtin_amdgcn_exp2f(S[r] - mn); ps += p[r]; }
        l = l * alpha + ps; m = mn;
        O0 *= alpha; O1 *= alpha;
    } else {
        float l2[16]; float sLo = 0.f, sHi = 0.f;
#pragma unroll
        for (int r = 0; r < 16; ++r) l2[r] = lsn2q(S[r]);
#pragma unroll
        for (int r = 0; r < 8; ++r) { sLo += l2[r]; sHi += l2[8 + r]; }
        const float pLo = __shfl_xor(sLo, 32), pHi = __shfl_xor(sHi, 32);
        float run = hi ? R : R + pHi;
#pragma unroll
        for (int r = 15; r >= 8; --r) { p[r] = __builtin_amdgcn_exp2f(S[r] + l2[r] + run); run += l2[r]; }
        run = hi ? (R + sHi + pHi) : (R + pHi + sHi + pLo);
#pragma unroll
        for (int r = 7; r >= 0; --r) { p[r] = __builtin_amdgcn_exp2f(S[r] + l2[r] + run); run += l2[r]; }
        R += (sLo + sHi) + (pLo + pHi);
    }
    u32x4 w0, w1;
    w0.x = pk2(p[0], p[1]); w0.y = pk2(p[2], p[3]); w0.z = pk2(p[4], p[5]); w0.w = pk2(p[6], p[7]);
    w1.x = pk2(p[8], p[9]); w1.y = pk2(p[10], p[11]); w1.z = pk2(p[12], p[13]); w1.w = pk2(p[14], p[15]);
    const bf16x8 pf0 = __builtin_bit_cast(bf16x8, w0), pf1 = __builtin_bit_cast(bf16x8, w1);
    O0 = __builtin_amdgcn_mfma_f32_32x32x16_bf16(vf[0][0], pf0, O0, 0, 0, 0); O0 = __builtin_amdgcn_mfma_f32_32x32x16_bf16(vf[1][0], pf1, O0, 0, 0, 0);
    O1 = __builtin_amdgcn_mfma_f32_32x32x16_bf16(vf[0][1], pf0, O1, 0, 0, 0); O1 = __builtin_amdgcn_mfma_f32_32x32x16_bf16(vf[1][1], pf1, O1, 0, 0, 0);
}
template <int KIND>
__device__ __forceinline__ f32x16 attn_bias(const float* CFh, float slope2, int kv0, int q0, int hi) {
    f32x16 b = f32x16{};
    if (KIND == 0) { const float* c = CFh + kv0 + 8 * hi; const f32x4 a0 = *(const f32x4*)c, a1 = *(const f32x4*)(c + 4), a2 = *(const f32x4*)(c + 16), a3 = *(const f32x4*)(c + 20);
        b[0] = -a0[0]; b[1] = -a0[1]; b[2] = -a0[2]; b[3] = -a0[3]; b[4] = -a1[0]; b[5] = -a1[1]; b[6] = -a1[2]; b[7] = -a1[3];
        b[8] = -a2[0]; b[9] = -a2[1]; b[10] = -a2[2]; b[11] = -a2[3]; b[12] = -a3[0]; b[13] = -a3[1]; b[14] = -a3[2]; b[15] = -a3[3]; }
    if (KIND == 2) {
#pragma unroll
        for (int r = 0; r < 16; ++r) b[r] = slope2 * (float)(kv0 + (r & 7) + 8 * hi + 16 * (r >> 3) - q0); }
    return b;
}
template <int KIND>
__device__ __forceinline__ void attn_wave(const bf16_t* Qh, const bf16_t* Kh, const bf16_t* Vth, const int q0, const int lane, const float* CFh, const float slope2, const float* KMh, bf16_t* AOp) {
    const int r32 = lane & 31, hi = lane >> 5, r32p = pi32(r32), q = q0 + r32;
    bf16x8 qr[4];
#pragma unroll
    for (int d0 = 0; d0 < 4; ++d0) qr[d0] = *(const bf16x8*)(Qh + (size_t)q * 64 + 16 * d0 + 8 * hi);
    f32x16 O0 = f32x16{}, O1 = f32x16{};
    float m = -INFINITY, l = 0.f, R = 0.f;
    bf16x8 kf[4], kfn[4], vf[2][2];
    const int nt = q0 / 32 + 1;
    if (KIND == 0) {
        attn_load_k(kf, Kh, 0, r32p, hi);
        for (int it = 0; it < nt; ++it) { const int kv0 = 32 * it;
            attn_load_v(vf, Vth, kv0, r32, hi); const f32x16 bias = attn_bias<0>(CFh, 0.f, kv0, q0, hi);
            if (it + 1 < nt) attn_load_k(kfn, Kh, kv0 + 32, r32p, hi);
            if (it == nt - 1) attn_tile<0, 1>(qr, kf, vf, O0, O1, m, l, R, bias, kv0, q, hi, true); else attn_tile<0, 0>(qr, kf, vf, O0, O1, m, l, R, bias, kv0, q, hi, true);
#pragma unroll
            for (int d0 = 0; d0 < 4; ++d0) kf[d0] = kfn[d0]; }
    } else if (KIND == 1) {
        attn_load_k(kf, Kh, 32 * (nt - 1), r32p, hi);
        for (int it = nt - 1; it >= 0; --it) { const int kv0 = 32 * it;
            attn_load_v(vf, Vth, kv0, r32, hi); const f32x16 bias = f32x16{};
            if (it > 0) attn_load_k(kfn, Kh, kv0 - 32, r32p, hi);
            if (it == nt - 1) attn_tile<1, 1>(qr, kf, vf, O0, O1, m, l, R, bias, kv0, q, hi, true); else attn_tile<1, 0>(qr, kf, vf, O0, O1, m, l, R, bias, kv0, q, hi, true);
#pragma unroll
            for (int d0 = 0; d0 < 4; ++d0) kf[d0] = kfn[d0];
            if (__all(R < -200.f)) break; }
    } else {
        const int qb = q0 >> 8;
        f32x16 G = f32x16{};
#pragma unroll
        for (int d0 = 0; d0 < 4; ++d0) { u32x4 kw = {0u, 0u, 0u, 0u};
            if (r32 < 8) { const float* kmp = KMh + r32 * 64 + 16 * d0 + 8 * hi; kw = pack8(*(const f32x4*)kmp, *(const f32x4*)(kmp + 4)); }
            G = __builtin_amdgcn_mfma_f32_32x32x16_bf16(__builtin_bit_cast(bf16x8, kw), qr[d0], G, 0, 0, 0); }
        float gate[8];
#pragma unroll
        for (int n = 0; n < 4; ++n) { const float own = G[n], oth = __shfl_xor(own, 32); gate[n] = hi ? oth : own; gate[n + 4] = hi ? own : oth; }
        unsigned sel = 0u; const int nsel = qb < 3 ? qb : 3;
#pragma unroll
        for (int r = 0; r < 3; ++r) if (r < nsel) { float best = -INFINITY; int bi = 0;
#pragma unroll
            for (int n = 0; n < 8; ++n) if (n < qb && !((sel >> n) & 1u) && gate[n] > best) { best = gate[n]; bi = n; }
            sel |= 1u << bi; }
        for (int kv0 = 256 * qb; kv0 <= q0; kv0 += 32) {
            attn_load_k(kf, Kh, kv0, r32p, hi); attn_load_v(vf, Vth, kv0, r32, hi); const f32x16 bias = attn_bias<2>(nullptr, slope2, kv0, q0, hi);
            if (kv0 == q0) attn_tile<2, 1>(qr, kf, vf, O0, O1, m, l, R, bias, kv0, q, hi, true); else attn_tile<2, 0>(qr, kf, vf, O0, O1, m, l, R, bias, kv0, q, hi, true); }
        for (int j = 0; j < qb; ++j) { const bool rowok = (sel >> j) & 1u;
            if (!__any(rowok)) continue;
            attn_load_k(kf, Kh, 256 * j, r32p, hi);
            for (int i = 0; i < 8; ++i) { const int kv0 = 256 * j + 32 * i;
                attn_load_v(vf, Vth, kv0, r32, hi); const f32x16 bias = attn_bias<2>(nullptr, slope2, kv0, q0, hi);
                if (i < 7) attn_load_k(kfn, Kh, kv0 + 32, r32p, hi);
                attn_tile<2, 2>(qr, kf, vf, O0, O1, m, l, R, bias, kv0, q, hi, rowok);
#pragma unroll
                for (int d0 = 0; d0 < 4; ++d0) kf[d0] = kfn[d0]; } }
    }
    float linv = 1.f;
    if (KIND != 1) linv = 1.f / (l + __shfl_xor(l, 32));
    bf16_t* orow = AOp + (size_t)q * DM;
#pragma unroll
    for (int g = 0; g < 4; ++g) { u32x2 w;
        w.x = pk2(O0[4 * g] * linv, O0[4 * g + 1] * linv); w.y = pk2(O0[4 * g + 2] * linv, O0[4 * g + 3] * linv); *(u32x2*)(orow + 8 * g + 4 * hi) = w;
        w.x = pk2(O1[4 * g] * linv, O1[4 * g + 1] * linv); w.y = pk2(O1[4 * g + 2] * linv, O1[4 * g + 3] * linv); *(u32x2*)(orow + 32 + 8 * g + 4 * hi) = w; }
}
template <int KIND>
__device__ __forceinline__ void phase_attn(Frame& F, const bf16_t* QH, const bf16_t* KH, const bf16_t* VT, int NH, int hbase, const float* CF, const float* KMEAN, bf16_t* AO, int ao_col0) {
    for (int ug = F.vcu; ug < NB * 8 * 2; ug += F.G) {
        const int bh = ug >> 1, b = bh >> 3, h = bh & 7, hh = hbase + h; const size_t hb = (size_t)(b * NH + hh);
        const float slope2 = __builtin_amdgcn_exp2f(-(float)(h + 1)) * LOG2E;
#pragma unroll 1
        for (int i = 0; i < 4; ++i) { const int base = (i >> 1) * 2 + (ug & 1), qb = (i & 1) ? 7 - base : base, w = (i & 1) ? 7 - F.wave : F.wave;
            attn_wave<KIND>(QH + hb * 2048 * 64, KH + hb * 2048 * 64, VT + hb * 64 * 2048, 256 * qb + 32 * w, opaque_i(F.lane),
                            CF ? CF + (size_t)bh * 2048 : nullptr, slope2, KMEAN ? KMEAN + (size_t)bh * 8 * 64 : nullptr, AO + (size_t)b * 2048 * DM + ao_col0 + h * 64); }
    }
}


constexpr int AT_SLOT = 16384, AT_CF = 3 * AT_SLOT;
__device__ __forceinline__ void attn_dma_tile(const bf16_t* Kh, const bf16_t* Vth, int T, LAS unsigned char* slot, int wave, int r32, int r32p, int hi) {
    const int j = wave >> 2, d0 = wave & 3, s2 = (wave >> 1) & 1, dh = wave & 1;
    const bf16_t* ks = Kh + (size_t)(64 * T + 32 * j + r32p) * 64 + 16 * d0 + 8 * hi;
    const bf16_t* vs = Vth + (size_t)(32 * dh + r32) * 2048 + 64 * T + 32 * j + 16 * s2 + 8 * hi;
    __builtin_amdgcn_global_load_lds((const unsigned*)ks, (LAS unsigned*)(slot + (j * 4 + d0) * 1024), 16, 0, 0);
    __builtin_amdgcn_global_load_lds((const unsigned*)vs, (LAS unsigned*)(slot + 8192 + ((j * 2 + s2) * 2 + dh) * 1024), 16, 0, 0);
}
template <int MODE>
__device__ __forceinline__ void attn_fox_sub(const bf16x8 (&qr)[4], f32x16& O0, f32x16& O1, float& m, float& l, unsigned saddr  , unsigned cfaddr  , int j, int kv0, int q, int hi) {
    bf16x8 kf[4], vf[2][2]; f32x4 c0, c1, c2, c3;
    asm volatile("ds_read_b128 %0, %12\n\tds_read_b128 %1, %12 offset:1024\n\tds_read_b128 %2, %12 offset:2048\n\tds_read_b128 %3, %12 offset:3072\n\t"
                 "ds_read_b128 %4, %13\n\tds_read_b128 %5, %13 offset:1024\n\tds_read_b128 %6, %13 offset:2048\n\tds_read_b128 %7, %13 offset:3072\n\t"
                 "ds_read_b128 %8, %14\n\tds_read_b128 %9, %14 offset:16\n\tds_read_b128 %10, %14 offset:64\n\tds_read_b128 %11, %14 offset:80\n\ts_waitcnt lgkmcnt(0)"
                 : "=&v"(kf[0]), "=&v"(kf[1]), "=&v"(kf[2]), "=&v"(kf[3]), "=&v"(vf[0][0]), "=&v"(vf[0][1]), "=&v"(vf[1][0]), "=&v"(vf[1][1]), "=&v"(c0), "=&v"(c1), "=&v"(c2), "=&v"(c3)
                 : "v"(saddr + (unsigned)j * 4096u), "v"(saddr + 8192u + (unsigned)j * 4096u), "v"(cfaddr) : "memory");
    f32x16 S;
    S[0] = c0[0]; S[1] = c0[1]; S[2] = c0[2]; S[3] = c0[3]; S[4] = c1[0]; S[5] = c1[1]; S[6] = c1[2]; S[7] = c1[3];
    S[8] = c2[0]; S[9] = c2[1]; S[10] = c2[2]; S[11] = c2[3]; S[12] = c3[0]; S[13] = c3[1]; S[14] = c3[2]; S[15] = c3[3];
#pragma unroll
    for (int d0 = 0; d0 < 4; ++d0) S = __builtin_amdgcn_mfma_f32_32x32x16_bf16(kf[d0], qr[d0], S, 0, 0, 0);
    if (MODE == 1) {
#pragma unroll
        for (int r = 0; r < 16; ++r) { const int key = kv0 + (r & 7) + 8 * hi + 16 * (r >> 3); if (key > q) S[r] = -INFINITY; }
    }
    float rm = fmaxf(fmaxf(S[0], S[1]), fmaxf(S[2], S[3]));
#pragma unroll
    for (int r = 4; r < 16; r += 4) rm = fmaxf(rm, fmaxf(fmaxf(S[r], S[r + 1]), fmaxf(S[r + 2], S[r + 3])));
    { const auto rr = __builtin_amdgcn_permlane32_swap(__float_as_uint(rm), __float_as_uint(rm), false, false); rm = fmaxf(__uint_as_float(rr[0]), __uint_as_float(rr[1])); }
    if (__any(rm > m)) {
        const float mn = fmaxf(fmaxf(m, rm), -1e30f); const float alpha = __builtin_amdgcn_exp2f(m - mn);
        l *= alpha; O0 *= alpha; O1 *= alpha; m = mn; }
    float p[16]; float ps = 0.f;
#pragma unroll
    for (int r = 0; r < 16; ++r) { p[r] = __builtin_amdgcn_exp2f(S[r] - m); ps += p[r]; }
    l += ps;
    u32x4 w0, w1;
    w0.x = pk2(p[0], p[1]); w0.y = pk2(p[2], p[3]); w0.z = pk2(p[4], p[5]); w0.w = pk2(p[6], p[7]);
    w1.x = pk2(p[8], p[9]); w1.y = pk2(p[10], p[11]); w1.z = pk2(p[12], p[13]); w1.w = pk2(p[14], p[15]);
    const bf16x8 pf0 = __builtin_bit_cast(bf16x8, w0), pf1 = __builtin_bit_cast(bf16x8, w1);
    O0 = __builtin_amdgcn_mfma_f32_32x32x16_bf16(vf[0][0], pf0, O0, 0, 0, 0); O0 = __builtin_amdgcn_mfma_f32_32x32x16_bf16(vf[1][0], pf1, O0, 0, 0, 0);
    O1 = __builtin_amdgcn_mfma_f32_32x32x16_bf16(vf[0][1], pf0, O1, 0, 0, 0); O1 = __builtin_amdgcn_mfma_f32_32x32x16_bf16(vf[1][1], pf1, O1, 0, 0, 0);
}
__device__ __forceinline__ void attn_fox_unit(Frame& F, const bf16_t* Qh, const bf16_t* Kh, const bf16_t* Vth, const float* CFh, const int qb, bf16_t* AOp) {
    const int lane = opaque_i(F.lane), r32 = lane & 31, hi = lane >> 5, r32p = pi32(r32), wave = F.wave, q0 = 256 * qb + 32 * wave, q = q0 + r32;
    LAS unsigned char* ring = F.lds; const unsigned ring_a = (unsigned)(uintptr_t)ring + 16u * (unsigned)lane, cf_a = (unsigned)(uintptr_t)ring + (unsigned)AT_CF + 32u * (unsigned)hi;
    bf16x8 qr[4];
#pragma unroll
    for (int d0 = 0; d0 < 4; ++d0) qr[d0] = *(const bf16x8*)(Qh + (size_t)q * 64 + 16 * d0 + 8 * hi);
    { const f32x4 cv = *(const f32x4*)(CFh + 4 * F.tid); *(LAS f32x4*)(ring + AT_CF + 16 * F.tid) = -cv; }
    asm volatile("s_waitcnt vmcnt(0) lgkmcnt(0)" ::: "memory"); __builtin_amdgcn_s_barrier();
    const int NT = 4 * qb + 4, my_last = 4 * qb + (wave >> 1), jdiag = wave & 1;
    attn_dma_tile(Kh, Vth, NT - 1, ring, wave, r32, r32p, hi);
    attn_dma_tile(Kh, Vth, NT - 2, ring + AT_SLOT, wave, r32, r32p, hi);
    f32x16 O0 = f32x16{}, O1 = f32x16{}; float m = -INFINITY, l = 0.f;
    int slot = 0;
#pragma unroll 1
    for (int T = NT - 1; T >= 0; --T) {
        if (T > 0) asm volatile("s_waitcnt vmcnt(2)" ::: "memory"); else asm volatile("s_waitcnt vmcnt(0)" ::: "memory");
        __builtin_amdgcn_s_barrier();
        if (T >= 2) { const int fs = (slot == 0) ? 2 : slot - 1; attn_dma_tile(Kh, Vth, T - 2, ring + fs * AT_SLOT, wave, r32, r32p, hi); }
        if (T <= my_last) {
            const unsigned sa = ring_a + (unsigned)(slot * AT_SLOT);
            if (T == my_last) {
                if (jdiag == 1) { attn_fox_sub<1>(qr, O0, O1, m, l, sa, cf_a + 4u * (unsigned)(64 * T + 32), 1, 64 * T + 32, q, hi); attn_fox_sub<0>(qr, O0, O1, m, l, sa, cf_a + 4u * (unsigned)(64 * T), 0, 64 * T, q, hi); }
                else attn_fox_sub<1>(qr, O0, O1, m, l, sa, cf_a + 4u * (unsigned)(64 * T), 0, 64 * T, q, hi);
            } else { attn_fox_sub<0>(qr, O0, O1, m, l, sa, cf_a + 4u * (unsigned)(64 * T + 32), 1, 64 * T + 32, q, hi); attn_fox_sub<0>(qr, O0, O1, m, l, sa, cf_a + 4u * (unsigned)(64 * T), 0, 64 * T, q, hi); }
        }
        slot = (slot == 2) ? 0 : slot + 1;
    }
    const float linv = 1.f / (l + __shfl_xor(l, 32));
    bf16_t* orow = AOp + (size_t)q * DM;
#pragma unroll
    for (int g = 0; g < 4; ++g) { u32x2 w;
        w.x = pk2(O0[4 * g] * linv, O0[4 * g + 1] * linv); w.y = pk2(O0[4 * g + 2] * linv, O0[4 * g + 3] * linv); *(u32x2*)(orow + 8 * g + 4 * hi) = w;
        w.x = pk2(O1[4 * g] * linv, O1[4 * g + 1] * linv); w.y = pk2(O1[4 * g + 2] * linv, O1[4 * g + 3] * linv); *(u32x2*)(orow + 32 + 8 * g + 4 * hi) = w; }
    asm volatile("s_waitcnt vmcnt(0) lgkmcnt(0)" ::: "memory"); __builtin_amdgcn_s_barrier();
}
__device__ __forceinline__ void phase_attn_fox(Frame& F, const bf16_t* QH, const bf16_t* KH, const bf16_t* VT, const float* LF, float* CF, bf16_t* AO) {
    for (int ug = F.vcu; ug < NB * 8 * 2; ug += F.G) {
        const int bh = ug >> 1, b = bh >> 3, h = bh & 7; const size_t hb = (size_t)(b * 16 + h);
        cfscan_block(F, LF, CF, bh);
#pragma unroll 1
        for (int i = 0; i < 4; ++i) { const int base = (i >> 1) * 2 + (ug & 1), qb = (i & 1) ? 7 - base : base;
            attn_fox_unit(F, QH + hb * 2048 * 64, KH + hb * 2048 * 64, VT + hb * 64 * 2048, CF + (size_t)bh * 2048, qb, AO + (size_t)b * 2048 * DM + h * 64); }
    }
}

template <int MODE>
__device__ __forceinline__ void attn_moba_sub(const bf16x8 (&qr)[4], f32x16& O0, f32x16& O1, float& m, float& l, unsigned saddr, int j, int kv0, int q, int q0, int hi, float slope2, bool rowok) {
    bf16x8 kf[4], vf[2][2];
    asm volatile("ds_read_b128 %0, %8\n\tds_read_b128 %1, %8 offset:1024\n\tds_read_b128 %2, %8 offset:2048\n\tds_read_b128 %3, %8 offset:3072\n\t"
                 "ds_read_b128 %4, %9\n\tds_read_b128 %5, %9 offset:1024\n\tds_read_b128 %6, %9 offset:2048\n\tds_read_b128 %7, %9 offset:3072\n\ts_waitcnt lgkmcnt(0)"
                 : "=&v"(kf[0]), "=&v"(kf[1]), "=&v"(kf[2]), "=&v"(kf[3]), "=&v"(vf[0][0]), "=&v"(vf[0][1]), "=&v"(vf[1][0]), "=&v"(vf[1][1])
                 : "v"(saddr + (unsigned)j * 4096u), "v"(saddr + 8192u + (unsigned)j * 4096u) : "memory");
    f32x16 S; const float sbase = slope2 * (float)(kv0 + 8 * hi - q0);
#pragma unroll
    for (int r = 0; r < 16; ++r) S[r] = sbase + slope2 * (float)((r & 7) + 16 * (r >> 3));
#pragma unroll
    for (int d0 = 0; d0 < 4; ++d0) S = __builtin_amdgcn_mfma_f32_32x32x16_bf16(kf[d0], qr[d0], S, 0, 0, 0);
    if (MODE == 1) {
#pragma unroll
        for (int r = 0; r < 16; ++r) { const int key = kv0 + (r & 7) + 8 * hi + 16 * (r >> 3); if (key > q) S[r] = -INFINITY; }
    }
    if (MODE == 2) { if (!rowok) {
#pragma unroll
        for (int r = 0; r < 16; ++r) S[r] = -INFINITY; } }
    float rm = fmaxf(fmaxf(S[0], S[1]), fmaxf(S[2], S[3]));
#pragma unroll
    for (int r = 4; r < 16; r += 4) rm = fmaxf(rm, fmaxf(fmaxf(S[r], S[r + 1]), fmaxf(S[r + 2], S[r + 3])));
    { const auto rr = __builtin_amdgcn_permlane32_swap(__float_as_uint(rm), __float_as_uint(rm), false, false); rm = fmaxf(__uint_as_float(rr[0]), __uint_as_float(rr[1])); }
    if (__any(rm > m)) { const float mn = fmaxf(fmaxf(m, rm), -1e30f); const float alpha = __builtin_amdgcn_exp2f(m - mn); l *= alpha; O0 *= alpha; O1 *= alpha; m = mn; }
    float p[16]; float ps = 0.f;
#pragma unroll
    for (int r = 0; r < 16; ++r) { p[r] = __builtin_amdgcn_exp2f(S[r] - m); ps += p[r]; }
    l += ps;
    u32x4 w0, w1;
    w0.x = pk2(p[0], p[1]); w0.y = pk2(p[2], p[3]); w0.z = pk2(p[4], p[5]); w0.w = pk2(p[6], p[7]);
    w1.x = pk2(p[8], p[9]); w1.y = pk2(p[10], p[11]); w1.z = pk2(p[12], p[13]); w1.w = pk2(p[14], p[15]);
    const bf16x8 pf0 = __builtin_bit_cast(bf16x8, w0), pf1 = __builtin_bit_cast(bf16x8, w1);
    O0 = __builtin_amdgcn_mfma_f32_32x32x16_bf16(vf[0][0], pf0, O0, 0, 0, 0); O0 = __builtin_amdgcn_mfma_f32_32x32x16_bf16(vf[1][0], pf1, O0, 0, 0, 0);
    O1 = __builtin_amdgcn_mfma_f32_32x32x16_bf16(vf[0][1], pf0, O1, 0, 0, 0); O1 = __builtin_amdgcn_mfma_f32_32x32x16_bf16(vf[1][1], pf1, O1, 0, 0, 0);
}
__device__ __forceinline__ void attn_moba_unit(Frame& F, const bf16_t* Qh, const bf16_t* Kh, const bf16_t* Vth, const float* KMh, const float slope2, const int qb, bf16_t* AOp) {
    const int lane = opaque_i(F.lane), r32 = lane & 31, hi = lane >> 5, r32p = pi32(r32), wave = F.wave, q0 = 256 * qb + 32 * wave, q = q0 + r32;
    LAS unsigned char* ring = F.lds; const unsigned ring_a = (unsigned)(uintptr_t)ring + 16u * (unsigned)lane;
    bf16x8 qr[4];
#pragma unroll
    for (int d0 = 0; d0 < 4; ++d0) qr[d0] = *(const bf16x8*)(Qh + (size_t)q * 64 + 16 * d0 + 8 * hi);
    f32x16 G = f32x16{};
#pragma unroll
    for (int d0 = 0; d0 < 4; ++d0) { u32x4 kw = {0u, 0u, 0u, 0u};
        if (r32 < 8) { const float* kmp = KMh + r32 * 64 + 16 * d0 + 8 * hi; kw = pack8(*(const f32x4*)kmp, *(const f32x4*)(kmp + 4)); }
        G = __builtin_amdgcn_mfma_f32_32x32x16_bf16(__builtin_bit_cast(bf16x8, kw), qr[d0], G, 0, 0, 0); }
    float gate[8];
#pragma unroll
    for (int n = 0; n < 4; ++n) { const float own = G[n], oth = __shfl_xor(own, 32); gate[n] = hi ? oth : own; gate[n + 4] = hi ? own : oth; }
    unsigned sel = 0u; const int nsel = qb < 3 ? qb : 3;
#pragma unroll
    for (int r = 0; r < 3; ++r) if (r < nsel) { float best = -INFINITY; int bi = 0;
#pragma unroll
        for (int n = 0; n < 8; ++n) if (n < qb && !((sel >> n) & 1u) && gate[n] > best) { best = gate[n]; bi = n; }
        sel |= 1u << bi; }
    unsigned wsel = 0u;
#pragma unroll
    for (int n = 0; n < 8; ++n) if (__any((sel >> n) & 1u)) wsel |= 1u << n;
    asm volatile("s_waitcnt vmcnt(0) lgkmcnt(0)" ::: "memory"); __builtin_amdgcn_s_barrier();
    const int NT = 4 * qb + 4, my_last = 4 * qb + (wave >> 1), jdiag = wave & 1;
    attn_dma_tile(Kh, Vth, NT - 1, ring, wave, r32, r32p, hi);
    attn_dma_tile(Kh, Vth, NT - 2, ring + AT_SLOT, wave, r32, r32p, hi);
    f32x16 O0 = f32x16{}, O1 = f32x16{}; float m = -INFINITY, l = 0.f;
    int slot = 0;
#pragma unroll 1
    for (int T = NT - 1; T >= 0; --T) {
        if (T > 0) asm volatile("s_waitcnt vmcnt(2)" ::: "memory"); else asm volatile("s_waitcnt vmcnt(0)" ::: "memory");
        __builtin_amdgcn_s_barrier();
        if (T >= 2) { const int fs = (slot == 0) ? 2 : slot - 1; attn_dma_tile(Kh, Vth, T - 2, ring + fs * AT_SLOT, wave, r32, r32p, hi); }
        const unsigned sa = ring_a + (unsigned)(slot * AT_SLOT);
        if (T >= 4 * qb) {
            if (T == my_last) {
                if (jdiag == 1) { attn_moba_sub<1>(qr, O0, O1, m, l, sa, 1, 64 * T + 32, q, q0, hi, slope2, true); attn_moba_sub<0>(qr, O0, O1, m, l, sa, 0, 64 * T, q, q0, hi, slope2, true); }
                else attn_moba_sub<1>(qr, O0, O1, m, l, sa, 0, 64 * T, q, q0, hi, slope2, true);
            } else if (T < my_last) { attn_moba_sub<0>(qr, O0, O1, m, l, sa, 1, 64 * T + 32, q, q0, hi, slope2, true); attn_moba_sub<0>(qr, O0, O1, m, l, sa, 0, 64 * T, q, q0, hi, slope2, true); }
        } else if ((wsel >> (T >> 2)) & 1u) {
            const bool rowok = (sel >> (T >> 2)) & 1u;
            attn_moba_sub<2>(qr, O0, O1, m, l, sa, 1, 64 * T + 32, q, q0, hi, slope2, rowok); attn_moba_sub<2>(qr, O0, O1, m, l, sa, 0, 64 * T, q, q0, hi, slope2, rowok);
        }
        slot = (slot == 2) ? 0 : slot + 1;
    }
    const float linv = 1.f / (l + __shfl_xor(l, 32));
    bf16_t* orow = AOp + (size_t)q * DM;
#pragma unroll
    for (int g = 0; g < 4; ++g) { u32x2 w;
        w.x = pk2(O0[4 * g] * linv, O0[4 * g + 1] * linv); w.y = pk2(O0[4 * g + 2] * linv, O0[4 * g + 3] * linv); *(u32x2*)(orow + 8 * g + 4 * hi) = w;
        w.x = pk2(O1[4 * g] * linv, O1[4 * g + 1] * linv); w.y = pk2(O1[4 * g + 2] * linv, O1[4 * g + 3] * linv); *(u32x2*)(orow + 32 + 8 * g + 4 * hi) = w; }
    asm volatile("s_waitcnt vmcnt(0) lgkmcnt(0)" ::: "memory"); __builtin_amdgcn_s_barrier();
}
__device__ __forceinline__ void phase_attn_moba(Frame& F, const bf16_t* QD, const bf16_t* KD, const bf16_t* VTD, float* KMEAN, bf16_t* AO) {
    for (int ug = F.vcu; ug < NB * 8 * 2; ug += F.G) {
        const int bh = ug >> 1, b = bh >> 3, h = bh & 7; const size_t hb = (size_t)bh;
        phase_kmean(F, KD, KMEAN, bh); asm volatile("s_waitcnt vmcnt(0)" ::: "memory"); __syncthreads();
        const float slope2 = __builtin_amdgcn_exp2f(-(float)(h + 1)) * LOG2E;
#pragma unroll 1
        for (int i = 0; i < 4; ++i) { const int base = (i >> 1) * 2 + (ug & 1), qb = (i & 1) ? 7 - base : base;
            attn_moba_unit(F, QD + hb * 2048 * 64, KD + hb * 2048 * 64, VTD + hb * 64 * 2048, KMEAN + (size_t)bh * 8 * 64, slope2, qb, AO + (size_t)b * 2048 * DM + 512 + h * 64); }
    }
}
__device__ __forceinline__ void phase_pool(Frame& F, const bf16_t* XC, const bf16_t* PWT, const float* pool_scale, bf16_t* AO) {
    const int gw = F.vcu * NWAVES + F.wave, NGW = F.G * NWAVES, lane = opaque_i(F.lane), r32 = lane & 31, hi = lane >> 5;
    for (int it = gw; it < (TOK / 32) * 4; it += NGW) {
        const int rnd = it / NGW, gq = it - rnd * NGW;
        const int g = (rnd & 1) ? 3 - (gq & 3) : (gq & 3), t0 = (rnd * (NGW >> 2) + (gq >> 2)) * 32, t = t0 + r32, tl = t & 2047, w = 2 << g;
        const int cnt = (tl + 1) < w ? (tl + 1) : w; const float rc = 1.f / (float)cnt;
        f32x16 acc[4];
#pragma unroll
        for (int nb = 0; nb < 4; ++nb) acc[nb] = f32x16{};
#pragma unroll 1
        for (int kk = 0; kk < 8; ++kk) {
            const int c0 = g * 128 + kk * 16 + hi * 8;
            const u32x4 self = *(const u32x4*)(XC + (size_t)t * 512 + c0);
            float s[8] = {0.f, 0.f, 0.f, 0.f, 0.f, 0.f, 0.f, 0.f};
            for (int i = 0; i < cnt; ++i) { const u32x4 x = *(const u32x4*)(XC + (size_t)(t - i) * 512 + c0);
                s[0] += bf_lo(x.x); s[1] += bf_hi(x.x); s[2] += bf_lo(x.y); s[3] += bf_hi(x.y); s[4] += bf_lo(x.z); s[5] += bf_hi(x.z); s[6] += bf_lo(x.w); s[7] += bf_hi(x.w); }
            u32x4 pa; pa.x = pk2(s[0] * rc - bf_lo(self.x), s[1] * rc - bf_hi(self.x)); pa.y = pk2(s[2] * rc - bf_lo(self.y), s[3] * rc - bf_hi(self.y));
            pa.z = pk2(s[4] * rc - bf_lo(self.z), s[5] * rc - bf_hi(self.z)); pa.w = pk2(s[6] * rc - bf_lo(self.w), s[7] * rc - bf_hi(self.w));
            const bf16x8 af = __builtin_bit_cast(bf16x8, pa);
#pragma unroll
            for (int nb = 0; nb < 4; ++nb) { const bf16x8 bfr = *(const bf16x8*)(PWT + ((size_t)g * 128 + nb * 32 + r32) * 128 + kk * 16 + hi * 8);
                acc[nb] = __builtin_amdgcn_mfma_f32_32x32x16_bf16(af, bfr, acc[nb], 0, 0, 0); }
        }
#pragma unroll
        for (int nb = 0; nb < 4; ++nb) { const int col = g * 128 + nb * 32 + r32; const float sc = pool_scale[col];
#pragma unroll
            for (int r = 0; r < 16; ++r) { const int row = (r & 3) + 8 * (r >> 2) + 4 * hi; AO[(size_t)(t0 + row) * DM + col] = (bf16_t)f2bf(acc[nb][r] * sc); } }
    }
}

__device__ __forceinline__ void phase_topk_naive(Frame& F, const bf16_t* QP, const bf16_t* K1B, const bf16_t* K2B, unsigned short* EID, float* GATE) {
    const int gw = F.vcu * NWAVES + F.wave, NGW = F.G * NWAVES, lane = opaque_i(F.lane);
    for (int task = gw; task < TOK * 8; task += NGW) {
        const int t = task >> 3, h = task & 7;
        const bf16_t* qrow = QP + (size_t)t * 2048 + h * 256; const bf16_t* k1 = K1B + (size_t)h * 128 * 128; const bf16_t* k2 = K2B + (size_t)h * 128 * 128;
        float s1a = 0.f, s1b = 0.f, s2a = 0.f, s2b = 0.f;
#pragma unroll 4
        for (int c = 0; c < 16; ++c) { const u32x4 q1 = *(const u32x4*)(qrow + 8 * c), q2 = *(const u32x4*)(qrow + 128 + 8 * c);
            s1a = dot8(*(const u32x4*)(k1 + (size_t)lane * 128 + 8 * c), q1, s1a); s1b = dot8(*(const u32x4*)(k1 + (size_t)(lane + 64) * 128 + 8 * c), q1, s1b);
            s2a = dot8(*(const u32x4*)(k2 + (size_t)lane * 128 + 8 * c), q2, s2a); s2b = dot8(*(const u32x4*)(k2 + (size_t)(lane + 64) * 128 + 8 * c), q2, s2b); }
        unsigned A = (f2ord(s1a) & ~127u) | (unsigned)(127 - lane), B = (f2ord(s1b) & ~127u) | (unsigned)(63 - lane);
        unsigned top1 = 0u, top2 = 0u, topc = 0u;
        for (int r = 0; r < 16; ++r) { const unsigned m = wave_umax(A > B ? A : B); if (lane == r) top1 = m; if (A == m) A = 0u; if (B == m) B = 0u; }
        A = (f2ord(s2a) & ~127u) | (unsigned)(127 - lane); B = (f2ord(s2b) & ~127u) | (unsigned)(63 - lane);
        for (int r = 0; r < 16; ++r) { const unsigned m = wave_umax(A > B ? A : B); if (lane == r) top2 = m; if (A == m) A = 0u; if (B == m) B = 0u; }
        const float v1 = ord2f(top1 & ~127u), v2 = ord2f(top2 & ~127u); const int i1 = 127 - (int)(top1 & 127u), i2 = 127 - (int)(top2 & 127u);
        const float va = __shfl(v1, lane >> 2); unsigned C[4];
#pragma unroll
        for (int j = 0; j < 4; ++j) { const float vb = __shfl(v2, (lane & 3) * 4 + j); C[j] = (f2ord(va + vb) & ~255u) | (unsigned)(255 - (lane * 4 + j)); }
        for (int r = 0; r < 16; ++r) { unsigned m = C[0] > C[1] ? C[0] : C[1]; const unsigned m2 = C[2] > C[3] ? C[2] : C[3]; m = wave_umax(m > m2 ? m : m2); if (lane == r) topc = m;
#pragma unroll
            for (int j = 0; j < 4; ++j) if (C[j] == m) C[j] = 0u; }
        const int c = 255 - (int)(topc & 255u); const float val = ord2f(topc & ~255u);
        const int ia = __shfl(i1, c >> 4), ib = __shfl(i2, c & 15);
        const float v0 = __shfl(val, 0); const float e = (lane < 16) ? __expf(val - v0) : 0.f; const float sum = wave_sum(e);
        if (lane < 16) { EID[(size_t)t * 128 + h * 16 + lane] = (unsigned short)(ia * 128 + ib); GATE[(size_t)t * 128 + h * 16 + lane] = e / sum; }
    }
}

#define DEVFN __device__ __forceinline__
template <int OFF, int N, int TOT> DEVFN void bitonic_sort_desc(unsigned (&a)[TOT]) {
#pragma unroll
    for (int k = 2; k <= N; k <<= 1)
#pragma unroll
        for (int j = k >> 1; j > 0; j >>= 1)
#pragma unroll
            for (int i = 0; i < N; ++i) { const int l = i ^ j; if (l > i) { const bool desc = ((i & k) == 0); const unsigned x = a[OFF + i], y = a[OFF + l];
                const unsigned mx = x > y ? x : y, mn = x > y ? y : x; a[OFF + i] = desc ? mx : mn; a[OFF + l] = desc ? mn : mx; } }
}
constexpr int OE16_N = 63;
constexpr unsigned char OE16[63][2] = {{0,1}, {2,3}, {0,2}, {1,3}, {1,2}, {4,5}, {6,7}, {4,6}, {5,7}, {5,6}, {0,4}, {2,6}, {2,4}, {1,5}, {3,7}, {3,5}, {1,2}, {3,4}, {5,6}, {8,9}, {10,11}, {8,10}, {9,11}, {9,10}, {12,13}, {14,15}, {12,14}, {13,15}, {13,14}, {8,12}, {10,14}, {10,12}, {9,13}, {11,15}, {11,13}, {9,10}, {11,12}, {13,14}, {0,8}, {4,12}, {4,8}, {2,10}, {6,14}, {6,10}, {2,4}, {6,8}, {10,12}, {1,9}, {5,13}, {5,9}, {3,11}, {7,15}, {7,11}, {3,5}, {7,9}, {11,13}, {1,2}, {3,4}, {5,6}, {7,8}, {9,10}, {11,12}, {13,14}};
template <int OFF, int TOT> DEVFN void sort16_desc(unsigned (&a)[TOT]) {
#pragma unroll
    for (int q = 0; q < OE16_N; ++q) { const int i = OFF + OE16[q][0], l = OFF + OE16[q][1]; const unsigned x = a[i], y = a[l]; a[i] = x > y ? x : y; a[l] = x > y ? y : x; }
}
template <int OFF, int TOT> DEVFN void bitonic_merge16_desc(unsigned (&a)[TOT]) {
#pragma unroll
    for (int j = 8; j > 0; j >>= 1)
#pragma unroll
        for (int i = 0; i < 16; ++i) { const int l = i ^ j; if (l > i) { const unsigned x = a[OFF + i], y = a[OFF + l]; a[OFF + i] = x > y ? x : y; a[OFF + l] = x > y ? y : x; } }
}
template <int A, int B, int TOT> DEVFN void merge_top16(unsigned (&a)[TOT]) {
#pragma unroll
    for (int i = 0; i < 16; ++i) { const unsigned x = a[A + i], y = a[B + 15 - i]; a[A + i] = x > y ? x : y; }
    bitonic_merge16_desc<A, TOT>(a);
}
DEVFN void top16of64(unsigned (&a)[64]) {
    sort16_desc<0, 64>(a); sort16_desc<16, 64>(a); sort16_desc<32, 64>(a); sort16_desc<48, 64>(a);
    merge_top16<0, 16, 64>(a); merge_top16<32, 48, 64>(a); merge_top16<0, 32, 64>(a);
}

constexpr int TK_KSTRIDE = 272, TK_KSET = 128 * TK_KSTRIDE, TK_KBYTES = 2 * TK_KSET;
__device__ __forceinline__ void phase_topk(Frame& F, const bf16_t* QP, const bf16_t* K1B, const bf16_t* K2B, unsigned short* EID, float* GATE) {
    const int lane = opaque_i(F.lane), r32 = lane & 31, hi = lane >> 5, b = (int)blockIdx.x, h = b & 7, nbh = F.G >> 3;
    for (int c = F.tid; c < 2 * 128 * 16; c += NWAVES * 64) { const int sub = c >> 11, n = (c >> 4) & 127, part = c & 15;
        *(LAS u32x4*)(F.lds + sub * TK_KSET + n * TK_KSTRIDE + 16 * part) = *(const u32x4*)((sub ? K2B : K1B) + ((size_t)h * 128 + n) * 128 + 8 * part); }
    __syncthreads();
    LAS unsigned* I1s = (LAS unsigned*)(F.lds + TK_KBYTES + F.wave * 8192); LAS unsigned* I2s = I1s + 1024;
    bf16x8 qn[8];
    { const int tile0 = (b >> 3) + nbh * F.wave; const bf16_t* qrow = QP + (size_t)((tile0 < TOK / 32 ? tile0 : 0) * 32 + r32) * 2048 + h * 256 + 8 * hi;
#pragma unroll
      for (int kk = 0; kk < 8; ++kk) qn[kk] = *(const bf16x8*)(qrow + 16 * kk); }
    for (int tile = (b >> 3) + nbh * F.wave; tile < TOK / 32; tile += nbh * NWAVES) {
        const int t = tile * 32 + r32;
        unsigned V1[16], V2[16]; unsigned h4 = (unsigned)hi << 2; asm volatile("" : "+v"(h4));
#pragma unroll
        for (int half = 0; half < 2; ++half) {
            bf16x8 qf[8];
#pragma unroll
            for (int kk = 0; kk < 8; ++kk) qf[kk] = qn[kk];
            { const int tnx = tile + nbh * NWAVES, tl = half ? (tnx < TOK / 32 ? tnx : tile) : tile;
              const bf16_t* qrow = QP + (size_t)(tl * 32 + r32) * 2048 + h * 256 + (half ? 0 : 128) + 8 * hi;
#pragma unroll
              for (int kk = 0; kk < 8; ++kk) qn[kk] = *(const bf16x8*)(qrow + 16 * kk); }
            unsigned K[64];
#pragma unroll
            for (int nb = 0; nb < 4; ++nb) { f32x16 acc = f32x16{};
                LAS const unsigned char* kb = F.lds + half * TK_KSET + (nb * 32 + r32) * TK_KSTRIDE + 16 * hi; asm volatile("" : "+v"(kb));
#pragma unroll
                for (int kk = 0; kk < 8; ++kk) acc = __builtin_amdgcn_mfma_f32_32x32x16_bf16(*(LAS const bf16x8*)(kb + 32 * kk), qf[kk], acc, 0, 0, 0);
#pragma unroll
                for (int r = 0; r < 16; ++r) {
                    const unsigned x = __float_as_uint(acc[r]), o = x ^ ((unsigned)((int)x >> 31) | 0x80000000u); const int j = r >> 2;
                    const unsigned pack = (unsigned)(127 - (nb * 32 + 0 + 8 * j)) | ((unsigned)(127 - (nb * 32 + 1 + 8 * j)) << 8) | ((unsigned)(127 - (nb * 32 + 2 + 8 * j)) << 16) | ((unsigned)(127 - (nb * 32 + 3 + 8 * j)) << 24);
                    K[nb * 16 + r] = __builtin_amdgcn_perm(o, pack, 0x07060500u | (unsigned)(r & 3)); }
                __builtin_amdgcn_sched_barrier(0); }
            __builtin_amdgcn_sched_barrier(0); top16of64(K); __builtin_amdgcn_sched_barrier(0);
#pragma unroll
            for (int i = 0; i < 16; ++i) K[i] ^= h4;
            unsigned C[16];
#pragma unroll
            for (int i = 0; i < 16; ++i) { const unsigned y = (unsigned)__shfl_xor((int)K[15 - i], 32); C[i] = K[i] > y ? K[i] : y; }
            bitonic_merge16_desc<0, 16>(C);
#pragma unroll
            for (int i = 0; i < 16; ++i) { if (half == 0) V1[i] = C[i]; else V2[i] = C[i]; }
            __builtin_amdgcn_sched_barrier(0);
        }
        float f1[16], f2[16];
#pragma unroll
        for (int a = 0; a < 16; ++a) { I1s[a * 64 + lane] = 127u - (V1[a] & 127u); I2s[a * 64 + lane] = 127u - (V2[a] & 127u); f1[a] = ord2f(V1[a] & ~127u); f2[a] = ord2f(V2[a] & ~127u); }
        __builtin_amdgcn_sched_barrier(0);
        unsigned Cd[64];
    Cd[0] = (f2ord(f1[0] + f2[0]) & ~255u) | 255u;
    Cd[1] = (f2ord(f1[0] + f2[1]) & ~255u) | 254u;
    Cd[2] = (f2ord(f1[0] + f2[2]) & ~255u) | 253u;
    Cd[3] = (f2ord(f1[0] + f2[3]) & ~255u) | 252u;
    Cd[4] = (f2ord(f1[0] + f2[4]) & ~255u) | 251u;
    Cd[5] = (f2ord(f1[0] + f2[5]) & ~255u) | 250u;
    Cd[6] = (f2ord(f1[0] + f2[6]) & ~255u) | 249u;
    Cd[7] = (f2ord(f1[0] + f2[7]) & ~255u) | 248u;
    Cd[8] = (f2ord(f1[0] + f2[8]) & ~255u) | 247u;
    Cd[9] = (f2ord(f1[0] + f2[9]) & ~255u) | 246u;
    Cd[10] = (f2ord(f1[0] + f2[10]) & ~255u) | 245u;
    Cd[11] = (f2ord(f1[0] + f2[11]) & ~255u) | 244u;
    Cd[12] = (f2ord(f1[0] + f2[12]) & ~255u) | 243u;
    Cd[13] = (f2ord(f1[0] + f2[13]) & ~255u) | 242u;
    Cd[14] = (f2ord(f1[0] + f2[14]) & ~255u) | 241u;
    Cd[15] = (f2ord(f1[0] + f2[15]) & ~255u) | 240u;
    Cd[16] = (f2ord(f1[1] + f2[0]) & ~255u) | 239u;
    Cd[17] = (f2ord(f1[1] + f2[1]) & ~255u) | 238u;
    Cd[18] = (f2ord(f1[1] + f2[2]) & ~255u) | 237u;
    Cd[19] = (f2ord(f1[1] + f2[3]) & ~255u) | 236u;
    Cd[20] = (f2ord(f1[1] + f2[4]) & ~255u) | 235u;
    Cd[21] = (f2ord(f1[1] + f2[5]) & ~255u) | 234u;
    Cd[22] = (f2ord(f1[1] + f2[6]) & ~255u) | 233u;
    Cd[23] = (f2ord(f1[1] + f2[7]) & ~255u) | 232u;
    Cd[24] = (f2ord(f1[2] + f2[0]) & ~255u) | 223u;
    Cd[25] = (f2ord(f1[2] + f2[1]) & ~255u) | 222u;
    Cd[26] = (f2ord(f1[2] + f2[2]) & ~255u) | 221u;
    Cd[27] = (f2ord(f1[2] + f2[3]) & ~255u) | 220u;
    Cd[28] = (f2ord(f1[2] + f2[4]) & ~255u) | 219u;
    Cd[29] = (f2ord(f1[3] + f2[0]) & ~255u) | 207u;
    Cd[30] = (f2ord(f1[3] + f2[1]) & ~255u) | 206u;
    Cd[31] = (f2ord(f1[3] + f2[2]) & ~255u) | 205u;
    Cd[32] = (f2ord(f1[3] + f2[3]) & ~255u) | 204u;
    Cd[33] = (f2ord(f1[4] + f2[0]) & ~255u) | 191u;
    Cd[34] = (f2ord(f1[4] + f2[1]) & ~255u) | 190u;
    Cd[35] = (f2ord(f1[4] + f2[2]) & ~255u) | 189u;
    Cd[36] = (f2ord(f1[5] + f2[0]) & ~255u) | 175u;
    Cd[37] = (f2ord(f1[5] + f2[1]) & ~255u) | 174u;
    Cd[38] = (f2ord(f1[6] + f2[0]) & ~255u) | 159u;
    Cd[39] = (f2ord(f1[6] + f2[1]) & ~255u) | 158u;
    Cd[40] = (f2ord(f1[7] + f2[0]) & ~255u) | 143u;
    Cd[41] = (f2ord(f1[7] + f2[1]) & ~255u) | 142u;
    Cd[42] = (f2ord(f1[8] + f2[0]) & ~255u) | 127u;
    Cd[43] = (f2ord(f1[9] + f2[0]) & ~255u) | 111u;
    Cd[44] = (f2ord(f1[10] + f2[0]) & ~255u) | 95u;
    Cd[45] = (f2ord(f1[11] + f2[0]) & ~255u) | 79u;
    Cd[46] = (f2ord(f1[12] + f2[0]) & ~255u) | 63u;
    Cd[47] = (f2ord(f1[13] + f2[0]) & ~255u) | 47u;
    Cd[48] = (f2ord(f1[14] + f2[0]) & ~255u) | 31u;
    Cd[49] = (f2ord(f1[15] + f2[0]) & ~255u) | 15u;
    Cd[50] = 0u;
    Cd[51] = 0u;
    Cd[52] = 0u;
    Cd[53] = 0u;
    Cd[54] = 0u;
    Cd[55] = 0u;
    Cd[56] = 0u;
    Cd[57] = 0u;
    Cd[58] = 0u;
    Cd[59] = 0u;
    Cd[60] = 0u;
    Cd[61] = 0u;
    Cd[62] = 0u;
    Cd[63] = 0u;
        __builtin_amdgcn_sched_barrier(0); top16of64(Cd); __builtin_amdgcn_sched_barrier(0);
        LDS_WAIT();
        unsigned eid[16]; float e[16]; float sum = 0.f; const float v0 = ord2f(Cd[0] & ~255u);
#pragma unroll
        for (int r = 0; r < 16; ++r) { const unsigned c = 255u - (Cd[r] & 255u); eid[r] = I1s[(c >> 4) * 64 + lane] * 128u + I2s[(c & 15u) * 64 + lane];
            e[r] = __builtin_amdgcn_exp2f((ord2f(Cd[r] & ~255u) - v0) * LOG2E); sum += e[r]; }
        const float inv = 1.f / sum;
        u32x4 ew; ew.x = (hi ? eid[8] : eid[0]) | ((hi ? eid[9] : eid[1]) << 16); ew.y = (hi ? eid[10] : eid[2]) | ((hi ? eid[11] : eid[3]) << 16);
        ew.z = (hi ? eid[12] : eid[4]) | ((hi ? eid[13] : eid[5]) << 16); ew.w = (hi ? eid[14] : eid[6]) | ((hi ? eid[15] : eid[7]) << 16);
        *(u32x4*)(EID + (size_t)t * 128 + h * 16 + 8 * hi) = ew;
        const f32x4 g0 = {(hi ? e[8] : e[0]) * inv, (hi ? e[9] : e[1]) * inv, (hi ? e[10] : e[2]) * inv, (hi ? e[11] : e[3]) * inv};
        const f32x4 g1 = {(hi ? e[12] : e[4]) * inv, (hi ? e[13] : e[5]) * inv, (hi ? e[14] : e[6]) * inv, (hi ? e[15] : e[7]) * inv};
        *(f32x4*)(GATE + (size_t)t * 128 + h * 16 + 8 * hi) = g0; *(f32x4*)(GATE + (size_t)t * 128 + h * 16 + 8 * hi + 4) = g1;
        LDS_WAIT();
    }
}

typedef float f32x2 __attribute__((ext_vector_type(2)));
__device__ __forceinline__ float dpp_f(float v, int sel) {
    const int iv = __builtin_bit_cast(int, v); int r;
    if (sel == 0) r = __builtin_amdgcn_update_dpp(0, iv, 0xB1, 0xf, 0xf, true); else if (sel == 1) r = __builtin_amdgcn_update_dpp(0, iv, 0x4E, 0xf, 0xf, true); else r = __builtin_amdgcn_update_dpp(0, iv, 0x141, 0xf, 0xf, true);
    return __builtin_bit_cast(float, r);
}
__device__ __forceinline__ float gelu_erf(float v) {
    const float av = fabsf(v), d = av * 0.2316418882f + 1.0f; const float t = __builtin_amdgcn_rcpf(d);
    float q = t * 0.5307027145f + (-0.7265760135f); q = q * t + 0.7107068705f; q = q * t + (-0.142248368f); q = q * t + 0.127414796f; q = q * t;
    const float e = __builtin_amdgcn_exp2f((v * v) * (-0.72134752044f));
    const float m = v * (q * e), r = v - m; return v < 0.f ? m : r;
}
typedef _Float16 h16x2 __attribute__((ext_vector_type(2)));
__device__ __forceinline__ h16x2 bf8_lo2(unsigned w) { return __builtin_bit_cast(h16x2, __builtin_amdgcn_perm(0u, w, 0x010c000cu)); }
__device__ __forceinline__ h16x2 bf8_hi2(unsigned w) { return __builtin_bit_cast(h16x2, __builtin_amdgcn_perm(0u, w, 0x030c020cu)); }
__device__ __forceinline__ h16x2 bf16pair_to_h2(unsigned w) { h16x2 r; r.x = (_Float16)bf_lo(w); r.y = (_Float16)bf_hi(w); return r; }
#define PEER_E(ev0_, ev1_, w_) (int)((((w_) < 8 ? (ev0_) : (ev1_))[((w_) & 7) >> 1] >> (16 * ((w_) & 1))) & 0xffffu)
#define GLD4(dst_, ptr_) asm volatile("global_load_dword %0, %1, off" : "=v"(dst_) : "v"(ptr_) : "memory")
#define GLD8(dst_, ptr_) asm volatile("global_load_dwordx2 %0, %1, off" : "=v"(dst_) : "v"(ptr_) : "memory")
#define GLD16(dst_, ptr_) asm volatile("global_load_dwordx4 %0, %1, off" : "=v"(dst_) : "v"(ptr_) : "memory")
#define GLDS16(dst_, off_, base_) asm volatile("global_load_dwordx4 %0, %1, %2" : "=v"(dst_) : "v"(off_), "s"(base_) : "memory")
typedef int i32x4 __attribute__((ext_vector_type(4)));
__device__ __forceinline__ int sdot8_z(int a, int b) { int d; asm("v_dot8_i32_i4 %0, %1, %2, 0" : "=v"(d) : "v"(a), "v"(b)); return d; }
__device__ __forceinline__ int sdot4_z(int a, int b) { int d; asm("v_dot4_i32_i8 %0, %1, %2, 0" : "=v"(d) : "v"(a), "v"(b)); return d; }
__device__ __forceinline__ unsigned u_quant4(u32x2 w, unsigned sqbits) {
    float sq = __uint_as_float(sqbits); sq += dpp_row_shr(sq, 1); sq += dpp_row_shr(sq, 2); sq += dpp_row_shr(sq, 4); sq += dpp_row_shr(sq, 8);
    sq = __builtin_bit_cast(float, __builtin_amdgcn_readlane(__builtin_bit_cast(int, sq), 15));
    const float sx = __builtin_amdgcn_rsqf(sq * (1.f / DM) + RMS_EPS) * I8_SX;
    const float v[4] = {bf_lo(w.x), bf_hi(w.x), bf_lo(w.y), bf_hi(w.y)}; unsigned A = 0u, B = 0u;
#pragma unroll
    for (int k = 0; k < 4; ++k) { int q = __float2int_rn(v[k] * sx); q = q < -120 ? -120 : (q > 119 ? 119 : q); const int a = (q + 8) >> 4, bb = q - 16 * a;
        A |= ((unsigned)a & 0xfu) << (4 * k); B |= ((unsigned)bb & 0xfu) << (4 * k); }
    return A | (B << 16);
}
template <int CP> __device__ __forceinline__ unsigned peer_bc_t(unsigned ev) { return (unsigned)__builtin_amdgcn_update_dpp(__builtin_amdgcn_update_dpp(0, (int)ev, 0x150 + CP, 0xf, 0x3, false), (int)ev, 0x158 + CP, 0xf, 0xc, false); }
__device__ __forceinline__ unsigned peer_bc(unsigned ev, int cp) {
    switch (cp) { case 0: return peer_bc_t<0>(ev); case 1: return peer_bc_t<1>(ev); case 2: return peer_bc_t<2>(ev); case 3: return peer_bc_t<3>(ev);
                  case 4: return peer_bc_t<4>(ev); case 5: return peer_bc_t<5>(ev); case 6: return peer_bc_t<6>(ev); default: return peer_bc_t<7>(ev); }
}
#define PEER_BC(ev_, cp_) peer_bc((ev_), (cp_))
#define PEER_E2(bc_, w_) (((w_) & 1) ? ((bc_) >> 16) : ((bc_) & 0xffffu))
__device__ __forceinline__ void phase_peer_u(Frame& F, const bf16_t* XB, const float* rsp, int rsmode, const unsigned short* EID, const unsigned char* U8S, int* PREP) {
    const int lane = opaque_i(F.lane), i16 = (lane >> 3) * 16, c = lane & 7, b = (int)blockIdx.x, x = b & 3, step = (F.G >> 2) * NWAVES;
    const unsigned c16 = 16u * (unsigned)c;
    const unsigned char* tabs = U8S + (size_t)x * NEXP * 128;
    LAS unsigned char* xl = F.lds + F.wave * 512;
    int t = (b >> 2) * NWAVES + F.wave; unsigned slot = 0;
    unsigned evB; u32x4 uw[16]; u32x2 xwA; unsigned sqA;
    {   unsigned e0 = *(const unsigned*)(EID + (size_t)t * 128 + i16 + 2 * c);
        u32x2 xw0 = *(const u32x2*)(XB + (size_t)t * DM + 256 * x + 4 * lane); unsigned sq0 = __float_as_uint(rsp[(size_t)t * 16 + (lane & 15)]);
        const int tn = (t + step < TOK) ? t + step : t;
        evB = *(const unsigned*)(EID + (size_t)tn * 128 + i16 + 2 * c);
        xwA = *(const u32x2*)(XB + (size_t)tn * DM + 256 * x + 4 * lane); sqA = __float_as_uint(rsp[(size_t)tn * 16 + (lane & 15)]);
        asm volatile("s_waitcnt vmcnt(0)" : "+v"(evB), "+v"(e0), "+v"(xwA), "+v"(sqA), "+v"(xw0), "+v"(sq0) :: "memory");
        { const unsigned ab = u_quant4(xw0, sq0); *(LAS unsigned short*)(xl + 2 * lane) = (unsigned short)ab; *(LAS unsigned short*)(xl + 128 + 2 * lane) = (unsigned short)(ab >> 16); }
#pragma unroll
        for (int w = 0; w < 16; w += 2) { const unsigned bc = PEER_BC(e0, w >> 1); const unsigned off0 = (PEER_E2(bc, 0) << 7) | c16, off1 = (PEER_E2(bc, 1) << 7) | c16; GLDS16(uw[w], off0, tabs); GLDS16(uw[w + 1], off1, tabs); } }
#pragma unroll 1
    for (; t < TOK; t += step) {
        const int tnn = (t + 2 * step < TOK) ? t + 2 * step : t;
        unsigned evC, sqC, bcw = 0u; u32x2 xwC;
        { const unsigned short* ep = EID + (size_t)tnn * 128 + i16 + 2 * c; const bf16_t* xp = XB + (size_t)tnn * DM + 256 * x + 4 * lane; const float* sp = rsp + (size_t)tnn * 16 + (lane & 15);
          GLD4(evC, ep); GLD8(xwC, xp); GLD4(sqC, sp); }
        { const unsigned ab = u_quant4(xwA, sqA); *(LAS unsigned short*)(xl + (slot ^ 256u) + 2 * lane) = (unsigned short)ab; *(LAS unsigned short*)(xl + (slot ^ 256u) + 128 + 2 * lane) = (unsigned short)(ab >> 16); }
        const u32x4 xa = *(LAS const u32x4*)(xl + slot + c16), xb = *(LAS const u32x4*)(xl + slot + 128 + c16);
        slot ^= 256u;
        int p[16];
#pragma unroll
        for (int w = 0; w < 16; ++w) {
            asm volatile("s_waitcnt vmcnt(18)" : "+v"(uw[w]) :: "memory");
            int a = sdot8_z((int)uw[w][0], (int)xa[0]), bl = sdot8_z((int)uw[w][0], (int)xb[0]);
#pragma unroll
            for (int k = 1; k < 4; ++k) { a = __builtin_amdgcn_sdot8((int)uw[w][k], (int)xa[k], a, false); bl = __builtin_amdgcn_sdot8((int)uw[w][k], (int)xb[k], bl, false); }
            p[w] = (a << 4) + bl;
            asm volatile("" : "+v"(p[w]));
            if ((w & 1) == 0) bcw = PEER_BC(evB, w >> 1);
            { const unsigned off = (PEER_E2(bcw, w) << 7) | c16; GLDS16(uw[w], off, tabs); }
        }
        asm volatile("s_nop 1\n\t"
#define UA_(k_, k8_) "v_add_u32_dpp %" #k_ ", %" #k_ ", %" #k_ " row_shl:4 row_mask:0xf bank_mask:0x5\n\t" "v_add_u32_dpp %" #k_ ", %" #k8_ ", %" #k8_ " row_shr:4 row_mask:0xf bank_mask:0xa\n\t"
            UA_(0, 8) UA_(1, 9) UA_(2, 10) UA_(3, 11) UA_(4, 12) UA_(5, 13) UA_(6, 14) UA_(7, 15)
#undef UA_
#define UB_(k_) "v_add_u32_dpp %" #k_ ", %" #k_ ", %" #k_ " quad_perm:[2,3,0,1] row_mask:0xf bank_mask:0xf\n\t"
            UB_(0) UB_(1) UB_(2) UB_(3) UB_(4) UB_(5) UB_(6) UB_(7)
#undef UB_
#define UC_(k_) "v_add_u32_dpp %" #k_ ", %" #k_ ", %" #k_ " quad_perm:[1,0,3,2] row_mask:0xf bank_mask:0xf\n\t"
            UC_(0) UC_(1) UC_(2) UC_(3) UC_(4) UC_(5) UC_(6) UC_(7)
#undef UC_
            "s_nop 0"
            : "+v"(p[0]), "+v"(p[1]), "+v"(p[2]), "+v"(p[3]), "+v"(p[4]), "+v"(p[5]), "+v"(p[6]), "+v"(p[7])
            : "v"(p[8]), "v"(p[9]), "v"(p[10]), "v"(p[11]), "v"(p[12]), "v"(p[13]), "v"(p[14]), "v"(p[15]));
        if ((c & 3) == 0) {
            int* dst = PREP + ((size_t)x * TOK + t) * 128 + i16 + 2 * c;
            __builtin_nontemporal_store(i32x4{p[0], p[1], p[2], p[3]}, (i32x4*)dst); __builtin_nontemporal_store(i32x4{p[4], p[5], p[6], p[7]}, (i32x4*)(dst + 4)); }
        asm volatile("s_waitcnt vmcnt(16)" : "+v"(evC), "+v"(xwC), "+v"(sqC) :: "memory");
        evB = evC; xwA = xwC; sqA = sqC;
    }
    asm volatile("s_waitcnt vmcnt(0)" ::: "memory");
}
__device__ __forceinline__ void phase_peer_c(Frame& F, const int* PREP, const float* GATE, unsigned char* ACO8, float* ASC  ) {
    const int gw = F.vcu * NWAVES + F.wave, NGW = F.G * NWAVES, lane = opaque_i(F.lane);
    for (int t = gw; t < TOK; t += NGW) {
        int i0 = 0, i1 = 0;
#pragma unroll
        for (int x = 0; x < 4; ++x) { const int* p = PREP + ((size_t)x * TOK + t) * 128; i0 += p[lane]; i1 += p[64 + lane]; }
        const float rsu = 1.f / (I4_SU * I8_SX);
        const float a0 = gelu_erf((float)i0 * rsu) * GATE[(size_t)t * 128 + lane], a1 = gelu_erf((float)i1 * rsu) * GATE[(size_t)t * 128 + 64 + lane];
        float m = fmaxf(fabsf(a0), fabsf(a1));
#pragma unroll
        for (int o = 32; o >= 1; o >>= 1) m = fmaxf(m, __shfl_xor(m, o));
        const float inv = m > 0.f ? 127.f / m : 0.f;
        const int q0 = __float2int_rn(a0 * inv), q1 = __float2int_rn(a1 * inv);
        ACO8[(size_t)t * 128 + lane] = (unsigned char)(q0 & 0xff); ACO8[(size_t)t * 128 + 64 + lane] = (unsigned char)(q1 & 0xff);
        const float sa = wave_total((float)(q0 + q1)), scl = m * (1.f / (127.f * I4_SV));
        if (lane == 0) { ASC[2 * (size_t)t] = scl; ASC[2 * (size_t)t + 1] = 8.f * sa * scl; }
    }
}
#define PIN16(o_) asm volatile("" : "+v"(o_[0]), "+v"(o_[1]), "+v"(o_[2]), "+v"(o_[3]), "+v"(o_[4]), "+v"(o_[5]), "+v"(o_[6]), "+v"(o_[7]), "+v"(o_[8]), "+v"(o_[9]), "+v"(o_[10]), "+v"(o_[11]), "+v"(o_[12]), "+v"(o_[13]), "+v"(o_[14]), "+v"(o_[15]))
__device__ __forceinline__ void red16_groups(const int (&o)[16], bool b3, int& r0, int& r1) {
    int h8[8], h4[4];
#pragma unroll
    for (int k = 0; k < 8; ++k) { const auto r = __builtin_amdgcn_permlane32_swap((unsigned)o[k], (unsigned)o[8 + k], false, false); h8[k] = (int)r[0] + (int)r[1]; }
#pragma unroll
    for (int k = 0; k < 4; ++k) { const auto r = __builtin_amdgcn_permlane16_swap((unsigned)h8[k], (unsigned)h8[4 + k], false, false); h4[k] = (int)r[0] + (int)r[1]; }
    { const int keep = b3 ? h4[2] : h4[0], send = b3 ? h4[0] : h4[2]; r0 = keep + __builtin_amdgcn_update_dpp(0, send, 0x128, 0xf, 0xf, true); }
    { const int keep = b3 ? h4[3] : h4[1], send = b3 ? h4[1] : h4[3]; r1 = keep + __builtin_amdgcn_update_dpp(0, send, 0x128, 0xf, 0xf, true); }
}
__device__ __forceinline__ void phase_peer_v(Frame& F, bf16_t* XB, const unsigned short* EID, const unsigned char* ACO8, const float* ASC, const unsigned char* V4S, float* SSQP) {
    const int lane = opaque_i(F.lane), i16 = (lane >> 3) * 16, c = lane & 7, b = (int)blockIdx.x, x = b & 3, step = (F.G >> 2) * NWAVES;
    const unsigned c16 = 16u * (unsigned)c;
    const unsigned char* tabs = V4S + (size_t)x * NEXP * 128;
    const bool b3 = lane & 8;
    const int col = 256 * x + 32 * c + ((lane & 32) ? 16 : 0) + ((lane & 16) ? 8 : 0) + (b3 ? 4 : 0);
    int t = (b >> 2) * NWAVES + F.wave;
    u32x4 aA, vw[16]; unsigned evB; u32x2 xfA, scA;
    {   unsigned e0 = *(const unsigned*)(EID + (size_t)t * 128 + i16 + 2 * c);
        aA = *(const u32x4*)(ACO8 + (size_t)t * 128 + i16);
        xfA = *(const u32x2*)(XB + (size_t)t * DM + col); scA = *(const u32x2*)(ASC + 2 * (size_t)t);
        const int tn = (t + step < TOK) ? t + step : t;
        evB = *(const unsigned*)(EID + (size_t)tn * 128 + i16 + 2 * c);
        asm volatile("s_waitcnt vmcnt(0)" : "+v"(evB), "+v"(e0), "+v"(aA), "+v"(xfA), "+v"(scA) :: "memory");
#pragma unroll
        for (int w = 0; w < 16; w += 2) { const unsigned bc = PEER_BC(e0, w >> 1); const unsigned off0 = (PEER_E2(bc, 0) << 7) | c16, off1 = (PEER_E2(bc, 1) << 7) | c16; GLDS16(vw[w], off0, tabs); GLDS16(vw[w + 1], off1, tabs); } }
#pragma unroll 1
    for (; t < TOK; t += step) {
        const int tn = (t + step < TOK) ? t + step : t, tnn = (t + 2 * step < TOK) ? t + 2 * step : t;
        u32x4 aB; unsigned evC; u32x2 xfB, scB;
        { const unsigned short* ep = EID + (size_t)tnn * 128 + i16 + 2 * c; const unsigned char* ap = ACO8 + (size_t)tn * 128 + i16; const bf16_t* xp = XB + (size_t)tn * DM + col; const float* sp = ASC + 2 * (size_t)tn;
          GLD4(evC, ep); GLD16(aB, ap); GLD8(xfB, xp); GLD8(scB, sp); }
        int oL[16], oP[16];
#pragma unroll
        for (int w = 0; w < 16; w += 4) {
            asm volatile("s_waitcnt vmcnt(16)" : "+v"(vw[w]), "+v"(vw[w + 1]), "+v"(vw[w + 2]), "+v"(vw[w + 3]) :: "memory");
            const int a4 = (int)aA[w >> 2];
#pragma unroll
            for (int k = 0; k < 4; ++k) { const unsigned d0 = vw[w][k], d1 = vw[w + 1][k], d2 = vw[w + 2][k], d3 = vw[w + 3][k];
                const unsigned q01l = __builtin_amdgcn_perm(d1, d0, 0x05010400u), q01h = __builtin_amdgcn_perm(d1, d0, 0x07030602u), q23l = __builtin_amdgcn_perm(d3, d2, 0x05010400u), q23h = __builtin_amdgcn_perm(d3, d2, 0x07030602u);
                const int t0 = (int)__builtin_amdgcn_perm(q23l, q01l, 0x05040100u), t1 = (int)__builtin_amdgcn_perm(q23l, q01l, 0x07060302u), t2 = (int)__builtin_amdgcn_perm(q23h, q01h, 0x05040100u), t3 = (int)__builtin_amdgcn_perm(q23h, q01h, 0x07060302u);
                const int l0 = t0 & 0x0f0f0f0f, l1 = t1 & 0x0f0f0f0f, l2 = t2 & 0x0f0f0f0f, l3 = t3 & 0x0f0f0f0f;
                if (w == 0) { oL[4 * k] = sdot4_z(l0, a4); oL[4 * k + 1] = sdot4_z(l1, a4); oL[4 * k + 2] = sdot4_z(l2, a4); oL[4 * k + 3] = sdot4_z(l3, a4);
                              oP[4 * k] = sdot4_z(t0, a4); oP[4 * k + 1] = sdot4_z(t1, a4); oP[4 * k + 2] = sdot4_z(t2, a4); oP[4 * k + 3] = sdot4_z(t3, a4); }
                else { oL[4 * k]     = __builtin_amdgcn_sdot4(l0, a4, oL[4 * k], false);     oL[4 * k + 1] = __builtin_amdgcn_sdot4(l1, a4, oL[4 * k + 1], false);
                       oL[4 * k + 2] = __builtin_amdgcn_sdot4(l2, a4, oL[4 * k + 2], false); oL[4 * k + 3] = __builtin_amdgcn_sdot4(l3, a4, oL[4 * k + 3], false);
                       oP[4 * k]     = __builtin_amdgcn_sdot4(t0, a4, oP[4 * k], false);     oP[4 * k + 1] = __builtin_amdgcn_sdot4(t1, a4, oP[4 * k + 1], false);
                       oP[4 * k + 2] = __builtin_amdgcn_sdot4(t2, a4, oP[4 * k + 2], false); oP[4 * k + 3] = __builtin_amdgcn_sdot4(t3, a4, oP[4 * k + 3], false); } }
            PIN16(oL); PIN16(oP);
            { const unsigned bc0 = PEER_BC(evB, w >> 1), bc1 = PEER_BC(evB, (w >> 1) + 1);
              const unsigned off0 = (PEER_E2(bc0, 0) << 7) | c16, off1 = (PEER_E2(bc0, 1) << 7) | c16, off2 = (PEER_E2(bc1, 0) << 7) | c16, off3 = (PEER_E2(bc1, 1) << 7) | c16;
              GLDS16(vw[w], off0, tabs); GLDS16(vw[w + 1], off1, tabs); GLDS16(vw[w + 2], off2, tabs); GLDS16(vw[w + 3], off3, tabs); } }
        int L0, L1, P0, P1; red16_groups(oL, b3, L0, L1); red16_groups(oP, b3, P0, P1);
        const float sc = __uint_as_float(scA.x), corr = __uint_as_float(scA.y);
        const float f0 = bf_lo(xfA.x) + ((float)L0 * sc - corr), f1 = bf_hi(xfA.x) + (float)((P0 - L0) >> 4) * sc, f2 = bf_lo(xfA.y) + ((float)L1 * sc - corr), f3 = bf_hi(xfA.y) + (float)((P1 - L1) >> 4) * sc;
        { u32x2 st; st.x = pk2(f0, f1); st.y = pk2(f2, f3); *(u32x2*)(XB + (size_t)t * DM + col) = st; }
        const float ss = wave_total((f0 * f0 + f1 * f1) + (f2 * f2 + f3 * f3));
        if (lane == 0) { float* sp = SSQP + (size_t)t * 16 + x; sp[0] = ss; sp[4] = 0.f; sp[8] = 0.f; sp[12] = 0.f; }
        asm volatile("s_waitcnt vmcnt(16)" : "+v"(evC), "+v"(aB), "+v"(xfB), "+v"(scB) :: "memory");
        aA = aB; evB = evC; xfA = xfB; scA = scB;
    }
    asm volatile("s_waitcnt vmcnt(0)" ::: "memory");
}

__device__ __forceinline__ void phase_final_norm(Frame& F, const bf16_t* XB, float* OUT, const float* SSQP, const float* norm_f) {
    const int gw = F.vcu * NWAVES + F.wave, NGW = F.G * NWAVES, lane = opaque_i(F.lane);
    for (int t = gw; t < TOK; t += NGW) { const float r = row_scale(SSQP, 1, t);
#pragma unroll
        for (int j = 0; j < 4; ++j) { const u32x2 w = *(const u32x2*)(XB + (size_t)t * DM + 256 * j + 4 * lane); const f32x4 x = {bf_lo(w.x), bf_hi(w.x), bf_lo(w.y), bf_hi(w.y)};
            __builtin_nontemporal_store(x * r * *(const f32x4*)(norm_f + 256 * j + 4 * lane), (f32x4*)(OUT + (size_t)t * DM + 256 * j + 4 * lane)); } }
}

constexpr int N_PHASES = 20;
struct Args { const float* in[16]; float* out; unsigned char* ws; int ph_lo, ph_hi; };
template <bool COOP>
__global__ void __launch_bounds__(NWAVES * 64, 2) mk_fwd(Args args) {
    extern __shared__ __attribute__((aligned(16))) unsigned char lds[];
    Frame F;
    F.lds = (LAS unsigned char*)lds;
    F.tid = threadIdx.x; F.lane = F.tid & 63; F.wave = __builtin_amdgcn_readfirstlane(F.tid >> 6);
    F.G = gridDim.x; { const int bx = blockIdx.x; F.vcu = (F.G % 8 == 0) ? (bx % 8) * (F.G / 8) + bx / 8 : bx; }
    Ptrs P;
    P.x = args.in[0]; P.norm_mix = args.in[1]; P.norm_ffn = args.in[2]; P.ev_w_in = args.in[3]; P.ev_b_f = args.in[4]; P.ev_w_out = args.in[5]; P.od_w_in = args.in[6];
    P.od_pool_w = args.in[7]; P.od_pool_scale = args.in[8]; P.od_w_out = args.in[9]; P.peer_wq = args.in[10]; P.peer_k1 = args.in[11]; P.peer_k2 = args.in[12];
    P.peer_u = args.in[13]; P.peer_v = args.in[14]; P.norm_f = args.in[15]; P.out = args.out; P.ws = args.ws;
    unsigned char* ws = args.ws;
    bf16_t* XB = (bf16_t*)(ws + WS_XB); bf16_t* AO = (bf16_t*)(ws + WS_AO); bf16_t* QP = (bf16_t*)(ws + WS_QP);
    unsigned short* EID = (unsigned short*)(ws + WS_EID); float* GATE = (float*)(ws + WS_GATE);
    float* RS0 = (float*)(ws + WS_RS0); float* SSQ2 = (float*)(ws + WS_SSQ2); int* PREP = (int*)(ws + WS_PREP); unsigned char* ACO8 = ws + WS_ACO; float* ASC = (float*)(ws + WS_ACO + 8 * MiB); float* SSQ1 = (float*)(ws + WS_SSQ1); float* SSQ3 = (float*)(ws + WS_SSQ3);
    const int lo = args.ph_lo, hi = args.ph_hi;
    volatile LAS unsigned* xbst = (volatile LAS unsigned*)(F.lds + LDS_BYTES - 64);
    if (F.tid < 4) xbst[F.tid] = 0u;
    __syncthreads();
    XcdBarrier xbar; xbar.bar = (unsigned*)(ws + WS_CTL) + 4096; xbar.x = 0; xbar.st = xbst;
    if (COOP) xbar = xcd_barrier_post((unsigned*)(ws + WS_CTL) + 4096, xbst);
#define IN(k) (lo <= (k) && (k) < hi)
#define SEAM(k) do { if (COOP && IN(k) && IN((k) + 1)) xcd_barrier(xbar); } while (0)
    if (COOP && lo < 0) cg::this_grid().sync();
    if (IN(0)) { phase_p0(F, P); } SEAM(0);
    if (IN(1)) {
        pg8::Gemm g{XB, (const bf16_t*)(ws + WS_W1T), TOK, 3072, DM}; pg8::StaticOrder S; S.init(TOK, 3072, F.G, (int)blockIdx.x);
        EpiL0In E{RS0, (bf16_t*)(ws + WS_QH), (bf16_t*)(ws + WS_KH), (bf16_t*)(ws + WS_VT), (float*)(ws + WS_LF), P.ev_b_f};
        pg8::gemm_phase<EpiL0In, pg8::StaticOrder, true, true>(F.lds, g, S, E);
    } SEAM(1);
    if (IN(3)) {
        phase_attn_fox(F, (const bf16_t*)(ws + WS_QH), (const bf16_t*)(ws + WS_KH), (const bf16_t*)(ws + WS_VT), (const float*)(ws + WS_LF), (float*)(ws + WS_CF), AO);
        phase_attn<1>(F, (const bf16_t*)(ws + WS_QH), (const bf16_t*)(ws + WS_KH), (const bf16_t*)(ws + WS_VT), 16, 8, nullptr, nullptr, AO, 512);
    } SEAM(3);
    if (IN(4)) {
        pg8::Gemm g{AO, (const bf16_t*)(ws + WS_W2T), TOK, DM, DM}; pg8::StaticOrder S; S.init(TOK, DM, F.G, (int)blockIdx.x);
        EpiRes<false> E{P.x, XB, SSQ1};
        pg8::gemm_phase<EpiRes<false>, pg8::StaticOrder, true, true>(F.lds, g, S, E);
    } SEAM(4);
    if (IN(5)) {
        pg8::Gemm g{XB, (const bf16_t*)(ws + WS_W3T), TOK, 2048, DM}; pg8::StaticOrder S; S.init(TOK, 2048, F.G, (int)blockIdx.x);
        EpiQ E{SSQ1, 1, QP};
        pg8::gemm_phase<EpiQ, pg8::StaticOrder, true, true>(F.lds, g, S, E);
    } SEAM(5);
    if (IN(6)) { phase_topk(F, QP, (const bf16_t*)(ws + WS_K1B), (const bf16_t*)(ws + WS_K2B), EID, GATE); } SEAM(6);
    if (IN(7)) { phase_peer_u(F, XB, SSQ1, 1, EID, ws + WS_U8S, PREP); } SEAM(7);
    if (IN(8)) { phase_peer_c(F, PREP, GATE, ACO8, ASC); } SEAM(8);
    if (IN(9)) { phase_peer_v(F, XB, EID, ACO8, ASC, ws + WS_V8S, SSQ2); } SEAM(9);
    if (IN(10)) {
        pg8::Gemm g{XB, (const bf16_t*)(ws + WS_W4T), TOK, 2048, DM}; pg8::StaticOrder S; S.init(TOK, 2048, F.G, (int)blockIdx.x);
        EpiL1In E{SSQ2, 1, (bf16_t*)(ws + WS_QH), (bf16_t*)(ws + WS_QH + 32 * MiB), (bf16_t*)(ws + WS_KH), (bf16_t*)(ws + WS_KH + 32 * MiB)};
        pg8::gemm_phase<EpiL1In, pg8::StaticOrder, true, true>(F.lds, g, S, E);
    } SEAM(10);
    if (IN(12)) {
        phase_attn_moba(F, (const bf16_t*)(ws + WS_QH + 32 * MiB), (const bf16_t*)(ws + WS_KH), (const bf16_t*)(ws + WS_KH + 32 * MiB), (float*)(ws + WS_KMEAN), AO);
        phase_pool(F, (const bf16_t*)(ws + WS_QH), (const bf16_t*)(ws + WS_PWT), P.od_pool_scale, AO);
    } SEAM(12);
    if (IN(13)) {
        pg8::Gemm g{AO, (const bf16_t*)(ws + WS_W5T), TOK, DM, DM}; pg8::StaticOrder S; S.init(TOK, DM, F.G, (int)blockIdx.x);
        EpiRes<true> E{XB, XB, SSQ3};
        pg8::gemm_phase<EpiRes<true>, pg8::StaticOrder, true, true>(F.lds, g, S, E);
    } SEAM(13);
    if (IN(14)) {
        pg8::Gemm g{XB, (const bf16_t*)(ws + WS_W6T), TOK, 2048, DM}; pg8::StaticOrder S; S.init(TOK, 2048, F.G, (int)blockIdx.x);
        EpiQ E{SSQ3, 1, QP};
        pg8::gemm_phase<EpiQ, pg8::StaticOrder, true, true>(F.lds, g, S, E);
    } SEAM(14);
    if (IN(15)) { phase_topk(F, QP, (const bf16_t*)(ws + WS_K1B) + 8 * 128 * 128, (const bf16_t*)(ws + WS_K2B) + 8 * 128 * 128, EID, GATE); } SEAM(15);
    if (IN(16)) { phase_peer_u(F, XB, SSQ3, 1, EID, ws + WS_U8S + (size_t)4 * NEXP * 128, PREP); } SEAM(16);
    if (IN(17)) { phase_peer_c(F, PREP, GATE, ACO8, ASC); } SEAM(17);
    if (IN(18)) { phase_peer_v(F, XB, EID, ACO8, ASC, ws + WS_V8S + (size_t)4 * NEXP * 128, SSQ2); } SEAM(18);
    if (IN(19)) { phase_final_norm(F, XB, P.out, SSQ2, P.norm_f); }
#undef IN
#undef SEAM
}

extern "C" void kernel_launch(void* const* d_in, const int* in_sizes, int n_in, void* d_out, int out_size, void* d_ws, size_t ws_size, hipStream_t stream) {
    static int grid = 0;
    constexpr bool COOP = (MK_MULTI == 0);
    if (grid == 0) {
        if (n_in != 16 || in_sizes[0] != TOK * DM || out_size != TOK * DM || ws_size < WS_END) { fprintf(stderr, "kernel_launch: unexpected shapes (n_in %d, in0 %d, out %d, ws %zu)\n", n_in, n_in > 0 ? in_sizes[0] : -1, out_size, ws_size); grid = -1; return; }
        int dev = 0, cus = 0, per_cu = 0;
        if (hipGetDevice(&dev) != hipSuccess || hipDeviceGetAttribute(&cus, hipDeviceAttributeMultiprocessorCount, dev) != hipSuccess) { grid = -1; return; }
        if (hipFuncSetAttribute((const void*)mk_fwd<COOP>, hipFuncAttributeMaxDynamicSharedMemorySize, LDS_BYTES) != hipSuccess) { fprintf(stderr, "kernel_launch: hipFuncSetAttribute failed\n"); grid = -1; return; }
        if (hipOccupancyMaxActiveBlocksPerMultiprocessor(&per_cu, (const void*)mk_fwd<COOP>, NWAVES * 64, LDS_BYTES) != hipSuccess || per_cu < 1) { fprintf(stderr, "kernel_launch: occupancy query says %d\n", per_cu); per_cu = 1; }
        (void)hipGetLastError();
        grid = cus;
    }
    if (grid < 0) return;
    if (hipMemsetAsync((char*)d_ws + WS_CTL, 0, CTL_ZERO_BYTES, stream) != hipSuccess) { fprintf(stderr, "kernel_launch: memset failed\n"); return; }
    Args a{};
    for (int i = 0; i < 16; ++i) a.in[i] = (const float*)d_in[i];
    a.out = (float*)d_out; a.ws = (unsigned char*)d_ws;
    if (COOP) {
        a.ph_lo = 0; a.ph_hi = N_PHASES;
        void* kargs[] = {&a};
        const hipError_t e = hipLaunchCooperativeKernel((const void*)mk_fwd<COOP>, dim3(grid), dim3(NWAVES * 64), kargs, LDS_BYTES, stream);
        if (e != hipSuccess) fprintf(stderr, "kernel_launch: cooperative launch failed: %s (grid %d)\n", hipGetErrorString(e), grid);
    } else {
        for (int p = 0; p < N_PHASES; ++p) { a.ph_lo = p; a.ph_hi = p + 1; hipLaunchKernelGGL(mk_fwd<COOP>, dim3(grid), dim3(NWAVES * 64), LDS_BYTES, stream, a); }
    }
}
```

```cpp
#include <hip/hip_runtime.h>
#include <hip/hip_cooperative_groups.h>
#include <cstdio>
#include <cstdint>
#include <cmath>
namespace cg = cooperative_groups;

#ifndef MK_MULTI
#define MK_MULTI 0
#endif

namespace pg8 {
#define PG8_LAS __attribute__((address_space(3)))
typedef unsigned short bf16_t;
typedef short bf16x8 __attribute__((ext_vector_type(8)));
typedef float f32x4 __attribute__((ext_vector_type(4)));
typedef unsigned u32x4 __attribute__((ext_vector_type(4)));
constexpr int BM = 256, BK = 64, HALF = 128, HTB = HALF * BK * 2  , STAGE_BYTES = 8 * HTB, NXCD = 8, WGM = 8;

__host__ __device__ __forceinline__ int lds_byte(int r, int c) { const int st = (r >> 4) * 2 + (c >> 5), rr = r & 15, cc = c & 31, ob = rr * 64 + cc * 2; return st * 1024 + (ob ^ (((ob >> 9) & 1) << 5)); }
__host__ __device__ __forceinline__ void stage_rc(int b, int& R, int& C) { const int st = b / 1024, sb = b % 1024, swz = sb ^ (((sb >> 9) & 1) << 5); R = (st >> 1) * 16 + swz / 64; C = (st & 1) * 32 + (swz % 64) / 2; }
__host__ __device__ __forceinline__ int perm32(int rho) { const int n = rho >> 4, i = rho & 15; return 8 * (i >> 2) + 4 * n + (i & 3); }

struct Unit { int pm, pn; };
struct Gemm { const bf16_t* A; const bf16_t* Bt; int M, N, K; };

struct StaticOrder {
    int nM, nN, nwg, G, c;
    __host__ __device__ void init(int M, int N, int G_, int c_) { nM = M / BM; nN = N / BM; nwg = nM * nN; G = G_; c = c_; }
    __host__ __device__ bool next(int i, Unit& u) const {
        const long L = (long)i * G + c; if (L >= nwg) return false;
        int wgid = (int)L; { const int q = nwg / NXCD, r = nwg % NXCD, xcd = wgid % NXCD, off = wgid / NXCD; wgid = (xcd < r ? xcd * (q + 1) : r * (q + 1) + (xcd - r) * q) + off; }
        const int nig = WGM * nN, gid = wgid / nig, fm = gid * WGM, gsz = (nM - fm) < WGM ? (nM - fm) : WGM;
        u.pm = fm + ((wgid % nig) % gsz); u.pn = (wgid % nig) / gsz; return true;
    }
    __device__ __forceinline__ void a_ready(const Unit&) const {}
    __device__ __forceinline__ void done(const Unit&) const {}
};
__device__ __forceinline__ unsigned cvt_pk_bf16(float lo, float hi) { unsigned r; asm volatile("v_cvt_pk_bf16_f32 %0, %1, %2" : "=v"(r) : "v"(lo), "v"(hi)); return r; }
template <class Epi, class Sched, bool ALIGN_EPI = false, bool SP2 = false>
__device__ __forceinline__ void gemm_phase(PG8_LAS unsigned char* lds, const Gemm g, const Sched& S, const Epi& E) {
    const int tid = threadIdx.x, wid = __builtin_amdgcn_readfirstlane(tid >> 6), lane = tid & 63, wr = wid >> 2, wc = wid & 3, fr = lane & 15, fq = lane >> 4;
    const int K = g.K, nt = K / BK;
    unsigned voffA[2], voffB[2];
#pragma unroll
    for (int i = 0; i < 2; ++i) { int R, C; stage_rc(tid * 16 + i * 8192, R, C); const int Rb = Epi::PERM ? ((R & ~31) + perm32(R & 31)) : R;
        voffA[i] = (unsigned)(R * K + C) * 2u; voffB[i] = (unsigned)(Rb * K + C) * 2u; }
    const size_t kstep = (size_t)(BK * 2);
    const size_t hstep = (size_t)HALF * K * 2;
    const size_t tstep = 2 * hstep;
    const unsigned ldsw = (unsigned)wid * 1024u;
    const int aoff = lds_byte(wr * 64 + fr, fq * 8), boff = lds_byte(wc * 32 + fr, fq * 8);
#define PG8_SA(b, h) (((b) * 2 + (h)) * HTB)
#define PG8_SB(b, h) ((4 + (b) * 2 + (h)) * HTB)
#define PG8_STAGE(bufoff, gbase, voff) do { _Pragma("unroll") for (int _i = 0; _i < 2; ++_i) \
        __builtin_amdgcn_global_load_lds((const unsigned*)((const char*)(gbase) + (voff)[_i]), (PG8_LAS unsigned*)(lds + (bufoff) + ldsw + _i * 8192), 16, 0, 0); } while (0)
#define PG8_LDA(dst, b, h) do { _Pragma("unroll") for (int m = 0; m < 4; ++m) _Pragma("unroll") for (int k = 0; k < 2; ++k) dst[m][k] = *(const PG8_LAS bf16x8*)(lds + PG8_SA(b, h) + aoff + m * 2048 + k * 1024); } while (0)
#define PG8_LDB(dst, b, h) do { _Pragma("unroll") for (int n = 0; n < 2; ++n) _Pragma("unroll") for (int k = 0; k < 2; ++k) dst[n][k] = *(const PG8_LAS bf16x8*)(lds + PG8_SB(b, h) + boff + n * 2048 + k * 1024); } while (0)
#define PG8_MMA(ai, bj, At, Bt) do { __builtin_amdgcn_s_setprio(1); _Pragma("unroll") for (int m = 0; m < 4; ++m) _Pragma("unroll") for (int n = 0; n < 2; ++n) _Pragma("unroll") for (int k = 0; k < 2; ++k) \
        acc[ai][bj][m][n] = __builtin_amdgcn_mfma_f32_16x16x32_bf16(Bt[n][k], At[m][k], acc[ai][bj][m][n], 0, 0, 0); __builtin_amdgcn_s_setprio(0); } while (0)
#define PG8_WAIT_V(n) asm volatile("s_waitcnt vmcnt(" #n ")" ::: "memory")
#define PG8_WAIT_L(n) asm volatile("s_waitcnt lgkmcnt(" #n ")" ::: "memory")
#define PG8_BAR __builtin_amdgcn_s_barrier()
#define PG8_SCHED __builtin_amdgcn_sched_barrier(0)
    Unit cur, nxt; int ui = 0;
    if (!S.next(0, cur)) return;
    f32x4 acc[2][2][4][2];
#pragma unroll
    for (int a = 0; a < 2; ++a)
#pragma unroll
        for (int b = 0; b < 2; ++b)
#pragma unroll
            for (int m = 0; m < 4; ++m)
#pragma unroll
                for (int n = 0; n < 2; ++n) acc[a][b][m][n] = (f32x4){0.f, 0.f, 0.f, 0.f};
    bf16x8 At[4][2], B0[2][2], B1[2][2];
    const char* cA = (const char*)g.A + (size_t)cur.pm * tstep; const char* cB = (const char*)g.Bt + (size_t)cur.pn * tstep;
    S.a_ready(cur);
    if constexpr (SP2) {
        PG8_STAGE(PG8_SB(0, 0), cB, voffB); PG8_STAGE(PG8_SB(0, 1), cB + hstep, voffB); PG8_STAGE(PG8_SA(0, 0), cA, voffA); PG8_STAGE(PG8_SA(0, 1), cA + hstep, voffA);
        if (wr == 1) PG8_BAR;
        PG8_WAIT_V(2); PG8_BAR;
        PG8_STAGE(PG8_SB(1, 0), cB + kstep, voffB); PG8_STAGE(PG8_SA(1, 0), cA + kstep, voffA); PG8_STAGE(PG8_SB(1, 1), cB + hstep + kstep, voffB);
        PG8_WAIT_V(6); PG8_BAR;
    } else {
        PG8_STAGE(PG8_SB(0, 0), cB, voffB); PG8_STAGE(PG8_SA(0, 0), cA, voffA); PG8_STAGE(PG8_SB(0, 1), cB + hstep, voffB); PG8_STAGE(PG8_SA(0, 1), cA + hstep, voffA);
        if (wr == 1) PG8_BAR;
        PG8_WAIT_V(4); PG8_BAR;
        PG8_STAGE(PG8_SB(1, 0), cB + kstep, voffB); PG8_STAGE(PG8_SA(1, 0), cA + kstep, voffA); PG8_STAGE(PG8_SB(1, 1), cB + hstep + kstep, voffB);
        PG8_WAIT_V(6); PG8_BAR;
    }
    for (;;) {
        const bool has_next = S.next(ui + 1, nxt);
        const char* nA = has_next ? (const char*)g.A + (size_t)nxt.pm * tstep : cA; const char* nB = has_next ? (const char*)g.Bt + (size_t)nxt.pn * tstep : cB;
        for (int t = 0; t < nt; t += 2) {
            const bool last = (t == nt - 2);
            const char* a1 = cA + (size_t)(t + 1) * kstep;
            const char* a2 = last ? nA : cA + (size_t)(t + 2) * kstep; const char* b2 = last ? nB : cB + (size_t)(t + 2) * kstep;
            const char* a3 = a2 + kstep; const char* b3 = b2 + kstep;
            if (last && has_next) S.a_ready(nxt);
            if constexpr (SP2) {
            PG8_LDB(B0, 0, 0); PG8_LDB(B1, 0, 1); PG8_SCHED; PG8_LDA(At, 0, 0); PG8_STAGE(PG8_SA(1, 1), a1 + hstep, voffA);
            PG8_WAIT_V(8); PG8_WAIT_L(0); PG8_BAR; PG8_MMA(0, 0, At, B0); PG8_MMA(0, 1, At, B1); PG8_BAR; PG8_SCHED;
            PG8_LDA(At, 0, 1); PG8_STAGE(PG8_SB(0, 0), b2, voffB); PG8_STAGE(PG8_SB(0, 1), b2 + hstep, voffB); PG8_STAGE(PG8_SA(0, 0), a2, voffA);
            PG8_WAIT_V(8); PG8_WAIT_L(0); PG8_BAR; PG8_MMA(1, 0, At, B0); PG8_MMA(1, 1, At, B1); PG8_BAR; PG8_SCHED;
            PG8_LDB(B0, 1, 0); PG8_LDB(B1, 1, 1); PG8_SCHED; PG8_LDA(At, 1, 0); PG8_STAGE(PG8_SA(0, 1), a2 + hstep, voffA);
            PG8_WAIT_V(8); PG8_WAIT_L(0); PG8_BAR; PG8_MMA(0, 0, At, B0); PG8_MMA(0, 1, At, B1); PG8_BAR; PG8_SCHED;
            PG8_LDA(At, 1, 1); PG8_STAGE(PG8_SB(1, 0), b3, voffB); PG8_STAGE(PG8_SB(1, 1), b3 + hstep, voffB); PG8_STAGE(PG8_SA(1, 0), a3, voffA);
            PG8_WAIT_V(8); PG8_WAIT_L(0); PG8_BAR; PG8_MMA(1, 0, At, B0); PG8_MMA(1, 1, At, B1); PG8_BAR; PG8_SCHED;
            } else {
            PG8_LDB(B0, 0, 0); PG8_SCHED; PG8_LDA(At, 0, 0); PG8_STAGE(PG8_SA(1, 1), a1 + hstep, voffA);
            PG8_WAIT_L(8); PG8_BAR; PG8_WAIT_L(0); PG8_MMA(0, 0, At, B0); PG8_BAR; PG8_SCHED;
            PG8_LDB(B1, 0, 1); PG8_STAGE(PG8_SB(0, 0), b2, voffB);
            PG8_BAR; PG8_WAIT_L(0); PG8_MMA(0, 1, At, B1); PG8_BAR;
            PG8_LDA(At, 0, 1); PG8_STAGE(PG8_SA(0, 0), a2, voffA);
            PG8_BAR; PG8_WAIT_L(0); PG8_MMA(1, 0, At, B0); PG8_BAR; PG8_SCHED;
            PG8_STAGE(PG8_SB(0, 1), b2 + hstep, voffB);
            PG8_WAIT_V(6); PG8_BAR; PG8_MMA(1, 1, At, B1); PG8_BAR;
            PG8_LDB(B0, 1, 0); PG8_SCHED; PG8_LDA(At, 1, 0); PG8_STAGE(PG8_SA(0, 1), a2 + hstep, voffA);
            PG8_WAIT_L(8); PG8_BAR; PG8_WAIT_L(0); PG8_MMA(0, 0, At, B0); PG8_BAR; PG8_SCHED;
            PG8_LDB(B1, 1, 1); PG8_STAGE(PG8_SB(1, 0), b3, voffB);
            PG8_BAR; PG8_WAIT_L(0); PG8_MMA(0, 1, At, B1); PG8_BAR;
            PG8_LDA(At, 1, 1); PG8_STAGE(PG8_SA(1, 0), a3, voffA);
            PG8_BAR; PG8_WAIT_L(0); PG8_MMA(1, 0, At, B0); PG8_BAR; PG8_SCHED;
            PG8_STAGE(PG8_SB(1, 1), b3 + hstep, voffB);
            PG8_WAIT_V(6); PG8_BAR; PG8_MMA(1, 1, At, B1); PG8_BAR;
            }
        }
        if constexpr (ALIGN_EPI) { if (wr == 0) PG8_BAR; }
        if constexpr (!Epi::AFTER_DRAIN) { E(acc, cur, wr, wc, fr, fq); S.done(cur); }
        if (!has_next) break;
#pragma unroll
        for (int a = 0; a < 2; ++a)
#pragma unroll
            for (int b = 0; b < 2; ++b)
#pragma unroll
                for (int m = 0; m < 4; ++m)
#pragma unroll
                    for (int n = 0; n < 2; ++n) acc[a][b][m][n] = (f32x4){0.f, 0.f, 0.f, 0.f};
        cur = nxt; cA = nA; cB = nB; ++ui;
        if constexpr (ALIGN_EPI) { if (wr == 1) PG8_BAR; }
    }
    PG8_WAIT_V(0);
    if constexpr (!ALIGN_EPI) { if (wr == 0) PG8_BAR; }
    PG8_BAR;
    if constexpr (Epi::AFTER_DRAIN) { E.fused(acc, cur, wr, wc, fr, fq, lds, wid, lane); S.done(cur); }
#undef PG8_SA
#undef PG8_SB
#undef PG8_STAGE
#undef PG8_LDA
#undef PG8_LDB
#undef PG8_MMA
#undef PG8_WAIT_V
#undef PG8_WAIT_L
#undef PG8_BAR
#undef PG8_SCHED
}
}

constexpr int NB = 16, SEQ = 2048, DM = 1024, TOK = NB * SEQ;
constexpr int EVEN_IN = 3080, EVEN_PAD = 3328;
constexpr int NEXP = 16384;
constexpr float RMS_EPS = 1e-6f;
constexpr float LOG2E = 1.4426950408889634f;
constexpr float C2 = 0.125f * LOG2E;

constexpr size_t MiB = 1u << 20;
constexpr size_t WS_CTL = 0, CTL_ZERO_BYTES = 1 * MiB;
constexpr size_t WS_W1T = 1 * MiB;
constexpr size_t WS_W2T = 8 * MiB;
constexpr size_t WS_W4T = 10 * MiB;
constexpr size_t WS_W5T = 14 * MiB;
constexpr size_t WS_W3T = 16 * MiB;
constexpr size_t WS_W6T = 20 * MiB;
constexpr size_t WS_K1B = 24 * MiB;
constexpr size_t WS_K2B = 24 * MiB + 512 * 1024;
constexpr size_t WS_PWT = 25 * MiB;
constexpr size_t WS_LF  = 25 * MiB + 256 * 1024;
constexpr size_t WS_CF  = 26 * MiB + 256 * 1024;
constexpr size_t WS_KMEAN = 27 * MiB + 256 * 1024;
constexpr size_t WS_RS0 = 27 * MiB + 512 * 1024;
constexpr size_t WS_RS2 = 27 * MiB + 640 * 1024;
constexpr size_t WS_SSQ1 = 28 * MiB;
constexpr size_t WS_SSQ3 = 30 * MiB;
constexpr size_t WS_U8S = 32 * MiB;
constexpr size_t WS_V8S = 64 * MiB;
constexpr size_t WS_XB = 160 * MiB;
constexpr size_t WS_QH = 224 * MiB;
constexpr size_t WS_KH = 288 * MiB;
constexpr size_t WS_VT = 352 * MiB;
constexpr size_t WS_QP = 224 * MiB;
constexpr size_t WS_AO = 416 * MiB;
constexpr size_t WS_EID = 480 * MiB;
constexpr size_t WS_GATE = 488 * MiB;
constexpr size_t WS_SSQ2 = 504 * MiB;
constexpr size_t WS_PREP = 224 * MiB;
constexpr size_t WS_ACO = 416 * MiB;
constexpr size_t WS_END = 506 * MiB;

constexpr int RING_BYTES = 131072;
constexpr int LDS_BYTES = 147456;
constexpr int NWAVES = 8;

#define GAS __attribute__((address_space(1)))
#define LAS __attribute__((address_space(3)))
typedef unsigned short bf16_t;
typedef unsigned u32x4 __attribute__((ext_vector_type(4)));
typedef unsigned u32x2 __attribute__((ext_vector_type(2)));
typedef float f32x4 __attribute__((ext_vector_type(4)));
typedef float f32x16 __attribute__((ext_vector_type(16)));
typedef short bf16x8 __attribute__((ext_vector_type(8)));
typedef __bf16 bf16x2 __attribute__((ext_vector_type(2)));
#define LDS_WAIT() asm volatile("s_waitcnt lgkmcnt(0)" ::: "memory")

__device__ __forceinline__ int opaque_i(int v) { asm volatile("" : "+v"(v)); return v; }
__device__ __forceinline__ unsigned f2bf(float f) { unsigned u = __builtin_bit_cast(unsigned, f); return (u + 0x7fffu + ((u >> 16) & 1u)) >> 16; }
typedef float f32x2_pk __attribute__((ext_vector_type(2)));
__device__ __forceinline__ unsigned pk2(float lo, float hi) { const f32x2_pk v = {lo, hi}; return __builtin_bit_cast(unsigned, __builtin_convertvector(v, bf16x2)); }
__device__ __forceinline__ float bf_lo(unsigned u) { return __uint_as_float(u << 16); }
__device__ __forceinline__ float bf_hi(unsigned u) { return __uint_as_float(u & 0xffff0000u); }
__device__ __forceinline__ float dot2(unsigned a, unsigned b, float acc) { return __builtin_amdgcn_fdot2_f32_bf16(__builtin_bit_cast(bf16x2, a), __builtin_bit_cast(bf16x2, b), acc, false); }
__device__ __forceinline__ float dot8(u32x4 a, u32x4 b, float acc) { acc = dot2(a.x, b.x, acc); acc = dot2(a.y, b.y, acc); acc = dot2(a.z, b.z, acc); return dot2(a.w, b.w, acc); }
__device__ __forceinline__ u32x4 pack8(f32x4 a, f32x4 b) { u32x4 w; w.x = pk2(a[0], a[1]); w.y = pk2(a[2], a[3]); w.z = pk2(b[0], b[1]); w.w = pk2(b[2], b[3]); return w; }

__device__ __forceinline__ float wave_sum(float v) {
#pragma unroll
    for (int o = 1; o < 64; o <<= 1) v += __shfl_xor(v, o);
    return v;
}
__device__ __forceinline__ float wave_max(float v) {
#pragma unroll
    for (int o = 1; o < 64; o <<= 1) v = fmaxf(v, __shfl_xor(v, o));
    return v;
}
__device__ __forceinline__ unsigned wave_umax(unsigned v) {
#pragma unroll
    for (int o = 1; o < 64; o <<= 1) { const unsigned w = (unsigned)__shfl_xor((int)v, o); v = v > w ? v : w; }
    return v;
}
__device__ __forceinline__ float dpp_row_shr(float v, int n) {
    const int iv = __builtin_bit_cast(int, v); int r;
    switch (n) { case 1: r = __builtin_amdgcn_update_dpp(0, iv, 0x111, 0xf, 0xf, true); break; case 2: r = __builtin_amdgcn_update_dpp(0, iv, 0x112, 0xf, 0xf, true); break;
                 case 4: r = __builtin_amdgcn_update_dpp(0, iv, 0x114, 0xf, 0xf, true); break; default: r = __builtin_amdgcn_update_dpp(0, iv, 0x118, 0xf, 0xf, true); break; }
    return __builtin_bit_cast(float, r);
}
__device__ __forceinline__ float wave_total(float v) {
    v += dpp_row_shr(v, 1); v += dpp_row_shr(v, 2); v += dpp_row_shr(v, 4); v += dpp_row_shr(v, 8);
    v += __builtin_bit_cast(float, __builtin_amdgcn_update_dpp(0, __builtin_bit_cast(int, v), 0x142, 0xa, 0xf, false));
    v += __builtin_bit_cast(float, __builtin_amdgcn_update_dpp(0, __builtin_bit_cast(int, v), 0x143, 0xc, 0xf, false));
    return __builtin_bit_cast(float, __builtin_amdgcn_readlane(__builtin_bit_cast(int, v), 63));
}
__device__ __forceinline__ unsigned f2ord(float f) { const unsigned u = __float_as_uint(f); return u ^ ((unsigned)((int)u >> 31) | 0x80000000u); }
__device__ __forceinline__ float ord2f(unsigned o) { return __uint_as_float(o ^ (~(unsigned)((int)o >> 31) | 0x80000000u)); }

__device__ __forceinline__ float row_scale(const float* p, int mode, int t) {
    if (mode == 0) return p[t];
    const f32x4* q = (const f32x4*)(p + (size_t)t * 16); const f32x4 a = q[0], b = q[1], c = q[2], d = q[3];
    const float s = (((a[0] + a[1]) + (a[2] + a[3])) + ((b[0] + b[1]) + (b[2] + b[3]))) + (((c[0] + c[1]) + (c[2] + c[3])) + ((d[0] + d[1]) + (d[2] + d[3])));
    return rsqrtf(s * (1.f / DM) + RMS_EPS);
}

struct EpiL0In {
    static constexpr bool PERM = true, AFTER_DRAIN = false;
    const float* rs; bf16_t* QH; bf16_t* KH; bf16_t* VT; float* LF; const float* b_f;
    __device__ __forceinline__ void operator()(const f32x4 (&acc)[2][2][4][2], const pg8::Unit& u, int wr, int wc, int fr, int fq) const {
        const int pn = u.pn;
        if (pn == 12) {
            if (wc == 0 && fq == 0) {
#pragma unroll
                for (int ai = 0; ai < 2; ++ai)
#pragma unroll
                    for (int m = 0; m < 4; ++m) {
                        const int t = u.pm * 256 + ai * 128 + wr * 64 + m * 16 + fr; const float sc = rs[t]; const int b = t >> 11, s = t & 2047;
#pragma unroll
                        for (int n = 0; n < 2; ++n)
#pragma unroll
                            for (int e = 0; e < 4; ++e) { const int h = n * 4 + e; const float x = acc[ai][0][m][n][e] * sc + b_f[h];
                                const float ls = fminf(x, 0.f) - log1pf(expf(-fabsf(x)));
                                LF[(size_t)(b * 8 + h) * 2048 + s] = ls * LOG2E; }
                    }
            }
            return;
        }
        const int sec = pn >> 1, kind = sec % 3, hbase = (sec >= 3) ? 8 : 0;
#pragma unroll
        for (int ai = 0; ai < 2; ++ai)
#pragma unroll
            for (int m = 0; m < 4; ++m) {
                const int t = u.pm * 256 + ai * 128 + wr * 64 + m * 16 + fr; const int b = t >> 11, s = t & 2047;
                const float sc = rs[t] * (kind == 0 ? C2 : 1.f);
#pragma unroll
                for (int bj = 0; bj < 2; ++bj) {
                    const int cc = (pn & 1) * 256 + bj * 128 + wc * 32 + fq * 8, hh = hbase + (cc >> 6), d0 = cc & 63;
                    const f32x4 v0 = acc[ai][bj][m][0] * sc, v1 = acc[ai][bj][m][1] * sc;
                    if (kind < 2) { bf16_t* dst = (kind == 0 ? QH : KH) + ((size_t)(b * 16 + hh) * 2048 + s) * 64 + d0; *(u32x4*)dst = pack8(v0, v1); }
                    else { bf16_t* dst = VT + ((size_t)(b * 16 + hh) * 64 + d0) * 2048 + s;
                        dst[0 * 2048] = (bf16_t)f2bf(v0[0]); dst[1 * 2048] = (bf16_t)f2bf(v0[1]); dst[2 * 2048] = (bf16_t)f2bf(v0[2]); dst[3 * 2048] = (bf16_t)f2bf(v0[3]);
                        dst[4 * 2048] = (bf16_t)f2bf(v1[0]); dst[5 * 2048] = (bf16_t)f2bf(v1[1]); dst[6 * 2048] = (bf16_t)f2bf(v1[2]); dst[7 * 2048] = (bf16_t)f2bf(v1[3]); }
                }
            }
    }
};
struct EpiL1In {
    static constexpr bool PERM = true, AFTER_DRAIN = false;
    const float* rsp; int rsmode; bf16_t* XC; bf16_t* QD; bf16_t* KD; bf16_t* VTD;
    __device__ __forceinline__ void operator()(const f32x4 (&acc)[2][2][4][2], const pg8::Unit& u, int wr, int wc, int fr, int fq) const {
        const int pn = u.pn, kind = pn >> 1;
#pragma unroll
        for (int ai = 0; ai < 2; ++ai)
#pragma unroll
            for (int m = 0; m < 4; ++m) {
                const int t = u.pm * 256 + ai * 128 + wr * 64 + m * 16 + fr; const int b = t >> 11, s = t & 2047;
                const float sc = row_scale(rsp, rsmode, t) * (kind == 1 ? C2 : 1.f);
#pragma unroll
                for (int bj = 0; bj < 2; ++bj) {
                    const int cc = (pn & 1) * 256 + bj * 128 + wc * 32 + fq * 8, hh = cc >> 6, d0 = cc & 63;
                    const f32x4 v0 = acc[ai][bj][m][0] * sc, v1 = acc[ai][bj][m][1] * sc;
                    if (kind == 0) { *(u32x4*)(XC + (size_t)t * 512 + cc) = pack8(v0, v1); }
                    else if (kind < 3) { bf16_t* dst = (kind == 1 ? QD : KD) + ((size_t)(b * 8 + hh) * 2048 + s) * 64 + d0; *(u32x4*)dst = pack8(v0, v1); }
                    else { bf16_t* dst = VTD + ((size_t)(b * 8 + hh) * 64 + d0) * 2048 + s;
                        dst[0 * 2048] = (bf16_t)f2bf(v0[0]); dst[1 * 2048] = (bf16_t)f2bf(v0[1]); dst[2 * 2048] = (bf16_t)f2bf(v0[2]); dst[3 * 2048] = (bf16_t)f2bf(v0[3]);
                        dst[4 * 2048] = (bf16_t)f2bf(v1[0]); dst[5 * 2048] = (bf16_t)f2bf(v1[1]); dst[6 * 2048] = (bf16_t)f2bf(v1[2]); dst[7 * 2048] = (bf16_t)f2bf(v1[3]); }
                }
            }
    }
};
struct EpiQ {
    static constexpr bool PERM = true, AFTER_DRAIN = false;
    const float* rsp; int rsmode; bf16_t* Q;
    __device__ __forceinline__ void operator()(const f32x4 (&acc)[2][2][4][2], const pg8::Unit& u, int wr, int wc, int fr, int fq) const {
#pragma unroll
        for (int ai = 0; ai < 2; ++ai)
#pragma unroll
            for (int m = 0; m < 4; ++m) {
                const int t = u.pm * 256 + ai * 128 + wr * 64 + m * 16 + fr; const float sc = row_scale(rsp, rsmode, t);
#pragma unroll
                for (int bj = 0; bj < 2; ++bj) { const int c = u.pn * 256 + bj * 128 + wc * 32 + fq * 8;
                    __builtin_nontemporal_store(pack8(acc[ai][bj][m][0] * sc, acc[ai][bj][m][1] * sc), (u32x4*)(Q + (size_t)t * 2048 + c)); }
            }
    }
};
template <bool BASE_BF16>
struct EpiRes {
    static constexpr bool PERM = true, AFTER_DRAIN = false;
    const void* base; bf16_t* xb; float* ssqp;
    __device__ __forceinline__ void operator()(const f32x4 (&acc)[2][2][4][2], const pg8::Unit& u, int wr, int wc, int fr, int fq) const {
#pragma unroll
        for (int ai = 0; ai < 2; ++ai)
#pragma unroll
            for (int m = 0; m < 4; ++m) {
                const int t = u.pm * 256 + ai * 128 + wr * 64 + m * 16 + fr; float ss = 0.f;
#pragma unroll
                for (int bj = 0; bj < 2; ++bj) { const size_t off = (size_t)t * DM + u.pn * 256 + bj * 128 + wc * 32 + fq * 8;
                    f32x4 b0, b1;
                    if (BASE_BF16) { const u32x4 w = *(const u32x4*)((const bf16_t*)base + off); b0 = (f32x4){bf_lo(w.x), bf_hi(w.x), bf_lo(w.y), bf_hi(w.y)}; b1 = (f32x4){bf_lo(w.z), bf_hi(w.z), bf_lo(w.w), bf_hi(w.w)}; }
                    else { b0 = *(const f32x4*)((const float*)base + off); b1 = *(const f32x4*)((const float*)base + off + 4); }
                    const f32x4 o0 = b0 + acc[ai][bj][m][0], o1 = b1 + acc[ai][bj][m][1];
                    *(u32x4*)(xb + off) = pack8(o0, o1);
                    ss += (o0[0] * o0[0] + o0[1] * o0[1]) + (o0[2] * o0[2] + o0[3] * o0[3]) + (o1[0] * o1[0] + o1[1] * o1[1]) + (o1[2] * o1[2] + o1[3] * o1[3]); }
                ss += __shfl_xor(ss, 16); ss += __shfl_xor(ss, 32);
                if (fq == 0) ssqp[(size_t)t * 16 + u.pn * 4 + wc] = ss;
            }
    }
};

#define XB_TMO      128
#define XB_XCNT(j)  (256  + 64 * (j))
#define XB_XSUB(j)  (1280 + 64 * (j))
#define XB_XGEN(j)  (2304 + 64 * (j))
#define XB_TOP      3328
#define XB_TOPGEN   3392
#define XCD_BAR_WORDS 3456
#define XB_SPIN_CAP (1u << 18)

__device__ __forceinline__ unsigned xb_ld(unsigned* p)              { return __hip_atomic_load(p, __ATOMIC_RELAXED, __HIP_MEMORY_SCOPE_AGENT); }
__device__ __forceinline__ unsigned xb_add(unsigned* p, unsigned v) { return __hip_atomic_fetch_add(p, v, __ATOMIC_RELAXED, __HIP_MEMORY_SCOPE_AGENT); }
__device__ __forceinline__ unsigned xb_xcc_id() { return (unsigned)__builtin_amdgcn_s_getreg((3 << 11) | 20) & 0xFu; }
#define XB_SPIN(cond, bar) do { unsigned _sp = 0; while (cond) { __builtin_amdgcn_s_sleep(1); \
    if ((++_sp & 255u) == 0u) { if (xb_ld(&(bar)[XB_TMO])) break; if (_sp > XB_SPIN_CAP) { atomicAdd(&(bar)[XB_TMO], 1u); break; } } } } while (0)

struct XcdBarrier {
    unsigned* bar; unsigned x;
    volatile LAS unsigned* st;
};

__device__ __forceinline__ XcdBarrier xcd_barrier_post(unsigned* bar, volatile LAS unsigned* st) {
    XcdBarrier b; b.bar = bar; b.x = xb_xcc_id(); b.st = st;
    if (threadIdx.x == 0) (void)xb_add(&bar[XB_XCNT(b.x)], 1u);
    return b;
}
__device__ __forceinline__ void xcd_barrier_complete(unsigned* bar, unsigned x, unsigned& nloc, unsigned& nx) {
    const unsigned G = gridDim.x * gridDim.y * gridDim.z;
    unsigned sum, cnt, mine, sp = 0u;
    for (;;) {
        sum = 0u; cnt = 0u; mine = 0u;
#pragma unroll
        for (unsigned j = 0; j < 16; ++j) { const unsigned c = xb_ld(&bar[XB_XCNT(j)]); sum += c; cnt += (c > 0u) ? 1u : 0u; mine = (j == x) ? c : mine; }
        if (sum == G) break;
        __builtin_amdgcn_s_sleep(1);
        if ((++sp & 255u) == 0u) { if (xb_ld(&bar[XB_TMO])) break; if (sp > XB_SPIN_CAP) { atomicAdd(&bar[XB_TMO], 1u); break; } }
    }
    nloc = mine > 0u ? mine : 1u; nx = cnt > 0u ? cnt : 1u;
}

__device__ __forceinline__ void xcd_barrier(const XcdBarrier& b) {
    asm volatile("s_waitcnt vmcnt(0)" ::: "memory");
    __syncthreads();
    if (threadIdx.x == 0) {
        unsigned* bar = b.bar;
        __builtin_amdgcn_s_waitcnt(0);
        unsigned nloc = b.st[0], nx = b.st[1];
        if (nloc == 0u) { xcd_barrier_complete(bar, b.x, nloc, nx); b.st[0] = nloc; b.st[1] = nx; }
        const unsigned old = xb_add(&bar[XB_XSUB(b.x)], 1u);
        const unsigned gen = old / nloc;
        if (old + 1u == (gen + 1u) * nloc) {
            __builtin_amdgcn_fence(__ATOMIC_RELEASE, "agent");
            asm volatile("s_waitcnt vmcnt(0)" ::: "memory");
            const unsigned og = xb_add(&bar[XB_TOP], 1u);
            const unsigned tg = og / nx;
            if (og + 1u == (tg + 1u) * nx) xb_add(&bar[XB_TOPGEN], 1u);
            else XB_SPIN(xb_ld(&bar[XB_TOPGEN]) == tg, bar);
            __builtin_amdgcn_fence(__ATOMIC_ACQUIRE, "agent");
            xb_add(&bar[XB_XGEN(b.x)], 1u);
            asm volatile("s_waitcnt vmcnt(0)" ::: "memory");
        } else {
            XB_SPIN(xb_ld(&bar[XB_XGEN(b.x)]) == gen, bar);
            __builtin_amdgcn_fence(__ATOMIC_ACQUIRE, "agent");
            asm volatile("s_waitcnt vmcnt(0)" ::: "memory");
        }
    }
    __syncthreads();
}

struct Frame {
    LAS unsigned char* lds;
    int tid, lane, wave, vcu, G;
};

__device__ __forceinline__ int remap0(int n) { return n < 1536 ? n : (n < 1544 ? 3072 + (n - 1536) : n - 8); }
__device__ __forceinline__ void p0_transpose_item(const float* W, int K, int N, bf16_t* WT, const float* g, bool remap, LAS float* scr, int item, int lane) {
    const int nblk = (N + 31) / 32, kb = item / nblk, nb = item % nblk, k0 = 64 * kb, n0 = 32 * nb;
#pragma unroll 8
    for (int i = 0; i < 32; ++i) { const int kk = 2 * i + (lane >> 5), n = n0 + (lane & 31);
        float v = (n < N) ? W[(size_t)(k0 + kk) * N + n] : 0.f; if (g) v *= g[k0 + kk]; scr[kk * 33 + (lane & 31)] = v; }
    LDS_WAIT(); asm volatile("" ::: "memory");
    const int c = lane & 7;
#pragma unroll
    for (int j = 0; j < 4; ++j) { const int nl = (lane >> 3) + 8 * j, n = n0 + nl; const LAS float* s = scr + (8 * c) * 33 + nl;
        u32x4 o; o.x = pk2(s[0 * 33], s[1 * 33]); o.y = pk2(s[2 * 33], s[3 * 33]); o.z = pk2(s[4 * 33], s[5 * 33]); o.w = pk2(s[6 * 33], s[7 * 33]);
        if (n < N) { const int nn = remap ? remap0(n) : n; *(u32x4*)(WT + (size_t)nn * K + k0 + 8 * c) = o; } }
    LDS_WAIT(); asm volatile("" ::: "memory");
}
__device__ __forceinline__ float cvt_row_1024(const float* src, bf16_t* dst, const float* g, int lane) {
    const f32x4 a0 = *(const f32x4*)(src + 8 * lane), a1 = *(const f32x4*)(src + 8 * lane + 4), c0 = *(const f32x4*)(src + 512 + 8 * lane), c1 = *(const f32x4*)(src + 516 + 8 * lane);
    float ss = (a0[0] * a0[0] + a0[1] * a0[1]) + (a0[2] * a0[2] + a0[3] * a0[3]) + (a1[0] * a1[0] + a1[1] * a1[1]) + (a1[2] * a1[2] + a1[3] * a1[3])
             + (c0[0] * c0[0] + c0[1] * c0[1]) + (c0[2] * c0[2] + c0[3] * c0[3]) + (c1[0] * c1[0] + c1[1] * c1[1]) + (c1[2] * c1[2] + c1[3] * c1[3]);
    f32x4 b0 = a0, b1 = a1, d0 = c0, d1 = c1;
    if (g) { b0 = b0 * *(const f32x4*)(g + 8 * lane); b1 = b1 * *(const f32x4*)(g + 8 * lane + 4); d0 = d0 * *(const f32x4*)(g + 512 + 8 * lane); d1 = d1 * *(const f32x4*)(g + 516 + 8 * lane); }
    *(u32x4*)(dst + 8 * lane) = pack8(b0, b1); *(u32x4*)(dst + 512 + 8 * lane) = pack8(d0, d1);
    return ss;
}

constexpr float I8_SV = 64.f;
constexpr float I4_SV = 8.44f;
constexpr float I4_SU = 95.5f;
constexpr float I8_SU = 600.f, I8_SX = 127.f / 6.f;
constexpr float FP8_SU = 64.f, FP8_SV = 8.f;
__device__ __forceinline__ void cvt_row_fp8_sliced(const float* src, unsigned char* tab  , int e, const float* g, float scale, int lane) {
#pragma unroll
    for (int j = 0; j < 4; ++j) { f32x4 a = *(const f32x4*)(src + 256 * j + 4 * lane) * scale; if (g) a = a * *(const f32x4*)(g + 256 * j + 4 * lane);
        int w = 0; w = __builtin_amdgcn_cvt_pk_bf8_f32(a[0], a[1], w, false); w = __builtin_amdgcn_cvt_pk_bf8_f32(a[2], a[3], w, true);
        const int x = 2 * j + (lane >> 5);
        *(unsigned*)(tab + ((size_t)x * NEXP + e) * 128 + 4 * (lane & 31)) = (unsigned)w; }
}
__device__ __forceinline__ void cvt_row_i8_sliced(const float* src, unsigned char* tab  , int e, const float* g, float scale, int lane) {
#pragma unroll
    for (int j = 0; j < 4; ++j) { f32x4 a = *(const f32x4*)(src + 256 * j + 4 * lane) * scale; if (g) a = a * *(const f32x4*)(g + 256 * j + 4 * lane);
        unsigned w = 0u;
#pragma unroll
        for (int q = 0; q < 4; ++q) { int v = __float2int_rn(a[q]); v = v < -127 ? -127 : (v > 127 ? 127 : v); w |= ((unsigned)v & 0xffu) << (8 * q); }
        const int x = 2 * j + (lane >> 5);
        *(unsigned*)(tab + ((size_t)x * NEXP + e) * 128 + 4 * (lane & 31)) = w; }
}
struct Ptrs {
    const float *x, *norm_mix, *norm_ffn, *ev_w_in, *ev_b_f, *ev_w_out, *od_w_in, *od_pool_w, *od_pool_scale, *od_w_out, *peer_wq, *peer_k1, *peer_k2, *peer_u, *peer_v, *norm_f;
    float* out; unsigned char* ws;
};

__device__ __forceinline__ void phase_p0(Frame& F, const Ptrs& P) {
    LAS float* scr = (LAS float*)(F.lds + F.wave * 16384);
    const int gw = F.vcu * NWAVES + F.wave, NGW = F.G * NWAVES, lane = opaque_i(F.lane);
    unsigned char* ws = P.ws;
    bf16_t* W1T = (bf16_t*)(ws + WS_W1T); bf16_t* W2T = (bf16_t*)(ws + WS_W2T); bf16_t* W4T = (bf16_t*)(ws + WS_W4T); bf16_t* W5T = (bf16_t*)(ws + WS_W5T);
    bf16_t* W3T = (bf16_t*)(ws + WS_W3T); bf16_t* W6T = (bf16_t*)(ws + WS_W6T); bf16_t* PWT = (bf16_t*)(ws + WS_PWT);
    constexpr int I1 = 16 * 97, I2 = 16 * 32, I4 = 16 * 64, I5 = I2, I3 = I4, I6 = I4, IP = 4 * 2 * 4;
    constexpr int NTR = I1 + I2 + I4 + I5 + I3 + I6 + IP;
    for (int it = gw; it < NTR; it += NGW) {
        int r = it;
        if (r < I1) { p0_transpose_item(P.ev_w_in, DM, EVEN_IN, W1T, P.norm_mix, true, scr, r, lane); continue; } r -= I1;
        if (r < I2) { p0_transpose_item(P.ev_w_out, DM, DM, W2T, nullptr, false, scr, r, lane); continue; } r -= I2;
        if (r < I4) { p0_transpose_item(P.od_w_in, DM, 2048, W4T, P.norm_mix + DM, false, scr, r, lane); continue; } r -= I4;
        if (r < I5) { p0_transpose_item(P.od_w_out, DM, DM, W5T, nullptr, false, scr, r, lane); continue; } r -= I5;
        if (r < I3) { p0_transpose_item(P.peer_wq, DM, 2048, W3T, P.norm_ffn, false, scr, r, lane); continue; } r -= I3;
        if (r < I6) { p0_transpose_item(P.peer_wq + (size_t)DM * 2048, DM, 2048, W6T, P.norm_ffn + DM, false, scr, r, lane); continue; } r -= I6;
        { const int g = r >> 3; p0_transpose_item(P.od_pool_w + (size_t)g * 128 * 128, 128, 128, PWT + (size_t)g * 128 * 128, nullptr, false, scr, r & 7, lane); }
    }
    bf16_t* XB = (bf16_t*)(ws + WS_XB); float* RS0 = (float*)(ws + WS_RS0);
    bf16_t* K1B = (bf16_t*)(ws + WS_K1B); bf16_t* K2B = (bf16_t*)(ws + WS_K2B);
    f32x4 wf[16][2];
    __syncthreads();
    { LAS float* wl = (LAS float*)F.lds;
      for (int k = F.tid; k < DM; k += NWAVES * 64) { const float gk = P.norm_mix[k]; const float* wp = P.ev_w_in + (size_t)k * EVEN_IN + 1536; LAS float* d = wl + 8 * k + 4 * (k >> 3);
          *(LAS f32x4*)d = *(const f32x4*)wp * gk; *(LAS f32x4*)(d + 4) = *(const f32x4*)(wp + 4) * gk; }
      __syncthreads();
#pragma unroll
      for (int j = 0; j < 16; ++j) { const int k = (j < 8 ? 0 : 512) + 8 * lane + (j & 7); const LAS float* s = wl + 8 * k + 4 * (k >> 3); wf[j][0] = *(const LAS f32x4*)s; wf[j][1] = *(const LAS f32x4*)(s + 4); } }
    float* LF = (float*)(ws + WS_LF); const float bfl = P.ev_b_f[lane & 7];
    for (int r0 = gw * 4; r0 < TOK; r0 += NGW * 4) {
        f32x4 a[4][4];
#pragma unroll
        for (int q = 0; q < 4; ++q) { const float* s = P.x + (size_t)(r0 + q) * DM + 8 * lane; a[q][0] = *(const f32x4*)s; a[q][1] = *(const f32x4*)(s + 4); a[q][2] = *(const f32x4*)(s + 512); a[q][3] = *(const f32x4*)(s + 516); }
#pragma unroll
        for (int q = 0; q < 4; ++q) { float ss = 0.f;
#pragma unroll
            for (int j = 0; j < 4; ++j) ss += (a[q][j][0] * a[q][j][0] + a[q][j][1] * a[q][j][1]) + (a[q][j][2] * a[q][j][2] + a[q][j][3] * a[q][j][3]);
            bf16_t* d = XB + (size_t)(r0 + q) * DM + 8 * lane; *(u32x4*)d = pack8(a[q][0], a[q][1]); *(u32x4*)(d + 512) = pack8(a[q][2], a[q][3]);
            ss = wave_sum(ss); const float rs = rsqrtf(ss * (1.f / DM) + RMS_EPS); if (lane == 0) RS0[r0 + q] = rs;
            f32x4 g0 = {0.f, 0.f, 0.f, 0.f}, g1 = {0.f, 0.f, 0.f, 0.f};
#pragma unroll
            for (int j = 0; j < 16; ++j) { const float xv = a[q][j >> 2][j & 3]; g0 += wf[j][0] * xv; g1 += wf[j][1] * xv; }
            float gv = 0.f;
#pragma unroll
            for (int h = 0; h < 8; ++h) { const float tot = wave_total(h < 4 ? g0[h & 3] : g1[h & 3]); gv = (lane == h) ? tot : gv; }
            if (lane < 8) { const int r = r0 + q; const float x = gv * rs + bfl; const float ls = fminf(x, 0.f) - log1pf(expf(-fabsf(x)));
                LF[(size_t)((r >> 11) * 8 + lane) * 2048 + (r & 2047)] = ls * LOG2E; }
        }
    }
#pragma unroll 1
    for (int tb = 0; tb < 2; ++tb) {
        const float* srcT = tb ? P.peer_v : P.peer_u; unsigned char* tabT = ws + (tb ? WS_V8S : WS_U8S); const float scale = tb ? I4_SV : I4_SU;
        for (int r0 = gw * 4; r0 < 2 * NEXP; r0 += NGW * 4) {
            const int ly = r0 >= NEXP, e0 = r0 - ly * NEXP; unsigned char* tab = tabT + (size_t)ly * 4 * NEXP * 128;
            f32x4 a[4][4], g[4];
#pragma unroll
            for (int q = 0; q < 4; ++q)
#pragma unroll
                for (int j = 0; j < 4; ++j) a[q][j] = *(const f32x4*)(srcT + (size_t)(r0 + q) * DM + 256 * j + 4 * lane);
#pragma unroll
            for (int j = 0; j < 4; ++j) { g[j] = (f32x4){scale, scale, scale, scale}; if (!tb) g[j] = g[j] * *(const f32x4*)(P.norm_ffn + (ly ? DM : 0) + 256 * j + 4 * lane); }
#pragma unroll
            for (int q = 0; q < 4; ++q)
#pragma unroll
                for (int j = 0; j < 4; ++j) { const f32x4 v = a[q][j] * g[j]; unsigned w = 0u;
                    if (!tb) {
#pragma unroll
                        for (int k = 0; k < 4; ++k) { int iv = __float2int_rn(v[k]); iv = iv < -8 ? -8 : (iv > 7 ? 7 : iv); w |= ((unsigned)iv & 0xfu) << (4 * k); }
                        *(unsigned short*)(tab + ((size_t)j * NEXP + e0 + q) * 128 + 2 * lane) = (unsigned short)w;
                    } else {
#pragma unroll
                        for (int k = 0; k < 4; ++k) { int iv = __float2int_rn(v[k]); iv = iv < -8 ? -8 : (iv > 7 ? 7 : iv); w |= ((unsigned)((k & 1) ? iv : iv + 8) & 0xfu) << (4 * k); }
                        *(unsigned short*)(tab + ((size_t)j * NEXP + e0 + q) * 128 + 2 * lane) = (unsigned short)w; } }
        }
    }
    constexpr int R_Z = EVEN_PAD - EVEN_IN, R_K = 2 * 256;
    for (int it = gw; it < R_Z + R_K; it += NGW) {
        int r = it;
        if (r < R_Z) { bf16_t* d = W1T + (size_t)(EVEN_IN + r) * DM; const u32x4 z = {0u, 0u, 0u, 0u}; *(u32x4*)(d + 8 * lane) = z; *(u32x4*)(d + 512 + 8 * lane) = z; continue; } r -= R_Z;
        if (r < 256) (void)cvt_row_1024(P.peer_k1 + (size_t)r * 1024, K1B + (size_t)r * 1024, nullptr, lane);
        else (void)cvt_row_1024(P.peer_k2 + (size_t)(r - 256) * 1024, K2B + (size_t)(r - 256) * 1024, nullptr, lane);
    }
}

__device__ __forceinline__ void phase_cfscan(Frame& F, const float* LF, float* CFo) {
    const int gw = F.vcu * NWAVES + F.wave, NGW = F.G * NWAVES, lane = opaque_i(F.lane);
    for (int bh = gw; bh < NB * 8; bh += NGW) {
        const float* src = LF + (size_t)bh * 2048 + 32 * lane; float v[32];
#pragma unroll
        for (int i = 0; i < 8; ++i) { const f32x4 w = *(const f32x4*)(src + 4 * i); v[4 * i] = w[0]; v[4 * i + 1] = w[1]; v[4 * i + 2] = w[2]; v[4 * i + 3] = w[3]; }
#pragma unroll
        for (int i = 1; i < 32; ++i) v[i] += v[i - 1];
        const float tot = v[31]; float inc = tot;
#pragma unroll
        for (int o = 1; o < 64; o <<= 1) { const float w = __shfl_up(inc, o); if (lane >= o) inc += w; }
        const float excl = inc - tot; float* dst = CFo + (size_t)bh * 2048 + 32 * lane;
#pragma unroll
        for (int i = 0; i < 8; ++i) { f32x4 w = {v[4 * i] + excl, v[4 * i + 1] + excl, v[4 * i + 2] + excl, v[4 * i + 3] + excl}; *(f32x4*)(dst + 4 * i) = w; }
    }
}
__device__ __forceinline__ void cfscan_block(Frame& F, const float* LF, float* CFo, int bh) {
    LAS float* wt = (LAS float*)(F.lds + RING_BYTES + 2048);
    const int lane = opaque_i(F.lane);
    const f32x4 w = *(const f32x4*)(LF + (size_t)bh * 2048 + 4 * F.tid);
    const float p0 = w[0], p1 = p0 + w[1], p2 = p1 + w[2], p3 = p2 + w[3];
    float inc = p3;
#pragma unroll
    for (int o = 1; o < 64; o <<= 1) { const float u = __shfl_up(inc, o); if (lane >= o) inc += u; }
    if (lane == 63) wt[F.wave] = inc;
    __syncthreads();
    float base = inc - p3;
#pragma unroll
    for (int k = 0; k < NWAVES - 1; ++k) base += (k < F.wave) ? wt[k] : 0.f;
    *(f32x4*)(CFo + (size_t)bh * 2048 + 4 * F.tid) = (f32x4){p0 + base, p1 + base, p2 + base, p3 + base};
    asm volatile("s_waitcnt vmcnt(0)" ::: "memory");
    __syncthreads();
}
__device__ __forceinline__ void phase_kmean(Frame& F, const bf16_t* KD, float* KMEAN, int bh) {
    const int lane = opaque_i(F.lane), jg = lane >> 3, dq = lane & 7;
    for (int it = bh * 8 + F.wave; it < bh * 8 + 8; it += NWAVES) {
        const int bh = it >> 3, blk = it & 7; const bf16_t* src = KD + ((size_t)bh * 2048 + blk * 256 + jg) * 64 + 8 * dq; float s[8] = {0.f, 0.f, 0.f, 0.f, 0.f, 0.f, 0.f, 0.f};
#pragma unroll 8
        for (int i = 0; i < 32; ++i) { const u32x4 w = *(const u32x4*)(src + (size_t)i * 8 * 64);
            s[0] += bf_lo(w.x); s[1] += bf_hi(w.x); s[2] += bf_lo(w.y); s[3] += bf_hi(w.y); s[4] += bf_lo(w.z); s[5] += bf_hi(w.z); s[6] += bf_lo(w.w); s[7] += bf_hi(w.w); }
#pragma unroll
        for (int k = 0; k < 8; ++k) { s[k] += __shfl_xor(s[k], 8); s[k] += __shfl_xor(s[k], 16); s[k] += __shfl_xor(s[k], 32); }
        if (jg == 0) { float* d = KMEAN + (size_t)it * 64 + 8 * dq; *(f32x4*)d = (f32x4){s[0], s[1], s[2], s[3]} * (1.f / 256.f); *(f32x4*)(d + 4) = (f32x4){s[4], s[5], s[6], s[7]} * (1.f / 256.f); }
    }
}
__device__ __forceinline__ int lgi(int s) { return s + (s >> 5); }
__device__ __forceinline__ float lsn2f(float z2) { return -(fmaxf(z2, 0.f) + __log2f(1.f + exp2f(-fabsf(z2)))); }
template <int KIND>
__device__ __forceinline__ void attn_naive(Frame& F, const bf16_t* QH, const bf16_t* KH, const bf16_t* VT, int NH, int hbase, const float* CF, const float* KMEAN, bf16_t* AO, int ao_col0) {
    LAS float* lg = (LAS float*)(F.lds + F.wave * 8704);
    const int gw = F.vcu * NWAVES + F.wave, NGW = F.G * NWAVES, lane = opaque_i(F.lane);
    for (int qi = gw; qi < NB * 8 * SEQ; qi += NGW) {
        const int bh = qi >> 11, b = bh >> 3, h = bh & 7, hh = hbase + h;
        const int t = (bh & 1) ? (2047 - (qi & 2047)) : (qi & 2047);
        const size_t hb = (size_t)(b * NH + hh);
        const bf16_t* qp = QH + (hb * 2048 + t) * 64; const bf16_t* kp = KH + hb * 2048 * 64;
        float q[64];
#pragma unroll
        for (int c = 0; c < 8; ++c) { const u32x4 w = *(const u32x4*)(qp + 8 * c);
            q[8 * c] = bf_lo(w.x); q[8 * c + 1] = bf_hi(w.x); q[8 * c + 2] = bf_lo(w.y); q[8 * c + 3] = bf_hi(w.y); q[8 * c + 4] = bf_lo(w.z); q[8 * c + 5] = bf_hi(w.z); q[8 * c + 6] = bf_lo(w.w); q[8 * c + 7] = bf_hi(w.w); }
        unsigned sel = 0u; const int qb = t >> 8;
        if (KIND == 2) {
            float gate[8];
#pragma unroll
            for (int n = 0; n < 8; ++n) { const float* km = KMEAN + ((size_t)(b * 8 + h) * 8 + n) * 64; float a = 0.f;
#pragma unroll
                for (int d = 0; d < 64; ++d) a += q[d] * km[d];
                gate[n] = a; }
            const int nsel = qb < 3 ? qb : 3;
#pragma unroll
            for (int r = 0; r < 3; ++r) if (r < nsel) { float best = -INFINITY; int bi = 0;
#pragma unroll
                for (int n = 0; n < 8; ++n) if (n < qb && !((sel >> n) & 1u) && gate[n] > best) { best = gate[n]; bi = n; }
                sel |= 1u << bi; }
        }
        const int nk = (KIND == 1) ? t : t + 1;
        const int tp = (nk + 7) & ~7;
        const float cft = (KIND == 0) ? CF[(size_t)(b * 8 + h) * 2048 + t] : 0.f;
        const float slope2 = (KIND == 2) ? exp2f(-(float)(h + 1)) * LOG2E : 0.f;
        float mloc = -INFINITY;
        for (int s = lane; s < nk; s += 64) {
            float dot = 0.f;
#pragma unroll
            for (int c = 0; c < 8; ++c) { const u32x4 w = *(const u32x4*)(kp + (size_t)s * 64 + 8 * c);
                dot += q[8 * c] * bf_lo(w.x) + q[8 * c + 1] * bf_hi(w.x) + q[8 * c + 2] * bf_lo(w.y) + q[8 * c + 3] * bf_hi(w.y) + q[8 * c + 4] * bf_lo(w.z) + q[8 * c + 5] * bf_hi(w.z) + q[8 * c + 6] * bf_lo(w.w) + q[8 * c + 7] * bf_hi(w.w); }
            float v = dot;
            if (KIND == 0) v += cft - CF[(size_t)(b * 8 + h) * 2048 + s];
            if (KIND == 2) { const int n = s >> 8; const bool valid = (n == qb) || ((sel >> n) & 1u); v = valid ? v + slope2 * (float)(s - t) : -INFINITY; }
            lg[lgi(s)] = v; mloc = fmaxf(mloc, v);
        }
        float linv = 1.f;
        if (KIND != 1) {
            const float m = wave_max(mloc); float lsum = 0.f;
            for (int s = lane; s < tp; s += 64) { const float p = (s < nk) ? exp2f(lg[lgi(s)] - m) : 0.f; lg[lgi(s)] = p; lsum += p; }
            linv = 1.f / wave_sum(lsum);
        } else {
            float tot = 0.f;
            for (int i = 0; i < 32; ++i) { const int s = 32 * lane + i; if (s < nk) tot += lsn2f(lg[lgi(s)]); }
            float inc = tot;
#pragma unroll
            for (int o = 1; o < 64; o <<= 1) { const float w = __shfl_down(inc, o); if (lane + o < 64) inc += w; }
            float run = inc - tot;
            for (int i = 31; i >= 0; --i) { const int s = 32 * lane + i; float a = 0.f;
                if (s < nk) { const float z = lg[lgi(s)], l2 = lsn2f(z); a = exp2f(z + l2 + run); run += l2; }
                if (s < tp) lg[lgi(s)] = a; }
        }
        LDS_WAIT();
        const bf16_t* vp = VT + (hb * 64 + lane) * 2048; float o = 0.f;
        for (int s0 = 0; s0 < tp; s0 += 8) { const u32x4 w = *(const u32x4*)(vp + s0); const int i0 = lgi(s0);
            o += lg[i0] * bf_lo(w.x) + lg[i0 + 1] * bf_hi(w.x) + lg[i0 + 2] * bf_lo(w.y) + lg[i0 + 3] * bf_hi(w.y) + lg[i0 + 4] * bf_lo(w.z) + lg[i0 + 5] * bf_hi(w.z) + lg[i0 + 6] * bf_lo(w.w) + lg[i0 + 7] * bf_hi(w.w); }
        AO[(size_t)(b * 2048 + t) * DM + ao_col0 + h * 64 + lane] = (bf16_t)f2bf(o * linv);
        LDS_WAIT();
    }
}

__device__ __forceinline__ float lsn2q(float z2) { return -(fmaxf(z2, 0.f) + __builtin_amdgcn_logf(1.f + __builtin_amdgcn_exp2f(-fabsf(z2)))); }
__device__ __forceinline__ int pi32(int i) { return (i & ~12) | ((i & 4) << 1) | ((i & 8) >> 1); }
__device__ __forceinline__ void attn_load_k(bf16x8 (&kf)[4], const bf16_t* Kh, int kv0, int r32p, int hi) {
    const bf16_t* p = Kh + (size_t)(kv0 + r32p) * 64 + 8 * hi;
#pragma unroll
    for (int d0 = 0; d0 < 4; ++d0) kf[d0] = *(const bf16x8*)(p + 16 * d0);
}
__device__ __forceinline__ void attn_load_v(bf16x8 (&vf)[2][2], const bf16_t* Vth, int kv0, int r32, int hi) {
#pragma unroll
    for (int s = 0; s < 2; ++s)
#pragma unroll
        for (int dh = 0; dh < 2; ++dh) vf[s][dh] = *(const bf16x8*)(Vth + (size_t)(32 * dh + r32) * 2048 + kv0 + 16 * s + 8 * hi);
}
template <int KIND, int MODE>
__device__ __forceinline__ void attn_tile(const bf16x8 (&qr)[4], const bf16x8 (&kf)[4], const bf16x8 (&vf)[2][2], f32x16& O0, f32x16& O1, float& m, float& l, float& R,
                                          const f32x16& bias, const int kv0, const int q, const int hi, const bool rowok) {
    f32x16 S = bias;
#pragma unroll
    for (int d0 = 0; d0 < 4; ++d0) S = __builtin_amdgcn_mfma_f32_32x32x16_bf16(kf[d0], qr[d0], S, 0, 0, 0);
    if (MODE == 1) {
#pragma unroll
        for (int r = 0; r < 16; ++r) { const int key = kv0 + (r & 7) + 8 * hi + 16 * (r >> 3); const bool bad = (KIND == 1) ? (key >= q) : (key > q); if (bad) S[r] = -INFINITY; }
    }
    if (MODE == 2) { if (!rowok) {
#pragma unroll
        for (int r = 0; r < 16; ++r) S[r] = -INFINITY; } }
    float p[16];
    if (KIND != 1) {
        float rm = fmaxf(fmaxf(S[0], S[1]), fmaxf(S[2], S[3]));
#pragma unroll
        for (int r = 4; r < 16; r += 4) rm = fmaxf(rm, fmaxf(fmaxf(S[r], S[r + 1]), fmaxf(S[r + 2], S[r + 3])));
        rm = fmaxf(rm, __shfl_xor(rm, 32));
        const float mn = fmaxf(fmaxf(m, rm), -1e30f); const float alpha = __builtin_amdgcn_exp2f(m - mn);
        float ps = 0.f;
#pragma unroll
        for (int r = 0; r < 16; ++r) { p[r] = __builtin_amdgcn_exp2f(S[r] - mn); ps += p[r]; }
        l = l * alpha + ps; m = mn;
        O0 *= alpha; O1 *= alpha;
    } else {
        float l2[16]; float sLo = 0.f, sHi = 0.f;
#pragma unroll
        for (int r = 0; r < 16; ++r) l2[r] = lsn2q(S[r]);
#pragma unroll
        for (int r = 0; r < 8; ++r) { sLo += l2[r]; sHi += l2[8 + r]; }
        const float pLo = __shfl_xor(sLo, 32), pHi = __shfl_xor(sHi, 32);
        float run = hi ? R : R + pHi;
#pragma unroll
        for (int r = 15; r >= 8; --r) { p[r] = __builtin_amdgcn_exp2f(S[r] + l2[r] + run); run += l2[r]; }
        run = hi ? (R + sHi + pHi) : (R + pHi + sHi + pLo);
#pragma unroll
        for (int r = 7; r >= 0; --r) { p[r] = __builtin_amdgcn_exp2f(S[r] + l2[r] + run); run += l2[r]; }
        R += (sLo + sHi) + (pLo + pHi);
    }
    u32x4 w0, w1;
    w0.x = pk2(p[0], p[1]); w0.y = pk2(p[2], p[3]); w0.z = pk2(p[4], p[5]); w0.w = pk2(p[6], p[7]);
    w1.x = pk2(p[8], p[9]); w1.y = pk2(p[10], p[11]); w1.z = pk2(p[12], p[13]); w1.w = pk2(p[14], p[15]);
    const bf16x8 pf0 = __builtin_bit_cast(bf16x8, w0), pf1 = __builtin_bit_cast(bf16x8, w1);
    O0 = __builtin_amdgcn_mfma_f32_32x32x16_bf16(vf[0][0], pf0, O0, 0, 0, 0); O0 = __builtin_amdgcn_mfma_f32_32x32x16_bf16(vf[1][0], pf1, O0, 0, 0, 0);
    O1 = __builtin_amdgcn_mfma_f32_32x32x16_bf16(vf[0][1], pf0, O1, 0, 0, 0); O1 = __builtin_amdgcn_mfma_f32_32x32x16_bf16(vf[1][1], pf1, O1, 0, 0, 0);
}
template <int KIND>
__device__ __forceinline__ f32x16 attn_bias(const float* CFh, float slope2, int kv0, int q0, int hi) {
    f32x16 b = f32x16{};
    if (KIND == 0) { const float* c = CFh + kv0 + 8 * hi; const f32x4 a0 = *(const f32x4*)c, a1 = *(const f32x4*)(c + 4), a2 = *(const f32x4*)(c + 16), a3 = *(const f32x4*)(c + 20);
        b[0] = -a0[0]; b[1] = -a0[1]; b[2] = -a0[2]; b[3] = -a0[3]; b[4] = -a1[0]; b[5] = -a1[1]; b[6] = -a1[2]; b[7] = -a1[3];
        b[8] = -a2[0]; b[9] = -a2[1]; b[10] = -a2[2]; b[11] = -a2[3]; b[12] = -a3[0]; b[13] = -a3[1]; b[14] = -a3[2]; b[15] = -a3[3]; }
    if (KIND == 2) {
#pragma unroll
        for (int r = 0; r < 16; ++r) b[r] = slope2 * (float)(kv0 + (r & 7) + 8 * hi + 16 * (r >> 3) - q0); }
    return b;
}
template <int KIND>
__device__ __forceinline__ void attn_wave(const bf16_t* Qh, const bf16_t* Kh, const bf16_t* Vth, const int q0, const int lane, const float* CFh, const float slope2, const float* KMh, bf16_t* AOp) {
    const int r32 = lane & 31, hi = lane >> 5, r32p = pi32(r32), q = q0 + r32;
    bf16x8 qr[4];
#pragma unroll
    for (int d0 = 0; d0 < 4; ++d0) qr[d0] = *(const bf16x8*)(Qh + (size_t)q * 64 + 16 * d0 + 8 * hi);
    f32x16 O0 = f32x16{}, O1 = f32x16{};
    float m = -INFINITY, l = 0.f, R = 0.f;
    bf16x8 kf[4], kfn[4], vf[2][2];
    const int nt = q0 / 32 + 1;
    if (KIND == 0) {
        attn_load_k(kf, Kh, 0, r32p, hi);
        for (int it = 0; it < nt; ++it) { const int kv0 = 32 * it;
            attn_load_v(vf, Vth, kv0, r32, hi); const f32x16 bias = attn_bias<0>(CFh, 0.f, kv0, q0, hi);
            if (it + 1 < nt) attn_load_k(kfn, Kh, kv0 + 32, r32p, hi);
            if (it == nt - 1) attn_tile<0, 1>(qr, kf, vf, O0, O1, m, l, R, bias, kv0, q, hi, true); else attn_tile<0, 0>(qr, kf, vf, O0, O1, m, l, R, bias, kv0, q, hi, true);
#pragma unroll
            for (int d0 = 0; d0 < 4; ++d0) kf[d0] = kfn[d0]; }
    } else if (KIND == 1) {
        attn_load_k(kf, Kh, 32 * (nt - 1), r32p, hi);
        for (int it = nt - 1; it >= 0; --it) { const int kv0 = 32 * it;
            attn_load_v(vf, Vth, kv0, r32, hi); const f32x16 bias = f32x16{};
            if (it > 0) attn_load_k(kfn, Kh, kv0 - 32, r32p, hi);
            if (it == nt - 1) attn_tile<1, 1>(qr, kf, vf, O0, O1, m, l, R, bias, kv0, q, hi, true); else attn_tile<1, 0>(qr, kf, vf, O0, O1, m, l, R, bias, kv0, q, hi, true);
#pragma unroll
            for (int d0 = 0; d0 < 4; ++d0) kf[d0] = kfn[d0];
            if (__all(R < -200.f)) break; }
    } else {
        const int qb = q0 >> 8;
        f32x16 G = f32x16{};
#pragma unroll
        for (int d0 = 0; d0 < 4; ++d0) { u32x4 kw = {0u, 0u, 0u, 0u};
            if (r32 < 8) { const float* kmp = KMh + r32 * 64 + 16 * d0 + 8 * hi; kw = pack8(*(const f32x4*)kmp, *(const f32x4*)(kmp + 4)); }
            G = __builtin_amdgcn_mfma_f32_32x32x16_bf16(__builtin_bit_cast(bf16x8, kw), qr[d0], G, 0, 0, 0); }
        float gate[8];
#pragma unroll
        for (int n = 0; n < 4; ++n) { const float own = G[n], oth = __shfl_xor(own, 32); gate[n] = hi ? oth : own; gate[n + 4] = hi ? own : oth; }
        unsigned sel = 0u; const int nsel = qb < 3 ? qb : 3;
#pragma unroll
        for (int r = 0; r < 3; ++r) if (r < nsel) { float best = -INFINITY; int bi = 0;
#pragma unroll
            for (int n = 0; n < 8; ++n) if (n < qb && !((sel >> n) & 1u) && gate[n] > best) { best = gate[n]; bi = n; }
            sel |= 1u << bi; }
        for (int kv0 = 256 * qb; kv0 <= q0; kv0 += 32) {
            attn_load_k(kf, Kh, kv0, r32p, hi); attn_load_v(vf, Vth, kv0, r32, hi); const f32x16 bias = attn_bias<2>(nullptr, slope2, kv0, q0, hi);
            if (kv0 == q0) attn_tile<2, 1>(qr, kf, vf, O0, O1, m, l, R, bias, kv0, q, hi, true); else attn_tile<2, 0>(qr, kf, vf, O0, O1, m, l, R, bias, kv0, q, hi, true); }
        for (int j = 0; j < qb; ++j) { const bool rowok = (sel >> j) & 1u;
            if (!__any(rowok)) continue;
            attn_load_k(kf, Kh, 256 * j, r32p, hi);
            for (int i = 0; i < 8; ++i) { const int kv0 = 256 * j + 32 * i;
                attn_load_v(vf, Vth, kv0, r32, hi); const f32x16 bias = attn_bias<2>(nullptr, slope2, kv0, q0, hi);
                if (i < 7) attn_load_k(kfn, Kh, kv0 + 32, r32p, hi);
                attn_tile<2, 2>(qr, kf, vf, O0, O1, m, l, R, bias, kv0, q, hi, rowok);
#pragma unroll
                for (int d0 = 0; d0 < 4; ++d0) kf[d0] = kfn[d0]; } }
    }
    float linv = 1.f;
    if (KIND != 1) linv = 1.f / (l + __shfl_xor(l, 32));
    bf16_t* orow = AOp + (size_t)q * DM;
#pragma unroll
    for (int g = 0; g < 4; ++g) { u32x2 w;
        w.x = pk2(O0[4 * g] * linv, O0[4 * g + 1] * linv); w.y = pk2(O0[4 * g + 2] * linv, O0[4 * g + 3] * linv); *(u32x2*)(orow + 8 * g + 4 * hi) = w;
        w.x = pk2(O1[4 * g] * linv, O1[4 * g + 1] * linv); w.y = pk2(O1[4 * g + 2] * linv, O1[4 * g + 3] * linv); *(u32x2*)(orow + 32 + 8 * g + 4 * hi) = w; }
}
template <int KIND>
__device__ __forceinline__ void phase_attn(Frame& F, const bf16_t* QH, const bf16_t* KH, const bf16_t* VT, int NH, int hbase, const float* CF, const float* KMEAN, bf16_t* AO, int ao_col0) {
    for (int ug = F.vcu; ug < NB * 8 * 2; ug += F.G) {
        const int bh = ug >> 1, b = bh >> 3, h = bh & 7, hh = hbase + h; const size_t hb = (size_t)(b * NH + hh);
        const float slope2 = __builtin_amdgcn_exp2f(-(float)(h + 1)) * LOG2E;
#pragma unroll 1
        for (int i = 0; i < 4; ++i) { const int base = (i >> 1) * 2 + (ug & 1), qb = (i & 1) ? 7 - base : base, w = (i & 1) ? 7 - F.wave : F.wave;
            attn_wave<KIND>(QH + hb * 2048 * 64, KH + hb * 2048 * 64, VT + hb * 64 * 2048, 256 * qb + 32 * w, opaque_i(F.lane),
                            CF ? CF + (size_t)bh * 2048 : nullptr, slope2, KMEAN ? KMEAN + (size_t)bh * 8 * 64 : nullptr, AO + (size_t)b * 2048 * DM + ao_col0 + h * 64); }
    }
}


constexpr int AT_SLOT = 16384, AT_CF = 3 * AT_SLOT;
__device__ __forceinline__ void attn_dma_tile(const bf16_t* Kh, const bf16_t* Vth, int T, LAS unsigned char* slot, int wave, int r32, int r32p, int hi) {
    const int j = wave >> 2, d0 = wave & 3, s2 = (wave >> 1) & 1, dh = wave & 1;
    const bf16_t* ks = Kh + (size_t)(64 * T + 32 * j + r32p) * 64 + 16 * d0 + 8 * hi;
    const bf16_t* vs = Vth + (size_t)(32 * dh + r32) * 2048 + 64 * T + 32 * j + 16 * s2 + 8 * hi;
    __builtin_amdgcn_global_load_lds((const unsigned*)ks, (LAS unsigned*)(slot + (j * 4 + d0) * 1024), 16, 0, 0);
    __builtin_amdgcn_global_load_lds((const unsigned*)vs, (LAS unsigned*)(slot + 8192 + ((j * 2 + s2) * 2 + dh) * 1024), 16, 0, 0);
}
template <int MODE>
__device__ __forceinline__ void attn_fox_sub(const bf16x8 (&qr)[4], f32x16& O0, f32x16& O1, float& m, float& l, unsigned saddr  , unsigned cfaddr  , int j, int kv0, int q, int hi) {
    bf16x8 kf[4], vf[2][2]; f32x4 c0, c1, c2, c3;
    asm volatile("ds_read_b128 %0, %12\n\tds_read_b128 %1, %12 offset:1024\n\tds_read_b128 %2, %12 offset:2048\n\tds_read_b128 %3, %12 offset:3072\n\t"
                 "ds_read_b128 %8, %14\n\tds_read_b128 %9, %14 offset:16\n\tds_read_b128 %10, %14 offset:64\n\tds_read_b128 %11, %14 offset:80\n\t"
                 "ds_read_b128 %4, %13\n\tds_read_b128 %5, %13 offset:1024\n\tds_read_b128 %6, %13 offset:2048\n\tds_read_b128 %7, %13 offset:3072\n\ts_waitcnt lgkmcnt(4)"
                 : "=&v"(kf[0]), "=&v"(kf[1]), "=&v"(kf[2]), "=&v"(kf[3]), "=&v"(vf[0][0]), "=&v"(vf[0][1]), "=&v"(vf[1][0]), "=&v"(vf[1][1]), "=&v"(c0), "=&v"(c1), "=&v"(c2), "=&v"(c3)
                 : "v"(saddr + (unsigned)j * 4096u), "v"(saddr + 8192u + (unsigned)j * 4096u), "v"(cfaddr) : "memory");
    f32x16 S;
    S[0] = c0[0]; S[1] = c0[1]; S[2] = c0[2]; S[3] = c0[3]; S[4] = c1[0]; S[5] = c1[1]; S[6] = c1[2]; S[7] = c1[3];
    S[8] = c2[0]; S[9] = c2[1]; S[10] = c2[2]; S[11] = c2[3]; S[12] = c3[0]; S[13] = c3[1]; S[14] = c3[2]; S[15] = c3[3];
#pragma unroll
    for (int d0 = 0; d0 < 4; ++d0) S = __builtin_amdgcn_mfma_f32_32x32x16_bf16(kf[d0], qr[d0], S, 0, 0, 0);
    if (MODE == 1) {
#pragma unroll
        for (int r = 0; r < 16; ++r) { const int key = kv0 + (r & 7) + 8 * hi + 16 * (r >> 3); if (key > q) S[r] = -INFINITY; }
    }
    float rm = fmaxf(fmaxf(S[0], S[1]), fmaxf(S[2], S[3]));
#pragma unroll
    for (int r = 4; r < 16; r += 4) rm = fmaxf(rm, fmaxf(fmaxf(S[r], S[r + 1]), fmaxf(S[r + 2], S[r + 3])));
    { const auto rr = __builtin_amdgcn_permlane32_swap(__float_as_uint(rm), __float_as_uint(rm), false, false); rm = fmaxf(__uint_as_float(rr[0]), __uint_as_float(rr[1])); }
    if (__any(rm > m)) {
        const float mn = fmaxf(fmaxf(m, rm), -1e30f); const float alpha = __builtin_amdgcn_exp2f(m - mn);
        l *= alpha; O0 *= alpha; O1 *= alpha; m = mn; }
    float p[16]; float ps = 0.f;
#pragma unroll
    for (int r = 0; r < 16; ++r) { p[r] = __builtin_amdgcn_exp2f(S[r] - m); ps += p[r]; }
    l += ps;
    u32x4 w0, w1;
    w0.x = pk2(p[0], p[1]); w0.y = pk2(p[2], p[3]); w0.z = pk2(p[4], p[5]); w0.w = pk2(p[6], p[7]);
    w1.x = pk2(p[8], p[9]); w1.y = pk2(p[10], p[11]); w1.z = pk2(p[12], p[13]); w1.w = pk2(p[14], p[15]);
    const bf16x8 pf0 = __builtin_bit_cast(bf16x8, w0), pf1 = __builtin_bit_cast(bf16x8, w1);
    asm volatile("s_waitcnt lgkmcnt(0)" : "+v"(vf[0][0]), "+v"(vf[0][1]), "+v"(vf[1][0]), "+v"(vf[1][1]) :: "memory");
    O0 = __builtin_amdgcn_mfma_f32_32x32x16_bf16(vf[0][0], pf0, O0, 0, 0, 0); O0 = __builtin_amdgcn_mfma_f32_32x32x16_bf16(vf[1][0], pf1, O0, 0, 0, 0);
    O1 = __builtin_amdgcn_mfma_f32_32x32x16_bf16(vf[0][1], pf0, O1, 0, 0, 0); O1 = __builtin_amdgcn_mfma_f32_32x32x16_bf16(vf[1][1], pf1, O1, 0, 0, 0);
}
__device__ __forceinline__ void attn_fox_unit(Frame& F, const bf16_t* Qh, const bf16_t* Kh, const bf16_t* Vth, const float* CFh, const int qb, bf16_t* AOp) {
    const int lane = opaque_i(F.lane), r32 = lane & 31, hi = lane >> 5, r32p = pi32(r32), wave = F.wave, q0 = 256 * qb + 32 * wave, q = q0 + r32;
    LAS unsigned char* ring = F.lds; const unsigned ring_a = (unsigned)(uintptr_t)ring + 16u * (unsigned)lane, cf_a = (unsigned)(uintptr_t)ring + (unsigned)AT_CF + 32u * (unsigned)hi;
    bf16x8 qr[4];
#pragma unroll
    for (int d0 = 0; d0 < 4; ++d0) qr[d0] = *(const bf16x8*)(Qh + (size_t)q * 64 + 16 * d0 + 8 * hi);
    { const f32x4 cv = *(const f32x4*)(CFh + 4 * F.tid); *(LAS f32x4*)(ring + AT_CF + 16 * F.tid) = -cv; }
    asm volatile("s_waitcnt vmcnt(0) lgkmcnt(0)" ::: "memory"); __builtin_amdgcn_s_barrier();
    const int NT = 4 * qb + 4, my_last = 4 * qb + (wave >> 1), jdiag = wave & 1;
    attn_dma_tile(Kh, Vth, NT - 1, ring, wave, r32, r32p, hi);
    attn_dma_tile(Kh, Vth, NT - 2, ring + AT_SLOT, wave, r32, r32p, hi);
    f32x16 O0 = f32x16{}, O1 = f32x16{}; float m = -INFINITY, l = 0.f;
    int slot = 0;
#pragma unroll 1
    for (int T = NT - 1; T >= 0; --T) {
        if (T > 0) asm volatile("s_waitcnt vmcnt(2)" ::: "memory"); else asm volatile("s_waitcnt vmcnt(0)" ::: "memory");
        __builtin_amdgcn_s_barrier();
        if (T >= 2) { const int fs = (slot == 0) ? 2 : slot - 1; attn_dma_tile(Kh, Vth, T - 2, ring + fs * AT_SLOT, wave, r32, r32p, hi); }
        if (T <= my_last) {
            const unsigned sa = ring_a + (unsigned)(slot * AT_SLOT);
            if (T == my_last) {
                if (jdiag == 1) { attn_fox_sub<1>(qr, O0, O1, m, l, sa, cf_a + 4u * (unsigned)(64 * T + 32), 1, 64 * T + 32, q, hi); attn_fox_sub<0>(qr, O0, O1, m, l, sa, cf_a + 4u * (unsigned)(64 * T), 0, 64 * T, q, hi); }
                else attn_fox_sub<1>(qr, O0, O1, m, l, sa, cf_a + 4u * (unsigned)(64 * T), 0, 64 * T, q, hi);
            } else { attn_fox_sub<0>(qr, O0, O1, m, l, sa, cf_a + 4u * (unsigned)(64 * T + 32), 1, 64 * T + 32, q, hi); attn_fox_sub<0>(qr, O0, O1, m, l, sa, cf_a + 4u * (unsigned)(64 * T), 0, 64 * T, q, hi); }
        }
        slot = (slot == 2) ? 0 : slot + 1;
    }
    const float linv = 1.f / (l + __shfl_xor(l, 32));
    bf16_t* orow = AOp + (size_t)q * DM;
#pragma unroll
    for (int g = 0; g < 4; ++g) { u32x2 w;
        w.x = pk2(O0[4 * g] * linv, O0[4 * g + 1] * linv); w.y = pk2(O0[4 * g + 2] * linv, O0[4 * g + 3] * linv); *(u32x2*)(orow + 8 * g + 4 * hi) = w;
        w.x = pk2(O1[4 * g] * linv, O1[4 * g + 1] * linv); w.y = pk2(O1[4 * g + 2] * linv, O1[4 * g + 3] * linv); *(u32x2*)(orow + 32 + 8 * g + 4 * hi) = w; }
    asm volatile("s_waitcnt vmcnt(0) lgkmcnt(0)" ::: "memory"); __builtin_amdgcn_s_barrier();
}
__device__ __forceinline__ void phase_attn_fox(Frame& F, const bf16_t* QH, const bf16_t* KH, const bf16_t* VT, const float* LF, float* CF, bf16_t* AO) {
    for (int ug = F.vcu; ug < NB * 8 * 2; ug += F.G) {
        const int bh = ug >> 1, b = bh >> 3, h = bh & 7; const size_t hb = (size_t)(b * 16 + h);
        cfscan_block(F, LF, CF, bh);
#pragma unroll 1
        for (int i = 0; i < 4; ++i) { const int base = (i >> 1) * 2 + (ug & 1), qb = (i & 1) ? 7 - base : base;
            attn_fox_unit(F, QH + hb * 2048 * 64, KH + hb * 2048 * 64, VT + hb * 64 * 2048, CF + (size_t)bh * 2048, qb, AO + (size_t)b * 2048 * DM + h * 64); }
    }
}

template <int MODE>
__device__ __forceinline__ void attn_moba_sub(const bf16x8 (&qr)[4], f32x16& O0, f32x16& O1, float& m, float& l, unsigned saddr, int j, int kv0, int q, int q0, int hi, float slope2, bool rowok) {
    bf16x8 kf[4], vf[2][2];
    asm volatile("ds_read_b128 %0, %8\n\tds_read_b128 %1, %8 offset:1024\n\tds_read_b128 %2, %8 offset:2048\n\tds_read_b128 %3, %8 offset:3072\n\t"
                 "ds_read_b128 %4, %9\n\tds_read_b128 %5, %9 offset:1024\n\tds_read_b128 %6, %9 offset:2048\n\tds_read_b128 %7, %9 offset:3072\n\ts_waitcnt lgkmcnt(4)"
                 : "=&v"(kf[0]), "=&v"(kf[1]), "=&v"(kf[2]), "=&v"(kf[3]), "=&v"(vf[0][0]), "=&v"(vf[0][1]), "=&v"(vf[1][0]), "=&v"(vf[1][1])
                 : "v"(saddr + (unsigned)j * 4096u), "v"(saddr + 8192u + (unsigned)j * 4096u) : "memory");
    f32x16 S; const float sbase = slope2 * (float)(kv0 + 8 * hi - q0);
#pragma unroll
    for (int r = 0; r < 16; ++r) S[r] = sbase + slope2 * (float)((r & 7) + 16 * (r >> 3));
#pragma unroll
    for (int d0 = 0; d0 < 4; ++d0) S = __builtin_amdgcn_mfma_f32_32x32x16_bf16(kf[d0], qr[d0], S, 0, 0, 0);
    if (MODE == 1) {
#pragma unroll
        for (int r = 0; r < 16; ++r) { const int key = kv0 + (r & 7) + 8 * hi + 16 * (r >> 3); if (key > q) S[r] = -INFINITY; }
    }
    if (MODE == 2) { if (!rowok) {
#pragma unroll
        for (int r = 0; r < 16; ++r) S[r] = -INFINITY; } }
    float rm = fmaxf(fmaxf(S[0], S[1]), fmaxf(S[2], S[3]));
#pragma unroll
    for (int r = 4; r < 16; r += 4) rm = fmaxf(rm, fmaxf(fmaxf(S[r], S[r + 1]), fmaxf(S[r + 2], S[r + 3])));
    { const auto rr = __builtin_amdgcn_permlane32_swap(__float_as_uint(rm), __float_as_uint(rm), false, false); rm = fmaxf(__uint_as_float(rr[0]), __uint_as_float(rr[1])); }
    if (__any(rm > m)) { const float mn = fmaxf(fmaxf(m, rm), -1e30f); const float alpha = __builtin_amdgcn_exp2f(m - mn); l *= alpha; O0 *= alpha; O1 *= alpha; m = mn; }
    float p[16]; float ps = 0.f;
#pragma unroll
    for (int r = 0; r < 16; ++r) { p[r] = __builtin_amdgcn_exp2f(S[r] - m); ps += p[r]; }
    l += ps;
    u32x4 w0, w1;
    w0.x = pk2(p[0], p[1]); w0.y = pk2(p[2], p[3]); w0.z = pk2(p[4], p[5]); w0.w = pk2(p[6], p[7]);
    w1.x = pk2(p[8], p[9]); w1.y = pk2(p[10], p[11]); w1.z = pk2(p[12], p[13]); w1.w = pk2(p[14], p[15]);
    const bf16x8 pf0 = __builtin_bit_cast(bf16x8, w0), pf1 = __builtin_bit_cast(bf16x8, w1);
    asm volatile("s_waitcnt lgkmcnt(0)" : "+v"(vf[0][0]), "+v"(vf[0][1]), "+v"(vf[1][0]), "+v"(vf[1][1]) :: "memory");
    O0 = __builtin_amdgcn_mfma_f32_32x32x16_bf16(vf[0][0], pf0, O0, 0, 0, 0); O0 = __builtin_amdgcn_mfma_f32_32x32x16_bf16(vf[1][0], pf1, O0, 0, 0, 0);
    O1 = __builtin_amdgcn_mfma_f32_32x32x16_bf16(vf[0][1], pf0, O1, 0, 0, 0); O1 = __builtin_amdgcn_mfma_f32_32x32x16_bf16(vf[1][1], pf1, O1, 0, 0, 0);
}
__device__ __forceinline__ void attn_moba_unit(Frame& F, const bf16_t* Qh, const bf16_t* Kh, const bf16_t* Vth, const float* KMh, const float slope2, const int qb, bf16_t* AOp) {
    const int lane = opaque_i(F.lane), r32 = lane & 31, hi = lane >> 5, r32p = pi32(r32), wave = F.wave, q0 = 256 * qb + 32 * wave, q = q0 + r32;
    LAS unsigned char* ring = F.lds; const unsigned ring_a = (unsigned)(uintptr_t)ring + 16u * (unsigned)lane;
    bf16x8 qr[4];
#pragma unroll
    for (int d0 = 0; d0 < 4; ++d0) qr[d0] = *(const bf16x8*)(Qh + (size_t)q * 64 + 16 * d0 + 8 * hi);
    f32x16 G = f32x16{};
#pragma unroll
    for (int d0 = 0; d0 < 4; ++d0) { u32x4 kw = {0u, 0u, 0u, 0u};
        if (r32 < 8) { const float* kmp = KMh + r32 * 64 + 16 * d0 + 8 * hi; kw = pack8(*(const f32x4*)kmp, *(const f32x4*)(kmp + 4)); }
        G = __builtin_amdgcn_mfma_f32_32x32x16_bf16(__builtin_bit_cast(bf16x8, kw), qr[d0], G, 0, 0, 0); }
    float gate[8];
#pragma unroll
    for (int n = 0; n < 4; ++n) { const float own = G[n], oth = __shfl_xor(own, 32); gate[n] = hi ? oth : own; gate[n + 4] = hi ? own : oth; }
    unsigned sel = 0u; const int nsel = qb < 3 ? qb : 3;
#pragma unroll
    for (int r = 0; r < 3; ++r) if (r < nsel) { float best = -INFINITY; int bi = 0;
#pragma unroll
        for (int n = 0; n < 8; ++n) if (n < qb && !((sel >> n) & 1u) && gate[n] > best) { best = gate[n]; bi = n; }
        sel |= 1u << bi; }
    unsigned wsel = 0u;
#pragma unroll
    for (int n = 0; n < 8; ++n) if (__any((sel >> n) & 1u)) wsel |= 1u << n;
    asm volatile("s_waitcnt vmcnt(0) lgkmcnt(0)" ::: "memory"); __builtin_amdgcn_s_barrier();
    const int NT = 4 * qb + 4, my_last = 4 * qb + (wave >> 1), jdiag = wave & 1;
    attn_dma_tile(Kh, Vth, NT - 1, ring, wave, r32, r32p, hi);
    attn_dma_tile(Kh, Vth, NT - 2, ring + AT_SLOT, wave, r32, r32p, hi);
    f32x16 O0 = f32x16{}, O1 = f32x16{}; float m = -INFINITY, l = 0.f;
    int slot = 0;
#pragma unroll 1
    for (int T = NT - 1; T >= 0; --T) {
        if (T > 0) asm volatile("s_waitcnt vmcnt(2)" ::: "memory"); else asm volatile("s_waitcnt vmcnt(0)" ::: "memory");
        __builtin_amdgcn_s_barrier();
        if (T >= 2) { const int fs = (slot == 0) ? 2 : slot - 1; attn_dma_tile(Kh, Vth, T - 2, ring + fs * AT_SLOT, wave, r32, r32p, hi); }
        const unsigned sa = ring_a + (unsigned)(slot * AT_SLOT);
        if (T >= 4 * qb) {
            if (T == my_last) {
                if (jdiag == 1) { attn_moba_sub<1>(qr, O0, O1, m, l, sa, 1, 64 * T + 32, q, q0, hi, slope2, true); attn_moba_sub<0>(qr, O0, O1, m, l, sa, 0, 64 * T, q, q0, hi, slope2, true); }
                else attn_moba_sub<1>(qr, O0, O1, m, l, sa, 0, 64 * T, q, q0, hi, slope2, true);
            } else if (T < my_last) { attn_moba_sub<0>(qr, O0, O1, m, l, sa, 1, 64 * T + 32, q, q0, hi, slope2, true); attn_moba_sub<0>(qr, O0, O1, m, l, sa, 0, 64 * T, q, q0, hi, slope2, true); }
        } else if ((wsel >> (T >> 2)) & 1u) {
            const bool rowok = (sel >> (T >> 2)) & 1u;
            attn_moba_sub<2>(qr, O0, O1, m, l, sa, 1, 64 * T + 32, q, q0, hi, slope2, rowok); attn_moba_sub<2>(qr, O0, O1, m, l, sa, 0, 64 * T, q, q0, hi, slope2, rowok);
        }
        slot = (slot == 2) ? 0 : slot + 1;
    }
    const float linv = 1.f / (l + __shfl_xor(l, 32));
    bf16_t* orow = AOp + (size_t)q * DM;
#pragma unroll
    for (int g = 0; g < 4; ++g) { u32x2 w;
        w.x = pk2(O0[4 * g] * linv, O0[4 * g + 1] * linv); w.y = pk2(O0[4 * g + 2] * linv, O0[4 * g + 3] * linv); *(u32x2*)(orow + 8 * g + 4 * hi) = w;
        w.x = pk2(O1[4 * g] * linv, O1[4 * g + 1] * linv); w.y = pk2(O1[4 * g + 2] * linv, O1[4 * g + 3] * linv); *(u32x2*)(orow + 32 + 8 * g + 4 * hi) = w; }
    asm volatile("s_waitcnt vmcnt(0) lgkmcnt(0)" ::: "memory"); __builtin_amdgcn_s_barrier();
}
__device__ __forceinline__ void phase_attn_moba(Frame& F, const bf16_t* QD, const bf16_t* KD, const bf16_t* VTD, float* KMEAN, bf16_t* AO) {
    for (int ug = F.vcu; ug < NB * 8 * 2; ug += F.G) {
        const int bh = ug >> 1, b = bh >> 3, h = bh & 7; const size_t hb = (size_t)bh;
        phase_kmean(F, KD, KMEAN, bh); asm volatile("s_waitcnt vmcnt(0)" ::: "memory"); __syncthreads();
        const float slope2 = __builtin_amdgcn_exp2f(-(float)(h + 1)) * LOG2E;
#pragma unroll 1
        for (int i = 0; i < 4; ++i) { const int base = (i >> 1) * 2 + (ug & 1), qb = (i & 1) ? 7 - base : base;
            attn_moba_unit(F, QD + hb * 2048 * 64, KD + hb * 2048 * 64, VTD + hb * 64 * 2048, KMEAN + (size_t)bh * 8 * 64, slope2, qb, AO + (size_t)b * 2048 * DM + 512 + h * 64); }
    }
}
__device__ __forceinline__ void phase_pool(Frame& F, const bf16_t* XC, const bf16_t* PWT, const float* pool_scale, bf16_t* AO) {
    const int gw = F.vcu * NWAVES + F.wave, NGW = F.G * NWAVES, lane = opaque_i(F.lane), r32 = lane & 31, hi = lane >> 5;
    for (int it = gw; it < (TOK / 32) * 4; it += NGW) {
        const int rnd = it / NGW, gq = it - rnd * NGW;
        const int g = (rnd & 1) ? 3 - (gq & 3) : (gq & 3), t0 = (rnd * (NGW >> 2) + (gq >> 2)) * 32, t = t0 + r32, tl = t & 2047, w = 2 << g;
        const int cnt = (tl + 1) < w ? (tl + 1) : w; const float rc = 1.f / (float)cnt;
        f32x16 acc[4];
#pragma unroll
        for (int nb = 0; nb < 4; ++nb) acc[nb] = f32x16{};
#pragma unroll 1
        for (int kk = 0; kk < 8; ++kk) {
            const int c0 = g * 128 + kk * 16 + hi * 8;
            const u32x4 self = *(const u32x4*)(XC + (size_t)t * 512 + c0);
            float s[8] = {0.f, 0.f, 0.f, 0.f, 0.f, 0.f, 0.f, 0.f};
            for (int i = 0; i < cnt; ++i) { const u32x4 x = *(const u32x4*)(XC + (size_t)(t - i) * 512 + c0);
                s[0] += bf_lo(x.x); s[1] += bf_hi(x.x); s[2] += bf_lo(x.y); s[3] += bf_hi(x.y); s[4] += bf_lo(x.z); s[5] += bf_hi(x.z); s[6] += bf_lo(x.w); s[7] += bf_hi(x.w); }
            u32x4 pa; pa.x = pk2(s[0] * rc - bf_lo(self.x), s[1] * rc - bf_hi(self.x)); pa.y = pk2(s[2] * rc - bf_lo(self.y), s[3] * rc - bf_hi(self.y));
            pa.z = pk2(s[4] * rc - bf_lo(self.z), s[5] * rc - bf_hi(self.z)); pa.w = pk2(s[6] * rc - bf_lo(self.w), s[7] * rc - bf_hi(self.w));
            const bf16x8 af = __builtin_bit_cast(bf16x8, pa);
#pragma unroll
            for (int nb = 0; nb < 4; ++nb) { const bf16x8 bfr = *(const bf16x8*)(PWT + ((size_t)g * 128 + nb * 32 + r32) * 128 + kk * 16 + hi * 8);
                acc[nb] = __builtin_amdgcn_mfma_f32_32x32x16_bf16(af, bfr, acc[nb], 0, 0, 0); }
        }
#pragma unroll
        for (int nb = 0; nb < 4; ++nb) { const int col = g * 128 + nb * 32 + r32; const float sc = pool_scale[col];
#pragma unroll
            for (int r = 0; r < 16; ++r) { const int row = (r & 3) + 8 * (r >> 2) + 4 * hi; AO[(size_t)(t0 + row) * DM + col] = (bf16_t)f2bf(acc[nb][r] * sc); } }
    }
}

__device__ __forceinline__ void phase_topk_naive(Frame& F, const bf16_t* QP, const bf16_t* K1B, const bf16_t* K2B, unsigned short* EID, float* GATE) {
    const int gw = F.vcu * NWAVES + F.wave, NGW = F.G * NWAVES, lane = opaque_i(F.lane);
    for (int task = gw; task < TOK * 8; task += NGW) {
        const int t = task >> 3, h = task & 7;
        const bf16_t* qrow = QP + (size_t)t * 2048 + h * 256; const bf16_t* k1 = K1B + (size_t)h * 128 * 128; const bf16_t* k2 = K2B + (size_t)h * 128 * 128;
        float s1a = 0.f, s1b = 0.f, s2a = 0.f, s2b = 0.f;
#pragma unroll 4
        for (int c = 0; c < 16; ++c) { const u32x4 q1 = *(const u32x4*)(qrow + 8 * c), q2 = *(const u32x4*)(qrow + 128 + 8 * c);
            s1a = dot8(*(const u32x4*)(k1 + (size_t)lane * 128 + 8 * c), q1, s1a); s1b = dot8(*(const u32x4*)(k1 + (size_t)(lane + 64) * 128 + 8 * c), q1, s1b);
            s2a = dot8(*(const u32x4*)(k2 + (size_t)lane * 128 + 8 * c), q2, s2a); s2b = dot8(*(const u32x4*)(k2 + (size_t)(lane + 64) * 128 + 8 * c), q2, s2b); }
        unsigned A = (f2ord(s1a) & ~127u) | (unsigned)(127 - lane), B = (f2ord(s1b) & ~127u) | (unsigned)(63 - lane);
        unsigned top1 = 0u, top2 = 0u, topc = 0u;
        for (int r = 0; r < 16; ++r) { const unsigned m = wave_umax(A > B ? A : B); if (lane == r) top1 = m; if (A == m) A = 0u; if (B == m) B = 0u; }
        A = (f2ord(s2a) & ~127u) | (unsigned)(127 - lane); B = (f2ord(s2b) & ~127u) | (unsigned)(63 - lane);
        for (int r = 0; r < 16; ++r) { const unsigned m = wave_umax(A > B ? A : B); if (lane == r) top2 = m; if (A == m) A = 0u; if (B == m) B = 0u; }
        const float v1 = ord2f(top1 & ~127u), v2 = ord2f(top2 & ~127u); const int i1 = 127 - (int)(top1 & 127u), i2 = 127 - (int)(top2 & 127u);
        const float va = __shfl(v1, lane >> 2); unsigned C[4];
#pragma unroll
        for (int j = 0; j < 4; ++j) { const float vb = __shfl(v2, (lane & 3) * 4 + j); C[j] = (f2ord(va + vb) & ~255u) | (unsigned)(255 - (lane * 4 + j)); }
        for (int r = 0; r < 16; ++r) { unsigned m = C[0] > C[1] ? C[0] : C[1]; const unsigned m2 = C[2] > C[3] ? C[2] : C[3]; m = wave_umax(m > m2 ? m : m2); if (lane == r) topc = m;
#pragma unroll
            for (int j = 0; j < 4; ++j) if (C[j] == m) C[j] = 0u; }
        const int c = 255 - (int)(topc & 255u); const float val = ord2f(topc & ~255u);
        const int ia = __shfl(i1, c >> 4), ib = __shfl(i2, c & 15);
        const float v0 = __shfl(val, 0); const float e = (lane < 16) ? __expf(val - v0) : 0.f; const float sum = wave_sum(e);
        if (lane < 16) { EID[(size_t)t * 128 + h * 16 + lane] = (unsigned short)(ia * 128 + ib); GATE[(size_t)t * 128 + h * 16 + lane] = e / sum; }
    }
}

#define DEVFN __device__ __forceinline__
template <int OFF, int N, int TOT> DEVFN void bitonic_sort_desc(unsigned (&a)[TOT]) {
#pragma unroll
    for (int k = 2; k <= N; k <<= 1)
#pragma unroll
        for (int j = k >> 1; j > 0; j >>= 1)
#pragma unroll
            for (int i = 0; i < N; ++i) { const int l = i ^ j; if (l > i) { const bool desc = ((i & k) == 0); const unsigned x = a[OFF + i], y = a[OFF + l];
                const unsigned mx = x > y ? x : y, mn = x > y ? y : x; a[OFF + i] = desc ? mx : mn; a[OFF + l] = desc ? mn : mx; } }
}
constexpr int OE16_N = 63;
constexpr unsigned char OE16[63][2] = {{0,1}, {2,3}, {0,2}, {1,3}, {1,2}, {4,5}, {6,7}, {4,6}, {5,7}, {5,6}, {0,4}, {2,6}, {2,4}, {1,5}, {3,7}, {3,5}, {1,2}, {3,4}, {5,6}, {8,9}, {10,11}, {8,10}, {9,11}, {9,10}, {12,13}, {14,15}, {12,14}, {13,15}, {13,14}, {8,12}, {10,14}, {10,12}, {9,13}, {11,15}, {11,13}, {9,10}, {11,12}, {13,14}, {0,8}, {4,12}, {4,8}, {2,10}, {6,14}, {6,10}, {2,4}, {6,8}, {10,12}, {1,9}, {5,13}, {5,9}, {3,11}, {7,15}, {7,11}, {3,5}, {7,9}, {11,13}, {1,2}, {3,4}, {5,6}, {7,8}, {9,10}, {11,12}, {13,14}};
template <int OFF, int TOT> DEVFN void sort16_desc(unsigned (&a)[TOT]) {
#pragma unroll
    for (int q = 0; q < OE16_N; ++q) { const int i = OFF + OE16[q][0], l = OFF + OE16[q][1]; const unsigned x = a[i], y = a[l]; a[i] = x > y ? x : y; a[l] = x > y ? y : x; }
}
template <int OFF, int TOT> DEVFN void bitonic_merge16_desc(unsigned (&a)[TOT]) {
#pragma unroll
    for (int j = 8; j > 0; j >>= 1)
#pragma unroll
        for (int i = 0; i < 16; ++i) { const int l = i ^ j; if (l > i) { const unsigned x = a[OFF + i], y = a[OFF + l]; a[OFF + i] = x > y ? x : y; a[OFF + l] = x > y ? y : x; } }
}
template <int A, int B, int TOT> DEVFN void merge_top16(unsigned (&a)[TOT]) {
#pragma unroll
    for (int i = 0; i < 16; ++i) { const unsigned x = a[A + i], y = a[B + 15 - i]; a[A + i] = x > y ? x : y; }
    bitonic_merge16_desc<A, TOT>(a);
}
DEVFN void top16of64(unsigned (&a)[64]) {
    sort16_desc<0, 64>(a); sort16_desc<16, 64>(a); sort16_desc<32, 64>(a); sort16_desc<48, 64>(a);
    merge_top16<0, 16, 64>(a); merge_top16<32, 48, 64>(a); merge_top16<0, 32, 64>(a);
}

constexpr int TK_KSTRIDE = 272, TK_KSET = 128 * TK_KSTRIDE, TK_KBYTES = 2 * TK_KSET;
__device__ __forceinline__ void phase_topk(Frame& F, const bf16_t* QP, const bf16_t* K1B, const bf16_t* K2B, unsigned short* EID, float* GATE) {
    const int lane = opaque_i(F.lane), r32 = lane & 31, hi = lane >> 5, b = (int)blockIdx.x, h = b & 7, nbh = F.G >> 3;
    for (int c = F.tid; c < 2 * 128 * 16; c += NWAVES * 64) { const int sub = c >> 11, n = (c >> 4) & 127, part = c & 15;
        *(LAS u32x4*)(F.lds + sub * TK_KSET + n * TK_KSTRIDE + 16 * part) = *(const u32x4*)((sub ? K2B : K1B) + ((size_t)h * 128 + n) * 128 + 8 * part); }
    __syncthreads();
    LAS unsigned* I1s = (LAS unsigned*)(F.lds + TK_KBYTES + F.wave * 8192); LAS unsigned* I2s = I1s + 1024;
    bf16x8 qn[8];
    { const int tile0 = (b >> 3) + nbh * F.wave; const bf16_t* qrow = QP + (size_t)((tile0 < TOK / 32 ? tile0 : 0) * 32 + r32) * 2048 + h * 256 + 8 * hi;
#pragma unroll
      for (int kk = 0; kk < 8; ++kk) qn[kk] = *(const bf16x8*)(qrow + 16 * kk); }
    for (int tile = (b >> 3) + nbh * F.wave; tile < TOK / 32; tile += nbh * NWAVES) {
        const int t = tile * 32 + r32;
        unsigned V1[16], V2[16]; unsigned h4 = (unsigned)hi << 2; asm volatile("" : "+v"(h4));
#pragma unroll
        for (int half = 0; half < 2; ++half) {
            bf16x8 qf[8];
#pragma unroll
            for (int kk = 0; kk < 8; ++kk) qf[kk] = qn[kk];
            { const int tnx = tile + nbh * NWAVES, tl = half ? (tnx < TOK / 32 ? tnx : tile) : tile;
              const bf16_t* qrow = QP + (size_t)(tl * 32 + r32) * 2048 + h * 256 + (half ? 0 : 128) + 8 * hi;
#pragma unroll
              for (int kk = 0; kk < 8; ++kk) qn[kk] = *(const bf16x8*)(qrow + 16 * kk); }
            unsigned K[64];
#pragma unroll
            for (int nb = 0; nb < 4; ++nb) { f32x16 acc = f32x16{};
                LAS const unsigned char* kb = F.lds + half * TK_KSET + (nb * 32 + r32) * TK_KSTRIDE + 16 * hi; asm volatile("" : "+v"(kb));
#pragma unroll
                for (int kk = 0; kk < 8; ++kk) acc = __builtin_amdgcn_mfma_f32_32x32x16_bf16(*(LAS const bf16x8*)(kb + 32 * kk), qf[kk], acc, 0, 0, 0);
#pragma unroll
                for (int r = 0; r < 16; ++r) {
                    const unsigned x = __float_as_uint(acc[r]), o = x ^ ((unsigned)((int)x >> 31) | 0x80000000u); const int j = r >> 2;
                    const unsigned pack = (unsigned)(127 - (nb * 32 + 0 + 8 * j)) | ((unsigned)(127 - (nb * 32 + 1 + 8 * j)) << 8) | ((unsigned)(127 - (nb * 32 + 2 + 8 * j)) << 16) | ((unsigned)(127 - (nb * 32 + 3 + 8 * j)) << 24);
                    K[nb * 16 + r] = __builtin_amdgcn_perm(o, pack, 0x07060500u | (unsigned)(r & 3)); }
                __builtin_amdgcn_sched_barrier(0); }
            __builtin_amdgcn_sched_barrier(0); top16of64(K); __builtin_amdgcn_sched_barrier(0);
#pragma unroll
            for (int i = 0; i < 16; ++i) K[i] ^= h4;
            unsigned C[16];
#pragma unroll
            for (int i = 0; i < 16; ++i) { const unsigned y = (unsigned)__shfl_xor((int)K[15 - i], 32); C[i] = K[i] > y ? K[i] : y; }
            bitonic_merge16_desc<0, 16>(C);
#pragma unroll
            for (int i = 0; i < 16; ++i) { if (half == 0) V1[i] = C[i]; else V2[i] = C[i]; }
            __builtin_amdgcn_sched_barrier(0);
        }
        float f1[16], f2[16];
#pragma unroll
        for (int a = 0; a < 16; ++a) { I1s[a * 64 + lane] = 127u - (V1[a] & 127u); I2s[a * 64 + lane] = 127u - (V2[a] & 127u); f1[a] = ord2f(V1[a] & ~127u); f2[a] = ord2f(V2[a] & ~127u); }
        __builtin_amdgcn_sched_barrier(0);
        unsigned Cd[64];
    Cd[0] = (f2ord(f1[0] + f2[0]) & ~255u) | 255u;
    Cd[1] = (f2ord(f1[0] + f2[1]) & ~255u) | 254u;
    Cd[2] = (f2ord(f1[0] + f2[2]) & ~255u) | 253u;
    Cd[3] = (f2ord(f1[0] + f2[3]) & ~255u) | 252u;
    Cd[4] = (f2ord(f1[0] + f2[4]) & ~255u) | 251u;
    Cd[5] = (f2ord(f1[0] + f2[5]) & ~255u) | 250u;
    Cd[6] = (f2ord(f1[0] + f2[6]) & ~255u) | 249u;
    Cd[7] = (f2ord(f1[0] + f2[7]) & ~255u) | 248u;
    Cd[8] = (f2ord(f1[0] + f2[8]) & ~255u) | 247u;
    Cd[9] = (f2ord(f1[0] + f2[9]) & ~255u) | 246u;
    Cd[10] = (f2ord(f1[0] + f2[10]) & ~255u) | 245u;
    Cd[11] = (f2ord(f1[0] + f2[11]) & ~255u) | 244u;
    Cd[12] = (f2ord(f1[0] + f2[12]) & ~255u) | 243u;
    Cd[13] = (f2ord(f1[0] + f2[13]) & ~255u) | 242u;
    Cd[14] = (f2ord(f1[0] + f2[14]) & ~255u) | 241u;
    Cd[15] = (f2ord(f1[0] + f2[15]) & ~255u) | 240u;
    Cd[16] = (f2ord(f1[1] + f2[0]) & ~255u) | 239u;
    Cd[17] = (f2ord(f1[1] + f2[1]) & ~255u) | 238u;
    Cd[18] = (f2ord(f1[1] + f2[2]) & ~255u) | 237u;
    Cd[19] = (f2ord(f1[1] + f2[3]) & ~255u) | 236u;
    Cd[20] = (f2ord(f1[1] + f2[4]) & ~255u) | 235u;
    Cd[21] = (f2ord(f1[1] + f2[5]) & ~255u) | 234u;
    Cd[22] = (f2ord(f1[1] + f2[6]) & ~255u) | 233u;
    Cd[23] = (f2ord(f1[1] + f2[7]) & ~255u) | 232u;
    Cd[24] = (f2ord(f1[2] + f2[0]) & ~255u) | 223u;
    Cd[25] = (f2ord(f1[2] + f2[1]) & ~255u) | 222u;
    Cd[26] = (f2ord(f1[2] + f2[2]) & ~255u) | 221u;
    Cd[27] = (f2ord(f1[2] + f2[3]) & ~255u) | 220u;
    Cd[28] = (f2ord(f1[2] + f2[4]) & ~255u) | 219u;
    Cd[29] = (f2ord(f1[3] + f2[0]) & ~255u) | 207u;
    Cd[30] = (f2ord(f1[3] + f2[1]) & ~255u) | 206u;
    Cd[31] = (f2ord(f1[3] + f2[2]) & ~255u) | 205u;
    Cd[32] = (f2ord(f1[3] + f2[3]) & ~255u) | 204u;
    Cd[33] = (f2ord(f1[4] + f2[0]) & ~255u) | 191u;
    Cd[34] = (f2ord(f1[4] + f2[1]) & ~255u) | 190u;
    Cd[35] = (f2ord(f1[4] + f2[2]) & ~255u) | 189u;
    Cd[36] = (f2ord(f1[5] + f2[0]) & ~255u) | 175u;
    Cd[37] = (f2ord(f1[5] + f2[1]) & ~255u) | 174u;
    Cd[38] = (f2ord(f1[6] + f2[0]) & ~255u) | 159u;
    Cd[39] = (f2ord(f1[6] + f2[1]) & ~255u) | 158u;
    Cd[40] = (f2ord(f1[7] + f2[0]) & ~255u) | 143u;
    Cd[41] = (f2ord(f1[7] + f2[1]) & ~255u) | 142u;
    Cd[42] = (f2ord(f1[8] + f2[0]) & ~255u) | 127u;
    Cd[43] = (f2ord(f1[9] + f2[0]) & ~255u) | 111u;
    Cd[44] = (f2ord(f1[10] + f2[0]) & ~255u) | 95u;
    Cd[45] = (f2ord(f1[11] + f2[0]) & ~255u) | 79u;
    Cd[46] = (f2ord(f1[12] + f2[0]) & ~255u) | 63u;
    Cd[47] = (f2ord(f1[13] + f2[0]) & ~255u) | 47u;
    Cd[48] = (f2ord(f1[14] + f2[0]) & ~255u) | 31u;
    Cd[49] = (f2ord(f1[15] + f2[0]) & ~255u) | 15u;
    Cd[50] = 0u;
    Cd[51] = 0u;
    Cd[52] = 0u;
    Cd[53] = 0u;
    Cd[54] = 0u;
    Cd[55] = 0u;
    Cd[56] = 0u;
    Cd[57] = 0u;
    Cd[58] = 0u;
    Cd[59] = 0u;
    Cd[60] = 0u;
    Cd[61] = 0u;
    Cd[62] = 0u;
    Cd[63] = 0u;
        __builtin_amdgcn_sched_barrier(0); top16of64(Cd); __builtin_amdgcn_sched_barrier(0);
        LDS_WAIT();
        unsigned eid[16]; float e[16]; float sum = 0.f; const float v0 = ord2f(Cd[0] & ~255u);
#pragma unroll
        for (int r = 0; r < 16; ++r) { const unsigned c = 255u - (Cd[r] & 255u); eid[r] = I1s[(c >> 4) * 64 + lane] * 128u + I2s[(c & 15u) * 64 + lane];
            e[r] = __builtin_amdgcn_exp2f((ord2f(Cd[r] & ~255u) - v0) * LOG2E); sum += e[r]; }
        const float inv = 1.f / sum;
        u32x4 ew; ew.x = (hi ? eid[8] : eid[0]) | ((hi ? eid[9] : eid[1]) << 16); ew.y = (hi ? eid[10] : eid[2]) | ((hi ? eid[11] : eid[3]) << 16);
        ew.z = (hi ? eid[12] : eid[4]) | ((hi ? eid[13] : eid[5]) << 16); ew.w = (hi ? eid[14] : eid[6]) | ((hi ? eid[15] : eid[7]) << 16);
        *(u32x4*)(EID + (size_t)t * 128 + h * 16 + 8 * hi) = ew;
        const f32x4 g0 = {(hi ? e[8] : e[0]) * inv, (hi ? e[9] : e[1]) * inv, (hi ? e[10] : e[2]) * inv, (hi ? e[11] : e[3]) * inv};
        const f32x4 g1 = {(hi ? e[12] : e[4]) * inv, (hi ? e[13] : e[5]) * inv, (hi ? e[14] : e[6]) * inv, (hi ? e[15] : e[7]) * inv};
        *(f32x4*)(GATE + (size_t)t * 128 + h * 16 + 8 * hi) = g0; *(f32x4*)(GATE + (size_t)t * 128 + h * 16 + 8 * hi + 4) = g1;
        LDS_WAIT();
    }
}

typedef float f32x2 __attribute__((ext_vector_type(2)));
__device__ __forceinline__ float dpp_f(float v, int sel) {
    const int iv = __builtin_bit_cast(int, v); int r;
    if (sel == 0) r = __builtin_amdgcn_update_dpp(0, iv, 0xB1, 0xf, 0xf, true); else if (sel == 1) r = __builtin_amdgcn_update_dpp(0, iv, 0x4E, 0xf, 0xf, true); else r = __builtin_amdgcn_update_dpp(0, iv, 0x141, 0xf, 0xf, true);
    return __builtin_bit_cast(float, r);
}
__device__ __forceinline__ float gelu_erf(float v) {
    const float av = fabsf(v), d = av * 0.2316418882f + 1.0f; const float t = __builtin_amdgcn_rcpf(d);
    float q = t * 0.5307027145f + (-0.7265760135f); q = q * t + 0.7107068705f; q = q * t + (-0.142248368f); q = q * t + 0.127414796f; q = q * t;
    const float e = __builtin_amdgcn_exp2f((v * v) * (-0.72134752044f));
    const float m = v * (q * e), r = v - m; return v < 0.f ? m : r;
}
typedef _Float16 h16x2 __attribute__((ext_vector_type(2)));
__device__ __forceinline__ h16x2 bf8_lo2(unsigned w) { return __builtin_bit_cast(h16x2, __builtin_amdgcn_perm(0u, w, 0x010c000cu)); }
__device__ __forceinline__ h16x2 bf8_hi2(unsigned w) { return __builtin_bit_cast(h16x2, __builtin_amdgcn_perm(0u, w, 0x030c020cu)); }
__device__ __forceinline__ h16x2 bf16pair_to_h2(unsigned w) { h16x2 r; r.x = (_Float16)bf_lo(w); r.y = (_Float16)bf_hi(w); return r; }
#define PEER_E(ev0_, ev1_, w_) (int)((((w_) < 8 ? (ev0_) : (ev1_))[((w_) & 7) >> 1] >> (16 * ((w_) & 1))) & 0xffffu)
#define GLD4(dst_, ptr_) asm volatile("global_load_dword %0, %1, off" : "=v"(dst_) : "v"(ptr_) : "memory")
#define GLD8(dst_, ptr_) asm volatile("global_load_dwordx2 %0, %1, off" : "=v"(dst_) : "v"(ptr_) : "memory")
#define GLD16(dst_, ptr_) asm volatile("global_load_dwordx4 %0, %1, off" : "=v"(dst_) : "v"(ptr_) : "memory")
#define GLDS16(dst_, off_, base_) asm volatile("global_load_dwordx4 %0, %1, %2" : "=v"(dst_) : "v"(off_), "s"(base_) : "memory")
typedef int i32x4 __attribute__((ext_vector_type(4)));
__device__ __forceinline__ int sdot8_z(int a, int b) { int d; asm("v_dot8_i32_i4 %0, %1, %2, 0" : "=v"(d) : "v"(a), "v"(b)); return d; }
__device__ __forceinline__ int sdot4_z(int a, int b) { int d; asm("v_dot4_i32_i8 %0, %1, %2, 0" : "=v"(d) : "v"(a), "v"(b)); return d; }
__device__ __forceinline__ unsigned u_quant4(u32x2 w, unsigned sqbits) {
    float sq = __uint_as_float(sqbits); sq += dpp_row_shr(sq, 1); sq += dpp_row_shr(sq, 2); sq += dpp_row_shr(sq, 4); sq += dpp_row_shr(sq, 8);
    sq = __builtin_bit_cast(float, __builtin_amdgcn_readlane(__builtin_bit_cast(int, sq), 15));
    const float sx = __builtin_amdgcn_rsqf(sq * (1.f / DM) + RMS_EPS) * I8_SX;
    const float v[4] = {bf_lo(w.x), bf_hi(w.x), bf_lo(w.y), bf_hi(w.y)}; unsigned A = 0u, B = 0u;
#pragma unroll
    for (int k = 0; k < 4; ++k) { int q = __float2int_rn(v[k] * sx); q = q < -120 ? -120 : (q > 119 ? 119 : q); const int a = (q + 8) >> 4, bb = q - 16 * a;
        A |= ((unsigned)a & 0xfu) << (4 * k); B |= ((unsigned)bb & 0xfu) << (4 * k); }
    return A | (B << 16);
}
template <int CP> __device__ __forceinline__ unsigned peer_bc_t(unsigned ev) { return (unsigned)__builtin_amdgcn_update_dpp(__builtin_amdgcn_update_dpp(0, (int)ev, 0x150 + CP, 0xf, 0x3, false), (int)ev, 0x158 + CP, 0xf, 0xc, false); }
__device__ __forceinline__ unsigned peer_bc(unsigned ev, int cp) {
    switch (cp) { case 0: return peer_bc_t<0>(ev); case 1: return peer_bc_t<1>(ev); case 2: return peer_bc_t<2>(ev); case 3: return peer_bc_t<3>(ev);
                  case 4: return peer_bc_t<4>(ev); case 5: return peer_bc_t<5>(ev); case 6: return peer_bc_t<6>(ev); default: return peer_bc_t<7>(ev); }
}
#define PEER_BC(ev_, cp_) peer_bc((ev_), (cp_))
#define PEER_E2(bc_, w_) (((w_) & 1) ? ((bc_) >> 16) : ((bc_) & 0xffffu))
__device__ __forceinline__ void phase_peer_u(Frame& F, const bf16_t* XB, const float* rsp, int rsmode, const unsigned short* EID, const unsigned char* U8S, int* PREP) {
    const int lane = opaque_i(F.lane), i16 = (lane >> 3) * 16, c = lane & 7, b = (int)blockIdx.x, x = b & 3, step = (F.G >> 2) * NWAVES;
    const unsigned c16 = 16u * (unsigned)c;
    const unsigned char* tabs = U8S + (size_t)x * NEXP * 128;
    LAS unsigned char* xl = F.lds + F.wave * 512;
    int t = (b >> 2) * NWAVES + F.wave; unsigned slot = 0;
    unsigned evB; u32x4 uw[16]; u32x2 xwA; unsigned sqA;
    {   unsigned e0 = *(const unsigned*)(EID + (size_t)t * 128 + i16 + 2 * c);
        u32x2 xw0 = *(const u32x2*)(XB + (size_t)t * DM + 256 * x + 4 * lane); unsigned sq0 = __float_as_uint(rsp[(size_t)t * 16 + (lane & 15)]);
        const int tn = (t + step < TOK) ? t + step : t;
        evB = *(const unsigned*)(EID + (size_t)tn * 128 + i16 + 2 * c);
        xwA = *(const u32x2*)(XB + (size_t)tn * DM + 256 * x + 4 * lane); sqA = __float_as_uint(rsp[(size_t)tn * 16 + (lane & 15)]);
        asm volatile("s_waitcnt vmcnt(0)" : "+v"(evB), "+v"(e0), "+v"(xwA), "+v"(sqA), "+v"(xw0), "+v"(sq0) :: "memory");
        { const unsigned ab = u_quant4(xw0, sq0); *(LAS unsigned short*)(xl + 2 * lane) = (unsigned short)ab; *(LAS unsigned short*)(xl + 128 + 2 * lane) = (unsigned short)(ab >> 16); }
#pragma unroll
        for (int w = 0; w < 16; w += 2) { const unsigned bc = PEER_BC(e0, w >> 1); const unsigned off0 = (PEER_E2(bc, 0) << 7) | c16, off1 = (PEER_E2(bc, 1) << 7) | c16; GLDS16(uw[w], off0, tabs); GLDS16(uw[w + 1], off1, tabs); } }
#pragma unroll 1
    for (; t < TOK; t += step) {
        const int tnn = (t + 2 * step < TOK) ? t + 2 * step : t;
        unsigned evC, sqC, bcw = 0u; u32x2 xwC;
        { const unsigned short* ep = EID + (size_t)tnn * 128 + i16 + 2 * c; const bf16_t* xp = XB + (size_t)tnn * DM + 256 * x + 4 * lane; const float* sp = rsp + (size_t)tnn * 16 + (lane & 15);
          GLD4(evC, ep); GLD8(xwC, xp); GLD4(sqC, sp); }
        { const unsigned ab = u_quant4(xwA, sqA); *(LAS unsigned short*)(xl + (slot ^ 256u) + 2 * lane) = (unsigned short)ab; *(LAS unsigned short*)(xl + (slot ^ 256u) + 128 + 2 * lane) = (unsigned short)(ab >> 16); }
        const u32x4 xa = *(LAS const u32x4*)(xl + slot + c16), xb = *(LAS const u32x4*)(xl + slot + 128 + c16);
        slot ^= 256u;
        int p[16];
#pragma unroll
        for (int w = 0; w < 16; ++w) {
            asm volatile("s_waitcnt vmcnt(18)" : "+v"(uw[w]) :: "memory");
            int a = sdot8_z((int)uw[w][0], (int)xa[0]), bl = sdot8_z((int)uw[w][0], (int)xb[0]);
#pragma unroll
            for (int k = 1; k < 4; ++k) { a = __builtin_amdgcn_sdot8((int)uw[w][k], (int)xa[k], a, false); bl = __builtin_amdgcn_sdot8((int)uw[w][k], (int)xb[k], bl, false); }
            p[w] = (a << 4) + bl;
            asm volatile("" : "+v"(p[w]));
            if ((w & 1) == 0) bcw = PEER_BC(evB, w >> 1);
            { const unsigned off = (PEER_E2(bcw, w) << 7) | c16; GLDS16(uw[w], off, tabs); }
        }
        asm volatile("s_nop 1\n\t"
#define UA_(k_, k8_) "v_add_u32_dpp %" #k_ ", %" #k_ ", %" #k_ " row_shl:4 row_mask:0xf bank_mask:0x5\n\t" "v_add_u32_dpp %" #k_ ", %" #k8_ ", %" #k8_ " row_shr:4 row_mask:0xf bank_mask:0xa\n\t"
            UA_(0, 8) UA_(1, 9) UA_(2, 10) UA_(3, 11) UA_(4, 12) UA_(5, 13) UA_(6, 14) UA_(7, 15)
#undef UA_
#define UB_(k_) "v_add_u32_dpp %" #k_ ", %" #k_ ", %" #k_ " quad_perm:[2,3,0,1] row_mask:0xf bank_mask:0xf\n\t"
            UB_(0) UB_(1) UB_(2) UB_(3) UB_(4) UB_(5) UB_(6) UB_(7)
#undef UB_
#define UC_(k_) "v_add_u32_dpp %" #k_ ", %" #k_ ", %" #k_ " quad_perm:[1,0,3,2] row_mask:0xf bank_mask:0xf\n\t"
            UC_(0) UC_(1) UC_(2) UC_(3) UC_(4) UC_(5) UC_(6) UC_(7)
#undef UC_
            "s_nop 0"
            : "+v"(p[0]), "+v"(p[1]), "+v"(p[2]), "+v"(p[3]), "+v"(p[4]), "+v"(p[5]), "+v"(p[6]), "+v"(p[7])
            : "v"(p[8]), "v"(p[9]), "v"(p[10]), "v"(p[11]), "v"(p[12]), "v"(p[13]), "v"(p[14]), "v"(p[15]));
        if ((c & 3) == 0) {
            int* dst = PREP + ((size_t)x * TOK + t) * 128 + i16 + 2 * c;
            *(i32x4*)dst = i32x4{p[0], p[1], p[2], p[3]}; *(i32x4*)(dst + 4) = i32x4{p[4], p[5], p[6], p[7]}; }
        asm volatile("s_waitcnt vmcnt(16)" : "+v"(evC), "+v"(xwC), "+v"(sqC) :: "memory");
        evB = evC; xwA = xwC; sqA = sqC;
    }
    asm volatile("s_waitcnt vmcnt(0)" ::: "memory");
}
__device__ __forceinline__ void phase_peer_c(Frame& F, const int* PREP, const float* GATE, unsigned char* ACO8, float* ASC  ) {
    const int gw = F.vcu * NWAVES + F.wave, NGW = F.G * NWAVES, lane = opaque_i(F.lane);
    for (int t = gw; t < TOK; t += NGW) {
        int i0 = 0, i1 = 0;
#pragma unroll
        for (int x = 0; x < 4; ++x) { const int* p = PREP + ((size_t)x * TOK + t) * 128; i0 += p[lane]; i1 += p[64 + lane]; }
        const float rsu = 1.f / (I4_SU * I8_SX);
        const float a0 = gelu_erf((float)i0 * rsu) * GATE[(size_t)t * 128 + lane], a1 = gelu_erf((float)i1 * rsu) * GATE[(size_t)t * 128 + 64 + lane];
        float m = fmaxf(fabsf(a0), fabsf(a1));
#pragma unroll
        for (int o = 32; o >= 1; o >>= 1) m = fmaxf(m, __shfl_xor(m, o));
        const float inv = m > 0.f ? 127.f / m : 0.f;
        const int q0 = __float2int_rn(a0 * inv), q1 = __float2int_rn(a1 * inv);
        ACO8[(size_t)t * 128 + lane] = (unsigned char)(q0 & 0xff); ACO8[(size_t)t * 128 + 64 + lane] = (unsigned char)(q1 & 0xff);
        const float sa = wave_total((float)(q0 + q1)), scl = m * (1.f / (127.f * I4_SV));
        if (lane == 0) { ASC[2 * (size_t)t] = scl; ASC[2 * (size_t)t + 1] = 8.f * sa * scl; }
    }
}
#define PIN16(o_) asm volatile("" : "+v"(o_[0]), "+v"(o_[1]), "+v"(o_[2]), "+v"(o_[3]), "+v"(o_[4]), "+v"(o_[5]), "+v"(o_[6]), "+v"(o_[7]), "+v"(o_[8]), "+v"(o_[9]), "+v"(o_[10]), "+v"(o_[11]), "+v"(o_[12]), "+v"(o_[13]), "+v"(o_[14]), "+v"(o_[15]))
__device__ __forceinline__ void red16_groups(const int (&o)[16], bool b3, int& r0, int& r1) {
    int h8[8], h4[4];
#pragma unroll
    for (int k = 0; k < 8; ++k) { const auto r = __builtin_amdgcn_permlane32_swap((unsigned)o[k], (unsigned)o[8 + k], false, false); h8[k] = (int)r[0] + (int)r[1]; }
#pragma unroll
    for (int k = 0; k < 4; ++k) { const auto r = __builtin_amdgcn_permlane16_swap((unsigned)h8[k], (unsigned)h8[4 + k], false, false); h4[k] = (int)r[0] + (int)r[1]; }
    { const int keep = b3 ? h4[2] : h4[0], send = b3 ? h4[0] : h4[2]; r0 = keep + __builtin_amdgcn_update_dpp(0, send, 0x128, 0xf, 0xf, true); }
    { const int keep = b3 ? h4[3] : h4[1], send = b3 ? h4[1] : h4[3]; r1 = keep + __builtin_amdgcn_update_dpp(0, send, 0x128, 0xf, 0xf, true); }
}
__device__ __forceinline__ void phase_peer_v(Frame& F, bf16_t* XB, const unsigned short* EID, const unsigned char* ACO8, const float* ASC, const unsigned char* V4S, float* SSQP) {
    const int lane = opaque_i(F.lane), i16 = (lane >> 3) * 16, c = lane & 7, b = (int)blockIdx.x, x = b & 3, step = (F.G >> 2) * NWAVES;
    const unsigned c16 = 16u * (unsigned)c;
    const unsigned char* tabs = V4S + (size_t)x * NEXP * 128;
    const bool b3 = lane & 8;
    const int col = 256 * x + 32 * c + ((lane & 32) ? 16 : 0) + ((lane & 16) ? 8 : 0) + (b3 ? 4 : 0);
    int t = (b >> 2) * NWAVES + F.wave;
    u32x4 aA, vw[16]; unsigned evB; u32x2 xfA, scA;
    {   unsigned e0 = *(const unsigned*)(EID + (size_t)t * 128 + i16 + 2 * c);
        aA = *(const u32x4*)(ACO8 + (size_t)t * 128 + i16);
        xfA = *(const u32x2*)(XB + (size_t)t * DM + col); scA = *(const u32x2*)(ASC + 2 * (size_t)t);
        const int tn = (t + step < TOK) ? t + step : t;
        evB = *(const unsigned*)(EID + (size_t)tn * 128 + i16 + 2 * c);
        asm volatile("s_waitcnt vmcnt(0)" : "+v"(evB), "+v"(e0), "+v"(aA), "+v"(xfA), "+v"(scA) :: "memory");
#pragma unroll
        for (int w = 0; w < 16; w += 2) { const unsigned bc = PEER_BC(e0, w >> 1); const unsigned off0 = (PEER_E2(bc, 0) << 7) | c16, off1 = (PEER_E2(bc, 1) << 7) | c16; GLDS16(vw[w], off0, tabs); GLDS16(vw[w + 1], off1, tabs); } }
#pragma unroll 1
    for (; t < TOK; t += step) {
        const int tn = (t + step < TOK) ? t + step : t, tnn = (t + 2 * step < TOK) ? t + 2 * step : t;
        u32x4 aB; unsigned evC; u32x2 xfB, scB;
        { const unsigned short* ep = EID + (size_t)tnn * 128 + i16 + 2 * c; const unsigned char* ap = ACO8 + (size_t)tn * 128 + i16; const bf16_t* xp = XB + (size_t)tn * DM + col; const float* sp = ASC + 2 * (size_t)tn;
          GLD4(evC, ep); GLD16(aB, ap); GLD8(xfB, xp); GLD8(scB, sp); }
        int oL[16], oP[16];
#pragma unroll
        for (int w = 0; w < 16; w += 4) {
            asm volatile("s_waitcnt vmcnt(16)" : "+v"(vw[w]), "+v"(vw[w + 1]), "+v"(vw[w + 2]), "+v"(vw[w + 3]) :: "memory");
            const int a4 = (int)aA[w >> 2];
#pragma unroll
            for (int k = 0; k < 4; ++k) { const unsigned d0 = vw[w][k], d1 = vw[w + 1][k], d2 = vw[w + 2][k], d3 = vw[w + 3][k];
                const unsigned q01l = __builtin_amdgcn_perm(d1, d0, 0x05010400u), q01h = __builtin_amdgcn_perm(d1, d0, 0x07030602u), q23l = __builtin_amdgcn_perm(d3, d2, 0x05010400u), q23h = __builtin_amdgcn_perm(d3, d2, 0x07030602u);
                const int t0 = (int)__builtin_amdgcn_perm(q23l, q01l, 0x05040100u), t1 = (int)__builtin_amdgcn_perm(q23l, q01l, 0x07060302u), t2 = (int)__builtin_amdgcn_perm(q23h, q01h, 0x05040100u), t3 = (int)__builtin_amdgcn_perm(q23h, q01h, 0x07060302u);
                const int l0 = t0 & 0x0f0f0f0f, l1 = t1 & 0x0f0f0f0f, l2 = t2 & 0x0f0f0f0f, l3 = t3 & 0x0f0f0f0f;
                if (w == 0) { oL[4 * k] = sdot4_z(l0, a4); oL[4 * k + 1] = sdot4_z(l1, a4); oL[4 * k + 2] = sdot4_z(l2, a4); oL[4 * k + 3] = sdot4_z(l3, a4);
                              oP[4 * k] = sdot4_z(t0, a4); oP[4 * k + 1] = sdot4_z(t1, a4); oP[4 * k + 2] = sdot4_z(t2, a4); oP[4 * k + 3] = sdot4_z(t3, a4); }
                else { oL[4 * k]     = __builtin_amdgcn_sdot4(l0, a4, oL[4 * k], false);     oL[4 * k + 1] = __builtin_amdgcn_sdot4(l1, a4, oL[4 * k + 1], false);
                       oL[4 * k + 2] = __builtin_amdgcn_sdot4(l2, a4, oL[4 * k + 2], false); oL[4 * k + 3] = __builtin_amdgcn_sdot4(l3, a4, oL[4 * k + 3], false);
                       oP[4 * k]     = __builtin_amdgcn_sdot4(t0, a4, oP[4 * k], false);     oP[4 * k + 1] = __builtin_amdgcn_sdot4(t1, a4, oP[4 * k + 1], false);
                       oP[4 * k + 2] = __builtin_amdgcn_sdot4(t2, a4, oP[4 * k + 2], false); oP[4 * k + 3] = __builtin_amdgcn_sdot4(t3, a4, oP[4 * k + 3], false); } }
            PIN16(oL); PIN16(oP);
            { const unsigned bc0 = PEER_BC(evB, w >> 1), bc1 = PEER_BC(evB, (w >> 1) + 1);
              const unsigned off0 = (PEER_E2(bc0, 0) << 7) | c16, off1 = (PEER_E2(bc0, 1) << 7) | c16, off2 = (PEER_E2(bc1, 0) << 7) | c16, off3 = (PEER_E2(bc1, 1) << 7) | c16;
              GLDS16(vw[w], off0, tabs); GLDS16(vw[w + 1], off1, tabs); GLDS16(vw[w + 2], off2, tabs); GLDS16(vw[w + 3], off3, tabs); } }
        int L0, L1, P0, P1; red16_groups(oL, b3, L0, L1); red16_groups(oP, b3, P0, P1);
        const float sc = __uint_as_float(scA.x), corr = __uint_as_float(scA.y);
        const float f0 = bf_lo(xfA.x) + ((float)L0 * sc - corr), f1 = bf_hi(xfA.x) + (float)((P0 - L0) >> 4) * sc, f2 = bf_lo(xfA.y) + ((float)L1 * sc - corr), f3 = bf_hi(xfA.y) + (float)((P1 - L1) >> 4) * sc;
        { u32x2 st; st.x = pk2(f0, f1); st.y = pk2(f2, f3); *(u32x2*)(XB + (size_t)t * DM + col) = st; }
        const float ss = wave_total((f0 * f0 + f1 * f1) + (f2 * f2 + f3 * f3));
        if (lane == 0) { float* sp = SSQP + (size_t)t * 16 + x; sp[0] = ss; sp[4] = 0.f; sp[8] = 0.f; sp[12] = 0.f; }
        asm volatile("s_waitcnt vmcnt(16)" : "+v"(evC), "+v"(aB), "+v"(xfB), "+v"(scB) :: "memory");
        aA = aB; evB = evC; xfA = xfB; scA = scB;
    }
    asm volatile("s_waitcnt vmcnt(0)" ::: "memory");
}

__device__ __forceinline__ void phase_final_norm(Frame& F, const bf16_t* XB, float* OUT, const float* SSQP, const float* norm_f) {
    const int gw = F.vcu * NWAVES + F.wave, NGW = F.G * NWAVES, lane = opaque_i(F.lane);
    for (int t = gw; t < TOK; t += NGW) { const float r = row_scale(SSQP, 1, t);
#pragma unroll
        for (int j = 0; j < 4; ++j) { const u32x2 w = *(const u32x2*)(XB + (size_t)t * DM + 256 * j + 4 * lane); const f32x4 x = {bf_lo(w.x), bf_hi(w.x), bf_lo(w.y), bf_hi(w.y)};
            *(f32x4*)(OUT + (size_t)t * DM + 256 * j + 4 * lane) = x * r * *(const f32x4*)(norm_f + 256 * j + 4 * lane); } }
}

constexpr int N_PHASES = 20;
struct Args { const float* in[16]; float* out; unsigned char* ws; int ph_lo, ph_hi; };
template <bool COOP>
__global__ void __launch_bounds__(NWAVES * 64, 2) mk_fwd(Args args) {
    extern __shared__ __attribute__((aligned(16))) unsigned char lds[];
    Frame F;
    F.lds = (LAS unsigned char*)lds;
    F.tid = threadIdx.x; F.lane = F.tid & 63; F.wave = __builtin_amdgcn_readfirstlane(F.tid >> 6);
    F.G = gridDim.x; { const int bx = blockIdx.x; F.vcu = (F.G % 8 == 0) ? (bx % 8) * (F.G / 8) + bx / 8 : bx; }
    Ptrs P;
    P.x = args.in[0]; P.norm_mix = args.in[1]; P.norm_ffn = args.in[2]; P.ev_w_in = args.in[3]; P.ev_b_f = args.in[4]; P.ev_w_out = args.in[5]; P.od_w_in = args.in[6];
    P.od_pool_w = args.in[7]; P.od_pool_scale = args.in[8]; P.od_w_out = args.in[9]; P.peer_wq = args.in[10]; P.peer_k1 = args.in[11]; P.peer_k2 = args.in[12];
    P.peer_u = args.in[13]; P.peer_v = args.in[14]; P.norm_f = args.in[15]; P.out = args.out; P.ws = args.ws;
    unsigned char* ws = args.ws;
    bf16_t* XB = (bf16_t*)(ws + WS_XB); bf16_t* AO = (bf16_t*)(ws + WS_AO); bf16_t* QP = (bf16_t*)(ws + WS_QP);
    unsigned short* EID = (unsigned short*)(ws + WS_EID); float* GATE = (float*)(ws + WS_GATE);
    float* RS0 = (float*)(ws + WS_RS0); float* SSQ2 = (float*)(ws + WS_SSQ2); int* PREP = (int*)(ws + WS_PREP); unsigned char* ACO8 = ws + WS_ACO; float* ASC = (float*)(ws + WS_ACO + 8 * MiB); float* SSQ1 = (float*)(ws + WS_SSQ1); float* SSQ3 = (float*)(ws + WS_SSQ3);
    const int lo = args.ph_lo, hi = args.ph_hi;
    volatile LAS unsigned* xbst = (volatile LAS unsigned*)(F.lds + LDS_BYTES - 64);
    if (F.tid < 4) xbst[F.tid] = 0u;
    __syncthreads();
    XcdBarrier xbar; xbar.bar = (unsigned*)(ws + WS_CTL) + 4096; xbar.x = 0; xbar.st = xbst;
    if (COOP) xbar = xcd_barrier_post((unsigned*)(ws + WS_CTL) + 4096, xbst);
#define IN(k) (lo <= (k) && (k) < hi)
#define SEAM(k) do { if (COOP && IN(k) && IN((k) + 1)) xcd_barrier(xbar); } while (0)
    if (COOP && lo < 0) cg::this_grid().sync();
    if (IN(0)) { phase_p0(F, P); } SEAM(0);
    if (IN(1)) {
        pg8::Gemm g{XB, (const bf16_t*)(ws + WS_W1T), TOK, 3072, DM}; pg8::StaticOrder S; S.init(TOK, 3072, F.G, (int)blockIdx.x);
        EpiL0In E{RS0, (bf16_t*)(ws + WS_QH), (bf16_t*)(ws + WS_KH), (bf16_t*)(ws + WS_VT), (float*)(ws + WS_LF), P.ev_b_f};
        pg8::gemm_phase<EpiL0In, pg8::StaticOrder, true, true>(F.lds, g, S, E);
    } SEAM(1);
    if (IN(3)) {
        phase_attn_fox(F, (const bf16_t*)(ws + WS_QH), (const bf16_t*)(ws + WS_KH), (const bf16_t*)(ws + WS_VT), (const float*)(ws + WS_LF), (float*)(ws + WS_CF), AO);
        phase_attn<1>(F, (const bf16_t*)(ws + WS_QH), (const bf16_t*)(ws + WS_KH), (const bf16_t*)(ws + WS_VT), 16, 8, nullptr, nullptr, AO, 512);
    } SEAM(3);
    if (IN(4)) {
        pg8::Gemm g{AO, (const bf16_t*)(ws + WS_W2T), TOK, DM, DM}; pg8::StaticOrder S; S.init(TOK, DM, F.G, (int)blockIdx.x);
        EpiRes<false> E{P.x, XB, SSQ1};
        pg8::gemm_phase<EpiRes<false>, pg8::StaticOrder, true, true>(F.lds, g, S, E);
    } SEAM(4);
    if (IN(5)) {
        pg8::Gemm g{XB, (const bf16_t*)(ws + WS_W3T), TOK, 2048, DM}; pg8::StaticOrder S; S.init(TOK, 2048, F.G, (int)blockIdx.x);
        EpiQ E{SSQ1, 1, QP};
        pg8::gemm_phase<EpiQ, pg8::StaticOrder, true, true>(F.lds, g, S, E);
    } SEAM(5);
    if (IN(6)) { phase_topk(F, QP, (const bf16_t*)(ws + WS_K1B), (const bf16_t*)(ws + WS_K2B), EID, GATE); } SEAM(6);
    if (IN(7)) { phase_peer_u(F, XB, SSQ1, 1, EID, ws + WS_U8S, PREP); } SEAM(7);
    if (IN(8)) { phase_peer_c(F, PREP, GATE, ACO8, ASC); } SEAM(8);
    if (IN(9)) { phase_peer_v(F, XB, EID, ACO8, ASC, ws + WS_V8S, SSQ2); } SEAM(9);
    if (IN(10)) {
        pg8::Gemm g{XB, (const bf16_t*)(ws + WS_W4T), TOK, 2048, DM}; pg8::StaticOrder S; S.init(TOK, 2048, F.G, (int)blockIdx.x);
        EpiL1In E{SSQ2, 1, (bf16_t*)(ws + WS_QH), (bf16_t*)(ws + WS_QH + 32 * MiB), (bf16_t*)(ws + WS_KH), (bf16_t*)(ws + WS_KH + 32 * MiB)};
        pg8::gemm_phase<EpiL1In, pg8::StaticOrder, true, true>(F.lds, g, S, E);
    } SEAM(10);
    if (IN(12)) {
        phase_attn_moba(F, (const bf16_t*)(ws + WS_QH + 32 * MiB), (const bf16_t*)(ws + WS_KH), (const bf16_t*)(ws + WS_KH + 32 * MiB), (float*)(ws + WS_KMEAN), AO);
        phase_pool(F, (const bf16_t*)(ws + WS_QH), (const bf16_t*)(ws + WS_PWT), P.od_pool_scale, AO);
    } SEAM(12);
    if (IN(13)) {
        pg8::Gemm g{AO, (const bf16_t*)(ws + WS_W5T), TOK, DM, DM}; pg8::StaticOrder S; S.init(TOK, DM, F.G, (int)blockIdx.x);
        EpiRes<true> E{XB, XB, SSQ3};
        pg8::gemm_phase<EpiRes<true>, pg8::StaticOrder, true, true>(F.lds, g, S, E);
    } SEAM(13);
    if (IN(14)) {
        pg8::Gemm g{XB, (const bf16_t*)(ws + WS_W6T), TOK, 2048, DM}; pg8::StaticOrder S; S.init(TOK, 2048, F.G, (int)blockIdx.x);
        EpiQ E{SSQ3, 1, QP};
        pg8::gemm_phase<EpiQ, pg8::StaticOrder, true, true>(F.lds, g, S, E);
    } SEAM(14);
    if (IN(15)) { phase_topk(F, QP, (const bf16_t*)(ws + WS_K1B) + 8 * 128 * 128, (const bf16_t*)(ws + WS_K2B) + 8 * 128 * 128, EID, GATE); } SEAM(15);
    if (IN(16)) { phase_peer_u(F, XB, SSQ3, 1, EID, ws + WS_U8S + (size_t)4 * NEXP * 128, PREP); } SEAM(16);
    if (IN(17)) { phase_peer_c(F, PREP, GATE, ACO8, ASC); } SEAM(17);
    if (IN(18)) { phase_peer_v(F, XB, EID, ACO8, ASC, ws + WS_V8S + (size_t)4 * NEXP * 128, SSQ2); } SEAM(18);
    if (IN(19)) { phase_final_norm(F, XB, P.out, SSQ2, P.norm_f); }
#undef IN
#undef SEAM
}

extern "C" void kernel_launch(void* const* d_in, const int* in_sizes, int n_in, void* d_out, int out_size, void* d_ws, size_t ws_size, hipStream_t stream) {
    static int grid = 0;
    constexpr bool COOP = (MK_MULTI == 0);
    if (grid == 0) {
        if (n_in != 16 || in_sizes[0] != TOK * DM || out_size != TOK * DM || ws_size < WS_END) { fprintf(stderr, "kernel_launch: unexpected shapes (n_in %d, in0 %d, out %d, ws %zu)\n", n_in, n_in > 0 ? in_sizes[0] : -1, out_size, ws_size); grid = -1; return; }
        int dev = 0, cus = 0, per_cu = 0;
        if (hipGetDevice(&dev) != hipSuccess || hipDeviceGetAttribute(&cus, hipDeviceAttributeMultiprocessorCount, dev) != hipSuccess) { grid = -1; return; }
        if (hipFuncSetAttribute((const void*)mk_fwd<COOP>, hipFuncAttributeMaxDynamicSharedMemorySize, LDS_BYTES) != hipSuccess) { fprintf(stderr, "kernel_launch: hipFuncSetAttribute failed\n"); grid = -1; return; }
        if (hipOccupancyMaxActiveBlocksPerMultiprocessor(&per_cu, (const void*)mk_fwd<COOP>, NWAVES * 64, LDS_BYTES) != hipSuccess || per_cu < 1) { fprintf(stderr, "kernel_launch: occupancy query says %d\n", per_cu); per_cu = 1; }
        (void)hipGetLastError();
        grid = cus;
    }
    if (grid < 0) return;
    if (hipMemsetAsync((char*)d_ws + WS_CTL, 0, CTL_ZERO_BYTES, stream) != hipSuccess) { fprintf(stderr, "kernel_launch: memset failed\n"); return; }
    Args a{};
    for (int i = 0; i < 16; ++i) a.in[i] = (const float*)d_in[i];
    a.out = (float*)d_out; a.ws = (unsigned char*)d_ws;
    if (COOP) {
        a.ph_lo = 0; a.ph_hi = N_PHASES;
        void* kargs[] = {&a};
        const hipError_t e = hipLaunchCooperativeKernel((const void*)mk_fwd<COOP>, dim3(grid), dim3(NWAVES * 64), kargs, LDS_BYTES, stream);
        if (e != hipSuccess) fprintf(stderr, "kernel_launch: cooperative launch failed: %s (grid %d)\n", hipGetErrorString(e), grid);
    } else {
        for (int p = 0; p < N_PHASES; ++p) { a.ph_lo = p; a.ph_hi = p + 1; hipLaunchKernelGGL(mk_fwd<COOP>, dim3(grid), dim3(NWAVES * 64), LDS_BYTES, stream, a); }
    }
}
```

```cpp
#include <hip/hip_runtime.h>
#include <hip/hip_cooperative_groups.h>
#include <cstdio>
#include <cstdint>
#include <cmath>
namespace cg = cooperative_groups;

#ifndef MK_MULTI
#define MK_MULTI 0
#endif

namespace pg8 {
#define PG8_LAS __attribute__((address_space(3)))
typedef unsigned short bf16_t;
typedef short bf16x8 __attribute__((ext_vector_type(8)));
typedef float f32x4 __attribute__((ext_vector_type(4)));
typedef unsigned u32x4 __attribute__((ext_vector_type(4)));
constexpr int BM = 256, BK = 64, HALF = 128, HTB = HALF * BK * 2  , STAGE_BYTES = 8 * HTB, NXCD = 8, WGM = 8;

__host__ __device__ __forceinline__ int lds_byte(int r, int c) { const int st = (r >> 4) * 2 + (c >> 5), rr = r & 15, cc = c & 31, ob = rr * 64 + cc * 2; return st * 1024 + (ob ^ (((ob >> 9) & 1) << 5)); }
__host__ __device__ __forceinline__ void stage_rc(int b, int& R, int& C) { const int st = b / 1024, sb = b % 1024, swz = sb ^ (((sb >> 9) & 1) << 5); R = (st >> 1) * 16 + swz / 64; C = (st & 1) * 32 + (swz % 64) / 2; }
__host__ __device__ __forceinline__ int perm32(int rho) { const int n = rho >> 4, i = rho & 15; return 8 * (i >> 2) + 4 * n + (i & 3); }

struct Unit { int pm, pn; };
struct Gemm { const bf16_t* A; const bf16_t* Bt; int M, N, K; };

struct StaticOrder {
    int nM, nN, nwg, G, c;
    __host__ __device__ void init(int M, int N, int G_, int c_) { nM = M / BM; nN = N / BM; nwg = nM * nN; G = G_; c = c_; }
    __host__ __device__ bool next(int i, Unit& u) const {
        const long L = (long)i * G + c; if (L >= nwg) return false;
        int wgid = (int)L; { const int q = nwg / NXCD, r = nwg % NXCD, xcd = wgid % NXCD, off = wgid / NXCD; wgid = (xcd < r ? xcd * (q + 1) : r * (q + 1) + (xcd - r) * q) + off; }
        const int nig = WGM * nN, gid = wgid / nig, fm = gid * WGM, gsz = (nM - fm) < WGM ? (nM - fm) : WGM;
        u.pm = fm + ((wgid % nig) % gsz); u.pn = (wgid % nig) / gsz; return true;
    }
    __device__ __forceinline__ void a_ready(const Unit&) const {}
    __device__ __forceinline__ void done(const Unit&) const {}
};
__device__ __forceinline__ unsigned cvt_pk_bf16(float lo, float hi) { unsigned r; asm volatile("v_cvt_pk_bf16_f32 %0, %1, %2" : "=v"(r) : "v"(lo), "v"(hi)); return r; }
template <class Epi, class Sched, bool ALIGN_EPI = false, bool SP2 = false>
__device__ __forceinline__ void gemm_phase(PG8_LAS unsigned char* lds, const Gemm g, const Sched& S, const Epi& E) {
    const int tid = threadIdx.x, wid = __builtin_amdgcn_readfirstlane(tid >> 6), lane = tid & 63, wr = wid >> 2, wc = wid & 3, fr = lane & 15, fq = lane >> 4;
    const int K = g.K, nt = K / BK;
    unsigned voffA[2], voffB[2];
#pragma unroll
    for (int i = 0; i < 2; ++i) { int R, C; stage_rc(tid * 16 + i * 8192, R, C); const int Rb = Epi::PERM ? ((R & ~31) + perm32(R & 31)) : R;
        voffA[i] = (unsigned)(R * K + C) * 2u; voffB[i] = (unsigned)(Rb * K + C) * 2u; }
    const size_t kstep = (size_t)(BK * 2);
    const size_t hstep = (size_t)HALF * K * 2;
    const size_t tstep = 2 * hstep;
    const unsigned ldsw = (unsigned)wid * 1024u;
    const int aoff = lds_byte(wr * 64 + fr, fq * 8), boff = lds_byte(wc * 32 + fr, fq * 8);
#define PG8_SA(b, h) (((b) * 2 + (h)) * HTB)
#define PG8_SB(b, h) ((4 + (b) * 2 + (h)) * HTB)
#define PG8_STAGE(bufoff, gbase, voff) do { _Pragma("unroll") for (int _i = 0; _i < 2; ++_i) \
        __builtin_amdgcn_global_load_lds((const unsigned*)((const char*)(gbase) + (voff)[_i]), (PG8_LAS unsigned*)(lds + (bufoff) + ldsw + _i * 8192), 16, 0, 0); } while (0)
#define PG8_LDA(dst, b, h) do { _Pragma("unroll") for (int m = 0; m < 4; ++m) _Pragma("unroll") for (int k = 0; k < 2; ++k) dst[m][k] = *(const PG8_LAS bf16x8*)(lds + PG8_SA(b, h) + aoff + m * 2048 + k * 1024); } while (0)
#define PG8_LDB(dst, b, h) do { _Pragma("unroll") for (int n = 0; n < 2; ++n) _Pragma("unroll") for (int k = 0; k < 2; ++k) dst[n][k] = *(const PG8_LAS bf16x8*)(lds + PG8_SB(b, h) + boff + n * 2048 + k * 1024); } while (0)
#define PG8_MMA(ai, bj, At, Bt) do { __builtin_amdgcn_s_setprio(1); _Pragma("unroll") for (int m = 0; m < 4; ++m) _Pragma("unroll") for (int n = 0; n < 2; ++n) _Pragma("unroll") for (int k = 0; k < 2; ++k) \
        acc[ai][bj][m][n] = __builtin_amdgcn_mfma_f32_16x16x32_bf16(Bt[n][k], At[m][k], acc[ai][bj][m][n], 0, 0, 0); __builtin_amdgcn_s_setprio(0); } while (0)
#define PG8_WAIT_V(n) asm volatile("s_waitcnt vmcnt(" #n ")" ::: "memory")
#define PG8_WAIT_L(n) asm volatile("s_waitcnt lgkmcnt(" #n ")" ::: "memory")
#define PG8_BAR __builtin_amdgcn_s_barrier()
#define PG8_SCHED __builtin_amdgcn_sched_barrier(0)
    Unit cur, nxt; int ui = 0;
    if (!S.next(0, cur)) return;
    f32x4 acc[2][2][4][2];
#pragma unroll
    for (int a = 0; a < 2; ++a)
#pragma unroll
        for (int b = 0; b < 2; ++b)
#pragma unroll
            for (int m = 0; m < 4; ++m)
#pragma unroll
                for (int n = 0; n < 2; ++n) acc[a][b][m][n] = (f32x4){0.f, 0.f, 0.f, 0.f};
    bf16x8 At[4][2], B0[2][2], B1[2][2];
    const char* cA = (const char*)g.A + (size_t)cur.pm * tstep; const char* cB = (const char*)g.Bt + (size_t)cur.pn * tstep;
    S.a_ready(cur);
    if constexpr (SP2) {
        PG8_STAGE(PG8_SB(0, 0), cB, voffB); PG8_STAGE(PG8_SB(0, 1), cB + hstep, voffB); PG8_STAGE(PG8_SA(0, 0), cA, voffA); PG8_STAGE(PG8_SA(0, 1), cA + hstep, voffA);
        if (wr == 1) PG8_BAR;
        PG8_WAIT_V(2); PG8_BAR;
        PG8_STAGE(PG8_SB(1, 0), cB + kstep, voffB); PG8_STAGE(PG8_SA(1, 0), cA + kstep, voffA); PG8_STAGE(PG8_SB(1, 1), cB + hstep + kstep, voffB);
        PG8_WAIT_V(6); PG8_BAR;
    } else {
        PG8_STAGE(PG8_SB(0, 0), cB, voffB); PG8_STAGE(PG8_SA(0, 0), cA, voffA); PG8_STAGE(PG8_SB(0, 1), cB + hstep, voffB); PG8_STAGE(PG8_SA(0, 1), cA + hstep, voffA);
        if (wr == 1) PG8_BAR;
        PG8_WAIT_V(4); PG8_BAR;
        PG8_STAGE(PG8_SB(1, 0), cB + kstep, voffB); PG8_STAGE(PG8_SA(1, 0), cA + kstep, voffA); PG8_STAGE(PG8_SB(1, 1), cB + hstep + kstep, voffB);
        PG8_WAIT_V(6); PG8_BAR;
    }
    for (;;) {
        const bool has_next = S.next(ui + 1, nxt);
        const char* nA = has_next ? (const char*)g.A + (size_t)nxt.pm * tstep : cA; const char* nB = has_next ? (const char*)g.Bt + (size_t)nxt.pn * tstep : cB;
        for (int t = 0; t < nt; t += 2) {
            const bool last = (t == nt - 2);
            const char* a1 = cA + (size_t)(t + 1) * kstep;
            const char* a2 = last ? nA : cA + (size_t)(t + 2) * kstep; const char* b2 = last ? nB : cB + (size_t)(t + 2) * kstep;
            const char* a3 = a2 + kstep; const char* b3 = b2 + kstep;
            if (last && has_next) S.a_ready(nxt);
            if constexpr (SP2) {
            PG8_LDB(B0, 0, 0); PG8_LDB(B1, 0, 1); PG8_SCHED; PG8_LDA(At, 0, 0); PG8_STAGE(PG8_SA(1, 1), a1 + hstep, voffA);
            PG8_WAIT_V(8); PG8_WAIT_L(0); PG8_BAR; PG8_MMA(0, 0, At, B0); PG8_MMA(0, 1, At, B1); PG8_BAR; PG8_SCHED;
            PG8_LDA(At, 0, 1); PG8_STAGE(PG8_SB(0, 0), b2, voffB); PG8_STAGE(PG8_SB(0, 1), b2 + hstep, voffB); PG8_STAGE(PG8_SA(0, 0), a2, voffA);
            PG8_WAIT_V(8); PG8_WAIT_L(0); PG8_BAR; PG8_MMA(1, 0, At, B0); PG8_MMA(1, 1, At, B1); PG8_BAR; PG8_SCHED;
            PG8_LDB(B0, 1, 0); PG8_LDB(B1, 1, 1); PG8_SCHED; PG8_LDA(At, 1, 0); PG8_STAGE(PG8_SA(0, 1), a2 + hstep, voffA);
            PG8_WAIT_V(8); PG8_WAIT_L(0); PG8_BAR; PG8_MMA(0, 0, At, B0); PG8_MMA(0, 1, At, B1); PG8_BAR; PG8_SCHED;
            PG8_LDA(At, 1, 1); PG8_STAGE(PG8_SB(1, 0), b3, voffB); PG8_STAGE(PG8_SB(1, 1), b3 + hstep, voffB); PG8_STAGE(PG8_SA(1, 0), a3, voffA);
            PG8_WAIT_V(8); PG8_WAIT_L(0); PG8_BAR; PG8_MMA(1, 0, At, B0); PG8_MMA(1, 1, At, B1); PG8_BAR; PG8_SCHED;
            } else {
            PG8_LDB(B0, 0, 0); PG8_SCHED; PG8_LDA(At, 0, 0); PG8_STAGE(PG8_SA(1, 1), a1 + hstep, voffA);
            PG8_WAIT_L(8); PG8_BAR; PG8_WAIT_L(0); PG8_MMA(0, 0, At, B0); PG8_BAR; PG8_SCHED;
            PG8_LDB(B1, 0, 1); PG8_STAGE(PG8_SB(0, 0), b2, voffB);
            PG8_BAR; PG8_WAIT_L(0); PG8_MMA(0, 1, At, B1); PG8_BAR;
            PG8_LDA(At, 0, 1); PG8_STAGE(PG8_SA(0, 0), a2, voffA);
            PG8_BAR; PG8_WAIT_L(0); PG8_MMA(1, 0, At, B0); PG8_BAR; PG8_SCHED;
            PG8_STAGE(PG8_SB(0, 1), b2 + hstep, voffB);
            PG8_WAIT_V(6); PG8_BAR; PG8_MMA(1, 1, At, B1); PG8_BAR;
            PG8_LDB(B0, 1, 0); PG8_SCHED; PG8_LDA(At, 1, 0); PG8_STAGE(PG8_SA(0, 1), a2 + hstep, voffA);
            PG8_WAIT_L(8); PG8_BAR; PG8_WAIT_L(0); PG8_MMA(0, 0, At, B0); PG8_BAR; PG8_SCHED;
            PG8_LDB(B1, 1, 1); PG8_STAGE(PG8_SB(1, 0), b3, voffB);
            PG8_BAR; PG8_WAIT_L(0); PG8_MMA(0, 1, At, B1); PG8_BAR;
            PG8_LDA(At, 1, 1); PG8_STAGE(PG8_SA(1, 0), a3, voffA);
            PG8_BAR; PG8_WAIT_L(0); PG8_MMA(1, 0, At, B0); PG8_BAR; PG8_SCHED;
            PG8_STAGE(PG8_SB(1, 1), b3 + hstep, voffB);
            PG8_WAIT_V(6); PG8_BAR; PG8_MMA(1, 1, At, B1); PG8_BAR;
            }
        }
        if constexpr (ALIGN_EPI) { if (wr == 0) PG8_BAR; }
        if constexpr (!Epi::AFTER_DRAIN) { E(acc, cur, wr, wc, fr, fq); S.done(cur); }
        if (!has_next) break;
#pragma unroll
        for (int a = 0; a < 2; ++a)
#pragma unroll
            for (int b = 0; b < 2; ++b)
#pragma unroll
                for (int m = 0; m < 4; ++m)
#pragma unroll
                    for (int n = 0; n < 2; ++n) acc[a][b][m][n] = (f32x4){0.f, 0.f, 0.f, 0.f};
        cur = nxt; cA = nA; cB = nB; ++ui;
        if constexpr (ALIGN_EPI) { if (wr == 1) PG8_BAR; }
    }
    PG8_WAIT_V(0);
    if constexpr (!ALIGN_EPI) { if (wr == 0) PG8_BAR; }
    PG8_BAR;
    if constexpr (Epi::AFTER_DRAIN) { E.fused(acc, cur, wr, wc, fr, fq, lds, wid, lane); S.done(cur); }
#undef PG8_SA
#undef PG8_SB
#undef PG8_STAGE
#undef PG8_LDA
#undef PG8_LDB
#undef PG8_MMA
#undef PG8_WAIT_V
#undef PG8_WAIT_L
#undef PG8_BAR
#undef PG8_SCHED
}
}

constexpr int NB = 16, SEQ = 2048, DM = 1024, TOK = NB * SEQ;
constexpr int EVEN_IN = 3080, EVEN_PAD = 3328;
constexpr int NEXP = 16384;
constexpr float RMS_EPS = 1e-6f;
constexpr float LOG2E = 1.4426950408889634f;
constexpr float C2 = 0.125f * LOG2E;

constexpr size_t MiB = 1u << 20;
constexpr size_t WS_CTL = 0, CTL_ZERO_BYTES = 1 * MiB;
constexpr size_t WS_W1T = 1 * MiB;
constexpr size_t WS_W2T = 8 * MiB;
constexpr size_t WS_W4T = 10 * MiB;
constexpr size_t WS_W5T = 14 * MiB;
constexpr size_t WS_W3T = 16 * MiB;
constexpr size_t WS_W6T = 20 * MiB;
constexpr size_t WS_K1B = 24 * MiB;
constexpr size_t WS_K2B = 24 * MiB + 512 * 1024;
constexpr size_t WS_PWT = 25 * MiB;
constexpr size_t WS_LF  = 25 * MiB + 256 * 1024;
constexpr size_t WS_CF  = 26 * MiB + 256 * 1024;
constexpr size_t WS_KMEAN = 27 * MiB + 256 * 1024;
constexpr size_t WS_RS0 = 27 * MiB + 512 * 1024;
constexpr size_t WS_RS2 = 27 * MiB + 640 * 1024;
constexpr size_t WS_SSQ1 = 28 * MiB;
constexpr size_t WS_SSQ3 = 30 * MiB;
constexpr size_t WS_U8S = 32 * MiB;
constexpr size_t WS_V8S = 64 * MiB;
constexpr size_t WS_XB = 160 * MiB;
constexpr size_t WS_QH = 224 * MiB;
constexpr size_t WS_KH = 288 * MiB;
constexpr size_t WS_VT = 352 * MiB;
constexpr size_t WS_QP = 224 * MiB;
constexpr size_t WS_AO = 416 * MiB;
constexpr size_t WS_EID = 480 * MiB;
constexpr size_t WS_GATE = 488 * MiB;
constexpr size_t WS_SSQ2 = 504 * MiB;
constexpr size_t WS_PREP = 224 * MiB;
constexpr size_t WS_ACO = 416 * MiB;
constexpr size_t WS_END = 506 * MiB;

constexpr int RING_BYTES = 131072;
constexpr int LDS_BYTES = 147456;
constexpr int NWAVES = 8;

#define GAS __attribute__((address_space(1)))
#define LAS __attribute__((address_space(3)))
typedef unsigned short bf16_t;
typedef unsigned u32x4 __attribute__((ext_vector_type(4)));
typedef unsigned u32x2 __attribute__((ext_vector_type(2)));
typedef float f32x4 __attribute__((ext_vector_type(4)));
typedef float f32x16 __attribute__((ext_vector_type(16)));
typedef short bf16x8 __attribute__((ext_vector_type(8)));
typedef __bf16 bf16x2 __attribute__((ext_vector_type(2)));
#define LDS_WAIT() asm volatile("s_waitcnt lgkmcnt(0)" ::: "memory")

__device__ __forceinline__ int opaque_i(int v) { asm volatile("" : "+v"(v)); return v; }
__device__ __forceinline__ unsigned f2bf(float f) { unsigned u = __builtin_bit_cast(unsigned, f); return (u + 0x7fffu + ((u >> 16) & 1u)) >> 16; }
typedef float f32x2_pk __attribute__((ext_vector_type(2)));
__device__ __forceinline__ unsigned pk2(float lo, float hi) { const f32x2_pk v = {lo, hi}; return __builtin_bit_cast(unsigned, __builtin_convertvector(v, bf16x2)); }
__device__ __forceinline__ float bf_lo(unsigned u) { return __uint_as_float(u << 16); }
__device__ __forceinline__ float bf_hi(unsigned u) { return __uint_as_float(u & 0xffff0000u); }
__device__ __forceinline__ float dot2(unsigned a, unsigned b, float acc) { return __builtin_amdgcn_fdot2_f32_bf16(__builtin_bit_cast(bf16x2, a), __builtin_bit_cast(bf16x2, b), acc, false); }
__device__ __forceinline__ float dot8(u32x4 a, u32x4 b, float acc) { acc = dot2(a.x, b.x, acc); acc = dot2(a.y, b.y, acc); acc = dot2(a.z, b.z, acc); return dot2(a.w, b.w, acc); }
__device__ __forceinline__ u32x4 pack8(f32x4 a, f32x4 b) { u32x4 w; w.x = pk2(a[0], a[1]); w.y = pk2(a[2], a[3]); w.z = pk2(b[0], b[1]); w.w = pk2(b[2], b[3]); return w; }

__device__ __forceinline__ float wave_sum(float v) {
#pragma unroll
    for (int o = 1; o < 64; o <<= 1) v += __shfl_xor(v, o);
    return v;
}
__device__ __forceinline__ float wave_max(float v) {
#pragma unroll
    for (int o = 1; o < 64; o <<= 1) v = fmaxf(v, __shfl_xor(v, o));
    return v;
}
__device__ __forceinline__ unsigned wave_umax(unsigned v) {
#pragma unroll
    for (int o = 1; o < 64; o <<= 1) { const unsigned w = (unsigned)__shfl_xor((int)v, o); v = v > w ? v : w; }
    return v;
}
__device__ __forceinline__ float dpp_row_shr(float v, int n) {
    const int iv = __builtin_bit_cast(int, v); int r;
    switch (n) { case 1: r = __builtin_amdgcn_update_dpp(0, iv, 0x111, 0xf, 0xf, true); break; case 2: r = __builtin_amdgcn_update_dpp(0, iv, 0x112, 0xf, 0xf, true); break;
                 case 4: r = __builtin_amdgcn_update_dpp(0, iv, 0x114, 0xf, 0xf, true); break; default: r = __builtin_amdgcn_update_dpp(0, iv, 0x118, 0xf, 0xf, true); break; }
    return __builtin_bit_cast(float, r);
}
__device__ __forceinline__ float wave_total(float v) {
    v += dpp_row_shr(v, 1); v += dpp_row_shr(v, 2); v += dpp_row_shr(v, 4); v += dpp_row_shr(v, 8);
    v += __builtin_bit_cast(float, __builtin_amdgcn_update_dpp(0, __builtin_bit_cast(int, v), 0x142, 0xa, 0xf, false));
    v += __builtin_bit_cast(float, __builtin_amdgcn_update_dpp(0, __builtin_bit_cast(int, v), 0x143, 0xc, 0xf, false));
    return __builtin_bit_cast(float, __builtin_amdgcn_readlane(__builtin_bit_cast(int, v), 63));
}
__device__ __forceinline__ unsigned f2ord(float f) { const unsigned u = __float_as_uint(f); return u ^ ((unsigned)((int)u >> 31) | 0x80000000u); }
__device__ __forceinline__ float ord2f(unsigned o) { return __uint_as_float(o ^ (~(unsigned)((int)o >> 31) | 0x80000000u)); }

__device__ __forceinline__ float row_scale(const float* p, int mode, int t) {
    if (mode == 0) return p[t];
    const f32x4* q = (const f32x4*)(p + (size_t)t * 16); const f32x4 a = q[0], b = q[1], c = q[2], d = q[3];
    const float s = (((a[0] + a[1]) + (a[2] + a[3])) + ((b[0] + b[1]) + (b[2] + b[3]))) + (((c[0] + c[1]) + (c[2] + c[3])) + ((d[0] + d[1]) + (d[2] + d[3])));
    return rsqrtf(s * (1.f / DM) + RMS_EPS);
}

struct EpiL0In {
    static constexpr bool PERM = true, AFTER_DRAIN = false;
    const float* rs; bf16_t* QH; bf16_t* KH; bf16_t* VT; float* LF; const float* b_f;
    __device__ __forceinline__ void operator()(const f32x4 (&acc)[2][2][4][2], const pg8::Unit& u, int wr, int wc, int fr, int fq) const {
        const int pn = u.pn;
        if (pn == 12) {
            if (wc == 0 && fq == 0) {
#pragma unroll
                for (int ai = 0; ai < 2; ++ai)
#pragma unroll
                    for (int m = 0; m < 4; ++m) {
                        const int t = u.pm * 256 + ai * 128 + wr * 64 + m * 16 + fr; const float sc = rs[t]; const int b = t >> 11, s = t & 2047;
#pragma unroll
                        for (int n = 0; n < 2; ++n)
#pragma unroll
                            for (int e = 0; e < 4; ++e) { const int h = n * 4 + e; const float x = acc[ai][0][m][n][e] * sc + b_f[h];
                                const float ls = fminf(x, 0.f) - log1pf(expf(-fabsf(x)));
                                LF[(size_t)(b * 8 + h) * 2048 + s] = ls * LOG2E; }
                    }
            }
            return;
        }
        const int sec = pn >> 1, kind = sec % 3, hbase = (sec >= 3) ? 8 : 0;
#pragma unroll
        for (int ai = 0; ai < 2; ++ai)
#pragma unroll
            for (int m = 0; m < 4; ++m) {
                const int t = u.pm * 256 + ai * 128 + wr * 64 + m * 16 + fr; const int b = t >> 11, s = t & 2047;
                const float sc = rs[t] * (kind == 0 ? C2 : 1.f);
#pragma unroll
                for (int bj = 0; bj < 2; ++bj) {
                    const int cc = (pn & 1) * 256 + bj * 128 + wc * 32 + fq * 8, hh = hbase + (cc >> 6), d0 = cc & 63;
                    const f32x4 v0 = acc[ai][bj][m][0] * sc, v1 = acc[ai][bj][m][1] * sc;
                    if (kind < 2) { bf16_t* dst = (kind == 0 ? QH : KH) + ((size_t)(b * 16 + hh) * 2048 + s) * 64 + d0; *(u32x4*)dst = pack8(v0, v1); }
                    else { bf16_t* dst = VT + ((size_t)(b * 16 + hh) * 64 + d0) * 2048 + s;
                        dst[0 * 2048] = (bf16_t)f2bf(v0[0]); dst[1 * 2048] = (bf16_t)f2bf(v0[1]); dst[2 * 2048] = (bf16_t)f2bf(v0[2]); dst[3 * 2048] = (bf16_t)f2bf(v0[3]);
                        dst[4 * 2048] = (bf16_t)f2bf(v1[0]); dst[5 * 2048] = (bf16_t)f2bf(v1[1]); dst[6 * 2048] = (bf16_t)f2bf(v1[2]); dst[7 * 2048] = (bf16_t)f2bf(v1[3]); }
                }
            }
    }
};
struct EpiL1In {
    static constexpr bool PERM = true, AFTER_DRAIN = false;
    const float* rsp; int rsmode; bf16_t* XC; bf16_t* QD; bf16_t* KD; bf16_t* VTD;
    __device__ __forceinline__ void operator()(const f32x4 (&acc)[2][2][4][2], const pg8::Unit& u, int wr, int wc, int fr, int fq) const {
        const int pn = u.pn, kind = pn >> 1;
#pragma unroll
        for (int ai = 0; ai < 2; ++ai)
#pragma unroll
            for (int m = 0; m < 4; ++m) {
                const int t = u.pm * 256 + ai * 128 + wr * 64 + m * 16 + fr; const int b = t >> 11, s = t & 2047;
                const float sc = row_scale(rsp, rsmode, t) * (kind == 1 ? C2 : 1.f);
#pragma unroll
                for (int bj = 0; bj < 2; ++bj) {
                    const int cc = (pn & 1) * 256 + bj * 128 + wc * 32 + fq * 8, hh = cc >> 6, d0 = cc & 63;
                    const f32x4 v0 = acc[ai][bj][m][0] * sc, v1 = acc[ai][bj][m][1] * sc;
                    if (kind == 0) { *(u32x4*)(XC + (size_t)t * 512 + cc) = pack8(v0, v1); }
                    else if (kind < 3) { bf16_t* dst = (kind == 1 ? QD : KD) + ((size_t)(b * 8 + hh) * 2048 + s) * 64 + d0; *(u32x4*)dst = pack8(v0, v1); }
                    else { bf16_t* dst = VTD + ((size_t)(b * 8 + hh) * 64 + d0) * 2048 + s;
                        dst[0 * 2048] = (bf16_t)f2bf(v0[0]); dst[1 * 2048] = (bf16_t)f2bf(v0[1]); dst[2 * 2048] = (bf16_t)f2bf(v0[2]); dst[3 * 2048] = (bf16_t)f2bf(v0[3]);
                        dst[4 * 2048] = (bf16_t)f2bf(v1[0]); dst[5 * 2048] = (bf16_t)f2bf(v1[1]); dst[6 * 2048] = (bf16_t)f2bf(v1[2]); dst[7 * 2048] = (bf16_t)f2bf(v1[3]); }
                }
            }
    }
};
struct EpiQ {
    static constexpr bool PERM = true, AFTER_DRAIN = false;
    const float* rsp; int rsmode; bf16_t* Q;
    __device__ __forceinline__ void operator()(const f32x4 (&acc)[2][2][4][2], const pg8::Unit& u, int wr, int wc, int fr, int fq) const {
#pragma unroll
        for (int ai = 0; ai < 2; ++ai)
#pragma unroll
            for (int m = 0; m < 4; ++m) {
                const int t = u.pm * 256 + ai * 128 + wr * 64 + m * 16 + fr; const float sc = row_scale(rsp, rsmode, t);
#pragma unroll
                for (int bj = 0; bj < 2; ++bj) { const int c = u.pn * 256 + bj * 128 + wc * 32 + fq * 8;
                    __builtin_nontemporal_store(pack8(acc[ai][bj][m][0] * sc, acc[ai][bj][m][1] * sc), (u32x4*)(Q + (size_t)t * 2048 + c)); }
            }
    }
};
template <bool BASE_BF16>
struct EpiRes {
    static constexpr bool PERM = true, AFTER_DRAIN = false;
    const void* base; bf16_t* xb; float* ssqp;
    __device__ __forceinline__ void operator()(const f32x4 (&acc)[2][2][4][2], const pg8::Unit& u, int wr, int wc, int fr, int fq) const {
#pragma unroll
        for (int ai = 0; ai < 2; ++ai)
#pragma unroll
            for (int m = 0; m < 4; ++m) {
                const int t = u.pm * 256 + ai * 128 + wr * 64 + m * 16 + fr; float ss = 0.f;
#pragma unroll
                for (int bj = 0; bj < 2; ++bj) { const size_t off = (size_t)t * DM + u.pn * 256 + bj * 128 + wc * 32 + fq * 8;
                    f32x4 b0, b1;
                    if (BASE_BF16) { const u32x4 w = *(const u32x4*)((const bf16_t*)base + off); b0 = (f32x4){bf_lo(w.x), bf_hi(w.x), bf_lo(w.y), bf_hi(w.y)}; b1 = (f32x4){bf_lo(w.z), bf_hi(w.z), bf_lo(w.w), bf_hi(w.w)}; }
                    else { b0 = *(const f32x4*)((const float*)base + off); b1 = *(const f32x4*)((const float*)base + off + 4); }
                    const f32x4 o0 = b0 + acc[ai][bj][m][0], o1 = b1 + acc[ai][bj][m][1];
                    *(u32x4*)(xb + off) = pack8(o0, o1);
                    ss += (o0[0] * o0[0] + o0[1] * o0[1]) + (o0[2] * o0[2] + o0[3] * o0[3]) + (o1[0] * o1[0] + o1[1] * o1[1]) + (o1[2] * o1[2] + o1[3] * o1[3]); }
                ss += __shfl_xor(ss, 16); ss += __shfl_xor(ss, 32);
                if (fq == 0) ssqp[(size_t)t * 16 + u.pn * 4 + wc] = ss;
            }
    }
};

#define XB_TMO      128
#define XB_XCNT(j)  (256  + 64 * (j))
#define XB_XSUB(j)  (1280 + 64 * (j))
#define XB_XGEN(j)  (2304 + 64 * (j))
#define XB_TOP      3328
#define XB_TOPGEN   3392
#define XCD_BAR_WORDS 3456
#define XB_SPIN_CAP (1u << 18)

__device__ __forceinline__ unsigned xb_ld(unsigned* p)              { return __hip_atomic_load(p, __ATOMIC_RELAXED, __HIP_MEMORY_SCOPE_AGENT); }
__device__ __forceinline__ unsigned xb_add(unsigned* p, unsigned v) { return __hip_atomic_fetch_add(p, v, __ATOMIC_RELAXED, __HIP_MEMORY_SCOPE_AGENT); }
__device__ __forceinline__ unsigned xb_xcc_id() { return (unsigned)__builtin_amdgcn_s_getreg((3 << 11) | 20) & 0xFu; }
#define XB_SPIN(cond, bar) do { unsigned _sp = 0; while (cond) { __builtin_amdgcn_s_sleep(1); \
    if ((++_sp & 255u) == 0u) { if (xb_ld(&(bar)[XB_TMO])) break; if (_sp > XB_SPIN_CAP) { atomicAdd(&(bar)[XB_TMO], 1u); break; } } } } while (0)

struct XcdBarrier {
    unsigned* bar; unsigned x;
    volatile LAS unsigned* st;
};

__device__ __forceinline__ XcdBarrier xcd_barrier_post(unsigned* bar, volatile LAS unsigned* st) {
    XcdBarrier b; b.bar = bar; b.x = xb_xcc_id(); b.st = st;
    if (threadIdx.x == 0) (void)xb_add(&bar[XB_XCNT(b.x)], 1u);
    return b;
}
__device__ __forceinline__ void xcd_barrier_complete(unsigned* bar, unsigned x, unsigned& nloc, unsigned& nx) {
    const unsigned G = gridDim.x * gridDim.y * gridDim.z;
    unsigned sum, cnt, mine, sp = 0u;
    for (;;) {
        sum = 0u; cnt = 0u; mine = 0u;
#pragma unroll
        for (unsigned j = 0; j < 16; ++j) { const unsigned c = xb_ld(&bar[XB_XCNT(j)]); sum += c; cnt += (c > 0u) ? 1u : 0u; mine = (j == x) ? c : mine; }
        if (sum == G) break;
        __builtin_amdgcn_s_sleep(1);
        if ((++sp & 255u) == 0u) { if (xb_ld(&bar[XB_TMO])) break; if (sp > XB_SPIN_CAP) { atomicAdd(&bar[XB_TMO], 1u); break; } }
    }
    nloc = mine > 0u ? mine : 1u; nx = cnt > 0u ? cnt : 1u;
}

__device__ __forceinline__ void xcd_barrier(const XcdBarrier& b) {
    asm volatile("s_waitcnt vmcnt(0)" ::: "memory");
    __syncthreads();
    if (threadIdx.x == 0) {
        unsigned* bar = b.bar;
        __builtin_amdgcn_s_waitcnt(0);
        unsigned nloc = b.st[0], nx = b.st[1];
        if (nloc == 0u) { xcd_barrier_complete(bar, b.x, nloc, nx); b.st[0] = nloc; b.st[1] = nx; }
        const unsigned old = xb_add(&bar[XB_XSUB(b.x)], 1u);
        const unsigned gen = old / nloc;
        if (old + 1u == (gen + 1u) * nloc) {
            __builtin_amdgcn_fence(__ATOMIC_RELEASE, "agent");
            asm volatile("s_waitcnt vmcnt(0)" ::: "memory");
            const unsigned og = xb_add(&bar[XB_TOP], 1u);
            const unsigned tg = og / nx;
            if (og + 1u == (tg + 1u) * nx) xb_add(&bar[XB_TOPGEN], 1u);
            else XB_SPIN(xb_ld(&bar[XB_TOPGEN]) == tg, bar);
            __builtin_amdgcn_fence(__ATOMIC_ACQUIRE, "agent");
            xb_add(&bar[XB_XGEN(b.x)], 1u);
            asm volatile("s_waitcnt vmcnt(0)" ::: "memory");
        } else {
            XB_SPIN(xb_ld(&bar[XB_XGEN(b.x)]) == gen, bar);
            __builtin_amdgcn_fence(__ATOMIC_ACQUIRE, "agent");
            asm volatile("s_waitcnt vmcnt(0)" ::: "memory");
        }
    }
    __syncthreads();
}

struct Frame {
    LAS unsigned char* lds;
    int tid, lane, wave, vcu, G;
};

__device__ __forceinline__ int remap0(int n) { return n < 1536 ? n : (n < 1544 ? 3072 + (n - 1536) : n - 8); }
__device__ __forceinline__ void p0_transpose_item(const float* W, int K, int N, bf16_t* WT, const float* g, bool remap, LAS float* scr, int item, int lane) {
    const int nblk = (N + 31) / 32, kb = item / nblk, nb = item % nblk, k0 = 64 * kb, n0 = 32 * nb;
#pragma unroll 8
    for (int i = 0; i < 32; ++i) { const int kk = 2 * i + (lane >> 5), n = n0 + (lane & 31);
        float v = (n < N) ? W[(size_t)(k0 + kk) * N + n] : 0.f; if (g) v *= g[k0 + kk]; scr[kk * 33 + (lane & 31)] = v; }
    LDS_WAIT(); asm volatile("" ::: "memory");
    const int c = lane & 7;
#pragma unroll
    for (int j = 0; j < 4; ++j) { const int nl = (lane >> 3) + 8 * j, n = n0 + nl; const LAS float* s = scr + (8 * c) * 33 + nl;
        u32x4 o; o.x = pk2(s[0 * 33], s[1 * 33]); o.y = pk2(s[2 * 33], s[3 * 33]); o.z = pk2(s[4 * 33], s[5 * 33]); o.w = pk2(s[6 * 33], s[7 * 33]);
        if (n < N) { const int nn = remap ? remap0(n) : n; *(u32x4*)(WT + (size_t)nn * K + k0 + 8 * c) = o; } }
    LDS_WAIT(); asm volatile("" ::: "memory");
}
__device__ __forceinline__ float cvt_row_1024(const float* src, bf16_t* dst, const float* g, int lane) {
    const f32x4 a0 = *(const f32x4*)(src + 8 * lane), a1 = *(const f32x4*)(src + 8 * lane + 4), c0 = *(const f32x4*)(src + 512 + 8 * lane), c1 = *(const f32x4*)(src + 516 + 8 * lane);
    float ss = (a0[0] * a0[0] + a0[1] * a0[1]) + (a0[2] * a0[2] + a0[3] * a0[3]) + (a1[0] * a1[0] + a1[1] * a1[1]) + (a1[2] * a1[2] + a1[3] * a1[3])
             + (c0[0] * c0[0] + c0[1] * c0[1]) + (c0[2] * c0[2] + c0[3] * c0[3]) + (c1[0] * c1[0] + c1[1] * c1[1]) + (c1[2] * c1[2] + c1[3] * c1[3]);
    f32x4 b0 = a0, b1 = a1, d0 = c0, d1 = c1;
    if (g) { b0 = b0 * *(const f32x4*)(g + 8 * lane); b1 = b1 * *(const f32x4*)(g + 8 * lane + 4); d0 = d0 * *(const f32x4*)(g + 512 + 8 * lane); d1 = d1 * *(const f32x4*)(g + 516 + 8 * lane); }
    *(u32x4*)(dst + 8 * lane) = pack8(b0, b1); *(u32x4*)(dst + 512 + 8 * lane) = pack8(d0, d1);
    return ss;
}

constexpr float I8_SV = 64.f;
constexpr float I4_SV = 8.44f;
constexpr float I4_SU = 95.5f;
constexpr float I8_SU = 600.f, I8_SX = 127.f / 6.f;
constexpr float FP8_SU = 64.f, FP8_SV = 8.f;
__device__ __forceinline__ void cvt_row_fp8_sliced(const float* src, unsigned char* tab  , int e, const float* g, float scale, int lane) {
#pragma unroll
    for (int j = 0; j < 4; ++j) { f32x4 a = *(const f32x4*)(src + 256 * j + 4 * lane) * scale; if (g) a = a * *(const f32x4*)(g + 256 * j + 4 * lane);
        int w = 0; w = __builtin_amdgcn_cvt_pk_bf8_f32(a[0], a[1], w, false); w = __builtin_amdgcn_cvt_pk_bf8_f32(a[2], a[3], w, true);
        const int x = 2 * j + (lane >> 5);
        *(unsigned*)(tab + ((size_t)x * NEXP + e) * 128 + 4 * (lane & 31)) = (unsigned)w; }
}
__device__ __forceinline__ void cvt_row_i8_sliced(const float* src, unsigned char* tab  , int e, const float* g, float scale, int lane) {
#pragma unroll
    for (int j = 0; j < 4; ++j) { f32x4 a = *(const f32x4*)(src + 256 * j + 4 * lane) * scale; if (g) a = a * *(const f32x4*)(g + 256 * j + 4 * lane);
        unsigned w = 0u;
#pragma unroll
        for (int q = 0; q < 4; ++q) { int v = __float2int_rn(a[q]); v = v < -127 ? -127 : (v > 127 ? 127 : v); w |= ((unsigned)v & 0xffu) << (8 * q); }
        const int x = 2 * j + (lane >> 5);
        *(unsigned*)(tab + ((size_t)x * NEXP + e) * 128 + 4 * (lane & 31)) = w; }
}
struct Ptrs {
    const float *x, *norm_mix, *norm_ffn, *ev_w_in, *ev_b_f, *ev_w_out, *od_w_in, *od_pool_w, *od_pool_scale, *od_w_out, *peer_wq, *peer_k1, *peer_k2, *peer_u, *peer_v, *norm_f;
    float* out; unsigned char* ws;
};

__device__ __forceinline__ void phase_p0(Frame& F, const Ptrs& P) {
    LAS float* scr = (LAS float*)(F.lds + F.wave * 16384);
    const int gw = F.vcu * NWAVES + F.wave, NGW = F.G * NWAVES, lane = opaque_i(F.lane);
    unsigned char* ws = P.ws;
    bf16_t* W1T = (bf16_t*)(ws + WS_W1T); bf16_t* W2T = (bf16_t*)(ws + WS_W2T); bf16_t* W4T = (bf16_t*)(ws + WS_W4T); bf16_t* W5T = (bf16_t*)(ws + WS_W5T);
    bf16_t* W3T = (bf16_t*)(ws + WS_W3T); bf16_t* W6T = (bf16_t*)(ws + WS_W6T); bf16_t* PWT = (bf16_t*)(ws + WS_PWT);
    constexpr int I1 = 16 * 97, I2 = 16 * 32, I4 = 16 * 64, I5 = I2, I3 = I4, I6 = I4, IP = 4 * 2 * 4;
    constexpr int NTR = I1 + I2 + I4 + I5 + I3 + I6 + IP;
    for (int it = gw; it < NTR; it += NGW) {
        int r = it;
        if (r < I1) { p0_transpose_item(P.ev_w_in, DM, EVEN_IN, W1T, P.norm_mix, true, scr, r, lane); continue; } r -= I1;
        if (r < I2) { p0_transpose_item(P.ev_w_out, DM, DM, W2T, nullptr, false, scr, r, lane); continue; } r -= I2;
        if (r < I4) { p0_transpose_item(P.od_w_in, DM, 2048, W4T, P.norm_mix + DM, false, scr, r, lane); continue; } r -= I4;
        if (r < I5) { p0_transpose_item(P.od_w_out, DM, DM, W5T, nullptr, false, scr, r, lane); continue; } r -= I5;
        if (r < I3) { p0_transpose_item(P.peer_wq, DM, 2048, W3T, P.norm_ffn, false, scr, r, lane); continue; } r -= I3;
        if (r < I6) { p0_transpose_item(P.peer_wq + (size_t)DM * 2048, DM, 2048, W6T, P.norm_ffn + DM, false, scr, r, lane); continue; } r -= I6;
        { const int g = r >> 3; p0_transpose_item(P.od_pool_w + (size_t)g * 128 * 128, 128, 128, PWT + (size_t)g * 128 * 128, nullptr, false, scr, r & 7, lane); }
    }
    bf16_t* XB = (bf16_t*)(ws + WS_XB); float* RS0 = (float*)(ws + WS_RS0);
    bf16_t* K1B = (bf16_t*)(ws + WS_K1B); bf16_t* K2B = (bf16_t*)(ws + WS_K2B);
    f32x4 wf[16][2];
    __syncthreads();
    { LAS float* wl = (LAS float*)F.lds;
      for (int k = F.tid; k < DM; k += NWAVES * 64) { const float gk = P.norm_mix[k]; const float* wp = P.ev_w_in + (size_t)k * EVEN_IN + 1536; LAS float* d = wl + 8 * k + 4 * (k >> 3);
          *(LAS f32x4*)d = *(const f32x4*)wp * gk; *(LAS f32x4*)(d + 4) = *(const f32x4*)(wp + 4) * gk; }
      __syncthreads();
#pragma unroll
      for (int j = 0; j < 16; ++j) { const int k = (j < 8 ? 0 : 512) + 8 * lane + (j & 7); const LAS float* s = wl + 8 * k + 4 * (k >> 3); wf[j][0] = *(const LAS f32x4*)s; wf[j][1] = *(const LAS f32x4*)(s + 4); } }
    float* LF = (float*)(ws + WS_LF); const float bfl = P.ev_b_f[lane & 7];
    for (int r0 = gw * 4; r0 < TOK; r0 += NGW * 4) {
        f32x4 a[4][4];
#pragma unroll
        for (int q = 0; q < 4; ++q) { const float* s = P.x + (size_t)(r0 + q) * DM + 8 * lane; a[q][0] = *(const f32x4*)s; a[q][1] = *(const f32x4*)(s + 4); a[q][2] = *(const f32x4*)(s + 512); a[q][3] = *(const f32x4*)(s + 516); }
#pragma unroll
        for (int q = 0; q < 4; ++q) { float ss = 0.f;
#pragma unroll
            for (int j = 0; j < 4; ++j) ss += (a[q][j][0] * a[q][j][0] + a[q][j][1] * a[q][j][1]) + (a[q][j][2] * a[q][j][2] + a[q][j][3] * a[q][j][3]);
            bf16_t* d = XB + (size_t)(r0 + q) * DM + 8 * lane; *(u32x4*)d = pack8(a[q][0], a[q][1]); *(u32x4*)(d + 512) = pack8(a[q][2], a[q][3]);
            ss = wave_sum(ss); const float rs = rsqrtf(ss * (1.f / DM) + RMS_EPS); if (lane == 0) RS0[r0 + q] = rs;
            f32x4 g0 = {0.f, 0.f, 0.f, 0.f}, g1 = {0.f, 0.f, 0.f, 0.f};
#pragma unroll
            for (int j = 0; j < 16; ++j) { const float xv = a[q][j >> 2][j & 3]; g0 += wf[j][0] * xv; g1 += wf[j][1] * xv; }
            float gv = 0.f;
#pragma unroll
            for (int h = 0; h < 8; ++h) { const float tot = wave_total(h < 4 ? g0[h & 3] : g1[h & 3]); gv = (lane == h) ? tot : gv; }
            if (lane < 8) { const int r = r0 + q; const float x = gv * rs + bfl; const float ls = fminf(x, 0.f) - log1pf(expf(-fabsf(x)));
                LF[(size_t)((r >> 11) * 8 + lane) * 2048 + (r & 2047)] = ls * LOG2E; }
        }
    }
#pragma unroll 1
    for (int tb = 0; tb < 2; ++tb) {
        const float* srcT = tb ? P.peer_v : P.peer_u; unsigned char* tabT = ws + (tb ? WS_V8S : WS_U8S); const float scale = tb ? I4_SV : I4_SU;
        for (int r0 = gw * 4; r0 < 2 * NEXP; r0 += NGW * 4) {
            const int ly = r0 >= NEXP, e0 = r0 - ly * NEXP; unsigned char* tab = tabT + (size_t)ly * 4 * NEXP * 128;
            f32x4 a[4][4], g[4];
#pragma unroll
            for (int q = 0; q < 4; ++q)
#pragma unroll
                for (int j = 0; j < 4; ++j) a[q][j] = *(const f32x4*)(srcT + (size_t)(r0 + q) * DM + 256 * j + 4 * lane);
#pragma unroll
            for (int j = 0; j < 4; ++j) { g[j] = (f32x4){scale, scale, scale, scale}; if (!tb) g[j] = g[j] * *(const f32x4*)(P.norm_ffn + (ly ? DM : 0) + 256 * j + 4 * lane); }
#pragma unroll
            for (int q = 0; q < 4; ++q)
#pragma unroll
                for (int j = 0; j < 4; ++j) { const f32x4 v = a[q][j] * g[j]; unsigned w = 0u;
                    if (!tb) {
#pragma unroll
                        for (int k = 0; k < 4; ++k) { int iv = __float2int_rn(v[k]); iv = iv < -8 ? -8 : (iv > 7 ? 7 : iv); w |= ((unsigned)iv & 0xfu) << (4 * k); }
                        *(unsigned short*)(tab + ((size_t)j * NEXP + e0 + q) * 128 + 2 * lane) = (unsigned short)w;
                    } else {
#pragma unroll
                        for (int k = 0; k < 4; ++k) { int iv = __float2int_rn(v[k]); iv = iv < -8 ? -8 : (iv > 7 ? 7 : iv); w |= ((unsigned)((k & 1) ? iv : iv + 8) & 0xfu) << (4 * k); }
                        *(unsigned short*)(tab + ((size_t)j * NEXP + e0 + q) * 128 + 2 * lane) = (unsigned short)w; } }
        }
    }
    constexpr int R_Z = EVEN_PAD - EVEN_IN, R_K = 2 * 256;
    for (int it = gw; it < R_Z + R_K; it += NGW) {
        int r = it;
        if (r < R_Z) { bf16_t* d = W1T + (size_t)(EVEN_IN + r) * DM; const u32x4 z = {0u, 0u, 0u, 0u}; *(u32x4*)(d + 8 * lane) = z; *(u32x4*)(d + 512 + 8 * lane) = z; continue; } r -= R_Z;
        if (r < 256) (void)cvt_row_1024(P.peer_k1 + (size_t)r * 1024, K1B + (size_t)r * 1024, nullptr, lane);
        else (void)cvt_row_1024(P.peer_k2 + (size_t)(r - 256) * 1024, K2B + (size_t)(r - 256) * 1024, nullptr, lane);
    }
}

__device__ __forceinline__ void phase_cfscan(Frame& F, const float* LF, float* CFo) {
    const int gw = F.vcu * NWAVES + F.wave, NGW = F.G * NWAVES, lane = opaque_i(F.lane);
    for (int bh = gw; bh < NB * 8; bh += NGW) {
        const float* src = LF + (size_t)bh * 2048 + 32 * lane; float v[32];
#pragma unroll
        for (int i = 0; i < 8; ++i) { const f32x4 w = *(const f32x4*)(src + 4 * i); v[4 * i] = w[0]; v[4 * i + 1] = w[1]; v[4 * i + 2] = w[2]; v[4 * i + 3] = w[3]; }
#pragma unroll
        for (int i = 1; i < 32; ++i) v[i] += v[i - 1];
        const float tot = v[31]; float inc = tot;
#pragma unroll
        for (int o = 1; o < 64; o <<= 1) { const float w = __shfl_up(inc, o); if (lane >= o) inc += w; }
        const float excl = inc - tot; float* dst = CFo + (size_t)bh * 2048 + 32 * lane;
#pragma unroll
        for (int i = 0; i < 8; ++i) { f32x4 w = {v[4 * i] + excl, v[4 * i + 1] + excl, v[4 * i + 2] + excl, v[4 * i + 3] + excl}; *(f32x4*)(dst + 4 * i) = w; }
    }
}
__device__ __forceinline__ void cfscan_block(Frame& F, const float* LF, float* CFo, int bh) {
    LAS float* wt = (LAS float*)(F.lds + RING_BYTES + 2048);
    const int lane = opaque_i(F.lane);
    const f32x4 w = *(const f32x4*)(LF + (size_t)bh * 2048 + 4 * F.tid);
    const float p0 = w[0], p1 = p0 + w[1], p2 = p1 + w[2], p3 = p2 + w[3];
    float inc = p3;
#pragma unroll
    for (int o = 1; o < 64; o <<= 1) { const float u = __shfl_up(inc, o); if (lane >= o) inc += u; }
    if (lane == 63) wt[F.wave] = inc;
    __syncthreads();
    float base = inc - p3;
#pragma unroll
    for (int k = 0; k < NWAVES - 1; ++k) base += (k < F.wave) ? wt[k] : 0.f;
    *(f32x4*)(CFo + (size_t)bh * 2048 + 4 * F.tid) = (f32x4){p0 + base, p1 + base, p2 + base, p3 + base};
    asm volatile("s_waitcnt vmcnt(0)" ::: "memory");
    __syncthreads();
}
__device__ __forceinline__ void phase_kmean(Frame& F, const bf16_t* KD, float* KMEAN, int bh) {
    const int lane = opaque_i(F.lane), jg = lane >> 3, dq = lane & 7;
    for (int it = bh * 8 + F.wave; it < bh * 8 + 8; it += NWAVES) {
        const int bh = it >> 3, blk = it & 7; const bf16_t* src = KD + ((size_t)bh * 2048 + blk * 256 + jg) * 64 + 8 * dq; float s[8] = {0.f, 0.f, 0.f, 0.f, 0.f, 0.f, 0.f, 0.f};
#pragma unroll 8
        for (int i = 0; i < 32; ++i) { const u32x4 w = *(const u32x4*)(src + (size_t)i * 8 * 64);
            s[0] += bf_lo(w.x); s[1] += bf_hi(w.x); s[2] += bf_lo(w.y); s[3] += bf_hi(w.y); s[4] += bf_lo(w.z); s[5] += bf_hi(w.z); s[6] += bf_lo(w.w); s[7] += bf_hi(w.w); }
#pragma unroll
        for (int k = 0; k < 8; ++k) { s[k] += __shfl_xor(s[k], 8); s[k] += __shfl_xor(s[k], 16); s[k] += __shfl_xor(s[k], 32); }
        if (jg == 0) { float* d = KMEAN + (size_t)it * 64 + 8 * dq; *(f32x4*)d = (f32x4){s[0], s[1], s[2], s[3]} * (1.f / 256.f); *(f32x4*)(d + 4) = (f32x4){s[4], s[5], s[6], s[7]} * (1.f / 256.f); }
    }
}
__device__ __forceinline__ int lgi(int s) { return s + (s >> 5); }
__device__ __forceinline__ float lsn2f(float z2) { return -(fmaxf(z2, 0.f) + __log2f(1.f + exp2f(-fabsf(z2)))); }
template <int KIND>
__device__ __forceinline__ void attn_naive(Frame& F, const bf16_t* QH, const bf16_t* KH, const bf16_t* VT, int NH, int hbase, const float* CF, const float* KMEAN, bf16_t* AO, int ao_col0) {
    LAS float* lg = (LAS float*)(F.lds + F.wave * 8704);
    const int gw = F.vcu * NWAVES + F.wave, NGW = F.G * NWAVES, lane = opaque_i(F.lane);
    for (int qi = gw; qi < NB * 8 * SEQ; qi += NGW) {
        const int bh = qi >> 11, b = bh >> 3, h = bh & 7, hh = hbase + h;
        const int t = (bh & 1) ? (2047 - (qi & 2047)) : (qi & 2047);
        const size_t hb = (size_t)(b * NH + hh);
        const bf16_t* qp = QH + (hb * 2048 + t) * 64; const bf16_t* kp = KH + hb * 2048 * 64;
        float q[64];
#pragma unroll
        for (int c = 0; c < 8; ++c) { const u32x4 w = *(const u32x4*)(qp + 8 * c);
            q[8 * c] = bf_lo(w.x); q[8 * c + 1] = bf_hi(w.x); q[8 * c + 2] = bf_lo(w.y); q[8 * c + 3] = bf_hi(w.y); q[8 * c + 4] = bf_lo(w.z); q[8 * c + 5] = bf_hi(w.z); q[8 * c + 6] = bf_lo(w.w); q[8 * c + 7] = bf_hi(w.w); }
        unsigned sel = 0u; const int qb = t >> 8;
        if (KIND == 2) {
            float gate[8];
#pragma unroll
            for (int n = 0; n < 8; ++n) { const float* km = KMEAN + ((size_t)(b * 8 + h) * 8 + n) * 64; float a = 0.f;
#pragma unroll
                for (int d = 0; d < 64; ++d) a += q[d] * km[d];
                gate[n] = a; }
            const int nsel = qb < 3 ? qb : 3;
#pragma unroll
            for (int r = 0; r < 3; ++r) if (r < nsel) { float best = -INFINITY; int bi = 0;
#pragma unroll
                for (int n = 0; n < 8; ++n) if (n < qb && !((sel >> n) & 1u) && gate[n] > best) { best = gate[n]; bi = n; }
                sel |= 1u << bi; }
        }
        const int nk = (KIND == 1) ? t : t + 1;
        const int tp = (nk + 7) & ~7;
        const float cft = (KIND == 0) ? CF[(size_t)(b * 8 + h) * 2048 + t] : 0.f;
        const float slope2 = (KIND == 2) ? exp2f(-(float)(h + 1)) * LOG2E : 0.f;
        float mloc = -INFINITY;
        for (int s = lane; s < nk; s += 64) {
            float dot = 0.f;
#pragma unroll
            for (int c = 0; c < 8; ++c) { const u32x4 w = *(const u32x4*)(kp + (size_t)s * 64 + 8 * c);
                dot += q[8 * c] * bf_lo(w.x) + q[8 * c + 1] * bf_hi(w.x) + q[8 * c + 2] * bf_lo(w.y) + q[8 * c + 3] * bf_hi(w.y) + q[8 * c + 4] * bf_lo(w.z) + q[8 * c + 5] * bf_hi(w.z) + q[8 * c + 6] * bf_lo(w.w) + q[8 * c + 7] * bf_hi(w.w); }
            float v = dot;
            if (KIND == 0) v += cft - CF[(size_t)(b * 8 + h) * 2048 + s];
            if (KIND == 2) { const int n = s >> 8; const bool valid = (n == qb) || ((sel >> n) & 1u); v = valid ? v + slope2 * (float)(s - t) : -INFINITY; }
            lg[lgi(s)] = v; mloc = fmaxf(mloc, v);
        }
        float linv = 1.f;
        if (KIND != 1) {
            const float m = wave_max(mloc); float lsum = 0.f;
            for (int s = lane; s < tp; s += 64) { const float p = (s < nk) ? exp2f(lg[lgi(s)] - m) : 0.f; lg[lgi(s)] = p; lsum += p; }
            linv = 1.f / wave_sum(lsum);
        } else {
            float tot = 0.f;
            for (int i = 0; i < 32; ++i) { const int s = 32 * lane + i; if (s < nk) tot += lsn2f(lg[lgi(s)]); }
            float inc = tot;
#pragma unroll
            for (int o = 1; o < 64; o <<= 1) { const float w = __shfl_down(inc, o); if (lane + o < 64) inc += w; }
            float run = inc - tot;
            for (int i = 31; i >= 0; --i) { const int s = 32 * lane + i; float a = 0.f;
                if (s < nk) { const float z = lg[lgi(s)], l2 = lsn2f(z); a = exp2f(z + l2 + run); run += l2; }
                if (s < tp) lg[lgi(s)] = a; }
        }
        LDS_WAIT();
        const bf16_t* vp = VT + (hb * 64 + lane) * 2048; float o = 0.f;
        for (int s0 = 0; s0 < tp; s0 += 8) { const u32x4 w = *(const u32x4*)(vp + s0); const int i0 = lgi(s0);
            o += lg[i0] * bf_lo(w.x) + lg[i0 + 1] * bf_hi(w.x) + lg[i0 + 2] * bf_lo(w.y) + lg[i0 + 3] * bf_hi(w.y) + lg[i0 + 4] * bf_lo(w.z) + lg[i0 + 5] * bf_hi(w.z) + lg[i0 + 6] * bf_lo(w.w) + lg[i0 + 7] * bf_hi(w.w); }
        AO[(size_t)(b * 2048 + t) * DM + ao_col0 + h * 64 + lane] = (bf16_t)f2bf(o * linv);
        LDS_WAIT();
    }
}

__device__ __forceinline__ float lsn2q(float z2) { return -(fmaxf(z2, 0.f) + __builtin_amdgcn_logf(1.f + __builtin_amdgcn_exp2f(-fabsf(z2)))); }
__device__ __forceinline__ int pi32(int i) { return (i & ~12) | ((i & 4) << 1) | ((i & 8) >> 1); }
__device__ __forceinline__ void attn_load_k(bf16x8 (&kf)[4], const bf16_t* Kh, int kv0, int r32p, int hi) {
    const bf16_t* p = Kh + (size_t)(kv0 + r32p) * 64 + 8 * hi;
#pragma unroll
    for (int d0 = 0; d0 < 4; ++d0) kf[d0] = *(const bf16x8*)(p + 16 * d0);
}
__device__ __forceinline__ void attn_load_v(bf16x8 (&vf)[2][2], const bf16_t* Vth, int kv0, int r32, int hi) {
#pragma unroll
    for (int s = 0; s < 2; ++s)
#pragma unroll
        for (int dh = 0; dh < 2; ++dh) vf[s][dh] = *(const bf16x8*)(Vth + (size_t)(32 * dh + r32) * 2048 + kv0 + 16 * s + 8 * hi);
}
template <int KIND, int MODE>
__device__ __forceinline__ void attn_tile(const bf16x8 (&qr)[4], const bf16x8 (&kf)[4], const bf16x8 (&vf)[2][2], f32x16& O0, f32x16& O1, float& m, float& l, float& R,
                                          const f32x16& bias, const int kv0, const int q, const int hi, const bool rowok) {
    f32x16 S = bias;
#pragma unroll
    for (int d0 = 0; d0 < 4; ++d0) S = __builtin_amdgcn_mfma_f32_32x32x16_bf16(kf[d0], qr[d0], S, 0, 0, 0);
    if (MODE == 1) {
#pragma unroll
        for (int r = 0; r < 16; ++r) { const int key = kv0 + (r & 7) + 8 * hi + 16 * (r >> 3); const bool bad = (KIND == 1) ? (key >= q) : (key > q); if (bad) S[r] = -INFINITY; }
    }
    if (MODE == 2) { if (!rowok) {
#pragma unroll
        for (int r = 0; r < 16; ++r) S[r] = -INFINITY; } }
    float p[16];
    if (KIND != 1) {
        float rm = fmaxf(fmaxf(S[0], S[1]), fmaxf(S[2], S[3]));
#pragma unroll
        for (int r = 4; r < 16; r += 4) rm = fmaxf(rm, fmaxf(fmaxf(S[r], S[r + 1]), fmaxf(S[r + 2], S[r + 3])));
        rm = fmaxf(rm, __shfl_xor(rm, 32));
        const float mn = fmaxf(fmaxf(m, rm), -1e30f); const float alpha = __builtin_amdgcn_exp2f(m - mn);
        float ps = 0.f;
#pragma unroll
        for (int r = 0; r < 16; ++r) { p[r] = __builtin_amdgcn_exp2f(S[r] - mn); ps += p[r]; }
        l = l * alpha + ps; m = mn;
        O0 *= alpha; O1 *= alpha;
    } else {
        float l2[16]; float sLo = 0.f, sHi = 0.f;
#pragma unroll
        for (int r = 0; r < 16; ++r) l2[r] = lsn2q(S[r]);
#pragma unroll
        for (int r = 0; r < 8; ++r) { sLo += l2[r]; sHi += l2[8 + r]; }
        const float pLo = __shfl_xor(sLo, 32), pHi = __shfl_xor(sHi, 32);
        float run = hi ? R : R + pHi;
#pragma unroll
        for (int r = 15; r >= 8; --r) { p[r] = __builtin_amdgcn_exp2f(S[r] + l2[r] + run); run += l2[r]; }
        run = hi ? (R + sHi + pHi) : (R + pHi + sHi + pLo);
#pragma unroll
        for (int r = 7; r >= 0; --r) { p[r] = __builtin_amdgcn_exp2f(S[r] + l2[r] + run); run += l2[r]; }
        R += (sLo + sHi) + (pLo + pHi);
    }
    u32x4 w0, w1;
    w0.x = pk2(p[0], p[1]); w0.y = pk2(p[2], p[3]); w0.z = pk2(p[4], p[5]); w0.w = pk2(p[6], p[7]);
    w1.x = pk2(p[8], p[9]); w1.y = pk2(p[10], p[11]); w1.z = pk2(p[12], p[13]); w1.w = pk2(p[14], p[15]);
    const bf16x8 pf0 = __builtin_bit_cast(bf16x8, w0), pf1 = __builtin_bit_cast(bf16x8, w1);
    O0 = __builtin_amdgcn_mfma_f32_32x32x16_bf16(vf[0][0], pf0, O0, 0, 0, 0); O0 = __builtin_amdgcn_mfma_f32_32x32x16_bf16(vf[1][0], pf1, O0, 0, 0, 0);
    O1 = __builtin_amdgcn_mfma_f32_32x32x16_bf16(vf[0][1], pf0, O1, 0, 0, 0); O1 = __builtin_amdgcn_mfma_f32_32x32x16_bf16(vf[1][1], pf1, O1, 0, 0, 0);
}
template <int KIND>
__device__ __forceinline__ f32x16 attn_bias(const float* CFh, float slope2, int kv0, int q0, int hi) {
    f32x16 b = f32x16{};
    if (KIND == 0) { const float* c = CFh + kv0 + 8 * hi; const f32x4 a0 = *(const f32x4*)c, a1 = *(const f32x4*)(c + 4), a2 = *(const f32x4*)(c + 16), a3 = *(const f32x4*)(c + 20);
        b[0] = -a0[0]; b[1] = -a0[1]; b[2] = -a0[2]; b[3] = -a0[3]; b[4] = -a1[0]; b[5] = -a1[1]; b[6] = -a1[2]; b[7] = -a1[3];
        b[8] = -a2[0]; b[9] = -a2[1]; b[10] = -a2[2]; b[11] = -a2[3]; b[12] = -a3[0]; b[13] = -a3[1]; b[14] = -a3[2]; b[15] = -a3[3]; }
    if (KIND == 2) {
#pragma unroll
        for (int r = 0; r < 16; ++r) b[r] = slope2 * (float)(kv0 + (r & 7) + 8 * hi + 16 * (r >> 3) - q0); }
    return b;
}
template <int KIND>
__device__ __forceinline__ void attn_wave(const bf16_t* Qh, const bf16_t* Kh, const bf16_t* Vth, const int q0, const int lane, const float* CFh, const float slope2, const float* KMh, bf16_t* AOp) {
    const int r32 = lane & 31, hi = lane >> 5, r32p = pi32(r32), q = q0 + r32;
    bf16x8 qr[4];
#pragma unroll
    for (int d0 = 0; d0 < 4; ++d0) qr[d0] = *(const bf16x8*)(Qh + (size_t)q * 64 + 16 * d0 + 8 * hi);
    f32x16 O0 = f32x16{}, O1 = f32x16{};
    float m = -INFINITY, l = 0.f, R = 0.f;
    bf16x8 kf[4], kfn[4], vf[2][2];
    const int nt = q0 / 32 + 1;
    if (KIND == 0) {
        attn_load_k(kf, Kh, 0, r32p, hi);
        for (int it = 0; it < nt; ++it) { const int kv0 = 32 * it;
            attn_load_v(vf, Vth, kv0, r32, hi); const f32x16 bias = attn_bias<0>(CFh, 0.f, kv0, q0, hi);
            if (it + 1 < nt) attn_load_k(kfn, Kh, kv0 + 32, r32p, hi);
            if (it == nt - 1) attn_tile<0, 1>(qr, kf, vf, O0, O1, m, l, R, bias, kv0, q, hi, true); else attn_tile<0, 0>(qr, kf, vf, O0, O1, m, l, R, bias, kv0, q, hi, true);
#pragma unroll
            for (int d0 = 0; d0 < 4; ++d0) kf[d0] = kfn[d0]; }
    } else if (KIND == 1) {
        attn_load_k(kf, Kh, 32 * (nt - 1), r32p, hi);
        for (int it = nt - 1; it >= 0; --it) { const int kv0 = 32 * it;
            attn_load_v(vf, Vth, kv0, r32, hi); const f32x16 bias = f32x16{};
            if (it > 0) attn_load_k(kfn, Kh, kv0 - 32, r32p, hi);
            if (it == nt - 1) attn_tile<1, 1>(qr, kf, vf, O0, O1, m, l, R, bias, kv0, q, hi, true); else attn_tile<1, 0>(qr, kf, vf, O0, O1, m, l, R, bias, kv0, q, hi, true);
#pragma unroll
            for (int d0 = 0; d0 < 4; ++d0) kf[d0] = kfn[d0];
            if (__all(R < -200.f)) break; }
    } else {
        const int qb = q0 >> 8;
        f32x16 G = f32x16{};
#pragma unroll
        for (int d0 = 0; d0 < 4; ++d0) { u32x4 kw = {0u, 0u, 0u, 0u};
            if (r32 < 8) { const float* kmp = KMh + r32 * 64 + 16 * d0 + 8 * hi; kw = pack8(*(const f32x4*)kmp, *(const f32x4*)(kmp + 4)); }
            G = __builtin_amdgcn_mfma_f32_32x32x16_bf16(__builtin_bit_cast(bf16x8, kw), qr[d0], G, 0, 0, 0); }
        float gate[8];
#pragma unroll
        for (int n = 0; n < 4; ++n) { const float own = G[n], oth = __shfl_xor(own, 32); gate[n] = hi ? oth : own; gate[n + 4] = hi ? own : oth; }
        unsigned sel = 0u; const int nsel = qb < 3 ? qb : 3;
#pragma unroll
        for (int r = 0; r < 3; ++r) if (r < nsel) { float best = -INFINITY; int bi = 0;
#pragma unroll
            for (int n = 0; n < 8; ++n) if (n < qb && !((sel >> n) & 1u) && gate[n] > best) { best = gate[n]; bi = n; }
            sel |= 1u << bi; }
        for (int kv0 = 256 * qb; kv0 <= q0; kv0 += 32) {
            attn_load_k(kf, Kh, kv0, r32p, hi); attn_load_v(vf, Vth, kv0, r32, hi); const f32x16 bias = attn_bias<2>(nullptr, slope2, kv0, q0, hi);
            if (kv0 == q0) attn_tile<2, 1>(qr, kf, vf, O0, O1, m, l, R, bias, kv0, q, hi, true); else attn_tile<2, 0>(qr, kf, vf, O0, O1, m, l, R, bias, kv0, q, hi, true); }
        for (int j = 0; j < qb; ++j) { const bool rowok = (sel >> j) & 1u;
            if (!__any(rowok)) continue;
            attn_load_k(kf, Kh, 256 * j, r32p, hi);
            for (int i = 0; i < 8; ++i) { const int kv0 = 256 * j + 32 * i;
                attn_load_v(vf, Vth, kv0, r32, hi); const f32x16 bias = attn_bias<2>(nullptr, slope2, kv0, q0, hi);
                if (i < 7) attn_load_k(kfn, Kh, kv0 + 32, r32p, hi);
                attn_tile<2, 2>(qr, kf, vf, O0, O1, m, l, R, bias, kv0, q, hi, rowok);
#pragma unroll
                for (int d0 = 0; d0 < 4; ++d0) kf[d0] = kfn[d0]; } }
    }
    float linv = 1.f;
    if (KIND != 1) linv = 1.f / (l + __shfl_xor(l, 32));
    bf16_t* orow = AOp + (size_t)q * DM;
#pragma unroll
    for (int g = 0; g < 4; ++g) { u32x2 w;
        w.x = pk2(O0[4 * g] * linv, O0[4 * g + 1] * linv); w.y = pk2(O0[4 * g + 2] * linv, O0[4 * g + 3] * linv); *(u32x2*)(orow + 8 * g + 4 * hi) = w;
        w.x = pk2(O1[4 * g] * linv, O1[4 * g + 1] * linv); w.y = pk2(O1[4 * g + 2] * linv, O1[4 * g + 3] * linv); *(u32x2*)(orow + 32 + 8 * g + 4 * hi) = w; }
}
template <int KIND>
__device__ __forceinline__ void phase_attn(Frame& F, const bf16_t* QH, const bf16_t* KH, const bf16_t* VT, int NH, int hbase, const float* CF, const float* KMEAN, bf16_t* AO, int ao_col0) {
    for (int ug = F.vcu; ug < NB * 8 * 2; ug += F.G) {
        const int bh = ug >> 1, b = bh >> 3, h = bh & 7, hh = hbase + h; const size_t hb = (size_t)(b * NH + hh);
        const float slope2 = __builtin_amdgcn_exp2f(-(float)(h + 1)) * LOG2E;
#pragma unroll 1
        for (int i = 0; i < 4; ++i) { const int base = (i >> 1) * 2 + (ug & 1), qb = (i & 1) ? 7 - base : base, w = (i & 1) ? 7 - F.wave : F.wave;
            attn_wave<KIND>(QH + hb * 2048 * 64, KH + hb * 2048 * 64, VT + hb * 64 * 2048, 256 * qb + 32 * w, opaque_i(F.lane),
                            CF ? CF + (size_t)bh * 2048 : nullptr, slope2, KMEAN ? KMEAN + (size_t)bh * 8 * 64 : nullptr, AO + (size_t)b * 2048 * DM + ao_col0 + h * 64); }
    }
}


constexpr int AT_SLOT = 16384, AT_CF = 4 * AT_SLOT;
__device__ __forceinline__ void attn_dma_tile(const bf16_t* Kh, const bf16_t* Vth, int T, LAS unsigned char* slot, int wave, int r32, int r32p, int hi) {
    const int j = wave >> 2, d0 = wave & 3, s2 = (wave >> 1) & 1, dh = wave & 1;
    const bf16_t* ks = Kh + (size_t)(64 * T + 32 * j + r32p) * 64 + 16 * d0 + 8 * hi;
    const bf16_t* vs = Vth + (size_t)(32 * dh + r32) * 2048 + 64 * T + 32 * j + 16 * s2 + 8 * hi;
    __builtin_amdgcn_global_load_lds((const unsigned*)ks, (LAS unsigned*)(slot + (j * 4 + d0) * 1024), 16, 0, 0);
    __builtin_amdgcn_global_load_lds((const unsigned*)vs, (LAS unsigned*)(slot + 8192 + ((j * 2 + s2) * 2 + dh) * 1024), 16, 0, 0);
}
template <int MODE>
__device__ __forceinline__ void attn_fox_sub(const bf16x8 (&qr)[4], f32x16& O0, f32x16& O1, float& m, float& l, unsigned saddr  , unsigned cfaddr  , int j, int kv0, int q, int hi) {
    bf16x8 kf[4], vf[2][2]; f32x4 c0, c1, c2, c3;
    asm volatile("ds_read_b128 %0, %12\n\tds_read_b128 %1, %12 offset:1024\n\tds_read_b128 %2, %12 offset:2048\n\tds_read_b128 %3, %12 offset:3072\n\t"
                 "ds_read_b128 %4, %13\n\tds_read_b128 %5, %13 offset:1024\n\tds_read_b128 %6, %13 offset:2048\n\tds_read_b128 %7, %13 offset:3072\n\t"
                 "ds_read_b128 %8, %14\n\tds_read_b128 %9, %14 offset:16\n\tds_read_b128 %10, %14 offset:64\n\tds_read_b128 %11, %14 offset:80\n\ts_waitcnt lgkmcnt(0)"
                 : "=&v"(kf[0]), "=&v"(kf[1]), "=&v"(kf[2]), "=&v"(kf[3]), "=&v"(vf[0][0]), "=&v"(vf[0][1]), "=&v"(vf[1][0]), "=&v"(vf[1][1]), "=&v"(c0), "=&v"(c1), "=&v"(c2), "=&v"(c3)
                 : "v"(saddr + (unsigned)j * 4096u), "v"(saddr + 8192u + (unsigned)j * 4096u), "v"(cfaddr) : "memory");
    f32x16 S;
    S[0] = c0[0]; S[1] = c0[1]; S[2] = c0[2]; S[3] = c0[3]; S[4] = c1[0]; S[5] = c1[1]; S[6] = c1[2]; S[7] = c1[3];
    S[8] = c2[0]; S[9] = c2[1]; S[10] = c2[2]; S[11] = c2[3]; S[12] = c3[0]; S[13] = c3[1]; S[14] = c3[2]; S[15] = c3[3];
#pragma unroll
    for (int d0 = 0; d0 < 4; ++d0) S = __builtin_amdgcn_mfma_f32_32x32x16_bf16(kf[d0], qr[d0], S, 0, 0, 0);
    if (MODE == 1) {
#pragma unroll
        for (int r = 0; r < 16; ++r) { const int key = kv0 + (r & 7) + 8 * hi + 16 * (r >> 3); if (key > q) S[r] = -INFINITY; }
    }
    float rm = fmaxf(fmaxf(S[0], S[1]), fmaxf(S[2], S[3]));
#pragma unroll
    for (int r = 4; r < 16; r += 4) rm = fmaxf(rm, fmaxf(fmaxf(S[r], S[r + 1]), fmaxf(S[r + 2], S[r + 3])));
    { const auto rr = __builtin_amdgcn_permlane32_swap(__float_as_uint(rm), __float_as_uint(rm), false, false); rm = fmaxf(__uint_as_float(rr[0]), __uint_as_float(rr[1])); }
    if (__any(rm > m)) {
        const float mn = fmaxf(fmaxf(m, rm), -1e30f); const float alpha = __builtin_amdgcn_exp2f(m - mn);
        l *= alpha; O0 *= alpha; O1 *= alpha; m = mn; }
    float p[16]; float ps = 0.f;
#pragma unroll
    for (int r = 0; r < 16; ++r) { p[r] = __builtin_amdgcn_exp2f(S[r] - m); ps += p[r]; }
    l += ps;
    u32x4 w0, w1;
    w0.x = pk2(p[0], p[1]); w0.y = pk2(p[2], p[3]); w0.z = pk2(p[4], p[5]); w0.w = pk2(p[6], p[7]);
    w1.x = pk2(p[8], p[9]); w1.y = pk2(p[10], p[11]); w1.z = pk2(p[12], p[13]); w1.w = pk2(p[14], p[15]);
    const bf16x8 pf0 = __builtin_bit_cast(bf16x8, w0), pf1 = __builtin_bit_cast(bf16x8, w1);
    O0 = __builtin_amdgcn_mfma_f32_32x32x16_bf16(vf[0][0], pf0, O0, 0, 0, 0); O0 = __builtin_amdgcn_mfma_f32_32x32x16_bf16(vf[1][0], pf1, O0, 0, 0, 0);
    O1 = __builtin_amdgcn_mfma_f32_32x32x16_bf16(vf[0][1], pf0, O1, 0, 0, 0); O1 = __builtin_amdgcn_mfma_f32_32x32x16_bf16(vf[1][1], pf1, O1, 0, 0, 0);
}
__device__ __forceinline__ void attn_fox_unit(Frame& F, const bf16_t* Qh, const bf16_t* Kh, const bf16_t* Vth, const float* CFh, const int qb, bf16_t* AOp) {
    const int lane = opaque_i(F.lane), r32 = lane & 31, hi = lane >> 5, r32p = pi32(r32), wave = F.wave, q0 = 256 * qb + 32 * wave, q = q0 + r32;
    LAS unsigned char* ring = F.lds; const unsigned ring_a = (unsigned)(uintptr_t)ring + 16u * (unsigned)lane, cf_a = (unsigned)(uintptr_t)ring + (unsigned)AT_CF + 32u * (unsigned)hi;
    bf16x8 qr[4];
#pragma unroll
    for (int d0 = 0; d0 < 4; ++d0) qr[d0] = *(const bf16x8*)(Qh + (size_t)q * 64 + 16 * d0 + 8 * hi);
    { const f32x4 cv = *(const f32x4*)(CFh + 4 * F.tid); *(LAS f32x4*)(ring + AT_CF + 16 * F.tid) = -cv; }
    asm volatile("s_waitcnt vmcnt(0) lgkmcnt(0)" ::: "memory"); __builtin_amdgcn_s_barrier();
    const int NT = 4 * qb + 4, my_last = 4 * qb + (wave >> 1), jdiag = wave & 1;
    attn_dma_tile(Kh, Vth, NT - 1, ring, wave, r32, r32p, hi);
    attn_dma_tile(Kh, Vth, NT - 2, ring + AT_SLOT, wave, r32, r32p, hi);
    attn_dma_tile(Kh, Vth, NT - 3, ring + 2 * AT_SLOT, wave, r32, r32p, hi);
    f32x16 O0 = f32x16{}, O1 = f32x16{}; float m = -INFINITY, l = 0.f;
    int slot = 0;
#pragma unroll 1
    for (int T = NT - 1; T >= 0; --T) {
        if (T >= 2) asm volatile("s_waitcnt vmcnt(4)" ::: "memory"); else if (T == 1) asm volatile("s_waitcnt vmcnt(2)" ::: "memory"); else asm volatile("s_waitcnt vmcnt(0)" ::: "memory");
        __builtin_amdgcn_s_barrier();
        if (T >= 3) { const int fs = (slot + 3) & 3; attn_dma_tile(Kh, Vth, T - 3, ring + fs * AT_SLOT, wave, r32, r32p, hi); }
        if (T <= my_last) {
            const unsigned sa = ring_a + (unsigned)(slot * AT_SLOT);
            if (T == my_last) {
                if (jdiag == 1) { attn_fox_sub<1>(qr, O0, O1, m, l, sa, cf_a + 4u * (unsigned)(64 * T + 32), 1, 64 * T + 32, q, hi); attn_fox_sub<0>(qr, O0, O1, m, l, sa, cf_a + 4u * (unsigned)(64 * T), 0, 64 * T, q, hi); }
                else attn_fox_sub<1>(qr, O0, O1, m, l, sa, cf_a + 4u * (unsigned)(64 * T), 0, 64 * T, q, hi);
            } else { attn_fox_sub<0>(qr, O0, O1, m, l, sa, cf_a + 4u * (unsigned)(64 * T + 32), 1, 64 * T + 32, q, hi); attn_fox_sub<0>(qr, O0, O1, m, l, sa, cf_a + 4u * (unsigned)(64 * T), 0, 64 * T, q, hi); }
        }
        slot = (slot + 1) & 3;
    }
    const float linv = 1.f / (l + __shfl_xor(l, 32));
    bf16_t* orow = AOp + (size_t)q * DM;
#pragma unroll
    for (int g = 0; g < 4; ++g) { u32x2 w;
        w.x = pk2(O0[4 * g] * linv, O0[4 * g + 1] * linv); w.y = pk2(O0[4 * g + 2] * linv, O0[4 * g + 3] * linv); *(u32x2*)(orow + 8 * g + 4 * hi) = w;
        w.x = pk2(O1[4 * g] * linv, O1[4 * g + 1] * linv); w.y = pk2(O1[4 * g + 2] * linv, O1[4 * g + 3] * linv); *(u32x2*)(orow + 32 + 8 * g + 4 * hi) = w; }
    asm volatile("s_waitcnt vmcnt(0) lgkmcnt(0)" ::: "memory"); __builtin_amdgcn_s_barrier();
}
__device__ __forceinline__ void phase_attn_fox(Frame& F, const bf16_t* QH, const bf16_t* KH, const bf16_t* VT, const float* LF, float* CF, bf16_t* AO) {
    for (int ug = F.vcu; ug < NB * 8 * 2; ug += F.G) {
        const int bh = ug >> 1, b = bh >> 3, h = bh & 7; const size_t hb = (size_t)(b * 16 + h);
        cfscan_block(F, LF, CF, bh);
#pragma unroll 1
        for (int i = 0; i < 4; ++i) { const int base = (i >> 1) * 2 + (ug & 1), qb = (i & 1) ? 7 - base : base;
            attn_fox_unit(F, QH + hb * 2048 * 64, KH + hb * 2048 * 64, VT + hb * 64 * 2048, CF + (size_t)bh * 2048, qb, AO + (size_t)b * 2048 * DM + h * 64); }
    }
}

template <int MODE>
__device__ __forceinline__ void attn_moba_sub(const bf16x8 (&qr)[4], f32x16& O0, f32x16& O1, float& m, float& l, unsigned saddr, int j, int kv0, int q, int q0, int hi, float slope2, bool rowok) {
    bf16x8 kf[4], vf[2][2];
    asm volatile("ds_read_b128 %0, %8\n\tds_read_b128 %1, %8 offset:1024\n\tds_read_b128 %2, %8 offset:2048\n\tds_read_b128 %3, %8 offset:3072\n\t"
                 "ds_read_b128 %4, %9\n\tds_read_b128 %5, %9 offset:1024\n\tds_read_b128 %6, %9 offset:2048\n\tds_read_b128 %7, %9 offset:3072\n\ts_waitcnt lgkmcnt(0)"
                 : "=&v"(kf[0]), "=&v"(kf[1]), "=&v"(kf[2]), "=&v"(kf[3]), "=&v"(vf[0][0]), "=&v"(vf[0][1]), "=&v"(vf[1][0]), "=&v"(vf[1][1])
                 : "v"(saddr + (unsigned)j * 4096u), "v"(saddr + 8192u + (unsigned)j * 4096u) : "memory");
    f32x16 S; const float sbase = slope2 * (float)(kv0 + 8 * hi - q0);
#pragma unroll
    for (int r = 0; r < 16; ++r) S[r] = sbase + slope2 * (float)((r & 7) + 16 * (r >> 3));
#pragma unroll
    for (int d0 = 0; d0 < 4; ++d0) S = __builtin_amdgcn_mfma_f32_32x32x16_bf16(kf[d0], qr[d0], S, 0, 0, 0);
    if (MODE == 1) {
#pragma unroll
        for (int r = 0; r < 16; ++r) { const int key = kv0 + (r & 7) + 8 * hi + 16 * (r >> 3); if (key > q) S[r] = -INFINITY; }
    }
    if (MODE == 2) { if (!rowok) {
#pragma unroll
        for (int r = 0; r < 16; ++r) S[r] = -INFINITY; } }
    float rm = fmaxf(fmaxf(S[0], S[1]), fmaxf(S[2], S[3]));
#pragma unroll
    for (int r = 4; r < 16; r += 4) rm = fmaxf(rm, fmaxf(fmaxf(S[r], S[r + 1]), fmaxf(S[r + 2], S[r + 3])));
    { const auto rr = __builtin_amdgcn_permlane32_swap(__float_as_uint(rm), __float_as_uint(rm), false, false); rm = fmaxf(__uint_as_float(rr[0]), __uint_as_float(rr[1])); }
    if (__any(rm > m)) { const float mn = fmaxf(fmaxf(m, rm), -1e30f); const float alpha = __builtin_amdgcn_exp2f(m - mn); l *= alpha; O0 *= alpha; O1 *= alpha; m = mn; }
    float p[16]; float ps = 0.f;
#pragma unroll
    for (int r = 0; r < 16; ++r) { p[r] = __builtin_amdgcn_exp2f(S[r] - m); ps += p[r]; }
    l += ps;
    u32x4 w0, w1;
    w0.x = pk2(p[0], p[1]); w0.y = pk2(p[2], p[3]); w0.z = pk2(p[4], p[5]); w0.w = pk2(p[6], p[7]);
    w1.x = pk2(p[8], p[9]); w1.y = pk2(p[10], p[11]); w1.z = pk2(p[12], p[13]); w1.w = pk2(p[14], p[15]);
    const bf16x8 pf0 = __builtin_bit_cast(bf16x8, w0), pf1 = __builtin_bit_cast(bf16x8, w1);
    O0 = __builtin_amdgcn_mfma_f32_32x32x16_bf16(vf[0][0], pf0, O0, 0, 0, 0); O0 = __builtin_amdgcn_mfma_f32_32x32x16_bf16(vf[1][0], pf1, O0, 0, 0, 0);
    O1 = __builtin_amdgcn_mfma_f32_32x32x16_bf16(vf[0][1], pf0, O1, 0, 0, 0); O1 = __builtin_amdgcn_mfma_f32_32x32x16_bf16(vf[1][1], pf1, O1, 0, 0, 0);
}
__device__ __forceinline__ void attn_moba_unit(Frame& F, const bf16_t* Qh, const bf16_t* Kh, const bf16_t* Vth, const float* KMh, const float slope2, const int qb, bf16_t* AOp) {
    const int lane = opaque_i(F.lane), r32 = lane & 31, hi = lane >> 5, r32p = pi32(r32), wave = F.wave, q0 = 256 * qb + 32 * wave, q = q0 + r32;
    LAS unsigned char* ring = F.lds; const unsigned ring_a = (unsigned)(uintptr_t)ring + 16u * (unsigned)lane;
    bf16x8 qr[4];
#pragma unroll
    for (int d0 = 0; d0 < 4; ++d0) qr[d0] = *(const bf16x8*)(Qh + (size_t)q * 64 + 16 * d0 + 8 * hi);
    f32x16 G = f32x16{};
#pragma unroll
    for (int d0 = 0; d0 < 4; ++d0) { u32x4 kw = {0u, 0u, 0u, 0u};
        if (r32 < 8) { const float* kmp = KMh + r32 * 64 + 16 * d0 + 8 * hi; kw = pack8(*(const f32x4*)kmp, *(const f32x4*)(kmp + 4)); }
        G = __builtin_amdgcn_mfma_f32_32x32x16_bf16(__builtin_bit_cast(bf16x8, kw), qr[d0], G, 0, 0, 0); }
    float gate[8];
#pragma unroll
    for (int n = 0; n < 4; ++n) { const float own = G[n], oth = __shfl_xor(own, 32); gate[n] = hi ? oth : own; gate[n + 4] = hi ? own : oth; }
    unsigned sel = 0u; const int nsel = qb < 3 ? qb : 3;
#pragma unroll
    for (int r = 0; r < 3; ++r) if (r < nsel) { float best = -INFINITY; int bi = 0;
#pragma unroll
        for (int n = 0; n < 8; ++n) if (n < qb && !((sel >> n) & 1u) && gate[n] > best) { best = gate[n]; bi = n; }
        sel |= 1u << bi; }
    unsigned wsel = 0u;
#pragma unroll
    for (int n = 0; n < 8; ++n) if (__any((sel >> n) & 1u)) wsel |= 1u << n;
    asm volatile("s_waitcnt vmcnt(0) lgkmcnt(0)" ::: "memory"); __builtin_amdgcn_s_barrier();
    const int NT = 4 * qb + 4, my_last = 4 * qb + (wave >> 1), jdiag = wave & 1;
    attn_dma_tile(Kh, Vth, NT - 1, ring, wave, r32, r32p, hi);
    attn_dma_tile(Kh, Vth, NT - 2, ring + AT_SLOT, wave, r32, r32p, hi);
    attn_dma_tile(Kh, Vth, NT - 3, ring + 2 * AT_SLOT, wave, r32, r32p, hi);
    f32x16 O0 = f32x16{}, O1 = f32x16{}; float m = -INFINITY, l = 0.f;
    int slot = 0;
#pragma unroll 1
    for (int T = NT - 1; T >= 0; --T) {
        if (T >= 2) asm volatile("s_waitcnt vmcnt(4)" ::: "memory"); else if (T == 1) asm volatile("s_waitcnt vmcnt(2)" ::: "memory"); else asm volatile("s_waitcnt vmcnt(0)" ::: "memory");
        __builtin_amdgcn_s_barrier();
        if (T >= 3) { const int fs = (slot + 3) & 3; attn_dma_tile(Kh, Vth, T - 3, ring + fs * AT_SLOT, wave, r32, r32p, hi); }
        const unsigned sa = ring_a + (unsigned)(slot * AT_SLOT);
        if (T >= 4 * qb) {
            if (T == my_last) {
                if (jdiag == 1) { attn_moba_sub<1>(qr, O0, O1, m, l, sa, 1, 64 * T + 32, q, q0, hi, slope2, true); attn_moba_sub<0>(qr, O0, O1, m, l, sa, 0, 64 * T, q, q0, hi, slope2, true); }
                else attn_moba_sub<1>(qr, O0, O1, m, l, sa, 0, 64 * T, q, q0, hi, slope2, true);
            } else if (T < my_last) { attn_moba_sub<0>(qr, O0, O1, m, l, sa, 1, 64 * T + 32, q, q0, hi, slope2, true); attn_moba_sub<0>(qr, O0, O1, m, l, sa, 0, 64 * T, q, q0, hi, slope2, true); }
        } else if ((wsel >> (T >> 2)) & 1u) {
            const bool rowok = (sel >> (T >> 2)) & 1u;
            attn_moba_sub<2>(qr, O0, O1, m, l, sa, 1, 64 * T + 32, q, q0, hi, slope2, rowok); attn_moba_sub<2>(qr, O0, O1, m, l, sa, 0, 64 * T, q, q0, hi, slope2, rowok);
        }
        slot = (slot + 1) & 3;
    }
    const float linv = 1.f / (l + __shfl_xor(l, 32));
    bf16_t* orow = AOp + (size_t)q * DM;
#pragma unroll
    for (int g = 0; g < 4; ++g) { u32x2 w;
        w.x = pk2(O0[4 * g] * linv, O0[4 * g + 1] * linv); w.y = pk2(O0[4 * g + 2] * linv, O0[4 * g + 3] * linv); *(u32x2*)(orow + 8 * g + 4 * hi) = w;
        w.x = pk2(O1[4 * g] * linv, O1[4 * g + 1] * linv); w.y = pk2(O1[4 * g + 2] * linv, O1[4 * g + 3] * linv); *(u32x2*)(orow + 32 + 8 * g + 4 * hi) = w; }
    asm volatile("s_waitcnt vmcnt(0) lgkmcnt(0)" ::: "memory"); __builtin_amdgcn_s_barrier();
}
__device__ __forceinline__ void phase_attn_moba(Frame& F, const bf16_t* QD, const bf16_t* KD, const bf16_t* VTD, float* KMEAN, bf16_t* AO) {
    for (int ug = F.vcu; ug < NB * 8 * 2; ug += F.G) {
        const int bh = ug >> 1, b = bh >> 3, h = bh & 7; const size_t hb = (size_t)bh;
        phase_kmean(F, KD, KMEAN, bh); asm volatile("s_waitcnt vmcnt(0)" ::: "memory"); __syncthreads();
        const float slope2 = __builtin_amdgcn_exp2f(-(float)(h + 1)) * LOG2E;
#pragma unroll 1
        for (int i = 0; i < 4; ++i) { const int base = (i >> 1) * 2 + (ug & 1), qb = (i & 1) ? 7 - base : base;
            attn_moba_unit(F, QD + hb * 2048 * 64, KD + hb * 2048 * 64, VTD + hb * 64 * 2048, KMEAN + (size_t)bh * 8 * 64, slope2, qb, AO + (size_t)b * 2048 * DM + 512 + h * 64); }
    }
}
__device__ __forceinline__ void phase_pool(Frame& F, const bf16_t* XC, const bf16_t* PWT, const float* pool_scale, bf16_t* AO) {
    const int gw = F.vcu * NWAVES + F.wave, NGW = F.G * NWAVES, lane = opaque_i(F.lane), r32 = lane & 31, hi = lane >> 5;
    for (int it = gw; it < (TOK / 32) * 4; it += NGW) {
        const int rnd = it / NGW, gq = it - rnd * NGW;
        const int g = (rnd & 1) ? 3 - (gq & 3) : (gq & 3), t0 = (rnd * (NGW >> 2) + (gq >> 2)) * 32, t = t0 + r32, tl = t & 2047, w = 2 << g;
        const int cnt = (tl + 1) < w ? (tl + 1) : w; const float rc = 1.f / (float)cnt;
        f32x16 acc[4];
#pragma unroll
        for (int nb = 0; nb < 4; ++nb) acc[nb] = f32x16{};
#pragma unroll 1
        for (int kk = 0; kk < 8; ++kk) {
            const int c0 = g * 128 + kk * 16 + hi * 8;
            const u32x4 self = *(const u32x4*)(XC + (size_t)t * 512 + c0);
            float s[8] = {0.f, 0.f, 0.f, 0.f, 0.f, 0.f, 0.f, 0.f};
            for (int i = 0; i < cnt; ++i) { const u32x4 x = *(const u32x4*)(XC + (size_t)(t - i) * 512 + c0);
                s[0] += bf_lo(x.x); s[1] += bf_hi(x.x); s[2] += bf_lo(x.y); s[3] += bf_hi(x.y); s[4] += bf_lo(x.z); s[5] += bf_hi(x.z); s[6] += bf_lo(x.w); s[7] += bf_hi(x.w); }
            u32x4 pa; pa.x = pk2(s[0] * rc - bf_lo(self.x), s[1] * rc - bf_hi(self.x)); pa.y = pk2(s[2] * rc - bf_lo(self.y), s[3] * rc - bf_hi(self.y));
            pa.z = pk2(s[4] * rc - bf_lo(self.z), s[5] * rc - bf_hi(self.z)); pa.w = pk2(s[6] * rc - bf_lo(self.w), s[7] * rc - bf_hi(self.w));
            const bf16x8 af = __builtin_bit_cast(bf16x8, pa);
#pragma unroll
            for (int nb = 0; nb < 4; ++nb) { const bf16x8 bfr = *(const bf16x8*)(PWT + ((size_t)g * 128 + nb * 32 + r32) * 128 + kk * 16 + hi * 8);
                acc[nb] = __builtin_amdgcn_mfma_f32_32x32x16_bf16(af, bfr, acc[nb], 0, 0, 0); }
        }
#pragma unroll
        for (int nb = 0; nb < 4; ++nb) { const int col = g * 128 + nb * 32 + r32; const float sc = pool_scale[col];
#pragma unroll
            for (int r = 0; r < 16; ++r) { const int row = (r & 3) + 8 * (r >> 2) + 4 * hi; AO[(size_t)(t0 + row) * DM + col] = (bf16_t)f2bf(acc[nb][r] * sc); } }
    }
}

__device__ __forceinline__ void phase_topk_naive(Frame& F, const bf16_t* QP, const bf16_t* K1B, const bf16_t* K2B, unsigned short* EID, float* GATE) {
    const int gw = F.vcu * NWAVES + F.wave, NGW = F.G * NWAVES, lane = opaque_i(F.lane);
    for (int task = gw; task < TOK * 8; task += NGW) {
        const int t = task >> 3, h = task & 7;
        const bf16_t* qrow = QP + (size_t)t * 2048 + h * 256; const bf16_t* k1 = K1B + (size_t)h * 128 * 128; const bf16_t* k2 = K2B + (size_t)h * 128 * 128;
        float s1a = 0.f, s1b = 0.f, s2a = 0.f, s2b = 0.f;
#pragma unroll 4
        for (int c = 0; c < 16; ++c) { const u32x4 q1 = *(const u32x4*)(qrow + 8 * c), q2 = *(const u32x4*)(qrow + 128 + 8 * c);
            s1a = dot8(*(const u32x4*)(k1 + (size_t)lane * 128 + 8 * c), q1, s1a); s1b = dot8(*(const u32x4*)(k1 + (size_t)(lane + 64) * 128 + 8 * c), q1, s1b);
            s2a = dot8(*(const u32x4*)(k2 + (size_t)lane * 128 + 8 * c), q2, s2a); s2b = dot8(*(const u32x4*)(k2 + (size_t)(lane + 64) * 128 + 8 * c), q2, s2b); }
        unsigned A = (f2ord(s1a) & ~127u) | (unsigned)(127 - lane), B = (f2ord(s1b) & ~127u) | (unsigned)(63 - lane);
        unsigned top1 = 0u, top2 = 0u, topc = 0u;
        for (int r = 0; r < 16; ++r) { const unsigned m = wave_umax(A > B ? A : B); if (lane == r) top1 = m; if (A == m) A = 0u; if (B == m) B = 0u; }
        A = (f2ord(s2a) & ~127u) | (unsigned)(127 - lane); B = (f2ord(s2b) & ~127u) | (unsigned)(63 - lane);
        for (int r = 0; r < 16; ++r) { const unsigned m = wave_umax(A > B ? A : B); if (lane == r) top2 = m; if (A == m) A = 0u; if (B == m) B = 0u; }
        const float v1 = ord2f(top1 & ~127u), v2 = ord2f(top2 & ~127u); const int i1 = 127 - (int)(top1 & 127u), i2 = 127 - (int)(top2 & 127u);
        const float va = __shfl(v1, lane >> 2); unsigned C[4];
#pragma unroll
        for (int j = 0; j < 4; ++j) { const float vb = __shfl(v2, (lane & 3) * 4 + j); C[j] = (f2ord(va + vb) & ~255u) | (unsigned)(255 - (lane * 4 + j)); }
        for (int r = 0; r < 16; ++r) { unsigned m = C[0] > C[1] ? C[0] : C[1]; const unsigned m2 = C[2] > C[3] ? C[2] : C[3]; m = wave_umax(m > m2 ? m : m2); if (lane == r) topc = m;
#pragma unroll
            for (int j = 0; j < 4; ++j) if (C[j] == m) C[j] = 0u; }
        const int c = 255 - (int)(topc & 255u); const float val = ord2f(topc & ~255u);
        const int ia = __shfl(i1, c >> 4), ib = __shfl(i2, c & 15);
        const float v0 = __shfl(val, 0); const float e = (lane < 16) ? __expf(val - v0) : 0.f; const float sum = wave_sum(e);
        if (lane < 16) { EID[(size_t)t * 128 + h * 16 + lane] = (unsigned short)(ia * 128 + ib); GATE[(size_t)t * 128 + h * 16 + lane] = e / sum; }
    }
}

#define DEVFN __device__ __forceinline__
template <int OFF, int N, int TOT> DEVFN void bitonic_sort_desc(unsigned (&a)[TOT]) {
#pragma unroll
    for (int k = 2; k <= N; k <<= 1)
#pragma unroll
        for (int j = k >> 1; j > 0; j >>= 1)
#pragma unroll
            for (int i = 0; i < N; ++i) { const int l = i ^ j; if (l > i) { const bool desc = ((i & k) == 0); const unsigned x = a[OFF + i], y = a[OFF + l];
                const unsigned mx = x > y ? x : y, mn = x > y ? y : x; a[OFF + i] = desc ? mx : mn; a[OFF + l] = desc ? mn : mx; } }
}
constexpr int OE16_N = 63;
constexpr unsigned char OE16[63][2] = {{0,1}, {2,3}, {0,2}, {1,3}, {1,2}, {4,5}, {6,7}, {4,6}, {5,7}, {5,6}, {0,4}, {2,6}, {2,4}, {1,5}, {3,7}, {3,5}, {1,2}, {3,4}, {5,6}, {8,9}, {10,11}, {8,10}, {9,11}, {9,10}, {12,13}, {14,15}, {12,14}, {13,15}, {13,14}, {8,12}, {10,14}, {10,12}, {9,13}, {11,15}, {11,13}, {9,10}, {11,12}, {13,14}, {0,8}, {4,12}, {4,8}, {2,10}, {6,14}, {6,10}, {2,4}, {6,8}, {10,12}, {1,9}, {5,13}, {5,9}, {3,11}, {7,15}, {7,11}, {3,5}, {7,9}, {11,13}, {1,2}, {3,4}, {5,6}, {7,8}, {9,10}, {11,12}, {13,14}};
template <int OFF, int TOT> DEVFN void sort16_desc(unsigned (&a)[TOT]) {
#pragma unroll
    for (int q = 0; q < OE16_N; ++q) { const int i = OFF + OE16[q][0], l = OFF + OE16[q][1]; const unsigned x = a[i], y = a[l]; a[i] = x > y ? x : y; a[l] = x > y ? y : x; }
}
template <int OFF, int TOT> DEVFN void bitonic_merge16_desc(unsigned (&a)[TOT]) {
#pragma unroll
    for (int j = 8; j > 0; j >>= 1)
#pragma unroll
        for (int i = 0; i < 16; ++i) { const int l = i ^ j; if (l > i) { const unsigned x = a[OFF + i], y = a[OFF + l]; a[OFF + i] = x > y ? x : y; a[OFF + l] = x > y ? y : x; } }
}
template <int A, int B, int TOT> DEVFN void merge_top16(unsigned (&a)[TOT]) {
#pragma unroll
    for (int i = 0; i < 16; ++i) { const unsigned x = a[A + i], y = a[B + 15 - i]; a[A + i] = x > y ? x : y; }
    bitonic_merge16_desc<A, TOT>(a);
}
DEVFN void top16of64(unsigned (&a)[64]) {
    sort16_desc<0, 64>(a); sort16_desc<16, 64>(a); sort16_desc<32, 64>(a); sort16_desc<48, 64>(a);
    merge_top16<0, 16, 64>(a); merge_top16<32, 48, 64>(a); merge_top16<0, 32, 64>(a);
}

constexpr int TK_KSTRIDE = 272, TK_KSET = 128 * TK_KSTRIDE, TK_KBYTES = 2 * TK_KSET;
__device__ __forceinline__ void phase_topk(Frame& F, const bf16_t* QP, const bf16_t* K1B, const bf16_t* K2B, unsigned short* EID, float* GATE) {
    const int lane = opaque_i(F.lane), r32 = lane & 31, hi = lane >> 5, b = (int)blockIdx.x, h = b & 7, nbh = F.G >> 3;
    for (int c = F.tid; c < 2 * 128 * 16; c += NWAVES * 64) { const int sub = c >> 11, n = (c >> 4) & 127, part = c & 15;
        *(LAS u32x4*)(F.lds + sub * TK_KSET + n * TK_KSTRIDE + 16 * part) = *(const u32x4*)((sub ? K2B : K1B) + ((size_t)h * 128 + n) * 128 + 8 * part); }
    __syncthreads();
    LAS unsigned* I1s = (LAS unsigned*)(F.lds + TK_KBYTES + F.wave * 8192); LAS unsigned* I2s = I1s + 1024;
    bf16x8 qn[8];
    { const int tile0 = (b >> 3) + nbh * F.wave; const bf16_t* qrow = QP + (size_t)((tile0 < TOK / 32 ? tile0 : 0) * 32 + r32) * 2048 + h * 256 + 8 * hi;
#pragma unroll
      for (int kk = 0; kk < 8; ++kk) qn[kk] = *(const bf16x8*)(qrow + 16 * kk); }
    for (int tile = (b >> 3) + nbh * F.wave; tile < TOK / 32; tile += nbh * NWAVES) {
        const int t = tile * 32 + r32;
        unsigned V1[16], V2[16]; unsigned h4 = (unsigned)hi << 2; asm volatile("" : "+v"(h4));
#pragma unroll
        for (int half = 0; half < 2; ++half) {
            bf16x8 qf[8];
#pragma unroll
            for (int kk = 0; kk < 8; ++kk) qf[kk] = qn[kk];
            { const int tnx = tile + nbh * NWAVES, tl = half ? (tnx < TOK / 32 ? tnx : tile) : tile;
              const bf16_t* qrow = QP + (size_t)(tl * 32 + r32) * 2048 + h * 256 + (half ? 0 : 128) + 8 * hi;
#pragma unroll
              for (int kk = 0; kk < 8; ++kk) qn[kk] = *(const bf16x8*)(qrow + 16 * kk); }
            unsigned K[64];
#pragma unroll
            for (int nb = 0; nb < 4; ++nb) { f32x16 acc = f32x16{};
                LAS const unsigned char* kb = F.lds + half * TK_KSET + (nb * 32 + r32) * TK_KSTRIDE + 16 * hi; asm volatile("" : "+v"(kb));
#pragma unroll
                for (int kk = 0; kk < 8; ++kk) acc = __builtin_amdgcn_mfma_f32_32x32x16_bf16(*(LAS const bf16x8*)(kb + 32 * kk), qf[kk], acc, 0, 0, 0);
#pragma unroll
                for (int r = 0; r < 16; ++r) {
                    const unsigned x = __float_as_uint(acc[r]), o = x ^ ((unsigned)((int)x >> 31) | 0x80000000u); const int j = r >> 2;
                    const unsigned pack = (unsigned)(127 - (nb * 32 + 0 + 8 * j)) | ((unsigned)(127 - (nb * 32 + 1 + 8 * j)) << 8) | ((unsigned)(127 - (nb * 32 + 2 + 8 * j)) << 16) | ((unsigned)(127 - (nb * 32 + 3 + 8 * j)) << 24);
                    K[nb * 16 + r] = __builtin_amdgcn_perm(o, pack, 0x07060500u | (unsigned)(r & 3)); }
                __builtin_amdgcn_sched_barrier(0); }
            __builtin_amdgcn_sched_barrier(0); top16of64(K); __builtin_amdgcn_sched_barrier(0);
#pragma unroll
            for (int i = 0; i < 16; ++i) K[i] ^= h4;
            unsigned C[16];
#pragma unroll
            for (int i = 0; i < 16; ++i) { const unsigned y = (unsigned)__shfl_xor((int)K[15 - i], 32); C[i] = K[i] > y ? K[i] : y; }
            bitonic_merge16_desc<0, 16>(C);
#pragma unroll
            for (int i = 0; i < 16; ++i) { if (half == 0) V1[i] = C[i]; else V2[i] = C[i]; }
            __builtin_amdgcn_sched_barrier(0);
        }
        float f1[16], f2[16];
#pragma unroll
        for (int a = 0; a < 16; ++a) { I1s[a * 64 + lane] = 127u - (V1[a] & 127u); I2s[a * 64 + lane] = 127u - (V2[a] & 127u); f1[a] = ord2f(V1[a] & ~127u); f2[a] = ord2f(V2[a] & ~127u); }
        __builtin_amdgcn_sched_barrier(0);
        unsigned Cd[64];
    Cd[0] = (f2ord(f1[0] + f2[0]) & ~255u) | 255u;
    Cd[1] = (f2ord(f1[0] + f2[1]) & ~255u) | 254u;
    Cd[2] = (f2ord(f1[0] + f2[2]) & ~255u) | 253u;
    Cd[3] = (f2ord(f1[0] + f2[3]) & ~255u) | 252u;
    Cd[4] = (f2ord(f1[0] + f2[4]) & ~255u) | 251u;
    Cd[5] = (f2ord(f1[0] + f2[5]) & ~255u) | 250u;
    Cd[6] = (f2ord(f1[0] + f2[6]) & ~255u) | 249u;
    Cd[7] = (f2ord(f1[0] + f2[7]) & ~255u) | 248u;
    Cd[8] = (f2ord(f1[0] + f2[8]) & ~255u) | 247u;
    Cd[9] = (f2ord(f1[0] + f2[9]) & ~255u) | 246u;
    Cd[10] = (f2ord(f1[0] + f2[10]) & ~255u) | 245u;
    Cd[11] = (f2ord(f1[0] + f2[11]) & ~255u) | 244u;
    Cd[12] = (f2ord(f1[0] + f2[12]) & ~255u) | 243u;
    Cd[13] = (f2ord(f1[0] + f2[13]) & ~255u) | 242u;
    Cd[14] = (f2ord(f1[0] + f2[14]) & ~255u) | 241u;
    Cd[15] = (f2ord(f1[0] + f2[15]) & ~255u) | 240u;
    Cd[16] = (f2ord(f1[1] + f2[0]) & ~255u) | 239u;
    Cd[17] = (f2ord(f1[1] + f2[1]) & ~255u) | 238u;
    Cd[18] = (f2ord(f1[1] + f2[2]) & ~255u) | 237u;
    Cd[19] = (f2ord(f1[1] + f2[3]) & ~255u) | 236u;
    Cd[20] = (f2ord(f1[1] + f2[4]) & ~255u) | 235u;
    Cd[21] = (f2ord(f1[1] + f2[5]) & ~255u) | 234u;
    Cd[22] = (f2ord(f1[1] + f2[6]) & ~255u) | 233u;
    Cd[23] = (f2ord(f1[1] + f2[7]) & ~255u) | 232u;
    Cd[24] = (f2ord(f1[2] + f2[0]) & ~255u) | 223u;
    Cd[25] = (f2ord(f1[2] + f2[1]) & ~255u) | 222u;
    Cd[26] = (f2ord(f1[2] + f2[2]) & ~255u) | 221u;
    Cd[27] = (f2ord(f1[2] + f2[3]) & ~255u) | 220u;
    Cd[28] = (f2ord(f1[2] + f2[4]) & ~255u) | 219u;
    Cd[29] = (f2ord(f1[3] + f2[0]) & ~255u) | 207u;
    Cd[30] = (f2ord(f1[3] + f2[1]) & ~255u) | 206u;
    Cd[31] = (f2ord(f1[3] + f2[2]) & ~255u) | 205u;
    Cd[32] = (f2ord(f1[3] + f2[3]) & ~255u) | 204u;
    Cd[33] = (f2ord(f1[4] + f2[0]) & ~255u) | 191u;
    Cd[34] = (f2ord(f1[4] + f2[1]) & ~255u) | 190u;
    Cd[35] = (f2ord(f1[4] + f2[2]) & ~255u) | 189u;
    Cd[36] = (f2ord(f1[5] + f2[0]) & ~255u) | 175u;
    Cd[37] = (f2ord(f1[5] + f2[1]) & ~255u) | 174u;
    Cd[38] = (f2ord(f1[6] + f2[0]) & ~255u) | 159u;
    Cd[39] = (f2ord(f1[6] + f2[1]) & ~255u) | 158u;
    Cd[40] = (f2ord(f1[7] + f2[0]) & ~255u) | 143u;
    Cd[41] = (f2ord(f1[7] + f2[1]) & ~255u) | 142u;
    Cd[42] = (f2ord(f1[8] + f2[0]) & ~255u) | 127u;
    Cd[43] = (f2ord(f1[9] + f2[0]) & ~255u) | 111u;
    Cd[44] = (f2ord(f1[10] + f2[0]) & ~255u) | 95u;
    Cd[45] = (f2ord(f1[11] + f2[0]) & ~255u) | 79u;
    Cd[46] = (f2ord(f1[12] + f2[0]) & ~255u) | 63u;
    Cd[47] = (f2ord(f1[13] + f2[0]) & ~255u) | 47u;
    Cd[48] = (f2ord(f1[14] + f2[0]) & ~255u) | 31u;
    Cd[49] = (f2ord(f1[15] + f2[0]) & ~255u) | 15u;
    Cd[50] = 0u;
    Cd[51] = 0u;
    Cd[52] = 0u;
    Cd[53] = 0u;
    Cd[54] = 0u;
    Cd[55] = 0u;
    Cd[56] = 0u;
    Cd[57] = 0u;
    Cd[58] = 0u;
    Cd[59] = 0u;
    Cd[60] = 0u;
    Cd[61] = 0u;
    Cd[62] = 0u;
    Cd[63] = 0u;
        __builtin_amdgcn_sched_barrier(0); top16of64(Cd); __builtin_amdgcn_sched_barrier(0);
        LDS_WAIT();
        unsigned eid[16]; float e[16]; float sum = 0.f; const float v0 = ord2f(Cd[0] & ~255u);
#pragma unroll
        for (int r = 0; r < 16; ++r) { const unsigned c = 255u - (Cd[r] & 255u); eid[r] = I1s[(c >> 4) * 64 + lane] * 128u + I2s[(c & 15u) * 64 + lane];
            e[r] = __builtin_amdgcn_exp2f((ord2f(Cd[r] & ~255u) - v0) * LOG2E); sum += e[r]; }
        const float inv = 1.f / sum;
        u32x4 ew; ew.x = (hi ? eid[8] : eid[0]) | ((hi ? eid[9] : eid[1]) << 16); ew.y = (hi ? eid[10] : eid[2]) | ((hi ? eid[11] : eid[3]) << 16);
        ew.z = (hi ? eid[12] : eid[4]) | ((hi ? eid[13] : eid[5]) << 16); ew.w = (hi ? eid[14] : eid[6]) | ((hi ? eid[15] : eid[7]) << 16);
        *(u32x4*)(EID + (size_t)t * 128 + h * 16 + 8 * hi) = ew;
        const f32x4 g0 = {(hi ? e[8] : e[0]) * inv, (hi ? e[9] : e[1]) * inv, (hi ? e[10] : e[2]) * inv, (hi ? e[11] : e[3]) * inv};
        const f32x4 g1 = {(hi ? e[12] : e[4]) * inv, (hi ? e[13] : e[5]) * inv, (hi ? e[14] : e[6]) * inv, (hi ? e[15] : e[7]) * inv};
        *(f32x4*)(GATE + (size_t)t * 128 + h * 16 + 8 * hi) = g0; *(f32x4*)(GATE + (size_t)t * 128 + h * 16 + 8 * hi + 4) = g1;
        LDS_WAIT();
    }
}

typedef float f32x2 __attribute__((ext_vector_type(2)));
__device__ __forceinline__ float dpp_f(float v, int sel) {
    const int iv = __builtin_bit_cast(int, v); int r;
    if (sel == 0) r = __builtin_amdgcn_update_dpp(0, iv, 0xB1, 0xf, 0xf, true); else if (sel == 1) r = __builtin_amdgcn_update_dpp(0, iv, 0x4E, 0xf, 0xf, true); else r = __builtin_amdgcn_update_dpp(0, iv, 0x141, 0xf, 0xf, true);
    return __builtin_bit_cast(float, r);
}
__device__ __forceinline__ float gelu_erf(float v) {
    const float av = fabsf(v), d = av * 0.2316418882f + 1.0f; const float t = __builtin_amdgcn_rcpf(d);
    float q = t * 0.5307027145f + (-0.7265760135f); q = q * t + 0.7107068705f; q = q * t + (-0.142248368f); q = q * t + 0.127414796f; q = q * t;
    const float e = __builtin_amdgcn_exp2f((v * v) * (-0.72134752044f));
    const float m = v * (q * e), r = v - m; return v < 0.f ? m : r;
}
typedef _Float16 h16x2 __attribute__((ext_vector_type(2)));
__device__ __forceinline__ h16x2 bf8_lo2(unsigned w) { return __builtin_bit_cast(h16x2, __builtin_amdgcn_perm(0u, w, 0x010c000cu)); }
__device__ __forceinline__ h16x2 bf8_hi2(unsigned w) { return __builtin_bit_cast(h16x2, __builtin_amdgcn_perm(0u, w, 0x030c020cu)); }
__device__ __forceinline__ h16x2 bf16pair_to_h2(unsigned w) { h16x2 r; r.x = (_Float16)bf_lo(w); r.y = (_Float16)bf_hi(w); return r; }
#define PEER_E(ev0_, ev1_, w_) (int)((((w_) < 8 ? (ev0_) : (ev1_))[((w_) & 7) >> 1] >> (16 * ((w_) & 1))) & 0xffffu)
#define GLD4(dst_, ptr_) asm volatile("global_load_dword %0, %1, off" : "=v"(dst_) : "v"(ptr_) : "memory")
#define GLD8(dst_, ptr_) asm volatile("global_load_dwordx2 %0, %1, off" : "=v"(dst_) : "v"(ptr_) : "memory")
#define GLD16(dst_, ptr_) asm volatile("global_load_dwordx4 %0, %1, off" : "=v"(dst_) : "v"(ptr_) : "memory")
#define GLDS16(dst_, off_, base_) asm volatile("global_load_dwordx4 %0, %1, %2" : "=v"(dst_) : "v"(off_), "s"(base_) : "memory")
typedef int i32x4 __attribute__((ext_vector_type(4)));
__device__ __forceinline__ int sdot8_z(int a, int b) { int d; asm("v_dot8_i32_i4 %0, %1, %2, 0" : "=v"(d) : "v"(a), "v"(b)); return d; }
__device__ __forceinline__ int sdot4_z(int a, int b) { int d; asm("v_dot4_i32_i8 %0, %1, %2, 0" : "=v"(d) : "v"(a), "v"(b)); return d; }
__device__ __forceinline__ unsigned u_quant4(u32x2 w, unsigned sqbits) {
    float sq = __uint_as_float(sqbits); sq += dpp_row_shr(sq, 1); sq += dpp_row_shr(sq, 2); sq += dpp_row_shr(sq, 4); sq += dpp_row_shr(sq, 8);
    sq = __builtin_bit_cast(float, __builtin_amdgcn_readlane(__builtin_bit_cast(int, sq), 15));
    const float sx = __builtin_amdgcn_rsqf(sq * (1.f / DM) + RMS_EPS) * I8_SX;
    const float v[4] = {bf_lo(w.x), bf_hi(w.x), bf_lo(w.y), bf_hi(w.y)}; unsigned A = 0u, B = 0u;
#pragma unroll
    for (int k = 0; k < 4; ++k) { int q = __float2int_rn(v[k] * sx); q = q < -120 ? -120 : (q > 119 ? 119 : q); const int a = (q + 8) >> 4, bb = q - 16 * a;
        A |= ((unsigned)a & 0xfu) << (4 * k); B |= ((unsigned)bb & 0xfu) << (4 * k); }
    return A | (B << 16);
}
template <int CP> __device__ __forceinline__ unsigned peer_bc_t(unsigned ev) { return (unsigned)__builtin_amdgcn_update_dpp(__builtin_amdgcn_update_dpp(0, (int)ev, 0x150 + CP, 0xf, 0x3, false), (int)ev, 0x158 + CP, 0xf, 0xc, false); }
__device__ __forceinline__ unsigned peer_bc(unsigned ev, int cp) {
    switch (cp) { case 0: return peer_bc_t<0>(ev); case 1: return peer_bc_t<1>(ev); case 2: return peer_bc_t<2>(ev); case 3: return peer_bc_t<3>(ev);
                  case 4: return peer_bc_t<4>(ev); case 5: return peer_bc_t<5>(ev); case 6: return peer_bc_t<6>(ev); default: return peer_bc_t<7>(ev); }
}
#define PEER_BC(ev_, cp_) peer_bc((ev_), (cp_))
#define PEER_E2(bc_, w_) (((w_) & 1) ? ((bc_) >> 16) : ((bc_) & 0xffffu))
__device__ __forceinline__ void phase_peer_u(Frame& F, const bf16_t* XB, const float* rsp, int rsmode, const unsigned short* EID, const unsigned char* U8S, int* PREP) {
    const int lane = opaque_i(F.lane), i16 = (lane >> 3) * 16, c = lane & 7, b = (int)blockIdx.x, x = b & 3, step = (F.G >> 2) * NWAVES;
    const unsigned c16 = 16u * (unsigned)c;
    const unsigned char* tabs = U8S + (size_t)x * NEXP * 128;
    LAS unsigned char* xl = F.lds + F.wave * 512;
    int t = (b >> 2) * NWAVES + F.wave; unsigned slot = 0;
    unsigned evB; u32x4 uw[16]; u32x2 xwA; unsigned sqA;
    {   unsigned e0 = *(const unsigned*)(EID + (size_t)t * 128 + i16 + 2 * c);
        u32x2 xw0 = *(const u32x2*)(XB + (size_t)t * DM + 256 * x + 4 * lane); unsigned sq0 = __float_as_uint(rsp[(size_t)t * 16 + (lane & 15)]);
        const int tn = (t + step < TOK) ? t + step : t;
        evB = *(const unsigned*)(EID + (size_t)tn * 128 + i16 + 2 * c);
        xwA = *(const u32x2*)(XB + (size_t)tn * DM + 256 * x + 4 * lane); sqA = __float_as_uint(rsp[(size_t)tn * 16 + (lane & 15)]);
        asm volatile("s_waitcnt vmcnt(0)" : "+v"(evB), "+v"(e0), "+v"(xwA), "+v"(sqA), "+v"(xw0), "+v"(sq0) :: "memory");
        { const unsigned ab = u_quant4(xw0, sq0); *(LAS unsigned short*)(xl + 2 * lane) = (unsigned short)ab; *(LAS unsigned short*)(xl + 128 + 2 * lane) = (unsigned short)(ab >> 16); }
#pragma unroll
        for (int w = 0; w < 16; w += 2) { const unsigned bc = PEER_BC(e0, w >> 1); const unsigned off0 = (PEER_E2(bc, 0) << 7) | c16, off1 = (PEER_E2(bc, 1) << 7) | c16; GLDS16(uw[w], off0, tabs); GLDS16(uw[w + 1], off1, tabs); } }
#pragma unroll 1
    for (; t < TOK; t += step) {
        const int tnn = (t + 2 * step < TOK) ? t + 2 * step : t;
        unsigned evC, sqC, bcw = 0u; u32x2 xwC;
        { const unsigned short* ep = EID + (size_t)tnn * 128 + i16 + 2 * c; const bf16_t* xp = XB + (size_t)tnn * DM + 256 * x + 4 * lane; const float* sp = rsp + (size_t)tnn * 16 + (lane & 15);
          GLD4(evC, ep); GLD8(xwC, xp); GLD4(sqC, sp); }
        { const unsigned ab = u_quant4(xwA, sqA); *(LAS unsigned short*)(xl + (slot ^ 256u) + 2 * lane) = (unsigned short)ab; *(LAS unsigned short*)(xl + (slot ^ 256u) + 128 + 2 * lane) = (unsigned short)(ab >> 16); }
        const u32x4 xa = *(LAS const u32x4*)(xl + slot + c16), xb = *(LAS const u32x4*)(xl + slot + 128 + c16);
        slot ^= 256u;
        int p[16];
#pragma unroll
        for (int w = 0; w < 16; ++w) {
            asm volatile("s_waitcnt vmcnt(18)" : "+v"(uw[w]) :: "memory");
            int a = sdot8_z((int)uw[w][0], (int)xa[0]), bl = sdot8_z((int)uw[w][0], (int)xb[0]);
#pragma unroll
            for (int k = 1; k < 4; ++k) { a = __builtin_amdgcn_sdot8((int)uw[w][k], (int)xa[k], a, false); bl = __builtin_amdgcn_sdot8((int)uw[w][k], (int)xb[k], bl, false); }
            p[w] = (a << 4) + bl;
            asm volatile("" : "+v"(p[w]));
            if ((w & 1) == 0) bcw = PEER_BC(evB, w >> 1);
            { const unsigned off = (PEER_E2(bcw, w) << 7) | c16; GLDS16(uw[w], off, tabs); }
        }
        asm volatile("s_nop 1\n\t"
#define UA_(k_, k8_) "v_add_u32_dpp %" #k_ ", %" #k_ ", %" #k_ " row_shl:4 row_mask:0xf bank_mask:0x5\n\t" "v_add_u32_dpp %" #k_ ", %" #k8_ ", %" #k8_ " row_shr:4 row_mask:0xf bank_mask:0xa\n\t"
            UA_(0, 8) UA_(1, 9) UA_(2, 10) UA_(3, 11) UA_(4, 12) UA_(5, 13) UA_(6, 14) UA_(7, 15)
#undef UA_
#define UB_(k_) "v_add_u32_dpp %" #k_ ", %" #k_ ", %" #k_ " quad_perm:[2,3,0,1] row_mask:0xf bank_mask:0xf\n\t"
            UB_(0) UB_(1) UB_(2) UB_(3) UB_(4) UB_(5) UB_(6) UB_(7)
#undef UB_
#define UC_(k_) "v_add_u32_dpp %" #k_ ", %" #k_ ", %" #k_ " quad_perm:[1,0,3,2] row_mask:0xf bank_mask:0xf\n\t"
            UC_(0) UC_(1) UC_(2) UC_(3) UC_(4) UC_(5) UC_(6) UC_(7)
#undef UC_
            "s_nop 0"
            : "+v"(p[0]), "+v"(p[1]), "+v"(p[2]), "+v"(p[3]), "+v"(p[4]), "+v"(p[5]), "+v"(p[6]), "+v"(p[7])
            : "v"(p[8]), "v"(p[9]), "v"(p[10]), "v"(p[11]), "v"(p[12]), "v"(p[13]), "v"(p[14]), "v"(p[15]));
        if ((c & 3) == 0) {
            int* dst = PREP + ((size_t)x * TOK + t) * 128 + i16 + 2 * c;
            *(i32x4*)dst = i32x4{p[0], p[1], p[2], p[3]}; *(i32x4*)(dst + 4) = i32x4{p[4], p[5], p[6], p[7]}; }
        asm volatile("s_waitcnt vmcnt(16)" : "+v"(evC), "+v"(xwC), "+v"(sqC) :: "memory");
        evB = evC; xwA = xwC; sqA = sqC;
    }
    asm volatile("s_waitcnt vmcnt(0)" ::: "memory");
}
__device__ __forceinline__ void phase_peer_c(Frame& F, const int* PREP, const float* GATE, unsigned char* ACO8, float* ASC  ) {
    const int gw = F.vcu * NWAVES + F.wave, NGW = F.G * NWAVES, lane = opaque_i(F.lane);
    for (int t = gw; t < TOK; t += NGW) {
        int i0 = 0, i1 = 0;
#pragma unroll
        for (int x = 0; x < 4; ++x) { const int* p = PREP + ((size_t)x * TOK + t) * 128; i0 += p[lane]; i1 += p[64 + lane]; }
        const float rsu = 1.f / (I4_SU * I8_SX);
        const float a0 = gelu_erf((float)i0 * rsu) * GATE[(size_t)t * 128 + lane], a1 = gelu_erf((float)i1 * rsu) * GATE[(size_t)t * 128 + 64 + lane];
        float m = fmaxf(fabsf(a0), fabsf(a1));
#pragma unroll
        for (int o = 32; o >= 1; o >>= 1) m = fmaxf(m, __shfl_xor(m, o));
        const float inv = m > 0.f ? 127.f / m : 0.f;
        const int q0 = __float2int_rn(a0 * inv), q1 = __float2int_rn(a1 * inv);
        ACO8[(size_t)t * 128 + lane] = (unsigned char)(q0 & 0xff); ACO8[(size_t)t * 128 + 64 + lane] = (unsigned char)(q1 & 0xff);
        const float sa = wave_total((float)(q0 + q1)), scl = m * (1.f / (127.f * I4_SV));
        if (lane == 0) { ASC[2 * (size_t)t] = scl; ASC[2 * (size_t)t + 1] = 8.f * sa * scl; }
    }
}
#define PIN16(o_) asm volatile("" : "+v"(o_[0]), "+v"(o_[1]), "+v"(o_[2]), "+v"(o_[3]), "+v"(o_[4]), "+v"(o_[5]), "+v"(o_[6]), "+v"(o_[7]), "+v"(o_[8]), "+v"(o_[9]), "+v"(o_[10]), "+v"(o_[11]), "+v"(o_[12]), "+v"(o_[13]), "+v"(o_[14]), "+v"(o_[15]))
__device__ __forceinline__ void red16_groups(const int (&o)[16], bool b3, int& r0, int& r1) {
    int h8[8], h4[4];
#pragma unroll
    for (int k = 0; k < 8; ++k) { const auto r = __builtin_amdgcn_permlane32_swap((unsigned)o[k], (unsigned)o[8 + k], false, false); h8[k] = (int)r[0] + (int)r[1]; }
#pragma unroll
    for (int k = 0; k < 4; ++k) { const auto r = __builtin_amdgcn_permlane16_swap((unsigned)h8[k], (unsigned)h8[4 + k], false, false); h4[k] = (int)r[0] + (int)r[1]; }
    { const int keep = b3 ? h4[2] : h4[0], send = b3 ? h4[0] : h4[2]; r0 = keep + __builtin_amdgcn_update_dpp(0, send, 0x128, 0xf, 0xf, true); }
    { const int keep = b3 ? h4[3] : h4[1], send = b3 ? h4[1] : h4[3]; r1 = keep + __builtin_amdgcn_update_dpp(0, send, 0x128, 0xf, 0xf, true); }
}
__device__ __forceinline__ void phase_peer_v(Frame& F, bf16_t* XB, const unsigned short* EID, const unsigned char* ACO8, const float* ASC, const unsigned char* V4S, float* SSQP) {
    const int lane = opaque_i(F.lane), i16 = (lane >> 3) * 16, c = lane & 7, b = (int)blockIdx.x, x = b & 3, step = (F.G >> 2) * NWAVES;
    const unsigned c16 = 16u * (unsigned)c;
    const unsigned char* tabs = V4S + (size_t)x * NEXP * 128;
    const bool b3 = lane & 8;
    const int col = 256 * x + 32 * c + ((lane & 32) ? 16 : 0) + ((lane & 16) ? 8 : 0) + (b3 ? 4 : 0);
    int t = (b >> 2) * NWAVES + F.wave;
    u32x4 aA, vw[16]; unsigned evB; u32x2 xfA, scA;
    {   unsigned e0 = *(const unsigned*)(EID + (size_t)t * 128 + i16 + 2 * c);
        aA = *(const u32x4*)(ACO8 + (size_t)t * 128 + i16);
        xfA = *(const u32x2*)(XB + (size_t)t * DM + col); scA = *(const u32x2*)(ASC + 2 * (size_t)t);
        const int tn = (t + step < TOK) ? t + step : t;
        evB = *(const unsigned*)(EID + (size_t)tn * 128 + i16 + 2 * c);
        asm volatile("s_waitcnt vmcnt(0)" : "+v"(evB), "+v"(e0), "+v"(aA), "+v"(xfA), "+v"(scA) :: "memory");
#pragma unroll
        for (int w = 0; w < 16; w += 2) { const unsigned bc = PEER_BC(e0, w >> 1); const unsigned off0 = (PEER_E2(bc, 0) << 7) | c16, off1 = (PEER_E2(bc, 1) << 7) | c16; GLDS16(vw[w], off0, tabs); GLDS16(vw[w + 1], off1, tabs); } }
#pragma unroll 1
    for (; t < TOK; t += step) {
        const int tn = (t + step < TOK) ? t + step : t, tnn = (t + 2 * step < TOK) ? t + 2 * step : t;
        u32x4 aB; unsigned evC; u32x2 xfB, scB;
        { const unsigned short* ep = EID + (size_t)tnn * 128 + i16 + 2 * c; const unsigned char* ap = ACO8 + (size_t)tn * 128 + i16; const bf16_t* xp = XB + (size_t)tn * DM + col; const float* sp = ASC + 2 * (size_t)tn;
          GLD4(evC, ep); GLD16(aB, ap); GLD8(xfB, xp); GLD8(scB, sp); }
        int oL[16], oP[16];
#pragma unroll
        for (int w = 0; w < 16; w += 4) {
            asm volatile("s_waitcnt vmcnt(16)" : "+v"(vw[w]), "+v"(vw[w + 1]), "+v"(vw[w + 2]), "+v"(vw[w + 3]) :: "memory");
            const int a4 = (int)aA[w >> 2];
#pragma unroll
            for (int k = 0; k < 4; ++k) { const unsigned d0 = vw[w][k], d1 = vw[w + 1][k], d2 = vw[w + 2][k], d3 = vw[w + 3][k];
                const unsigned q01l = __builtin_amdgcn_perm(d1, d0, 0x05010400u), q01h = __builtin_amdgcn_perm(d1, d0, 0x07030602u), q23l = __builtin_amdgcn_perm(d3, d2, 0x05010400u), q23h = __builtin_amdgcn_perm(d3, d2, 0x07030602u);
                const int t0 = (int)__builtin_amdgcn_perm(q23l, q01l, 0x05040100u), t1 = (int)__builtin_amdgcn_perm(q23l, q01l, 0x07060302u), t2 = (int)__builtin_amdgcn_perm(q23h, q01h, 0x05040100u), t3 = (int)__builtin_amdgcn_perm(q23h, q01h, 0x07060302u);
                const int l0 = t0 & 0x0f0f0f0f, l1 = t1 & 0x0f0f0f0f, l2 = t2 & 0x0f0f0f0f, l3 = t3 & 0x0f0f0f0f;
                if (w == 0) { oL[4 * k] = sdot4_z(l0, a4); oL[4 * k + 1] = sdot4_z(l1, a4); oL[4 * k + 2] = sdot4_z(l2, a4); oL[4 * k + 3] = sdot4_z(l3, a4);
                              oP[4 * k] = sdot4_z(t0, a4); oP[4 * k + 1] = sdot4_z(t1, a4); oP[4 * k + 2] = sdot4_z(t2, a4); oP[4 * k + 3] = sdot4_z(t3, a4); }
                else { oL[4 * k]     = __builtin_amdgcn_sdot4(l0, a4, oL[4 * k], false);     oL[4 * k + 1] = __builtin_amdgcn_sdot4(l1, a4, oL[4 * k + 1], false);
                       oL[4 * k + 2] = __builtin_amdgcn_sdot4(l2, a4, oL[4 * k + 2], false); oL[4 * k + 3] = __builtin_amdgcn_sdot4(l3, a4, oL[4 * k + 3], false);
                       oP[4 * k]     = __builtin_amdgcn_sdot4(t0, a4, oP[4 * k], false);     oP[4 * k + 1] = __builtin_amdgcn_sdot4(t1, a4, oP[4 * k + 1], false);
                       oP[4 * k + 2] = __builtin_amdgcn_sdot4(t2, a4, oP[4 * k + 2], false); oP[4 * k + 3] = __builtin_amdgcn_sdot4(t3, a4, oP[4 * k + 3], false); } }
            PIN16(oL); PIN16(oP);
            { const unsigned bc0 = PEER_BC(evB, w >> 1), bc1 = PEER_BC(evB, (w >> 1) + 1);
              const unsigned off0 = (PEER_E2(bc0, 0) << 7) | c16, off1 = (PEER_E2(bc0, 1) << 7) | c16, off2 = (PEER_E2(bc1, 0) << 7) | c16, off3 = (PEER_E2(bc1, 1) << 7) | c16;
              GLDS16(vw[w], off0, tabs); GLDS16(vw[w + 1], off1, tabs); GLDS16(vw[w + 2], off2, tabs); GLDS16(vw[w + 3], off3, tabs); } }
        int L0, L1, P0, P1; red16_groups(oL, b3, L0, L1); red16_groups(oP, b3, P0, P1);
        const float sc = __uint_as_float(scA.x), corr = __uint_as_float(scA.y);
        const float f0 = bf_lo(xfA.x) + ((float)L0 * sc - corr), f1 = bf_hi(xfA.x) + (float)((P0 - L0) >> 4) * sc, f2 = bf_lo(xfA.y) + ((float)L1 * sc - corr), f3 = bf_hi(xfA.y) + (float)((P1 - L1) >> 4) * sc;
        { u32x2 st; st.x = pk2(f0, f1); st.y = pk2(f2, f3); *(u32x2*)(XB + (size_t)t * DM + col) = st; }
        const float ss = wave_total((f0 * f0 + f1 * f1) + (f2 * f2 + f3 * f3));
        if (lane == 0) { float* sp = SSQP + (size_t)t * 16 + x; sp[0] = ss; sp[4] = 0.f; sp[8] = 0.f; sp[12] = 0.f; }
        asm volatile("s_waitcnt vmcnt(16)" : "+v"(evC), "+v"(aB), "+v"(xfB), "+v"(scB) :: "memory");
        aA = aB; evB = evC; xfA = xfB; scA = scB;
    }
    asm volatile("s_waitcnt vmcnt(0)" ::: "memory");
}

__device__ __forceinline__ void phase_final_norm(Frame& F, const bf16_t* XB, float* OUT, const float* SSQP, const float* norm_f) {
    const int gw = F.vcu * NWAVES + F.wave, NGW = F.G * NWAVES, lane = opaque_i(F.lane);
    for (int t = gw; t < TOK; t += NGW) { const float r = row_scale(SSQP, 1, t);
#pragma unroll
        for (int j = 0; j < 4; ++j) { const u32x2 w = *(const u32x2*)(XB + (size_t)t * DM + 256 * j + 4 * lane); const f32x4 x = {bf_lo(w.x), bf_hi(w.x), bf_lo(w.y), bf_hi(w.y)};
            *(f32x4*)(OUT + (size_t)t * DM + 256 * j + 4 * lane) = x * r * *(const f32x4*)(norm_f + 256 * j + 4 * lane); } }
}

constexpr int N_PHASES = 20;
struct Args { const float* in[16]; float* out; unsigned char* ws; int ph_lo, ph_hi; };
template <bool COOP>
__global__ void __launch_bounds__(NWAVES * 64, 2) mk_fwd(Args args) {
    extern __shared__ __attribute__((aligned(16))) unsigned char lds[];
    Frame F;
    F.lds = (LAS unsigned char*)lds;
    F.tid = threadIdx.x; F.lane = F.tid & 63; F.wave = __builtin_amdgcn_readfirstlane(F.tid >> 6);
    F.G = gridDim.x; { const int bx = blockIdx.x; F.vcu = (F.G % 8 == 0) ? (bx % 8) * (F.G / 8) + bx / 8 : bx; }
    Ptrs P;
    P.x = args.in[0]; P.norm_mix = args.in[1]; P.norm_ffn = args.in[2]; P.ev_w_in = args.in[3]; P.ev_b_f = args.in[4]; P.ev_w_out = args.in[5]; P.od_w_in = args.in[6];
    P.od_pool_w = args.in[7]; P.od_pool_scale = args.in[8]; P.od_w_out = args.in[9]; P.peer_wq = args.in[10]; P.peer_k1 = args.in[11]; P.peer_k2 = args.in[12];
    P.peer_u = args.in[13]; P.peer_v = args.in[14]; P.norm_f = args.in[15]; P.out = args.out; P.ws = args.ws;
    unsigned char* ws = args.ws;
    bf16_t* XB = (bf16_t*)(ws + WS_XB); bf16_t* AO = (bf16_t*)(ws + WS_AO); bf16_t* QP = (bf16_t*)(ws + WS_QP);
    unsigned short* EID = (unsigned short*)(ws + WS_EID); float* GATE = (float*)(ws + WS_GATE);
    float* RS0 = (float*)(ws + WS_RS0); float* SSQ2 = (float*)(ws + WS_SSQ2); int* PREP = (int*)(ws + WS_PREP); unsigned char* ACO8 = ws + WS_ACO; float* ASC = (float*)(ws + WS_ACO + 8 * MiB); float* SSQ1 = (float*)(ws + WS_SSQ1); float* SSQ3 = (float*)(ws + WS_SSQ3);
    const int lo = args.ph_lo, hi = args.ph_hi;
    volatile LAS unsigned* xbst = (volatile LAS unsigned*)(F.lds + LDS_BYTES - 64);
    if (F.tid < 4) xbst[F.tid] = 0u;
    __syncthreads();
    XcdBarrier xbar; xbar.bar = (unsigned*)(ws + WS_CTL) + 4096; xbar.x = 0; xbar.st = xbst;
    if (COOP) xbar = xcd_barrier_post((unsigned*)(ws + WS_CTL) + 4096, xbst);
#define IN(k) (lo <= (k) && (k) < hi)
#define SEAM(k) do { if (COOP && IN(k) && IN((k) + 1)) xcd_barrier(xbar); } while (0)
    if (COOP && lo < 0) cg::this_grid().sync();
    if (IN(0)) { phase_p0(F, P); } SEAM(0);
    if (IN(1)) {
        pg8::Gemm g{XB, (const bf16_t*)(ws + WS_W1T), TOK, 3072, DM}; pg8::StaticOrder S; S.init(TOK, 3072, F.G, (int)blockIdx.x);
        EpiL0In E{RS0, (bf16_t*)(ws + WS_QH), (bf16_t*)(ws + WS_KH), (bf16_t*)(ws + WS_VT), (float*)(ws + WS_LF), P.ev_b_f};
        pg8::gemm_phase<EpiL0In, pg8::StaticOrder, true, true>(F.lds, g, S, E);
    } SEAM(1);
    if (IN(3)) {
        phase_attn_fox(F, (const bf16_t*)(ws + WS_QH), (const bf16_t*)(ws + WS_KH), (const bf16_t*)(ws + WS_VT), (const float*)(ws + WS_LF), (float*)(ws + WS_CF), AO);
        phase_attn<1>(F, (const bf16_t*)(ws + WS_QH), (const bf16_t*)(ws + WS_KH), (const bf16_t*)(ws + WS_VT), 16, 8, nullptr, nullptr, AO, 512);
    } SEAM(3);
    if (IN(4)) {
        pg8::Gemm g{AO, (const bf16_t*)(ws + WS_W2T), TOK, DM, DM}; pg8::StaticOrder S; S.init(TOK, DM, F.G, (int)blockIdx.x);
        EpiRes<false> E{P.x, XB, SSQ1};
        pg8::gemm_phase<EpiRes<false>, pg8::StaticOrder, true, true>(F.lds, g, S, E);
    } SEAM(4);
    if (IN(5)) {
        pg8::Gemm g{XB, (const bf16_t*)(ws + WS_W3T), TOK, 2048, DM}; pg8::StaticOrder S; S.init(TOK, 2048, F.G, (int)blockIdx.x);
        EpiQ E{SSQ1, 1, QP};
        pg8::gemm_phase<EpiQ, pg8::StaticOrder, true, true>(F.lds, g, S, E);
    } SEAM(5);
    if (IN(6)) { phase_topk(F, QP, (const bf16_t*)(ws + WS_K1B), (const bf16_t*)(ws + WS_K2B), EID, GATE); } SEAM(6);
    if (IN(7)) { phase_peer_u(F, XB, SSQ1, 1, EID, ws + WS_U8S, PREP); } SEAM(7);
    if (IN(8)) { phase_peer_c(F, PREP, GATE, ACO8, ASC); } SEAM(8);
    if (IN(9)) { phase_peer_v(F, XB, EID, ACO8, ASC, ws + WS_V8S, SSQ2); } SEAM(9);
    if (IN(10)) {
        pg8::Gemm g{XB, (const bf16_t*)(ws + WS_W4T), TOK, 2048, DM}; pg8::StaticOrder S; S.init(TOK, 2048, F.G, (int)blockIdx.x);
        EpiL1In E{SSQ2, 1, (bf16_t*)(ws + WS_QH), (bf16_t*)(ws + WS_QH + 32 * MiB), (bf16_t*)(ws + WS_KH), (bf16_t*)(ws + WS_KH + 32 * MiB)};
        pg8::gemm_phase<EpiL1In, pg8::StaticOrder, true, true>(F.lds, g, S, E);
    } SEAM(10);
    if (IN(12)) {
        phase_attn_moba(F, (const bf16_t*)(ws + WS_QH + 32 * MiB), (const bf16_t*)(ws + WS_KH), (const bf16_t*)(ws + WS_KH + 32 * MiB), (float*)(ws + WS_KMEAN), AO);
        phase_pool(F, (const bf16_t*)(ws + WS_QH), (const bf16_t*)(ws + WS_PWT), P.od_pool_scale, AO);
    } SEAM(12);
    if (IN(13)) {
        pg8::Gemm g{AO, (const bf16_t*)(ws + WS_W5T), TOK, DM, DM}; pg8::StaticOrder S; S.init(TOK, DM, F.G, (int)blockIdx.x);
        EpiRes<true> E{XB, XB, SSQ3};
        pg8::gemm_phase<EpiRes<true>, pg8::StaticOrder, true, true>(F.lds, g, S, E);
    } SEAM(13);
    if (IN(14)) {
        pg8::Gemm g{XB, (const bf16_t*)(ws + WS_W6T), TOK, 2048, DM}; pg8::StaticOrder S; S.init(TOK, 2048, F.G, (int)blockIdx.x);
        EpiQ E{SSQ3, 1, QP};
        pg8::gemm_phase<EpiQ, pg8::StaticOrder, true, true>(F.lds, g, S, E);
    } SEAM(14);
    if (IN(15)) { phase_topk(F, QP, (const bf16_t*)(ws + WS_K1B) + 8 * 128 * 128, (const bf16_t*)(ws + WS_K2B) + 8 * 128 * 128, EID, GATE); } SEAM(15);
    if (IN(16)) { phase_peer_u(F, XB, SSQ3, 1, EID, ws + WS_U8S + (size_t)4 * NEXP * 128, PREP); } SEAM(16);
    if (IN(17)) { phase_peer_c(F, PREP, GATE, ACO8, ASC); } SEAM(17);
    if (IN(18)) { phase_peer_v(F, XB, EID, ACO8, ASC, ws + WS_V8S + (size_t)4 * NEXP * 128, SSQ2); } SEAM(18);
    if (IN(19)) { phase_final_norm(F, XB, P.out, SSQ2, P.norm_f); }
#undef IN
#undef SEAM
}

extern "C" void kernel_launch(void* const* d_in, const int* in_sizes, int n_in, void* d_out, int out_size, void* d_ws, size_t ws_size, hipStream_t stream) {
    static int grid = 0;
    constexpr bool COOP = (MK_MULTI == 0);
    if (grid == 0) {
        if (n_in != 16 || in_sizes[0] != TOK * DM || out_size != TOK * DM || ws_size < WS_END) { fprintf(stderr, "kernel_launch: unexpected shapes (n_in %d, in0 %d, out %d, ws %zu)\n", n_in, n_in > 0 ? in_sizes[0] : -1, out_size, ws_size); grid = -1; return; }
        int dev = 0, cus = 0, per_cu = 0;
        if (hipGetDevice(&dev) != hipSuccess || hipDeviceGetAttribute(&cus, hipDeviceAttributeMultiprocessorCount, dev) != hipSuccess) { grid = -1; return; }
        if (hipFuncSetAttribute((const void*)mk_fwd<COOP>, hipFuncAttributeMaxDynamicSharedMemorySize, LDS_BYTES) != hipSuccess) { fprintf(stderr, "kernel_launch: hipFuncSetAttribute failed\n"); grid = -1; return; }
        if (hipOccupancyMaxActiveBlocksPerMultiprocessor(&per_cu, (const void*)mk_fwd<COOP>, NWAVES * 64, LDS_BYTES) != hipSuccess || per_cu < 1) { fprintf(stderr, "kernel_launch: occupancy query says %d\n", per_cu); per_cu = 1; }
        (void)hipGetLastError();
        grid = cus;
    }
    if (grid < 0) return;
    if (hipMemsetAsync((char*)d_ws + WS_CTL, 0, CTL_ZERO_BYTES, stream) != hipSuccess) { fprintf(stderr, "kernel_launch: memset failed\n"); return; }
    Args a{};
    for (int i = 0; i < 16; ++i) a.in[i] = (const float*)d_in[i];
    a.out = (float*)d_out; a.ws = (unsigned char*)d_ws;
    if (COOP) {
        a.ph_lo = 0; a.ph_hi = N_PHASES;
        void* kargs[] = {&a};
        const hipError_t e = hipLaunchCooperativeKernel((const void*)mk_fwd<COOP>, dim3(grid), dim3(NWAVES * 64), kargs, LDS_BYTES, stream);
        if (e != hipSuccess) fprintf(stderr, "kernel_launch: cooperative launch failed: %s (grid %d)\n", hipGetErrorString(e), grid);
    } else {
        for (int p = 0; p < N_PHASES; ++p) { a.ph_lo = p; a.ph_hi = p + 1; hipLaunchKernelGGL(mk_fwd<COOP>, dim3(grid), dim3(NWAVES * 64), LDS_BYTES, stream, a); }
    }
}
```

```cpp
#include <hip/hip_runtime.h>
#include <hip/hip_cooperative_groups.h>
#include <cstdio>
#include <cstdint>
#include <cmath>
namespace cg = cooperative_groups;

#ifndef MK_MULTI
#define MK_MULTI 0
#endif

namespace pg8 {
#define PG8_LAS __attribute__((address_space(3)))
typedef unsigned short bf16_t;
typedef short bf16x8 __attribute__((ext_vector_type(8)));
typedef float f32x4 __attribute__((ext_vector_type(4)));
typedef unsigned u32x4 __attribute__((ext_vector_type(4)));
constexpr int BM = 256, BK = 64, HALF = 128, HTB = HALF * BK * 2  , STAGE_BYTES = 8 * HTB, NXCD = 8, WGM = 8;

__host__ __device__ __forceinline__ int lds_byte(int r, int c) { const int st = (r >> 4) * 2 + (c >> 5), rr = r & 15, cc = c & 31, ob = rr * 64 + cc * 2; return st * 1024 + (ob ^ (((ob >> 9) & 1) << 5)); }
__host__ __device__ __forceinline__ void stage_rc(int b, int& R, int& C) { const int st = b / 1024, sb = b % 1024, swz = sb ^ (((sb >> 9) & 1) << 5); R = (st >> 1) * 16 + swz / 64; C = (st & 1) * 32 + (swz % 64) / 2; }
__host__ __device__ __forceinline__ int perm32(int rho) { const int n = rho >> 4, i = rho & 15; return 8 * (i >> 2) + 4 * n + (i & 3); }

struct Unit { int pm, pn; };
struct Gemm { const bf16_t* A; const bf16_t* Bt; int M, N, K; };

struct StaticOrder {
    int nM, nN, nwg, G, c;
    __host__ __device__ void init(int M, int N, int G_, int c_) { nM = M / BM; nN = N / BM; nwg = nM * nN; G = G_; c = c_; }
    __host__ __device__ bool next(int i, Unit& u) const {
        const long L = (long)i * G + c; if (L >= nwg) return false;
        int wgid = (int)L; { const int q = nwg / NXCD, r = nwg % NXCD, xcd = wgid % NXCD, off = wgid / NXCD; wgid = (xcd < r ? xcd * (q + 1) : r * (q + 1) + (xcd - r) * q) + off; }
        const int nig = WGM * nN, gid = wgid / nig, fm = gid * WGM, gsz = (nM - fm) < WGM ? (nM - fm) : WGM;
        u.pm = fm + ((wgid % nig) % gsz); u.pn = (wgid % nig) / gsz; return true;
    }
    __device__ __forceinline__ void a_ready(const Unit&) const {}
    __device__ __forceinline__ void done(const Unit&) const {}
};
__device__ __forceinline__ unsigned cvt_pk_bf16(float lo, float hi) { unsigned r; asm volatile("v_cvt_pk_bf16_f32 %0, %1, %2" : "=v"(r) : "v"(lo), "v"(hi)); return r; }
template <class Epi, class Sched, bool ALIGN_EPI = false, bool SP2 = false>
__device__ __forceinline__ void gemm_phase(PG8_LAS unsigned char* lds, const Gemm g, const Sched& S, const Epi& E) {
    const int tid = threadIdx.x, wid = __builtin_amdgcn_readfirstlane(tid >> 6), lane = tid & 63, wr = wid >> 2, wc = wid & 3, fr = lane & 15, fq = lane >> 4;
    const int K = g.K, nt = K / BK;
    unsigned voffA[2], voffB[2];
#pragma unroll
    for (int i = 0; i < 2; ++i) { int R, C; stage_rc(tid * 16 + i * 8192, R, C); const int Rb = Epi::PERM ? ((R & ~31) + perm32(R & 31)) : R;
        voffA[i] = (unsigned)(R * K + C) * 2u; voffB[i] = (unsigned)(Rb * K + C) * 2u; }
    const size_t kstep = (size_t)(BK * 2);
    const size_t hstep = (size_t)HALF * K * 2;
    const size_t tstep = 2 * hstep;
    const unsigned ldsw = (unsigned)wid * 1024u;
    const int aoff = lds_byte(wr * 64 + fr, fq * 8), boff = lds_byte(wc * 32 + fr, fq * 8);
#define PG8_SA(b, h) (((b) * 2 + (h)) * HTB)
#define PG8_SB(b, h) ((4 + (b) * 2 + (h)) * HTB)
#define PG8_STAGE(bufoff, gbase, voff) do { _Pragma("unroll") for (int _i = 0; _i < 2; ++_i) \
        __builtin_amdgcn_global_load_lds((const unsigned*)((const char*)(gbase) + (voff)[_i]), (PG8_LAS unsigned*)(lds + (bufoff) + ldsw + _i * 8192), 16, 0, 0); } while (0)
#define PG8_LDA(dst, b, h) do { _Pragma("unroll") for (int m = 0; m < 4; ++m) _Pragma("unroll") for (int k = 0; k < 2; ++k) dst[m][k] = *(const PG8_LAS bf16x8*)(lds + PG8_SA(b, h) + aoff + m * 2048 + k * 1024); } while (0)
#define PG8_LDB(dst, b, h) do { _Pragma("unroll") for (int n = 0; n < 2; ++n) _Pragma("unroll") for (int k = 0; k < 2; ++k) dst[n][k] = *(const PG8_LAS bf16x8*)(lds + PG8_SB(b, h) + boff + n * 2048 + k * 1024); } while (0)
#define PG8_MMA(ai, bj, At, Bt) do { __builtin_amdgcn_s_setprio(1); _Pragma("unroll") for (int m = 0; m < 4; ++m) _Pragma("unroll") for (int n = 0; n < 2; ++n) _Pragma("unroll") for (int k = 0; k < 2; ++k) \
        acc[ai][bj][m][n] = __builtin_amdgcn_mfma_f32_16x16x32_bf16(Bt[n][k], At[m][k], acc[ai][bj][m][n], 0, 0, 0); __builtin_amdgcn_s_setprio(0); } while (0)
#define PG8_WAIT_V(n) asm volatile("s_waitcnt vmcnt(" #n ")" ::: "memory")
#define PG8_WAIT_L(n) asm volatile("s_waitcnt lgkmcnt(" #n ")" ::: "memory")
#define PG8_BAR __builtin_amdgcn_s_barrier()
#define PG8_SCHED __builtin_amdgcn_sched_barrier(0)
    Unit cur, nxt; int ui = 0;
    if (!S.next(0, cur)) return;
    f32x4 acc[2][2][4][2];
#pragma unroll
    for (int a = 0; a < 2; ++a)
#pragma unroll
        for (int b = 0; b < 2; ++b)
#pragma unroll
            for (int m = 0; m < 4; ++m)
#pragma unroll
                for (int n = 0; n < 2; ++n) acc[a][b][m][n] = (f32x4){0.f, 0.f, 0.f, 0.f};
    bf16x8 At[4][2], B0[2][2], B1[2][2];
    const char* cA = (const char*)g.A + (size_t)cur.pm * tstep; const char* cB = (const char*)g.Bt + (size_t)cur.pn * tstep;
    S.a_ready(cur);
    if constexpr (SP2) {
        PG8_STAGE(PG8_SB(0, 0), cB, voffB); PG8_STAGE(PG8_SB(0, 1), cB + hstep, voffB); PG8_STAGE(PG8_SA(0, 0), cA, voffA); PG8_STAGE(PG8_SA(0, 1), cA + hstep, voffA);
        if (wr == 1) PG8_BAR;
        PG8_WAIT_V(2); PG8_BAR;
        PG8_STAGE(PG8_SB(1, 0), cB + kstep, voffB); PG8_STAGE(PG8_SA(1, 0), cA + kstep, voffA); PG8_STAGE(PG8_SB(1, 1), cB + hstep + kstep, voffB);
        PG8_WAIT_V(6); PG8_BAR;
    } else {
        PG8_STAGE(PG8_SB(0, 0), cB, voffB); PG8_STAGE(PG8_SA(0, 0), cA, voffA); PG8_STAGE(PG8_SB(0, 1), cB + hstep, voffB); PG8_STAGE(PG8_SA(0, 1), cA + hstep, voffA);
        if (wr == 1) PG8_BAR;
        PG8_WAIT_V(4); PG8_BAR;
        PG8_STAGE(PG8_SB(1, 0), cB + kstep, voffB); PG8_STAGE(PG8_SA(1, 0), cA + kstep, voffA); PG8_STAGE(PG8_SB(1, 1), cB + hstep + kstep, voffB);
        PG8_WAIT_V(6); PG8_BAR;
    }
    for (;;) {
        const bool has_next = S.next(ui + 1, nxt);
        const char* nA = has_next ? (const char*)g.A + (size_t)nxt.pm * tstep : cA; const char* nB = has_next ? (const char*)g.Bt + (size_t)nxt.pn * tstep : cB;
        for (int t = 0; t < nt; t += 2) {
            const bool last = (t == nt - 2);
            const char* a1 = cA + (size_t)(t + 1) * kstep;
            const char* a2 = last ? nA : cA + (size_t)(t + 2) * kstep; const char* b2 = last ? nB : cB + (size_t)(t + 2) * kstep;
            const char* a3 = a2 + kstep; const char* b3 = b2 + kstep;
            if (last && has_next) S.a_ready(nxt);
            if constexpr (SP2) {
            PG8_LDB(B0, 0, 0); PG8_LDB(B1, 0, 1); PG8_SCHED; PG8_LDA(At, 0, 0); PG8_STAGE(PG8_SA(1, 1), a1 + hstep, voffA);
            PG8_WAIT_V(8); PG8_WAIT_L(0); PG8_BAR; PG8_MMA(0, 0, At, B0); PG8_MMA(0, 1, At, B1); PG8_BAR; PG8_SCHED;
            PG8_LDA(At, 0, 1); PG8_STAGE(PG8_SB(0, 0), b2, voffB); PG8_STAGE(PG8_SB(0, 1), b2 + hstep, voffB); PG8_STAGE(PG8_SA(0, 0), a2, voffA);
            PG8_WAIT_V(8); PG8_WAIT_L(0); PG8_BAR; PG8_MMA(1, 0, At, B0); PG8_MMA(1, 1, At, B1); PG8_BAR; PG8_SCHED;
            PG8_LDB(B0, 1, 0); PG8_LDB(B1, 1, 1); PG8_SCHED; PG8_LDA(At, 1, 0); PG8_STAGE(PG8_SA(0, 1), a2 + hstep, voffA);
            PG8_WAIT_V(8); PG8_WAIT_L(0); PG8_BAR; PG8_MMA(0, 0, At, B0); PG8_MMA(0, 1, At, B1); PG8_BAR; PG8_SCHED;
            PG8_LDA(At, 1, 1); PG8_STAGE(PG8_SB(1, 0), b3, voffB); PG8_STAGE(PG8_SB(1, 1), b3 + hstep, voffB); PG8_STAGE(PG8_SA(1, 0), a3, voffA);
            PG8_WAIT_V(8); PG8_WAIT_L(0); PG8_BAR; PG8_MMA(1, 0, At, B0); PG8_MMA(1, 1, At, B1); PG8_BAR; PG8_SCHED;
            } else {
            PG8_LDB(B0, 0, 0); PG8_SCHED; PG8_LDA(At, 0, 0); PG8_STAGE(PG8_SA(1, 1), a1 + hstep, voffA);
            PG8_WAIT_L(8); PG8_BAR; PG8_WAIT_L(0); PG8_MMA(0, 0, At, B0); PG8_BAR; PG8_SCHED;
            PG8_LDB(B1, 0, 1); PG8_STAGE(PG8_SB(0, 0), b2, voffB);
            PG8_BAR; PG8_WAIT_L(0); PG8_MMA(0, 1, At, B1); PG8_BAR;
            PG8_LDA(At, 0, 1); PG8_STAGE(PG8_SA(0, 0), a2, voffA);
            PG8_BAR; PG8_WAIT_L(0); PG8_MMA(1, 0, At, B0); PG8_BAR; PG8_SCHED;
            PG8_STAGE(PG8_SB(0, 1), b2 + hstep, voffB);
            PG8_WAIT_V(6); PG8_BAR; PG8_MMA(1, 1, At, B1); PG8_BAR;
            PG8_LDB(B0, 1, 0); PG8_SCHED; PG8_LDA(At, 1, 0); PG8_STAGE(PG8_SA(0, 1), a2 + hstep, voffA);
            PG8_WAIT_L(8); PG8_BAR; PG8_WAIT_L(0); PG8_MMA(0, 0, At, B0); PG8_BAR; PG8_SCHED;
            PG8_LDB(B1, 1, 1); PG8_STAGE(PG8_SB(1, 0), b3, voffB);
            PG8_BAR; PG8_WAIT_L(0); PG8_MMA(0, 1, At, B1); PG8_BAR;
            PG8_LDA(At, 1, 1); PG8_STAGE(PG8_SA(1, 0), a3, voffA);
            PG8_BAR; PG8_WAIT_L(0); PG8_MMA(1, 0, At, B0); PG8_BAR; PG8_SCHED;
            PG8_STAGE(PG8_SB(1, 1), b3 + hstep, voffB);
            PG8_WAIT_V(6); PG8_BAR; PG8_MMA(1, 1, At, B1); PG8_BAR;
            }
        }
        if constexpr (ALIGN_EPI) { if (wr == 0) PG8_BAR; }
        if constexpr (!Epi::AFTER_DRAIN) { E(acc, cur, wr, wc, fr, fq); S.done(cur); }
        if (!has_next) break;
#pragma unroll
        for (int a = 0; a < 2; ++a)
#pragma unroll
            for (int b = 0; b < 2; ++b)
#pragma unroll
                for (int m = 0; m < 4; ++m)
#pragma unroll
                    for (int n = 0; n < 2; ++n) acc[a][b][m][n] = (f32x4){0.f, 0.f, 0.f, 0.f};
        cur = nxt; cA = nA; cB = nB; ++ui;
        if constexpr (ALIGN_EPI) { if (wr == 1) PG8_BAR; }
    }
    PG8_WAIT_V(0);
    if constexpr (!ALIGN_EPI) { if (wr == 0) PG8_BAR; }
    PG8_BAR;
    if constexpr (Epi::AFTER_DRAIN) { E.fused(acc, cur, wr, wc, fr, fq, lds, wid, lane); S.done(cur); }
#undef PG8_SA
#undef PG8_SB
#undef PG8_STAGE
#undef PG8_LDA
#undef PG8_LDB
#undef PG8_MMA
#undef PG8_WAIT_V
#undef PG8_WAIT_L
#undef PG8_BAR
#undef PG8_SCHED
}
}

constexpr int NB = 16, SEQ = 2048, DM = 1024, TOK = NB * SEQ;
constexpr int EVEN_IN = 3080, EVEN_PAD = 3328;
constexpr int NEXP = 16384;
constexpr float RMS_EPS = 1e-6f;
constexpr float LOG2E = 1.4426950408889634f;
constexpr float C2 = 0.125f * LOG2E;

constexpr size_t MiB = 1u << 20;
constexpr size_t WS_CTL = 0, CTL_ZERO_BYTES = 1 * MiB;
constexpr size_t WS_W1T = 1 * MiB;
constexpr size_t WS_W2T = 8 * MiB;
constexpr size_t WS_W4T = 10 * MiB;
constexpr size_t WS_W5T = 14 * MiB;
constexpr size_t WS_W3T = 16 * MiB;
constexpr size_t WS_W6T = 20 * MiB;
constexpr size_t WS_K1B = 24 * MiB;
constexpr size_t WS_K2B = 24 * MiB + 512 * 1024;
constexpr size_t WS_PWT = 25 * MiB;
constexpr size_t WS_LF  = 25 * MiB + 256 * 1024;
constexpr size_t WS_CF  = 26 * MiB + 256 * 1024;
constexpr size_t WS_KMEAN = 27 * MiB + 256 * 1024;
constexpr size_t WS_RS0 = 27 * MiB + 512 * 1024;
constexpr size_t WS_RS2 = 27 * MiB + 640 * 1024;
constexpr size_t WS_SSQ1 = 28 * MiB;
constexpr size_t WS_SSQ3 = 30 * MiB;
constexpr size_t WS_U8S = 32 * MiB;
constexpr size_t WS_V8S = 64 * MiB;
constexpr size_t WS_XB = 160 * MiB;
constexpr size_t WS_QH = 224 * MiB;
constexpr size_t WS_KH = 288 * MiB;
constexpr size_t WS_VT = 352 * MiB;
constexpr size_t WS_QP = 224 * MiB;
constexpr size_t WS_AO = 416 * MiB;
constexpr size_t WS_EID = 480 * MiB;
constexpr size_t WS_GATE = 488 * MiB;
constexpr size_t WS_SSQ2 = 504 * MiB;
constexpr size_t WS_PREP = 224 * MiB;
constexpr size_t WS_ACO = 416 * MiB;
constexpr size_t WS_END = 506 * MiB;

constexpr int RING_BYTES = 131072;
constexpr int LDS_BYTES = 147456;
constexpr int NWAVES = 8;

#define GAS __attribute__((address_space(1)))
#define LAS __attribute__((address_space(3)))
typedef unsigned short bf16_t;
typedef unsigned u32x4 __attribute__((ext_vector_type(4)));
typedef unsigned u32x2 __attribute__((ext_vector_type(2)));
typedef float f32x4 __attribute__((ext_vector_type(4)));
typedef float f32x16 __attribute__((ext_vector_type(16)));
typedef short bf16x8 __attribute__((ext_vector_type(8)));
typedef __bf16 bf16x2 __attribute__((ext_vector_type(2)));
#define LDS_WAIT() asm volatile("s_waitcnt lgkmcnt(0)" ::: "memory")

__device__ __forceinline__ int opaque_i(int v) { asm volatile("" : "+v"(v)); return v; }
__device__ __forceinline__ unsigned f2bf(float f) { unsigned u = __builtin_bit_cast(unsigned, f); return (u + 0x7fffu + ((u >> 16) & 1u)) >> 16; }
typedef float f32x2_pk __attribute__((ext_vector_type(2)));
__device__ __forceinline__ unsigned pk2(float lo, float hi) { const f32x2_pk v = {lo, hi}; return __builtin_bit_cast(unsigned, __builtin_convertvector(v, bf16x2)); }
__device__ __forceinline__ float bf_lo(unsigned u) { return __uint_as_float(u << 16); }
__device__ __forceinline__ float bf_hi(unsigned u) { return __uint_as_float(u & 0xffff0000u); }
__device__ __forceinline__ float dot2(unsigned a, unsigned b, float acc) { return __builtin_amdgcn_fdot2_f32_bf16(__builtin_bit_cast(bf16x2, a), __builtin_bit_cast(bf16x2, b), acc, false); }
__device__ __forceinline__ float dot8(u32x4 a, u32x4 b, float acc) { acc = dot2(a.x, b.x, acc); acc = dot2(a.y, b.y, acc); acc = dot2(a.z, b.z, acc); return dot2(a.w, b.w, acc); }
__device__ __forceinline__ u32x4 pack8(f32x4 a, f32x4 b) { u32x4 w; w.x = pk2(a[0], a[1]); w.y = pk2(a[2], a[3]); w.z = pk2(b[0], b[1]); w.w = pk2(b[2], b[3]); return w; }

__device__ __forceinline__ float wave_sum(float v) {
#pragma unroll
    for (int o = 1; o < 64; o <<= 1) v += __shfl_xor(v, o);
    return v;
}
__device__ __forceinline__ float wave_max(float v) {
#pragma unroll
    for (int o = 1; o < 64; o <<= 1) v = fmaxf(v, __shfl_xor(v, o));
    return v;
}
__device__ __forceinline__ unsigned wave_umax(unsigned v) {
#pragma unroll
    for (int o = 1; o < 64; o <<= 1) { const unsigned w = (unsigned)__shfl_xor((int)v, o); v = v > w ? v : w; }
    return v;
}
__device__ __forceinline__ float dpp_row_shr(float v, int n) {
    const int iv = __builtin_bit_cast(int, v); int r;
    switch (n) { case 1: r = __builtin_amdgcn_update_dpp(0, iv, 0x111, 0xf, 0xf, true); break; case 2: r = __builtin_amdgcn_update_dpp(0, iv, 0x112, 0xf, 0xf, true); break;
                 case 4: r = __builtin_amdgcn_update_dpp(0, iv, 0x114, 0xf, 0xf, true); break; default: r = __builtin_amdgcn_update_dpp(0, iv, 0x118, 0xf, 0xf, true); break; }
    return __builtin_bit_cast(float, r);
}
__device__ __forceinline__ float wave_total(float v) {
    v += dpp_row_shr(v, 1); v += dpp_row_shr(v, 2); v += dpp_row_shr(v, 4); v += dpp_row_shr(v, 8);
    v += __builtin_bit_cast(float, __builtin_amdgcn_update_dpp(0, __builtin_bit_cast(int, v), 0x142, 0xa, 0xf, false));
    v += __builtin_bit_cast(float, __builtin_amdgcn_update_dpp(0, __builtin_bit_cast(int, v), 0x143, 0xc, 0xf, false));
    return __builtin_bit_cast(float, __builtin_amdgcn_readlane(__builtin_bit_cast(int, v), 63));
}
__device__ __forceinline__ unsigned f2ord(float f) { const unsigned u = __float_as_uint(f); return u ^ ((unsigned)((int)u >> 31) | 0x80000000u); }
__device__ __forceinline__ float ord2f(unsigned o) { return __uint_as_float(o ^ (~(unsigned)((int)o >> 31) | 0x80000000u)); }

__device__ __forceinline__ float row_scale(const float* p, int mode, int t) {
    if (mode == 0) return p[t];
    const f32x4* q = (const f32x4*)(p + (size_t)t * 16); const f32x4 a = q[0], b = q[1], c = q[2], d = q[3];
    const float s = (((a[0] + a[1]) + (a[2] + a[3])) + ((b[0] + b[1]) + (b[2] + b[3]))) + (((c[0] + c[1]) + (c[2] + c[3])) + ((d[0] + d[1]) + (d[2] + d[3])));
    return rsqrtf(s * (1.f / DM) + RMS_EPS);
}

struct EpiL0In {
    static constexpr bool PERM = true, AFTER_DRAIN = false;
    const float* rs; bf16_t* QH; bf16_t* KH; bf16_t* VT; float* LF; const float* b_f;
    __device__ __forceinline__ void operator()(const f32x4 (&acc)[2][2][4][2], const pg8::Unit& u, int wr, int wc, int fr, int fq) const {
        const int pn = u.pn;
        if (pn == 12) {
            if (wc == 0 && fq == 0) {
#pragma unroll
                for (int ai = 0; ai < 2; ++ai)
#pragma unroll
                    for (int m = 0; m < 4; ++m) {
                        const int t = u.pm * 256 + ai * 128 + wr * 64 + m * 16 + fr; const float sc = rs[t]; const int b = t >> 11, s = t & 2047;
#pragma unroll
                        for (int n = 0; n < 2; ++n)
#pragma unroll
                            for (int e = 0; e < 4; ++e) { const int h = n * 4 + e; const float x = acc[ai][0][m][n][e] * sc + b_f[h];
                                const float ls = fminf(x, 0.f) - log1pf(expf(-fabsf(x)));
                                LF[(size_t)(b * 8 + h) * 2048 + s] = ls * LOG2E; }
                    }
            }
            return;
        }
        const int sec = pn >> 1, kind = sec % 3, hbase = (sec >= 3) ? 8 : 0;
#pragma unroll
        for (int ai = 0; ai < 2; ++ai)
#pragma unroll
            for (int m = 0; m < 4; ++m) {
                const int t = u.pm * 256 + ai * 128 + wr * 64 + m * 16 + fr; const int b = t >> 11, s = t & 2047;
                const float sc = rs[t] * (kind == 0 ? C2 : 1.f);
#pragma unroll
                for (int bj = 0; bj < 2; ++bj) {
                    const int cc = (pn & 1) * 256 + bj * 128 + wc * 32 + fq * 8, hh = hbase + (cc >> 6), d0 = cc & 63;
                    const f32x4 v0 = acc[ai][bj][m][0] * sc, v1 = acc[ai][bj][m][1] * sc;
                    if (kind < 2) { bf16_t* dst = (kind == 0 ? QH : KH) + ((size_t)(b * 16 + hh) * 2048 + s) * 64 + d0; *(u32x4*)dst = pack8(v0, v1); }
                    else { bf16_t* dst = VT + ((size_t)(b * 16 + hh) * 64 + d0) * 2048 + s;
                        dst[0 * 2048] = (bf16_t)f2bf(v0[0]); dst[1 * 2048] = (bf16_t)f2bf(v0[1]); dst[2 * 2048] = (bf16_t)f2bf(v0[2]); dst[3 * 2048] = (bf16_t)f2bf(v0[3]);
                        dst[4 * 2048] = (bf16_t)f2bf(v1[0]); dst[5 * 2048] = (bf16_t)f2bf(v1[1]); dst[6 * 2048] = (bf16_t)f2bf(v1[2]); dst[7 * 2048] = (bf16_t)f2bf(v1[3]); }
                }
            }
    }
};
struct EpiL1In {
    static constexpr bool PERM = true, AFTER_DRAIN = false;
    const float* rsp; int rsmode; bf16_t* XC; bf16_t* QD; bf16_t* KD; bf16_t* VTD;
    __device__ __forceinline__ void operator()(const f32x4 (&acc)[2][2][4][2], const pg8::Unit& u, int wr, int wc, int fr, int fq) const {
        const int pn = u.pn, kind = pn >> 1;
#pragma unroll
        for (int ai = 0; ai < 2; ++ai)
#pragma unroll
            for (int m = 0; m < 4; ++m) {
                const int t = u.pm * 256 + ai * 128 + wr * 64 + m * 16 + fr; const int b = t >> 11, s = t & 2047;
                const float sc = row_scale(rsp, rsmode, t) * (kind == 1 ? C2 : 1.f);
#pragma unroll
                for (int bj = 0; bj < 2; ++bj) {
                    const int cc = (pn & 1) * 256 + bj * 128 + wc * 32 + fq * 8, hh = cc >> 6, d0 = cc & 63;
                    const f32x4 v0 = acc[ai][bj][m][0] * sc, v1 = acc[ai][bj][m][1] * sc;
                    if (kind == 0) { *(u32x4*)(XC + (size_t)t * 512 + cc) = pack8(v0, v1); }
                    else if (kind < 3) { bf16_t* dst = (kind == 1 ? QD : KD) + ((size_t)(b * 8 + hh) * 2048 + s) * 64 + d0; *(u32x4*)dst = pack8(v0, v1); }
                    else { bf16_t* dst = VTD + ((size_t)(b * 8 + hh) * 64 + d0) * 2048 + s;
                        dst[0 * 2048] = (bf16_t)f2bf(v0[0]); dst[1 * 2048] = (bf16_t)f2bf(v0[1]); dst[2 * 2048] = (bf16_t)f2bf(v0[2]); dst[3 * 2048] = (bf16_t)f2bf(v0[3]);
                        dst[4 * 2048] = (bf16_t)f2bf(v1[0]); dst[5 * 2048] = (bf16_t)f2bf(v1[1]); dst[6 * 2048] = (bf16_t)f2bf(v1[2]); dst[7 * 2048] = (bf16_t)f2bf(v1[3]); }
                }
            }
    }
};
struct EpiQ {
    static constexpr bool PERM = true, AFTER_DRAIN = false;
    const float* rsp; int rsmode; bf16_t* Q;
    __device__ __forceinline__ void operator()(const f32x4 (&acc)[2][2][4][2], const pg8::Unit& u, int wr, int wc, int fr, int fq) const {
#pragma unroll
        for (int ai = 0; ai < 2; ++ai)
#pragma unroll
            for (int m = 0; m < 4; ++m) {
                const int t = u.pm * 256 + ai * 128 + wr * 64 + m * 16 + fr; const float sc = row_scale(rsp, rsmode, t);
#pragma unroll
                for (int bj = 0; bj < 2; ++bj) { const int c = u.pn * 256 + bj * 128 + wc * 32 + fq * 8;
                    __builtin_nontemporal_store(pack8(acc[ai][bj][m][0] * sc, acc[ai][bj][m][1] * sc), (u32x4*)(Q + (size_t)t * 2048 + c)); }
            }
    }
};
template <bool BASE_BF16>
struct EpiRes {
    static constexpr bool PERM = true, AFTER_DRAIN = false;
    const void* base; bf16_t* xb; float* ssqp;
    __device__ __forceinline__ void operator()(const f32x4 (&acc)[2][2][4][2], const pg8::Unit& u, int wr, int wc, int fr, int fq) const {
#pragma unroll
        for (int ai = 0; ai < 2; ++ai)
#pragma unroll
            for (int m = 0; m < 4; ++m) {
                const int t = u.pm * 256 + ai * 128 + wr * 64 + m * 16 + fr; float ss = 0.f;
#pragma unroll
                for (int bj = 0; bj < 2; ++bj) { const size_t off = (size_t)t * DM + u.pn * 256 + bj * 128 + wc * 32 + fq * 8;
                    f32x4 b0, b1;
                    if (BASE_BF16) { const u32x4 w = *(const u32x4*)((const bf16_t*)base + off); b0 = (f32x4){bf_lo(w.x), bf_hi(w.x), bf_lo(w.y), bf_hi(w.y)}; b1 = (f32x4){bf_lo(w.z), bf_hi(w.z), bf_lo(w.w), bf_hi(w.w)}; }
                    else { b0 = *(const f32x4*)((const float*)base + off); b1 = *(const f32x4*)((const float*)base + off + 4); }
                    const f32x4 o0 = b0 + acc[ai][bj][m][0], o1 = b1 + acc[ai][bj][m][1];
                    *(u32x4*)(xb + off) = pack8(o0, o1);
                    ss += (o0[0] * o0[0] + o0[1] * o0[1]) + (o0[2] * o0[2] + o0[3] * o0[3]) + (o1[0] * o1[0] + o1[1] * o1[1]) + (o1[2] * o1[2] + o1[3] * o1[3]); }
                ss += __shfl_xor(ss, 16); ss += __shfl_xor(ss, 32);
                if (fq == 0) ssqp[(size_t)t * 16 + u.pn * 4 + wc] = ss;
            }
    }
};

#define XB_TMO      128
#define XB_XCNT(j)  (256  + 64 * (j))
#define XB_XSUB(j)  (1280 + 64 * (j))
#define XB_XGEN(j)  (2304 + 64 * (j))
#define XB_TOP      3328
#define XB_TOPGEN   3392
#define XCD_BAR_WORDS 3456
#define XB_SPIN_CAP (1u << 18)

__device__ __forceinline__ unsigned xb_ld(unsigned* p)              { return __hip_atomic_load(p, __ATOMIC_RELAXED, __HIP_MEMORY_SCOPE_AGENT); }
__device__ __forceinline__ unsigned xb_add(unsigned* p, unsigned v) { return __hip_atomic_fetch_add(p, v, __ATOMIC_RELAXED, __HIP_MEMORY_SCOPE_AGENT); }
__device__ __forceinline__ unsigned xb_xcc_id() { return (unsigned)__builtin_amdgcn_s_getreg((3 << 11) | 20) & 0xFu; }
#define XB_SPIN(cond, bar) do { unsigned _sp = 0; while (cond) { __builtin_amdgcn_s_sleep(1); \
    if ((++_sp & 255u) == 0u) { if (xb_ld(&(bar)[XB_TMO])) break; if (_sp > XB_SPIN_CAP) { atomicAdd(&(bar)[XB_TMO], 1u); break; } } } } while (0)

struct XcdBarrier {
    unsigned* bar; unsigned x;
    volatile LAS unsigned* st;
};

__device__ __forceinline__ XcdBarrier xcd_barrier_post(unsigned* bar, volatile LAS unsigned* st) {
    XcdBarrier b; b.bar = bar; b.x = xb_xcc_id(); b.st = st;
    if (threadIdx.x == 0) (void)xb_add(&bar[XB_XCNT(b.x)], 1u);
    return b;
}
__device__ __forceinline__ void xcd_barrier_complete(unsigned* bar, unsigned x, unsigned& nloc, unsigned& nx) {
    const unsigned G = gridDim.x * gridDim.y * gridDim.z;
    unsigned sum, cnt, mine, sp = 0u;
    for (;;) {
        sum = 0u; cnt = 0u; mine = 0u;
#pragma unroll
        for (unsigned j = 0; j < 16; ++j) { const unsigned c = xb_ld(&bar[XB_XCNT(j)]); sum += c; cnt += (c > 0u) ? 1u : 0u; mine = (j == x) ? c : mine; }
        if (sum == G) break;
        __builtin_amdgcn_s_sleep(1);
        if ((++sp & 255u) == 0u) { if (xb_ld(&bar[XB_TMO])) break; if (sp > XB_SPIN_CAP) { atomicAdd(&bar[XB_TMO], 1u); break; } }
    }
    nloc = mine > 0u ? mine : 1u; nx = cnt > 0u ? cnt : 1u;
}

__device__ __forceinline__ void xcd_barrier(const XcdBarrier& b) {
    asm volatile("s_waitcnt vmcnt(0)" ::: "memory");
    __syncthreads();
    if (threadIdx.x == 0) {
        unsigned* bar = b.bar;
        __builtin_amdgcn_s_waitcnt(0);
        unsigned nloc = b.st[0], nx = b.st[1];
        if (nloc == 0u) { xcd_barrier_complete(bar, b.x, nloc, nx); b.st[0] = nloc; b.st[1] = nx; }
        const unsigned old = xb_add(&bar[XB_XSUB(b.x)], 1u);
        const unsigned gen = old / nloc;
        if (old + 1u == (gen + 1u) * nloc) {
            __builtin_amdgcn_fence(__ATOMIC_RELEASE, "agent");
            asm volatile("s_waitcnt vmcnt(0)" ::: "memory");
            const unsigned og = xb_add(&bar[XB_TOP], 1u);
            const unsigned tg = og / nx;
            if (og + 1u == (tg + 1u) * nx) xb_add(&bar[XB_TOPGEN], 1u);
            else XB_SPIN(xb_ld(&bar[XB_TOPGEN]) == tg, bar);
            __builtin_amdgcn_fence(__ATOMIC_ACQUIRE, "agent");
            xb_add(&bar[XB_XGEN(b.x)], 1u);
            asm volatile("s_waitcnt vmcnt(0)" ::: "memory");
        } else {
            XB_SPIN(xb_ld(&bar[XB_XGEN(b.x)]) == gen, bar);
            __builtin_amdgcn_fence(__ATOMIC_ACQUIRE, "agent");
            asm volatile("s_waitcnt vmcnt(0)" ::: "memory");
        }
    }
    __syncthreads();
}

struct Frame {
    LAS unsigned char* lds;
    int tid, lane, wave, vcu, G;
};

__device__ __forceinline__ int remap0(int n) { return n < 1536 ? n : (n < 1544 ? 3072 + (n - 1536) : n - 8); }
__device__ __forceinline__ void p0_transpose_item(const float* W, int K, int N, bf16_t* WT, const float* g, bool remap, LAS float* scr, int item, int lane) {
    const int nblk = (N + 31) / 32, kb = item / nblk, nb = item % nblk, k0 = 64 * kb, n0 = 32 * nb;
#pragma unroll 8
    for (int i = 0; i < 32; ++i) { const int kk = 2 * i + (lane >> 5), n = n0 + (lane & 31);
        float v = (n < N) ? W[(size_t)(k0 + kk) * N + n] : 0.f; if (g) v *= g[k0 + kk]; scr[kk * 33 + (lane & 31)] = v; }
    LDS_WAIT(); asm volatile("" ::: "memory");
    const int c = lane & 7;
#pragma unroll
    for (int j = 0; j < 4; ++j) { const int nl = (lane >> 3) + 8 * j, n = n0 + nl; const LAS float* s = scr + (8 * c) * 33 + nl;
        u32x4 o; o.x = pk2(s[0 * 33], s[1 * 33]); o.y = pk2(s[2 * 33], s[3 * 33]); o.z = pk2(s[4 * 33], s[5 * 33]); o.w = pk2(s[6 * 33], s[7 * 33]);
        if (n < N) { const int nn = remap ? remap0(n) : n; *(u32x4*)(WT + (size_t)nn * K + k0 + 8 * c) = o; } }
    LDS_WAIT(); asm volatile("" ::: "memory");
}
__device__ __forceinline__ float cvt_row_1024(const float* src, bf16_t* dst, const float* g, int lane) {
    const f32x4 a0 = *(const f32x4*)(src + 8 * lane), a1 = *(const f32x4*)(src + 8 * lane + 4), c0 = *(const f32x4*)(src + 512 + 8 * lane), c1 = *(const f32x4*)(src + 516 + 8 * lane);
    float ss = (a0[0] * a0[0] + a0[1] * a0[1]) + (a0[2] * a0[2] + a0[3] * a0[3]) + (a1[0] * a1[0] + a1[1] * a1[1]) + (a1[2] * a1[2] + a1[3] * a1[3])
             + (c0[0] * c0[0] + c0[1] * c0[1]) + (c0[2] * c0[2] + c0[3] * c0[3]) + (c1[0] * c1[0] + c1[1] * c1[1]) + (c1[2] * c1[2] + c1[3] * c1[3]);
    f32x4 b0 = a0, b1 = a1, d0 = c0, d1 = c1;
    if (g) { b0 = b0 * *(const f32x4*)(g + 8 * lane); b1 = b1 * *(const f32x4*)(g + 8 * lane + 4); d0 = d0 * *(const f32x4*)(g + 512 + 8 * lane); d1 = d1 * *(const f32x4*)(g + 516 + 8 * lane); }
    *(u32x4*)(dst + 8 * lane) = pack8(b0, b1); *(u32x4*)(dst + 512 + 8 * lane) = pack8(d0, d1);
    return ss;
}

constexpr float I8_SV = 64.f;
constexpr float I4_SV = 8.44f;
constexpr float I4_SU = 95.5f;
constexpr float I8_SU = 600.f, I8_SX = 127.f / 6.f;
constexpr float FP8_SU = 64.f, FP8_SV = 8.f;
__device__ __forceinline__ void cvt_row_fp8_sliced(const float* src, unsigned char* tab  , int e, const float* g, float scale, int lane) {
#pragma unroll
    for (int j = 0; j < 4; ++j) { f32x4 a = *(const f32x4*)(src + 256 * j + 4 * lane) * scale; if (g) a = a * *(const f32x4*)(g + 256 * j + 4 * lane);
        int w = 0; w = __builtin_amdgcn_cvt_pk_bf8_f32(a[0], a[1], w, false); w = __builtin_amdgcn_cvt_pk_bf8_f32(a[2], a[3], w, true);
        const int x = 2 * j + (lane >> 5);
        *(unsigned*)(tab + ((size_t)x * NEXP + e) * 128 + 4 * (lane & 31)) = (unsigned)w; }
}
__device__ __forceinline__ void cvt_row_i8_sliced(const float* src, unsigned char* tab  , int e, const float* g, float scale, int lane) {
#pragma unroll
    for (int j = 0; j < 4; ++j) { f32x4 a = *(const f32x4*)(src + 256 * j + 4 * lane) * scale; if (g) a = a * *(const f32x4*)(g + 256 * j + 4 * lane);
        unsigned w = 0u;
#pragma unroll
        for (int q = 0; q < 4; ++q) { int v = __float2int_rn(a[q]); v = v < -127 ? -127 : (v > 127 ? 127 : v); w |= ((unsigned)v & 0xffu) << (8 * q); }
        const int x = 2 * j + (lane >> 5);
        *(unsigned*)(tab + ((size_t)x * NEXP + e) * 128 + 4 * (lane & 31)) = w; }
}
struct Ptrs {
    const float *x, *norm_mix, *norm_ffn, *ev_w_in, *ev_b_f, *ev_w_out, *od_w_in, *od_pool_w, *od_pool_scale, *od_w_out, *peer_wq, *peer_k1, *peer_k2, *peer_u, *peer_v, *norm_f;
    float* out; unsigned char* ws;
};

__device__ __forceinline__ void phase_p0(Frame& F, const Ptrs& P) {
    LAS float* scr = (LAS float*)(F.lds + F.wave * 16384);
    const int gw = F.vcu * NWAVES + F.wave, NGW = F.G * NWAVES, lane = opaque_i(F.lane);
    unsigned char* ws = P.ws;
    bf16_t* W1T = (bf16_t*)(ws + WS_W1T); bf16_t* W2T = (bf16_t*)(ws + WS_W2T); bf16_t* W4T = (bf16_t*)(ws + WS_W4T); bf16_t* W5T = (bf16_t*)(ws + WS_W5T);
    bf16_t* W3T = (bf16_t*)(ws + WS_W3T); bf16_t* W6T = (bf16_t*)(ws + WS_W6T); bf16_t* PWT = (bf16_t*)(ws + WS_PWT);
    constexpr int I1 = 16 * 97, I2 = 16 * 32, I4 = 16 * 64, I5 = I2, I3 = I4, I6 = I4, IP = 4 * 2 * 4;
    constexpr int NTR = I1 + I2 + I4 + I5 + I3 + I6 + IP;
    for (int it = gw; it < NTR; it += NGW) {
        int r = it;
        if (r < I1) { p0_transpose_item(P.ev_w_in, DM, EVEN_IN, W1T, P.norm_mix, true, scr, r, lane); continue; } r -= I1;
        if (r < I2) { p0_transpose_item(P.ev_w_out, DM, DM, W2T, nullptr, false, scr, r, lane); continue; } r -= I2;
        if (r < I4) { p0_transpose_item(P.od_w_in, DM, 2048, W4T, P.norm_mix + DM, false, scr, r, lane); continue; } r -= I4;
        if (r < I5) { p0_transpose_item(P.od_w_out, DM, DM, W5T, nullptr, false, scr, r, lane); continue; } r -= I5;
        if (r < I3) { p0_transpose_item(P.peer_wq, DM, 2048, W3T, P.norm_ffn, false, scr, r, lane); continue; } r -= I3;
        if (r < I6) { p0_transpose_item(P.peer_wq + (size_t)DM * 2048, DM, 2048, W6T, P.norm_ffn + DM, false, scr, r, lane); continue; } r -= I6;
        { const int g = r >> 3; p0_transpose_item(P.od_pool_w + (size_t)g * 128 * 128, 128, 128, PWT + (size_t)g * 128 * 128, nullptr, false, scr, r & 7, lane); }
    }
    bf16_t* XB = (bf16_t*)(ws + WS_XB); float* RS0 = (float*)(ws + WS_RS0);
    bf16_t* K1B = (bf16_t*)(ws + WS_K1B); bf16_t* K2B = (bf16_t*)(ws + WS_K2B);
    f32x4 wf[16][2];
    __syncthreads();
    { LAS float* wl = (LAS float*)F.lds;
      for (int k = F.tid; k < DM; k += NWAVES * 64) { const float gk = P.norm_mix[k]; const float* wp = P.ev_w_in + (size_t)k * EVEN_IN + 1536; LAS float* d = wl + 8 * k + 4 * (k >> 3);
          *(LAS f32x4*)d = *(const f32x4*)wp * gk; *(LAS f32x4*)(d + 4) = *(const f32x4*)(wp + 4) * gk; }
      __syncthreads();
#pragma unroll
      for (int j = 0; j < 16; ++j) { const int k = (j < 8 ? 0 : 512) + 8 * lane + (j & 7); const LAS float* s = wl + 8 * k + 4 * (k >> 3); wf[j][0] = *(const LAS f32x4*)s; wf[j][1] = *(const LAS f32x4*)(s + 4); } }
    float* LF = (float*)(ws + WS_LF); const float bfl = P.ev_b_f[lane & 7];
    for (int r0 = gw * 4; r0 < TOK; r0 += NGW * 4) {
        f32x4 a[4][4];
#pragma unroll
        for (int q = 0; q < 4; ++q) { const float* s = P.x + (size_t)(r0 + q) * DM + 8 * lane; a[q][0] = *(const f32x4*)s; a[q][1] = *(const f32x4*)(s + 4); a[q][2] = *(const f32x4*)(s + 512); a[q][3] = *(const f32x4*)(s + 516); }
#pragma unroll
        for (int q = 0; q < 4; ++q) { float ss = 0.f;
#pragma unroll
            for (int j = 0; j < 4; ++j) ss += (a[q][j][0] * a[q][j][0] + a[q][j][1] * a[q][j][1]) + (a[q][j][2] * a[q][j][2] + a[q][j][3] * a[q][j][3]);
            bf16_t* d = XB + (size_t)(r0 + q) * DM + 8 * lane; *(u32x4*)d = pack8(a[q][0], a[q][1]); *(u32x4*)(d + 512) = pack8(a[q][2], a[q][3]);
            ss = wave_sum(ss); const float rs = rsqrtf(ss * (1.f / DM) + RMS_EPS); if (lane == 0) RS0[r0 + q] = rs;
            f32x4 g0 = {0.f, 0.f, 0.f, 0.f}, g1 = {0.f, 0.f, 0.f, 0.f};
#pragma unroll
            for (int j = 0; j < 16; ++j) { const float xv = a[q][j >> 2][j & 3]; g0 += wf[j][0] * xv; g1 += wf[j][1] * xv; }
            float gv = 0.f;
#pragma unroll
            for (int h = 0; h < 8; ++h) { const float tot = wave_total(h < 4 ? g0[h & 3] : g1[h & 3]); gv = (lane == h) ? tot : gv; }
            if (lane < 8) { const int r = r0 + q; const float x = gv * rs + bfl; const float ls = fminf(x, 0.f) - log1pf(expf(-fabsf(x)));
                LF[(size_t)((r >> 11) * 8 + lane) * 2048 + (r & 2047)] = ls * LOG2E; }
        }
    }
#pragma unroll 1
    for (int tb = 0; tb < 2; ++tb) {
        const float* srcT = tb ? P.peer_v : P.peer_u; unsigned char* tabT = ws + (tb ? WS_V8S : WS_U8S); const float scale = tb ? I4_SV : I4_SU;
        for (int r0 = gw * 4; r0 < 2 * NEXP; r0 += NGW * 4) {
            const int ly = r0 >= NEXP, e0 = r0 - ly * NEXP; unsigned char* tab = tabT + (size_t)ly * 4 * NEXP * 128;
            f32x4 a[4][4], g[4];
#pragma unroll
            for (int q = 0; q < 4; ++q)
#pragma unroll
                for (int j = 0; j < 4; ++j) a[q][j] = *(const f32x4*)(srcT + (size_t)(r0 + q) * DM + 256 * j + 4 * lane);
#pragma unroll
            for (int j = 0; j < 4; ++j) { g[j] = (f32x4){scale, scale, scale, scale}; if (!tb) g[j] = g[j] * *(const f32x4*)(P.norm_ffn + (ly ? DM : 0) + 256 * j + 4 * lane); }
#pragma unroll
            for (int q = 0; q < 4; ++q)
#pragma unroll
                for (int j = 0; j < 4; ++j) { const f32x4 v = a[q][j] * g[j]; unsigned w = 0u;
                    if (!tb) {
#pragma unroll
                        for (int k = 0; k < 4; ++k) { int iv = __float2int_rn(v[k]); iv = iv < -8 ? -8 : (iv > 7 ? 7 : iv); w |= ((unsigned)iv & 0xfu) << (4 * k); }
                        *(unsigned short*)(tab + ((size_t)j * NEXP + e0 + q) * 128 + 2 * lane) = (unsigned short)w;
                    } else {
#pragma unroll
                        for (int k = 0; k < 4; ++k) { int iv = __float2int_rn(v[k]); iv = iv < -8 ? -8 : (iv > 7 ? 7 : iv); w |= ((unsigned)((k & 1) ? iv : iv + 8) & 0xfu) << (4 * k); }
                        *(unsigned short*)(tab + ((size_t)j * NEXP + e0 + q) * 128 + 2 * lane) = (unsigned short)w; } }
        }
    }
    constexpr int R_Z = EVEN_PAD - EVEN_IN, R_K = 2 * 256;
    for (int it = gw; it < R_Z + R_K; it += NGW) {
        int r = it;
        if (r < R_Z) { bf16_t* d = W1T + (size_t)(EVEN_IN + r) * DM; const u32x4 z = {0u, 0u, 0u, 0u}; *(u32x4*)(d + 8 * lane) = z; *(u32x4*)(d + 512 + 8 * lane) = z; continue; } r -= R_Z;
        if (r < 256) (void)cvt_row_1024(P.peer_k1 + (size_t)r * 1024, K1B + (size_t)r * 1024, nullptr, lane);
        else (void)cvt_row_1024(P.peer_k2 + (size_t)(r - 256) * 1024, K2B + (size_t)(r - 256) * 1024, nullptr, lane);
    }
}

__device__ __forceinline__ void phase_cfscan(Frame& F, const float* LF, float* CFo) {
    const int gw = F.vcu * NWAVES + F.wave, NGW = F.G * NWAVES, lane = opaque_i(F.lane);
    for (int bh = gw; bh < NB * 8; bh += NGW) {
        const float* src = LF + (size_t)bh * 2048 + 32 * lane; float v[32];
#pragma unroll
        for (int i = 0; i < 8; ++i) { const f32x4 w = *(const f32x4*)(src + 4 * i); v[4 * i] = w[0]; v[4 * i + 1] = w[1]; v[4 * i + 2] = w[2]; v[4 * i + 3] = w[3]; }
#pragma unroll
        for (int i = 1; i < 32; ++i) v[i] += v[i - 1];
        const float tot = v[31]; float inc = tot;
#pragma unroll
        for (int o = 1; o < 64; o <<= 1) { const float w = __shfl_up(inc, o); if (lane >= o) inc += w; }
        const float excl = inc - tot; float* dst = CFo + (size_t)bh * 2048 + 32 * lane;
#pragma unroll
        for (int i = 0; i < 8; ++i) { f32x4 w = {v[4 * i] + excl, v[4 * i + 1] + excl, v[4 * i + 2] + excl, v[4 * i + 3] + excl}; *(f32x4*)(dst + 4 * i) = w; }
    }
}
__device__ __forceinline__ void cfscan_block(Frame& F, const float* LF, float* CFo, int bh) {
    LAS float* wt = (LAS float*)(F.lds + RING_BYTES + 2048);
    const int lane = opaque_i(F.lane);
    const f32x4 w = *(const f32x4*)(LF + (size_t)bh * 2048 + 4 * F.tid);
    const float p0 = w[0], p1 = p0 + w[1], p2 = p1 + w[2], p3 = p2 + w[3];
    float inc = p3;
#pragma unroll
    for (int o = 1; o < 64; o <<= 1) { const float u = __shfl_up(inc, o); if (lane >= o) inc += u; }
    if (lane == 63) wt[F.wave] = inc;
    __syncthreads();
    float base = inc - p3;
#pragma unroll
    for (int k = 0; k < NWAVES - 1; ++k) base += (k < F.wave) ? wt[k] : 0.f;
    *(f32x4*)(CFo + (size_t)bh * 2048 + 4 * F.tid) = (f32x4){p0 + base, p1 + base, p2 + base, p3 + base};
    asm volatile("s_waitcnt vmcnt(0)" ::: "memory");
    __syncthreads();
}
__device__ __forceinline__ void phase_kmean(Frame& F, const bf16_t* KD, float* KMEAN, int bh) {
    const int lane = opaque_i(F.lane), jg = lane >> 3, dq = lane & 7;
    for (int it = bh * 8 + F.wave; it < bh * 8 + 8; it += NWAVES) {
        const int bh = it >> 3, blk = it & 7; const bf16_t* src = KD + ((size_t)bh * 2048 + blk * 256 + jg) * 64 + 8 * dq; float s[8] = {0.f, 0.f, 0.f, 0.f, 0.f, 0.f, 0.f, 0.f};
#pragma unroll
        for (int i = 0; i < 32; ++i) { const u32x4 w = *(const u32x4*)(src + (size_t)i * 8 * 64);
            s[0] += bf_lo(w.x); s[1] += bf_hi(w.x); s[2] += bf_lo(w.y); s[3] += bf_hi(w.y); s[4] += bf_lo(w.z); s[5] += bf_hi(w.z); s[6] += bf_lo(w.w); s[7] += bf_hi(w.w); }
#pragma unroll
        for (int k = 0; k < 8; ++k) { s[k] += __shfl_xor(s[k], 8); s[k] += __shfl_xor(s[k], 16); s[k] += __shfl_xor(s[k], 32); }
        if (jg == 0) { float* d = KMEAN + (size_t)it * 64 + 8 * dq; *(f32x4*)d = (f32x4){s[0], s[1], s[2], s[3]} * (1.f / 256.f); *(f32x4*)(d + 4) = (f32x4){s[4], s[5], s[6], s[7]} * (1.f / 256.f); }
    }
}
__device__ __forceinline__ int lgi(int s) { return s + (s >> 5); }
__device__ __forceinline__ float lsn2f(float z2) { return -(fmaxf(z2, 0.f) + __log2f(1.f + exp2f(-fabsf(z2)))); }
template <int KIND>
__device__ __forceinline__ void attn_naive(Frame& F, const bf16_t* QH, const bf16_t* KH, const bf16_t* VT, int NH, int hbase, const float* CF, const float* KMEAN, bf16_t* AO, int ao_col0) {
    LAS float* lg = (LAS float*)(F.lds + F.wave * 8704);
    const int gw = F.vcu * NWAVES + F.wave, NGW = F.G * NWAVES, lane = opaque_i(F.lane);
    for (int qi = gw; qi < NB * 8 * SEQ; qi += NGW) {
        const int bh = qi >> 11, b = bh >> 3, h = bh & 7, hh = hbase + h;
        const int t = (bh & 1) ? (2047 - (qi & 2047)) : (qi & 2047);
        const size_t hb = (size_t)(b * NH + hh);
        const bf16_t* qp = QH + (hb * 2048 + t) * 64; const bf16_t* kp = KH + hb * 2048 * 64;
        float q[64];
#pragma unroll
        for (int c = 0; c < 8; ++c) { const u32x4 w = *(const u32x4*)(qp + 8 * c);
            q[8 * c] = bf_lo(w.x); q[8 * c + 1] = bf_hi(w.x); q[8 * c + 2] = bf_lo(w.y); q[8 * c + 3] = bf_hi(w.y); q[8 * c + 4] = bf_lo(w.z); q[8 * c + 5] = bf_hi(w.z); q[8 * c + 6] = bf_lo(w.w); q[8 * c + 7] = bf_hi(w.w); }
        unsigned sel = 0u; const int qb = t >> 8;
        if (KIND == 2) {
            float gate[8];
#pragma unroll
            for (int n = 0; n < 8; ++n) { const float* km = KMEAN + ((size_t)(b * 8 + h) * 8 + n) * 64; float a = 0.f;
#pragma unroll
                for (int d = 0; d < 64; ++d) a += q[d] * km[d];
                gate[n] = a; }
            const int nsel = qb < 3 ? qb : 3;
#pragma unroll
            for (int r = 0; r < 3; ++r) if (r < nsel) { float best = -INFINITY; int bi = 0;
#pragma unroll
                for (int n = 0; n < 8; ++n) if (n < qb && !((sel >> n) & 1u) && gate[n] > best) { best = gate[n]; bi = n; }
                sel |= 1u << bi; }
        }
        const int nk = (KIND == 1) ? t : t + 1;
        const int tp = (nk + 7) & ~7;
        const float cft = (KIND == 0) ? CF[(size_t)(b * 8 + h) * 2048 + t] : 0.f;
        const float slope2 = (KIND == 2) ? exp2f(-(float)(h + 1)) * LOG2E : 0.f;
        float mloc = -INFINITY;
        for (int s = lane; s < nk; s += 64) {
            float dot = 0.f;
#pragma unroll
            for (int c = 0; c < 8; ++c) { const u32x4 w = *(const u32x4*)(kp + (size_t)s * 64 + 8 * c);
                dot += q[8 * c] * bf_lo(w.x) + q[8 * c + 1] * bf_hi(w.x) + q[8 * c + 2] * bf_lo(w.y) + q[8 * c + 3] * bf_hi(w.y) + q[8 * c + 4] * bf_lo(w.z) + q[8 * c + 5] * bf_hi(w.z) + q[8 * c + 6] * bf_lo(w.w) + q[8 * c + 7] * bf_hi(w.w); }
            float v = dot;
            if (KIND == 0) v += cft - CF[(size_t)(b * 8 + h) * 2048 + s];
            if (KIND == 2) { const int n = s >> 8; const bool valid = (n == qb) || ((sel >> n) & 1u); v = valid ? v + slope2 * (float)(s - t) : -INFINITY; }
            lg[lgi(s)] = v; mloc = fmaxf(mloc, v);
        }
        float linv = 1.f;
        if (KIND != 1) {
            const float m = wave_max(mloc); float lsum = 0.f;
            for (int s = lane; s < tp; s += 64) { const float p = (s < nk) ? exp2f(lg[lgi(s)] - m) : 0.f; lg[lgi(s)] = p; lsum += p; }
            linv = 1.f / wave_sum(lsum);
        } else {
            float tot = 0.f;
            for (int i = 0; i < 32; ++i) { const int s = 32 * lane + i; if (s < nk) tot += lsn2f(lg[lgi(s)]); }
            float inc = tot;
#pragma unroll
            for (int o = 1; o < 64; o <<= 1) { const float w = __shfl_down(inc, o); if (lane + o < 64) inc += w; }
            float run = inc - tot;
            for (int i = 31; i >= 0; --i) { const int s = 32 * lane + i; float a = 0.f;
                if (s < nk) { const float z = lg[lgi(s)], l2 = lsn2f(z); a = exp2f(z + l2 + run); run += l2; }
                if (s < tp) lg[lgi(s)] = a; }
        }
        LDS_WAIT();
        const bf16_t* vp = VT + (hb * 64 + lane) * 2048; float o = 0.f;
        for (int s0 = 0; s0 < tp; s0 += 8) { const u32x4 w = *(const u32x4*)(vp + s0); const int i0 = lgi(s0);
            o += lg[i0] * bf_lo(w.x) + lg[i0 + 1] * bf_hi(w.x) + lg[i0 + 2] * bf_lo(w.y) + lg[i0 + 3] * bf_hi(w.y) + lg[i0 + 4] * bf_lo(w.z) + lg[i0 + 5] * bf_hi(w.z) + lg[i0 + 6] * bf_lo(w.w) + lg[i0 + 7] * bf_hi(w.w); }
        AO[(size_t)(b * 2048 + t) * DM + ao_col0 + h * 64 + lane] = (bf16_t)f2bf(o * linv);
        LDS_WAIT();
    }
}

__device__ __forceinline__ float lsn2q(float z2) { return -(fmaxf(z2, 0.f) + __builtin_amdgcn_logf(1.f + __builtin_amdgcn_exp2f(-fabsf(z2)))); }
__device__ __forceinline__ int pi32(int i) { return (i & ~12) | ((i & 4) << 1) | ((i & 8) >> 1); }
__device__ __forceinline__ void attn_load_k(bf16x8 (&kf)[4], const bf16_t* Kh, int kv0, int r32p, int hi) {
    const bf16_t* p = Kh + (size_t)(kv0 + r32p) * 64 + 8 * hi;
#pragma unroll
    for (int d0 = 0; d0 < 4; ++d0) kf[d0] = *(const bf16x8*)(p + 16 * d0);
}
__device__ __forceinline__ void attn_load_v(bf16x8 (&vf)[2][2], const bf16_t* Vth, int kv0, int r32, int hi) {
#pragma unroll
    for (int s = 0; s < 2; ++s)
#pragma unroll
        for (int dh = 0; dh < 2; ++dh) vf[s][dh] = *(const bf16x8*)(Vth + (size_t)(32 * dh + r32) * 2048 + kv0 + 16 * s + 8 * hi);
}
template <int KIND, int MODE>
__device__ __forceinline__ void attn_tile(const bf16x8 (&qr)[4], const bf16x8 (&kf)[4], const bf16x8 (&vf)[2][2], f32x16& O0, f32x16& O1, float& m, float& l, float& R,
                                          const f32x16& bias, const int kv0, const int q, const int hi, const bool rowok) {
    f32x16 S = bias;
#pragma unroll
    for (int d0 = 0; d0 < 4; ++d0) S = __builtin_amdgcn_mfma_f32_32x32x16_bf16(kf[d0], qr[d0], S, 0, 0, 0);
    if (MODE == 1) {
#pragma unroll
        for (int r = 0; r < 16; ++r) { const int key = kv0 + (r & 7) + 8 * hi + 16 * (r >> 3); const bool bad = (KIND == 1) ? (key >= q) : (key > q); if (bad) S[r] = -INFINITY; }
    }
    if (MODE == 2) { if (!rowok) {
#pragma unroll
        for (int r = 0; r < 16; ++r) S[r] = -INFINITY; } }
    float p[16];
    if (KIND != 1) {
        float rm = fmaxf(fmaxf(S[0], S[1]), fmaxf(S[2], S[3]));
#pragma unroll
        for (int r = 4; r < 16; r += 4) rm = fmaxf(rm, fmaxf(fmaxf(S[r], S[r + 1]), fmaxf(S[r + 2], S[r + 3])));
        rm = fmaxf(rm, __shfl_xor(rm, 32));
        const float mn = fmaxf(fmaxf(m, rm), -1e30f); const float alpha = __builtin_amdgcn_exp2f(m - mn);
        float ps = 0.f;
#pragma unroll
        for (int r = 0; r < 16; ++r) { p[r] = __builtin_amdgcn_exp2f(S[r] - mn); ps += p[r]; }
        l = l * alpha + ps; m = mn;
        O0 *= alpha; O1 *= alpha;
    } else {
        float l2[16]; float sLo = 0.f, sHi = 0.f;
#pragma unroll
        for (int r = 0; r < 16; ++r) l2[r] = lsn2q(S[r]);
#pragma unroll
        for (int r = 0; r < 8; ++r) { sLo += l2[r]; sHi += l2[8 + r]; }
        const float pLo = __shfl_xor(sLo, 32), pHi = __shfl_xor(sHi, 32);
        float run = hi ? R : R + pHi;
#pragma unroll
        for (int r = 15; r >= 8; --r) { p[r] = __builtin_amdgcn_exp2f(S[r] + l2[r] + run); run += l2[r]; }
        run = hi ? (R + sHi + pHi) : (R + pHi + sHi + pLo);
#pragma unroll
        for (int r = 7; r >= 0; --r) { p[r] = __builtin_amdgcn_exp2f(S[r] + l2[r] + run); run += l2[r]; }
        R += (sLo + sHi) + (pLo + pHi);
    }
    u32x4 w0, w1;
    w0.x = pk2(p[0], p[1]); w0.y = pk2(p[2], p[3]); w0.z = pk2(p[4], p[5]); w0.w = pk2(p[6], p[7]);
    w1.x = pk2(p[8], p[9]); w1.y = pk2(p[10], p[11]); w1.z = pk2(p[12], p[13]); w1.w = pk2(p[14], p[15]);
    const bf16x8 pf0 = __builtin_bit_cast(bf16x8, w0), pf1 = __builtin_bit_cast(bf16x8, w1);
    O0 = __builtin_amdgcn_mfma_f32_32x32x16_bf16(vf[0][0], pf0, O0, 0, 0, 0); O0 = __builtin_amdgcn_mfma_f32_32x32x16_bf16(vf[1][0], pf1, O0, 0, 0, 0);
    O1 = __builtin_amdgcn_mfma_f32_32x32x16_bf16(vf[0][1], pf0, O1, 0, 0, 0); O1 = __builtin_amdgcn_mfma_f32_32x32x16_bf16(vf[1][1], pf1, O1, 0, 0, 0);
}
template <int KIND>
__device__ __forceinline__ f32x16 attn_bias(const float* CFh, float slope2, int kv0, int q0, int hi) {
    f32x16 b = f32x16{};
    if (KIND == 0) { const float* c = CFh + kv0 + 8 * hi; const f32x4 a0 = *(const f32x4*)c, a1 = *(const f32x4*)(c + 4), a2 = *(const f32x4*)(c + 16), a3 = *(const f32x4*)(c + 20);
        b[0] = -a0[0]; b[1] = -a0[1]; b[2] = -a0[2]; b[3] = -a0[3]; b[4] = -a1[0]; b[5] = -a1[1]; b[6] = -a1[2]; b[7] = -a1[3];
        b[8] = -a2[0]; b[9] = -a2[1]; b[10] = -a2[2]; b[11] = -a2[3]; b[12] = -a3[0]; b[13] = -a3[1]; b[14] = -a3[2]; b[15] = -a3[3]; }
    if (KIND == 2) {
#pragma unroll
        for (int r = 0; r < 16; ++r) b[r] = slope2 * (float)(kv0 + (r & 7) + 8 * hi + 16 * (r >> 3) - q0); }
    return b;
}
template <int KIND>
__device__ __forceinline__ void attn_wave(const bf16_t* Qh, const bf16_t* Kh, const bf16_t* Vth, const int q0, const int lane, const float* CFh, const float slope2, const float* KMh, bf16_t* AOp) {
    const int r32 = lane & 31, hi = lane >> 5, r32p = pi32(r32), q = q0 + r32;
    bf16x8 qr[4];
#pragma unroll
    for (int d0 = 0; d0 < 4; ++d0) qr[d0] = *(const bf16x8*)(Qh + (size_t)q * 64 + 16 * d0 + 8 * hi);
    f32x16 O0 = f32x16{}, O1 = f32x16{};
    float m = -INFINITY, l = 0.f, R = 0.f;
    bf16x8 kf[4], kfn[4], vf[2][2];
    const int nt = q0 / 32 + 1;
    if (KIND == 0) {
        attn_load_k(kf, Kh, 0, r32p, hi);
        for (int it = 0; it < nt; ++it) { const int kv0 = 32 * it;
            attn_load_v(vf, Vth, kv0, r32, hi); const f32x16 bias = attn_bias<0>(CFh, 0.f, kv0, q0, hi);
            if (it + 1 < nt) attn_load_k(kfn, Kh, kv0 + 32, r32p, hi);
            if (it == nt - 1) attn_tile<0, 1>(qr, kf, vf, O0, O1, m, l, R, bias, kv0, q, hi, true); else attn_tile<0, 0>(qr, kf, vf, O0, O1, m, l, R, bias, kv0, q, hi, true);
#pragma unroll
            for (int d0 = 0; d0 < 4; ++d0) kf[d0] = kfn[d0]; }
    } else if (KIND == 1) {
        attn_load_k(kf, Kh, 32 * (nt - 1), r32p, hi);
        for (int it = nt - 1; it >= 0; --it) { const int kv0 = 32 * it;
            attn_load_v(vf, Vth, kv0, r32, hi); const f32x16 bias = f32x16{};
            if (it > 0) attn_load_k(kfn, Kh, kv0 - 32, r32p, hi);
            if (it == nt - 1) attn_tile<1, 1>(qr, kf, vf, O0, O1, m, l, R, bias, kv0, q, hi, true); else attn_tile<1, 0>(qr, kf, vf, O0, O1, m, l, R, bias, kv0, q, hi, true);
#pragma unroll
            for (int d0 = 0; d0 < 4; ++d0) kf[d0] = kfn[d0];
            if (__all(R < -200.f)) break; }
    } else {
        const int qb = q0 >> 8;
        f32x16 G = f32x16{};
#pragma unroll
        for (int d0 = 0; d0 < 4; ++d0) { u32x4 kw = {0u, 0u, 0u, 0u};
            if (r32 < 8) { const float* kmp = KMh + r32 * 64 + 16 * d0 + 8 * hi; kw = pack8(*(const f32x4*)kmp, *(const f32x4*)(kmp + 4)); }
            G = __builtin_amdgcn_mfma_f32_32x32x16_bf16(__builtin_bit_cast(bf16x8, kw), qr[d0], G, 0, 0, 0); }
        float gate[8];
#pragma unroll
        for (int n = 0; n < 4; ++n) { const float own = G[n], oth = __shfl_xor(own, 32); gate[n] = hi ? oth : own; gate[n + 4] = hi ? own : oth; }
        unsigned sel = 0u; const int nsel = qb < 3 ? qb : 3;
#pragma unroll
        for (int r = 0; r < 3; ++r) if (r < nsel) { float best = -INFINITY; int bi = 0;
#pragma unroll
            for (int n = 0; n < 8; ++n) if (n < qb && !((sel >> n) & 1u) && gate[n] > best) { best = gate[n]; bi = n; }
            sel |= 1u << bi; }
        for (int kv0 = 256 * qb; kv0 <= q0; kv0 += 32) {
            attn_load_k(kf, Kh, kv0, r32p, hi); attn_load_v(vf, Vth, kv0, r32, hi); const f32x16 bias = attn_bias<2>(nullptr, slope2, kv0, q0, hi);
            if (kv0 == q0) attn_tile<2, 1>(qr, kf, vf, O0, O1, m, l, R, bias, kv0, q, hi, true); else attn_tile<2, 0>(qr, kf, vf, O0, O1, m, l, R, bias, kv0, q, hi, true); }
        for (int j = 0; j < qb; ++j) { const bool rowok = (sel >> j) & 1u;
            if (!__any(rowok)) continue;
            attn_load_k(kf, Kh, 256 * j, r32p, hi);
            for (int i = 0; i < 8; ++i) { const int kv0 = 256 * j + 32 * i;
                attn_load_v(vf, Vth, kv0, r32, hi); const f32x16 bias = attn_bias<2>(nullptr, slope2, kv0, q0, hi);
                if (i < 7) attn_load_k(kfn, Kh, kv0 + 32, r32p, hi);
                attn_tile<2, 2>(qr, kf, vf, O0, O1, m, l, R, bias, kv0, q, hi, rowok);
#pragma unroll
                for (int d0 = 0; d0 < 4; ++d0) kf[d0] = kfn[d0]; } }
    }
    float linv = 1.f;
    if (KIND != 1) linv = 1.f / (l + __shfl_xor(l, 32));
    bf16_t* orow = AOp + (size_t)q * DM;
#pragma unroll
    for (int g = 0; g < 4; ++g) { u32x2 w;
        w.x = pk2(O0[4 * g] * linv, O0[4 * g + 1] * linv); w.y = pk2(O0[4 * g + 2] * linv, O0[4 * g + 3] * linv); *(u32x2*)(orow + 8 * g + 4 * hi) = w;
        w.x = pk2(O1[4 * g] * linv, O1[4 * g + 1] * linv); w.y = pk2(O1[4 * g + 2] * linv, O1[4 * g + 3] * linv); *(u32x2*)(orow + 32 + 8 * g + 4 * hi) = w; }
}
template <int KIND>
__device__ __forceinline__ void phase_attn(Frame& F, const bf16_t* QH, const bf16_t* KH, const bf16_t* VT, int NH, int hbase, const float* CF, const float* KMEAN, bf16_t* AO, int ao_col0) {
    for (int ug = F.vcu; ug < NB * 8 * 2; ug += F.G) {
        const int bh = ug >> 1, b = bh >> 3, h = bh & 7, hh = hbase + h; const size_t hb = (size_t)(b * NH + hh);
        const float slope2 = __builtin_amdgcn_exp2f(-(float)(h + 1)) * LOG2E;
#pragma unroll 1
        for (int i = 0; i < 4; ++i) { const int base = (i >> 1) * 2 + (ug & 1), qb = (i & 1) ? 7 - base : base, w = (i & 1) ? 7 - F.wave : F.wave;
            attn_wave<KIND>(QH + hb * 2048 * 64, KH + hb * 2048 * 64, VT + hb * 64 * 2048, 256 * qb + 32 * w, opaque_i(F.lane),
                            CF ? CF + (size_t)bh * 2048 : nullptr, slope2, KMEAN ? KMEAN + (size_t)bh * 8 * 64 : nullptr, AO + (size_t)b * 2048 * DM + ao_col0 + h * 64); }
    }
}


__device__ __forceinline__ float rowmax16_raw(const f32x16& S) {
    float r, ta, tb;
    asm("s_nop 11\n\tv_max3_f32 %0, %3, %4, %5\n\tv_max3_f32 %1, %6, %7, %8\n\tv_max3_f32 %2, %9, %10, %11\n\tv_max3_f32 %0, %0, %1, %2\n\t"
        "v_max3_f32 %1, %12, %13, %14\n\tv_max3_f32 %2, %15, %16, %17\n\tv_max3_f32 %1, %1, %2, %18\n\tv_max_f32 %0, %0, %1"
        : "=&v"(r), "=&v"(ta), "=&v"(tb)
        : "v"(S[0]), "v"(S[1]), "v"(S[2]), "v"(S[3]), "v"(S[4]), "v"(S[5]), "v"(S[6]), "v"(S[7]), "v"(S[8]), "v"(S[9]), "v"(S[10]), "v"(S[11]), "v"(S[12]), "v"(S[13]), "v"(S[14]), "v"(S[15]));
    return r;
}
__device__ __forceinline__ float max2_raw(float a, float b) { float d; asm("v_max_f32 %0, %1, %2" : "=v"(d) : "v"(a), "v"(b)); return d; }
constexpr int AT_SLOT = 16384, AT_CF = 4 * AT_SLOT;
__device__ __forceinline__ void attn_dma_tile(const bf16_t* Kh, const bf16_t* Vth, int T, LAS unsigned char* slot, int wave, int r32, int r32p, int hi) {
    const int j = wave >> 2, d0 = wave & 3, s2 = (wave >> 1) & 1, dh = wave & 1;
    const bf16_t* ks = Kh + (size_t)(64 * T + 32 * j + r32p) * 64 + 16 * d0 + 8 * hi;
    const bf16_t* vs = Vth + (size_t)(32 * dh + r32) * 2048 + 64 * T + 32 * j + 16 * s2 + 8 * hi;
    __builtin_amdgcn_global_load_lds((const unsigned*)ks, (LAS unsigned*)(slot + (j * 4 + d0) * 1024), 16, 0, 0);
    __builtin_amdgcn_global_load_lds((const unsigned*)vs, (LAS unsigned*)(slot + 8192 + ((j * 2 + s2) * 2 + dh) * 1024), 16, 0, 0);
}
template <int MODE>
__device__ __forceinline__ void attn_fox_sub(const bf16x8 (&qr)[4], f32x16& O0, f32x16& O1, float& m, float& l, unsigned saddr  , unsigned cfaddr  , int j, int kv0, int q, int hi) {
    bf16x8 kf[4], vf[2][2]; f32x4 c0, c1, c2, c3;
    asm volatile("ds_read_b128 %0, %12\n\tds_read_b128 %1, %12 offset:1024\n\tds_read_b128 %2, %12 offset:2048\n\tds_read_b128 %3, %12 offset:3072\n\t"
                 "ds_read_b128 %4, %13\n\tds_read_b128 %5, %13 offset:1024\n\tds_read_b128 %6, %13 offset:2048\n\tds_read_b128 %7, %13 offset:3072\n\t"
                 "ds_read_b128 %8, %14\n\tds_read_b128 %9, %14 offset:16\n\tds_read_b128 %10, %14 offset:64\n\tds_read_b128 %11, %14 offset:80\n\ts_waitcnt lgkmcnt(0)"
                 : "=&v"(kf[0]), "=&v"(kf[1]), "=&v"(kf[2]), "=&v"(kf[3]), "=&v"(vf[0][0]), "=&v"(vf[0][1]), "=&v"(vf[1][0]), "=&v"(vf[1][1]), "=&v"(c0), "=&v"(c1), "=&v"(c2), "=&v"(c3)
                 : "v"(saddr + (unsigned)j * 4096u), "v"(saddr + 8192u + (unsigned)j * 4096u), "v"(cfaddr) : "memory");
    f32x16 S;
    S[0] = c0[0]; S[1] = c0[1]; S[2] = c0[2]; S[3] = c0[3]; S[4] = c1[0]; S[5] = c1[1]; S[6] = c1[2]; S[7] = c1[3];
    S[8] = c2[0]; S[9] = c2[1]; S[10] = c2[2]; S[11] = c2[3]; S[12] = c3[0]; S[13] = c3[1]; S[14] = c3[2]; S[15] = c3[3];
#pragma unroll
    for (int d0 = 0; d0 < 4; ++d0) S = __builtin_amdgcn_mfma_f32_32x32x16_bf16(kf[d0], qr[d0], S, 0, 0, 0);
    if (MODE == 1) {
#pragma unroll
        for (int r = 0; r < 16; ++r) { const int key = kv0 + (r & 7) + 8 * hi + 16 * (r >> 3); if (key > q) S[r] = -INFINITY; }
    }
    float rm = rowmax16_raw(S);
    { const auto rr = __builtin_amdgcn_permlane32_swap(__float_as_uint(rm), __float_as_uint(rm), false, false); rm = max2_raw(__uint_as_float(rr[0]), __uint_as_float(rr[1])); }
    if (__any(rm > m)) {
        const float mn = fmaxf(fmaxf(m, rm), -1e30f); const float alpha = __builtin_amdgcn_exp2f(m - mn);
        l *= alpha; O0 *= alpha; O1 *= alpha; m = mn; }
    float p[16]; float ps = 0.f;
#pragma unroll
    for (int r = 0; r < 16; ++r) { p[r] = __builtin_amdgcn_exp2f(S[r] - m); ps += p[r]; }
    l += ps;
    u32x4 w0, w1;
    w0.x = pk2(p[0], p[1]); w0.y = pk2(p[2], p[3]); w0.z = pk2(p[4], p[5]); w0.w = pk2(p[6], p[7]);
    w1.x = pk2(p[8], p[9]); w1.y = pk2(p[10], p[11]); w1.z = pk2(p[12], p[13]); w1.w = pk2(p[14], p[15]);
    const bf16x8 pf0 = __builtin_bit_cast(bf16x8, w0), pf1 = __builtin_bit_cast(bf16x8, w1);
    O0 = __builtin_amdgcn_mfma_f32_32x32x16_bf16(vf[0][0], pf0, O0, 0, 0, 0); O0 = __builtin_amdgcn_mfma_f32_32x32x16_bf16(vf[1][0], pf1, O0, 0, 0, 0);
    O1 = __builtin_amdgcn_mfma_f32_32x32x16_bf16(vf[0][1], pf0, O1, 0, 0, 0); O1 = __builtin_amdgcn_mfma_f32_32x32x16_bf16(vf[1][1], pf1, O1, 0, 0, 0);
}
__device__ __forceinline__ float kmax2_block(Frame& F, const bf16_t* Kh) {
    LAS float* wt = (LAS float*)(F.lds + RING_BYTES + 2048 + 64);
    float mx = 0.f;
#pragma unroll
    for (int key = F.tid; key < 2048; key += NWAVES * 64) { const u32x4* p = (const u32x4*)(Kh + (size_t)key * 64); float s = 0.f;
#pragma unroll
        for (int j = 0; j < 8; ++j) { const u32x4 w = p[j]; s += (bf_lo(w.x) * bf_lo(w.x) + bf_hi(w.x) * bf_hi(w.x)) + (bf_lo(w.y) * bf_lo(w.y) + bf_hi(w.y) * bf_hi(w.y)) + (bf_lo(w.z) * bf_lo(w.z) + bf_hi(w.z) * bf_hi(w.z)) + (bf_lo(w.w) * bf_lo(w.w) + bf_hi(w.w) * bf_hi(w.w)); }
        mx = fmaxf(mx, s); }
    mx = wave_max(mx);
    __syncthreads();
    if (F.lane == 0) wt[F.wave] = mx;
    __syncthreads();
    float r = wt[0];
#pragma unroll
    for (int k = 1; k < NWAVES; ++k) r = fmaxf(r, wt[k]);
    return r;
}
__device__ __forceinline__ void attn_fox_unit(Frame& F, const bf16_t* Qh, const bf16_t* Kh, const bf16_t* Vth, const float* CFh, const int qb, bf16_t* AOp, const float k2max) {
    const int lane = opaque_i(F.lane), r32 = lane & 31, hi = lane >> 5, r32p = pi32(r32), wave = F.wave, q0 = 256 * qb + 32 * wave, q = q0 + r32;
    LAS unsigned char* ring = F.lds; const unsigned ring_a = (unsigned)(uintptr_t)ring + 16u * (unsigned)lane, cf_a = (unsigned)(uintptr_t)ring + (unsigned)AT_CF + 32u * (unsigned)hi;
    bf16x8 qr[4];
#pragma unroll
    for (int d0 = 0; d0 < 4; ++d0) qr[d0] = *(const bf16x8*)(Qh + (size_t)q * 64 + 16 * d0 + 8 * hi);
    LAS float* xs = (LAS float*)(ring + AT_CF + 8192);
    const f32x4 cv = *(const f32x4*)(CFh + 4 * F.tid);
    { float q2 = 0.f;
#pragma unroll
      for (int d0 = 0; d0 < 4; ++d0) { const u32x4 w = __builtin_bit_cast(u32x4, qr[d0]); q2 += (bf_lo(w.x) * bf_lo(w.x) + bf_hi(w.x) * bf_hi(w.x)) + (bf_lo(w.y) * bf_lo(w.y) + bf_hi(w.y) * bf_hi(w.y)) + (bf_lo(w.z) * bf_lo(w.z) + bf_hi(w.z) * bf_hi(w.z)) + (bf_lo(w.w) * bf_lo(w.w) + bf_hi(w.w) * bf_hi(w.w)); }
      q2 += __shfl_xor(q2, 32); q2 = wave_max(q2); if (lane == 0) xs[wave] = q2; }
    *(LAS f32x4*)(ring + AT_CF + 16 * F.tid) = -cv;
    asm volatile("s_waitcnt vmcnt(0) lgkmcnt(0)" ::: "memory"); __builtin_amdgcn_s_barrier();
    int Tmin;
    { float q2m = xs[0];
#pragma unroll
      for (int k = 1; k < NWAVES; ++k) q2m = fmaxf(q2m, xs[k]);
      const float B = __builtin_sqrtf(q2m * k2max) * 1.02f + 1.f, cq0 = -*(LAS const float*)(ring + AT_CF + 4 * (256 * qb)), thr = cq0 + 2.f * B + 160.f;
      const float cnt = wave_total((float)((cv[0] > thr) + (cv[1] > thr) + (cv[2] > thr) + (cv[3] > thr)));
      if (lane == 0) xs[16 + wave] = cnt;
      asm volatile("s_waitcnt lgkmcnt(0)" ::: "memory"); __builtin_amdgcn_s_barrier();
      float tot = xs[16];
#pragma unroll
      for (int k = 1; k < NWAVES; ++k) tot += xs[16 + k];
      Tmin = (int)tot >> 6; if (Tmin > 4 * qb) Tmin = 4 * qb; Tmin = __builtin_amdgcn_readfirstlane(Tmin); }
    const int NT = 4 * qb + 4, my_last = 4 * qb + (wave >> 1), jdiag = wave & 1;
    attn_dma_tile(Kh, Vth, NT - 1, ring, wave, r32, r32p, hi);
    attn_dma_tile(Kh, Vth, NT - 2, ring + AT_SLOT, wave, r32, r32p, hi);
    attn_dma_tile(Kh, Vth, NT - 3, ring + 2 * AT_SLOT, wave, r32, r32p, hi);
    f32x16 O0 = f32x16{}, O1 = f32x16{}; float m = -INFINITY, l = 0.f;
    int slot = 0;
#pragma unroll 1
    for (int T = NT - 1; T >= Tmin; --T) {
        if (T - Tmin >= 2) asm volatile("s_waitcnt vmcnt(4)" ::: "memory"); else if (T - Tmin == 1) asm volatile("s_waitcnt vmcnt(2)" ::: "memory"); else asm volatile("s_waitcnt vmcnt(0)" ::: "memory");
        __builtin_amdgcn_s_barrier();
        if (T - 3 >= Tmin) { const int fs = (slot + 3) & 3; attn_dma_tile(Kh, Vth, T - 3, ring + fs * AT_SLOT, wave, r32, r32p, hi); }
        if (T <= my_last) {
            const unsigned sa = ring_a + (unsigned)(slot * AT_SLOT);
            if (T == my_last) {
                if (jdiag == 1) { attn_fox_sub<1>(qr, O0, O1, m, l, sa, cf_a + 4u * (unsigned)(64 * T + 32), 1, 64 * T + 32, q, hi); attn_fox_sub<0>(qr, O0, O1, m, l, sa, cf_a + 4u * (unsigned)(64 * T), 0, 64 * T, q, hi); }
                else attn_fox_sub<1>(qr, O0, O1, m, l, sa, cf_a + 4u * (unsigned)(64 * T), 0, 64 * T, q, hi);
            } else { attn_fox_sub<0>(qr, O0, O1, m, l, sa, cf_a + 4u * (unsigned)(64 * T + 32), 1, 64 * T + 32, q, hi); attn_fox_sub<0>(qr, O0, O1, m, l, sa, cf_a + 4u * (unsigned)(64 * T), 0, 64 * T, q, hi); }
        }
        slot = (slot + 1) & 3;
    }
    const float linv = 1.f / (l + __shfl_xor(l, 32));
    bf16_t* orow = AOp + (size_t)q * DM;
#pragma unroll
    for (int g = 0; g < 4; ++g) { u32x2 w;
        w.x = pk2(O0[4 * g] * linv, O0[4 * g + 1] * linv); w.y = pk2(O0[4 * g + 2] * linv, O0[4 * g + 3] * linv); *(u32x2*)(orow + 8 * g + 4 * hi) = w;
        w.x = pk2(O1[4 * g] * linv, O1[4 * g + 1] * linv); w.y = pk2(O1[4 * g + 2] * linv, O1[4 * g + 3] * linv); *(u32x2*)(orow + 32 + 8 * g + 4 * hi) = w; }
    asm volatile("s_waitcnt vmcnt(0) lgkmcnt(0)" ::: "memory"); __builtin_amdgcn_s_barrier();
}
__device__ __forceinline__ void phase_attn_fox(Frame& F, const bf16_t* QH, const bf16_t* KH, const bf16_t* VT, const float* LF, float* CF, bf16_t* AO) {
    for (int ug = F.vcu; ug < NB * 8 * 2; ug += F.G) {
        const int bh = ug >> 1, b = bh >> 3, h = bh & 7; const size_t hb = (size_t)(b * 16 + h);
        cfscan_block(F, LF, CF, bh);
        const float k2max = kmax2_block(F, KH + hb * 2048 * 64);
#pragma unroll 1
        for (int i = 0; i < 4; ++i) { const int base = (i >> 1) * 2 + (ug & 1), qb = (i & 1) ? 7 - base : base;
            attn_fox_unit(F, QH + hb * 2048 * 64, KH + hb * 2048 * 64, VT + hb * 64 * 2048, CF + (size_t)bh * 2048, qb, AO + (size_t)b * 2048 * DM + h * 64, k2max); }
    }
}

__device__ __forceinline__ void phase_attn_sb_dyn(Frame& F, const bf16_t* QH, const bf16_t* KH, const bf16_t* VT, bf16_t* AO, unsigned* ctr) {
    LAS int* slotw = (LAS int*)(F.lds + AT_CF + 8192 + 256);
    for (;;) {
        __syncthreads();
        if (F.tid == 0) *slotw = (int)atomicAdd(ctr, 1u);
        __syncthreads();
        const int k = *slotw; if (k >= NB * 8 * 2 * 4) break;
        const int r = k >> 8, i = (r == 0) ? 1 : (r == 1) ? 3 : (r == 2) ? 2 : 0, ug = k & 255;
        const int bh = ug >> 1, b = bh >> 3, h = bh & 7; const size_t hb = (size_t)(b * 16 + 8 + h);
        const int base = (i >> 1) * 2 + (ug & 1), qb = (i & 1) ? 7 - base : base, w = (i & 1) ? 7 - F.wave : F.wave;
        attn_wave<1>(QH + hb * 2048 * 64, KH + hb * 2048 * 64, VT + hb * 64 * 2048, 256 * qb + 32 * w, opaque_i(F.lane), nullptr, 0.f, nullptr, AO + (size_t)b * 2048 * DM + 512 + h * 64);
    }
}
template <int MODE>
__device__ __forceinline__ void attn_moba_sub(const bf16x8 (&qr)[4], f32x16& O0, f32x16& O1, float& m, float& l, unsigned saddr, int j, int kv0, int q, int q0, int hi, float slope2, bool rowok) {
    bf16x8 kf[4], vf[2][2];
    asm volatile("ds_read_b128 %0, %8\n\tds_read_b128 %1, %8 offset:1024\n\tds_read_b128 %2, %8 offset:2048\n\tds_read_b128 %3, %8 offset:3072\n\t"
                 "ds_read_b128 %4, %9\n\tds_read_b128 %5, %9 offset:1024\n\tds_read_b128 %6, %9 offset:2048\n\tds_read_b128 %7, %9 offset:3072\n\ts_waitcnt lgkmcnt(0)"
                 : "=&v"(kf[0]), "=&v"(kf[1]), "=&v"(kf[2]), "=&v"(kf[3]), "=&v"(vf[0][0]), "=&v"(vf[0][1]), "=&v"(vf[1][0]), "=&v"(vf[1][1])
                 : "v"(saddr + (unsigned)j * 4096u), "v"(saddr + 8192u + (unsigned)j * 4096u) : "memory");
    f32x16 S; const float sbase = slope2 * (float)(kv0 + 8 * hi - q0);
#pragma unroll
    for (int r = 0; r < 16; ++r) S[r] = sbase + slope2 * (float)((r & 7) + 16 * (r >> 3));
#pragma unroll
    for (int d0 = 0; d0 < 4; ++d0) S = __builtin_amdgcn_mfma_f32_32x32x16_bf16(kf[d0], qr[d0], S, 0, 0, 0);
    if (MODE == 1) {
#pragma unroll
        for (int r = 0; r < 16; ++r) { const int key = kv0 + (r & 7) + 8 * hi + 16 * (r >> 3); if (key > q) S[r] = -INFINITY; }
    }
    if (MODE == 2) { if (!rowok) {
#pragma unroll
        for (int r = 0; r < 16; ++r) S[r] = -INFINITY; } }
    float rm = rowmax16_raw(S);
    { const auto rr = __builtin_amdgcn_permlane32_swap(__float_as_uint(rm), __float_as_uint(rm), false, false); rm = max2_raw(__uint_as_float(rr[0]), __uint_as_float(rr[1])); }
    if (__any(rm > m)) { const float mn = fmaxf(fmaxf(m, rm), -1e30f); const float alpha = __builtin_amdgcn_exp2f(m - mn); l *= alpha; O0 *= alpha; O1 *= alpha; m = mn; }
    float p[16]; float ps = 0.f;
#pragma unroll
    for (int r = 0; r < 16; ++r) { p[r] = __builtin_amdgcn_exp2f(S[r] - m); ps += p[r]; }
    l += ps;
    u32x4 w0, w1;
    w0.x = pk2(p[0], p[1]); w0.y = pk2(p[2], p[3]); w0.z = pk2(p[4], p[5]); w0.w = pk2(p[6], p[7]);
    w1.x = pk2(p[8], p[9]); w1.y = pk2(p[10], p[11]); w1.z = pk2(p[12], p[13]); w1.w = pk2(p[14], p[15]);
    const bf16x8 pf0 = __builtin_bit_cast(bf16x8, w0), pf1 = __builtin_bit_cast(bf16x8, w1);
    O0 = __builtin_amdgcn_mfma_f32_32x32x16_bf16(vf[0][0], pf0, O0, 0, 0, 0); O0 = __builtin_amdgcn_mfma_f32_32x32x16_bf16(vf[1][0], pf1, O0, 0, 0, 0);
    O1 = __builtin_amdgcn_mfma_f32_32x32x16_bf16(vf[0][1], pf0, O1, 0, 0, 0); O1 = __builtin_amdgcn_mfma_f32_32x32x16_bf16(vf[1][1], pf1, O1, 0, 0, 0);
}
__device__ __forceinline__ void attn_moba_unit(Frame& F, const bf16_t* Qh, const bf16_t* Kh, const bf16_t* Vth, const float* KMh, const float slope2, const int qb, bf16_t* AOp) {
    const int lane = opaque_i(F.lane), r32 = lane & 31, hi = lane >> 5, r32p = pi32(r32), wave = F.wave, q0 = 256 * qb + 32 * wave, q = q0 + r32;
    LAS unsigned char* ring = F.lds; const unsigned ring_a = (unsigned)(uintptr_t)ring + 16u * (unsigned)lane;
    bf16x8 qr[4];
#pragma unroll
    for (int d0 = 0; d0 < 4; ++d0) qr[d0] = *(const bf16x8*)(Qh + (size_t)q * 64 + 16 * d0 + 8 * hi);
    f32x16 G = f32x16{};
#pragma unroll
    for (int d0 = 0; d0 < 4; ++d0) { u32x4 kw = {0u, 0u, 0u, 0u};
        if (r32 < 8) { const float* kmp = KMh + r32 * 64 + 16 * d0 + 8 * hi; kw = pack8(*(const f32x4*)kmp, *(const f32x4*)(kmp + 4)); }
        G = __builtin_amdgcn_mfma_f32_32x32x16_bf16(__builtin_bit_cast(bf16x8, kw), qr[d0], G, 0, 0, 0); }
    float gate[8];
#pragma unroll
    for (int n = 0; n < 4; ++n) { const float own = G[n], oth = __shfl_xor(own, 32); gate[n] = hi ? oth : own; gate[n + 4] = hi ? own : oth; }
    unsigned sel = 0u; const int nsel = qb < 3 ? qb : 3;
#pragma unroll
    for (int r = 0; r < 3; ++r) if (r < nsel) { float best = -INFINITY; int bi = 0;
#pragma unroll
        for (int n = 0; n < 8; ++n) if (n < qb && !((sel >> n) & 1u) && gate[n] > best) { best = gate[n]; bi = n; }
        sel |= 1u << bi; }
    unsigned wsel = 0u;
#pragma unroll
    for (int n = 0; n < 8; ++n) if (__any((sel >> n) & 1u)) wsel |= 1u << n;
    asm volatile("s_waitcnt vmcnt(0) lgkmcnt(0)" ::: "memory"); __builtin_amdgcn_s_barrier();
    const int NT = 4 * qb + 4, my_last = 4 * qb + (wave >> 1), jdiag = wave & 1;
    attn_dma_tile(Kh, Vth, NT - 1, ring, wave, r32, r32p, hi);
    attn_dma_tile(Kh, Vth, NT - 2, ring + AT_SLOT, wave, r32, r32p, hi);
    attn_dma_tile(Kh, Vth, NT - 3, ring + 2 * AT_SLOT, wave, r32, r32p, hi);
    f32x16 O0 = f32x16{}, O1 = f32x16{}; float m = -INFINITY, l = 0.f;
    int slot = 0;
#pragma unroll 1
    for (int T = NT - 1; T >= 0; --T) {
        if (T >= 2) asm volatile("s_waitcnt vmcnt(4)" ::: "memory"); else if (T == 1) asm volatile("s_waitcnt vmcnt(2)" ::: "memory"); else asm volatile("s_waitcnt vmcnt(0)" ::: "memory");
        __builtin_amdgcn_s_barrier();
        if (T >= 3) { const int fs = (slot + 3) & 3; attn_dma_tile(Kh, Vth, T - 3, ring + fs * AT_SLOT, wave, r32, r32p, hi); }
        const unsigned sa = ring_a + (unsigned)(slot * AT_SLOT);
        if (T >= 4 * qb) {
            if (T == my_last) {
                if (jdiag == 1) { attn_moba_sub<1>(qr, O0, O1, m, l, sa, 1, 64 * T + 32, q, q0, hi, slope2, true); attn_moba_sub<0>(qr, O0, O1, m, l, sa, 0, 64 * T, q, q0, hi, slope2, true); }
                else attn_moba_sub<1>(qr, O0, O1, m, l, sa, 0, 64 * T, q, q0, hi, slope2, true);
            } else if (T < my_last) { attn_moba_sub<0>(qr, O0, O1, m, l, sa, 1, 64 * T + 32, q, q0, hi, slope2, true); attn_moba_sub<0>(qr, O0, O1, m, l, sa, 0, 64 * T, q, q0, hi, slope2, true); }
        } else if ((wsel >> (T >> 2)) & 1u) {
            const bool rowok = (sel >> (T >> 2)) & 1u;
            attn_moba_sub<2>(qr, O0, O1, m, l, sa, 1, 64 * T + 32, q, q0, hi, slope2, rowok); attn_moba_sub<2>(qr, O0, O1, m, l, sa, 0, 64 * T, q, q0, hi, slope2, rowok);
        }
        slot = (slot + 1) & 3;
    }
    const float linv = 1.f / (l + __shfl_xor(l, 32));
    bf16_t* orow = AOp + (size_t)q * DM;
#pragma unroll
    for (int g = 0; g < 4; ++g) { u32x2 w;
        w.x = pk2(O0[4 * g] * linv, O0[4 * g + 1] * linv); w.y = pk2(O0[4 * g + 2] * linv, O0[4 * g + 3] * linv); *(u32x2*)(orow + 8 * g + 4 * hi) = w;
        w.x = pk2(O1[4 * g] * linv, O1[4 * g + 1] * linv); w.y = pk2(O1[4 * g + 2] * linv, O1[4 * g + 3] * linv); *(u32x2*)(orow + 32 + 8 * g + 4 * hi) = w; }
    asm volatile("s_waitcnt vmcnt(0) lgkmcnt(0)" ::: "memory"); __builtin_amdgcn_s_barrier();
}
__device__ __forceinline__ void phase_attn_moba(Frame& F, const bf16_t* QD, const bf16_t* KD, const bf16_t* VTD, float* KMEAN, bf16_t* AO) {
    for (int ug = F.vcu; ug < NB * 8 * 2; ug += F.G) {
        const int bh = ug >> 1, b = bh >> 3, h = bh & 7; const size_t hb = (size_t)bh;
        phase_kmean(F, KD, KMEAN, bh); asm volatile("s_waitcnt vmcnt(0)" ::: "memory"); __syncthreads();
        const float slope2 = __builtin_amdgcn_exp2f(-(float)(h + 1)) * LOG2E;
#pragma unroll 1
        for (int i = 0; i < 4; ++i) { const int base = (i >> 1) * 2 + (ug & 1), qb = (i & 1) ? 7 - base : base;
            attn_moba_unit(F, QD + hb * 2048 * 64, KD + hb * 2048 * 64, VTD + hb * 64 * 2048, KMEAN + (size_t)bh * 8 * 64, slope2, qb, AO + (size_t)b * 2048 * DM + 512 + h * 64); }
    }
}
__device__ __forceinline__ void phase_pool(Frame& F, const bf16_t* XC, const bf16_t* PWT, const float* pool_scale, bf16_t* AO) {
    const int gw = F.vcu * NWAVES + F.wave, NGW = F.G * NWAVES, lane = opaque_i(F.lane), r32 = lane & 31, hi = lane >> 5;
    for (int it = gw; it < (TOK / 32) * 4; it += NGW) {
        const int rnd = it / NGW, gq = it - rnd * NGW;
        const int g = (rnd & 1) ? 3 - (gq & 3) : (gq & 3), t0 = (rnd * (NGW >> 2) + (gq >> 2)) * 32, t = t0 + r32, tl = t & 2047, w = 2 << g;
        const int cnt = (tl + 1) < w ? (tl + 1) : w; const float rc = 1.f / (float)cnt;
        f32x16 acc[4];
#pragma unroll
        for (int nb = 0; nb < 4; ++nb) acc[nb] = f32x16{};
#pragma unroll 1
        for (int kk = 0; kk < 8; ++kk) {
            const int c0 = g * 128 + kk * 16 + hi * 8;
            const u32x4 self = *(const u32x4*)(XC + (size_t)t * 512 + c0);
            float s[8] = {0.f, 0.f, 0.f, 0.f, 0.f, 0.f, 0.f, 0.f};
            for (int i = 0; i < cnt; ++i) { const u32x4 x = *(const u32x4*)(XC + (size_t)(t - i) * 512 + c0);
                s[0] += bf_lo(x.x); s[1] += bf_hi(x.x); s[2] += bf_lo(x.y); s[3] += bf_hi(x.y); s[4] += bf_lo(x.z); s[5] += bf_hi(x.z); s[6] += bf_lo(x.w); s[7] += bf_hi(x.w); }
            u32x4 pa; pa.x = pk2(s[0] * rc - bf_lo(self.x), s[1] * rc - bf_hi(self.x)); pa.y = pk2(s[2] * rc - bf_lo(self.y), s[3] * rc - bf_hi(self.y));
            pa.z = pk2(s[4] * rc - bf_lo(self.z), s[5] * rc - bf_hi(self.z)); pa.w = pk2(s[6] * rc - bf_lo(self.w), s[7] * rc - bf_hi(self.w));
            const bf16x8 af = __builtin_bit_cast(bf16x8, pa);
#pragma unroll
            for (int nb = 0; nb < 4; ++nb) { const bf16x8 bfr = *(const bf16x8*)(PWT + ((size_t)g * 128 + nb * 32 + r32) * 128 + kk * 16 + hi * 8);
                acc[nb] = __builtin_amdgcn_mfma_f32_32x32x16_bf16(af, bfr, acc[nb], 0, 0, 0); }
        }
#pragma unroll
        for (int nb = 0; nb < 4; ++nb) { const int col = g * 128 + nb * 32 + r32; const float sc = pool_scale[col];
#pragma unroll
            for (int r = 0; r < 16; ++r) { const int row = (r & 3) + 8 * (r >> 2) + 4 * hi; AO[(size_t)(t0 + row) * DM + col] = (bf16_t)f2bf(acc[nb][r] * sc); } }
    }
}

__device__ __forceinline__ void phase_topk_naive(Frame& F, const bf16_t* QP, const bf16_t* K1B, const bf16_t* K2B, unsigned short* EID, float* GATE) {
    const int gw = F.vcu * NWAVES + F.wave, NGW = F.G * NWAVES, lane = opaque_i(F.lane);
    for (int task = gw; task < TOK * 8; task += NGW) {
        const int t = task >> 3, h = task & 7;
        const bf16_t* qrow = QP + (size_t)t * 2048 + h * 256; const bf16_t* k1 = K1B + (size_t)h * 128 * 128; const bf16_t* k2 = K2B + (size_t)h * 128 * 128;
        float s1a = 0.f, s1b = 0.f, s2a = 0.f, s2b = 0.f;
#pragma unroll 4
        for (int c = 0; c < 16; ++c) { const u32x4 q1 = *(const u32x4*)(qrow + 8 * c), q2 = *(const u32x4*)(qrow + 128 + 8 * c);
            s1a = dot8(*(const u32x4*)(k1 + (size_t)lane * 128 + 8 * c), q1, s1a); s1b = dot8(*(const u32x4*)(k1 + (size_t)(lane + 64) * 128 + 8 * c), q1, s1b);
            s2a = dot8(*(const u32x4*)(k2 + (size_t)lane * 128 + 8 * c), q2, s2a); s2b = dot8(*(const u32x4*)(k2 + (size_t)(lane + 64) * 128 + 8 * c), q2, s2b); }
        unsigned A = (f2ord(s1a) & ~127u) | (unsigned)(127 - lane), B = (f2ord(s1b) & ~127u) | (unsigned)(63 - lane);
        unsigned top1 = 0u, top2 = 0u, topc = 0u;
        for (int r = 0; r < 16; ++r) { const unsigned m = wave_umax(A > B ? A : B); if (lane == r) top1 = m; if (A == m) A = 0u; if (B == m) B = 0u; }
        A = (f2ord(s2a) & ~127u) | (unsigned)(127 - lane); B = (f2ord(s2b) & ~127u) | (unsigned)(63 - lane);
        for (int r = 0; r < 16; ++r) { const unsigned m = wave_umax(A > B ? A : B); if (lane == r) top2 = m; if (A == m) A = 0u; if (B == m) B = 0u; }
        const float v1 = ord2f(top1 & ~127u), v2 = ord2f(top2 & ~127u); const int i1 = 127 - (int)(top1 & 127u), i2 = 127 - (int)(top2 & 127u);
        const float va = __shfl(v1, lane >> 2); unsigned C[4];
#pragma unroll
        for (int j = 0; j < 4; ++j) { const float vb = __shfl(v2, (lane & 3) * 4 + j); C[j] = (f2ord(va + vb) & ~255u) | (unsigned)(255 - (lane * 4 + j)); }
        for (int r = 0; r < 16; ++r) { unsigned m = C[0] > C[1] ? C[0] : C[1]; const unsigned m2 = C[2] > C[3] ? C[2] : C[3]; m = wave_umax(m > m2 ? m : m2); if (lane == r) topc = m;
#pragma unroll
            for (int j = 0; j < 4; ++j) if (C[j] == m) C[j] = 0u; }
        const int c = 255 - (int)(topc & 255u); const float val = ord2f(topc & ~255u);
        const int ia = __shfl(i1, c >> 4), ib = __shfl(i2, c & 15);
        const float v0 = __shfl(val, 0); const float e = (lane < 16) ? __expf(val - v0) : 0.f; const float sum = wave_sum(e);
        if (lane < 16) { EID[(size_t)t * 128 + h * 16 + lane] = (unsigned short)(ia * 128 + ib); GATE[(size_t)t * 128 + h * 16 + lane] = e / sum; }
    }
}

#define DEVFN __device__ __forceinline__
template <int OFF, int N, int TOT> DEVFN void bitonic_sort_desc(unsigned (&a)[TOT]) {
#pragma unroll
    for (int k = 2; k <= N; k <<= 1)
#pragma unroll
        for (int j = k >> 1; j > 0; j >>= 1)
#pragma unroll
            for (int i = 0; i < N; ++i) { const int l = i ^ j; if (l > i) { const bool desc = ((i & k) == 0); const unsigned x = a[OFF + i], y = a[OFF + l];
                const unsigned mx = x > y ? x : y, mn = x > y ? y : x; a[OFF + i] = desc ? mx : mn; a[OFF + l] = desc ? mn : mx; } }
}
constexpr int OE16_N = 63;
constexpr unsigned char OE16[63][2] = {{0,1}, {2,3}, {0,2}, {1,3}, {1,2}, {4,5}, {6,7}, {4,6}, {5,7}, {5,6}, {0,4}, {2,6}, {2,4}, {1,5}, {3,7}, {3,5}, {1,2}, {3,4}, {5,6}, {8,9}, {10,11}, {8,10}, {9,11}, {9,10}, {12,13}, {14,15}, {12,14}, {13,15}, {13,14}, {8,12}, {10,14}, {10,12}, {9,13}, {11,15}, {11,13}, {9,10}, {11,12}, {13,14}, {0,8}, {4,12}, {4,8}, {2,10}, {6,14}, {6,10}, {2,4}, {6,8}, {10,12}, {1,9}, {5,13}, {5,9}, {3,11}, {7,15}, {7,11}, {3,5}, {7,9}, {11,13}, {1,2}, {3,4}, {5,6}, {7,8}, {9,10}, {11,12}, {13,14}};
template <int OFF, int TOT> DEVFN void sort16_desc(unsigned (&a)[TOT]) {
#pragma unroll
    for (int q = 0; q < OE16_N; ++q) { const int i = OFF + OE16[q][0], l = OFF + OE16[q][1]; const unsigned x = a[i], y = a[l]; a[i] = x > y ? x : y; a[l] = x > y ? y : x; }
}
template <int OFF, int TOT> DEVFN void bitonic_merge16_desc(unsigned (&a)[TOT]) {
#pragma unroll
    for (int j = 8; j > 0; j >>= 1)
#pragma unroll
        for (int i = 0; i < 16; ++i) { const int l = i ^ j; if (l > i) { const unsigned x = a[OFF + i], y = a[OFF + l]; a[OFF + i] = x > y ? x : y; a[OFF + l] = x > y ? y : x; } }
}
template <int A, int B, int TOT> DEVFN void merge_top16(unsigned (&a)[TOT]) {
#pragma unroll
    for (int i = 0; i < 16; ++i) { const unsigned x = a[A + i], y = a[B + 15 - i]; a[A + i] = x > y ? x : y; }
    bitonic_merge16_desc<A, TOT>(a);
}
DEVFN void top16of64(unsigned (&a)[64]) {
    sort16_desc<0, 64>(a); sort16_desc<16, 64>(a); sort16_desc<32, 64>(a); sort16_desc<48, 64>(a);
    merge_top16<0, 16, 64>(a); merge_top16<32, 48, 64>(a); merge_top16<0, 32, 64>(a);
}

constexpr int TK_KSTRIDE = 272, TK_KSET = 128 * TK_KSTRIDE, TK_KBYTES = 2 * TK_KSET;
__device__ __forceinline__ void phase_topk(Frame& F, const bf16_t* QP, const bf16_t* K1B, const bf16_t* K2B, unsigned short* EID, float* GATE) {
    const int lane = opaque_i(F.lane), r32 = lane & 31, hi = lane >> 5, b = (int)blockIdx.x, h = b & 7, nbh = F.G >> 3;
    { u32x4 kv[8];
#pragma unroll
      for (int k = 0; k < 8; ++k) { const int c = F.tid + k * (NWAVES * 64), sub = c >> 11, n = (c >> 4) & 127, part = c & 15; kv[k] = *(const u32x4*)((sub ? K2B : K1B) + ((size_t)h * 128 + n) * 128 + 8 * part); }
#pragma unroll
      for (int k = 0; k < 8; ++k) { const int c = F.tid + k * (NWAVES * 64), sub = c >> 11, n = (c >> 4) & 127, part = c & 15; *(LAS u32x4*)(F.lds + sub * TK_KSET + n * TK_KSTRIDE + 16 * part) = kv[k]; } }
    __syncthreads();
    LAS unsigned* I1s = (LAS unsigned*)(F.lds + TK_KBYTES + F.wave * 8192); LAS unsigned* I2s = I1s + 1024;
    bf16x8 qn[8];
    { const int tile0 = (b >> 3) + nbh * F.wave; const bf16_t* qrow = QP + (size_t)((tile0 < TOK / 32 ? tile0 : 0) * 32 + r32) * 2048 + h * 256 + 8 * hi;
#pragma unroll
      for (int kk = 0; kk < 8; ++kk) qn[kk] = *(const bf16x8*)(qrow + 16 * kk); }
    for (int tile = (b >> 3) + nbh * F.wave; tile < TOK / 32; tile += nbh * NWAVES) {
        const int t = tile * 32 + r32;
        unsigned V1[16], V2[16]; unsigned h4 = (unsigned)hi << 2; asm volatile("" : "+v"(h4));
#pragma unroll
        for (int half = 0; half < 2; ++half) {
            bf16x8 qf[8];
#pragma unroll
            for (int kk = 0; kk < 8; ++kk) qf[kk] = qn[kk];
            { const int tnx = tile + nbh * NWAVES, tl = half ? (tnx < TOK / 32 ? tnx : tile) : tile;
              const bf16_t* qrow = QP + (size_t)(tl * 32 + r32) * 2048 + h * 256 + (half ? 0 : 128) + 8 * hi;
#pragma unroll
              for (int kk = 0; kk < 8; ++kk) qn[kk] = *(const bf16x8*)(qrow + 16 * kk); }
            unsigned K[64];
#pragma unroll
            for (int nb = 0; nb < 4; ++nb) { f32x16 acc = f32x16{};
                LAS const unsigned char* kb = F.lds + half * TK_KSET + (nb * 32 + r32) * TK_KSTRIDE + 16 * hi; asm volatile("" : "+v"(kb));
#pragma unroll
                for (int kk = 0; kk < 8; ++kk) acc = __builtin_amdgcn_mfma_f32_32x32x16_bf16(*(LAS const bf16x8*)(kb + 32 * kk), qf[kk], acc, 0, 0, 0);
#pragma unroll
                for (int r = 0; r < 16; ++r) {
                    const unsigned x = __float_as_uint(acc[r]), o = x ^ ((unsigned)((int)x >> 31) | 0x80000000u); const int j = r >> 2;
                    const unsigned pack = (unsigned)(127 - (nb * 32 + 0 + 8 * j)) | ((unsigned)(127 - (nb * 32 + 1 + 8 * j)) << 8) | ((unsigned)(127 - (nb * 32 + 2 + 8 * j)) << 16) | ((unsigned)(127 - (nb * 32 + 3 + 8 * j)) << 24);
                    K[nb * 16 + r] = __builtin_amdgcn_perm(o, pack, 0x07060500u | (unsigned)(r & 3)); }
                __builtin_amdgcn_sched_barrier(0); }
            __builtin_amdgcn_sched_barrier(0); top16of64(K); __builtin_amdgcn_sched_barrier(0);
#pragma unroll
            for (int i = 0; i < 16; ++i) K[i] ^= h4;
            unsigned C[16];
#pragma unroll
            for (int i = 0; i < 16; ++i) { const unsigned y = (unsigned)__shfl_xor((int)K[15 - i], 32); C[i] = K[i] > y ? K[i] : y; }
            bitonic_merge16_desc<0, 16>(C);
#pragma unroll
            for (int i = 0; i < 16; ++i) { if (half == 0) V1[i] = C[i]; else V2[i] = C[i]; }
            __builtin_amdgcn_sched_barrier(0);
        }
        float f1[16], f2[16];
#pragma unroll
        for (int a = 0; a < 16; ++a) { I1s[a * 64 + lane] = 127u - (V1[a] & 127u); I2s[a * 64 + lane] = 127u - (V2[a] & 127u); f1[a] = ord2f(V1[a] & ~127u); f2[a] = ord2f(V2[a] & ~127u); }
        __builtin_amdgcn_sched_barrier(0);
        unsigned Cd[64];
    Cd[0] = (f2ord(f1[0] + f2[0]) & ~255u) | 255u;
    Cd[1] = (f2ord(f1[0] + f2[1]) & ~255u) | 254u;
    Cd[2] = (f2ord(f1[0] + f2[2]) & ~255u) | 253u;
    Cd[3] = (f2ord(f1[0] + f2[3]) & ~255u) | 252u;
    Cd[4] = (f2ord(f1[0] + f2[4]) & ~255u) | 251u;
    Cd[5] = (f2ord(f1[0] + f2[5]) & ~255u) | 250u;
    Cd[6] = (f2ord(f1[0] + f2[6]) & ~255u) | 249u;
    Cd[7] = (f2ord(f1[0] + f2[7]) & ~255u) | 248u;
    Cd[8] = (f2ord(f1[0] + f2[8]) & ~255u) | 247u;
    Cd[9] = (f2ord(f1[0] + f2[9]) & ~255u) | 246u;
    Cd[10] = (f2ord(f1[0] + f2[10]) & ~255u) | 245u;
    Cd[11] = (f2ord(f1[0] + f2[11]) & ~255u) | 244u;
    Cd[12] = (f2ord(f1[0] + f2[12]) & ~255u) | 243u;
    Cd[13] = (f2ord(f1[0] + f2[13]) & ~255u) | 242u;
    Cd[14] = (f2ord(f1[0] + f2[14]) & ~255u) | 241u;
    Cd[15] = (f2ord(f1[0] + f2[15]) & ~255u) | 240u;
    Cd[16] = (f2ord(f1[1] + f2[0]) & ~255u) | 239u;
    Cd[17] = (f2ord(f1[1] + f2[1]) & ~255u) | 238u;
    Cd[18] = (f2ord(f1[1] + f2[2]) & ~255u) | 237u;
    Cd[19] = (f2ord(f1[1] + f2[3]) & ~255u) | 236u;
    Cd[20] = (f2ord(f1[1] + f2[4]) & ~255u) | 235u;
    Cd[21] = (f2ord(f1[1] + f2[5]) & ~255u) | 234u;
    Cd[22] = (f2ord(f1[1] + f2[6]) & ~255u) | 233u;
    Cd[23] = (f2ord(f1[1] + f2[7]) & ~255u) | 232u;
    Cd[24] = (f2ord(f1[2] + f2[0]) & ~255u) | 223u;
    Cd[25] = (f2ord(f1[2] + f2[1]) & ~255u) | 222u;
    Cd[26] = (f2ord(f1[2] + f2[2]) & ~255u) | 221u;
    Cd[27] = (f2ord(f1[2] + f2[3]) & ~255u) | 220u;
    Cd[28] = (f2ord(f1[2] + f2[4]) & ~255u) | 219u;
    Cd[29] = (f2ord(f1[3] + f2[0]) & ~255u) | 207u;
    Cd[30] = (f2ord(f1[3] + f2[1]) & ~255u) | 206u;
    Cd[31] = (f2ord(f1[3] + f2[2]) & ~255u) | 205u;
    Cd[32] = (f2ord(f1[3] + f2[3]) & ~255u) | 204u;
    Cd[33] = (f2ord(f1[4] + f2[0]) & ~255u) | 191u;
    Cd[34] = (f2ord(f1[4] + f2[1]) & ~255u) | 190u;
    Cd[35] = (f2ord(f1[4] + f2[2]) & ~255u) | 189u;
    Cd[36] = (f2ord(f1[5] + f2[0]) & ~255u) | 175u;
    Cd[37] = (f2ord(f1[5] + f2[1]) & ~255u) | 174u;
    Cd[38] = (f2ord(f1[6] + f2[0]) & ~255u) | 159u;
    Cd[39] = (f2ord(f1[6] + f2[1]) & ~255u) | 158u;
    Cd[40] = (f2ord(f1[7] + f2[0]) & ~255u) | 143u;
    Cd[41] = (f2ord(f1[7] + f2[1]) & ~255u) | 142u;
    Cd[42] = (f2ord(f1[8] + f2[0]) & ~255u) | 127u;
    Cd[43] = (f2ord(f1[9] + f2[0]) & ~255u) | 111u;
    Cd[44] = (f2ord(f1[10] + f2[0]) & ~255u) | 95u;
    Cd[45] = (f2ord(f1[11] + f2[0]) & ~255u) | 79u;
    Cd[46] = (f2ord(f1[12] + f2[0]) & ~255u) | 63u;
    Cd[47] = (f2ord(f1[13] + f2[0]) & ~255u) | 47u;
    Cd[48] = (f2ord(f1[14] + f2[0]) & ~255u) | 31u;
    Cd[49] = (f2ord(f1[15] + f2[0]) & ~255u) | 15u;
    Cd[50] = 0u;
    Cd[51] = 0u;
    Cd[52] = 0u;
    Cd[53] = 0u;
    Cd[54] = 0u;
    Cd[55] = 0u;
    Cd[56] = 0u;
    Cd[57] = 0u;
    Cd[58] = 0u;
    Cd[59] = 0u;
    Cd[60] = 0u;
    Cd[61] = 0u;
    Cd[62] = 0u;
    Cd[63] = 0u;
        __builtin_amdgcn_sched_barrier(0); top16of64(Cd); __builtin_amdgcn_sched_barrier(0);
        LDS_WAIT();
        unsigned eid[16]; float e[16]; float sum = 0.f; const float v0 = ord2f(Cd[0] & ~255u);
#pragma unroll
        for (int r = 0; r < 16; ++r) { const unsigned c = 255u - (Cd[r] & 255u); eid[r] = I1s[(c >> 4) * 64 + lane] * 128u + I2s[(c & 15u) * 64 + lane];
            e[r] = __builtin_amdgcn_exp2f((ord2f(Cd[r] & ~255u) - v0) * LOG2E); sum += e[r]; }
        const float inv = 1.f / sum;
        u32x4 ew; ew.x = (hi ? eid[8] : eid[0]) | ((hi ? eid[9] : eid[1]) << 16); ew.y = (hi ? eid[10] : eid[2]) | ((hi ? eid[11] : eid[3]) << 16);
        ew.z = (hi ? eid[12] : eid[4]) | ((hi ? eid[13] : eid[5]) << 16); ew.w = (hi ? eid[14] : eid[6]) | ((hi ? eid[15] : eid[7]) << 16);
        *(u32x4*)(EID + (size_t)t * 128 + h * 16 + 8 * hi) = ew;
        const f32x4 g0 = {(hi ? e[8] : e[0]) * inv, (hi ? e[9] : e[1]) * inv, (hi ? e[10] : e[2]) * inv, (hi ? e[11] : e[3]) * inv};
        const f32x4 g1 = {(hi ? e[12] : e[4]) * inv, (hi ? e[13] : e[5]) * inv, (hi ? e[14] : e[6]) * inv, (hi ? e[15] : e[7]) * inv};
        *(f32x4*)(GATE + (size_t)t * 128 + h * 16 + 8 * hi) = g0; *(f32x4*)(GATE + (size_t)t * 128 + h * 16 + 8 * hi + 4) = g1;
        LDS_WAIT();
    }
}

typedef float f32x2 __attribute__((ext_vector_type(2)));
__device__ __forceinline__ float dpp_f(float v, int sel) {
    const int iv = __builtin_bit_cast(int, v); int r;
    if (sel == 0) r = __builtin_amdgcn_update_dpp(0, iv, 0xB1, 0xf, 0xf, true); else if (sel == 1) r = __builtin_amdgcn_update_dpp(0, iv, 0x4E, 0xf, 0xf, true); else r = __builtin_amdgcn_update_dpp(0, iv, 0x141, 0xf, 0xf, true);
    return __builtin_bit_cast(float, r);
}
__device__ __forceinline__ float gelu_erf(float v) {
    const float av = fabsf(v), d = av * 0.2316418882f + 1.0f; const float t = __builtin_amdgcn_rcpf(d);
    float q = t * 0.5307027145f + (-0.7265760135f); q = q * t + 0.7107068705f; q = q * t + (-0.142248368f); q = q * t + 0.127414796f; q = q * t;
    const float e = __builtin_amdgcn_exp2f((v * v) * (-0.72134752044f));
    const float m = v * (q * e), r = v - m; return v < 0.f ? m : r;
}
typedef _Float16 h16x2 __attribute__((ext_vector_type(2)));
__device__ __forceinline__ h16x2 bf8_lo2(unsigned w) { return __builtin_bit_cast(h16x2, __builtin_amdgcn_perm(0u, w, 0x010c000cu)); }
__device__ __forceinline__ h16x2 bf8_hi2(unsigned w) { return __builtin_bit_cast(h16x2, __builtin_amdgcn_perm(0u, w, 0x030c020cu)); }
__device__ __forceinline__ h16x2 bf16pair_to_h2(unsigned w) { h16x2 r; r.x = (_Float16)bf_lo(w); r.y = (_Float16)bf_hi(w); return r; }
#define PEER_E(ev0_, ev1_, w_) (int)((((w_) < 8 ? (ev0_) : (ev1_))[((w_) & 7) >> 1] >> (16 * ((w_) & 1))) & 0xffffu)
#define GLD4(dst_, ptr_) asm volatile("global_load_dword %0, %1, off" : "=v"(dst_) : "v"(ptr_) : "memory")
#define GLD8(dst_, ptr_) asm volatile("global_load_dwordx2 %0, %1, off" : "=v"(dst_) : "v"(ptr_) : "memory")
#define GLD16(dst_, ptr_) asm volatile("global_load_dwordx4 %0, %1, off" : "=v"(dst_) : "v"(ptr_) : "memory")
#define GLDS16(dst_, off_, base_) asm volatile("global_load_dwordx4 %0, %1, %2" : "=v"(dst_) : "v"(off_), "s"(base_) : "memory")
typedef int i32x4 __attribute__((ext_vector_type(4)));
__device__ __forceinline__ int sdot8_z(int a, int b) { int d; asm("v_dot8_i32_i4 %0, %1, %2, 0" : "=v"(d) : "v"(a), "v"(b)); return d; }
__device__ __forceinline__ int sdot4_z(int a, int b) { int d; asm("v_dot4_i32_i8 %0, %1, %2, 0" : "=v"(d) : "v"(a), "v"(b)); return d; }
__device__ __forceinline__ unsigned u_quant4(u32x2 w, unsigned sqbits) {
    float sq = __uint_as_float(sqbits); sq += dpp_row_shr(sq, 1); sq += dpp_row_shr(sq, 2); sq += dpp_row_shr(sq, 4); sq += dpp_row_shr(sq, 8);
    sq = __builtin_bit_cast(float, __builtin_amdgcn_readlane(__builtin_bit_cast(int, sq), 15));
    const float sx = __builtin_amdgcn_rsqf(sq * (1.f / DM) + RMS_EPS) * I8_SX;
    const float v[4] = {bf_lo(w.x), bf_hi(w.x), bf_lo(w.y), bf_hi(w.y)}; unsigned A = 0u, B = 0u;
#pragma unroll
    for (int k = 0; k < 4; ++k) { int q = __float2int_rn(v[k] * sx); q = q < -120 ? -120 : (q > 119 ? 119 : q); const int a = (q + 8) >> 4, bb = q - 16 * a;
        A |= ((unsigned)a & 0xfu) << (4 * k); B |= ((unsigned)bb & 0xfu) << (4 * k); }
    return A | (B << 16);
}
template <int CP> __device__ __forceinline__ unsigned peer_bc_t(unsigned ev) { return (unsigned)__builtin_amdgcn_update_dpp(__builtin_amdgcn_update_dpp(0, (int)ev, 0x150 + CP, 0xf, 0x3, false), (int)ev, 0x158 + CP, 0xf, 0xc, false); }
__device__ __forceinline__ unsigned peer_bc(unsigned ev, int cp) {
    switch (cp) { case 0: return peer_bc_t<0>(ev); case 1: return peer_bc_t<1>(ev); case 2: return peer_bc_t<2>(ev); case 3: return peer_bc_t<3>(ev);
                  case 4: return peer_bc_t<4>(ev); case 5: return peer_bc_t<5>(ev); case 6: return peer_bc_t<6>(ev); default: return peer_bc_t<7>(ev); }
}
#define PEER_BC(ev_, cp_) peer_bc((ev_), (cp_))
#define PEER_E2(bc_, w_) (((w_) & 1) ? ((bc_) >> 16) : ((bc_) & 0xffffu))
__device__ __forceinline__ void phase_peer_u(Frame& F, const bf16_t* XB, const float* rsp, int rsmode, const unsigned short* EID, const unsigned char* U8S, int* PREP) {
    const int lane = opaque_i(F.lane), i16 = (lane >> 3) * 16, c = lane & 7, b = (int)blockIdx.x, x = b & 3, step = (F.G >> 2) * NWAVES;
    const unsigned c16 = 16u * (unsigned)c;
    const unsigned char* tabs = U8S + (size_t)x * NEXP * 128;
    LAS unsigned char* xl = F.lds + F.wave * 512;
    int t = (b >> 2) * NWAVES + F.wave; unsigned slot = 0;
    unsigned evB; u32x4 uw[16]; u32x2 xwA; unsigned sqA;
    {   unsigned e0 = *(const unsigned*)(EID + (size_t)t * 128 + i16 + 2 * c);
        u32x2 xw0 = *(const u32x2*)(XB + (size_t)t * DM + 256 * x + 4 * lane); unsigned sq0 = __float_as_uint(rsp[(size_t)t * 16 + (lane & 15)]);
        const int tn = (t + step < TOK) ? t + step : t;
        evB = *(const unsigned*)(EID + (size_t)tn * 128 + i16 + 2 * c);
        xwA = *(const u32x2*)(XB + (size_t)tn * DM + 256 * x + 4 * lane); sqA = __float_as_uint(rsp[(size_t)tn * 16 + (lane & 15)]);
        asm volatile("s_waitcnt vmcnt(0)" : "+v"(evB), "+v"(e0), "+v"(xwA), "+v"(sqA), "+v"(xw0), "+v"(sq0) :: "memory");
        { const unsigned ab = u_quant4(xw0, sq0); *(LAS unsigned short*)(xl + 2 * lane) = (unsigned short)ab; *(LAS unsigned short*)(xl + 128 + 2 * lane) = (unsigned short)(ab >> 16); }
#pragma unroll
        for (int w = 0; w < 16; w += 2) { const unsigned bc = PEER_BC(e0, w >> 1); const unsigned off0 = (PEER_E2(bc, 0) << 7) | c16, off1 = (PEER_E2(bc, 1) << 7) | c16; GLDS16(uw[w], off0, tabs); GLDS16(uw[w + 1], off1, tabs); } }
#pragma unroll 1
    for (; t < TOK; t += step) {
        const int tnn = (t + 2 * step < TOK) ? t + 2 * step : t;
        unsigned evC, sqC, bcw = 0u; u32x2 xwC;
        { const unsigned short* ep = EID + (size_t)tnn * 128 + i16 + 2 * c; const bf16_t* xp = XB + (size_t)tnn * DM + 256 * x + 4 * lane; const float* sp = rsp + (size_t)tnn * 16 + (lane & 15);
          GLD4(evC, ep); GLD8(xwC, xp); GLD4(sqC, sp); }
        { const unsigned ab = u_quant4(xwA, sqA); *(LAS unsigned short*)(xl + (slot ^ 256u) + 2 * lane) = (unsigned short)ab; *(LAS unsigned short*)(xl + (slot ^ 256u) + 128 + 2 * lane) = (unsigned short)(ab >> 16); }
        const u32x4 xa = *(LAS const u32x4*)(xl + slot + c16), xb = *(LAS const u32x4*)(xl + slot + 128 + c16);
        slot ^= 256u;
        int p[16];
#pragma unroll
        for (int w = 0; w < 16; ++w) {
            asm volatile("s_waitcnt vmcnt(18)" : "+v"(uw[w]) :: "memory");
            int a = sdot8_z((int)uw[w][0], (int)xa[0]), bl = sdot8_z((int)uw[w][0], (int)xb[0]);
#pragma unroll
            for (int k = 1; k < 4; ++k) { a = __builtin_amdgcn_sdot8((int)uw[w][k], (int)xa[k], a, false); bl = __builtin_amdgcn_sdot8((int)uw[w][k], (int)xb[k], bl, false); }
            p[w] = (a << 4) + bl;
            asm volatile("" : "+v"(p[w]));
            if ((w & 1) == 0) bcw = PEER_BC(evB, w >> 1);
            { const unsigned off = (PEER_E2(bcw, w) << 7) | c16; GLDS16(uw[w], off, tabs); }
        }
        asm volatile("s_nop 1\n\t"
#define UA_(k_, k8_) "v_add_u32_dpp %" #k_ ", %" #k_ ", %" #k_ " row_shl:4 row_mask:0xf bank_mask:0x5\n\t" "v_add_u32_dpp %" #k_ ", %" #k8_ ", %" #k8_ " row_shr:4 row_mask:0xf bank_mask:0xa\n\t"
            UA_(0, 8) UA_(1, 9) UA_(2, 10) UA_(3, 11) UA_(4, 12) UA_(5, 13) UA_(6, 14) UA_(7, 15)
#undef UA_
#define UB_(k_) "v_add_u32_dpp %" #k_ ", %" #k_ ", %" #k_ " quad_perm:[2,3,0,1] row_mask:0xf bank_mask:0xf\n\t"
            UB_(0) UB_(1) UB_(2) UB_(3) UB_(4) UB_(5) UB_(6) UB_(7)
#undef UB_
#define UC_(k_) "v_add_u32_dpp %" #k_ ", %" #k_ ", %" #k_ " quad_perm:[1,0,3,2] row_mask:0xf bank_mask:0xf\n\t"
            UC_(0) UC_(1) UC_(2) UC_(3) UC_(4) UC_(5) UC_(6) UC_(7)
#undef UC_
            "s_nop 0"
            : "+v"(p[0]), "+v"(p[1]), "+v"(p[2]), "+v"(p[3]), "+v"(p[4]), "+v"(p[5]), "+v"(p[6]), "+v"(p[7])
            : "v"(p[8]), "v"(p[9]), "v"(p[10]), "v"(p[11]), "v"(p[12]), "v"(p[13]), "v"(p[14]), "v"(p[15]));
        if ((c & 3) == 0) {
            int* dst = PREP + ((size_t)x * TOK + t) * 128 + i16 + 2 * c;
            *(i32x4*)dst = i32x4{p[0], p[1], p[2], p[3]}; *(i32x4*)(dst + 4) = i32x4{p[4], p[5], p[6], p[7]}; }
        asm volatile("s_waitcnt vmcnt(16)" : "+v"(evC), "+v"(xwC), "+v"(sqC) :: "memory");
        evB = evC; xwA = xwC; sqA = sqC;
    }
    asm volatile("s_waitcnt vmcnt(0)" ::: "memory");
}
__device__ __forceinline__ void phase_peer_c(Frame& F, const int* PREP, const float* GATE, unsigned char* ACO8, float* ASC  ) {
    const int gw = F.vcu * NWAVES + F.wave, NGW = F.G * NWAVES, lane = opaque_i(F.lane);
    for (int t0 = gw * 4; t0 < TOK; t0 += NGW * 4) {
        int pv[4][4][2]; float gt[4][2];
#pragma unroll
        for (int q = 0; q < 4; ++q) {
#pragma unroll
            for (int x = 0; x < 4; ++x) { const int* p = PREP + ((size_t)x * TOK + t0 + q) * 128; pv[q][x][0] = p[lane]; pv[q][x][1] = p[64 + lane]; }
            gt[q][0] = GATE[(size_t)(t0 + q) * 128 + lane]; gt[q][1] = GATE[(size_t)(t0 + q) * 128 + 64 + lane]; }
#pragma unroll
        for (int q = 0; q < 4; ++q) { const int t = t0 + q;
            const int i0 = (pv[q][0][0] + pv[q][1][0]) + (pv[q][2][0] + pv[q][3][0]), i1 = (pv[q][0][1] + pv[q][1][1]) + (pv[q][2][1] + pv[q][3][1]);
            const float rsu = 1.f / (I4_SU * I8_SX);
            const float a0 = gelu_erf((float)i0 * rsu) * gt[q][0], a1 = gelu_erf((float)i1 * rsu) * gt[q][1];
            float m = fmaxf(fabsf(a0), fabsf(a1));
            m = fmaxf(m, dpp_row_shr(m, 1)); m = fmaxf(m, dpp_row_shr(m, 2)); m = fmaxf(m, dpp_row_shr(m, 4)); m = fmaxf(m, dpp_row_shr(m, 8));
            m = fmaxf(m, __builtin_bit_cast(float, __builtin_amdgcn_update_dpp(0, __builtin_bit_cast(int, m), 0x142, 0xa, 0xf, false)));
            m = fmaxf(m, __builtin_bit_cast(float, __builtin_amdgcn_update_dpp(0, __builtin_bit_cast(int, m), 0x143, 0xc, 0xf, false)));
            m = __builtin_bit_cast(float, __builtin_amdgcn_readlane(__builtin_bit_cast(int, m), 63));
            const float inv = m > 0.f ? 127.f / m : 0.f;
            const int q0 = __float2int_rn(a0 * inv), q1 = __float2int_rn(a1 * inv);
            ACO8[(size_t)t * 128 + lane] = (unsigned char)(q0 & 0xff); ACO8[(size_t)t * 128 + 64 + lane] = (unsigned char)(q1 & 0xff);
            const float sa = wave_total((float)(q0 + q1)), scl = m * (1.f / (127.f * I4_SV));
            if (lane == 0) { ASC[2 * (size_t)t] = scl; ASC[2 * (size_t)t + 1] = 8.f * sa * scl; } }
    }
}
#define PIN16(o_) asm volatile("" : "+v"(o_[0]), "+v"(o_[1]), "+v"(o_[2]), "+v"(o_[3]), "+v"(o_[4]), "+v"(o_[5]), "+v"(o_[6]), "+v"(o_[7]), "+v"(o_[8]), "+v"(o_[9]), "+v"(o_[10]), "+v"(o_[11]), "+v"(o_[12]), "+v"(o_[13]), "+v"(o_[14]), "+v"(o_[15]))
__device__ __forceinline__ void red16_groups(const int (&o)[16], bool b3, int& r0, int& r1) {
    int h8[8], h4[4];
#pragma unroll
    for (int k = 0; k < 8; ++k) { const auto r = __builtin_amdgcn_permlane32_swap((unsigned)o[k], (unsigned)o[8 + k], false, false); h8[k] = (int)r[0] + (int)r[1]; }
#pragma unroll
    for (int k = 0; k < 4; ++k) { const auto r = __builtin_amdgcn_permlane16_swap((unsigned)h8[k], (unsigned)h8[4 + k], false, false); h4[k] = (int)r[0] + (int)r[1]; }
    { const int keep = b3 ? h4[2] : h4[0], send = b3 ? h4[0] : h4[2]; r0 = keep + __builtin_amdgcn_update_dpp(0, send, 0x128, 0xf, 0xf, true); }
    { const int keep = b3 ? h4[3] : h4[1], send = b3 ? h4[1] : h4[3]; r1 = keep + __builtin_amdgcn_update_dpp(0, send, 0x128, 0xf, 0xf, true); }
}
__device__ __forceinline__ void phase_peer_v(Frame& F, bf16_t* XB, const unsigned short* EID, const unsigned char* ACO8, const float* ASC, const unsigned char* V4S, float* SSQP) {
    const int lane = opaque_i(F.lane), i16 = (lane >> 3) * 16, c = lane & 7, b = (int)blockIdx.x, x = b & 3, step = (F.G >> 2) * NWAVES;
    const unsigned c16 = 16u * (unsigned)c;
    const unsigned char* tabs = V4S + (size_t)x * NEXP * 128;
    const bool b3 = lane & 8;
    const int col = 256 * x + 32 * c + ((lane & 32) ? 16 : 0) + ((lane & 16) ? 8 : 0) + (b3 ? 4 : 0);
    int t = (b >> 2) * NWAVES + F.wave;
    u32x4 aA, vw[16]; unsigned evB; u32x2 xfA, scA;
    {   unsigned e0 = *(const unsigned*)(EID + (size_t)t * 128 + i16 + 2 * c);
        aA = *(const u32x4*)(ACO8 + (size_t)t * 128 + i16);
        xfA = *(const u32x2*)(XB + (size_t)t * DM + col); scA = *(const u32x2*)(ASC + 2 * (size_t)t);
        const int tn = (t + step < TOK) ? t + step : t;
        evB = *(const unsigned*)(EID + (size_t)tn * 128 + i16 + 2 * c);
        asm volatile("s_waitcnt vmcnt(0)" : "+v"(evB), "+v"(e0), "+v"(aA), "+v"(xfA), "+v"(scA) :: "memory");
#pragma unroll
        for (int w = 0; w < 16; w += 2) { const unsigned bc = PEER_BC(e0, w >> 1); const unsigned off0 = (PEER_E2(bc, 0) << 7) | c16, off1 = (PEER_E2(bc, 1) << 7) | c16; GLDS16(vw[w], off0, tabs); GLDS16(vw[w + 1], off1, tabs); } }
#pragma unroll 1
    for (; t < TOK; t += step) {
        const int tn = (t + step < TOK) ? t + step : t, tnn = (t + 2 * step < TOK) ? t + 2 * step : t;
        u32x4 aB; unsigned evC; u32x2 xfB, scB;
        { const unsigned short* ep = EID + (size_t)tnn * 128 + i16 + 2 * c; const unsigned char* ap = ACO8 + (size_t)tn * 128 + i16; const bf16_t* xp = XB + (size_t)tn * DM + col; const float* sp = ASC + 2 * (size_t)tn;
          GLD4(evC, ep); GLD16(aB, ap); GLD8(xfB, xp); GLD8(scB, sp); }
        int oL[16], oP[16];
#pragma unroll
        for (int w = 0; w < 16; w += 4) {
            asm volatile("s_waitcnt vmcnt(16)" : "+v"(vw[w]), "+v"(vw[w + 1]), "+v"(vw[w + 2]), "+v"(vw[w + 3]) :: "memory");
            const int a4 = (int)aA[w >> 2];
#pragma unroll
            for (int k = 0; k < 4; ++k) { const unsigned d0 = vw[w][k], d1 = vw[w + 1][k], d2 = vw[w + 2][k], d3 = vw[w + 3][k];
                const unsigned q01l = __builtin_amdgcn_perm(d1, d0, 0x05010400u), q01h = __builtin_amdgcn_perm(d1, d0, 0x07030602u), q23l = __builtin_amdgcn_perm(d3, d2, 0x05010400u), q23h = __builtin_amdgcn_perm(d3, d2, 0x07030602u);
                const int t0 = (int)__builtin_amdgcn_perm(q23l, q01l, 0x05040100u), t1 = (int)__builtin_amdgcn_perm(q23l, q01l, 0x07060302u), t2 = (int)__builtin_amdgcn_perm(q23h, q01h, 0x05040100u), t3 = (int)__builtin_amdgcn_perm(q23h, q01h, 0x07060302u);
                const int l0 = t0 & 0x0f0f0f0f, l1 = t1 & 0x0f0f0f0f, l2 = t2 & 0x0f0f0f0f, l3 = t3 & 0x0f0f0f0f;
                if (w == 0) { oL[4 * k] = sdot4_z(l0, a4); oL[4 * k + 1] = sdot4_z(l1, a4); oL[4 * k + 2] = sdot4_z(l2, a4); oL[4 * k + 3] = sdot4_z(l3, a4);
                              oP[4 * k] = sdot4_z(t0, a4); oP[4 * k + 1] = sdot4_z(t1, a4); oP[4 * k + 2] = sdot4_z(t2, a4); oP[4 * k + 3] = sdot4_z(t3, a4); }
                else { oL[4 * k]     = __builtin_amdgcn_sdot4(l0, a4, oL[4 * k], false);     oL[4 * k + 1] = __builtin_amdgcn_sdot4(l1, a4, oL[4 * k + 1], false);
                       oL[4 * k + 2] = __builtin_amdgcn_sdot4(l2, a4, oL[4 * k + 2], false); oL[4 * k + 3] = __builtin_amdgcn_sdot4(l3, a4, oL[4 * k + 3], false);
                       oP[4 * k]     = __builtin_amdgcn_sdot4(t0, a4, oP[4 * k], false);     oP[4 * k + 1] = __builtin_amdgcn_sdot4(t1, a4, oP[4 * k + 1], false);
                       oP[4 * k + 2] = __builtin_amdgcn_sdot4(t2, a4, oP[4 * k + 2], false); oP[4 * k + 3] = __builtin_amdgcn_sdot4(t3, a4, oP[4 * k + 3], false); } }
            PIN16(oL); PIN16(oP);
            { const unsigned bc0 = PEER_BC(evB, w >> 1), bc1 = PEER_BC(evB, (w >> 1) + 1);
              const unsigned off0 = (PEER_E2(bc0, 0) << 7) | c16, off1 = (PEER_E2(bc0, 1) << 7) | c16, off2 = (PEER_E2(bc1, 0) << 7) | c16, off3 = (PEER_E2(bc1, 1) << 7) | c16;
              GLDS16(vw[w], off0, tabs); GLDS16(vw[w + 1], off1, tabs); GLDS16(vw[w + 2], off2, tabs); GLDS16(vw[w + 3], off3, tabs); } }
        int L0, L1, P0, P1; red16_groups(oL, b3, L0, L1); red16_groups(oP, b3, P0, P1);
        const float sc = __uint_as_float(scA.x), corr = __uint_as_float(scA.y);
        const float f0 = bf_lo(xfA.x) + ((float)L0 * sc - corr), f1 = bf_hi(xfA.x) + (float)((P0 - L0) >> 4) * sc, f2 = bf_lo(xfA.y) + ((float)L1 * sc - corr), f3 = bf_hi(xfA.y) + (float)((P1 - L1) >> 4) * sc;
        { u32x2 st; st.x = pk2(f0, f1); st.y = pk2(f2, f3); *(u32x2*)(XB + (size_t)t * DM + col) = st; }
        const float ss = wave_total((f0 * f0 + f1 * f1) + (f2 * f2 + f3 * f3));
        if (lane == 0) { float* sp = SSQP + (size_t)t * 16 + x; sp[0] = ss; sp[4] = 0.f; sp[8] = 0.f; sp[12] = 0.f; }
        asm volatile("s_waitcnt vmcnt(16)" : "+v"(evC), "+v"(aB), "+v"(xfB), "+v"(scB) :: "memory");
        aA = aB; evB = evC; xfA = xfB; scA = scB;
    }
    asm volatile("s_waitcnt vmcnt(0)" ::: "memory");
}

__device__ __forceinline__ void phase_final_norm(Frame& F, const bf16_t* XB, float* OUT, const float* SSQP, const float* norm_f) {
    const int gw = F.vcu * NWAVES + F.wave, NGW = F.G * NWAVES, lane = opaque_i(F.lane);
    f32x4 nf[4];
#pragma unroll
    for (int j = 0; j < 4; ++j) nf[j] = *(const f32x4*)(norm_f + 256 * j + 4 * lane);
    for (int t0 = gw * 4; t0 < TOK; t0 += NGW * 4) {
        float r[4]; u32x2 w[4][4];
#pragma unroll
        for (int q = 0; q < 4; ++q) { r[q] = row_scale(SSQP, 1, t0 + q);
#pragma unroll
            for (int j = 0; j < 4; ++j) w[q][j] = *(const u32x2*)(XB + (size_t)(t0 + q) * DM + 256 * j + 4 * lane); }
#pragma unroll
        for (int q = 0; q < 4; ++q)
#pragma unroll
            for (int j = 0; j < 4; ++j) { const f32x4 x = {bf_lo(w[q][j].x), bf_hi(w[q][j].x), bf_lo(w[q][j].y), bf_hi(w[q][j].y)};
                __builtin_nontemporal_store(x * r[q] * nf[j], (f32x4*)(OUT + (size_t)(t0 + q) * DM + 256 * j + 4 * lane)); }
    }
}

constexpr int N_PHASES = 20;
struct Args { const float* in[16]; float* out; unsigned char* ws; int ph_lo, ph_hi; };
template <bool COOP>
__global__ void __launch_bounds__(NWAVES * 64, 2) mk_fwd(Args args) {
    extern __shared__ __attribute__((aligned(16))) unsigned char lds[];
    Frame F;
    F.lds = (LAS unsigned char*)lds;
    F.tid = threadIdx.x; F.lane = F.tid & 63; F.wave = __builtin_amdgcn_readfirstlane(F.tid >> 6);
    F.G = gridDim.x; { const int bx = blockIdx.x; F.vcu = (F.G % 8 == 0) ? (bx % 8) * (F.G / 8) + bx / 8 : bx; }
    Ptrs P;
    P.x = args.in[0]; P.norm_mix = args.in[1]; P.norm_ffn = args.in[2]; P.ev_w_in = args.in[3]; P.ev_b_f = args.in[4]; P.ev_w_out = args.in[5]; P.od_w_in = args.in[6];
    P.od_pool_w = args.in[7]; P.od_pool_scale = args.in[8]; P.od_w_out = args.in[9]; P.peer_wq = args.in[10]; P.peer_k1 = args.in[11]; P.peer_k2 = args.in[12];
    P.peer_u = args.in[13]; P.peer_v = args.in[14]; P.norm_f = args.in[15]; P.out = args.out; P.ws = args.ws;
    unsigned char* ws = args.ws;
    bf16_t* XB = (bf16_t*)(ws + WS_XB); bf16_t* AO = (bf16_t*)(ws + WS_AO); bf16_t* QP = (bf16_t*)(ws + WS_QP);
    unsigned short* EID = (unsigned short*)(ws + WS_EID); float* GATE = (float*)(ws + WS_GATE);
    float* RS0 = (float*)(ws + WS_RS0); float* SSQ2 = (float*)(ws + WS_SSQ2); int* PREP = (int*)(ws + WS_PREP); unsigned char* ACO8 = ws + WS_ACO; float* ASC = (float*)(ws + WS_ACO + 8 * MiB); float* SSQ1 = (float*)(ws + WS_SSQ1); float* SSQ3 = (float*)(ws + WS_SSQ3);
    const int lo = args.ph_lo, hi = args.ph_hi;
    volatile LAS unsigned* xbst = (volatile LAS unsigned*)(F.lds + LDS_BYTES - 64);
    if (F.tid < 4) xbst[F.tid] = 0u;
    __syncthreads();
    XcdBarrier xbar; xbar.bar = (unsigned*)(ws + WS_CTL) + 4096; xbar.x = 0; xbar.st = xbst;
    if (COOP) xbar = xcd_barrier_post((unsigned*)(ws + WS_CTL) + 4096, xbst);
#define IN(k) (lo <= (k) && (k) < hi)
#define SEAM(k) do { if (COOP && IN(k) && IN((k) + 1)) xcd_barrier(xbar); } while (0)
    if (COOP && lo < 0) cg::this_grid().sync();
    if (IN(0)) { phase_p0(F, P); } SEAM(0);
    if (IN(1)) {
        pg8::Gemm g{XB, (const bf16_t*)(ws + WS_W1T), TOK, 3072, DM}; pg8::StaticOrder S; S.init(TOK, 3072, F.G, (int)blockIdx.x);
        EpiL0In E{RS0, (bf16_t*)(ws + WS_QH), (bf16_t*)(ws + WS_KH), (bf16_t*)(ws + WS_VT), (float*)(ws + WS_LF), P.ev_b_f};
        pg8::gemm_phase<EpiL0In, pg8::StaticOrder, true, true>(F.lds, g, S, E);
    } SEAM(1);
    if (IN(3)) {
        phase_attn_fox(F, (const bf16_t*)(ws + WS_QH), (const bf16_t*)(ws + WS_KH), (const bf16_t*)(ws + WS_VT), (const float*)(ws + WS_LF), (float*)(ws + WS_CF), AO);
        phase_attn_sb_dyn(F, (const bf16_t*)(ws + WS_QH), (const bf16_t*)(ws + WS_KH), (const bf16_t*)(ws + WS_VT), AO, (unsigned*)(ws + WS_CTL) + 16384);
    } SEAM(3);
    if (IN(4)) {
        pg8::Gemm g{AO, (const bf16_t*)(ws + WS_W2T), TOK, DM, DM}; pg8::StaticOrder S; S.init(TOK, DM, F.G, (int)blockIdx.x);
        EpiRes<false> E{P.x, XB, SSQ1};
        pg8::gemm_phase<EpiRes<false>, pg8::StaticOrder, true, true>(F.lds, g, S, E);
    } SEAM(4);
    if (IN(5)) {
        pg8::Gemm g{XB, (const bf16_t*)(ws + WS_W3T), TOK, 2048, DM}; pg8::StaticOrder S; S.init(TOK, 2048, F.G, (int)blockIdx.x);
        EpiQ E{SSQ1, 1, QP};
        pg8::gemm_phase<EpiQ, pg8::StaticOrder, true, true>(F.lds, g, S, E);
    } SEAM(5);
    if (IN(6)) { phase_topk(F, QP, (const bf16_t*)(ws + WS_K1B), (const bf16_t*)(ws + WS_K2B), EID, GATE); } SEAM(6);
    if (IN(7)) { phase_peer_u(F, XB, SSQ1, 1, EID, ws + WS_U8S, PREP); } SEAM(7);
    if (IN(8)) { phase_peer_c(F, PREP, GATE, ACO8, ASC); } SEAM(8);
    if (IN(9)) { phase_peer_v(F, XB, EID, ACO8, ASC, ws + WS_V8S, SSQ2); } SEAM(9);
    if (IN(10)) {
        pg8::Gemm g{XB, (const bf16_t*)(ws + WS_W4T), TOK, 2048, DM}; pg8::StaticOrder S; S.init(TOK, 2048, F.G, (int)blockIdx.x);
        EpiL1In E{SSQ2, 1, (bf16_t*)(ws + WS_QH), (bf16_t*)(ws + WS_QH + 32 * MiB), (bf16_t*)(ws + WS_KH), (bf16_t*)(ws + WS_KH + 32 * MiB)};
        pg8::gemm_phase<EpiL1In, pg8::StaticOrder, true, true>(F.lds, g, S, E);
    } SEAM(10);
    if (IN(12)) {
        phase_attn_moba(F, (const bf16_t*)(ws + WS_QH + 32 * MiB), (const bf16_t*)(ws + WS_KH), (const bf16_t*)(ws + WS_KH + 32 * MiB), (float*)(ws + WS_KMEAN), AO);
        phase_pool(F, (const bf16_t*)(ws + WS_QH), (const bf16_t*)(ws + WS_PWT), P.od_pool_scale, AO);
    } SEAM(12);
    if (IN(13)) {
        pg8::Gemm g{AO, (const bf16_t*)(ws + WS_W5T), TOK, DM, DM}; pg8::StaticOrder S; S.init(TOK, DM, F.G, (int)blockIdx.x);
        EpiRes<true> E{XB, XB, SSQ3};
        pg8::gemm_phase<EpiRes<true>, pg8::StaticOrder, true, true>(F.lds, g, S, E);
    } SEAM(13);
    if (IN(14)) {
        pg8::Gemm g{XB, (const bf16_t*)(ws + WS_W6T), TOK, 2048, DM}; pg8::StaticOrder S; S.init(TOK, 2048, F.G, (int)blockIdx.x);
        EpiQ E{SSQ3, 1, QP};
        pg8::gemm_phase<EpiQ, pg8::StaticOrder, true, true>(F.lds, g, S, E);
    } SEAM(14);
    if (IN(15)) { phase_topk(F, QP, (const bf16_t*)(ws + WS_K1B) + 8 * 128 * 128, (const bf16_t*)(ws + WS_K2B) + 8 * 128 * 128, EID, GATE); } SEAM(15);
    if (IN(16)) { phase_peer_u(F, XB, SSQ3, 1, EID, ws + WS_U8S + (size_t)4 * NEXP * 128, PREP); } SEAM(16);
    if (IN(17)) { phase_peer_c(F, PREP, GATE, ACO8, ASC); } SEAM(17);
    if (IN(18)) { phase_peer_v(F, XB, EID, ACO8, ASC, ws + WS_V8S + (size_t)4 * NEXP * 128, SSQ2); } SEAM(18);
    if (IN(19)) { phase_final_norm(F, XB, P.out, SSQ2, P.norm_f); }
#undef IN
#undef SEAM
}

extern "C" void kernel_launch(void* const* d_in, const int* in_sizes, int n_in, void* d_out, int out_size, void* d_ws, size_t ws_size, hipStream_t stream) {
    static int grid = 0;
    constexpr bool COOP = (MK_MULTI == 0);
    if (grid == 0) {
        if (n_in != 16 || in_sizes[0] != TOK * DM || out_size != TOK * DM || ws_size < WS_END) { fprintf(stderr, "kernel_launch: unexpected shapes (n_in %d, in0 %d, out %d, ws %zu)\n", n_in, n_in > 0 ? in_sizes[0] : -1, out_size, ws_size); grid = -1; return; }
        int dev = 0, cus = 0, per_cu = 0;
        if (hipGetDevice(&dev) != hipSuccess || hipDeviceGetAttribute(&cus, hipDeviceAttributeMultiprocessorCount, dev) != hipSuccess) { grid = -1; return; }
        if (hipFuncSetAttribute((const void*)mk_fwd<COOP>, hipFuncAttributeMaxDynamicSharedMemorySize, LDS_BYTES) != hipSuccess) { fprintf(stderr, "kernel_launch: hipFuncSetAttribute failed\n"); grid = -1; return; }
        if (hipOccupancyMaxActiveBlocksPerMultiprocessor(&per_cu, (const void*)mk_fwd<COOP>, NWAVES * 64, LDS_BYTES) != hipSuccess || per_cu < 1) { fprintf(stderr, "kernel_launch: occupancy query says %d\n", per_cu); per_cu = 1; }
        (void)hipGetLastError();
        grid = cus;
    }
    if (grid < 0) return;
    if (hipMemsetAsync((char*)d_ws + WS_CTL, 0, CTL_ZERO_BYTES, stream) != hipSuccess) { fprintf(stderr, "kernel_launch: memset failed\n"); return; }
    Args a{};
    for (int i = 0; i < 16; ++i) a.in[i] = (const float*)d_in[i];
    a.out = (float*)d_out; a.ws = (unsigned char*)d_ws;
    if (COOP) {
        a.ph_lo = 0; a.ph_hi = N_PHASES;
        void* kargs[] = {&a};
        const hipError_t e = hipLaunchCooperativeKernel((const void*)mk_fwd<COOP>, dim3(grid), dim3(NWAVES * 64), kargs, LDS_BYTES, stream);
        if (e != hipSuccess) fprintf(stderr, "kernel_launch: cooperative launch failed: %s (grid %d)\n", hipGetErrorString(e), grid);
    } else {
        for (int p = 0; p < N_PHASES; ++p) { a.ph_lo = p; a.ph_hi = p + 1; hipLaunchKernelGGL(mk_fwd<COOP>, dim3(grid), dim3(NWAVES * 64), LDS_BYTES, stream, a); }
    }
}
```
